# Optimizing an MI355X kernel written in HIP

```python
import jax, jax.numpy as jnp
from jax import lax
import numpy as np

D_MODEL = 2048
BATCH = 2
SEQ = 8192
DEPTH = 4

HEAD_DIM = 128
A_HEADS = 8
A_KV_HEADS = 2
A_GROUP = A_HEADS // A_KV_HEADS
B_HEADS = 8
D_A = A_HEADS * HEAD_DIM
D_B = B_HEADS * HEAD_DIM
KV_DIM = A_KV_HEADS * HEAD_DIM
D_MIX = D_A + D_B
D_IN = 2 * D_A + 2 * KV_DIM + 4 * D_B
GRID_W = 64
AXIS_DIM = HEAD_DIM // 2
ROPE_THETA = 10000.0
Q_BLOCK = 128
DILATED_PATTERNS = ((128, 1), (512, 4), (2048, 16))
MAX_REACH = 1024
ALIBI_SLOPES = (2.0 ** -np.arange(1, B_HEADS + 1)).astype(np.float32)
SCALE = HEAD_DIM ** -0.5
EPS = 1e-6
NEG_INF = -1e30

kernel_name = 'hymba_axial_gqa_dilated_encoder'


def rms_norm(x, w):
    xf = x.astype(jnp.float32)
    y = xf * lax.rsqrt(jnp.mean(xf * xf, axis=-1, keepdims=True) + EPS)
    return (y * w.astype(jnp.float32)).astype(x.dtype)


def axial_rope_tables(T):
    rows = T // GRID_W
    row = jnp.broadcast_to(jnp.arange(rows, dtype=jnp.float32)[:, None], (rows, GRID_W)).reshape(-1)
    col = jnp.broadcast_to(jnp.arange(GRID_W, dtype=jnp.float32)[None, :], (rows, GRID_W)).reshape(-1)
    inv_freq = ROPE_THETA ** (-jnp.arange(0, AXIS_DIM, 2, dtype=jnp.float32) / AXIS_DIM)
    ang_r = row[:, None] * inv_freq[None, :]
    ang_c = col[:, None] * inv_freq[None, :]
    return (jnp.cos(ang_r), jnp.sin(ang_r), jnp.cos(ang_c), jnp.sin(ang_c))


def rotate_axis(x, cos, sin):
    x1, x2 = jnp.split(x, 2, axis=-1)
    return jnp.concatenate([x1 * cos - x2 * sin, x1 * sin + x2 * cos], axis=-1)


def apply_axial_rope(x, tables):
    cr, sr, cc, sc = tables
    xf = x.astype(jnp.float32)
    out = jnp.concatenate([rotate_axis(xf[..., :AXIS_DIM], cr, sr),
                           rotate_axis(xf[..., AXIS_DIM:], cc, sc)], axis=-1)
    return out.astype(x.dtype)


def axial_gqa(q, k, v, q_gain, k_gain, tables):
    B_, T = q.shape[0], q.shape[1]
    nb = T // Q_BLOCK
    q = apply_axial_rope(rms_norm(q, q_gain).transpose(0, 2, 1, 3), tables)
    k = apply_axial_rope(rms_norm(k, k_gain).transpose(0, 2, 1, 3), tables)
    v = v.transpose(0, 2, 1, 3)
    qb = jnp.moveaxis(q.reshape(B_, A_KV_HEADS, A_GROUP, nb, Q_BLOCK, HEAD_DIM), 3, 0)

    def one_block(qblk):
        s = jnp.einsum('bkgqd,bksd->bkgqs', qblk, k, preferred_element_type=jnp.float32) * SCALE
        p = jax.nn.softmax(s, axis=-1).astype(v.dtype)
        return jnp.einsum('bkgqs,bksd->bkgqd', p, v)

    o = lax.map(one_block, qb)
    o = jnp.moveaxis(o, 0, 3).reshape(B_, A_HEADS, T, HEAD_DIM)
    return o.transpose(0, 2, 1, 3).reshape(B_, T, D_A)


def dilated_attention(q, k, v):
    B_, T = q.shape[0], q.shape[1]
    nb = T // Q_BLOCK
    q = q.transpose(0, 2, 1, 3)
    pad = ((0, 0), (0, 0), (MAX_REACH, MAX_REACH), (0, 0))
    kp = jnp.pad(k.transpose(0, 2, 1, 3), pad)
    vp = jnp.pad(v.transpose(0, 2, 1, 3), pad)
    span = Q_BLOCK + 2 * MAX_REACH
    qb = jnp.moveaxis(q.reshape(B_, B_HEADS, nb, Q_BLOCK, HEAD_DIM), 2, 0)

    patterns = []
    for w, d in DILATED_PATTERNS:
        n = w // (2 * d)
        offs = (np.arange(-n, n + 1) * d).astype(np.int32)
        idx = np.arange(Q_BLOCK, dtype=np.int32)[:, None] + MAX_REACH + offs[None, :]
        bias = -ALIBI_SLOPES[:, None, None] * np.abs(offs).astype(np.float32)[None, None, :]
        patterns.append((offs, idx, bias))

    def one_block(args):
        blk, qblk = args
        t0 = blk * Q_BLOCK
        kc = lax.dynamic_slice_in_dim(kp, t0, span, axis=2)
        vc = lax.dynamic_slice_in_dim(vp, t0, span, axis=2)
        outs, lses = [], []
        for offs, idx, bias in patterns:
            kg = kc[:, :, idx, :]
            vg = vc[:, :, idx, :]
            pos = t0 + jnp.arange(Q_BLOCK)[:, None] + offs[None, :]
            valid = (pos >= 0) & (pos < T)
            s = jnp.einsum('bhqd,bhqjd->bhqj', qblk, kg, preferred_element_type=jnp.float32) * SCALE + bias
            s = jnp.where(valid, s, NEG_INF)
            lse = jax.nn.logsumexp(s, axis=-1, keepdims=True)
            p = jnp.exp(s - lse).astype(vg.dtype)
            outs.append(jnp.einsum('bhqj,bhqjd->bhqd', p, vg, preferred_element_type=jnp.float32))
            lses.append(lse)
        wts = jax.nn.softmax(jnp.stack(lses, axis=0), axis=0)
        o = jnp.sum(wts * jnp.stack(outs, axis=0), axis=0)
        return o.astype(qblk.dtype)

    o = lax.map(one_block, (jnp.arange(nb), qb))
    o = jnp.moveaxis(o, 0, 2).reshape(B_, B_HEADS, T, HEAD_DIM)
    return o.transpose(0, 2, 1, 3).reshape(B_, T, D_B)


def setup_inputs(seed: int = 0) -> dict:
    key = jax.random.key(seed)
    ks = jax.random.split(key, 9)
    f32 = jnp.float32
    x = jax.random.normal(ks[0], (BATCH, SEQ, D_MODEL), f32)
    norm_w = 1.0 + 0.02 * jax.random.normal(ks[1], (DEPTH, D_MODEL), f32)
    w_in = jax.random.normal(ks[2], (DEPTH, D_MODEL, D_IN), f32) * D_MODEL ** -0.5
    q_norm_a = 1.0 + 0.02 * jax.random.normal(ks[3], (DEPTH, HEAD_DIM), f32)
    k_norm_a = 1.0 + 0.02 * jax.random.normal(ks[4], (DEPTH, HEAD_DIM), f32)
    out_norm_a = 1.0 + 0.02 * jax.random.normal(ks[5], (DEPTH, D_A), f32)
    out_norm_b = 1.0 + 0.02 * jax.random.normal(ks[6], (DEPTH, D_B), f32)
    w_out = jax.random.normal(ks[7], (DEPTH, D_MIX, D_MODEL), f32) * D_MIX ** -0.5
    final_norm = 1.0 + 0.02 * jax.random.normal(ks[8], (D_MODEL,), f32)
    return {'x': x, 'norm_w': norm_w, 'w_in': w_in, 'q_norm_a': q_norm_a, 'k_norm_a': k_norm_a,
            'out_norm_a': out_norm_a, 'out_norm_b': out_norm_b, 'w_out': w_out, 'final_norm': final_norm}


def reference(x, norm_w, w_in, q_norm_a, k_norm_a, out_norm_a, out_norm_b, w_out, final_norm):
    B_, T, _ = x.shape
    tables = axial_rope_tables(T)
    splits = [int(s) for s in np.cumsum([D_A, KV_DIM, KV_DIM, D_A, D_B, D_B, D_B])]
    for l in range(DEPTH):
        h = rms_norm(x, norm_w[l])
        proj = h @ w_in[l]
        q_a, k_a, v_a, g_a, q_b, k_b, v_b, g_b = jnp.split(proj, splits, axis=-1)
        y_a = axial_gqa(q_a.reshape(B_, T, A_HEADS, HEAD_DIM),
                        k_a.reshape(B_, T, A_KV_HEADS, HEAD_DIM),
                        v_a.reshape(B_, T, A_KV_HEADS, HEAD_DIM),
                        q_norm_a[l], k_norm_a[l], tables)
        y_b = dilated_attention(q_b.reshape(B_, T, B_HEADS, HEAD_DIM),
                                k_b.reshape(B_, T, B_HEADS, HEAD_DIM),
                                v_b.reshape(B_, T, B_HEADS, HEAD_DIM))
        y = jnp.concatenate([rms_norm(y_a, out_norm_a[l]) * jax.nn.silu(g_a),
                             rms_norm(y_b, out_norm_b[l]) * jax.nn.silu(g_b)], axis=-1)
        x = x + y @ w_out[l]
    return rms_norm(x, final_norm)
```

```cpp
#include <hip/hip_runtime.h>
#include <hip/hip_bf16.h>
#include <hip/hip_cooperative_groups.h>
#include <cstdio>
#include <cstdint>
namespace cg = cooperative_groups;

#ifndef MK_DUP
#define MK_DUP 0
#endif
#define DUPREP(k) for (int rep_ = 0; rep_ < 1 + ((MK_DUP >> (k)) & 1); ++rep_)
#ifndef MK_ONE_LAUNCH
#define MK_ONE_LAUNCH 1
#endif

constexpr int BATCH = 2, T = 8192, DM = 2048, DEPTH = 4, HD = 128, DA = 1024, DB = 1024, DIN = 6656, M = BATCH * T;
constexpr int C_QA = 0, C_KA = 1024, C_VA = 1280, C_GA = 1536, C_QB = 2560, C_KB = 3584, C_VB = 4608, C_GB = 5632;
constexpr int H_QA = 0, H_KA = 8, H_VA = 10, H_GA = 12, H_QB = 20, H_KB = 28, H_VB = 36, H_GB = 44;
constexpr float EPS = 1e-6f;
__device__ __forceinline__ int otid() { int t = threadIdx.x; asm volatile("" : "+v"(t)); return t; }

namespace pg8 {
#define PG8_LAS __attribute__((address_space(3)))
typedef unsigned short bf16_t;
typedef short bf16x8 __attribute__((ext_vector_type(8)));
typedef float f32x4 __attribute__((ext_vector_type(4)));
typedef unsigned u32x4 __attribute__((ext_vector_type(4)));
constexpr int BM = 256, BK = 64, HALF = 128, HTB = HALF * BK * 2  , STAGE_BYTES = 8 * HTB, NXCD = 8, WGM = 8;

__host__ __device__ __forceinline__ int lds_byte(int r, int c) { const int st = (r >> 4) * 2 + (c >> 5), rr = r & 15, cc = c & 31, ob = rr * 64 + cc * 2; return st * 1024 + (ob ^ (((ob >> 9) & 1) << 5)); }
__host__ __device__ __forceinline__ void stage_rc(int b, int& R, int& C) { const int st = b / 1024, sb = b % 1024, swz = sb ^ (((sb >> 9) & 1) << 5); R = (st >> 1) * 16 + swz / 64; C = (st & 1) * 32 + (swz % 64) / 2; }
__host__ __device__ __forceinline__ int perm32(int rho) { const int n = rho >> 4, i = rho & 15; return 8 * (i >> 2) + 4 * n + (i & 3); }

struct Unit { int pm, pn; };
struct Gemm { const bf16_t* A; const bf16_t* Bt; int M, N, K; };

struct StaticOrder {
    int nM, nN, nwg, G, c;
    __host__ __device__ void init(int M, int N, int G_, int c_) { nM = M / BM; nN = N / BM; nwg = nM * nN; G = G_; c = c_; }
    __host__ __device__ bool next(int i, Unit& u) const {
        const long L = (long)i * G + c; if (L >= nwg) return false;
        int wgid = (int)L; { const int q = nwg / NXCD, r = nwg % NXCD, xcd = wgid % NXCD, off = wgid / NXCD; wgid = (xcd < r ? xcd * (q + 1) : r * (q + 1) + (xcd - r) * q) + off; }
        const int nig = WGM * nN, gid = wgid / nig, fm = gid * WGM, gsz = (nM - fm) < WGM ? (nM - fm) : WGM;
        u.pm = fm + ((wgid % nig) % gsz); u.pn = (wgid % nig) / gsz; return true;
    }
    __device__ __forceinline__ void a_ready(const Unit&) const {}
    __device__ __forceinline__ void done(const Unit&) const {}
};

__device__ __forceinline__ unsigned cvt_pk_bf16(float lo, float hi) { unsigned r; asm volatile("v_cvt_pk_bf16_f32 %0, %1, %2" : "=v"(r) : "v"(lo), "v"(hi)); return r; }
typedef float f32x2 __attribute__((ext_vector_type(2)));
__device__ __forceinline__ f32x2 gelu_pk(f32x2 v) {
    const f32x2 av = __builtin_elementwise_abs(v), d = av * 0.2316418882f + 1.0f;
    f32x2 t; t.x = __builtin_amdgcn_rcpf(d.x); t.y = __builtin_amdgcn_rcpf(d.y);
    f32x2 q = t * 0.5307027145f + (-0.7265760135f); q = q * t + 0.7107068705f; q = q * t + (-0.142248368f); q = q * t + 0.127414796f; q = q * t;
    const f32x2 s = (v * v) * (-0.72134752044f);
    f32x2 e; e.x = __builtin_amdgcn_exp2f(s.x); e.y = __builtin_amdgcn_exp2f(s.y);
    const f32x2 m = v * (q * e), r = v - m;
    f32x2 o; o.x = v.x < 0.f ? m.x : r.x; o.y = v.y < 0.f ? m.y : r.y; return o;
}

template <int ACT  > struct EpiBf16 {
    static constexpr bool PERM = true, AFTER_DRAIN = false; static_assert(ACT == 0 || ACT == 1, "EpiBf16: ACT is 0 (none) or 1 (gelu_pk)");
    bf16_t* O; int ldc; const float* bias; int split_cols; size_t split_stride; float scale0;
    __device__ __forceinline__ void operator()(const f32x4 (&acc)[2][2][4][2], const Unit& u, int wr, int wc, int fr, int fq) const {
        const int row0 = u.pm * BM + wr * 64 + fr; int colt = u.pn * BM; bf16_t* base = O;
        float sc = 1.f; if (split_cols) { const int t = colt / split_cols; base += (size_t)t * split_stride; colt -= t * split_cols; if (t == 0) sc = scale0; }
        const int col0 = colt + wc * 32 + 8 * fq, bcol0 = u.pn * BM + wc * 32 + 8 * fq;
        f32x4 bv[2][2];
#pragma unroll
        for (int bj = 0; bj < 2; ++bj)
#pragma unroll
            for (int n = 0; n < 2; ++n) bv[bj][n] = bias ? *(const f32x4*)(bias + bcol0 + bj * HALF + 4 * n) : (f32x4){0.f, 0.f, 0.f, 0.f};
#pragma unroll
        for (int ai = 0; ai < 2; ++ai)
#pragma unroll
            for (int m = 0; m < 4; ++m) { bf16_t* rowp = base + (size_t)(row0 + ai * HALF + m * 16) * ldc + col0;
#pragma unroll
                for (int bj = 0; bj < 2; ++bj) { f32x4 v0 = acc[ai][bj][m][0] + bv[bj][0], v1 = acc[ai][bj][m][1] + bv[bj][1];
                    if (ACT == 1) { f32x2 a = gelu_pk((f32x2){v0[0], v0[1]}), b = gelu_pk((f32x2){v0[2], v0[3]}), c = gelu_pk((f32x2){v1[0], v1[1]}), d = gelu_pk((f32x2){v1[2], v1[3]});
                        v0 = (f32x4){a.x, a.y, b.x, b.y}; v1 = (f32x4){c.x, c.y, d.x, d.y}; }
                    v0 = v0 * sc; v1 = v1 * sc; u32x4 w; w.x = cvt_pk_bf16(v0[0], v0[1]); w.y = cvt_pk_bf16(v0[2], v0[3]); w.z = cvt_pk_bf16(v1[0], v1[1]); w.w = cvt_pk_bf16(v1[2], v1[3]);
                    *(u32x4*)(rowp + bj * HALF) = w; } }
    }
};
struct EpiHeadMajor {
    static constexpr bool PERM = true, AFTER_DRAIN = false;
    bf16_t* O; int Mrows; const float* rowsq; float inv_k, eps;
    __device__ __forceinline__ void operator()(const f32x4 (&acc)[2][2][4][2], const Unit& u, int wr, int wc, int fr, int fq) const {
        const int row0 = u.pm * BM + wr * 64 + fr, col0 = wc * 32 + 8 * fq;
#pragma unroll
        for (int ai = 0; ai < 2; ++ai) {
            f32x4 pa[4], pb[4];
#pragma unroll
            for (int m = 0; m < 4; ++m) { const f32x4* pp = (const f32x4*)(rowsq + (size_t)(row0 + ai * HALF + m * 16) * 32 + 8 * fq); pa[m] = pp[0]; pb[m] = pp[1]; }
#pragma unroll
            for (int m = 0; m < 4; ++m) { const int row = row0 + ai * HALF + m * 16; const f32x4 a = pa[m], b = pb[m];
                float sq = ((a[0] + a[1]) + (a[2] + a[3])) + ((b[0] + b[1]) + (b[2] + b[3])); sq += __shfl_xor(sq, 16); sq += __shfl_xor(sq, 32);
                const float rs = 1.0f / sqrtf(sq * inv_k + eps);
#pragma unroll
                for (int bj = 0; bj < 2; ++bj) { const f32x4 v0 = acc[ai][bj][m][0] * rs, v1 = acc[ai][bj][m][1] * rs;
                    u32x4 w; w.x = cvt_pk_bf16(v0[0], v0[1]); w.y = cvt_pk_bf16(v0[2], v0[3]); w.z = cvt_pk_bf16(v1[0], v1[1]); w.w = cvt_pk_bf16(v1[2], v1[3]);
                    *(u32x4*)(O + ((size_t)(u.pn * 2 + bj) * Mrows + row) * HALF + col0) = w; } }
            asm volatile("" ::: "memory"); }
    }
};
struct EpiResF32 {
    static constexpr bool PERM = false, AFTER_DRAIN = false;
    const float* base; float* out; bf16_t* xb; float* rowsq; int ldc;
    __device__ __forceinline__ void operator()(const f32x4 (&acc)[2][2][4][2], const Unit& u, int wr, int wc, int fr, int fq) const {
        typedef unsigned u32x2v __attribute__((ext_vector_type(2)));
        const int col0 = u.pn * BM + wc * 32 + 4 * fq;
#pragma unroll
        for (int ai = 0; ai < 2; ++ai)
#pragma unroll
            for (int m = 0; m < 4; ++m) { const int row = u.pm * BM + ai * HALF + wr * 64 + m * 16 + fr; const size_t off = (size_t)row * ldc + col0; float ss = 0.f;
#pragma unroll
                for (int bj = 0; bj < 2; ++bj)
#pragma unroll
                    for (int n = 0; n < 2; ++n) { const f32x4 v = *(const f32x4*)(base + off + bj * HALF + n * 16) + acc[ai][bj][m][n];
                        *(f32x4*)(out + off + bj * HALF + n * 16) = v;
                        ss += (v[0] * v[0] + v[1] * v[1]) + (v[2] * v[2] + v[3] * v[3]);
                        u32x2v w; w.x = cvt_pk_bf16(v[0], v[1]); w.y = cvt_pk_bf16(v[2], v[3]);
                        *(u32x2v*)(xb + off + bj * HALF + n * 16) = w; }
                ss += __shfl_xor(ss, 16); ss += __shfl_xor(ss, 32);
                if (fq == 0) rowsq[(size_t)row * 32 + u.pn * 4 + wc] = ss; }
    }
};


template <class Epi, class Sched, bool ALIGN_EPI = false, bool SP2 = false>
__device__ __forceinline__ void gemm_phase(PG8_LAS unsigned char* lds, const Gemm g, const Sched& S, const Epi& E) {
    const int tid = otid(), wid = __builtin_amdgcn_readfirstlane(tid >> 6), lane = tid & 63, wr = wid >> 2, wc = wid & 3, fr = lane & 15, fq = lane >> 4;
    const int K = g.K, nt = K / BK;
    unsigned voffA[2], voffB[2];
#pragma unroll
    for (int i = 0; i < 2; ++i) { int R, C; stage_rc(tid * 16 + i * 8192, R, C); const int Rb = Epi::PERM ? ((R & ~31) + perm32(R & 31)) : R;
        voffA[i] = (unsigned)(R * K + C) * 2u; voffB[i] = (unsigned)(Rb * K + C) * 2u; }
    const size_t kstep = (size_t)(BK * 2);
    const size_t hstep = (size_t)HALF * K * 2;
    const size_t tstep = 2 * hstep;
    const unsigned ldsw = (unsigned)wid * 1024u;
    const int aoff = lds_byte(wr * 64 + fr, fq * 8), boff = lds_byte(wc * 32 + fr, fq * 8);
#define PG8_SA(b, h) (((b) * 2 + (h)) * HTB)
#define PG8_SB(b, h) ((4 + (b) * 2 + (h)) * HTB)
#define PG8_STAGE(bufoff, gbase, voff) do { _Pragma("unroll") for (int _i = 0; _i < 2; ++_i) \
        __builtin_amdgcn_global_load_lds((const unsigned*)((const char*)(gbase) + (voff)[_i]), (PG8_LAS unsigned*)(lds + (bufoff) + ldsw + _i * 8192), 16, 0, 0); } while (0)
#define PG8_LDA(dst, b, h) do { _Pragma("unroll") for (int m = 0; m < 4; ++m) _Pragma("unroll") for (int k = 0; k < 2; ++k) dst[m][k] = *(const PG8_LAS bf16x8*)(lds + PG8_SA(b, h) + aoff + m * 2048 + k * 1024); } while (0)
#define PG8_LDB(dst, b, h) do { _Pragma("unroll") for (int n = 0; n < 2; ++n) _Pragma("unroll") for (int k = 0; k < 2; ++k) dst[n][k] = *(const PG8_LAS bf16x8*)(lds + PG8_SB(b, h) + boff + n * 2048 + k * 1024); } while (0)
#define PG8_MMA(ai, bj, At, Bt) do { __builtin_amdgcn_s_setprio(1); _Pragma("unroll") for (int m = 0; m < 4; ++m) _Pragma("unroll") for (int n = 0; n < 2; ++n) _Pragma("unroll") for (int k = 0; k < 2; ++k) \
        acc[ai][bj][m][n] = __builtin_amdgcn_mfma_f32_16x16x32_bf16(Bt[n][k], At[m][k], acc[ai][bj][m][n], 0, 0, 0); __builtin_amdgcn_s_setprio(0); } while (0)
#define PG8_WAIT_V(n) asm volatile("s_waitcnt vmcnt(" #n ")" ::: "memory")
#define PG8_WAIT_L(n) asm volatile("s_waitcnt lgkmcnt(" #n ")" ::: "memory")
#define PG8_BAR __builtin_amdgcn_s_barrier()
#define PG8_SCHED __builtin_amdgcn_sched_barrier(0)
    Unit cur, nxt; int ui = 0;
    if (!S.next(0, cur)) return;
    f32x4 acc[2][2][4][2];
#pragma unroll
    for (int a = 0; a < 2; ++a)
#pragma unroll
        for (int b = 0; b < 2; ++b)
#pragma unroll
            for (int m = 0; m < 4; ++m)
#pragma unroll
                for (int n = 0; n < 2; ++n) acc[a][b][m][n] = (f32x4){0.f, 0.f, 0.f, 0.f};
    bf16x8 At[4][2], B0[2][2], B1[2][2];
    const char* cA = (const char*)g.A + (size_t)cur.pm * tstep; const char* cB = (const char*)g.Bt + (size_t)cur.pn * tstep;
    S.a_ready(cur);
    if constexpr (SP2) {
        PG8_STAGE(PG8_SB(0, 0), cB, voffB); PG8_STAGE(PG8_SB(0, 1), cB + hstep, voffB); PG8_STAGE(PG8_SA(0, 0), cA, voffA); PG8_STAGE(PG8_SA(0, 1), cA + hstep, voffA);
        if (wr == 1) PG8_BAR;
        PG8_WAIT_V(2); PG8_BAR;
        PG8_STAGE(PG8_SB(1, 0), cB + kstep, voffB); PG8_STAGE(PG8_SA(1, 0), cA + kstep, voffA); PG8_STAGE(PG8_SB(1, 1), cB + hstep + kstep, voffB);
        PG8_WAIT_V(6); PG8_BAR;
    } else {
        PG8_STAGE(PG8_SB(0, 0), cB, voffB); PG8_STAGE(PG8_SA(0, 0), cA, voffA); PG8_STAGE(PG8_SB(0, 1), cB + hstep, voffB); PG8_STAGE(PG8_SA(0, 1), cA + hstep, voffA);
        if (wr == 1) PG8_BAR;
        PG8_WAIT_V(4); PG8_BAR;
        PG8_STAGE(PG8_SB(1, 0), cB + kstep, voffB); PG8_STAGE(PG8_SA(1, 0), cA + kstep, voffA); PG8_STAGE(PG8_SB(1, 1), cB + hstep + kstep, voffB);
        PG8_WAIT_V(6); PG8_BAR;
    }
    for (;;) {
        const bool has_next = S.next(ui + 1, nxt);
        const char* nA = has_next ? (const char*)g.A + (size_t)nxt.pm * tstep : cA; const char* nB = has_next ? (const char*)g.Bt + (size_t)nxt.pn * tstep : cB;
        for (int t = 0; t < nt; t += 2) {
            const bool last = (t == nt - 2);
            const char* a1 = cA + (size_t)(t + 1) * kstep;
            const char* a2 = last ? nA : cA + (size_t)(t + 2) * kstep; const char* b2 = last ? nB : cB + (size_t)(t + 2) * kstep;
            const char* a3 = a2 + kstep; const char* b3 = b2 + kstep;
            if (last && has_next) S.a_ready(nxt);
            if constexpr (SP2) {
            PG8_LDB(B0, 0, 0); PG8_LDB(B1, 0, 1); PG8_SCHED; PG8_LDA(At, 0, 0); PG8_STAGE(PG8_SA(1, 1), a1 + hstep, voffA);
            PG8_WAIT_V(8); PG8_WAIT_L(0); PG8_BAR; PG8_MMA(0, 0, At, B0); PG8_MMA(0, 1, At, B1); PG8_BAR; PG8_SCHED;
            PG8_LDA(At, 0, 1); PG8_STAGE(PG8_SB(0, 0), b2, voffB); PG8_STAGE(PG8_SB(0, 1), b2 + hstep, voffB); PG8_STAGE(PG8_SA(0, 0), a2, voffA);
            PG8_WAIT_V(8); PG8_WAIT_L(0); PG8_BAR; PG8_MMA(1, 0, At, B0); PG8_MMA(1, 1, At, B1); PG8_BAR; PG8_SCHED;
            PG8_LDB(B0, 1, 0); PG8_LDB(B1, 1, 1); PG8_SCHED; PG8_LDA(At, 1, 0); PG8_STAGE(PG8_SA(0, 1), a2 + hstep, voffA);
            PG8_WAIT_V(8); PG8_WAIT_L(0); PG8_BAR; PG8_MMA(0, 0, At, B0); PG8_MMA(0, 1, At, B1); PG8_BAR; PG8_SCHED;
            PG8_LDA(At, 1, 1); PG8_STAGE(PG8_SB(1, 0), b3, voffB); PG8_STAGE(PG8_SB(1, 1), b3 + hstep, voffB); PG8_STAGE(PG8_SA(1, 0), a3, voffA);
            PG8_WAIT_V(8); PG8_WAIT_L(0); PG8_BAR; PG8_MMA(1, 0, At, B0); PG8_MMA(1, 1, At, B1); PG8_BAR; PG8_SCHED;
            } else {
            PG8_LDB(B0, 0, 0); PG8_SCHED; PG8_LDA(At, 0, 0); PG8_STAGE(PG8_SA(1, 1), a1 + hstep, voffA);
            PG8_WAIT_L(8); PG8_BAR; PG8_WAIT_L(0); PG8_MMA(0, 0, At, B0); PG8_BAR; PG8_SCHED;
            PG8_LDB(B1, 0, 1); PG8_STAGE(PG8_SB(0, 0), b2, voffB);
            PG8_BAR; PG8_WAIT_L(0); PG8_MMA(0, 1, At, B1); PG8_BAR;
            PG8_LDA(At, 0, 1); PG8_STAGE(PG8_SA(0, 0), a2, voffA);
            PG8_BAR; PG8_WAIT_L(0); PG8_MMA(1, 0, At, B0); PG8_BAR; PG8_SCHED;
            PG8_STAGE(PG8_SB(0, 1), b2 + hstep, voffB);
            PG8_WAIT_V(6); PG8_BAR; PG8_MMA(1, 1, At, B1); PG8_BAR;
            PG8_LDB(B0, 1, 0); PG8_SCHED; PG8_LDA(At, 1, 0); PG8_STAGE(PG8_SA(0, 1), a2 + hstep, voffA);
            PG8_WAIT_L(8); PG8_BAR; PG8_WAIT_L(0); PG8_MMA(0, 0, At, B0); PG8_BAR; PG8_SCHED;
            PG8_LDB(B1, 1, 1); PG8_STAGE(PG8_SB(1, 0), b3, voffB);
            PG8_BAR; PG8_WAIT_L(0); PG8_MMA(0, 1, At, B1); PG8_BAR;
            PG8_LDA(At, 1, 1); PG8_STAGE(PG8_SA(1, 0), a3, voffA);
            PG8_BAR; PG8_WAIT_L(0); PG8_MMA(1, 0, At, B0); PG8_BAR; PG8_SCHED;
            PG8_STAGE(PG8_SB(1, 1), b3 + hstep, voffB);
            PG8_WAIT_V(6); PG8_BAR; PG8_MMA(1, 1, At, B1); PG8_BAR;
            }
        }
        if constexpr (ALIGN_EPI) { if (wr == 0) PG8_BAR; }
        if constexpr (!Epi::AFTER_DRAIN) { E(acc, cur, wr, wc, fr, fq); S.done(cur); }
        if (!has_next) break;
#pragma unroll
        for (int a = 0; a < 2; ++a)
#pragma unroll
            for (int b = 0; b < 2; ++b)
#pragma unroll
                for (int m = 0; m < 4; ++m)
#pragma unroll
                    for (int n = 0; n < 2; ++n) acc[a][b][m][n] = (f32x4){0.f, 0.f, 0.f, 0.f};
        cur = nxt; cA = nA; cB = nB; ++ui;
        if constexpr (ALIGN_EPI) { if (wr == 1) PG8_BAR; }
    }
    PG8_WAIT_V(0);
    if constexpr (!ALIGN_EPI) { if (wr == 0) PG8_BAR; }
    PG8_BAR;
    if constexpr (Epi::AFTER_DRAIN) { E.fused(acc, cur, wr, wc, fr, fq, lds, wid, lane); S.done(cur); }
#undef PG8_SA
#undef PG8_SB
#undef PG8_STAGE
#undef PG8_LDA
#undef PG8_LDB
#undef PG8_MMA
#undef PG8_WAIT_V
#undef PG8_WAIT_L
#undef PG8_BAR
#undef PG8_SCHED
}
}
#define PG8_SP2 true
#define PG8_ALIGN true
namespace att {
using bf16 = __hip_bfloat16;
constexpr int D = 128, NW = 8, QBLK = 32, KVBLK = 64;
constexpr float SCALE = 0.088388347648318440f;
constexpr float THR = 8.f;
constexpr size_t SHM_V = KVBLK * D * 2, SHM_K = KVBLK * D * 2, SHM_ATTN = 2 * SHM_V + 2 * SHM_K + NW * 64 * 4;
using bf16x8 = __attribute__((ext_vector_type(8))) short;
using s16x4  = __attribute__((ext_vector_type(4))) short;
using f32x16 = __attribute__((ext_vector_type(16))) float;
using f32x8  = __attribute__((ext_vector_type(8))) float;
using u32x4  = __attribute__((ext_vector_type(4))) unsigned;
#define KSWZ(row, colB) ((row) * 256 + ((colB) ^ (((row) & 7) << 4)))
#define SBAR() __builtin_amdgcn_sched_barrier(0)
__device__ __forceinline__ int crow(int r, int hi) { return (r & 3) + 8 * (r >> 2) + 4 * hi; }
__device__ __forceinline__ unsigned cvtpk(float lo, float hi) {
  unsigned r; asm volatile("v_cvt_pk_bf16_f32 %0, %1, %2" : "=v"(r) : "v"(lo), "v"(hi)); return r;
}
template <typename TIn> struct Stage;
template <> struct Stage<bf16>  { using T = bf16x8;
  __device__ static __forceinline__ T ld8(const bf16* p) { return *reinterpret_cast<const bf16x8*>(p); }
  __device__ static __forceinline__ bf16x8 tobf(T x) { return x; } };
template <> struct Stage<float> { using T = f32x8;
  __device__ static __forceinline__ T ld8(const float* p) { return *reinterpret_cast<const f32x8*>(p); }
  __device__ static __forceinline__ bf16x8 tobf(T x) {
    u32x4 w = {cvtpk(x[0], x[1]), cvtpk(x[2], x[3]), cvtpk(x[4], x[5]), cvtpk(x[6], x[7])}; return *reinterpret_cast<bf16x8*>(&w); } };

__device__ __forceinline__ void partialSM(f32x16& p0, f32x16& p1, float& m_reg, float& mn, float& alpha) {
  constexpr float C = SCALE * 1.4426950408889634f;
  float pmax = p0[0]; for (int r = 1; r < 16; ++r) pmax = fmaxf(pmax, p0[r]); for (int r = 0; r < 16; ++r) pmax = fmaxf(pmax, p1[r]);
  { auto rr = __builtin_amdgcn_permlane32_swap(__float_as_uint(pmax), __float_as_uint(pmax), false, false);
    pmax = fmaxf(__uint_as_float(rr[0]), __uint_as_float(rr[1])); }
  if (__builtin_expect(__all(pmax - m_reg <= THR / SCALE), 1)) { mn = m_reg; alpha = 1.f; }
  else { mn = fmaxf(m_reg, pmax); alpha = __builtin_amdgcn_exp2f((m_reg - mn) * C); m_reg = mn; }
  float mnC = -mn * C;
  for (int r = 0; r < 16; ++r) p0[r] = fmaf(p0[r], C, mnC); for (int r = 0; r < 16; ++r) p1[r] = fmaf(p1[r], C, mnC);
  for (int r = 0; r < 16; ++r) p0[r] = __builtin_amdgcn_exp2f(p0[r]);
}
__device__ __forceinline__ void finishSM(f32x16& p0, f32x16& p1, float alpha, float& l_reg, bf16x8& pa0, bf16x8& pa1, bf16x8& pa2, bf16x8& pa3) {
  for (int r = 0; r < 16; ++r) p1[r] = __builtin_amdgcn_exp2f(p1[r]);
  float ps = 0; for (int r = 0; r < 16; ++r) ps += p0[r]; for (int r = 0; r < 16; ++r) ps += p1[r];
  { auto rr = __builtin_amdgcn_permlane32_swap(__float_as_uint(ps), __float_as_uint(ps), false, false);
    ps = __uint_as_float(rr[0]) + __uint_as_float(rr[1]); }
  l_reg = l_reg * alpha + ps;
#define PK4(P, BASE, OUT) do { unsigned a0 = cvtpk(P[BASE + 0], P[BASE + 1]), a1 = cvtpk(P[BASE + 2], P[BASE + 3]);   \
    unsigned b0 = cvtpk(P[BASE + 4], P[BASE + 5]), b1 = cvtpk(P[BASE + 6], P[BASE + 7]);                              \
    auto r0 = __builtin_amdgcn_permlane32_swap(a0, b0, false, false); auto r1 = __builtin_amdgcn_permlane32_swap(a1, b1, false, false); \
    u32x4 w = {r0[0], r1[0], r0[1], r1[1]}; OUT = *reinterpret_cast<bf16x8*>(&w); } while (0)
  PK4(p0, 0, pa0); PK4(p0, 8, pa1); PK4(p1, 0, pa2); PK4(p1, 8, pa3);
#undef PK4
}
__device__ __forceinline__ void qkt(f32x16& p0, f32x16& p1, const bf16* Ks, const bf16x8* qr, int r32, int hi) {
  p0 = f32x16{}; p1 = f32x16{};
  for (int d0 = 0; d0 < 8; ++d0) { int cb = (d0 * 16 + hi * 8) * 2;
    bf16x8 b0 = *reinterpret_cast<const bf16x8*>((const char*)Ks + KSWZ(r32, cb));
    bf16x8 b1 = *reinterpret_cast<const bf16x8*>((const char*)Ks + KSWZ(32 + r32, cb));
    p0 = __builtin_amdgcn_mfma_f32_32x32x16_bf16(b0, qr[d0], p0, 0, 0, 0);
    p1 = __builtin_amdgcn_mfma_f32_32x32x16_bf16(b1, qr[d0], p1, 0, 0, 0); }
}
__device__ __forceinline__ int v_st(int k, int c) { const int kk = (k & ~0xC) | ((k & 4) << 1) | ((k & 8) >> 1); return ((kk >> 3) * 4 + (c >> 5)) * 512 + ((kk & 7) * 32 + (c & 31)) * 2; }
__device__ __forceinline__ int v_rd_base(int lane) { return ((lane & 3) << 3) | (((lane >> 2) & 3) << 6) | (((lane >> 4) & 1) << 5) | (((lane >> 5) & 1) << 8); }
constexpr int v_rd_off(int d0, int ks, int half) { return d0 * 512 + ks * 4096 + half * 2048; }
template <int OFF> __device__ __forceinline__ s16x4 tr_read(int vb) {
  s16x4 r; asm volatile("ds_read_b64_tr_b16 %0, %1 offset:%2" : "=&v"(r) : "v"(vb), "i"(OFF) : "memory"); return r;
}
template <int D0> __device__ __forceinline__ void pv_one(f32x16& od, int vb, bf16x8 pa0, bf16x8 pa1, bf16x8 pa2, bf16x8 pa3) {
  const s16x4 l0 = tr_read<v_rd_off(D0, 0, 0)>(vb), h0 = tr_read<v_rd_off(D0, 0, 1)>(vb), l1 = tr_read<v_rd_off(D0, 1, 0)>(vb), h1 = tr_read<v_rd_off(D0, 1, 1)>(vb);
  const s16x4 l2 = tr_read<v_rd_off(D0, 2, 0)>(vb), h2 = tr_read<v_rd_off(D0, 2, 1)>(vb), l3 = tr_read<v_rd_off(D0, 3, 0)>(vb), h3 = tr_read<v_rd_off(D0, 3, 1)>(vb);
  asm volatile("s_waitcnt lgkmcnt(0)" ::: "memory"); SBAR();
#define PK(L, H) (bf16x8){L[0], L[1], L[2], L[3], H[0], H[1], H[2], H[3]}
  od = __builtin_amdgcn_mfma_f32_32x32x16_bf16(pa0, PK(l0, h0), od, 0, 0, 0);
  od = __builtin_amdgcn_mfma_f32_32x32x16_bf16(pa1, PK(l1, h1), od, 0, 0, 0);
  od = __builtin_amdgcn_mfma_f32_32x32x16_bf16(pa2, PK(l2, h2), od, 0, 0, 0);
  od = __builtin_amdgcn_mfma_f32_32x32x16_bf16(pa3, PK(l3, h3), od, 0, 0, 0);
#undef PK
}
__device__ __forceinline__ void pv_d0(f32x16* o, int vb, bf16x8 pa0, bf16x8 pa1, bf16x8 pa2, bf16x8 pa3) {
  pv_one<0>(o[0], vb, pa0, pa1, pa2, pa3); pv_one<1>(o[1], vb, pa0, pa1, pa2, pa3); pv_one<2>(o[2], vb, pa0, pa1, pa2, pa3); pv_one<3>(o[3], vb, pa0, pa1, pa2, pa3);
}
constexpr int crow0(int r) { return (r & 3) + 8 * (r >> 2); }
constexpr float LOG2E = 1.4426950408889634f;
__device__ __forceinline__ void partialSM_dil(f32x16& p0, f32x16& p1, float& m_reg, float& mn, float& alpha, float dq, float dlo, float dhi, float nslopeC) {
  constexpr float C = SCALE * LOG2E;
#pragma unroll
  for (int r = 0; r < 16; ++r) {
    const float d0 = dq + (float)crow0(r), d1 = d0 + 32.f;
    const float t0 = fmaf(p0[r], C, nslopeC * fabsf(d0)), t1 = fmaf(p1[r], C, nslopeC * fabsf(d1));
    p0[r] = (d0 >= dlo && d0 <= dhi) ? t0 : -1e30f;
    p1[r] = (d1 >= dlo && d1 <= dhi) ? t1 : -1e30f;
  }
  float pmax = p0[0];
#pragma unroll
  for (int r = 1; r < 16; ++r) pmax = fmaxf(pmax, p0[r]);
#pragma unroll
  for (int r = 0; r < 16; ++r) pmax = fmaxf(pmax, p1[r]);
  { auto rr = __builtin_amdgcn_permlane32_swap(__float_as_uint(pmax), __float_as_uint(pmax), false, false);
    pmax = fmaxf(__uint_as_float(rr[0]), __uint_as_float(rr[1])); }
  if (__builtin_expect(__all(pmax - m_reg <= THR * LOG2E), 1)) { mn = m_reg; alpha = 1.f; }
  else { mn = fmaxf(m_reg, pmax); alpha = __builtin_amdgcn_exp2f(m_reg - mn); m_reg = mn; }
#pragma unroll
  for (int r = 0; r < 16; ++r) { p0[r] = p0[r] - mn; p1[r] = p1[r] - mn; }
#pragma unroll
  for (int r = 0; r < 16; ++r) p0[r] = __builtin_amdgcn_exp2f(p0[r]);
}

template <bool DIL>
__device__ __forceinline__ void attn_body(const bf16* __restrict__ Qb, const bf16* __restrict__ Kh, const bf16* __restrict__ Vh, long qs, long ks,
                                          bf16* __restrict__ Ob, long os, float* __restrict__ lse_o, int lse_s, int i0, int nsub, float nslopeC, int seq, char* lds) {
  using St = Stage<bf16>;
  const int tid = otid(), wid = __builtin_amdgcn_readfirstlane(tid >> 6), lane = tid & 63, r32 = lane & 31, hi = lane >> 5;
  bf16* V_lds = (bf16*)lds; bf16* K_lds = (bf16*)(lds + 2 * SHM_V);
  float* ws = (float*)(lds + 2 * SHM_V + 2 * SHM_K) + wid * 64; float* li_l = ws; float* al_l = ws + 32;
  float m_reg = -1e30f, l_reg = 0; f32x16 o[4] = {}; bf16x8 qr[8];
  const bf16* Qw = Qb + (long)(wid * QBLK + r32) * qs + hi * 8;
#pragma unroll
  for (int d0 = 0; d0 < 8; ++d0) qr[d0] = St::ld8(Qw + d0 * 16);
  const int sr = tid >> 4, sc = (tid & 15) * 8, vst0 = v_st(sr, sc), vst1 = v_st(32 + sr, sc);
  const int vb0 = (int)(uintptr_t)V_lds + v_rd_base(lane);
  constexpr int SDEPTH = 1;
  struct { typename St::T vs0, vs1, ks0, ks1; } sr_[SDEPTH];
  const int kb = DIL ? i0 - 64 : 0;
#define KROW(k) (DIL ? (long)min(max(kb + (k), 0), nsub - 1) : (long)(k))
#define SLOAD(i, k0) do { const long ra_ = KROW((k0) + sr) * ks + sc, rb_ = KROW((k0) + 32 + sr) * ks + sc; \
    sr_[i].vs0 = St::ld8(&Vh[ra_]); sr_[i].vs1 = St::ld8(&Vh[rb_]); sr_[i].ks0 = St::ld8(&Kh[ra_]); sr_[i].ks1 = St::ld8(&Kh[rb_]); } while (0)
#define SWRITE(b, i) do { *(bf16x8*)((char*)V_lds + (b) * SHM_V + vst0) = St::tobf(sr_[i].vs0);          \
    *(bf16x8*)((char*)V_lds + (b) * SHM_V + vst1) = St::tobf(sr_[i].vs1); int kc = sc * 2;               \
    *(bf16x8*)((char*)K_lds + (b) * SHM_K + KSWZ(sr, kc)) = St::tobf(sr_[i].ks0);                       \
    *(bf16x8*)((char*)K_lds + (b) * SHM_K + KSWZ(32 + sr, kc)) = St::tobf(sr_[i].ks1); } while (0)
#define SWAIT() do { if constexpr (SDEPTH == 2) asm volatile("s_waitcnt vmcnt(4)" ::: "memory"); else asm volatile("s_waitcnt vmcnt(0)" ::: "memory"); } while (0)
#define RESC(a) do { if (__any((a) < 1.f)) { if (hi == 0) al_l[r32] = (a); asm volatile("s_waitcnt lgkmcnt(0)" ::: "memory"); \
    for (int d = 0; d < 4; ++d) for (int r = 0; r < 16; ++r) o[d][r] *= al_l[crow(r, hi)]; } } while (0)
#define PSM(P0, P1, MN, AL, jt) do { if constexpr (DIL) { const int t_ = otid(), iq_ = (t_ >> 6) * QBLK + (t_ & 31), hi_ = (t_ >> 5) & 1; \
      partialSM_dil(P0, P1, m_reg, MN, AL, (float)(-64 - iq_ + 4 * hi_ + 64 * (jt)), fmaxf(-64.f, (float)(-(i0 + iq_))), fminf(64.f, (float)(nsub - 1 - (i0 + iq_))), nslopeC); } \
    else partialSM(P0, P1, m_reg, MN, AL); } while (0)
  f32x16 pA0, pA1, pB0, pB1; float mnA, mnB, alA, alB; bf16x8 pa0, pa1, pa2, pa3; const int NT = DIL ? 6 : seq / KVBLK;
  constexpr int SE = 0, SO = SDEPTH - 1;
  SLOAD(SE, 0); asm volatile("s_waitcnt vmcnt(0)" ::: "memory"); SWRITE(0, SE); __syncthreads();
  qkt(pA0, pA1, K_lds, qr, r32, hi); PSM(pA0, pA1, mnA, alA, 0);
  SLOAD(SO, KVBLK); if constexpr (SDEPTH == 2) { if (2 < NT) SLOAD(SE, 2 * KVBLK); }
  SWAIT(); SWRITE(1, SO); __syncthreads();
  for (int j = 1; j + 1 < NT; j += 2) {
    SBAR(); qkt(pB0, pB1, (bf16*)((char*)K_lds + SHM_K), qr, r32, hi);
    finishSM(pA0, pA1, alA, l_reg, pa0, pa1, pa2, pa3); SBAR();
    SLOAD(SO, (j + SDEPTH) * KVBLK); SBAR();
    pv_d0(o, vb0, pa0, pa1, pa2, pa3); PSM(pB0, pB1, mnB, alB, j);
    __syncthreads(); SWAIT(); SWRITE(0, SE);
    RESC(alB); __syncthreads();
    SBAR(); qkt(pA0, pA1, K_lds, qr, r32, hi);
    finishSM(pB0, pB1, alB, l_reg, pa0, pa1, pa2, pa3); SBAR();
    if (SDEPTH == 1 || j + 3 < NT) SLOAD(SE, (j + 1 + SDEPTH) * KVBLK); SBAR();
    pv_d0(o, vb0 + (int)SHM_V, pa0, pa1, pa2, pa3); PSM(pA0, pA1, mnA, alA, j + 1);
    __syncthreads(); SWAIT(); SWRITE(1, SO);
    RESC(alA); __syncthreads();
  }
  SBAR(); qkt(pB0, pB1, (bf16*)((char*)K_lds + SHM_K), qr, r32, hi);
  finishSM(pA0, pA1, alA, l_reg, pa0, pa1, pa2, pa3); SBAR();
  pv_d0(o, vb0, pa0, pa1, pa2, pa3); PSM(pB0, pB1, mnB, alB, NT - 1);
  __syncthreads(); RESC(alB);
  finishSM(pB0, pB1, alB, l_reg, pa0, pa1, pa2, pa3); SBAR();
  pv_d0(o, vb0 + (int)SHM_V, pa0, pa1, pa2, pa3);
  if (hi == 0) li_l[r32] = l_reg; asm volatile("s_waitcnt lgkmcnt(0)" ::: "memory");
  if constexpr (DIL) { if (hi == 0) lse_o[(long)(wid * QBLK + r32) * lse_s] = m_reg + __log2f(l_reg); }
  float rli[16];
#pragma unroll
  for (int r = 0; r < 16; ++r) rli[r] = __builtin_amdgcn_rcpf(li_l[crow(r, hi)]);
  bf16* Ow = Ob + (long)(wid * QBLK) * os;
#pragma unroll
  for (int r = 0; r < 16; ++r) { const int orow = crow(r, hi);
#pragma unroll
    for (int d0 = 0; d0 < 4; ++d0) Ow[(long)orow * os + d0 * 32 + r32] = __float2bfloat16(o[d0][r] * rli[r]); }
  __syncthreads();
#undef KROW
#undef SLOAD
#undef SWRITE
#undef SWAIT
#undef RESC
#undef PSM
}
}

#define GAS __attribute__((address_space(1)))
#define LAS __attribute__((address_space(3)))
typedef unsigned short bf16_t;
typedef unsigned v4u __attribute__((ext_vector_type(4)));
typedef unsigned v2u __attribute__((ext_vector_type(2)));
typedef float f32x4 __attribute__((ext_vector_type(4)));
#define LDS_WAIT() asm volatile("s_waitcnt lgkmcnt(0)" ::: "memory")

constexpr size_t MiB = 1u << 20;
constexpr size_t WS_W1T = 0;
constexpr size_t WS_W2T = 104 * MiB;
constexpr size_t WS_H = 136 * MiB;
constexpr size_t WS_PROJ = 200 * MiB;
constexpr size_t WS_YA = 408 * MiB;
constexpr size_t WS_YB = 440 * MiB;
constexpr size_t WS_LSE = 536 * MiB;
constexpr size_t WS_ROPE = 538 * MiB;
constexpr size_t WS_XB = 540 * MiB;
constexpr size_t WS_ROWSQ = 604 * MiB;
constexpr size_t WS_END = 616 * MiB;
static_assert((size_t)DEPTH * DIN * DM * 2 <= WS_W2T - WS_W1T && (size_t)M * DIN * 2 <= WS_YA - WS_PROJ && (size_t)3 * M * DB * 2 <= WS_LSE - WS_YB, "ws map");
constexpr int LDS_BYTES = 147456;
constexpr int N_PHASES = 2 + 5 * DEPTH;

__device__ __forceinline__ unsigned f2bf(float f) { unsigned u = __builtin_bit_cast(unsigned, f); return (u + 0x7fffu + ((u >> 16) & 1u)) >> 16; }
__device__ __forceinline__ unsigned pk2(float lo, float hi) { return f2bf(lo) | (f2bf(hi) << 16); }
__device__ __forceinline__ float bflo(unsigned w) { return __uint_as_float(w << 16); }
__device__ __forceinline__ float bfhi(unsigned w) { return __uint_as_float(w & 0xffff0000u); }
__device__ __forceinline__ float wave_sum(float v) {
#pragma unroll
    for (int o = 1; o < 64; o <<= 1) v += __shfl_xor(v, o);
    return v;
}

__device__ const float INV_FREQ[32] = {1.000000000e+00f, 7.498942614e-01f, 5.623413324e-01f, 4.216965139e-01f, 3.162277639e-01f, 2.371373773e-01f, 1.778279394e-01f, 1.333521307e-01f,
    1.000000015e-01f, 7.498941571e-02f, 5.623413250e-02f, 4.216965288e-02f, 3.162277490e-02f, 2.371373773e-02f, 1.778279431e-02f, 1.333521493e-02f,
    9.999999776e-03f, 7.498941850e-03f, 5.623413250e-03f, 4.216964822e-03f, 3.162277630e-03f, 2.371373586e-03f, 1.778279431e-03f, 1.333521446e-03f,
    1.000000047e-03f, 7.498942432e-04f, 5.623413017e-04f, 4.216965172e-04f, 3.162277571e-04f, 2.371373703e-04f, 1.778279402e-04f, 1.333521504e-04f};

__device__ __forceinline__ void sincos_acc(float a, float& s, float& c) {
    const double x = (double)a, kd = __builtin_rint(x * 0.63661977236758134308);
    const int k = (int)kd; const double r = x - kd * 1.57079632679489661923, r2 = r * r;
    const double sp = r * (1.0 + r2 * (-1.0 / 6 + r2 * (1.0 / 120 + r2 * (-1.0 / 5040 + r2 * (1.0 / 362880 + r2 * (-1.0 / 39916800 + r2 * (1.0 / 6227020800.0)))))));
    const double cp = 1.0 + r2 * (-0.5 + r2 * (1.0 / 24 + r2 * (-1.0 / 720 + r2 * (1.0 / 40320 + r2 * (-1.0 / 3628800 + r2 * (1.0 / 479001600.0 + r2 * (-1.0 / 87178291200.0)))))));
    const int q = k & 3;
    const double sv = (q == 0) ? sp : (q == 1) ? cp : (q == 2) ? -sp : -cp, cv = (q == 0) ? cp : (q == 1) ? -sp : (q == 2) ? -cp : sp;
    s = (float)sv; c = (float)cv;
}

__device__ __forceinline__ void p0_transpose_item(const float* W, int K, int N, bf16_t* WT, LAS float* scr, int item, int lane, const float* kscale) {
    const int nblk = N / 32, kb = item / nblk, nb = item % nblk, k0 = 64 * kb, n0 = 32 * nb;
#pragma unroll 8
    for (int i = 0; i < 32; ++i) { const int kk = 2 * i + (lane >> 5); scr[kk * 33 + (lane & 31)] = W[(size_t)(k0 + kk) * N + n0 + (lane & 31)] * (kscale ? kscale[k0 + kk] : 1.0f); }
    LDS_WAIT(); asm volatile("" ::: "memory");
    const int c = lane & 7;
#pragma unroll
    for (int j = 0; j < 4; ++j) { const int n = (lane >> 3) + 8 * j; const LAS float* s = scr + (8 * c) * 33 + n;
        v4u o; o.x = pk2(s[0 * 33], s[1 * 33]); o.y = pk2(s[2 * 33], s[3 * 33]); o.z = pk2(s[4 * 33], s[5 * 33]); o.w = pk2(s[6 * 33], s[7 * 33]);
        *(v4u*)(WT + (size_t)(n0 + n) * K + k0 + 8 * c) = o; }
    LDS_WAIT(); asm volatile("" ::: "memory");
}

#define XB_TMO      128
#define XB_XCNT(j)  (256  + 64 * (j))
#define XB_XSUB(j)  (1280 + 64 * (j))
#define XB_XGEN(j)  (2304 + 64 * (j))
#define XB_TOP      3328
#define XB_TOPGEN   3392
#define XCD_BAR_WORDS 3456
#define XB_SPIN_CAP (1u << 18)

__device__ __forceinline__ unsigned xb_ld(unsigned* p)              { return __hip_atomic_load(p, __ATOMIC_RELAXED, __HIP_MEMORY_SCOPE_AGENT); }
__device__ __forceinline__ unsigned xb_add(unsigned* p, unsigned v) { return __hip_atomic_fetch_add(p, v, __ATOMIC_RELAXED, __HIP_MEMORY_SCOPE_AGENT); }
__device__ __forceinline__ unsigned xb_xcc_id() { return (unsigned)__builtin_amdgcn_s_getreg((3 << 11) | 20) & 0xFu; }
#define XB_SPIN(cond, bar) do { unsigned _sp = 0; while (cond) { __builtin_amdgcn_s_sleep(1); \
    if ((++_sp & 255u) == 0u) { if (xb_ld(&(bar)[XB_TMO])) break; if (_sp > XB_SPIN_CAP) { atomicAdd(&(bar)[XB_TMO], 1u); break; } } } } while (0)

struct XcdBarrier {
    unsigned* bar; unsigned x;
    volatile LAS unsigned* st;
};

__device__ __forceinline__ XcdBarrier xcd_barrier_post(unsigned* bar, volatile LAS unsigned* st) {
    XcdBarrier b; b.bar = bar; b.x = xb_xcc_id(); b.st = st;
    if (threadIdx.x == 0) (void)xb_add(&bar[XB_XCNT(b.x)], 1u);
    return b;
}
__device__ __forceinline__ void xcd_barrier_complete(unsigned* bar, unsigned x, unsigned& nloc, unsigned& nx) {
    const unsigned G = gridDim.x * gridDim.y * gridDim.z;
    unsigned sum, cnt, mine, sp = 0u;
    for (;;) {
        sum = 0u; cnt = 0u; mine = 0u;
#pragma unroll
        for (unsigned j = 0; j < 16; ++j) { const unsigned c = xb_ld(&bar[XB_XCNT(j)]); sum += c; cnt += (c > 0u) ? 1u : 0u; mine = (j == x) ? c : mine; }
        if (sum == G) break;
        __builtin_amdgcn_s_sleep(1);
        if ((++sp & 255u) == 0u) { if (xb_ld(&bar[XB_TMO])) break; if (sp > XB_SPIN_CAP) { atomicAdd(&bar[XB_TMO], 1u); break; } }
    }
    nloc = mine > 0u ? mine : 1u; nx = cnt > 0u ? cnt : 1u;
}

__device__ __forceinline__ void xcd_barrier(const XcdBarrier& b) {
    asm volatile("s_waitcnt vmcnt(0)" ::: "memory");
    __syncthreads();
    if (threadIdx.x == 0) {
        unsigned* bar = b.bar;
        __builtin_amdgcn_s_waitcnt(0);
        unsigned nloc = b.st[0], nx = b.st[1];
        if (nloc == 0u) { xcd_barrier_complete(bar, b.x, nloc, nx); b.st[0] = nloc; b.st[1] = nx; }
        const unsigned old = xb_add(&bar[XB_XSUB(b.x)], 1u);
        const unsigned gen = old / nloc;
        if (old + 1u == (gen + 1u) * nloc) {
            __builtin_amdgcn_fence(__ATOMIC_RELEASE, "agent");
            asm volatile("s_waitcnt vmcnt(0)" ::: "memory");
            const unsigned og = xb_add(&bar[XB_TOP], 1u);
            const unsigned tg = og / nx;
            if (og + 1u == (tg + 1u) * nx) xb_add(&bar[XB_TOPGEN], 1u);
            else XB_SPIN(xb_ld(&bar[XB_TOPGEN]) == tg, bar);
            __builtin_amdgcn_fence(__ATOMIC_ACQUIRE, "agent");
            xb_add(&bar[XB_XGEN(b.x)], 1u);
            asm volatile("s_waitcnt vmcnt(0)" ::: "memory");
        } else {
            XB_SPIN(xb_ld(&bar[XB_XGEN(b.x)]) == gen, bar);
            __builtin_amdgcn_fence(__ATOMIC_ACQUIRE, "agent");
            asm volatile("s_waitcnt vmcnt(0)" ::: "memory");
        }
    }
    __syncthreads();
}

constexpr size_t WS_CTL = 539 * MiB, CTL_BYTES = 16384;
constexpr int MISC_OFF = 131072 + 320;
struct Params { const float *x, *norm_w, *w_in, *qn, *kn, *ona, *onb, *w_out, *fnorm; float* out; unsigned char* ws; int ph_lo, ph_hi; };

__global__ void __launch_bounds__(512, 2) mk_fwd(Params p) {
    extern __shared__ __attribute__((aligned(16))) unsigned char lds[];
    volatile LAS unsigned* MISC = (volatile LAS unsigned*)((LAS unsigned char*)lds + MISC_OFF);
    if (threadIdx.x < 32) MISC[threadIdx.x] = 0u;
    __syncthreads();
    XcdBarrier bar = xcd_barrier_post((unsigned*)(p.ws + WS_CTL), MISC + 8);
    for (int ph = p.ph_lo; ph < p.ph_hi; ++ph) {
        const int tid = otid(), lane = tid & 63, wave = __builtin_amdgcn_readfirstlane(tid >> 6);
        int G = gridDim.x, bx = blockIdx.x; asm volatile("" : "+s"(G), "+s"(bx));
        const int vcu = (G % 8 == 0) ? (bx % 8) * (G / 8) + bx / 8 : bx;
        const int gw = vcu * 8 + wave, NGW = G * 8;
        size_t zoff = 0; asm volatile("" : "+s"(zoff));
        unsigned char* ws = p.ws + zoff;
        bf16_t* W1T = (bf16_t*)(ws + WS_W1T); bf16_t* W2T = (bf16_t*)(ws + WS_W2T); bf16_t* H = (bf16_t*)(ws + WS_H); bf16_t* PROJ = (bf16_t*)(ws + WS_PROJ);
        bf16_t* YA = (bf16_t*)(ws + WS_YA); bf16_t* YB = (bf16_t*)(ws + WS_YB); float* LSE = (float*)(ws + WS_LSE);
        float* RCOS = (float*)(ws + WS_ROPE); float* RSIN = RCOS + 192 * 32;
        bf16_t* XB = (bf16_t*)(ws + WS_XB); float* ROWSQ = (float*)(ws + WS_ROWSQ);
        if (ph == 0) {
            LAS float* scr = (LAS float*)((LAS unsigned char*)lds + wave * 16384);
            constexpr int I1 = (DM / 64) * (DIN / 32), I2 = (DM / 64) * (DM / 32), IL = I1 + I2;
            DUPREP(0) for (int it = gw; it < DEPTH * IL; it += NGW) {
                const int l = it / IL, r = it % IL;
                if (r < I1) p0_transpose_item(p.w_in + (size_t)l * DM * DIN, DM, DIN, W1T + (size_t)l * DIN * DM, scr, r, lane, p.norm_w + (size_t)l * DM);
                else p0_transpose_item(p.w_out + (size_t)l * DM * DM, DM, DM, W2T + (size_t)l * DM * DM, scr, r - I1, lane, nullptr);
            }
            for (int m = gw; m < M; m += NGW) {
                const f32x4* xr = (const f32x4*)(p.x + (size_t)m * DM) + lane; v2u* o8 = (v2u*)(XB + (size_t)m * DM) + lane; float sq = 0.f;
#pragma unroll
                for (int j = 0; j < 8; ++j) { const f32x4 v = xr[64 * j]; sq += (v.x * v.x + v.y * v.y) + (v.z * v.z + v.w * v.w); v2u w; w.x = pk2(v.x, v.y); w.y = pk2(v.z, v.w); o8[64 * j] = w; }
                sq = wave_sum(sq); if (lane < 32) ROWSQ[(size_t)m * 32 + lane] = (lane == 0) ? sq : 0.f;
            }
            for (int i = gw * 64 + lane; i < 192 * 32; i += NGW * 64) {
                const int pos = i >> 5, f = i & 31; const float pv = (float)(pos < 128 ? pos : pos - 128);
                float s, c; sincos_acc(pv * INV_FREQ[f], s, c); RCOS[i] = c; RSIN[i] = s;
            }
        } else if (ph == N_PHASES - 1) {
            for (int m = gw; m < M; m += NGW) {
                f32x4* xr = (f32x4*)(p.out + (size_t)m * DM) + lane; const f32x4* wr_ = (const f32x4*)p.fnorm + lane;
                const float rstd = 1.0f / sqrtf(wave_sum(lane < 32 ? ROWSQ[((size_t)DEPTH * M + m) * 32 + lane] : 0.f) * (1.0f / DM) + EPS);
#pragma unroll
                for (int j = 0; j < 8; ++j) xr[64 * j] = xr[64 * j] * rstd * wr_[64 * j];
            }
        } else {
            const int l = (ph - 1) / 5, st = (ph - 1) % 5 + 1;
            const float* xin = (l == 0) ? p.x : p.out;
            if (st == 1) {
                pg8::Gemm g{XB, W1T + (size_t)l * DIN * DM, M, DIN, DM}; pg8::StaticOrder S; S.init(M, DIN, G, bx);
                pg8::EpiHeadMajor E{PROJ, M, ROWSQ + (size_t)l * M * 32, 1.0f / DM, EPS};
#ifndef MK_NO_G1
                DUPREP(2) pg8::gemm_phase<pg8::EpiHeadMajor, pg8::StaticOrder, PG8_ALIGN, PG8_SP2>((PG8_LAS unsigned char*)lds, g, S, E);
#endif
            } else if (st == 2) {
                const float* qg = p.qn + l * HD; const float* kg = p.kn + l * HD;
                for (int it = gw; it < M * 10 / 4; it += NGW) {
                    const int g = it * 4 + (lane >> 4), row = g / 10, hs = g - row * 10;
                    const int j = lane & 15, half = j >> 3, jj = j & 7, e = half * 64 + 4 * jj;
                    bf16_t* pp = PROJ + ((size_t)hs * M + row) * HD + e;
                    const v2u a = *(const v2u*)pp, b = *(const v2u*)(pp + 32);
                    float x1[4] = {bflo(a.x), bfhi(a.x), bflo(a.y), bfhi(a.y)}, x2[4] = {bflo(b.x), bfhi(b.x), bflo(b.y), bfhi(b.y)};
                    float ss = 0.f;
#pragma unroll
                    for (int i = 0; i < 4; ++i) ss += x1[i] * x1[i] + x2[i] * x2[i];
                    ss += __shfl_xor(ss, 1); ss += __shfl_xor(ss, 2); ss += __shfl_xor(ss, 4); ss += __shfl_xor(ss, 8);
                    const float rstd = 1.0f / sqrtf(ss * (1.0f / HD) + EPS);
                    const float* gn = (hs < 8) ? qg : kg;
                    const f32x4 g1 = *(const f32x4*)(gn + e), g2 = *(const f32x4*)(gn + e + 32);
                    const int t = row & (T - 1), pos = half ? 128 + (t & 63) : (t >> 6);
                    const f32x4 cs = *(const f32x4*)(RCOS + pos * 32 + 4 * jj), sn = *(const f32x4*)(RSIN + pos * 32 + 4 * jj);
                    float o1[4], o2[4];
#pragma unroll
                    for (int i = 0; i < 4; ++i) { const float y1 = x1[i] * rstd * g1[i], y2 = x2[i] * rstd * g2[i]; o1[i] = y1 * cs[i] - y2 * sn[i]; o2[i] = y1 * sn[i] + y2 * cs[i]; }
                    v2u w1, w2; w1.x = pk2(o1[0], o1[1]); w1.y = pk2(o1[2], o1[3]); w2.x = pk2(o2[0], o2[1]); w2.y = pk2(o2[2], o2[3]);
                    *(v2u*)pp = w1; *(v2u*)(pp + 32) = w2;
                }
#ifndef MK_NO_DIL
                DUPREP(3) for (int u = vcu; u < 1536; u += G) {
                    const int pt = u >> 9, rem = u & 511, b = rem >> 8, h = (rem >> 5) & 7, w = rem & 31;
                    const int d = (pt == 0) ? 1 : (pt == 1) ? 4 : 16, res = w & (d - 1), blk = w / d, i0 = blk * 256, nsub = T / d;
                    const float slope = __builtin_amdgcn_exp2f(-(float)(h + 1));
                    const float nslopeC = -slope * (float)d * att::LOG2E;
                    const size_t tok0 = (size_t)b * T + res;
                    const att::bf16* Pb = (const att::bf16*)PROJ + ((size_t)h * M + tok0) * HD;
                    const long rs = (long)d * HD;
                    att::attn_body<true>(Pb + (size_t)H_QB * M * HD + (long)i0 * rs, Pb + (size_t)H_KB * M * HD, Pb + (size_t)H_VB * M * HD, rs, rs,
                                         (att::bf16*)YB + ((size_t)pt * M + tok0 + (size_t)i0 * d) * DB + h * HD, (long)d * DB,
                                         LSE + ((size_t)pt * M + tok0 + (size_t)i0 * d) * 8 + h, d * 8, i0, nsub, nslopeC, 0, (char*)lds);
                }
#endif
            } else if (st == 3) {
#ifndef MK_NO_DENSE
                DUPREP(4) for (int u = vcu; u < 512; u += G) {
                    const int combo = u >> 7, b = combo >> 1, kvh = combo & 1, h = kvh * 4 + ((u >> 5) & 3), qb = u & 31;
                    const att::bf16* Pb = (const att::bf16*)PROJ + (size_t)b * T * HD;
                    att::attn_body<false>(Pb + ((size_t)(H_QA + h) * M + qb * 256) * HD, Pb + (size_t)(H_KA + kvh) * M * HD, Pb + (size_t)(H_VA + kvh) * M * HD, HD, HD,
                                          (att::bf16*)YA + ((size_t)b * T + qb * 256) * DA + h * HD, DA, nullptr, 0, 0, 0, 0.f, T, (char*)lds);
                }
#endif
            } else if (st == 4) {
                const float* wa = p.ona + (size_t)l * DA; const float* wb = p.onb + (size_t)l * DB;
                DUPREP(5) for (int m = gw; m < M; m += NGW) {
                    float ya[2][8], yb[2][8]; float ssa = 0.f, ssb = 0.f;
#pragma unroll
                    for (int j = 0; j < 2; ++j) { const int c = lane + 64 * j, hh = c >> 4;
                        const v4u a = *(const v4u*)(YA + (size_t)m * DA + 8 * c);
                        ya[j][0] = bflo(a.x); ya[j][1] = bfhi(a.x); ya[j][2] = bflo(a.y); ya[j][3] = bfhi(a.y); ya[j][4] = bflo(a.z); ya[j][5] = bfhi(a.z); ya[j][6] = bflo(a.w); ya[j][7] = bfhi(a.w);
                        const float l0 = LSE[((size_t)0 * M + m) * 8 + hh], l1 = LSE[((size_t)1 * M + m) * 8 + hh], l2 = LSE[((size_t)2 * M + m) * 8 + hh];
                        const float mx = fmaxf(l0, fmaxf(l1, l2)); const float e0 = __builtin_amdgcn_exp2f(l0 - mx), e1 = __builtin_amdgcn_exp2f(l1 - mx), e2 = __builtin_amdgcn_exp2f(l2 - mx);
                        const float inv = 1.0f / (e0 + e1 + e2); const float w0 = e0 * inv, w1 = e1 * inv, w2 = e2 * inv;
                        const v4u b0 = *(const v4u*)(YB + ((size_t)0 * M + m) * DB + 8 * c), b1 = *(const v4u*)(YB + ((size_t)1 * M + m) * DB + 8 * c), b2 = *(const v4u*)(YB + ((size_t)2 * M + m) * DB + 8 * c);
                        yb[j][0] = w0 * bflo(b0.x) + w1 * bflo(b1.x) + w2 * bflo(b2.x); yb[j][1] = w0 * bfhi(b0.x) + w1 * bfhi(b1.x) + w2 * bfhi(b2.x);
                        yb[j][2] = w0 * bflo(b0.y) + w1 * bflo(b1.y) + w2 * bflo(b2.y); yb[j][3] = w0 * bfhi(b0.y) + w1 * bfhi(b1.y) + w2 * bfhi(b2.y);
                        yb[j][4] = w0 * bflo(b0.z) + w1 * bflo(b1.z) + w2 * bflo(b2.z); yb[j][5] = w0 * bfhi(b0.z) + w1 * bfhi(b1.z) + w2 * bfhi(b2.z);
                        yb[j][6] = w0 * bflo(b0.w) + w1 * bflo(b1.w) + w2 * bflo(b2.w); yb[j][7] = w0 * bfhi(b0.w) + w1 * bfhi(b1.w) + w2 * bfhi(b2.w);
#pragma unroll
                        for (int i = 0; i < 8; ++i) { ssa += ya[j][i] * ya[j][i]; ssb += yb[j][i] * yb[j][i]; } }
                    const float ra = 1.0f / sqrtf(wave_sum(ssa) * (1.0f / DA) + EPS), rb = 1.0f / sqrtf(wave_sum(ssb) * (1.0f / DB) + EPS);
#pragma unroll
                    for (int j = 0; j < 2; ++j) { const int c = lane + 64 * j;
                        const v4u ga = *(const v4u*)(PROJ + ((size_t)(H_GA + (c >> 4)) * M + m) * HD + 8 * (c & 15)), gb = *(const v4u*)(PROJ + ((size_t)(H_GB + (c >> 4)) * M + m) * HD + 8 * (c & 15));
                        const float gaf[8] = {bflo(ga.x), bfhi(ga.x), bflo(ga.y), bfhi(ga.y), bflo(ga.z), bfhi(ga.z), bflo(ga.w), bfhi(ga.w)};
                        const float gbf[8] = {bflo(gb.x), bfhi(gb.x), bflo(gb.y), bfhi(gb.y), bflo(gb.z), bfhi(gb.z), bflo(gb.w), bfhi(gb.w)};
                        const f32x4 wa0 = *(const f32x4*)(wa + 8 * c), wa1 = *(const f32x4*)(wa + 8 * c + 4), wb0 = *(const f32x4*)(wb + 8 * c), wb1 = *(const f32x4*)(wb + 8 * c + 4);
                        float za[8], zb[8];
#pragma unroll
                        for (int i = 0; i < 8; ++i) { const float wai = i < 4 ? wa0[i & 3] : wa1[i & 3], wbi = i < 4 ? wb0[i & 3] : wb1[i & 3];
                            const float sa = gaf[i] / (1.0f + __expf(-gaf[i])), sb = gbf[i] / (1.0f + __expf(-gbf[i]));
                            za[i] = ya[j][i] * ra * wai * sa; zb[i] = yb[j][i] * rb * wbi * sb; }
                        v4u oa, ob; oa.x = pk2(za[0], za[1]); oa.y = pk2(za[2], za[3]); oa.z = pk2(za[4], za[5]); oa.w = pk2(za[6], za[7]);
                        ob.x = pk2(zb[0], zb[1]); ob.y = pk2(zb[2], zb[3]); ob.z = pk2(zb[4], zb[5]); ob.w = pk2(zb[6], zb[7]);
                        *(v4u*)(H + (size_t)m * DM + 8 * c) = oa; *(v4u*)(H + (size_t)m * DM + DA + 8 * c) = ob; }
                }
            } else {
                pg8::Gemm g{H, W2T + (size_t)l * DM * DM, M, DM, DM}; pg8::StaticOrder S; S.init(M, DM, G, bx);
                pg8::EpiResF32 E{xin, p.out, XB, ROWSQ + (size_t)(l + 1) * M * 32, DM};
#ifndef MK_NO_G2
                pg8::gemm_phase<pg8::EpiResF32, pg8::StaticOrder, PG8_ALIGN, PG8_SP2>((PG8_LAS unsigned char*)lds, g, S, E);
#endif
            }
        }
        if (ph + 1 < p.ph_hi) { if (ph == 0) cg::this_grid().sync(); else xcd_barrier(bar); if (MK_DUP & 64) xcd_barrier(bar); }
    }
}

extern "C" void kernel_launch(void* const* d_in, const int* in_sizes, int n_in, void* d_out, int out_size, void* d_ws, size_t ws_size, hipStream_t stream) {
    static int grid = 0;
    if (grid == 0) {
        if (n_in != 9 || in_sizes[0] != M * DM || out_size != M * DM || ws_size < WS_END) { fprintf(stderr, "kernel_launch: unexpected shapes (n_in %d, ws %zu)\n", n_in, ws_size); grid = -1; return; }
        int dev = 0, cus = 0, per_cu = 0;
        hipGetDevice(&dev); hipDeviceGetAttribute(&cus, hipDeviceAttributeMultiprocessorCount, dev);
        if (hipFuncSetAttribute((const void*)mk_fwd, hipFuncAttributeMaxDynamicSharedMemorySize, LDS_BYTES) != hipSuccess) { fprintf(stderr, "kernel_launch: hipFuncSetAttribute failed\n"); grid = -1; return; }
        if (hipOccupancyMaxActiveBlocksPerMultiprocessor(&per_cu, (const void*)mk_fwd, 512, LDS_BYTES) != hipSuccess || per_cu < 1) per_cu = 1;
        (void)hipGetLastError();
        grid = cus * per_cu;
    }
    if (grid < 0) return;
    Params p{};
    p.x = (const float*)d_in[0]; p.norm_w = (const float*)d_in[1]; p.w_in = (const float*)d_in[2]; p.qn = (const float*)d_in[3]; p.kn = (const float*)d_in[4];
    p.ona = (const float*)d_in[5]; p.onb = (const float*)d_in[6]; p.w_out = (const float*)d_in[7]; p.fnorm = (const float*)d_in[8];
    p.out = (float*)d_out; p.ws = (unsigned char*)d_ws;
    if (hipMemsetAsync((char*)d_ws + WS_CTL, 0, CTL_BYTES, stream) != hipSuccess) { fprintf(stderr, "kernel_launch: memset failed\n"); return; }
#if MK_ONE_LAUNCH
    p.ph_lo = 0; p.ph_hi = N_PHASES;
    void* args[] = {&p};
    hipError_t e = hipLaunchCooperativeKernel((const void*)mk_fwd, dim3(grid), dim3(512), args, LDS_BYTES, stream);
    if (e != hipSuccess) fprintf(stderr, "kernel_launch: cooperative launch failed: %s (grid %d)\n", hipGetErrorString(e), grid);
#else
    for (int ph = 0; ph < N_PHASES; ++ph) { p.ph_lo = ph; p.ph_hi = ph + 1; hipLaunchKernelGGL(mk_fwd, dim3(grid), dim3(512), LDS_BYTES, stream, p); }
#endif
}
```

```cpp
#include <hip/hip_runtime.h>
#include <hip/hip_bf16.h>
#include <hip/hip_cooperative_groups.h>
#include <cstdio>
#include <cstdint>
namespace cg = cooperative_groups;

#ifndef MK_DUP
#define MK_DUP 0
#endif
#define DUPREP(k) for (int rep_ = 0; rep_ < 1 + ((MK_DUP >> (k)) & 1); ++rep_)
#ifndef MK_ONE_LAUNCH
#define MK_ONE_LAUNCH 1
#endif

constexpr int BATCH = 2, T = 8192, DM = 2048, DEPTH = 4, HD = 128, DA = 1024, DB = 1024, DIN = 6656, M = BATCH * T;
constexpr int C_QA = 0, C_KA = 1024, C_VA = 1280, C_GA = 1536, C_QB = 2560, C_KB = 3584, C_VB = 4608, C_GB = 5632;
constexpr int H_QA = 0, H_KA = 8, H_VA = 10, H_GA = 12, H_QB = 20, H_KB = 28, H_VB = 36, H_GB = 44;
constexpr float EPS = 1e-6f;
__device__ __forceinline__ int otid() { int t = threadIdx.x; asm volatile("" : "+v"(t)); return t; }

namespace pg8 {
#define PG8_LAS __attribute__((address_space(3)))
typedef unsigned short bf16_t;
typedef short bf16x8 __attribute__((ext_vector_type(8)));
typedef float f32x4 __attribute__((ext_vector_type(4)));
typedef unsigned u32x4 __attribute__((ext_vector_type(4)));
constexpr int BM = 256, BK = 64, HALF = 128, HTB = HALF * BK * 2  , STAGE_BYTES = 8 * HTB, NXCD = 8, WGM = 8;

__host__ __device__ __forceinline__ int lds_byte(int r, int c) { const int st = (r >> 4) * 2 + (c >> 5), rr = r & 15, cc = c & 31, ob = rr * 64 + cc * 2; return st * 1024 + (ob ^ (((ob >> 9) & 1) << 5)); }
__host__ __device__ __forceinline__ void stage_rc(int b, int& R, int& C) { const int st = b / 1024, sb = b % 1024, swz = sb ^ (((sb >> 9) & 1) << 5); R = (st >> 1) * 16 + swz / 64; C = (st & 1) * 32 + (swz % 64) / 2; }
__host__ __device__ __forceinline__ int perm32(int rho) { const int n = rho >> 4, i = rho & 15; return 8 * (i >> 2) + 4 * n + (i & 3); }

struct Unit { int pm, pn; };
struct Gemm { const bf16_t* A; const bf16_t* Bt; int M, N, K; };

struct StaticOrder {
    int nM, nN, nwg, G, c;
    __host__ __device__ void init(int M, int N, int G_, int c_) { nM = M / BM; nN = N / BM; nwg = nM * nN; G = G_; c = c_; }
    __host__ __device__ bool next(int i, Unit& u) const {
        const long L = (long)i * G + c; if (L >= nwg) return false;
        int wgid = (int)L; { const int q = nwg / NXCD, r = nwg % NXCD, xcd = wgid % NXCD, off = wgid / NXCD; wgid = (xcd < r ? xcd * (q + 1) : r * (q + 1) + (xcd - r) * q) + off; }
        const int nig = WGM * nN, gid = wgid / nig, fm = gid * WGM, gsz = (nM - fm) < WGM ? (nM - fm) : WGM;
        u.pm = fm + ((wgid % nig) % gsz); u.pn = (wgid % nig) / gsz; return true;
    }
    __device__ __forceinline__ void a_ready(const Unit&) const {}
    __device__ __forceinline__ void done(const Unit&) const {}
};

__device__ __forceinline__ unsigned cvt_pk_bf16(float lo, float hi) { unsigned r; asm volatile("v_cvt_pk_bf16_f32 %0, %1, %2" : "=v"(r) : "v"(lo), "v"(hi)); return r; }
typedef float f32x2 __attribute__((ext_vector_type(2)));
__device__ __forceinline__ f32x2 gelu_pk(f32x2 v) {
    const f32x2 av = __builtin_elementwise_abs(v), d = av * 0.2316418882f + 1.0f;
    f32x2 t; t.x = __builtin_amdgcn_rcpf(d.x); t.y = __builtin_amdgcn_rcpf(d.y);
    f32x2 q = t * 0.5307027145f + (-0.7265760135f); q = q * t + 0.7107068705f; q = q * t + (-0.142248368f); q = q * t + 0.127414796f; q = q * t;
    const f32x2 s = (v * v) * (-0.72134752044f);
    f32x2 e; e.x = __builtin_amdgcn_exp2f(s.x); e.y = __builtin_amdgcn_exp2f(s.y);
    const f32x2 m = v * (q * e), r = v - m;
    f32x2 o; o.x = v.x < 0.f ? m.x : r.x; o.y = v.y < 0.f ? m.y : r.y; return o;
}

template <int ACT  > struct EpiBf16 {
    static constexpr bool PERM = true, AFTER_DRAIN = false; static_assert(ACT == 0 || ACT == 1, "EpiBf16: ACT is 0 (none) or 1 (gelu_pk)");
    bf16_t* O; int ldc; const float* bias; int split_cols; size_t split_stride; float scale0;
    __device__ __forceinline__ void operator()(const f32x4 (&acc)[2][2][4][2], const Unit& u, int wr, int wc, int fr, int fq) const {
        const int row0 = u.pm * BM + wr * 64 + fr; int colt = u.pn * BM; bf16_t* base = O;
        float sc = 1.f; if (split_cols) { const int t = colt / split_cols; base += (size_t)t * split_stride; colt -= t * split_cols; if (t == 0) sc = scale0; }
        const int col0 = colt + wc * 32 + 8 * fq, bcol0 = u.pn * BM + wc * 32 + 8 * fq;
        f32x4 bv[2][2];
#pragma unroll
        for (int bj = 0; bj < 2; ++bj)
#pragma unroll
            for (int n = 0; n < 2; ++n) bv[bj][n] = bias ? *(const f32x4*)(bias + bcol0 + bj * HALF + 4 * n) : (f32x4){0.f, 0.f, 0.f, 0.f};
#pragma unroll
        for (int ai = 0; ai < 2; ++ai)
#pragma unroll
            for (int m = 0; m < 4; ++m) { bf16_t* rowp = base + (size_t)(row0 + ai * HALF + m * 16) * ldc + col0;
#pragma unroll
                for (int bj = 0; bj < 2; ++bj) { f32x4 v0 = acc[ai][bj][m][0] + bv[bj][0], v1 = acc[ai][bj][m][1] + bv[bj][1];
                    if (ACT == 1) { f32x2 a = gelu_pk((f32x2){v0[0], v0[1]}), b = gelu_pk((f32x2){v0[2], v0[3]}), c = gelu_pk((f32x2){v1[0], v1[1]}), d = gelu_pk((f32x2){v1[2], v1[3]});
                        v0 = (f32x4){a.x, a.y, b.x, b.y}; v1 = (f32x4){c.x, c.y, d.x, d.y}; }
                    v0 = v0 * sc; v1 = v1 * sc; u32x4 w; w.x = cvt_pk_bf16(v0[0], v0[1]); w.y = cvt_pk_bf16(v0[2], v0[3]); w.z = cvt_pk_bf16(v1[0], v1[1]); w.w = cvt_pk_bf16(v1[2], v1[3]);
                    *(u32x4*)(rowp + bj * HALF) = w; } }
    }
};
struct EpiHeadMajor {
    static constexpr bool PERM = true, AFTER_DRAIN = false;
    bf16_t* O; int Mrows; const float* rowsq; float inv_k, eps;
    __device__ __forceinline__ void operator()(const f32x4 (&acc)[2][2][4][2], const Unit& u, int wr, int wc, int fr, int fq) const {
        const int row0 = u.pm * BM + wr * 64 + fr, col0 = wc * 32 + 8 * fq;
#pragma unroll
        for (int ai = 0; ai < 2; ++ai) {
            f32x4 pa[4], pb[4];
#pragma unroll
            for (int m = 0; m < 4; ++m) { const f32x4* pp = (const f32x4*)(rowsq + (size_t)(row0 + ai * HALF + m * 16) * 32 + 8 * fq); pa[m] = pp[0]; pb[m] = pp[1]; }
#pragma unroll
            for (int m = 0; m < 4; ++m) { const int row = row0 + ai * HALF + m * 16; const f32x4 a = pa[m], b = pb[m];
                float sq = ((a[0] + a[1]) + (a[2] + a[3])) + ((b[0] + b[1]) + (b[2] + b[3])); sq += __shfl_xor(sq, 16); sq += __shfl_xor(sq, 32);
                const float rs = 1.0f / sqrtf(sq * inv_k + eps);
#pragma unroll
                for (int bj = 0; bj < 2; ++bj) { const f32x4 v0 = acc[ai][bj][m][0] * rs, v1 = acc[ai][bj][m][1] * rs;
                    u32x4 w; w.x = cvt_pk_bf16(v0[0], v0[1]); w.y = cvt_pk_bf16(v0[2], v0[3]); w.z = cvt_pk_bf16(v1[0], v1[1]); w.w = cvt_pk_bf16(v1[2], v1[3]);
                    *(u32x4*)(O + ((size_t)(u.pn * 2 + bj) * Mrows + row) * HALF + col0) = w; } }
            asm volatile("" ::: "memory"); }
    }
};
struct EpiResF32 {
    static constexpr bool PERM = true, AFTER_DRAIN = false;
    bf16_t* xb; float* rowsq; int ldc;
    __device__ __forceinline__ void operator()(const f32x4 (&acc)[2][2][4][2], const Unit& u, int wr, int wc, int fr, int fq) const {
        const int col0 = u.pn * BM + wc * 32 + 8 * fq;
#pragma unroll
        for (int ai = 0; ai < 2; ++ai) {
            u32x4 pre[4][2];
#pragma unroll
            for (int m = 0; m < 4; ++m) { const size_t off = (size_t)(u.pm * BM + ai * HALF + wr * 64 + m * 16 + fr) * ldc + col0;
#pragma unroll
                for (int bj = 0; bj < 2; ++bj) pre[m][bj] = *(const u32x4*)(xb + off + bj * HALF); }
            asm volatile("" ::: "memory");
#pragma unroll
            for (int m = 0; m < 4; ++m) { const int row = u.pm * BM + ai * HALF + wr * 64 + m * 16 + fr; const size_t off = (size_t)row * ldc + col0; float ss = 0.f;
#pragma unroll
                for (int bj = 0; bj < 2; ++bj) { const u32x4 pb = pre[m][bj]; const f32x4 a0 = acc[ai][bj][m][0], a1 = acc[ai][bj][m][1];
                    u32x4 w; w.x = cvt_pk_bf16(__uint_as_float(pb.x << 16) + a0[0], __uint_as_float(pb.x & 0xffff0000u) + a0[1]); w.y = cvt_pk_bf16(__uint_as_float(pb.y << 16) + a0[2], __uint_as_float(pb.y & 0xffff0000u) + a0[3]);
                    w.z = cvt_pk_bf16(__uint_as_float(pb.z << 16) + a1[0], __uint_as_float(pb.z & 0xffff0000u) + a1[1]); w.w = cvt_pk_bf16(__uint_as_float(pb.w << 16) + a1[2], __uint_as_float(pb.w & 0xffff0000u) + a1[3]);
#pragma unroll
                    for (int q = 0; q < 4; ++q) { const float r0 = __uint_as_float(w[q] << 16), r1 = __uint_as_float(w[q] & 0xffff0000u); ss += r0 * r0 + r1 * r1; }
                    *(u32x4*)(xb + off + bj * HALF) = w; }
                ss += __shfl_xor(ss, 16); ss += __shfl_xor(ss, 32);
                if (fq == 0) rowsq[(size_t)row * 32 + u.pn * 4 + wc] = ss; }
            asm volatile("" ::: "memory"); }
    }
};


template <class Epi, class Sched, bool ALIGN_EPI = false, bool SP2 = false>
__device__ __forceinline__ void gemm_phase(PG8_LAS unsigned char* lds, const Gemm g, const Sched& S, const Epi& E) {
    const int tid = otid(), wid = __builtin_amdgcn_readfirstlane(tid >> 6), lane = tid & 63, wr = wid >> 2, wc = wid & 3, fr = lane & 15, fq = lane >> 4;
    const int K = g.K, nt = K / BK;
    unsigned voffA[2], voffB[2];
#pragma unroll
    for (int i = 0; i < 2; ++i) { int R, C; stage_rc(tid * 16 + i * 8192, R, C); const int Rb = Epi::PERM ? ((R & ~31) + perm32(R & 31)) : R;
        voffA[i] = (unsigned)(R * K + C) * 2u; voffB[i] = (unsigned)(Rb * K + C) * 2u; }
    const size_t kstep = (size_t)(BK * 2);
    const size_t hstep = (size_t)HALF * K * 2;
    const size_t tstep = 2 * hstep;
    const unsigned ldsw = (unsigned)wid * 1024u;
    const int aoff = lds_byte(wr * 64 + fr, fq * 8), boff = lds_byte(wc * 32 + fr, fq * 8);
#define PG8_SA(b, h) (((b) * 2 + (h)) * HTB)
#define PG8_SB(b, h) ((4 + (b) * 2 + (h)) * HTB)
#define PG8_STAGE(bufoff, gbase, voff) do { _Pragma("unroll") for (int _i = 0; _i < 2; ++_i) \
        __builtin_amdgcn_global_load_lds((const unsigned*)((const char*)(gbase) + (voff)[_i]), (PG8_LAS unsigned*)(lds + (bufoff) + ldsw + _i * 8192), 16, 0, 0); } while (0)
#define PG8_LDA(dst, b, h) do { _Pragma("unroll") for (int m = 0; m < 4; ++m) _Pragma("unroll") for (int k = 0; k < 2; ++k) dst[m][k] = *(const PG8_LAS bf16x8*)(lds + PG8_SA(b, h) + aoff + m * 2048 + k * 1024); } while (0)
#define PG8_LDB(dst, b, h) do { _Pragma("unroll") for (int n = 0; n < 2; ++n) _Pragma("unroll") for (int k = 0; k < 2; ++k) dst[n][k] = *(const PG8_LAS bf16x8*)(lds + PG8_SB(b, h) + boff + n * 2048 + k * 1024); } while (0)
#define PG8_MMA(ai, bj, At, Bt) do { __builtin_amdgcn_s_setprio(1); _Pragma("unroll") for (int m = 0; m < 4; ++m) _Pragma("unroll") for (int n = 0; n < 2; ++n) _Pragma("unroll") for (int k = 0; k < 2; ++k) \
        acc[ai][bj][m][n] = __builtin_amdgcn_mfma_f32_16x16x32_bf16(Bt[n][k], At[m][k], acc[ai][bj][m][n], 0, 0, 0); __builtin_amdgcn_s_setprio(0); } while (0)
#define PG8_WAIT_V(n) asm volatile("s_waitcnt vmcnt(" #n ")" ::: "memory")
#define PG8_WAIT_L(n) asm volatile("s_waitcnt lgkmcnt(" #n ")" ::: "memory")
#define PG8_BAR __builtin_amdgcn_s_barrier()
#define PG8_SCHED __builtin_amdgcn_sched_barrier(0)
    Unit cur, nxt; int ui = 0;
    if (!S.next(0, cur)) return;
    f32x4 acc[2][2][4][2];
#pragma unroll
    for (int a = 0; a < 2; ++a)
#pragma unroll
        for (int b = 0; b < 2; ++b)
#pragma unroll
            for (int m = 0; m < 4; ++m)
#pragma unroll
                for (int n = 0; n < 2; ++n) acc[a][b][m][n] = (f32x4){0.f, 0.f, 0.f, 0.f};
    bf16x8 At[4][2], B0[2][2], B1[2][2];
    const char* cA = (const char*)g.A + (size_t)cur.pm * tstep; const char* cB = (const char*)g.Bt + (size_t)cur.pn * tstep;
    S.a_ready(cur);
    if constexpr (SP2) {
        PG8_STAGE(PG8_SB(0, 0), cB, voffB); PG8_STAGE(PG8_SB(0, 1), cB + hstep, voffB); PG8_STAGE(PG8_SA(0, 0), cA, voffA); PG8_STAGE(PG8_SA(0, 1), cA + hstep, voffA);
        if (wr == 1) PG8_BAR;
        PG8_WAIT_V(2); PG8_BAR;
        PG8_STAGE(PG8_SB(1, 0), cB + kstep, voffB); PG8_STAGE(PG8_SA(1, 0), cA + kstep, voffA); PG8_STAGE(PG8_SB(1, 1), cB + hstep + kstep, voffB);
        PG8_WAIT_V(6); PG8_BAR;
    } else {
        PG8_STAGE(PG8_SB(0, 0), cB, voffB); PG8_STAGE(PG8_SA(0, 0), cA, voffA); PG8_STAGE(PG8_SB(0, 1), cB + hstep, voffB); PG8_STAGE(PG8_SA(0, 1), cA + hstep, voffA);
        if (wr == 1) PG8_BAR;
        PG8_WAIT_V(4); PG8_BAR;
        PG8_STAGE(PG8_SB(1, 0), cB + kstep, voffB); PG8_STAGE(PG8_SA(1, 0), cA + kstep, voffA); PG8_STAGE(PG8_SB(1, 1), cB + hstep + kstep, voffB);
        PG8_WAIT_V(6); PG8_BAR;
    }
    for (;;) {
        const bool has_next = S.next(ui + 1, nxt);
        const char* nA = has_next ? (const char*)g.A + (size_t)nxt.pm * tstep : cA; const char* nB = has_next ? (const char*)g.Bt + (size_t)nxt.pn * tstep : cB;
        for (int t = 0; t < nt; t += 2) {
            const bool last = (t == nt - 2);
            const char* a1 = cA + (size_t)(t + 1) * kstep;
            const char* a2 = last ? nA : cA + (size_t)(t + 2) * kstep; const char* b2 = last ? nB : cB + (size_t)(t + 2) * kstep;
            const char* a3 = a2 + kstep; const char* b3 = b2 + kstep;
            if (last && has_next) S.a_ready(nxt);
            if constexpr (SP2) {
            PG8_LDB(B0, 0, 0); PG8_LDB(B1, 0, 1); PG8_SCHED; PG8_LDA(At, 0, 0); PG8_STAGE(PG8_SA(1, 1), a1 + hstep, voffA);
            PG8_WAIT_V(8); PG8_WAIT_L(0); PG8_BAR; PG8_MMA(0, 0, At, B0); PG8_MMA(0, 1, At, B1); PG8_BAR; PG8_SCHED;
            PG8_LDA(At, 0, 1); PG8_STAGE(PG8_SB(0, 0), b2, voffB); PG8_STAGE(PG8_SB(0, 1), b2 + hstep, voffB); PG8_STAGE(PG8_SA(0, 0), a2, voffA);
            PG8_WAIT_V(8); PG8_WAIT_L(0); PG8_BAR; PG8_MMA(1, 0, At, B0); PG8_MMA(1, 1, At, B1); PG8_BAR; PG8_SCHED;
            PG8_LDB(B0, 1, 0); PG8_LDB(B1, 1, 1); PG8_SCHED; PG8_LDA(At, 1, 0); PG8_STAGE(PG8_SA(0, 1), a2 + hstep, voffA);
            PG8_WAIT_V(8); PG8_WAIT_L(0); PG8_BAR; PG8_MMA(0, 0, At, B0); PG8_MMA(0, 1, At, B1); PG8_BAR; PG8_SCHED;
            PG8_LDA(At, 1, 1); PG8_STAGE(PG8_SB(1, 0), b3, voffB); PG8_STAGE(PG8_SB(1, 1), b3 + hstep, voffB); PG8_STAGE(PG8_SA(1, 0), a3, voffA);
            PG8_WAIT_V(8); PG8_WAIT_L(0); PG8_BAR; PG8_MMA(1, 0, At, B0); PG8_MMA(1, 1, At, B1); PG8_BAR; PG8_SCHED;
            } else {
            PG8_LDB(B0, 0, 0); PG8_SCHED; PG8_LDA(At, 0, 0); PG8_STAGE(PG8_SA(1, 1), a1 + hstep, voffA);
            PG8_WAIT_L(8); PG8_BAR; PG8_WAIT_L(0); PG8_MMA(0, 0, At, B0); PG8_BAR; PG8_SCHED;
            PG8_LDB(B1, 0, 1); PG8_STAGE(PG8_SB(0, 0), b2, voffB);
            PG8_BAR; PG8_WAIT_L(0); PG8_MMA(0, 1, At, B1); PG8_BAR;
            PG8_LDA(At, 0, 1); PG8_STAGE(PG8_SA(0, 0), a2, voffA);
            PG8_BAR; PG8_WAIT_L(0); PG8_MMA(1, 0, At, B0); PG8_BAR; PG8_SCHED;
            PG8_STAGE(PG8_SB(0, 1), b2 + hstep, voffB);
            PG8_WAIT_V(6); PG8_BAR; PG8_MMA(1, 1, At, B1); PG8_BAR;
            PG8_LDB(B0, 1, 0); PG8_SCHED; PG8_LDA(At, 1, 0); PG8_STAGE(PG8_SA(0, 1), a2 + hstep, voffA);
            PG8_WAIT_L(8); PG8_BAR; PG8_WAIT_L(0); PG8_MMA(0, 0, At, B0); PG8_BAR; PG8_SCHED;
            PG8_LDB(B1, 1, 1); PG8_STAGE(PG8_SB(1, 0), b3, voffB);
            PG8_BAR; PG8_WAIT_L(0); PG8_MMA(0, 1, At, B1); PG8_BAR;
            PG8_LDA(At, 1, 1); PG8_STAGE(PG8_SA(1, 0), a3, voffA);
            PG8_BAR; PG8_WAIT_L(0); PG8_MMA(1, 0, At, B0); PG8_BAR; PG8_SCHED;
            PG8_STAGE(PG8_SB(1, 1), b3 + hstep, voffB);
            PG8_WAIT_V(6); PG8_BAR; PG8_MMA(1, 1, At, B1); PG8_BAR;
            }
        }
        if constexpr (ALIGN_EPI) { if (wr == 0) PG8_BAR; }
        if constexpr (!Epi::AFTER_DRAIN) { E(acc, cur, wr, wc, fr, fq); S.done(cur); }
        if (!has_next) break;
#pragma unroll
        for (int a = 0; a < 2; ++a)
#pragma unroll
            for (int b = 0; b < 2; ++b)
#pragma unroll
                for (int m = 0; m < 4; ++m)
#pragma unroll
                    for (int n = 0; n < 2; ++n) acc[a][b][m][n] = (f32x4){0.f, 0.f, 0.f, 0.f};
        cur = nxt; cA = nA; cB = nB; ++ui;
        if constexpr (ALIGN_EPI) { if (wr == 1) PG8_BAR; }
    }
    PG8_WAIT_V(0);
    if constexpr (!ALIGN_EPI) { if (wr == 0) PG8_BAR; }
    PG8_BAR;
    if constexpr (Epi::AFTER_DRAIN) { E.fused(acc, cur, wr, wc, fr, fq, lds, wid, lane); S.done(cur); }
#undef PG8_SA
#undef PG8_SB
#undef PG8_STAGE
#undef PG8_LDA
#undef PG8_LDB
#undef PG8_MMA
#undef PG8_WAIT_V
#undef PG8_WAIT_L
#undef PG8_BAR
#undef PG8_SCHED
}
}
#define PG8_SP2 true
#define PG8_ALIGN true
namespace att {
using bf16 = __hip_bfloat16;
constexpr int D = 128, NW = 8, QBLK = 32, KVBLK = 64;
constexpr float SCALE = 0.088388347648318440f;
constexpr float THR = 8.f;
constexpr size_t SHM_V = KVBLK * D * 2, SHM_K = KVBLK * D * 2, SHM_ATTN = 2 * SHM_V + 2 * SHM_K + NW * 64 * 4;
using bf16x8 = __attribute__((ext_vector_type(8))) short;
using s16x4  = __attribute__((ext_vector_type(4))) short;
using f32x16 = __attribute__((ext_vector_type(16))) float;
using f32x8  = __attribute__((ext_vector_type(8))) float;
using u32x4  = __attribute__((ext_vector_type(4))) unsigned;
#define KSWZ(row, colB) ((row) * 256 + ((colB) ^ (((row) & 7) << 4)))
#define SBAR() __builtin_amdgcn_sched_barrier(0)
__device__ __forceinline__ int crow(int r, int hi) { return (r & 3) + 8 * (r >> 2) + 4 * hi; }
__device__ __forceinline__ unsigned cvtpk(float lo, float hi) {
  unsigned r; asm volatile("v_cvt_pk_bf16_f32 %0, %1, %2" : "=v"(r) : "v"(lo), "v"(hi)); return r;
}
template <typename TIn> struct Stage;
template <> struct Stage<bf16>  { using T = bf16x8;
  __device__ static __forceinline__ T ld8(const bf16* p) { return *reinterpret_cast<const bf16x8*>(p); }
  __device__ static __forceinline__ bf16x8 tobf(T x) { return x; } };
template <> struct Stage<float> { using T = f32x8;
  __device__ static __forceinline__ T ld8(const float* p) { return *reinterpret_cast<const f32x8*>(p); }
  __device__ static __forceinline__ bf16x8 tobf(T x) {
    u32x4 w = {cvtpk(x[0], x[1]), cvtpk(x[2], x[3]), cvtpk(x[4], x[5]), cvtpk(x[6], x[7])}; return *reinterpret_cast<bf16x8*>(&w); } };

__device__ __forceinline__ void partialSM(f32x16& p0, f32x16& p1, float& m_reg, float& mn, float& alpha) {
  constexpr float C = SCALE * 1.4426950408889634f;
  float pmax = p0[0]; for (int r = 1; r < 16; ++r) pmax = fmaxf(pmax, p0[r]); for (int r = 0; r < 16; ++r) pmax = fmaxf(pmax, p1[r]);
  { auto rr = __builtin_amdgcn_permlane32_swap(__float_as_uint(pmax), __float_as_uint(pmax), false, false);
    pmax = fmaxf(__uint_as_float(rr[0]), __uint_as_float(rr[1])); }
  if (__builtin_expect(__all(pmax - m_reg <= THR / SCALE), 1)) { mn = m_reg; alpha = 1.f; }
  else { mn = fmaxf(m_reg, pmax); alpha = __builtin_amdgcn_exp2f((m_reg - mn) * C); m_reg = mn; }
  float mnC = -mn * C;
  for (int r = 0; r < 16; ++r) p0[r] = fmaf(p0[r], C, mnC); for (int r = 0; r < 16; ++r) p1[r] = fmaf(p1[r], C, mnC);
  for (int r = 0; r < 16; ++r) p0[r] = __builtin_amdgcn_exp2f(p0[r]);
}
__device__ __forceinline__ void finishSM(f32x16& p0, f32x16& p1, float alpha, float& l_reg, bf16x8& pa0, bf16x8& pa1, bf16x8& pa2, bf16x8& pa3) {
  for (int r = 0; r < 16; ++r) p1[r] = __builtin_amdgcn_exp2f(p1[r]);
  float ps = 0; for (int r = 0; r < 16; ++r) ps += p0[r]; for (int r = 0; r < 16; ++r) ps += p1[r];
  { auto rr = __builtin_amdgcn_permlane32_swap(__float_as_uint(ps), __float_as_uint(ps), false, false);
    ps = __uint_as_float(rr[0]) + __uint_as_float(rr[1]); }
  l_reg = l_reg * alpha + ps;
#define PK4(P, BASE, OUT) do { unsigned a0 = cvtpk(P[BASE + 0], P[BASE + 1]), a1 = cvtpk(P[BASE + 2], P[BASE + 3]);   \
    unsigned b0 = cvtpk(P[BASE + 4], P[BASE + 5]), b1 = cvtpk(P[BASE + 6], P[BASE + 7]);                              \
    auto r0 = __builtin_amdgcn_permlane32_swap(a0, b0, false, false); auto r1 = __builtin_amdgcn_permlane32_swap(a1, b1, false, false); \
    u32x4 w = {r0[0], r1[0], r0[1], r1[1]}; OUT = *reinterpret_cast<bf16x8*>(&w); } while (0)
  PK4(p0, 0, pa0); PK4(p0, 8, pa1); PK4(p1, 0, pa2); PK4(p1, 8, pa3);
#undef PK4
}
__device__ __forceinline__ void qkt(f32x16& p0, f32x16& p1, const bf16* Ks, const bf16x8* qr, int r32, int hi) {
  p0 = f32x16{}; p1 = f32x16{};
  for (int d0 = 0; d0 < 8; ++d0) { int cb = (d0 * 16 + hi * 8) * 2;
    bf16x8 b0 = *reinterpret_cast<const bf16x8*>((const char*)Ks + KSWZ(r32, cb));
    bf16x8 b1 = *reinterpret_cast<const bf16x8*>((const char*)Ks + KSWZ(32 + r32, cb));
    p0 = __builtin_amdgcn_mfma_f32_32x32x16_bf16(b0, qr[d0], p0, 0, 0, 0);
    p1 = __builtin_amdgcn_mfma_f32_32x32x16_bf16(b1, qr[d0], p1, 0, 0, 0); }
}
__device__ __forceinline__ int v_st(int k, int c) { const int kk = (k & ~0xC) | ((k & 4) << 1) | ((k & 8) >> 1); return ((kk >> 3) * 4 + (c >> 5)) * 512 + ((kk & 7) * 32 + (c & 31)) * 2; }
__device__ __forceinline__ int v_rd_base(int lane) { return ((lane & 3) << 3) | (((lane >> 2) & 3) << 6) | (((lane >> 4) & 1) << 5) | (((lane >> 5) & 1) << 8); }
constexpr int v_rd_off(int d0, int ks, int half) { return d0 * 512 + ks * 4096 + half * 2048; }
template <int OFF> __device__ __forceinline__ s16x4 tr_read(int vb) {
  s16x4 r; asm volatile("ds_read_b64_tr_b16 %0, %1 offset:%2" : "=&v"(r) : "v"(vb), "i"(OFF) : "memory"); return r;
}
template <int D0> __device__ __forceinline__ void pv_one(f32x16& od, int vb, bf16x8 pa0, bf16x8 pa1, bf16x8 pa2, bf16x8 pa3) {
  const s16x4 l0 = tr_read<v_rd_off(D0, 0, 0)>(vb), h0 = tr_read<v_rd_off(D0, 0, 1)>(vb), l1 = tr_read<v_rd_off(D0, 1, 0)>(vb), h1 = tr_read<v_rd_off(D0, 1, 1)>(vb);
  const s16x4 l2 = tr_read<v_rd_off(D0, 2, 0)>(vb), h2 = tr_read<v_rd_off(D0, 2, 1)>(vb), l3 = tr_read<v_rd_off(D0, 3, 0)>(vb), h3 = tr_read<v_rd_off(D0, 3, 1)>(vb);
  asm volatile("s_waitcnt lgkmcnt(0)" ::: "memory"); SBAR();
#define PK(L, H) (bf16x8){L[0], L[1], L[2], L[3], H[0], H[1], H[2], H[3]}
  od = __builtin_amdgcn_mfma_f32_32x32x16_bf16(pa0, PK(l0, h0), od, 0, 0, 0);
  od = __builtin_amdgcn_mfma_f32_32x32x16_bf16(pa1, PK(l1, h1), od, 0, 0, 0);
  od = __builtin_amdgcn_mfma_f32_32x32x16_bf16(pa2, PK(l2, h2), od, 0, 0, 0);
  od = __builtin_amdgcn_mfma_f32_32x32x16_bf16(pa3, PK(l3, h3), od, 0, 0, 0);
#undef PK
}
__device__ __forceinline__ void pv_d0(f32x16* o, int vb, bf16x8 pa0, bf16x8 pa1, bf16x8 pa2, bf16x8 pa3) {
  pv_one<0>(o[0], vb, pa0, pa1, pa2, pa3); pv_one<1>(o[1], vb, pa0, pa1, pa2, pa3); pv_one<2>(o[2], vb, pa0, pa1, pa2, pa3); pv_one<3>(o[3], vb, pa0, pa1, pa2, pa3);
}
constexpr int crow0(int r) { return (r & 3) + 8 * (r >> 2); }
constexpr float LOG2E = 1.4426950408889634f;
__device__ __forceinline__ void partialSM_dil(f32x16& p0, f32x16& p1, float& m_reg, float& mn, float& alpha, float dq, float dlo, float dhi, float nslopeC) {
  constexpr float C = SCALE * LOG2E;
#pragma unroll
  for (int r = 0; r < 16; ++r) {
    const float d0 = dq + (float)crow0(r), d1 = d0 + 32.f;
    const float t0 = fmaf(p0[r], C, nslopeC * fabsf(d0)), t1 = fmaf(p1[r], C, nslopeC * fabsf(d1));
    p0[r] = (d0 >= dlo && d0 <= dhi) ? t0 : -1e30f;
    p1[r] = (d1 >= dlo && d1 <= dhi) ? t1 : -1e30f;
  }
  float pmax = p0[0];
#pragma unroll
  for (int r = 1; r < 16; ++r) pmax = fmaxf(pmax, p0[r]);
#pragma unroll
  for (int r = 0; r < 16; ++r) pmax = fmaxf(pmax, p1[r]);
  { auto rr = __builtin_amdgcn_permlane32_swap(__float_as_uint(pmax), __float_as_uint(pmax), false, false);
    pmax = fmaxf(__uint_as_float(rr[0]), __uint_as_float(rr[1])); }
  if (__builtin_expect(__all(pmax - m_reg <= THR * LOG2E), 1)) { mn = m_reg; alpha = 1.f; }
  else { mn = fmaxf(m_reg, pmax); alpha = __builtin_amdgcn_exp2f(m_reg - mn); m_reg = mn; }
#pragma unroll
  for (int r = 0; r < 16; ++r) { p0[r] = p0[r] - mn; p1[r] = p1[r] - mn; }
#pragma unroll
  for (int r = 0; r < 16; ++r) p0[r] = __builtin_amdgcn_exp2f(p0[r]);
}

template <bool DIL>
__device__ __forceinline__ void attn_body(const bf16* __restrict__ Qb, const bf16* __restrict__ Kh, const bf16* __restrict__ Vh, long qs, long ks,
                                          bf16* __restrict__ Ob, long os, float* __restrict__ lse_o, int lse_s, int i0, int nsub, float nslopeC, int seq, char* lds) {
  using St = Stage<bf16>;
  const int tid = otid(), wid = __builtin_amdgcn_readfirstlane(tid >> 6), lane = tid & 63, r32 = lane & 31, hi = lane >> 5;
  bf16* V_lds = (bf16*)lds; bf16* K_lds = (bf16*)(lds + 2 * SHM_V);
  float* ws = (float*)(lds + 2 * SHM_V + 2 * SHM_K) + wid * 64; float* li_l = ws; float* al_l = ws + 32;
  float m_reg = -1e30f, l_reg = 0; f32x16 o[4] = {}; bf16x8 qr[8];
  const bf16* Qw = Qb + (long)(wid * QBLK + r32) * qs + hi * 8;
#pragma unroll
  for (int d0 = 0; d0 < 8; ++d0) qr[d0] = St::ld8(Qw + d0 * 16);
  const int sr = tid >> 4, sc = (tid & 15) * 8, vst0 = v_st(sr, sc), vst1 = v_st(32 + sr, sc);
  const int vb0 = (int)(uintptr_t)V_lds + v_rd_base(lane);
  constexpr int SDEPTH = 1;
  struct { typename St::T vs0, vs1, ks0, ks1; } sr_[SDEPTH];
  const int kb = DIL ? i0 - 64 : 0;
#define KROW(k) (DIL ? (long)min(max(kb + (k), 0), nsub - 1) : (long)(k))
#define SLOAD(i, k0) do { const long ra_ = KROW((k0) + sr) * ks + sc, rb_ = KROW((k0) + 32 + sr) * ks + sc; \
    sr_[i].vs0 = St::ld8(&Vh[ra_]); sr_[i].vs1 = St::ld8(&Vh[rb_]); sr_[i].ks0 = St::ld8(&Kh[ra_]); sr_[i].ks1 = St::ld8(&Kh[rb_]); } while (0)
#define SWRITE(b, i) do { *(bf16x8*)((char*)V_lds + (b) * SHM_V + vst0) = St::tobf(sr_[i].vs0);          \
    *(bf16x8*)((char*)V_lds + (b) * SHM_V + vst1) = St::tobf(sr_[i].vs1); int kc = sc * 2;               \
    *(bf16x8*)((char*)K_lds + (b) * SHM_K + KSWZ(sr, kc)) = St::tobf(sr_[i].ks0);                       \
    *(bf16x8*)((char*)K_lds + (b) * SHM_K + KSWZ(32 + sr, kc)) = St::tobf(sr_[i].ks1); } while (0)
#define SWAIT() do { if constexpr (SDEPTH == 2) asm volatile("s_waitcnt vmcnt(4)" ::: "memory"); else asm volatile("s_waitcnt vmcnt(0)" ::: "memory"); } while (0)
#define RESC(a) do { if (__any((a) < 1.f)) { if (hi == 0) al_l[r32] = (a); asm volatile("s_waitcnt lgkmcnt(0)" ::: "memory"); \
    for (int d = 0; d < 4; ++d) for (int r = 0; r < 16; ++r) o[d][r] *= al_l[crow(r, hi)]; } } while (0)
#define PSM(P0, P1, MN, AL, jt) do { if constexpr (DIL) { const int t_ = otid(), iq_ = (t_ >> 6) * QBLK + (t_ & 31), hi_ = (t_ >> 5) & 1; \
      partialSM_dil(P0, P1, m_reg, MN, AL, (float)(-64 - iq_ + 4 * hi_ + 64 * (jt)), fmaxf(-64.f, (float)(-(i0 + iq_))), fminf(64.f, (float)(nsub - 1 - (i0 + iq_))), nslopeC); } \
    else partialSM(P0, P1, m_reg, MN, AL); } while (0)
  f32x16 pA0, pA1, pB0, pB1; float mnA, mnB, alA, alB; bf16x8 pa0, pa1, pa2, pa3; const int NT = DIL ? 6 : seq / KVBLK;
  constexpr int SE = 0, SO = SDEPTH - 1;
  SLOAD(SE, 0); asm volatile("s_waitcnt vmcnt(0)" ::: "memory"); SWRITE(0, SE); __syncthreads();
  qkt(pA0, pA1, K_lds, qr, r32, hi); PSM(pA0, pA1, mnA, alA, 0);
  SLOAD(SO, KVBLK); if constexpr (SDEPTH == 2) { if (2 < NT) SLOAD(SE, 2 * KVBLK); }
  SWAIT(); SWRITE(1, SO); __syncthreads();
  for (int j = 1; j + 1 < NT; j += 2) {
    SBAR(); qkt(pB0, pB1, (bf16*)((char*)K_lds + SHM_K), qr, r32, hi);
    finishSM(pA0, pA1, alA, l_reg, pa0, pa1, pa2, pa3); SBAR();
    SLOAD(SO, (j + SDEPTH) * KVBLK); SBAR();
    pv_d0(o, vb0, pa0, pa1, pa2, pa3); PSM(pB0, pB1, mnB, alB, j);
    __syncthreads(); SWAIT(); SWRITE(0, SE);
    RESC(alB); __syncthreads();
    SBAR(); qkt(pA0, pA1, K_lds, qr, r32, hi);
    finishSM(pB0, pB1, alB, l_reg, pa0, pa1, pa2, pa3); SBAR();
    if (SDEPTH == 1 || j + 3 < NT) SLOAD(SE, (j + 1 + SDEPTH) * KVBLK); SBAR();
    pv_d0(o, vb0 + (int)SHM_V, pa0, pa1, pa2, pa3); PSM(pA0, pA1, mnA, alA, j + 1);
    __syncthreads(); SWAIT(); SWRITE(1, SO);
    RESC(alA); __syncthreads();
  }
  SBAR(); qkt(pB0, pB1, (bf16*)((char*)K_lds + SHM_K), qr, r32, hi);
  finishSM(pA0, pA1, alA, l_reg, pa0, pa1, pa2, pa3); SBAR();
  pv_d0(o, vb0, pa0, pa1, pa2, pa3); PSM(pB0, pB1, mnB, alB, NT - 1);
  __syncthreads(); RESC(alB);
  finishSM(pB0, pB1, alB, l_reg, pa0, pa1, pa2, pa3); SBAR();
  pv_d0(o, vb0 + (int)SHM_V, pa0, pa1, pa2, pa3);
  if (hi == 0) li_l[r32] = l_reg; asm volatile("s_waitcnt lgkmcnt(0)" ::: "memory");
  if constexpr (DIL) { if (hi == 0) lse_o[(long)(wid * QBLK + r32) * lse_s] = m_reg + __log2f(l_reg); }
  float rli[16];
#pragma unroll
  for (int r = 0; r < 16; ++r) rli[r] = __builtin_amdgcn_rcpf(li_l[crow(r, hi)]);
  bf16* Ow = Ob + (long)(wid * QBLK) * os;
#pragma unroll
  for (int r = 0; r < 16; ++r) { const int orow = crow(r, hi);
#pragma unroll
    for (int d0 = 0; d0 < 4; ++d0) Ow[(long)orow * os + d0 * 32 + r32] = __float2bfloat16(o[d0][r] * rli[r]); }
  __syncthreads();
#undef KROW
#undef SLOAD
#undef SWRITE
#undef SWAIT
#undef RESC
#undef PSM
}
}

#define GAS __attribute__((address_space(1)))
#define LAS __attribute__((address_space(3)))
typedef unsigned short bf16_t;
typedef unsigned v4u __attribute__((ext_vector_type(4)));
typedef unsigned v2u __attribute__((ext_vector_type(2)));
typedef float f32x4 __attribute__((ext_vector_type(4)));
#define LDS_WAIT() asm volatile("s_waitcnt lgkmcnt(0)" ::: "memory")

constexpr size_t MiB = 1u << 20;
constexpr size_t WS_W1T = 0;
constexpr size_t WS_W2T = 104 * MiB;
constexpr size_t WS_H = 136 * MiB;
constexpr size_t WS_PROJ = 200 * MiB;
constexpr size_t WS_YA = 408 * MiB;
constexpr size_t WS_YB = 440 * MiB;
constexpr size_t WS_LSE = 536 * MiB;
constexpr size_t WS_ROPE = 538 * MiB;
constexpr size_t WS_XB = 540 * MiB;
constexpr size_t WS_ROWSQ = 604 * MiB;
constexpr size_t WS_END = 616 * MiB;
static_assert((size_t)DEPTH * DIN * DM * 2 <= WS_W2T - WS_W1T && (size_t)M * DIN * 2 <= WS_YA - WS_PROJ && (size_t)3 * M * DB * 2 <= WS_LSE - WS_YB, "ws map");
constexpr int LDS_BYTES = 147456;
constexpr int N_PHASES = 2 + 5 * DEPTH;

__device__ __forceinline__ unsigned f2bf(float f) { unsigned u = __builtin_bit_cast(unsigned, f); return (u + 0x7fffu + ((u >> 16) & 1u)) >> 16; }
__device__ __forceinline__ unsigned pk2(float lo, float hi) { return f2bf(lo) | (f2bf(hi) << 16); }
__device__ __forceinline__ float bflo(unsigned w) { return __uint_as_float(w << 16); }
__device__ __forceinline__ float bfhi(unsigned w) { return __uint_as_float(w & 0xffff0000u); }
__device__ __forceinline__ float wave_sum(float v) {
#pragma unroll
    for (int o = 1; o < 64; o <<= 1) v += __shfl_xor(v, o);
    return v;
}

__device__ const float INV_FREQ[32] = {1.000000000e+00f, 7.498942614e-01f, 5.623413324e-01f, 4.216965139e-01f, 3.162277639e-01f, 2.371373773e-01f, 1.778279394e-01f, 1.333521307e-01f,
    1.000000015e-01f, 7.498941571e-02f, 5.623413250e-02f, 4.216965288e-02f, 3.162277490e-02f, 2.371373773e-02f, 1.778279431e-02f, 1.333521493e-02f,
    9.999999776e-03f, 7.498941850e-03f, 5.623413250e-03f, 4.216964822e-03f, 3.162277630e-03f, 2.371373586e-03f, 1.778279431e-03f, 1.333521446e-03f,
    1.000000047e-03f, 7.498942432e-04f, 5.623413017e-04f, 4.216965172e-04f, 3.162277571e-04f, 2.371373703e-04f, 1.778279402e-04f, 1.333521504e-04f};

__device__ __forceinline__ void sincos_acc(float a, float& s, float& c) {
    const double x = (double)a, kd = __builtin_rint(x * 0.63661977236758134308);
    const int k = (int)kd; const double r = x - kd * 1.57079632679489661923, r2 = r * r;
    const double sp = r * (1.0 + r2 * (-1.0 / 6 + r2 * (1.0 / 120 + r2 * (-1.0 / 5040 + r2 * (1.0 / 362880 + r2 * (-1.0 / 39916800 + r2 * (1.0 / 6227020800.0)))))));
    const double cp = 1.0 + r2 * (-0.5 + r2 * (1.0 / 24 + r2 * (-1.0 / 720 + r2 * (1.0 / 40320 + r2 * (-1.0 / 3628800 + r2 * (1.0 / 479001600.0 + r2 * (-1.0 / 87178291200.0)))))));
    const int q = k & 3;
    const double sv = (q == 0) ? sp : (q == 1) ? cp : (q == 2) ? -sp : -cp, cv = (q == 0) ? cp : (q == 1) ? -sp : (q == 2) ? -cp : sp;
    s = (float)sv; c = (float)cv;
}

__device__ __forceinline__ void p0_transpose_item(const float* W, int K, int N, bf16_t* WT, LAS float* scr, int item, int lane, const float* kscale) {
    const int nblk = N / 32, kb = item / nblk, nb = item % nblk, k0 = 64 * kb, n0 = 32 * nb;
#pragma unroll 8
    for (int i = 0; i < 32; ++i) { const int kk = 2 * i + (lane >> 5); scr[kk * 33 + (lane & 31)] = W[(size_t)(k0 + kk) * N + n0 + (lane & 31)] * (kscale ? kscale[k0 + kk] : 1.0f); }
    LDS_WAIT(); asm volatile("" ::: "memory");
    const int c = lane & 7;
#pragma unroll
    for (int j = 0; j < 4; ++j) { const int n = (lane >> 3) + 8 * j; const LAS float* s = scr + (8 * c) * 33 + n;
        v4u o; o.x = pk2(s[0 * 33], s[1 * 33]); o.y = pk2(s[2 * 33], s[3 * 33]); o.z = pk2(s[4 * 33], s[5 * 33]); o.w = pk2(s[6 * 33], s[7 * 33]);
        *(v4u*)(WT + (size_t)(n0 + n) * K + k0 + 8 * c) = o; }
    LDS_WAIT(); asm volatile("" ::: "memory");
}

#define XB_TMO      128
#define XB_XCNT(j)  (256  + 64 * (j))
#define XB_XSUB(j)  (1280 + 64 * (j))
#define XB_XGEN(j)  (2304 + 64 * (j))
#define XB_TOP      3328
#define XB_TOPGEN   3392
#define XCD_BAR_WORDS 3456
#define XB_SPIN_CAP (1u << 18)

__device__ __forceinline__ unsigned xb_ld(unsigned* p)              { return __hip_atomic_load(p, __ATOMIC_RELAXED, __HIP_MEMORY_SCOPE_AGENT); }
__device__ __forceinline__ unsigned xb_add(unsigned* p, unsigned v) { return __hip_atomic_fetch_add(p, v, __ATOMIC_RELAXED, __HIP_MEMORY_SCOPE_AGENT); }
__device__ __forceinline__ unsigned xb_xcc_id() { return (unsigned)__builtin_amdgcn_s_getreg((3 << 11) | 20) & 0xFu; }
#define XB_SPIN(cond, bar) do { unsigned _sp = 0; while (cond) { __builtin_amdgcn_s_sleep(1); \
    if ((++_sp & 255u) == 0u) { if (xb_ld(&(bar)[XB_TMO])) break; if (_sp > XB_SPIN_CAP) { atomicAdd(&(bar)[XB_TMO], 1u); break; } } } } while (0)

struct XcdBarrier {
    unsigned* bar; unsigned x;
    volatile LAS unsigned* st;
};

__device__ __forceinline__ XcdBarrier xcd_barrier_post(unsigned* bar, volatile LAS unsigned* st) {
    XcdBarrier b; b.bar = bar; b.x = xb_xcc_id(); b.st = st;
    if (threadIdx.x == 0) (void)xb_add(&bar[XB_XCNT(b.x)], 1u);
    return b;
}
__device__ __forceinline__ void xcd_barrier_complete(unsigned* bar, unsigned x, unsigned& nloc, unsigned& nx) {
    const unsigned G = gridDim.x * gridDim.y * gridDim.z;
    unsigned sum, cnt, mine, sp = 0u;
    for (;;) {
        sum = 0u; cnt = 0u; mine = 0u;
#pragma unroll
        for (unsigned j = 0; j < 16; ++j) { const unsigned c = xb_ld(&bar[XB_XCNT(j)]); sum += c; cnt += (c > 0u) ? 1u : 0u; mine = (j == x) ? c : mine; }
        if (sum == G) break;
        __builtin_amdgcn_s_sleep(1);
        if ((++sp & 255u) == 0u) { if (xb_ld(&bar[XB_TMO])) break; if (sp > XB_SPIN_CAP) { atomicAdd(&bar[XB_TMO], 1u); break; } }
    }
    nloc = mine > 0u ? mine : 1u; nx = cnt > 0u ? cnt : 1u;
}

__device__ __forceinline__ void xcd_barrier(const XcdBarrier& b) {
    asm volatile("s_waitcnt vmcnt(0)" ::: "memory");
    __syncthreads();
    if (threadIdx.x == 0) {
        unsigned* bar = b.bar;
        __builtin_amdgcn_s_waitcnt(0);
        unsigned nloc = b.st[0], nx = b.st[1];
        if (nloc == 0u) { xcd_barrier_complete(bar, b.x, nloc, nx); b.st[0] = nloc; b.st[1] = nx; }
        const unsigned old = xb_add(&bar[XB_XSUB(b.x)], 1u);
        const unsigned gen = old / nloc;
        if (old + 1u == (gen + 1u) * nloc) {
            __builtin_amdgcn_fence(__ATOMIC_RELEASE, "agent");
            asm volatile("s_waitcnt vmcnt(0)" ::: "memory");
            const unsigned og = xb_add(&bar[XB_TOP], 1u);
            const unsigned tg = og / nx;
            if (og + 1u == (tg + 1u) * nx) xb_add(&bar[XB_TOPGEN], 1u);
            else XB_SPIN(xb_ld(&bar[XB_TOPGEN]) == tg, bar);
            __builtin_amdgcn_fence(__ATOMIC_ACQUIRE, "agent");
            xb_add(&bar[XB_XGEN(b.x)], 1u);
            asm volatile("s_waitcnt vmcnt(0)" ::: "memory");
        } else {
            XB_SPIN(xb_ld(&bar[XB_XGEN(b.x)]) == gen, bar);
            __builtin_amdgcn_fence(__ATOMIC_ACQUIRE, "agent");
            asm volatile("s_waitcnt vmcnt(0)" ::: "memory");
        }
    }
    __syncthreads();
}

constexpr size_t WS_CTL = 539 * MiB, CTL_BYTES = 16384;
constexpr int MISC_OFF = 131072 + 320;
struct Params { const float *x, *norm_w, *w_in, *qn, *kn, *ona, *onb, *w_out, *fnorm; float* out; unsigned char* ws; int ph_lo, ph_hi; };

__global__ void __launch_bounds__(512, 2) mk_fwd(Params p) {
    extern __shared__ __attribute__((aligned(16))) unsigned char lds[];
    volatile LAS unsigned* MISC = (volatile LAS unsigned*)((LAS unsigned char*)lds + MISC_OFF);
    if (threadIdx.x < 32) MISC[threadIdx.x] = 0u;
    __syncthreads();
    XcdBarrier bar = xcd_barrier_post((unsigned*)(p.ws + WS_CTL), MISC + 8);
    for (int ph = p.ph_lo; ph < p.ph_hi; ++ph) {
        const int tid = otid(), lane = tid & 63, wave = __builtin_amdgcn_readfirstlane(tid >> 6);
        int G = gridDim.x, bx = blockIdx.x; asm volatile("" : "+s"(G), "+s"(bx));
        const int vcu = (G % 8 == 0) ? (bx % 8) * (G / 8) + bx / 8 : bx;
        const int gw = vcu * 8 + wave, NGW = G * 8;
        size_t zoff = 0; asm volatile("" : "+s"(zoff));
        unsigned char* ws = p.ws + zoff;
        bf16_t* W1T = (bf16_t*)(ws + WS_W1T); bf16_t* W2T = (bf16_t*)(ws + WS_W2T); bf16_t* H = (bf16_t*)(ws + WS_H); bf16_t* PROJ = (bf16_t*)(ws + WS_PROJ);
        bf16_t* YA = (bf16_t*)(ws + WS_YA); bf16_t* YB = (bf16_t*)(ws + WS_YB); float* LSE = (float*)(ws + WS_LSE);
        float* RCOS = (float*)(ws + WS_ROPE); float* RSIN = RCOS + 192 * 32;
        bf16_t* XB = (bf16_t*)(ws + WS_XB); float* ROWSQ = (float*)(ws + WS_ROWSQ);
        if (ph == 0) {
            LAS float* scr = (LAS float*)((LAS unsigned char*)lds + wave * 16384);
            constexpr int I1 = (DM / 64) * (DIN / 32), I2 = (DM / 64) * (DM / 32), IL = I1 + I2;
            DUPREP(0) for (int it = gw; it < DEPTH * IL; it += NGW) {
                const int l = it / IL, r = it % IL;
                if (r < I1) p0_transpose_item(p.w_in + (size_t)l * DM * DIN, DM, DIN, W1T + (size_t)l * DIN * DM, scr, r, lane, p.norm_w + (size_t)l * DM);
                else p0_transpose_item(p.w_out + (size_t)l * DM * DM, DM, DM, W2T + (size_t)l * DM * DM, scr, r - I1, lane, nullptr);
            }
            for (int m = gw; m < M; m += NGW) {
                const f32x4* xr = (const f32x4*)(p.x + (size_t)m * DM) + lane; v2u* o8 = (v2u*)(XB + (size_t)m * DM) + lane; float sq = 0.f;
#pragma unroll
                for (int j = 0; j < 8; ++j) { const f32x4 v = xr[64 * j]; v2u w; w.x = pk2(v.x, v.y); w.y = pk2(v.z, v.w); o8[64 * j] = w;
                    const float r0 = bflo(w.x), r1 = bfhi(w.x), r2 = bflo(w.y), r3 = bfhi(w.y); sq += (r0 * r0 + r1 * r1) + (r2 * r2 + r3 * r3); }
                sq = wave_sum(sq); if (lane < 32) ROWSQ[(size_t)m * 32 + lane] = (lane == 0) ? sq : 0.f;
            }
            for (int i = gw * 64 + lane; i < 192 * 32; i += NGW * 64) {
                const int pos = i >> 5, f = i & 31; const float pv = (float)(pos < 128 ? pos : pos - 128);
                float s, c; sincos_acc(pv * INV_FREQ[f], s, c); RCOS[i] = c; RSIN[i] = s;
            }
        } else if (ph == N_PHASES - 1) {
            for (int m = gw; m < M; m += NGW) {
                f32x4* xr = (f32x4*)(p.out + (size_t)m * DM) + lane; const f32x4* wr_ = (const f32x4*)p.fnorm + lane; const v2u* xb8 = (const v2u*)(XB + (size_t)m * DM) + lane;
                const float rstd = 1.0f / sqrtf(wave_sum(lane < 32 ? ROWSQ[((size_t)DEPTH * M + m) * 32 + lane] : 0.f) * (1.0f / DM) + EPS);
#pragma unroll
                for (int j = 0; j < 8; ++j) { const v2u w = xb8[64 * j]; const f32x4 v = {bflo(w.x), bfhi(w.x), bflo(w.y), bfhi(w.y)}; xr[64 * j] = v * rstd * wr_[64 * j]; }
            }
        } else {
            const int l = (ph - 1) / 5, st = (ph - 1) % 5 + 1;
            if (st == 1) {
                pg8::Gemm g{XB, W1T + (size_t)l * DIN * DM, M, DIN, DM}; pg8::StaticOrder S; S.init(M, DIN, G, bx);
                pg8::EpiHeadMajor E{PROJ, M, ROWSQ + (size_t)l * M * 32, 1.0f / DM, EPS};
#ifndef MK_NO_G1
                DUPREP(2) pg8::gemm_phase<pg8::EpiHeadMajor, pg8::StaticOrder, PG8_ALIGN, PG8_SP2>((PG8_LAS unsigned char*)lds, g, S, E);
#endif
            } else if (st == 2) {
                const float* qg = p.qn + l * HD; const float* kg = p.kn + l * HD;
                for (int it = gw; it < M * 10 / 4; it += NGW) {
                    const int g = it * 4 + (lane >> 4), row = g / 10, hs = g - row * 10;
                    const int j = lane & 15, half = j >> 3, jj = j & 7, e = half * 64 + 4 * jj;
                    bf16_t* pp = PROJ + ((size_t)hs * M + row) * HD + e;
                    const v2u a = *(const v2u*)pp, b = *(const v2u*)(pp + 32);
                    float x1[4] = {bflo(a.x), bfhi(a.x), bflo(a.y), bfhi(a.y)}, x2[4] = {bflo(b.x), bfhi(b.x), bflo(b.y), bfhi(b.y)};
                    float ss = 0.f;
#pragma unroll
                    for (int i = 0; i < 4; ++i) ss += x1[i] * x1[i] + x2[i] * x2[i];
                    ss += __shfl_xor(ss, 1); ss += __shfl_xor(ss, 2); ss += __shfl_xor(ss, 4); ss += __shfl_xor(ss, 8);
                    const float rstd = 1.0f / sqrtf(ss * (1.0f / HD) + EPS);
                    const float* gn = (hs < 8) ? qg : kg;
                    const f32x4 g1 = *(const f32x4*)(gn + e), g2 = *(const f32x4*)(gn + e + 32);
                    const int t = row & (T - 1), pos = half ? 128 + (t & 63) : (t >> 6);
                    const f32x4 cs = *(const f32x4*)(RCOS + pos * 32 + 4 * jj), sn = *(const f32x4*)(RSIN + pos * 32 + 4 * jj);
                    float o1[4], o2[4];
#pragma unroll
                    for (int i = 0; i < 4; ++i) { const float y1 = x1[i] * rstd * g1[i], y2 = x2[i] * rstd * g2[i]; o1[i] = y1 * cs[i] - y2 * sn[i]; o2[i] = y1 * sn[i] + y2 * cs[i]; }
                    v2u w1, w2; w1.x = pk2(o1[0], o1[1]); w1.y = pk2(o1[2], o1[3]); w2.x = pk2(o2[0], o2[1]); w2.y = pk2(o2[2], o2[3]);
                    *(v2u*)pp = w1; *(v2u*)(pp + 32) = w2;
                }
#ifndef MK_NO_DIL
                DUPREP(3) for (int u = vcu; u < 1536; u += G) {
                    const int pt = u >> 9, rem = u & 511, b = rem >> 8, h = (rem >> 5) & 7, w = rem & 31;
                    const int d = (pt == 0) ? 1 : (pt == 1) ? 4 : 16, res = w & (d - 1), blk = w / d, i0 = blk * 256, nsub = T / d;
                    const float slope = __builtin_amdgcn_exp2f(-(float)(h + 1));
                    const float nslopeC = -slope * (float)d * att::LOG2E;
                    const size_t tok0 = (size_t)b * T + res;
                    const att::bf16* Pb = (const att::bf16*)PROJ + ((size_t)h * M + tok0) * HD;
                    const long rs = (long)d * HD;
                    att::attn_body<true>(Pb + (size_t)H_QB * M * HD + (long)i0 * rs, Pb + (size_t)H_KB * M * HD, Pb + (size_t)H_VB * M * HD, rs, rs,
                                         (att::bf16*)YB + ((size_t)pt * M + tok0 + (size_t)i0 * d) * DB + h * HD, (long)d * DB,
                                         LSE + ((size_t)pt * M + tok0 + (size_t)i0 * d) * 8 + h, d * 8, i0, nsub, nslopeC, 0, (char*)lds);
                }
#endif
            } else if (st == 3) {
#ifndef MK_NO_DENSE
                DUPREP(4) for (int u = vcu; u < 512; u += G) {
                    const int combo = u >> 7, b = combo >> 1, kvh = combo & 1, h = kvh * 4 + ((u >> 5) & 3), qb = u & 31;
                    const att::bf16* Pb = (const att::bf16*)PROJ + (size_t)b * T * HD;
                    att::attn_body<false>(Pb + ((size_t)(H_QA + h) * M + qb * 256) * HD, Pb + (size_t)(H_KA + kvh) * M * HD, Pb + (size_t)(H_VA + kvh) * M * HD, HD, HD,
                                          (att::bf16*)YA + ((size_t)b * T + qb * 256) * DA + h * HD, DA, nullptr, 0, 0, 0, 0.f, T, (char*)lds);
                }
#endif
            } else if (st == 4) {
                const float* wa = p.ona + (size_t)l * DA; const float* wb = p.onb + (size_t)l * DB;
                DUPREP(5) for (int m = gw; m < M; m += NGW) {
                    float ya[2][8], yb[2][8]; float ssa = 0.f, ssb = 0.f;
#pragma unroll
                    for (int j = 0; j < 2; ++j) { const int c = lane + 64 * j, hh = c >> 4;
                        const v4u a = *(const v4u*)(YA + (size_t)m * DA + 8 * c);
                        ya[j][0] = bflo(a.x); ya[j][1] = bfhi(a.x); ya[j][2] = bflo(a.y); ya[j][3] = bfhi(a.y); ya[j][4] = bflo(a.z); ya[j][5] = bfhi(a.z); ya[j][6] = bflo(a.w); ya[j][7] = bfhi(a.w);
                        const float l0 = LSE[((size_t)0 * M + m) * 8 + hh], l1 = LSE[((size_t)1 * M + m) * 8 + hh], l2 = LSE[((size_t)2 * M + m) * 8 + hh];
                        const float mx = fmaxf(l0, fmaxf(l1, l2)); const float e0 = __builtin_amdgcn_exp2f(l0 - mx), e1 = __builtin_amdgcn_exp2f(l1 - mx), e2 = __builtin_amdgcn_exp2f(l2 - mx);
                        const float inv = 1.0f / (e0 + e1 + e2); const float w0 = e0 * inv, w1 = e1 * inv, w2 = e2 * inv;
                        const v4u b0 = *(const v4u*)(YB + ((size_t)0 * M + m) * DB + 8 * c), b1 = *(const v4u*)(YB + ((size_t)1 * M + m) * DB + 8 * c), b2 = *(const v4u*)(YB + ((size_t)2 * M + m) * DB + 8 * c);
                        yb[j][0] = w0 * bflo(b0.x) + w1 * bflo(b1.x) + w2 * bflo(b2.x); yb[j][1] = w0 * bfhi(b0.x) + w1 * bfhi(b1.x) + w2 * bfhi(b2.x);
                        yb[j][2] = w0 * bflo(b0.y) + w1 * bflo(b1.y) + w2 * bflo(b2.y); yb[j][3] = w0 * bfhi(b0.y) + w1 * bfhi(b1.y) + w2 * bfhi(b2.y);
                        yb[j][4] = w0 * bflo(b0.z) + w1 * bflo(b1.z) + w2 * bflo(b2.z); yb[j][5] = w0 * bfhi(b0.z) + w1 * bfhi(b1.z) + w2 * bfhi(b2.z);
                        yb[j][6] = w0 * bflo(b0.w) + w1 * bflo(b1.w) + w2 * bflo(b2.w); yb[j][7] = w0 * bfhi(b0.w) + w1 * bfhi(b1.w) + w2 * bfhi(b2.w);
#pragma unroll
                        for (int i = 0; i < 8; ++i) { ssa += ya[j][i] * ya[j][i]; ssb += yb[j][i] * yb[j][i]; } }
                    const float ra = 1.0f / sqrtf(wave_sum(ssa) * (1.0f / DA) + EPS), rb = 1.0f / sqrtf(wave_sum(ssb) * (1.0f / DB) + EPS);
#pragma unroll
                    for (int j = 0; j < 2; ++j) { const int c = lane + 64 * j;
                        const v4u ga = *(const v4u*)(PROJ + ((size_t)(H_GA + (c >> 4)) * M + m) * HD + 8 * (c & 15)), gb = *(const v4u*)(PROJ + ((size_t)(H_GB + (c >> 4)) * M + m) * HD + 8 * (c & 15));
                        const float gaf[8] = {bflo(ga.x), bfhi(ga.x), bflo(ga.y), bfhi(ga.y), bflo(ga.z), bfhi(ga.z), bflo(ga.w), bfhi(ga.w)};
                        const float gbf[8] = {bflo(gb.x), bfhi(gb.x), bflo(gb.y), bfhi(gb.y), bflo(gb.z), bfhi(gb.z), bflo(gb.w), bfhi(gb.w)};
                        const f32x4 wa0 = *(const f32x4*)(wa + 8 * c), wa1 = *(const f32x4*)(wa + 8 * c + 4), wb0 = *(const f32x4*)(wb + 8 * c), wb1 = *(const f32x4*)(wb + 8 * c + 4);
                        float za[8], zb[8];
#pragma unroll
                        for (int i = 0; i < 8; ++i) { const float wai = i < 4 ? wa0[i & 3] : wa1[i & 3], wbi = i < 4 ? wb0[i & 3] : wb1[i & 3];
                            const float sa = gaf[i] / (1.0f + __expf(-gaf[i])), sb = gbf[i] / (1.0f + __expf(-gbf[i]));
                            za[i] = ya[j][i] * ra * wai * sa; zb[i] = yb[j][i] * rb * wbi * sb; }
                        v4u oa, ob; oa.x = pk2(za[0], za[1]); oa.y = pk2(za[2], za[3]); oa.z = pk2(za[4], za[5]); oa.w = pk2(za[6], za[7]);
                        ob.x = pk2(zb[0], zb[1]); ob.y = pk2(zb[2], zb[3]); ob.z = pk2(zb[4], zb[5]); ob.w = pk2(zb[6], zb[7]);
                        *(v4u*)(H + (size_t)m * DM + 8 * c) = oa; *(v4u*)(H + (size_t)m * DM + DA + 8 * c) = ob; }
                }
            } else {
                pg8::Gemm g{H, W2T + (size_t)l * DM * DM, M, DM, DM}; pg8::StaticOrder S; S.init(M, DM, G, bx);
                pg8::EpiResF32 E{XB, ROWSQ + (size_t)(l + 1) * M * 32, DM};
#ifndef MK_NO_G2
                pg8::gemm_phase<pg8::EpiResF32, pg8::StaticOrder, PG8_ALIGN, PG8_SP2>((PG8_LAS unsigned char*)lds, g, S, E);
#endif
            }
        }
        if (ph + 1 < p.ph_hi) { if (ph == 0) cg::this_grid().sync(); else xcd_barrier(bar); if (MK_DUP & 64) xcd_barrier(bar); }
    }
}

extern "C" void kernel_launch(void* const* d_in, const int* in_sizes, int n_in, void* d_out, int out_size, void* d_ws, size_t ws_size, hipStream_t stream) {
    static int grid = 0;
    if (grid == 0) {
        if (n_in != 9 || in_sizes[0] != M * DM || out_size != M * DM || ws_size < WS_END) { fprintf(stderr, "kernel_launch: unexpected shapes (n_in %d, ws %zu)\n", n_in, ws_size); grid = -1; return; }
        int dev = 0, cus = 0, per_cu = 0;
        hipGetDevice(&dev); hipDeviceGetAttribute(&cus, hipDeviceAttributeMultiprocessorCount, dev);
        if (hipFuncSetAttribute((const void*)mk_fwd, hipFuncAttributeMaxDynamicSharedMemorySize, LDS_BYTES) != hipSuccess) { fprintf(stderr, "kernel_launch: hipFuncSetAttribute failed\n"); grid = -1; return; }
        if (hipOccupancyMaxActiveBlocksPerMultiprocessor(&per_cu, (const void*)mk_fwd, 512, LDS_BYTES) != hipSuccess || per_cu < 1) per_cu = 1;
        (void)hipGetLastError();
        grid = cus * per_cu;
    }
    if (grid < 0) return;
    Params p{};
    p.x = (const float*)d_in[0]; p.norm_w = (const float*)d_in[1]; p.w_in = (const float*)d_in[2]; p.qn = (const float*)d_in[3]; p.kn = (const float*)d_in[4];
    p.ona = (const float*)d_in[5]; p.onb = (const float*)d_in[6]; p.w_out = (const float*)d_in[7]; p.fnorm = (const float*)d_in[8];
    p.out = (float*)d_out; p.ws = (unsigned char*)d_ws;
    if (hipMemsetAsync((char*)d_ws + WS_CTL, 0, CTL_BYTES, stream) != hipSuccess) { fprintf(stderr, "kernel_launch: memset failed\n"); return; }
#if MK_ONE_LAUNCH
    p.ph_lo = 0; p.ph_hi = N_PHASES;
    void* args[] = {&p};
    hipError_t e = hipLaunchCooperativeKernel((const void*)mk_fwd, dim3(grid), dim3(512), args, LDS_BYTES, stream);
    if (e != hipSuccess) fprintf(stderr, "kernel_launch: cooperative launch failed: %s (grid %d)\n", hipGetErrorString(e), grid);
#else
    for (int ph = 0; ph < N_PHASES; ++ph) { p.ph_lo = ph; p.ph_hi = ph + 1; hipLaunchKernelGGL(mk_fwd, dim3(grid), dim3(512), LDS_BYTES, stream, p); }
#endif
}
```

```cpp
#include <hip/hip_runtime.h>
#include <hip/hip_bf16.h>
#include <hip/hip_cooperative_groups.h>
#include <cstdio>
#include <cstdint>
namespace cg = cooperative_groups;

#ifndef MK_DUP
#define MK_DUP 0
#endif
#define DUPREP(k) for (int rep_ = 0; rep_ < 1 + ((MK_DUP >> (k)) & 1); ++rep_)
#ifndef MK_ONE_LAUNCH
#define MK_ONE_LAUNCH 1
#endif

constexpr int BATCH = 2, T = 8192, DM = 2048, DEPTH = 4, HD = 128, DA = 1024, DB = 1024, DIN = 6656, M = BATCH * T;
constexpr int C_QA = 0, C_KA = 1024, C_VA = 1280, C_GA = 1536, C_QB = 2560, C_KB = 3584, C_VB = 4608, C_GB = 5632;
constexpr int H_QA = 0, H_KA = 8, H_VA = 10, H_GA = 12, H_QB = 20, H_KB = 28, H_VB = 36, H_GB = 44;
constexpr float EPS = 1e-6f;
__device__ __forceinline__ int otid() { int t = threadIdx.x; asm volatile("" : "+v"(t)); return t; }

namespace pg8 {
#define PG8_LAS __attribute__((address_space(3)))
typedef unsigned short bf16_t;
typedef short bf16x8 __attribute__((ext_vector_type(8)));
typedef float f32x4 __attribute__((ext_vector_type(4)));
typedef unsigned u32x4 __attribute__((ext_vector_type(4)));
constexpr int BM = 256, BK = 64, HALF = 128, HTB = HALF * BK * 2  , STAGE_BYTES = 8 * HTB, NXCD = 8, WGM = 8;

__host__ __device__ __forceinline__ int lds_byte(int r, int c) { const int st = (r >> 4) * 2 + (c >> 5), rr = r & 15, cc = c & 31, ob = rr * 64 + cc * 2; return st * 1024 + (ob ^ (((ob >> 9) & 1) << 5)); }
__host__ __device__ __forceinline__ void stage_rc(int b, int& R, int& C) { const int st = b / 1024, sb = b % 1024, swz = sb ^ (((sb >> 9) & 1) << 5); R = (st >> 1) * 16 + swz / 64; C = (st & 1) * 32 + (swz % 64) / 2; }
__host__ __device__ __forceinline__ int perm32(int rho) { const int n = rho >> 4, i = rho & 15; return 8 * (i >> 2) + 4 * n + (i & 3); }

struct Unit { int pm, pn; };
struct Gemm { const bf16_t* A; const bf16_t* Bt; int M, N, K; };

struct StaticOrder {
    int nM, nN, nwg, G, c;
    __host__ __device__ void init(int M, int N, int G_, int c_) { nM = M / BM; nN = N / BM; nwg = nM * nN; G = G_; c = c_; }
    __host__ __device__ bool next(int i, Unit& u) const {
        const long L = (long)i * G + c; if (L >= nwg) return false;
        int wgid = (int)L; { const int q = nwg / NXCD, r = nwg % NXCD, xcd = wgid % NXCD, off = wgid / NXCD; wgid = (xcd < r ? xcd * (q + 1) : r * (q + 1) + (xcd - r) * q) + off; }
        const int nig = WGM * nN, gid = wgid / nig, fm = gid * WGM, gsz = (nM - fm) < WGM ? (nM - fm) : WGM;
        u.pm = fm + ((wgid % nig) % gsz); u.pn = (wgid % nig) / gsz; return true;
    }
    __device__ __forceinline__ void a_ready(const Unit&) const {}
    __device__ __forceinline__ void done(const Unit&) const {}
};

__device__ __forceinline__ unsigned cvt_pk_bf16(float lo, float hi) { unsigned r; asm volatile("v_cvt_pk_bf16_f32 %0, %1, %2" : "=v"(r) : "v"(lo), "v"(hi)); return r; }
typedef float f32x2 __attribute__((ext_vector_type(2)));
__device__ __forceinline__ f32x2 gelu_pk(f32x2 v) {
    const f32x2 av = __builtin_elementwise_abs(v), d = av * 0.2316418882f + 1.0f;
    f32x2 t; t.x = __builtin_amdgcn_rcpf(d.x); t.y = __builtin_amdgcn_rcpf(d.y);
    f32x2 q = t * 0.5307027145f + (-0.7265760135f); q = q * t + 0.7107068705f; q = q * t + (-0.142248368f); q = q * t + 0.127414796f; q = q * t;
    const f32x2 s = (v * v) * (-0.72134752044f);
    f32x2 e; e.x = __builtin_amdgcn_exp2f(s.x); e.y = __builtin_amdgcn_exp2f(s.y);
    const f32x2 m = v * (q * e), r = v - m;
    f32x2 o; o.x = v.x < 0.f ? m.x : r.x; o.y = v.y < 0.f ? m.y : r.y; return o;
}

template <int ACT  > struct EpiBf16 {
    static constexpr bool PERM = true, AFTER_DRAIN = false; static_assert(ACT == 0 || ACT == 1, "EpiBf16: ACT is 0 (none) or 1 (gelu_pk)");
    bf16_t* O; int ldc; const float* bias; int split_cols; size_t split_stride; float scale0;
    __device__ __forceinline__ void operator()(const f32x4 (&acc)[2][2][4][2], const Unit& u, int wr, int wc, int fr, int fq) const {
        const int row0 = u.pm * BM + wr * 64 + fr; int colt = u.pn * BM; bf16_t* base = O;
        float sc = 1.f; if (split_cols) { const int t = colt / split_cols; base += (size_t)t * split_stride; colt -= t * split_cols; if (t == 0) sc = scale0; }
        const int col0 = colt + wc * 32 + 8 * fq, bcol0 = u.pn * BM + wc * 32 + 8 * fq;
        f32x4 bv[2][2];
#pragma unroll
        for (int bj = 0; bj < 2; ++bj)
#pragma unroll
            for (int n = 0; n < 2; ++n) bv[bj][n] = bias ? *(const f32x4*)(bias + bcol0 + bj * HALF + 4 * n) : (f32x4){0.f, 0.f, 0.f, 0.f};
#pragma unroll
        for (int ai = 0; ai < 2; ++ai)
#pragma unroll
            for (int m = 0; m < 4; ++m) { bf16_t* rowp = base + (size_t)(row0 + ai * HALF + m * 16) * ldc + col0;
#pragma unroll
                for (int bj = 0; bj < 2; ++bj) { f32x4 v0 = acc[ai][bj][m][0] + bv[bj][0], v1 = acc[ai][bj][m][1] + bv[bj][1];
                    if (ACT == 1) { f32x2 a = gelu_pk((f32x2){v0[0], v0[1]}), b = gelu_pk((f32x2){v0[2], v0[3]}), c = gelu_pk((f32x2){v1[0], v1[1]}), d = gelu_pk((f32x2){v1[2], v1[3]});
                        v0 = (f32x4){a.x, a.y, b.x, b.y}; v1 = (f32x4){c.x, c.y, d.x, d.y}; }
                    v0 = v0 * sc; v1 = v1 * sc; u32x4 w; w.x = cvt_pk_bf16(v0[0], v0[1]); w.y = cvt_pk_bf16(v0[2], v0[3]); w.z = cvt_pk_bf16(v1[0], v1[1]); w.w = cvt_pk_bf16(v1[2], v1[3]);
                    *(u32x4*)(rowp + bj * HALF) = w; } }
    }
};
struct EpiHeadMajor {
    static constexpr bool PERM = true, AFTER_DRAIN = false;
    bf16_t* O; int Mrows; const float* rowsq; float inv_k, eps;
    __device__ __forceinline__ void operator()(const f32x4 (&acc)[2][2][4][2], const Unit& u, int wr, int wc, int fr, int fq) const {
        const int row0 = u.pm * BM + wr * 64 + fr, col0 = wc * 32 + 8 * fq;
#pragma unroll
        for (int ai = 0; ai < 2; ++ai) {
            f32x4 pa[4], pb[4];
#pragma unroll
            for (int m = 0; m < 4; ++m) { const f32x4* pp = (const f32x4*)(rowsq + (size_t)(row0 + ai * HALF + m * 16) * 32 + 8 * fq); pa[m] = pp[0]; pb[m] = pp[1]; }
#pragma unroll
            for (int m = 0; m < 4; ++m) { const int row = row0 + ai * HALF + m * 16; const f32x4 a = pa[m], b = pb[m];
                float sq = ((a[0] + a[1]) + (a[2] + a[3])) + ((b[0] + b[1]) + (b[2] + b[3])); sq += __shfl_xor(sq, 16); sq += __shfl_xor(sq, 32);
                const float rs = 1.0f / sqrtf(sq * inv_k + eps);
#pragma unroll
                for (int bj = 0; bj < 2; ++bj) { const f32x4 v0 = acc[ai][bj][m][0] * rs, v1 = acc[ai][bj][m][1] * rs;
                    u32x4 w; w.x = cvt_pk_bf16(v0[0], v0[1]); w.y = cvt_pk_bf16(v0[2], v0[3]); w.z = cvt_pk_bf16(v1[0], v1[1]); w.w = cvt_pk_bf16(v1[2], v1[3]);
                    *(u32x4*)(O + ((size_t)(u.pn * 2 + bj) * Mrows + row) * HALF + col0) = w; } }
            asm volatile("" ::: "memory"); }
    }
};
struct EpiResF32 {
    static constexpr bool PERM = true, AFTER_DRAIN = false;
    bf16_t* xb; float* rowsq; int ldc;
    __device__ __forceinline__ void operator()(const f32x4 (&acc)[2][2][4][2], const Unit& u, int wr, int wc, int fr, int fq) const {
        const int col0 = u.pn * BM + wc * 32 + 8 * fq;
#pragma unroll
        for (int ai = 0; ai < 2; ++ai) {
            u32x4 pre[4][2];
#pragma unroll
            for (int m = 0; m < 4; ++m) { const size_t off = (size_t)(u.pm * BM + ai * HALF + wr * 64 + m * 16 + fr) * ldc + col0;
#pragma unroll
                for (int bj = 0; bj < 2; ++bj) pre[m][bj] = *(const u32x4*)(xb + off + bj * HALF); }
            asm volatile("" ::: "memory");
#pragma unroll
            for (int m = 0; m < 4; ++m) { const int row = u.pm * BM + ai * HALF + wr * 64 + m * 16 + fr; const size_t off = (size_t)row * ldc + col0; float ss = 0.f;
#pragma unroll
                for (int bj = 0; bj < 2; ++bj) { const u32x4 pb = pre[m][bj]; const f32x4 a0 = acc[ai][bj][m][0], a1 = acc[ai][bj][m][1];
                    u32x4 w; w.x = cvt_pk_bf16(__uint_as_float(pb.x << 16) + a0[0], __uint_as_float(pb.x & 0xffff0000u) + a0[1]); w.y = cvt_pk_bf16(__uint_as_float(pb.y << 16) + a0[2], __uint_as_float(pb.y & 0xffff0000u) + a0[3]);
                    w.z = cvt_pk_bf16(__uint_as_float(pb.z << 16) + a1[0], __uint_as_float(pb.z & 0xffff0000u) + a1[1]); w.w = cvt_pk_bf16(__uint_as_float(pb.w << 16) + a1[2], __uint_as_float(pb.w & 0xffff0000u) + a1[3]);
#pragma unroll
                    for (int q = 0; q < 4; ++q) { const float r0 = __uint_as_float(w[q] << 16), r1 = __uint_as_float(w[q] & 0xffff0000u); ss += r0 * r0 + r1 * r1; }
                    *(u32x4*)(xb + off + bj * HALF) = w; }
                ss += __shfl_xor(ss, 16); ss += __shfl_xor(ss, 32);
                if (fq == 0) rowsq[(size_t)row * 32 + u.pn * 4 + wc] = ss; }
            asm volatile("" ::: "memory"); }
    }
};


template <class Epi, class Sched, bool ALIGN_EPI = false, bool SP2 = false>
__device__ __forceinline__ void gemm_phase(PG8_LAS unsigned char* lds, const Gemm g, const Sched& S, const Epi& E) {
    const int tid = otid(), wid = __builtin_amdgcn_readfirstlane(tid >> 6), lane = tid & 63, wr = wid >> 2, wc = wid & 3, fr = lane & 15, fq = lane >> 4;
    const int K = g.K, nt = K / BK;
    unsigned voffA[2], voffB[2];
#pragma unroll
    for (int i = 0; i < 2; ++i) { int R, C; stage_rc(tid * 16 + i * 8192, R, C); const int Rb = Epi::PERM ? ((R & ~31) + perm32(R & 31)) : R;
        voffA[i] = (unsigned)(R * K + C) * 2u; voffB[i] = (unsigned)(Rb * K + C) * 2u; }
    const size_t kstep = (size_t)(BK * 2);
    const size_t hstep = (size_t)HALF * K * 2;
    const size_t tstep = 2 * hstep;
    const unsigned ldsw = (unsigned)wid * 1024u;
    const int aoff = lds_byte(wr * 64 + fr, fq * 8), boff = lds_byte(wc * 32 + fr, fq * 8);
#define PG8_SA(b, h) (((b) * 2 + (h)) * HTB)
#define PG8_SB(b, h) ((4 + (b) * 2 + (h)) * HTB)
#define PG8_STAGE(bufoff, gbase, voff) do { _Pragma("unroll") for (int _i = 0; _i < 2; ++_i) \
        __builtin_amdgcn_global_load_lds((const unsigned*)((const char*)(gbase) + (voff)[_i]), (PG8_LAS unsigned*)(lds + (bufoff) + ldsw + _i * 8192), 16, 0, 0); } while (0)
#define PG8_LDA(dst, b, h) do { _Pragma("unroll") for (int m = 0; m < 4; ++m) _Pragma("unroll") for (int k = 0; k < 2; ++k) dst[m][k] = *(const PG8_LAS bf16x8*)(lds + PG8_SA(b, h) + aoff + m * 2048 + k * 1024); } while (0)
#define PG8_LDB(dst, b, h) do { _Pragma("unroll") for (int n = 0; n < 2; ++n) _Pragma("unroll") for (int k = 0; k < 2; ++k) dst[n][k] = *(const PG8_LAS bf16x8*)(lds + PG8_SB(b, h) + boff + n * 2048 + k * 1024); } while (0)
#define PG8_MMA(ai, bj, At, Bt) do { __builtin_amdgcn_s_setprio(1); _Pragma("unroll") for (int m = 0; m < 4; ++m) _Pragma("unroll") for (int n = 0; n < 2; ++n) _Pragma("unroll") for (int k = 0; k < 2; ++k) \
        acc[ai][bj][m][n] = __builtin_amdgcn_mfma_f32_16x16x32_bf16(Bt[n][k], At[m][k], acc[ai][bj][m][n], 0, 0, 0); __builtin_amdgcn_s_setprio(0); } while (0)
#define PG8_WAIT_V(n) asm volatile("s_waitcnt vmcnt(" #n ")" ::: "memory")
#define PG8_WAIT_L(n) asm volatile("s_waitcnt lgkmcnt(" #n ")" ::: "memory")
#define PG8_BAR __builtin_amdgcn_s_barrier()
#define PG8_SCHED __builtin_amdgcn_sched_barrier(0)
    Unit cur, nxt; int ui = 0;
    if (!S.next(0, cur)) return;
    f32x4 acc[2][2][4][2];
#pragma unroll
    for (int a = 0; a < 2; ++a)
#pragma unroll
        for (int b = 0; b < 2; ++b)
#pragma unroll
            for (int m = 0; m < 4; ++m)
#pragma unroll
                for (int n = 0; n < 2; ++n) acc[a][b][m][n] = (f32x4){0.f, 0.f, 0.f, 0.f};
    bf16x8 At[4][2], B0[2][2], B1[2][2];
    const char* cA = (const char*)g.A + (size_t)cur.pm * tstep; const char* cB = (const char*)g.Bt + (size_t)cur.pn * tstep;
    S.a_ready(cur);
    if constexpr (SP2) {
        PG8_STAGE(PG8_SB(0, 0), cB, voffB); PG8_STAGE(PG8_SB(0, 1), cB + hstep, voffB); PG8_STAGE(PG8_SA(0, 0), cA, voffA); PG8_STAGE(PG8_SA(0, 1), cA + hstep, voffA);
        if (wr == 1) PG8_BAR;
        PG8_WAIT_V(2); PG8_BAR;
        PG8_STAGE(PG8_SB(1, 0), cB + kstep, voffB); PG8_STAGE(PG8_SA(1, 0), cA + kstep, voffA); PG8_STAGE(PG8_SB(1, 1), cB + hstep + kstep, voffB);
        PG8_WAIT_V(6); PG8_BAR;
    } else {
        PG8_STAGE(PG8_SB(0, 0), cB, voffB); PG8_STAGE(PG8_SA(0, 0), cA, voffA); PG8_STAGE(PG8_SB(0, 1), cB + hstep, voffB); PG8_STAGE(PG8_SA(0, 1), cA + hstep, voffA);
        if (wr == 1) PG8_BAR;
        PG8_WAIT_V(4); PG8_BAR;
        PG8_STAGE(PG8_SB(1, 0), cB + kstep, voffB); PG8_STAGE(PG8_SA(1, 0), cA + kstep, voffA); PG8_STAGE(PG8_SB(1, 1), cB + hstep + kstep, voffB);
        PG8_WAIT_V(6); PG8_BAR;
    }
    for (;;) {
        const bool has_next = S.next(ui + 1, nxt);
        const char* nA = has_next ? (const char*)g.A + (size_t)nxt.pm * tstep : cA; const char* nB = has_next ? (const char*)g.Bt + (size_t)nxt.pn * tstep : cB;
        for (int t = 0; t < nt; t += 2) {
            const bool last = (t == nt - 2);
            const char* a1 = cA + (size_t)(t + 1) * kstep;
            const char* a2 = last ? nA : cA + (size_t)(t + 2) * kstep; const char* b2 = last ? nB : cB + (size_t)(t + 2) * kstep;
            const char* a3 = a2 + kstep; const char* b3 = b2 + kstep;
            if (last && has_next) S.a_ready(nxt);
            if constexpr (SP2) {
            PG8_LDB(B0, 0, 0); PG8_LDB(B1, 0, 1); PG8_SCHED; PG8_LDA(At, 0, 0); PG8_STAGE(PG8_SA(1, 1), a1 + hstep, voffA);
            PG8_WAIT_V(8); PG8_WAIT_L(0); PG8_BAR; PG8_MMA(0, 0, At, B0); PG8_MMA(0, 1, At, B1); PG8_BAR; PG8_SCHED;
            PG8_LDA(At, 0, 1); PG8_STAGE(PG8_SB(0, 0), b2, voffB); PG8_STAGE(PG8_SB(0, 1), b2 + hstep, voffB); PG8_STAGE(PG8_SA(0, 0), a2, voffA);
            PG8_WAIT_V(8); PG8_WAIT_L(0); PG8_BAR; PG8_MMA(1, 0, At, B0); PG8_MMA(1, 1, At, B1); PG8_BAR; PG8_SCHED;
            PG8_LDB(B0, 1, 0); PG8_LDB(B1, 1, 1); PG8_SCHED; PG8_LDA(At, 1, 0); PG8_STAGE(PG8_SA(0, 1), a2 + hstep, voffA);
            PG8_WAIT_V(8); PG8_WAIT_L(0); PG8_BAR; PG8_MMA(0, 0, At, B0); PG8_MMA(0, 1, At, B1); PG8_BAR; PG8_SCHED;
            PG8_LDA(At, 1, 1); PG8_STAGE(PG8_SB(1, 0), b3, voffB); PG8_STAGE(PG8_SB(1, 1), b3 + hstep, voffB); PG8_STAGE(PG8_SA(1, 0), a3, voffA);
            PG8_WAIT_V(8); PG8_WAIT_L(0); PG8_BAR; PG8_MMA(1, 0, At, B0); PG8_MMA(1, 1, At, B1); PG8_BAR; PG8_SCHED;
            } else {
            PG8_LDB(B0, 0, 0); PG8_SCHED; PG8_LDA(At, 0, 0); PG8_STAGE(PG8_SA(1, 1), a1 + hstep, voffA);
            PG8_WAIT_L(8); PG8_BAR; PG8_WAIT_L(0); PG8_MMA(0, 0, At, B0); PG8_BAR; PG8_SCHED;
            PG8_LDB(B1, 0, 1); PG8_STAGE(PG8_SB(0, 0), b2, voffB);
            PG8_BAR; PG8_WAIT_L(0); PG8_MMA(0, 1, At, B1); PG8_BAR;
            PG8_LDA(At, 0, 1); PG8_STAGE(PG8_SA(0, 0), a2, voffA);
            PG8_BAR; PG8_WAIT_L(0); PG8_MMA(1, 0, At, B0); PG8_BAR; PG8_SCHED;
            PG8_STAGE(PG8_SB(0, 1), b2 + hstep, voffB);
            PG8_WAIT_V(6); PG8_BAR; PG8_MMA(1, 1, At, B1); PG8_BAR;
            PG8_LDB(B0, 1, 0); PG8_SCHED; PG8_LDA(At, 1, 0); PG8_STAGE(PG8_SA(0, 1), a2 + hstep, voffA);
            PG8_WAIT_L(8); PG8_BAR; PG8_WAIT_L(0); PG8_MMA(0, 0, At, B0); PG8_BAR; PG8_SCHED;
            PG8_LDB(B1, 1, 1); PG8_STAGE(PG8_SB(1, 0), b3, voffB);
            PG8_BAR; PG8_WAIT_L(0); PG8_MMA(0, 1, At, B1); PG8_BAR;
            PG8_LDA(At, 1, 1); PG8_STAGE(PG8_SA(1, 0), a3, voffA);
            PG8_BAR; PG8_WAIT_L(0); PG8_MMA(1, 0, At, B0); PG8_BAR; PG8_SCHED;
            PG8_STAGE(PG8_SB(1, 1), b3 + hstep, voffB);
            PG8_WAIT_V(6); PG8_BAR; PG8_MMA(1, 1, At, B1); PG8_BAR;
            }
        }
        if constexpr (ALIGN_EPI) { if (wr == 0) PG8_BAR; }
        if constexpr (!Epi::AFTER_DRAIN) { E(acc, cur, wr, wc, fr, fq); S.done(cur); }
        if (!has_next) break;
#pragma unroll
        for (int a = 0; a < 2; ++a)
#pragma unroll
            for (int b = 0; b < 2; ++b)
#pragma unroll
                for (int m = 0; m < 4; ++m)
#pragma unroll
                    for (int n = 0; n < 2; ++n) acc[a][b][m][n] = (f32x4){0.f, 0.f, 0.f, 0.f};
        cur = nxt; cA = nA; cB = nB; ++ui;
        if constexpr (ALIGN_EPI) { if (wr == 1) PG8_BAR; }
    }
    PG8_WAIT_V(0);
    if constexpr (!ALIGN_EPI) { if (wr == 0) PG8_BAR; }
    PG8_BAR;
    if constexpr (Epi::AFTER_DRAIN) { E.fused(acc, cur, wr, wc, fr, fq, lds, wid, lane); S.done(cur); }
#undef PG8_SA
#undef PG8_SB
#undef PG8_STAGE
#undef PG8_LDA
#undef PG8_LDB
#undef PG8_MMA
#undef PG8_WAIT_V
#undef PG8_WAIT_L
#undef PG8_BAR
#undef PG8_SCHED
}
}
#define PG8_SP2 true
#define PG8_ALIGN true
namespace att {
using bf16 = __hip_bfloat16;
constexpr int D = 128, NW = 8, QBLK = 32, KVBLK = 64;
constexpr float SCALE = 0.088388347648318440f;
constexpr float THR = 8.f;
constexpr size_t SHM_V = KVBLK * D * 2, SHM_K = KVBLK * D * 2, SHM_ATTN = 2 * SHM_V + 2 * SHM_K + NW * 64 * 4;
using bf16x8 = __attribute__((ext_vector_type(8))) short;
using s16x4  = __attribute__((ext_vector_type(4))) short;
using f32x16 = __attribute__((ext_vector_type(16))) float;
using f32x8  = __attribute__((ext_vector_type(8))) float;
using u32x4  = __attribute__((ext_vector_type(4))) unsigned;
#define KSWZ(row, colB) ((row) * 256 + ((colB) ^ (((row) & 7) << 4)))
#define SBAR() __builtin_amdgcn_sched_barrier(0)
__device__ __forceinline__ int crow(int r, int hi) { return (r & 3) + 8 * (r >> 2) + 4 * hi; }
__device__ __forceinline__ unsigned cvtpk(float lo, float hi) {
  unsigned r; asm volatile("v_cvt_pk_bf16_f32 %0, %1, %2" : "=v"(r) : "v"(lo), "v"(hi)); return r;
}
template <typename TIn> struct Stage;
template <> struct Stage<bf16>  { using T = bf16x8;
  __device__ static __forceinline__ T ld8(const bf16* p) { return *reinterpret_cast<const bf16x8*>(p); }
  __device__ static __forceinline__ bf16x8 tobf(T x) { return x; } };
template <> struct Stage<float> { using T = f32x8;
  __device__ static __forceinline__ T ld8(const float* p) { return *reinterpret_cast<const f32x8*>(p); }
  __device__ static __forceinline__ bf16x8 tobf(T x) {
    u32x4 w = {cvtpk(x[0], x[1]), cvtpk(x[2], x[3]), cvtpk(x[4], x[5]), cvtpk(x[6], x[7])}; return *reinterpret_cast<bf16x8*>(&w); } };

__device__ __forceinline__ void partialSM(f32x16& p0, f32x16& p1, float& m_reg, float& mn, float& alpha) {
  constexpr float C = SCALE * 1.4426950408889634f;
  float pmax = p0[0]; for (int r = 1; r < 16; ++r) pmax = fmaxf(pmax, p0[r]); for (int r = 0; r < 16; ++r) pmax = fmaxf(pmax, p1[r]);
  { auto rr = __builtin_amdgcn_permlane32_swap(__float_as_uint(pmax), __float_as_uint(pmax), false, false);
    pmax = fmaxf(__uint_as_float(rr[0]), __uint_as_float(rr[1])); }
  if (__builtin_expect(__all(pmax - m_reg <= THR / SCALE), 1)) { mn = m_reg; alpha = 1.f; }
  else { mn = fmaxf(m_reg, pmax); alpha = __builtin_amdgcn_exp2f((m_reg - mn) * C); m_reg = mn; }
  float mnC = -mn * C;
  for (int r = 0; r < 16; ++r) p0[r] = fmaf(p0[r], C, mnC); for (int r = 0; r < 16; ++r) p1[r] = fmaf(p1[r], C, mnC);
  for (int r = 0; r < 16; ++r) p0[r] = __builtin_amdgcn_exp2f(p0[r]);
}
__device__ __forceinline__ void finishSM(f32x16& p0, f32x16& p1, float alpha, float& l_reg, bf16x8& pa0, bf16x8& pa1, bf16x8& pa2, bf16x8& pa3) {
  for (int r = 0; r < 16; ++r) p1[r] = __builtin_amdgcn_exp2f(p1[r]);
  float ps = 0; for (int r = 0; r < 16; ++r) ps += p0[r]; for (int r = 0; r < 16; ++r) ps += p1[r];
  { auto rr = __builtin_amdgcn_permlane32_swap(__float_as_uint(ps), __float_as_uint(ps), false, false);
    ps = __uint_as_float(rr[0]) + __uint_as_float(rr[1]); }
  l_reg = l_reg * alpha + ps;
#define PK4(P, BASE, OUT) do { unsigned a0 = cvtpk(P[BASE + 0], P[BASE + 1]), a1 = cvtpk(P[BASE + 2], P[BASE + 3]);   \
    unsigned b0 = cvtpk(P[BASE + 4], P[BASE + 5]), b1 = cvtpk(P[BASE + 6], P[BASE + 7]);                              \
    auto r0 = __builtin_amdgcn_permlane32_swap(a0, b0, false, false); auto r1 = __builtin_amdgcn_permlane32_swap(a1, b1, false, false); \
    u32x4 w = {r0[0], r1[0], r0[1], r1[1]}; OUT = *reinterpret_cast<bf16x8*>(&w); } while (0)
  PK4(p0, 0, pa0); PK4(p0, 8, pa1); PK4(p1, 0, pa2); PK4(p1, 8, pa3);
#undef PK4
}
__device__ __forceinline__ void qkt(f32x16& p0, f32x16& p1, const bf16* Ks, const bf16x8* qr, int r32, int hi) {
  p0 = f32x16{}; p1 = f32x16{};
  for (int d0 = 0; d0 < 8; ++d0) { int cb = (d0 * 16 + hi * 8) * 2;
    bf16x8 b0 = *reinterpret_cast<const bf16x8*>((const char*)Ks + KSWZ(r32, cb));
    bf16x8 b1 = *reinterpret_cast<const bf16x8*>((const char*)Ks + KSWZ(32 + r32, cb));
    p0 = __builtin_amdgcn_mfma_f32_32x32x16_bf16(b0, qr[d0], p0, 0, 0, 0);
    p1 = __builtin_amdgcn_mfma_f32_32x32x16_bf16(b1, qr[d0], p1, 0, 0, 0); }
}
__device__ __forceinline__ int v_st(int k, int c) { const int kk = (k & ~0xC) | ((k & 4) << 1) | ((k & 8) >> 1); return ((kk >> 3) * 4 + (c >> 5)) * 512 + ((kk & 7) * 32 + (c & 31)) * 2; }
__device__ __forceinline__ int v_rd_base(int lane) { return ((lane & 3) << 3) | (((lane >> 2) & 3) << 6) | (((lane >> 4) & 1) << 5) | (((lane >> 5) & 1) << 8); }
constexpr int v_rd_off(int d0, int ks, int half) { return d0 * 512 + ks * 4096 + half * 2048; }
template <int OFF> __device__ __forceinline__ s16x4 tr_read(int vb) {
  s16x4 r; asm volatile("ds_read_b64_tr_b16 %0, %1 offset:%2" : "=&v"(r) : "v"(vb), "i"(OFF) : "memory"); return r;
}
template <int D0> __device__ __forceinline__ void pv_one(f32x16& od, int vb, bf16x8 pa0, bf16x8 pa1, bf16x8 pa2, bf16x8 pa3) {
  const s16x4 l0 = tr_read<v_rd_off(D0, 0, 0)>(vb), h0 = tr_read<v_rd_off(D0, 0, 1)>(vb), l1 = tr_read<v_rd_off(D0, 1, 0)>(vb), h1 = tr_read<v_rd_off(D0, 1, 1)>(vb);
  const s16x4 l2 = tr_read<v_rd_off(D0, 2, 0)>(vb), h2 = tr_read<v_rd_off(D0, 2, 1)>(vb), l3 = tr_read<v_rd_off(D0, 3, 0)>(vb), h3 = tr_read<v_rd_off(D0, 3, 1)>(vb);
  asm volatile("s_waitcnt lgkmcnt(0)" ::: "memory"); SBAR();
#define PK(L, H) (bf16x8){L[0], L[1], L[2], L[3], H[0], H[1], H[2], H[3]}
  od = __builtin_amdgcn_mfma_f32_32x32x16_bf16(pa0, PK(l0, h0), od, 0, 0, 0);
  od = __builtin_amdgcn_mfma_f32_32x32x16_bf16(pa1, PK(l1, h1), od, 0, 0, 0);
  od = __builtin_amdgcn_mfma_f32_32x32x16_bf16(pa2, PK(l2, h2), od, 0, 0, 0);
  od = __builtin_amdgcn_mfma_f32_32x32x16_bf16(pa3, PK(l3, h3), od, 0, 0, 0);
#undef PK
}
__device__ __forceinline__ void pv_d0(f32x16* o, int vb, bf16x8 pa0, bf16x8 pa1, bf16x8 pa2, bf16x8 pa3) {
  pv_one<0>(o[0], vb, pa0, pa1, pa2, pa3); pv_one<1>(o[1], vb, pa0, pa1, pa2, pa3); pv_one<2>(o[2], vb, pa0, pa1, pa2, pa3); pv_one<3>(o[3], vb, pa0, pa1, pa2, pa3);
}
constexpr int crow0(int r) { return (r & 3) + 8 * (r >> 2); }
constexpr float LOG2E = 1.4426950408889634f;
__device__ __forceinline__ void partialSM_dil(f32x16& p0, f32x16& p1, float& m_reg, float& mn, float& alpha, float dq, float dlo, float dhi, float nslopeC) {
  constexpr float C = SCALE * LOG2E;
#pragma unroll
  for (int r = 0; r < 16; ++r) {
    const float d0 = dq + (float)crow0(r), d1 = d0 + 32.f;
    const float t0 = fmaf(p0[r], C, nslopeC * fabsf(d0)), t1 = fmaf(p1[r], C, nslopeC * fabsf(d1));
    p0[r] = (d0 >= dlo && d0 <= dhi) ? t0 : -1e30f;
    p1[r] = (d1 >= dlo && d1 <= dhi) ? t1 : -1e30f;
  }
  float pmax = p0[0];
#pragma unroll
  for (int r = 1; r < 16; ++r) pmax = fmaxf(pmax, p0[r]);
#pragma unroll
  for (int r = 0; r < 16; ++r) pmax = fmaxf(pmax, p1[r]);
  { auto rr = __builtin_amdgcn_permlane32_swap(__float_as_uint(pmax), __float_as_uint(pmax), false, false);
    pmax = fmaxf(__uint_as_float(rr[0]), __uint_as_float(rr[1])); }
  if (__builtin_expect(__all(pmax - m_reg <= THR * LOG2E), 1)) { mn = m_reg; alpha = 1.f; }
  else { mn = fmaxf(m_reg, pmax); alpha = __builtin_amdgcn_exp2f(m_reg - mn); m_reg = mn; }
#pragma unroll
  for (int r = 0; r < 16; ++r) { p0[r] = p0[r] - mn; p1[r] = p1[r] - mn; }
#pragma unroll
  for (int r = 0; r < 16; ++r) p0[r] = __builtin_amdgcn_exp2f(p0[r]);
}

template <bool DIL>
__device__ __forceinline__ void attn_body(const bf16* __restrict__ Qb, const bf16* __restrict__ Kh, const bf16* __restrict__ Vh, long qs, long ks,
                                          bf16* __restrict__ Ob, long os, float* __restrict__ lse_o, int lse_s, int i0, int nsub, float nslopeC, int seq, char* lds) {
  typedef __attribute__((address_space(3))) unsigned lds_u32;
  using St = Stage<bf16>;
  const int tid = otid(), wid = __builtin_amdgcn_readfirstlane(tid >> 6), lane = tid & 63, r32 = lane & 31, hi = lane >> 5;
  char* V_lds = lds + 4 * SHM_K; char* K_lds = lds;
  float* ws = (float*)(lds + 4 * SHM_K + 4 * SHM_V) + wid * 64; float* li_l = ws; float* al_l = ws + 32;
  float m_reg = -1e30f, l_reg = 0; f32x16 o[4] = {}; bf16x8 qr[8];
  const bf16* Qw = Qb + (long)(wid * QBLK + r32) * qs + hi * 8;
#pragma unroll
  for (int d0 = 0; d0 < 8; ++d0) qr[d0] = St::ld8(Qw + d0 * 16);
  const int vb0 = (int)(uintptr_t)V_lds + v_rd_base(lane);
  const int kb = DIL ? i0 - 64 : 0;
#define KROW(k) (DIL ? (long)min(max(kb + (k), 0), nsub - 1) : (long)(k))
  int krow[2], kcol[2], vrow[2], vcol[2];
#pragma unroll
  for (int i = 0; i < 2; ++i) { const int pc = 2 * wid + i;
    krow[i] = pc * 4 + (lane >> 4); kcol[i] = (((lane & 15) ^ (krow[i] & 7)) << 3);
    const int sub = pc * 2 + (lane >> 5), kk = ((sub >> 2) << 3) + ((lane & 31) >> 2);
    vrow[i] = (kk & ~0xC) | ((kk & 4) << 1) | ((kk & 8) >> 1); vcol[i] = ((sub & 3) << 5) + ((lane & 3) << 3); }
#define DMA(t, buf) do { _Pragma("unroll") for (int i_ = 0; i_ < 2; ++i_) { \
      __builtin_amdgcn_global_load_lds((const unsigned*)(Kh + KROW((t) * KVBLK + krow[i_]) * ks + kcol[i_]), (lds_u32*)(K_lds + (buf) * SHM_K + (2 * wid + i_) * 1024), 16, 0, 0); \
      __builtin_amdgcn_global_load_lds((const unsigned*)(Vh + KROW((t) * KVBLK + vrow[i_]) * ks + vcol[i_]), (lds_u32*)(V_lds + (buf) * SHM_V + (2 * wid + i_) * 1024), 16, 0, 0); } } while (0)
#define ENDSTEP(j) do { if ((j) + 2 < NT) asm volatile("s_waitcnt vmcnt(4) lgkmcnt(0)\n\ts_barrier" ::: "memory"); else asm volatile("s_waitcnt vmcnt(0) lgkmcnt(0)\n\ts_barrier" ::: "memory"); } while (0)
#define RESC(a) do { if (__any((a) < 1.f)) { if (hi == 0) al_l[r32] = (a); asm volatile("s_waitcnt lgkmcnt(0)" ::: "memory"); \
    for (int d = 0; d < 4; ++d) for (int r = 0; r < 16; ++r) o[d][r] *= al_l[crow(r, hi)]; } } while (0)
#define PSM(P0, P1, MN, AL, jt) do { if constexpr (DIL) { const int t_ = otid(), iq_ = (t_ >> 6) * QBLK + (t_ & 31), hi_ = (t_ >> 5) & 1; \
      partialSM_dil(P0, P1, m_reg, MN, AL, (float)(-64 - iq_ + 4 * hi_ + 64 * (jt)), fmaxf(-64.f, (float)(-(i0 + iq_))), fminf(64.f, (float)(nsub - 1 - (i0 + iq_))), nslopeC); } \
    else partialSM(P0, P1, m_reg, MN, AL); } while (0)
#define KBUF(j) ((const bf16*)(K_lds + ((j) & 3) * SHM_K))
#define VBUF(j) (vb0 + ((j) & 3) * (int)SHM_V)
  f32x16 pA0, pA1, pB0, pB1; float mnA, mnB, alA, alB; bf16x8 pa0, pa1, pa2, pa3; const int NT = DIL ? 6 : seq / KVBLK;
  DMA(0, 0); DMA(1, 1);
  asm volatile("s_waitcnt vmcnt(4)\n\ts_barrier" ::: "memory");
  if constexpr (DIL) {
    const int rlo = wid >> 1;
    for (int j = 0; j < NT; ++j) {
      if (j + 2 < NT) DMA(j + 2, (j + 2) & 3);
      if (j >= rlo && j <= rlo + 2) {
        SBAR(); qkt(pA0, pA1, KBUF(j), qr, r32, hi);
        PSM(pA0, pA1, mnA, alA, j); RESC(alA);
        finishSM(pA0, pA1, alA, l_reg, pa0, pa1, pa2, pa3); SBAR();
        pv_d0(o, VBUF(j), pa0, pa1, pa2, pa3);
      }
      if (j + 1 < NT) ENDSTEP(j);
    }
  } else {
  if (2 < NT) DMA(2, 2);
  qkt(pA0, pA1, KBUF(0), qr, r32, hi); PSM(pA0, pA1, mnA, alA, 0);
  ENDSTEP(0);
  for (int j = 1; j + 1 < NT; j += 2) {
    if (j + 2 < NT) DMA(j + 2, (j + 2) & 3);
    SBAR(); qkt(pB0, pB1, KBUF(j), qr, r32, hi);
    finishSM(pA0, pA1, alA, l_reg, pa0, pa1, pa2, pa3); SBAR();
    pv_d0(o, VBUF(j - 1), pa0, pa1, pa2, pa3); PSM(pB0, pB1, mnB, alB, j);
    RESC(alB); ENDSTEP(j);
    if (j + 3 < NT) DMA(j + 3, (j + 3) & 3);
    SBAR(); qkt(pA0, pA1, KBUF(j + 1), qr, r32, hi);
    finishSM(pB0, pB1, alB, l_reg, pa0, pa1, pa2, pa3); SBAR();
    pv_d0(o, VBUF(j), pa0, pa1, pa2, pa3); PSM(pA0, pA1, mnA, alA, j + 1);
    RESC(alA); ENDSTEP(j + 1);
  }
  SBAR(); qkt(pB0, pB1, KBUF(NT - 1), qr, r32, hi);
  finishSM(pA0, pA1, alA, l_reg, pa0, pa1, pa2, pa3); SBAR();
  pv_d0(o, VBUF(NT - 2), pa0, pa1, pa2, pa3); PSM(pB0, pB1, mnB, alB, NT - 1);
  RESC(alB);
  finishSM(pB0, pB1, alB, l_reg, pa0, pa1, pa2, pa3); SBAR();
  pv_d0(o, VBUF(NT - 1), pa0, pa1, pa2, pa3);
  }
  if (hi == 0) li_l[r32] = l_reg; asm volatile("s_waitcnt lgkmcnt(0)" ::: "memory");
  if constexpr (DIL) { if (hi == 0) lse_o[(long)(wid * QBLK + r32) * lse_s] = m_reg + __log2f(l_reg); }
  float rli[16];
#pragma unroll
  for (int r = 0; r < 16; ++r) rli[r] = __builtin_amdgcn_rcpf(li_l[crow(r, hi)]);
  bf16* Ow = Ob + (long)(wid * QBLK) * os;
#pragma unroll
  for (int r = 0; r < 16; ++r) { const int orow = crow(r, hi);
#pragma unroll
    for (int d0 = 0; d0 < 4; ++d0) Ow[(long)orow * os + d0 * 32 + r32] = __float2bfloat16(o[d0][r] * rli[r]); }
  asm volatile("s_waitcnt lgkmcnt(0)\n\ts_barrier" ::: "memory");
#undef KROW
#undef DMA
#undef ENDSTEP
#undef RESC
#undef PSM
#undef KBUF
#undef VBUF
}
}

#define GAS __attribute__((address_space(1)))
#define LAS __attribute__((address_space(3)))
typedef unsigned short bf16_t;
typedef unsigned v4u __attribute__((ext_vector_type(4)));
typedef unsigned v2u __attribute__((ext_vector_type(2)));
typedef float f32x4 __attribute__((ext_vector_type(4)));
#define LDS_WAIT() asm volatile("s_waitcnt lgkmcnt(0)" ::: "memory")

constexpr size_t MiB = 1u << 20;
constexpr size_t WS_W1T = 0;
constexpr size_t WS_W2T = 104 * MiB;
constexpr size_t WS_H = 136 * MiB;
constexpr size_t WS_PROJ = 200 * MiB;
constexpr size_t WS_YA = 408 * MiB;
constexpr size_t WS_YB = 440 * MiB;
constexpr size_t WS_LSE = 536 * MiB;
constexpr size_t WS_ROPE = 538 * MiB;
constexpr size_t WS_XB = 540 * MiB;
constexpr size_t WS_ROWSQ = 604 * MiB;
constexpr size_t WS_END = 616 * MiB;
static_assert((size_t)DEPTH * DIN * DM * 2 <= WS_W2T - WS_W1T && (size_t)M * DIN * 2 <= WS_YA - WS_PROJ && (size_t)3 * M * DB * 2 <= WS_LSE - WS_YB, "ws map");
constexpr int LDS_BYTES = 147456;
constexpr int N_PHASES = 2 + 5 * DEPTH;

__device__ __forceinline__ unsigned f2bf(float f) { unsigned u = __builtin_bit_cast(unsigned, f); return (u + 0x7fffu + ((u >> 16) & 1u)) >> 16; }
__device__ __forceinline__ unsigned pk2(float lo, float hi) { return f2bf(lo) | (f2bf(hi) << 16); }
__device__ __forceinline__ float bflo(unsigned w) { return __uint_as_float(w << 16); }
__device__ __forceinline__ float bfhi(unsigned w) { return __uint_as_float(w & 0xffff0000u); }
__device__ __forceinline__ float wave_sum(float v) {
#pragma unroll
    for (int o = 1; o < 64; o <<= 1) v += __shfl_xor(v, o);
    return v;
}

__device__ const float INV_FREQ[32] = {1.000000000e+00f, 7.498942614e-01f, 5.623413324e-01f, 4.216965139e-01f, 3.162277639e-01f, 2.371373773e-01f, 1.778279394e-01f, 1.333521307e-01f,
    1.000000015e-01f, 7.498941571e-02f, 5.623413250e-02f, 4.216965288e-02f, 3.162277490e-02f, 2.371373773e-02f, 1.778279431e-02f, 1.333521493e-02f,
    9.999999776e-03f, 7.498941850e-03f, 5.623413250e-03f, 4.216964822e-03f, 3.162277630e-03f, 2.371373586e-03f, 1.778279431e-03f, 1.333521446e-03f,
    1.000000047e-03f, 7.498942432e-04f, 5.623413017e-04f, 4.216965172e-04f, 3.162277571e-04f, 2.371373703e-04f, 1.778279402e-04f, 1.333521504e-04f};

__device__ __forceinline__ void sincos_acc(float a, float& s, float& c) {
    const double x = (double)a, kd = __builtin_rint(x * 0.63661977236758134308);
    const int k = (int)kd; const double r = x - kd * 1.57079632679489661923, r2 = r * r;
    const double sp = r * (1.0 + r2 * (-1.0 / 6 + r2 * (1.0 / 120 + r2 * (-1.0 / 5040 + r2 * (1.0 / 362880 + r2 * (-1.0 / 39916800 + r2 * (1.0 / 6227020800.0)))))));
    const double cp = 1.0 + r2 * (-0.5 + r2 * (1.0 / 24 + r2 * (-1.0 / 720 + r2 * (1.0 / 40320 + r2 * (-1.0 / 3628800 + r2 * (1.0 / 479001600.0 + r2 * (-1.0 / 87178291200.0)))))));
    const int q = k & 3;
    const double sv = (q == 0) ? sp : (q == 1) ? cp : (q == 2) ? -sp : -cp, cv = (q == 0) ? cp : (q == 1) ? -sp : (q == 2) ? -cp : sp;
    s = (float)sv; c = (float)cv;
}

__device__ __forceinline__ void p0_transpose_item(const float* W, int K, int N, bf16_t* WT, LAS float* scr, int item, int lane, const float* kscale) {
    const int nblk = N / 32, kb = item / nblk, nb = item % nblk, k0 = 64 * kb, n0 = 32 * nb;
#pragma unroll 8
    for (int i = 0; i < 32; ++i) { const int kk = 2 * i + (lane >> 5); scr[kk * 33 + (lane & 31)] = W[(size_t)(k0 + kk) * N + n0 + (lane & 31)] * (kscale ? kscale[k0 + kk] : 1.0f); }
    LDS_WAIT(); asm volatile("" ::: "memory");
    const int c = lane & 7;
#pragma unroll
    for (int j = 0; j < 4; ++j) { const int n = (lane >> 3) + 8 * j; const LAS float* s = scr + (8 * c) * 33 + n;
        v4u o; o.x = pk2(s[0 * 33], s[1 * 33]); o.y = pk2(s[2 * 33], s[3 * 33]); o.z = pk2(s[4 * 33], s[5 * 33]); o.w = pk2(s[6 * 33], s[7 * 33]);
        *(v4u*)(WT + (size_t)(n0 + n) * K + k0 + 8 * c) = o; }
    LDS_WAIT(); asm volatile("" ::: "memory");
}

#define XB_TMO      128
#define XB_XCNT(j)  (256  + 64 * (j))
#define XB_XSUB(j)  (1280 + 64 * (j))
#define XB_XGEN(j)  (2304 + 64 * (j))
#define XB_TOP      3328
#define XB_TOPGEN   3392
#define XCD_BAR_WORDS 3456
#define XB_SPIN_CAP (1u << 18)

__device__ __forceinline__ unsigned xb_ld(unsigned* p)              { return __hip_atomic_load(p, __ATOMIC_RELAXED, __HIP_MEMORY_SCOPE_AGENT); }
__device__ __forceinline__ unsigned xb_add(unsigned* p, unsigned v) { return __hip_atomic_fetch_add(p, v, __ATOMIC_RELAXED, __HIP_MEMORY_SCOPE_AGENT); }
__device__ __forceinline__ unsigned xb_xcc_id() { return (unsigned)__builtin_amdgcn_s_getreg((3 << 11) | 20) & 0xFu; }
#define XB_SPIN(cond, bar) do { unsigned _sp = 0; while (cond) { __builtin_amdgcn_s_sleep(1); \
    if ((++_sp & 255u) == 0u) { if (xb_ld(&(bar)[XB_TMO])) break; if (_sp > XB_SPIN_CAP) { atomicAdd(&(bar)[XB_TMO], 1u); break; } } } } while (0)

struct XcdBarrier {
    unsigned* bar; unsigned x;
    volatile LAS unsigned* st;
};

__device__ __forceinline__ XcdBarrier xcd_barrier_post(unsigned* bar, volatile LAS unsigned* st) {
    XcdBarrier b; b.bar = bar; b.x = xb_xcc_id(); b.st = st;
    if (threadIdx.x == 0) (void)xb_add(&bar[XB_XCNT(b.x)], 1u);
    return b;
}
__device__ __forceinline__ void xcd_barrier_complete(unsigned* bar, unsigned x, unsigned& nloc, unsigned& nx) {
    const unsigned G = gridDim.x * gridDim.y * gridDim.z;
    unsigned sum, cnt, mine, sp = 0u;
    for (;;) {
        sum = 0u; cnt = 0u; mine = 0u;
#pragma unroll
        for (unsigned j = 0; j < 16; ++j) { const unsigned c = xb_ld(&bar[XB_XCNT(j)]); sum += c; cnt += (c > 0u) ? 1u : 0u; mine = (j == x) ? c : mine; }
        if (sum == G) break;
        __builtin_amdgcn_s_sleep(1);
        if ((++sp & 255u) == 0u) { if (xb_ld(&bar[XB_TMO])) break; if (sp > XB_SPIN_CAP) { atomicAdd(&bar[XB_TMO], 1u); break; } }
    }
    nloc = mine > 0u ? mine : 1u; nx = cnt > 0u ? cnt : 1u;
}

__device__ __forceinline__ void xcd_barrier(const XcdBarrier& b) {
    asm volatile("s_waitcnt vmcnt(0)" ::: "memory");
    __syncthreads();
    if (threadIdx.x == 0) {
        unsigned* bar = b.bar;
        __builtin_amdgcn_s_waitcnt(0);
        unsigned nloc = b.st[0], nx = b.st[1];
        if (nloc == 0u) { xcd_barrier_complete(bar, b.x, nloc, nx); b.st[0] = nloc; b.st[1] = nx; }
        const unsigned old = xb_add(&bar[XB_XSUB(b.x)], 1u);
        const unsigned gen = old / nloc;
        if (old + 1u == (gen + 1u) * nloc) {
            __builtin_amdgcn_fence(__ATOMIC_RELEASE, "agent");
            asm volatile("s_waitcnt vmcnt(0)" ::: "memory");
            const unsigned og = xb_add(&bar[XB_TOP], 1u);
            const unsigned tg = og / nx;
            if (og + 1u == (tg + 1u) * nx) xb_add(&bar[XB_TOPGEN], 1u);
            else XB_SPIN(xb_ld(&bar[XB_TOPGEN]) == tg, bar);
            __builtin_amdgcn_fence(__ATOMIC_ACQUIRE, "agent");
            xb_add(&bar[XB_XGEN(b.x)], 1u);
            asm volatile("s_waitcnt vmcnt(0)" ::: "memory");
        } else {
            XB_SPIN(xb_ld(&bar[XB_XGEN(b.x)]) == gen, bar);
            __builtin_amdgcn_fence(__ATOMIC_ACQUIRE, "agent");
            asm volatile("s_waitcnt vmcnt(0)" ::: "memory");
        }
    }
    __syncthreads();
}

constexpr size_t WS_CTL = 539 * MiB, CTL_BYTES = 16384;
constexpr int MISC_OFF = 147456 - 128;
struct Params { const float *x, *norm_w, *w_in, *qn, *kn, *ona, *onb, *w_out, *fnorm; float* out; unsigned char* ws; int ph_lo, ph_hi; };

__global__ void __launch_bounds__(512, 2) mk_fwd(Params p) {
    extern __shared__ __attribute__((aligned(16))) unsigned char lds[];
    volatile LAS unsigned* MISC = (volatile LAS unsigned*)((LAS unsigned char*)lds + MISC_OFF);
    if (threadIdx.x < 32) MISC[threadIdx.x] = 0u;
    __syncthreads();
    XcdBarrier bar = xcd_barrier_post((unsigned*)(p.ws + WS_CTL), MISC + 8);
    for (int ph = p.ph_lo; ph < p.ph_hi; ++ph) {
        const int tid = otid(), lane = tid & 63, wave = __builtin_amdgcn_readfirstlane(tid >> 6);
        int G = gridDim.x, bx = blockIdx.x; asm volatile("" : "+s"(G), "+s"(bx));
        const int vcu = (G % 8 == 0) ? (bx % 8) * (G / 8) + bx / 8 : bx;
        const int gw = vcu * 8 + wave, NGW = G * 8;
        size_t zoff = 0; asm volatile("" : "+s"(zoff));
        unsigned char* ws = p.ws + zoff;
        bf16_t* W1T = (bf16_t*)(ws + WS_W1T); bf16_t* W2T = (bf16_t*)(ws + WS_W2T); bf16_t* H = (bf16_t*)(ws + WS_H); bf16_t* PROJ = (bf16_t*)(ws + WS_PROJ);
        bf16_t* YA = (bf16_t*)(ws + WS_YA); bf16_t* YB = (bf16_t*)(ws + WS_YB); float* LSE = (float*)(ws + WS_LSE);
        float* RCOS = (float*)(ws + WS_ROPE); float* RSIN = RCOS + 192 * 32;
        bf16_t* XB = (bf16_t*)(ws + WS_XB); float* ROWSQ = (float*)(ws + WS_ROWSQ);
        if (ph == 0) {
            LAS float* scr = (LAS float*)((LAS unsigned char*)lds + wave * 16384);
            constexpr int I1 = (DM / 64) * (DIN / 32), I2 = (DM / 64) * (DM / 32), IL = I1 + I2;
            DUPREP(0) for (int it = gw; it < DEPTH * IL; it += NGW) {
                const int l = it / IL, r = it % IL;
                if (r < I1) p0_transpose_item(p.w_in + (size_t)l * DM * DIN, DM, DIN, W1T + (size_t)l * DIN * DM, scr, r, lane, p.norm_w + (size_t)l * DM);
                else p0_transpose_item(p.w_out + (size_t)l * DM * DM, DM, DM, W2T + (size_t)l * DM * DM, scr, r - I1, lane, nullptr);
            }
            for (int m = gw; m < M; m += NGW) {
                const f32x4* xr = (const f32x4*)(p.x + (size_t)m * DM) + lane; v2u* o8 = (v2u*)(XB + (size_t)m * DM) + lane; float sq = 0.f;
#pragma unroll
                for (int j = 0; j < 8; ++j) { const f32x4 v = xr[64 * j]; v2u w; w.x = pk2(v.x, v.y); w.y = pk2(v.z, v.w); o8[64 * j] = w;
                    const float r0 = bflo(w.x), r1 = bfhi(w.x), r2 = bflo(w.y), r3 = bfhi(w.y); sq += (r0 * r0 + r1 * r1) + (r2 * r2 + r3 * r3); }
                sq = wave_sum(sq); if (lane < 32) ROWSQ[(size_t)m * 32 + lane] = (lane == 0) ? sq : 0.f;
            }
            for (int i = gw * 64 + lane; i < 192 * 32; i += NGW * 64) {
                const int pos = i >> 5, f = i & 31; const float pv = (float)(pos < 128 ? pos : pos - 128);
                float s, c; sincos_acc(pv * INV_FREQ[f], s, c); RCOS[i] = c; RSIN[i] = s;
            }
        } else if (ph == N_PHASES - 1) {
            for (int m = gw; m < M; m += NGW) {
                f32x4* xr = (f32x4*)(p.out + (size_t)m * DM) + lane; const f32x4* wr_ = (const f32x4*)p.fnorm + lane; const v2u* xb8 = (const v2u*)(XB + (size_t)m * DM) + lane;
                const float rstd = 1.0f / sqrtf(wave_sum(lane < 32 ? ROWSQ[((size_t)DEPTH * M + m) * 32 + lane] : 0.f) * (1.0f / DM) + EPS);
#pragma unroll
                for (int j = 0; j < 8; ++j) { const v2u w = xb8[64 * j]; const f32x4 v = {bflo(w.x), bfhi(w.x), bflo(w.y), bfhi(w.y)}; xr[64 * j] = v * rstd * wr_[64 * j]; }
            }
        } else {
            const int l = (ph - 1) / 5, st = (ph - 1) % 5 + 1;
            if (st == 1) {
                pg8::Gemm g{XB, W1T + (size_t)l * DIN * DM, M, DIN, DM}; pg8::StaticOrder S; S.init(M, DIN, G, bx);
                pg8::EpiHeadMajor E{PROJ, M, ROWSQ + (size_t)l * M * 32, 1.0f / DM, EPS};
#ifndef MK_NO_G1
                DUPREP(2) pg8::gemm_phase<pg8::EpiHeadMajor, pg8::StaticOrder, PG8_ALIGN, PG8_SP2>((PG8_LAS unsigned char*)lds, g, S, E);
#endif
            } else if (st == 2) {
                const float* qg = p.qn + l * HD; const float* kg = p.kn + l * HD;
                for (int it = gw; it < M * 10 / 4; it += NGW) {
                    const int g = it * 4 + (lane >> 4), row = g / 10, hs = g - row * 10;
                    const int j = lane & 15, half = j >> 3, jj = j & 7, e = half * 64 + 4 * jj;
                    bf16_t* pp = PROJ + ((size_t)hs * M + row) * HD + e;
                    const v2u a = *(const v2u*)pp, b = *(const v2u*)(pp + 32);
                    float x1[4] = {bflo(a.x), bfhi(a.x), bflo(a.y), bfhi(a.y)}, x2[4] = {bflo(b.x), bfhi(b.x), bflo(b.y), bfhi(b.y)};
                    float ss = 0.f;
#pragma unroll
                    for (int i = 0; i < 4; ++i) ss += x1[i] * x1[i] + x2[i] * x2[i];
                    ss += __shfl_xor(ss, 1); ss += __shfl_xor(ss, 2); ss += __shfl_xor(ss, 4); ss += __shfl_xor(ss, 8);
                    const float rstd = 1.0f / sqrtf(ss * (1.0f / HD) + EPS);
                    const float* gn = (hs < 8) ? qg : kg;
                    const f32x4 g1 = *(const f32x4*)(gn + e), g2 = *(const f32x4*)(gn + e + 32);
                    const int t = row & (T - 1), pos = half ? 128 + (t & 63) : (t >> 6);
                    const f32x4 cs = *(const f32x4*)(RCOS + pos * 32 + 4 * jj), sn = *(const f32x4*)(RSIN + pos * 32 + 4 * jj);
                    float o1[4], o2[4];
#pragma unroll
                    for (int i = 0; i < 4; ++i) { const float y1 = x1[i] * rstd * g1[i], y2 = x2[i] * rstd * g2[i]; o1[i] = y1 * cs[i] - y2 * sn[i]; o2[i] = y1 * sn[i] + y2 * cs[i]; }
                    v2u w1, w2; w1.x = pk2(o1[0], o1[1]); w1.y = pk2(o1[2], o1[3]); w2.x = pk2(o2[0], o2[1]); w2.y = pk2(o2[2], o2[3]);
                    *(v2u*)pp = w1; *(v2u*)(pp + 32) = w2;
                }
#ifndef MK_NO_DIL
                DUPREP(3) for (int u = vcu; u < 1536; u += G) {
                    const int pt = u >> 9, rem = u & 511, b = rem >> 8, h = (rem >> 5) & 7, w = rem & 31;
                    const int d = (pt == 0) ? 1 : (pt == 1) ? 4 : 16, res = w & (d - 1), blk = w / d, i0 = blk * 256, nsub = T / d;
                    const float slope = __builtin_amdgcn_exp2f(-(float)(h + 1));
                    const float nslopeC = -slope * (float)d * att::LOG2E;
                    const size_t tok0 = (size_t)b * T + res;
                    const att::bf16* Pb = (const att::bf16*)PROJ + ((size_t)h * M + tok0) * HD;
                    const long rs = (long)d * HD;
                    att::attn_body<true>(Pb + (size_t)H_QB * M * HD + (long)i0 * rs, Pb + (size_t)H_KB * M * HD, Pb + (size_t)H_VB * M * HD, rs, rs,
                                         (att::bf16*)YB + ((size_t)pt * M + tok0 + (size_t)i0 * d) * DB + h * HD, (long)d * DB,
                                         LSE + ((size_t)pt * M + tok0 + (size_t)i0 * d) * 8 + h, d * 8, i0, nsub, nslopeC, 0, (char*)lds);
                }
#endif
            } else if (st == 3) {
#ifndef MK_NO_DENSE
                DUPREP(4) for (int u = vcu; u < 512; u += G) {
                    const int combo = u >> 7, b = combo >> 1, kvh = combo & 1, h = kvh * 4 + ((u >> 5) & 3), qb = u & 31;
                    const att::bf16* Pb = (const att::bf16*)PROJ + (size_t)b * T * HD;
                    att::attn_body<false>(Pb + ((size_t)(H_QA + h) * M + qb * 256) * HD, Pb + (size_t)(H_KA + kvh) * M * HD, Pb + (size_t)(H_VA + kvh) * M * HD, HD, HD,
                                          (att::bf16*)YA + ((size_t)b * T + qb * 256) * DA + h * HD, DA, nullptr, 0, 0, 0, 0.f, T, (char*)lds);
                }
#endif
            } else if (st == 4) {
                const float* wa = p.ona + (size_t)l * DA; const float* wb = p.onb + (size_t)l * DB;
                DUPREP(5) for (int m = gw; m < M; m += NGW) {
                    float ya[2][8], yb[2][8]; float ssa = 0.f, ssb = 0.f;
#pragma unroll
                    for (int j = 0; j < 2; ++j) { const int c = lane + 64 * j, hh = c >> 4;
                        const v4u a = *(const v4u*)(YA + (size_t)m * DA + 8 * c);
                        ya[j][0] = bflo(a.x); ya[j][1] = bfhi(a.x); ya[j][2] = bflo(a.y); ya[j][3] = bfhi(a.y); ya[j][4] = bflo(a.z); ya[j][5] = bfhi(a.z); ya[j][6] = bflo(a.w); ya[j][7] = bfhi(a.w);
                        const float l0 = LSE[((size_t)0 * M + m) * 8 + hh], l1 = LSE[((size_t)1 * M + m) * 8 + hh], l2 = LSE[((size_t)2 * M + m) * 8 + hh];
                        const float mx = fmaxf(l0, fmaxf(l1, l2)); const float e0 = __builtin_amdgcn_exp2f(l0 - mx), e1 = __builtin_amdgcn_exp2f(l1 - mx), e2 = __builtin_amdgcn_exp2f(l2 - mx);
                        const float inv = 1.0f / (e0 + e1 + e2); const float w0 = e0 * inv, w1 = e1 * inv, w2 = e2 * inv;
                        const v4u b0 = *(const v4u*)(YB + ((size_t)0 * M + m) * DB + 8 * c), b1 = *(const v4u*)(YB + ((size_t)1 * M + m) * DB + 8 * c), b2 = *(const v4u*)(YB + ((size_t)2 * M + m) * DB + 8 * c);
                        yb[j][0] = w0 * bflo(b0.x) + w1 * bflo(b1.x) + w2 * bflo(b2.x); yb[j][1] = w0 * bfhi(b0.x) + w1 * bfhi(b1.x) + w2 * bfhi(b2.x);
                        yb[j][2] = w0 * bflo(b0.y) + w1 * bflo(b1.y) + w2 * bflo(b2.y); yb[j][3] = w0 * bfhi(b0.y) + w1 * bfhi(b1.y) + w2 * bfhi(b2.y);
                        yb[j][4] = w0 * bflo(b0.z) + w1 * bflo(b1.z) + w2 * bflo(b2.z); yb[j][5] = w0 * bfhi(b0.z) + w1 * bfhi(b1.z) + w2 * bfhi(b2.z);
                        yb[j][6] = w0 * bflo(b0.w) + w1 * bflo(b1.w) + w2 * bflo(b2.w); yb[j][7] = w0 * bfhi(b0.w) + w1 * bfhi(b1.w) + w2 * bfhi(b2.w);
#pragma unroll
                        for (int i = 0; i < 8; ++i) { ssa += ya[j][i] * ya[j][i]; ssb += yb[j][i] * yb[j][i]; } }
                    const float ra = 1.0f / sqrtf(wave_sum(ssa) * (1.0f / DA) + EPS), rb = 1.0f / sqrtf(wave_sum(ssb) * (1.0f / DB) + EPS);
#pragma unroll
                    for (int j = 0; j < 2; ++j) { const int c = lane + 64 * j;
                        const v4u ga = *(const v4u*)(PROJ + ((size_t)(H_GA + (c >> 4)) * M + m) * HD + 8 * (c & 15)), gb = *(const v4u*)(PROJ + ((size_t)(H_GB + (c >> 4)) * M + m) * HD + 8 * (c & 15));
                        const float gaf[8] = {bflo(ga.x), bfhi(ga.x), bflo(ga.y), bfhi(ga.y), bflo(ga.z), bfhi(ga.z), bflo(ga.w), bfhi(ga.w)};
                        const float gbf[8] = {bflo(gb.x), bfhi(gb.x), bflo(gb.y), bfhi(gb.y), bflo(gb.z), bfhi(gb.z), bflo(gb.w), bfhi(gb.w)};
                        const f32x4 wa0 = *(const f32x4*)(wa + 8 * c), wa1 = *(const f32x4*)(wa + 8 * c + 4), wb0 = *(const f32x4*)(wb + 8 * c), wb1 = *(const f32x4*)(wb + 8 * c + 4);
                        float za[8], zb[8];
#pragma unroll
                        for (int i = 0; i < 8; ++i) { const float wai = i < 4 ? wa0[i & 3] : wa1[i & 3], wbi = i < 4 ? wb0[i & 3] : wb1[i & 3];
                            const float sa = gaf[i] / (1.0f + __expf(-gaf[i])), sb = gbf[i] / (1.0f + __expf(-gbf[i]));
                            za[i] = ya[j][i] * ra * wai * sa; zb[i] = yb[j][i] * rb * wbi * sb; }
                        v4u oa, ob; oa.x = pk2(za[0], za[1]); oa.y = pk2(za[2], za[3]); oa.z = pk2(za[4], za[5]); oa.w = pk2(za[6], za[7]);
                        ob.x = pk2(zb[0], zb[1]); ob.y = pk2(zb[2], zb[3]); ob.z = pk2(zb[4], zb[5]); ob.w = pk2(zb[6], zb[7]);
                        *(v4u*)(H + (size_t)m * DM + 8 * c) = oa; *(v4u*)(H + (size_t)m * DM + DA + 8 * c) = ob; }
                }
            } else {
                pg8::Gemm g{H, W2T + (size_t)l * DM * DM, M, DM, DM}; pg8::StaticOrder S; S.init(M, DM, G, bx);
                pg8::EpiResF32 E{XB, ROWSQ + (size_t)(l + 1) * M * 32, DM};
#ifndef MK_NO_G2
                pg8::gemm_phase<pg8::EpiResF32, pg8::StaticOrder, PG8_ALIGN, PG8_SP2>((PG8_LAS unsigned char*)lds, g, S, E);
#endif
            }
        }
        if (ph + 1 < p.ph_hi) { if (ph == 0) cg::this_grid().sync(); else xcd_barrier(bar); if (MK_DUP & 64) xcd_barrier(bar); }
    }
}

extern "C" void kernel_launch(void* const* d_in, const int* in_sizes, int n_in, void* d_out, int out_size, void* d_ws, size_t ws_size, hipStream_t stream) {
    static int grid = 0;
    if (grid == 0) {
        if (n_in != 9 || in_sizes[0] != M * DM || out_size != M * DM || ws_size < WS_END) { fprintf(stderr, "kernel_launch: unexpected shapes (n_in %d, ws %zu)\n", n_in, ws_size); grid = -1; return; }
        int dev = 0, cus = 0, per_cu = 0;
        hipGetDevice(&dev); hipDeviceGetAttribute(&cus, hipDeviceAttributeMultiprocessorCount, dev);
        if (hipFuncSetAttribute((const void*)mk_fwd, hipFuncAttributeMaxDynamicSharedMemorySize, LDS_BYTES) != hipSuccess) { fprintf(stderr, "kernel_launch: hipFuncSetAttribute failed\n"); grid = -1; return; }
        if (hipOccupancyMaxActiveBlocksPerMultiprocessor(&per_cu, (const void*)mk_fwd, 512, LDS_BYTES) != hipSuccess || per_cu < 1) per_cu = 1;
        (void)hipGetLastError();
        grid = cus * per_cu;
    }
    if (grid < 0) return;
    Params p{};
    p.x = (const float*)d_in[0]; p.norm_w = (const float*)d_in[1]; p.w_in = (const float*)d_in[2]; p.qn = (const float*)d_in[3]; p.kn = (const float*)d_in[4];
    p.ona = (const float*)d_in[5]; p.onb = (const float*)d_in[6]; p.w_out = (const float*)d_in[7]; p.fnorm = (const float*)d_in[8];
    p.out = (float*)d_out; p.ws = (unsigned char*)d_ws;
    if (hipMemsetAsync((char*)d_ws + WS_CTL, 0, CTL_BYTES, stream) != hipSuccess) { fprintf(stderr, "kernel_launch: memset failed\n"); return; }
#if MK_ONE_LAUNCH
    p.ph_lo = 0; p.ph_hi = N_PHASES;
    void* args[] = {&p};
    hipError_t e = hipLaunchCooperativeKernel((const void*)mk_fwd, dim3(grid), dim3(512), args, LDS_BYTES, stream);
    if (e != hipSuccess) fprintf(stderr, "kernel_launch: cooperative launch failed: %s (grid %d)\n", hipGetErrorString(e), grid);
#else
    for (int ph = 0; ph < N_PHASES; ++ph) { p.ph_lo = ph; p.ph_hi = ph + 1; hipLaunchKernelGGL(mk_fwd, dim3(grid), dim3(512), LDS_BYTES, stream, p); }
#endif
}
```

```cpp
#include <hip/hip_runtime.h>
#include <hip/hip_bf16.h>
#include <hip/hip_cooperative_groups.h>
#include <cstdio>
#include <cstdint>
namespace cg = cooperative_groups;

#ifndef MK_DUP
#define MK_DUP 0
#endif
#define DUPREP(k) for (int rep_ = 0; rep_ < 1 + ((MK_DUP >> (k)) & 1); ++rep_)
#ifndef MK_PVPIPE
#define MK_PVPIPE 1
#endif
#ifndef MK_SGB
#define MK_SGB 0
#endif
#ifndef MK_PP
#define MK_PP 1
#endif
#ifndef MK_ONE_LAUNCH
#define MK_ONE_LAUNCH 1
#endif

constexpr int BATCH = 2, T = 8192, DM = 2048, DEPTH = 4, HD = 128, DA = 1024, DB = 1024, DIN = 6656, M = BATCH * T;
constexpr int C_QA = 0, C_KA = 1024, C_VA = 1280, C_GA = 1536, C_QB = 2560, C_KB = 3584, C_VB = 4608, C_GB = 5632;
constexpr int H_QA = 0, H_KA = 8, H_VA = 10, H_GA = 12, H_QB = 20, H_KB = 28, H_VB = 36, H_GB = 44;
constexpr float EPS = 1e-6f;
__device__ __forceinline__ int otid() { int t = threadIdx.x; asm volatile("" : "+v"(t)); return t; }

namespace pg8 {
#define PG8_LAS __attribute__((address_space(3)))
typedef unsigned short bf16_t;
typedef short bf16x8 __attribute__((ext_vector_type(8)));
typedef float f32x4 __attribute__((ext_vector_type(4)));
typedef unsigned u32x4 __attribute__((ext_vector_type(4)));
constexpr int BM = 256, BK = 64, HALF = 128, HTB = HALF * BK * 2  , STAGE_BYTES = 8 * HTB, NXCD = 8, WGM = 8;

__host__ __device__ __forceinline__ int lds_byte(int r, int c) { const int st = (r >> 4) * 2 + (c >> 5), rr = r & 15, cc = c & 31, ob = rr * 64 + cc * 2; return st * 1024 + (ob ^ (((ob >> 9) & 1) << 5)); }
__host__ __device__ __forceinline__ void stage_rc(int b, int& R, int& C) { const int st = b / 1024, sb = b % 1024, swz = sb ^ (((sb >> 9) & 1) << 5); R = (st >> 1) * 16 + swz / 64; C = (st & 1) * 32 + (swz % 64) / 2; }
__host__ __device__ __forceinline__ int perm32(int rho) { const int n = rho >> 4, i = rho & 15; return 8 * (i >> 2) + 4 * n + (i & 3); }

struct Unit { int pm, pn; };
struct Gemm { const bf16_t* A; const bf16_t* Bt; int M, N, K; };

struct StaticOrder {
    int nM, nN, nwg, G, c;
    __host__ __device__ void init(int M, int N, int G_, int c_) { nM = M / BM; nN = N / BM; nwg = nM * nN; G = G_; c = c_; }
    __host__ __device__ bool next(int i, Unit& u) const {
        const long L = (long)i * G + c; if (L >= nwg) return false;
        int wgid = (int)L; { const int q = nwg / NXCD, r = nwg % NXCD, xcd = wgid % NXCD, off = wgid / NXCD; wgid = (xcd < r ? xcd * (q + 1) : r * (q + 1) + (xcd - r) * q) + off; }
        const int nig = WGM * nN, gid = wgid / nig, fm = gid * WGM, gsz = (nM - fm) < WGM ? (nM - fm) : WGM;
        u.pm = fm + ((wgid % nig) % gsz); u.pn = (wgid % nig) / gsz; return true;
    }
    __device__ __forceinline__ void a_ready(const Unit&) const {}
    __device__ __forceinline__ void done(const Unit&) const {}
};

__device__ __forceinline__ unsigned cvt_pk_bf16(float lo, float hi) { unsigned r; asm volatile("v_cvt_pk_bf16_f32 %0, %1, %2" : "=v"(r) : "v"(lo), "v"(hi)); return r; }
typedef float f32x2 __attribute__((ext_vector_type(2)));
__device__ __forceinline__ f32x2 gelu_pk(f32x2 v) {
    const f32x2 av = __builtin_elementwise_abs(v), d = av * 0.2316418882f + 1.0f;
    f32x2 t; t.x = __builtin_amdgcn_rcpf(d.x); t.y = __builtin_amdgcn_rcpf(d.y);
    f32x2 q = t * 0.5307027145f + (-0.7265760135f); q = q * t + 0.7107068705f; q = q * t + (-0.142248368f); q = q * t + 0.127414796f; q = q * t;
    const f32x2 s = (v * v) * (-0.72134752044f);
    f32x2 e; e.x = __builtin_amdgcn_exp2f(s.x); e.y = __builtin_amdgcn_exp2f(s.y);
    const f32x2 m = v * (q * e), r = v - m;
    f32x2 o; o.x = v.x < 0.f ? m.x : r.x; o.y = v.y < 0.f ? m.y : r.y; return o;
}

template <int ACT  > struct EpiBf16 {
    static constexpr bool PERM = true, AFTER_DRAIN = false; static_assert(ACT == 0 || ACT == 1, "EpiBf16: ACT is 0 (none) or 1 (gelu_pk)");
    bf16_t* O; int ldc; const float* bias; int split_cols; size_t split_stride; float scale0;
    __device__ __forceinline__ void operator()(const f32x4 (&acc)[2][2][4][2], const Unit& u, int wr, int wc, int fr, int fq) const {
        const int row0 = u.pm * BM + wr * 64 + fr; int colt = u.pn * BM; bf16_t* base = O;
        float sc = 1.f; if (split_cols) { const int t = colt / split_cols; base += (size_t)t * split_stride; colt -= t * split_cols; if (t == 0) sc = scale0; }
        const int col0 = colt + wc * 32 + 8 * fq, bcol0 = u.pn * BM + wc * 32 + 8 * fq;
        f32x4 bv[2][2];
#pragma unroll
        for (int bj = 0; bj < 2; ++bj)
#pragma unroll
            for (int n = 0; n < 2; ++n) bv[bj][n] = bias ? *(const f32x4*)(bias + bcol0 + bj * HALF + 4 * n) : (f32x4){0.f, 0.f, 0.f, 0.f};
#pragma unroll
        for (int ai = 0; ai < 2; ++ai)
#pragma unroll
            for (int m = 0; m < 4; ++m) { bf16_t* rowp = base + (size_t)(row0 + ai * HALF + m * 16) * ldc + col0;
#pragma unroll
                for (int bj = 0; bj < 2; ++bj) { f32x4 v0 = acc[ai][bj][m][0] + bv[bj][0], v1 = acc[ai][bj][m][1] + bv[bj][1];
                    if (ACT == 1) { f32x2 a = gelu_pk((f32x2){v0[0], v0[1]}), b = gelu_pk((f32x2){v0[2], v0[3]}), c = gelu_pk((f32x2){v1[0], v1[1]}), d = gelu_pk((f32x2){v1[2], v1[3]});
                        v0 = (f32x4){a.x, a.y, b.x, b.y}; v1 = (f32x4){c.x, c.y, d.x, d.y}; }
                    v0 = v0 * sc; v1 = v1 * sc; u32x4 w; w.x = cvt_pk_bf16(v0[0], v0[1]); w.y = cvt_pk_bf16(v0[2], v0[3]); w.z = cvt_pk_bf16(v1[0], v1[1]); w.w = cvt_pk_bf16(v1[2], v1[3]);
                    *(u32x4*)(rowp + bj * HALF) = w; } }
    }
};
struct EpiHeadMajor {
    static constexpr bool PERM = true, AFTER_DRAIN = false;
    bf16_t* O; int Mrows; const float* rowsq; float inv_k, eps;
    __device__ __forceinline__ void operator()(const f32x4 (&acc)[2][2][4][2], const Unit& u, int wr, int wc, int fr, int fq) const {
        const int row0 = u.pm * BM + wr * 64 + fr, col0 = wc * 32 + 8 * fq;
#pragma unroll
        for (int ai = 0; ai < 2; ++ai) {
            f32x4 pa[4], pb[4];
#pragma unroll
            for (int m = 0; m < 4; ++m) { const f32x4* pp = (const f32x4*)(rowsq + (size_t)(row0 + ai * HALF + m * 16) * 32 + 8 * fq); pa[m] = pp[0]; pb[m] = pp[1]; }
#pragma unroll
            for (int m = 0; m < 4; ++m) { const int row = row0 + ai * HALF + m * 16; const f32x4 a = pa[m], b = pb[m];
                float sq = ((a[0] + a[1]) + (a[2] + a[3])) + ((b[0] + b[1]) + (b[2] + b[3])); sq += __shfl_xor(sq, 16); sq += __shfl_xor(sq, 32);
                const float rs = 1.0f / sqrtf(sq * inv_k + eps);
#pragma unroll
                for (int bj = 0; bj < 2; ++bj) { const f32x4 v0 = acc[ai][bj][m][0] * rs, v1 = acc[ai][bj][m][1] * rs;
                    u32x4 w; w.x = cvt_pk_bf16(v0[0], v0[1]); w.y = cvt_pk_bf16(v0[2], v0[3]); w.z = cvt_pk_bf16(v1[0], v1[1]); w.w = cvt_pk_bf16(v1[2], v1[3]);
                    *(u32x4*)(O + ((size_t)(u.pn * 2 + bj) * Mrows + row) * HALF + col0) = w; } }
            asm volatile("" ::: "memory"); }
    }
};
struct EpiResF32 {
    static constexpr bool PERM = true, AFTER_DRAIN = false;
    bf16_t* xb; float* rowsq; int ldc;
    __device__ __forceinline__ void operator()(const f32x4 (&acc)[2][2][4][2], const Unit& u, int wr, int wc, int fr, int fq) const {
        const int col0 = u.pn * BM + wc * 32 + 8 * fq;
#pragma unroll
        for (int ai = 0; ai < 2; ++ai) {
            u32x4 pre[4][2];
#pragma unroll
            for (int m = 0; m < 4; ++m) { const size_t off = (size_t)(u.pm * BM + ai * HALF + wr * 64 + m * 16 + fr) * ldc + col0;
#pragma unroll
                for (int bj = 0; bj < 2; ++bj) pre[m][bj] = *(const u32x4*)(xb + off + bj * HALF); }
            asm volatile("" ::: "memory");
#pragma unroll
            for (int m = 0; m < 4; ++m) { const int row = u.pm * BM + ai * HALF + wr * 64 + m * 16 + fr; const size_t off = (size_t)row * ldc + col0; float ss = 0.f;
#pragma unroll
                for (int bj = 0; bj < 2; ++bj) { const u32x4 pb = pre[m][bj]; const f32x4 a0 = acc[ai][bj][m][0], a1 = acc[ai][bj][m][1];
                    u32x4 w; w.x = cvt_pk_bf16(__uint_as_float(pb.x << 16) + a0[0], __uint_as_float(pb.x & 0xffff0000u) + a0[1]); w.y = cvt_pk_bf16(__uint_as_float(pb.y << 16) + a0[2], __uint_as_float(pb.y & 0xffff0000u) + a0[3]);
                    w.z = cvt_pk_bf16(__uint_as_float(pb.z << 16) + a1[0], __uint_as_float(pb.z & 0xffff0000u) + a1[1]); w.w = cvt_pk_bf16(__uint_as_float(pb.w << 16) + a1[2], __uint_as_float(pb.w & 0xffff0000u) + a1[3]);
#pragma unroll
                    for (int q = 0; q < 4; ++q) { const float r0 = __uint_as_float(w[q] << 16), r1 = __uint_as_float(w[q] & 0xffff0000u); ss += r0 * r0 + r1 * r1; }
                    *(u32x4*)(xb + off + bj * HALF) = w; }
                ss += __shfl_xor(ss, 16); ss += __shfl_xor(ss, 32);
                if (fq == 0) rowsq[(size_t)row * 32 + u.pn * 4 + wc] = ss; }
            asm volatile("" ::: "memory"); }
    }
};


template <class Epi, class Sched, bool ALIGN_EPI = false, bool SP2 = false>
__device__ __forceinline__ void gemm_phase(PG8_LAS unsigned char* lds, const Gemm g, const Sched& S, const Epi& E) {
    const int tid = otid(), wid = __builtin_amdgcn_readfirstlane(tid >> 6), lane = tid & 63, wr = wid >> 2, wc = wid & 3, fr = lane & 15, fq = lane >> 4;
    const int K = g.K, nt = K / BK;
    unsigned voffA[2], voffB[2];
#pragma unroll
    for (int i = 0; i < 2; ++i) { int R, C; stage_rc(tid * 16 + i * 8192, R, C); const int Rb = Epi::PERM ? ((R & ~31) + perm32(R & 31)) : R;
        voffA[i] = (unsigned)(R * K + C) * 2u; voffB[i] = (unsigned)(Rb * K + C) * 2u; }
    const size_t kstep = (size_t)(BK * 2);
    const size_t hstep = (size_t)HALF * K * 2;
    const size_t tstep = 2 * hstep;
    const unsigned ldsw = (unsigned)wid * 1024u;
    const int aoff = lds_byte(wr * 64 + fr, fq * 8), boff = lds_byte(wc * 32 + fr, fq * 8);
#define PG8_SA(b, h) (((b) * 2 + (h)) * HTB)
#define PG8_SB(b, h) ((4 + (b) * 2 + (h)) * HTB)
#define PG8_STAGE(bufoff, gbase, voff) do { _Pragma("unroll") for (int _i = 0; _i < 2; ++_i) \
        __builtin_amdgcn_global_load_lds((const unsigned*)((const char*)(gbase) + (voff)[_i]), (PG8_LAS unsigned*)(lds + (bufoff) + ldsw + _i * 8192), 16, 0, 0); } while (0)
#define PG8_LDA(dst, b, h) do { _Pragma("unroll") for (int m = 0; m < 4; ++m) _Pragma("unroll") for (int k = 0; k < 2; ++k) dst[m][k] = *(const PG8_LAS bf16x8*)(lds + PG8_SA(b, h) + aoff + m * 2048 + k * 1024); } while (0)
#define PG8_LDB(dst, b, h) do { _Pragma("unroll") for (int n = 0; n < 2; ++n) _Pragma("unroll") for (int k = 0; k < 2; ++k) dst[n][k] = *(const PG8_LAS bf16x8*)(lds + PG8_SB(b, h) + boff + n * 2048 + k * 1024); } while (0)
#define PG8_MMA(ai, bj, At, Bt) do { __builtin_amdgcn_s_setprio(1); _Pragma("unroll") for (int m = 0; m < 4; ++m) _Pragma("unroll") for (int n = 0; n < 2; ++n) _Pragma("unroll") for (int k = 0; k < 2; ++k) \
        acc[ai][bj][m][n] = __builtin_amdgcn_mfma_f32_16x16x32_bf16(Bt[n][k], At[m][k], acc[ai][bj][m][n], 0, 0, 0); __builtin_amdgcn_s_setprio(0); } while (0)
#define PG8_WAIT_V(n) asm volatile("s_waitcnt vmcnt(" #n ")" ::: "memory")
#define PG8_WAIT_L(n) asm volatile("s_waitcnt lgkmcnt(" #n ")" ::: "memory")
#define PG8_BAR __builtin_amdgcn_s_barrier()
#define PG8_SCHED __builtin_amdgcn_sched_barrier(0)
    Unit cur, nxt; int ui = 0;
    if (!S.next(0, cur)) return;
    f32x4 acc[2][2][4][2];
#pragma unroll
    for (int a = 0; a < 2; ++a)
#pragma unroll
        for (int b = 0; b < 2; ++b)
#pragma unroll
            for (int m = 0; m < 4; ++m)
#pragma unroll
                for (int n = 0; n < 2; ++n) acc[a][b][m][n] = (f32x4){0.f, 0.f, 0.f, 0.f};
    bf16x8 At[4][2], B0[2][2], B1[2][2];
    const char* cA = (const char*)g.A + (size_t)cur.pm * tstep; const char* cB = (const char*)g.Bt + (size_t)cur.pn * tstep;
    S.a_ready(cur);
    if constexpr (SP2) {
        PG8_STAGE(PG8_SB(0, 0), cB, voffB); PG8_STAGE(PG8_SB(0, 1), cB + hstep, voffB); PG8_STAGE(PG8_SA(0, 0), cA, voffA); PG8_STAGE(PG8_SA(0, 1), cA + hstep, voffA);
        if (wr == 1) PG8_BAR;
        PG8_WAIT_V(2); PG8_BAR;
        PG8_STAGE(PG8_SB(1, 0), cB + kstep, voffB); PG8_STAGE(PG8_SA(1, 0), cA + kstep, voffA); PG8_STAGE(PG8_SB(1, 1), cB + hstep + kstep, voffB);
        PG8_WAIT_V(6); PG8_BAR;
    } else {
        PG8_STAGE(PG8_SB(0, 0), cB, voffB); PG8_STAGE(PG8_SA(0, 0), cA, voffA); PG8_STAGE(PG8_SB(0, 1), cB + hstep, voffB); PG8_STAGE(PG8_SA(0, 1), cA + hstep, voffA);
        if (wr == 1) PG8_BAR;
        PG8_WAIT_V(4); PG8_BAR;
        PG8_STAGE(PG8_SB(1, 0), cB + kstep, voffB); PG8_STAGE(PG8_SA(1, 0), cA + kstep, voffA); PG8_STAGE(PG8_SB(1, 1), cB + hstep + kstep, voffB);
        PG8_WAIT_V(6); PG8_BAR;
    }
    for (;;) {
        const bool has_next = S.next(ui + 1, nxt);
        const char* nA = has_next ? (const char*)g.A + (size_t)nxt.pm * tstep : cA; const char* nB = has_next ? (const char*)g.Bt + (size_t)nxt.pn * tstep : cB;
        for (int t = 0; t < nt; t += 2) {
            const bool last = (t == nt - 2);
            const char* a1 = cA + (size_t)(t + 1) * kstep;
            const char* a2 = last ? nA : cA + (size_t)(t + 2) * kstep; const char* b2 = last ? nB : cB + (size_t)(t + 2) * kstep;
            const char* a3 = a2 + kstep; const char* b3 = b2 + kstep;
            if (last && has_next) S.a_ready(nxt);
            if constexpr (SP2) {
            PG8_LDB(B0, 0, 0); PG8_LDB(B1, 0, 1); PG8_SCHED; PG8_LDA(At, 0, 0); PG8_STAGE(PG8_SA(1, 1), a1 + hstep, voffA);
            PG8_WAIT_V(8); PG8_WAIT_L(0); PG8_BAR; PG8_MMA(0, 0, At, B0); PG8_MMA(0, 1, At, B1); PG8_BAR; PG8_SCHED;
            PG8_LDA(At, 0, 1); PG8_STAGE(PG8_SB(0, 0), b2, voffB); PG8_STAGE(PG8_SB(0, 1), b2 + hstep, voffB); PG8_STAGE(PG8_SA(0, 0), a2, voffA);
            PG8_WAIT_V(8); PG8_WAIT_L(0); PG8_BAR; PG8_MMA(1, 0, At, B0); PG8_MMA(1, 1, At, B1); PG8_BAR; PG8_SCHED;
            PG8_LDB(B0, 1, 0); PG8_LDB(B1, 1, 1); PG8_SCHED; PG8_LDA(At, 1, 0); PG8_STAGE(PG8_SA(0, 1), a2 + hstep, voffA);
            PG8_WAIT_V(8); PG8_WAIT_L(0); PG8_BAR; PG8_MMA(0, 0, At, B0); PG8_MMA(0, 1, At, B1); PG8_BAR; PG8_SCHED;
            PG8_LDA(At, 1, 1); PG8_STAGE(PG8_SB(1, 0), b3, voffB); PG8_STAGE(PG8_SB(1, 1), b3 + hstep, voffB); PG8_STAGE(PG8_SA(1, 0), a3, voffA);
            PG8_WAIT_V(8); PG8_WAIT_L(0); PG8_BAR; PG8_MMA(1, 0, At, B0); PG8_MMA(1, 1, At, B1); PG8_BAR; PG8_SCHED;
            } else {
            PG8_LDB(B0, 0, 0); PG8_SCHED; PG8_LDA(At, 0, 0); PG8_STAGE(PG8_SA(1, 1), a1 + hstep, voffA);
            PG8_WAIT_L(8); PG8_BAR; PG8_WAIT_L(0); PG8_MMA(0, 0, At, B0); PG8_BAR; PG8_SCHED;
            PG8_LDB(B1, 0, 1); PG8_STAGE(PG8_SB(0, 0), b2, voffB);
            PG8_BAR; PG8_WAIT_L(0); PG8_MMA(0, 1, At, B1); PG8_BAR;
            PG8_LDA(At, 0, 1); PG8_STAGE(PG8_SA(0, 0), a2, voffA);
            PG8_BAR; PG8_WAIT_L(0); PG8_MMA(1, 0, At, B0); PG8_BAR; PG8_SCHED;
            PG8_STAGE(PG8_SB(0, 1), b2 + hstep, voffB);
            PG8_WAIT_V(6); PG8_BAR; PG8_MMA(1, 1, At, B1); PG8_BAR;
            PG8_LDB(B0, 1, 0); PG8_SCHED; PG8_LDA(At, 1, 0); PG8_STAGE(PG8_SA(0, 1), a2 + hstep, voffA);
            PG8_WAIT_L(8); PG8_BAR; PG8_WAIT_L(0); PG8_MMA(0, 0, At, B0); PG8_BAR; PG8_SCHED;
            PG8_LDB(B1, 1, 1); PG8_STAGE(PG8_SB(1, 0), b3, voffB);
            PG8_BAR; PG8_WAIT_L(0); PG8_MMA(0, 1, At, B1); PG8_BAR;
            PG8_LDA(At, 1, 1); PG8_STAGE(PG8_SA(1, 0), a3, voffA);
            PG8_BAR; PG8_WAIT_L(0); PG8_MMA(1, 0, At, B0); PG8_BAR; PG8_SCHED;
            PG8_STAGE(PG8_SB(1, 1), b3 + hstep, voffB);
            PG8_WAIT_V(6); PG8_BAR; PG8_MMA(1, 1, At, B1); PG8_BAR;
            }
        }
        if constexpr (ALIGN_EPI) { if (wr == 0) PG8_BAR; }
        if constexpr (!Epi::AFTER_DRAIN) { E(acc, cur, wr, wc, fr, fq); S.done(cur); }
        if (!has_next) break;
#pragma unroll
        for (int a = 0; a < 2; ++a)
#pragma unroll
            for (int b = 0; b < 2; ++b)
#pragma unroll
                for (int m = 0; m < 4; ++m)
#pragma unroll
                    for (int n = 0; n < 2; ++n) acc[a][b][m][n] = (f32x4){0.f, 0.f, 0.f, 0.f};
        cur = nxt; cA = nA; cB = nB; ++ui;
        if constexpr (ALIGN_EPI) { if (wr == 1) PG8_BAR; }
    }
    PG8_WAIT_V(0);
    if constexpr (!ALIGN_EPI) { if (wr == 0) PG8_BAR; }
    PG8_BAR;
    if constexpr (Epi::AFTER_DRAIN) { E.fused(acc, cur, wr, wc, fr, fq, lds, wid, lane); S.done(cur); }
#undef PG8_SA
#undef PG8_SB
#undef PG8_STAGE
#undef PG8_LDA
#undef PG8_LDB
#undef PG8_MMA
#undef PG8_WAIT_V
#undef PG8_WAIT_L
#undef PG8_BAR
#undef PG8_SCHED
}
}
#define PG8_SP2 true
#define PG8_ALIGN true
namespace att {
using bf16 = __hip_bfloat16;
constexpr int D = 128, NW = 8, QBLK = 32, KVBLK = 64;
constexpr float SCALE = 0.088388347648318440f;
constexpr float THR = 8.f;
constexpr size_t SHM_V = KVBLK * D * 2, SHM_K = KVBLK * D * 2, SHM_ATTN = 2 * SHM_V + 2 * SHM_K + NW * 64 * 4;
using bf16x8 = __attribute__((ext_vector_type(8))) short;
using s16x4  = __attribute__((ext_vector_type(4))) short;
using f32x16 = __attribute__((ext_vector_type(16))) float;
using f32x8  = __attribute__((ext_vector_type(8))) float;
using u32x4  = __attribute__((ext_vector_type(4))) unsigned;
#define KSWZ(row, colB) ((row) * 256 + ((colB) ^ (((row) & 7) << 4)))
#define SBAR() __builtin_amdgcn_sched_barrier(0)
__device__ __forceinline__ int crow(int r, int hi) { return (r & 3) + 8 * (r >> 2) + 4 * hi; }
__device__ __forceinline__ unsigned cvtpk(float lo, float hi) {
  unsigned r; asm("v_cvt_pk_bf16_f32 %0, %1, %2" : "=v"(r) : "v"(lo), "v"(hi)); return r;
}
template <typename TIn> struct Stage;
template <> struct Stage<bf16>  { using T = bf16x8;
  __device__ static __forceinline__ T ld8(const bf16* p) { return *reinterpret_cast<const bf16x8*>(p); }
  __device__ static __forceinline__ bf16x8 tobf(T x) { return x; } };
template <> struct Stage<float> { using T = f32x8;
  __device__ static __forceinline__ T ld8(const float* p) { return *reinterpret_cast<const f32x8*>(p); }
  __device__ static __forceinline__ bf16x8 tobf(T x) {
    u32x4 w = {cvtpk(x[0], x[1]), cvtpk(x[2], x[3]), cvtpk(x[4], x[5]), cvtpk(x[6], x[7])}; return *reinterpret_cast<bf16x8*>(&w); } };

__device__ __forceinline__ void partialSM(f32x16& p0, f32x16& p1, float& m_reg, float& mn, float& alpha) {
  constexpr float C = SCALE * 1.4426950408889634f;
  float pmax = p0[0]; for (int r = 1; r < 16; ++r) pmax = fmaxf(pmax, p0[r]); for (int r = 0; r < 16; ++r) pmax = fmaxf(pmax, p1[r]);
  { auto rr = __builtin_amdgcn_permlane32_swap(__float_as_uint(pmax), __float_as_uint(pmax), false, false);
    pmax = fmaxf(__uint_as_float(rr[0]), __uint_as_float(rr[1])); }
  if (__builtin_expect(__all(pmax - m_reg <= THR / SCALE), 1)) { mn = m_reg; alpha = 1.f; }
  else { mn = fmaxf(m_reg, pmax); alpha = __builtin_amdgcn_exp2f((m_reg - mn) * C); m_reg = mn; }
  float mnC = -mn * C;
  for (int r = 0; r < 16; ++r) p0[r] = fmaf(p0[r], C, mnC); for (int r = 0; r < 16; ++r) p1[r] = fmaf(p1[r], C, mnC);
  for (int r = 0; r < 16; ++r) p0[r] = __builtin_amdgcn_exp2f(p0[r]);
}
__device__ __forceinline__ void finishSM(f32x16& p0, f32x16& p1, float alpha, float& l_reg, bf16x8& pa0, bf16x8& pa1, bf16x8& pa2, bf16x8& pa3) {
  for (int r = 0; r < 16; ++r) p1[r] = __builtin_amdgcn_exp2f(p1[r]);
  float ps = 0; for (int r = 0; r < 16; ++r) ps += p0[r]; for (int r = 0; r < 16; ++r) ps += p1[r];
  { auto rr = __builtin_amdgcn_permlane32_swap(__float_as_uint(ps), __float_as_uint(ps), false, false);
    ps = __uint_as_float(rr[0]) + __uint_as_float(rr[1]); }
  l_reg = l_reg * alpha + ps;
#define PK4(P, BASE, OUT) do { unsigned a0 = cvtpk(P[BASE + 0], P[BASE + 1]), a1 = cvtpk(P[BASE + 2], P[BASE + 3]);   \
    unsigned b0 = cvtpk(P[BASE + 4], P[BASE + 5]), b1 = cvtpk(P[BASE + 6], P[BASE + 7]);                              \
    auto r0 = __builtin_amdgcn_permlane32_swap(a0, b0, false, false); auto r1 = __builtin_amdgcn_permlane32_swap(a1, b1, false, false); \
    u32x4 w = {r0[0], r1[0], r0[1], r1[1]}; OUT = *reinterpret_cast<bf16x8*>(&w); } while (0)
  PK4(p0, 0, pa0); PK4(p0, 8, pa1); PK4(p1, 0, pa2); PK4(p1, 8, pa3);
#undef PK4
}
__device__ __forceinline__ void qkt(f32x16& p0, f32x16& p1, const bf16* Ks, const bf16x8* qr, int r32, int hi) {
  p0 = f32x16{}; p1 = f32x16{};
  for (int d0 = 0; d0 < 8; ++d0) { int cb = (d0 * 16 + hi * 8) * 2;
    bf16x8 b0 = *reinterpret_cast<const bf16x8*>((const char*)Ks + KSWZ(r32, cb));
    bf16x8 b1 = *reinterpret_cast<const bf16x8*>((const char*)Ks + KSWZ(32 + r32, cb));
    p0 = __builtin_amdgcn_mfma_f32_32x32x16_bf16(b0, qr[d0], p0, 0, 0, 0);
    p1 = __builtin_amdgcn_mfma_f32_32x32x16_bf16(b1, qr[d0], p1, 0, 0, 0); }
}
__device__ __forceinline__ int v_st(int k, int c) { const int kk = (k & ~0xC) | ((k & 4) << 1) | ((k & 8) >> 1); return ((kk >> 3) * 4 + (c >> 5)) * 512 + ((kk & 7) * 32 + (c & 31)) * 2; }
__device__ __forceinline__ int v_rd_base(int lane) { return ((lane & 3) << 3) | (((lane >> 2) & 3) << 6) | (((lane >> 4) & 1) << 5) | (((lane >> 5) & 1) << 8); }
constexpr int v_rd_off(int d0, int ks, int half) { return d0 * 512 + ks * 4096 + half * 2048; }
template <int OFF> __device__ __forceinline__ s16x4 tr_read(int vb) {
  s16x4 r; asm volatile("ds_read_b64_tr_b16 %0, %1 offset:%2" : "=&v"(r) : "v"(vb), "i"(OFF) : "memory"); return r;
}
template <int D0> __device__ __forceinline__ void pv_one(f32x16& od, int vb, bf16x8 pa0, bf16x8 pa1, bf16x8 pa2, bf16x8 pa3) {
  const s16x4 l0 = tr_read<v_rd_off(D0, 0, 0)>(vb), h0 = tr_read<v_rd_off(D0, 0, 1)>(vb), l1 = tr_read<v_rd_off(D0, 1, 0)>(vb), h1 = tr_read<v_rd_off(D0, 1, 1)>(vb);
  const s16x4 l2 = tr_read<v_rd_off(D0, 2, 0)>(vb), h2 = tr_read<v_rd_off(D0, 2, 1)>(vb), l3 = tr_read<v_rd_off(D0, 3, 0)>(vb), h3 = tr_read<v_rd_off(D0, 3, 1)>(vb);
  asm volatile("s_waitcnt lgkmcnt(0)" ::: "memory"); SBAR();
#define PK(L, H) (bf16x8){L[0], L[1], L[2], L[3], H[0], H[1], H[2], H[3]}
  od = __builtin_amdgcn_mfma_f32_32x32x16_bf16(pa0, PK(l0, h0), od, 0, 0, 0);
  od = __builtin_amdgcn_mfma_f32_32x32x16_bf16(pa1, PK(l1, h1), od, 0, 0, 0);
  od = __builtin_amdgcn_mfma_f32_32x32x16_bf16(pa2, PK(l2, h2), od, 0, 0, 0);
  od = __builtin_amdgcn_mfma_f32_32x32x16_bf16(pa3, PK(l3, h3), od, 0, 0, 0);
#undef PK
}
struct VFrag { s16x4 l0, h0, l1, h1, l2, h2, l3, h3; };
template <int D0> __device__ __forceinline__ void pv_rd(VFrag& f, int vb) {
  f.l0 = tr_read<v_rd_off(D0, 0, 0)>(vb); f.h0 = tr_read<v_rd_off(D0, 0, 1)>(vb); f.l1 = tr_read<v_rd_off(D0, 1, 0)>(vb); f.h1 = tr_read<v_rd_off(D0, 1, 1)>(vb);
  f.l2 = tr_read<v_rd_off(D0, 2, 0)>(vb); f.h2 = tr_read<v_rd_off(D0, 2, 1)>(vb); f.l3 = tr_read<v_rd_off(D0, 3, 0)>(vb); f.h3 = tr_read<v_rd_off(D0, 3, 1)>(vb);
}
__device__ __forceinline__ void pv_mm(f32x16& od, const VFrag& f, bf16x8 pa0, bf16x8 pa1, bf16x8 pa2, bf16x8 pa3) {
#define PK(L, H) (bf16x8){L[0], L[1], L[2], L[3], H[0], H[1], H[2], H[3]}
  od = __builtin_amdgcn_mfma_f32_32x32x16_bf16(pa0, PK(f.l0, f.h0), od, 0, 0, 0);
  od = __builtin_amdgcn_mfma_f32_32x32x16_bf16(pa1, PK(f.l1, f.h1), od, 0, 0, 0);
  od = __builtin_amdgcn_mfma_f32_32x32x16_bf16(pa2, PK(f.l2, f.h2), od, 0, 0, 0);
  od = __builtin_amdgcn_mfma_f32_32x32x16_bf16(pa3, PK(f.l3, f.h3), od, 0, 0, 0);
#undef PK
}
#define PV_WAIT(n) do { asm volatile("s_waitcnt lgkmcnt(" #n ")" ::: "memory"); SBAR(); } while (0)
__device__ __forceinline__ void pv_d0(f32x16* o, int vb, bf16x8 pa0, bf16x8 pa1, bf16x8 pa2, bf16x8 pa3) {
#if MK_PVPIPE
  VFrag fa, fb;
  pv_rd<0>(fa, vb); pv_rd<1>(fb, vb);
  PV_WAIT(8); pv_mm(o[0], fa, pa0, pa1, pa2, pa3); SBAR();
  pv_rd<2>(fa, vb);
  PV_WAIT(8); pv_mm(o[1], fb, pa0, pa1, pa2, pa3); SBAR();
  pv_rd<3>(fb, vb);
  PV_WAIT(8); pv_mm(o[2], fa, pa0, pa1, pa2, pa3); SBAR();
  PV_WAIT(0); pv_mm(o[3], fb, pa0, pa1, pa2, pa3);
#else
  pv_one<0>(o[0], vb, pa0, pa1, pa2, pa3); pv_one<1>(o[1], vb, pa0, pa1, pa2, pa3); pv_one<2>(o[2], vb, pa0, pa1, pa2, pa3); pv_one<3>(o[3], vb, pa0, pa1, pa2, pa3);
#endif
}
constexpr int crow0(int r) { return (r & 3) + 8 * (r >> 2); }
constexpr float LOG2E = 1.4426950408889634f;
__device__ __forceinline__ void partialSM_dil(f32x16& p0, f32x16& p1, float& m_reg, float& mn, float& alpha, float dq, float dlo, float dhi, float nslopeC) {
  constexpr float C = SCALE * LOG2E;
#pragma unroll
  for (int r = 0; r < 16; ++r) {
    const float d0 = dq + (float)crow0(r), d1 = d0 + 32.f;
    const float t0 = fmaf(p0[r], C, nslopeC * fabsf(d0)), t1 = fmaf(p1[r], C, nslopeC * fabsf(d1));
    p0[r] = (d0 >= dlo && d0 <= dhi) ? t0 : -1e30f;
    p1[r] = (d1 >= dlo && d1 <= dhi) ? t1 : -1e30f;
  }
  float pmax = p0[0];
#pragma unroll
  for (int r = 1; r < 16; ++r) pmax = fmaxf(pmax, p0[r]);
#pragma unroll
  for (int r = 0; r < 16; ++r) pmax = fmaxf(pmax, p1[r]);
  { auto rr = __builtin_amdgcn_permlane32_swap(__float_as_uint(pmax), __float_as_uint(pmax), false, false);
    pmax = fmaxf(__uint_as_float(rr[0]), __uint_as_float(rr[1])); }
  if (__builtin_expect(__all(pmax - m_reg <= THR * LOG2E), 1)) { mn = m_reg; alpha = 1.f; }
  else { mn = fmaxf(m_reg, pmax); alpha = __builtin_amdgcn_exp2f(m_reg - mn); m_reg = mn; }
#pragma unroll
  for (int r = 0; r < 16; ++r) { p0[r] = p0[r] - mn; p1[r] = p1[r] - mn; }
#pragma unroll
  for (int r = 0; r < 16; ++r) p0[r] = __builtin_amdgcn_exp2f(p0[r]);
}

template <bool DIL>
__device__ __forceinline__ void attn_body(const bf16* __restrict__ Qb, const bf16* __restrict__ Kh, const bf16* __restrict__ Vh, long qs, long ks,
                                          bf16* __restrict__ Ob, long os, float* __restrict__ lse_o, int lse_s, int i0, int nsub, float nslopeC, int seq, char* lds) {
  typedef __attribute__((address_space(3))) unsigned lds_u32;
  using St = Stage<bf16>;
  const int tid = otid(), wid = __builtin_amdgcn_readfirstlane(tid >> 6), lane = tid & 63, r32 = lane & 31, hi = lane >> 5;
  char* V_lds = lds + 4 * SHM_K; char* K_lds = lds;
  float* ws = (float*)(lds + 4 * SHM_K + 4 * SHM_V) + wid * 64; float* li_l = ws; float* al_l = ws + 32;
  float m_reg = -1e30f, l_reg = 0; f32x16 o[4] = {}; bf16x8 qr[8];
  const bf16* Qw = Qb + (long)(wid * QBLK + r32) * qs + hi * 8;
#pragma unroll
  for (int d0 = 0; d0 < 8; ++d0) qr[d0] = St::ld8(Qw + d0 * 16);
  const int vb0 = (int)(uintptr_t)V_lds + v_rd_base(lane);
  const int kb = DIL ? i0 - 64 : 0;
#define KROW(k) (DIL ? (long)min(max(kb + (k), 0), nsub - 1) : (long)(k))
  int krow[2], kcol[2], vrow[2], vcol[2];
#pragma unroll
  for (int i = 0; i < 2; ++i) { const int pc = 2 * wid + i;
    krow[i] = pc * 4 + (lane >> 4); kcol[i] = (((lane & 15) ^ (krow[i] & 7)) << 3);
    const int sub = pc * 2 + (lane >> 5), kk = ((sub >> 2) << 3) + ((lane & 31) >> 2);
    vrow[i] = (kk & ~0xC) | ((kk & 4) << 1) | ((kk & 8) >> 1); vcol[i] = ((sub & 3) << 5) + ((lane & 3) << 3); }
#define DMA(t, buf) do { _Pragma("unroll") for (int i_ = 0; i_ < 2; ++i_) { \
      __builtin_amdgcn_global_load_lds((const unsigned*)(Kh + KROW((t) * KVBLK + krow[i_]) * ks + kcol[i_]), (lds_u32*)(K_lds + (buf) * SHM_K + (2 * wid + i_) * 1024), 16, 0, 0); \
      __builtin_amdgcn_global_load_lds((const unsigned*)(Vh + KROW((t) * KVBLK + vrow[i_]) * ks + vcol[i_]), (lds_u32*)(V_lds + (buf) * SHM_V + (2 * wid + i_) * 1024), 16, 0, 0); } } while (0)
#define ENDSTEP(j) do { if ((j) + 2 < NT) asm volatile("s_waitcnt vmcnt(4) lgkmcnt(0)\n\ts_barrier" ::: "memory"); else asm volatile("s_waitcnt vmcnt(0) lgkmcnt(0)\n\ts_barrier" ::: "memory"); } while (0)
#define RESC(a) do { if (__any((a) < 1.f)) { if (hi == 0) al_l[r32] = (a); asm volatile("s_waitcnt lgkmcnt(0)" ::: "memory"); \
    for (int d = 0; d < 4; ++d) for (int r = 0; r < 16; ++r) o[d][r] *= al_l[crow(r, hi)]; } } while (0)
#define PSM(P0, P1, MN, AL, jt) do { if constexpr (DIL) { const int t_ = otid(), iq_ = (t_ >> 6) * QBLK + (t_ & 31), hi_ = (t_ >> 5) & 1; \
      partialSM_dil(P0, P1, m_reg, MN, AL, (float)(-64 - iq_ + 4 * hi_ + 64 * (jt)), fmaxf(-64.f, (float)(-(i0 + iq_))), fminf(64.f, (float)(nsub - 1 - (i0 + iq_))), nslopeC); } \
    else partialSM(P0, P1, m_reg, MN, AL); } while (0)
#if MK_SGB
#define SGB_A() do { __builtin_amdgcn_sched_group_barrier(0x100, 4, 0); \
    _Pragma("unroll") for (int g_ = 0; g_ < 12; ++g_) { __builtin_amdgcn_sched_group_barrier(0x008, 1, 0); __builtin_amdgcn_sched_group_barrier(0x100, 1, 0); __builtin_amdgcn_sched_group_barrier(0x002, 6, 0); } \
    _Pragma("unroll") for (int g_ = 0; g_ < 4; ++g_) { __builtin_amdgcn_sched_group_barrier(0x008, 1, 0); __builtin_amdgcn_sched_group_barrier(0x002, 6, 0); } } while (0)
#else
#define SGB_A() do {} while (0)
#endif
#define KBUF(j) ((const bf16*)(K_lds + ((j) & 3) * SHM_K))
#define VBUF(j) (vb0 + ((j) & 3) * (int)SHM_V)
  f32x16 pA0, pA1, pB0, pB1; float mnA, mnB, alA, alB; bf16x8 pa0, pa1, pa2, pa3; const int NT = DIL ? 6 : seq / KVBLK;
  DMA(0, 0); DMA(1, 1);
  if constexpr (!DIL && MK_PP) { DMA(2, 2); asm volatile("s_waitcnt vmcnt(8)\n\ts_barrier" ::: "memory"); }
  else asm volatile("s_waitcnt vmcnt(4)\n\ts_barrier" ::: "memory");
  if constexpr (DIL) {
    const int rlo = wid >> 1;
    for (int j = 0; j < NT; ++j) {
      if (j + 2 < NT) DMA(j + 2, (j + 2) & 3);
      if (j >= rlo && j <= rlo + 2) {
        SBAR(); qkt(pA0, pA1, KBUF(j), qr, r32, hi);
        PSM(pA0, pA1, mnA, alA, j); RESC(alA);
        finishSM(pA0, pA1, alA, l_reg, pa0, pa1, pa2, pa3); SBAR();
        pv_d0(o, VBUF(j), pa0, pa1, pa2, pa3);
      }
      if (j + 1 < NT) ENDSTEP(j);
    }
  } else if constexpr (MK_PP) {
    const bool grpB = wid >= 4;
    struct KFrag { bf16x8 a, b; };
    int koff[8];
#pragma unroll
    for (int d0 = 0; d0 < 8; ++d0) koff[d0] = KSWZ(r32, (d0 * 16 + hi * 8) * 2);
    const int kbase0 = (int)(uintptr_t)K_lds;
#define KRD(f, d0, kb) asm volatile("ds_read_b128 %0, %2\n\tds_read_b128 %1, %2 offset:8192" : "=&v"(f.a), "=&v"(f.b) : "v"((kb) + koff[d0]) : "memory")
#define QMM(f, d0) do { pA0 = __builtin_amdgcn_mfma_f32_32x32x16_bf16(f.a, qr[d0], pA0, 0, 0, 0); pA1 = __builtin_amdgcn_mfma_f32_32x32x16_bf16(f.b, qr[d0], pA1, 0, 0, 0); } while (0)
#define LW(n) do { asm volatile("s_waitcnt lgkmcnt(" #n ")" ::: "memory"); SBAR(); } while (0)
#define PP_BAR(VM) do { if (VM) { asm volatile("s_waitcnt vmcnt(4) lgkmcnt(0)\n\ts_barrier" ::: "memory"); } else { asm volatile("s_waitcnt vmcnt(0) lgkmcnt(0)\n\ts_barrier" ::: "memory"); } } while (0)
#define PP_BAR_PLAIN() asm volatile("s_waitcnt lgkmcnt(0)\n\ts_barrier" ::: "memory")
    if (grpB) PP_BAR_PLAIN();
    qkt(pA0, pA1, KBUF(0), qr, r32, hi);
    if (grpB) PP_BAR(2 < NT); else PP_BAR_PLAIN();
    for (int t = 0; t < NT; ++t) {
      if (grpB && t + 3 < NT) DMA(t + 3, (t + 3) & 3);
      PSM(pA0, pA1, mnA, alA, t); RESC(alA);
      finishSM(pA0, pA1, alA, l_reg, pa0, pa1, pa2, pa3);
      if (!grpB) PP_BAR(t + 2 < NT); else PP_BAR_PLAIN();
      if (!grpB && t + 3 < NT) DMA(t + 3, (t + 3) & 3);
      SBAR();
      if (t + 1 < NT) {
        const int kb_ = kbase0 + ((t + 1) & 3) * (int)SHM_K, vb_ = VBUF(t);
        KFrag k0_, k1_, k2_; VFrag fa_, fb_;
        KRD(k0_, 0, kb_); KRD(k1_, 1, kb_); KRD(k2_, 2, kb_); pv_rd<0>(fa_, vb_);
        pA0 = f32x16{}; pA1 = f32x16{};
        LW(12); QMM(k0_, 0); SBAR(); KRD(k0_, 3, kb_);
        LW(12); QMM(k1_, 1); SBAR(); KRD(k1_, 4, kb_);
        LW(4);  pv_mm(o[0], fa_, pa0, pa1, pa2, pa3); SBAR(); pv_rd<1>(fb_, vb_);
        QMM(k2_, 2); SBAR(); KRD(k2_, 5, kb_);
        LW(12); QMM(k0_, 3); SBAR(); KRD(k0_, 6, kb_);
        LW(4);  pv_mm(o[1], fb_, pa0, pa1, pa2, pa3); SBAR(); pv_rd<2>(fa_, vb_);
        QMM(k1_, 4); SBAR(); KRD(k1_, 7, kb_);
        LW(12); QMM(k2_, 5); SBAR();
        LW(2);  pv_mm(o[2], fa_, pa0, pa1, pa2, pa3); SBAR(); pv_rd<3>(fb_, vb_);
        QMM(k0_, 6); SBAR();
        LW(8);  QMM(k1_, 7); SBAR();
        LW(0);  pv_mm(o[3], fb_, pa0, pa1, pa2, pa3);
      } else pv_d0(o, VBUF(t), pa0, pa1, pa2, pa3);
      if (t + 1 < NT) { if (grpB) PP_BAR(t + 3 < NT); else PP_BAR_PLAIN(); }
    }
    if (!grpB) PP_BAR_PLAIN();
#undef PP_BAR
#undef PP_BAR_PLAIN
#undef KRD
#undef QMM
#undef LW
  } else {
  if (2 < NT) DMA(2, 2);
  qkt(pA0, pA1, KBUF(0), qr, r32, hi); PSM(pA0, pA1, mnA, alA, 0);
  ENDSTEP(0);
  for (int j = 1; j + 1 < NT; j += 2) {
    if (j + 2 < NT) DMA(j + 2, (j + 2) & 3);
    SBAR(); qkt(pB0, pB1, KBUF(j), qr, r32, hi);
    finishSM(pA0, pA1, alA, l_reg, pa0, pa1, pa2, pa3); SGB_A(); SBAR();
    pv_d0(o, VBUF(j - 1), pa0, pa1, pa2, pa3); PSM(pB0, pB1, mnB, alB, j);
    RESC(alB); ENDSTEP(j);
    if (j + 3 < NT) DMA(j + 3, (j + 3) & 3);
    SBAR(); qkt(pA0, pA1, KBUF(j + 1), qr, r32, hi);
    finishSM(pB0, pB1, alB, l_reg, pa0, pa1, pa2, pa3); SGB_A(); SBAR();
    pv_d0(o, VBUF(j), pa0, pa1, pa2, pa3); PSM(pA0, pA1, mnA, alA, j + 1);
    RESC(alA); ENDSTEP(j + 1);
  }
  SBAR(); qkt(pB0, pB1, KBUF(NT - 1), qr, r32, hi);
  finishSM(pA0, pA1, alA, l_reg, pa0, pa1, pa2, pa3); SBAR();
  pv_d0(o, VBUF(NT - 2), pa0, pa1, pa2, pa3); PSM(pB0, pB1, mnB, alB, NT - 1);
  RESC(alB);
  finishSM(pB0, pB1, alB, l_reg, pa0, pa1, pa2, pa3); SBAR();
  pv_d0(o, VBUF(NT - 1), pa0, pa1, pa2, pa3);
  }
  if (hi == 0) li_l[r32] = l_reg; asm volatile("s_waitcnt lgkmcnt(0)" ::: "memory");
  if constexpr (DIL) { if (hi == 0) lse_o[(long)(wid * QBLK + r32) * lse_s] = m_reg + __log2f(l_reg); }
  float rli[16];
#pragma unroll
  for (int r = 0; r < 16; ++r) rli[r] = __builtin_amdgcn_rcpf(li_l[crow(r, hi)]);
  bf16* Ow = Ob + (long)(wid * QBLK) * os;
#pragma unroll
  for (int r = 0; r < 16; ++r) { const int orow = crow(r, hi);
#pragma unroll
    for (int d0 = 0; d0 < 4; ++d0) Ow[(long)orow * os + d0 * 32 + r32] = __float2bfloat16(o[d0][r] * rli[r]); }
  asm volatile("s_waitcnt lgkmcnt(0)\n\ts_barrier" ::: "memory");
#undef KROW
#undef DMA
#undef ENDSTEP
#undef RESC
#undef PSM
#undef KBUF
#undef SGB_A
#undef VBUF
}
}

#define GAS __attribute__((address_space(1)))
#define LAS __attribute__((address_space(3)))
typedef unsigned short bf16_t;
typedef unsigned v4u __attribute__((ext_vector_type(4)));
typedef unsigned v2u __attribute__((ext_vector_type(2)));
typedef float f32x4 __attribute__((ext_vector_type(4)));
#define LDS_WAIT() asm volatile("s_waitcnt lgkmcnt(0)" ::: "memory")

constexpr size_t MiB = 1u << 20;
constexpr size_t WS_W1T = 0;
constexpr size_t WS_W2T = 104 * MiB;
constexpr size_t WS_H = 136 * MiB;
constexpr size_t WS_PROJ = 200 * MiB;
constexpr size_t WS_YA = 408 * MiB;
constexpr size_t WS_YB = 440 * MiB;
constexpr size_t WS_LSE = 536 * MiB;
constexpr size_t WS_ROPE = 538 * MiB;
constexpr size_t WS_XB = 540 * MiB;
constexpr size_t WS_ROWSQ = 604 * MiB;
constexpr size_t WS_END = 616 * MiB;
static_assert((size_t)DEPTH * DIN * DM * 2 <= WS_W2T - WS_W1T && (size_t)M * DIN * 2 <= WS_YA - WS_PROJ && (size_t)3 * M * DB * 2 <= WS_LSE - WS_YB, "ws map");
constexpr int LDS_BYTES = 147456;
constexpr int N_PHASES = 2 + 5 * DEPTH;

__device__ __forceinline__ unsigned f2bf(float f) { unsigned u = __builtin_bit_cast(unsigned, f); return (u + 0x7fffu + ((u >> 16) & 1u)) >> 16; }
__device__ __forceinline__ unsigned pk2(float lo, float hi) { return f2bf(lo) | (f2bf(hi) << 16); }
__device__ __forceinline__ float bflo(unsigned w) { return __uint_as_float(w << 16); }
__device__ __forceinline__ float bfhi(unsigned w) { return __uint_as_float(w & 0xffff0000u); }
__device__ __forceinline__ float wave_sum(float v) {
#pragma unroll
    for (int o = 1; o < 64; o <<= 1) v += __shfl_xor(v, o);
    return v;
}

__device__ const float INV_FREQ[32] = {1.000000000e+00f, 7.498942614e-01f, 5.623413324e-01f, 4.216965139e-01f, 3.162277639e-01f, 2.371373773e-01f, 1.778279394e-01f, 1.333521307e-01f,
    1.000000015e-01f, 7.498941571e-02f, 5.623413250e-02f, 4.216965288e-02f, 3.162277490e-02f, 2.371373773e-02f, 1.778279431e-02f, 1.333521493e-02f,
    9.999999776e-03f, 7.498941850e-03f, 5.623413250e-03f, 4.216964822e-03f, 3.162277630e-03f, 2.371373586e-03f, 1.778279431e-03f, 1.333521446e-03f,
    1.000000047e-03f, 7.498942432e-04f, 5.623413017e-04f, 4.216965172e-04f, 3.162277571e-04f, 2.371373703e-04f, 1.778279402e-04f, 1.333521504e-04f};

__device__ __forceinline__ void sincos_acc(float a, float& s, float& c) {
    const double x = (double)a, kd = __builtin_rint(x * 0.63661977236758134308);
    const int k = (int)kd; const double r = x - kd * 1.57079632679489661923, r2 = r * r;
    const double sp = r * (1.0 + r2 * (-1.0 / 6 + r2 * (1.0 / 120 + r2 * (-1.0 / 5040 + r2 * (1.0 / 362880 + r2 * (-1.0 / 39916800 + r2 * (1.0 / 6227020800.0)))))));
    const double cp = 1.0 + r2 * (-0.5 + r2 * (1.0 / 24 + r2 * (-1.0 / 720 + r2 * (1.0 / 40320 + r2 * (-1.0 / 3628800 + r2 * (1.0 / 479001600.0 + r2 * (-1.0 / 87178291200.0)))))));
    const int q = k & 3;
    const double sv = (q == 0) ? sp : (q == 1) ? cp : (q == 2) ? -sp : -cp, cv = (q == 0) ? cp : (q == 1) ? -sp : (q == 2) ? -cp : sp;
    s = (float)sv; c = (float)cv;
}

__device__ __forceinline__ void p0_transpose_item(const float* W, int K, int N, bf16_t* WT, LAS float* scr, int item, int lane, const float* kscale) {
    const int nblk = N / 32, kb = item / nblk, nb = item % nblk, k0 = 64 * kb, n0 = 32 * nb;
#pragma unroll 8
    for (int i = 0; i < 32; ++i) { const int kk = 2 * i + (lane >> 5); scr[kk * 33 + (lane & 31)] = W[(size_t)(k0 + kk) * N + n0 + (lane & 31)] * (kscale ? kscale[k0 + kk] : 1.0f); }
    LDS_WAIT(); asm volatile("" ::: "memory");
    const int c = lane & 7;
#pragma unroll
    for (int j = 0; j < 4; ++j) { const int n = (lane >> 3) + 8 * j; const LAS float* s = scr + (8 * c) * 33 + n;
        v4u o; o.x = pk2(s[0 * 33], s[1 * 33]); o.y = pk2(s[2 * 33], s[3 * 33]); o.z = pk2(s[4 * 33], s[5 * 33]); o.w = pk2(s[6 * 33], s[7 * 33]);
        *(v4u*)(WT + (size_t)(n0 + n) * K + k0 + 8 * c) = o; }
    LDS_WAIT(); asm volatile("" ::: "memory");
}

#define XB_TMO      128
#define XB_XCNT(j)  (256  + 64 * (j))
#define XB_XSUB(j)  (1280 + 64 * (j))
#define XB_XGEN(j)  (2304 + 64 * (j))
#define XB_TOP      3328
#define XB_TOPGEN   3392
#define XCD_BAR_WORDS 3456
#define XB_SPIN_CAP (1u << 18)

__device__ __forceinline__ unsigned xb_ld(unsigned* p)              { return __hip_atomic_load(p, __ATOMIC_RELAXED, __HIP_MEMORY_SCOPE_AGENT); }
__device__ __forceinline__ unsigned xb_add(unsigned* p, unsigned v) { return __hip_atomic_fetch_add(p, v, __ATOMIC_RELAXED, __HIP_MEMORY_SCOPE_AGENT); }
__device__ __forceinline__ unsigned xb_xcc_id() { return (unsigned)__builtin_amdgcn_s_getreg((3 << 11) | 20) & 0xFu; }
#define XB_SPIN(cond, bar) do { unsigned _sp = 0; while (cond) { __builtin_amdgcn_s_sleep(1); \
    if ((++_sp & 255u) == 0u) { if (xb_ld(&(bar)[XB_TMO])) break; if (_sp > XB_SPIN_CAP) { atomicAdd(&(bar)[XB_TMO], 1u); break; } } } } while (0)

struct XcdBarrier {
    unsigned* bar; unsigned x;
    volatile LAS unsigned* st;
};

__device__ __forceinline__ XcdBarrier xcd_barrier_post(unsigned* bar, volatile LAS unsigned* st) {
    XcdBarrier b; b.bar = bar; b.x = xb_xcc_id(); b.st = st;
    if (threadIdx.x == 0) (void)xb_add(&bar[XB_XCNT(b.x)], 1u);
    return b;
}
__device__ __forceinline__ void xcd_barrier_complete(unsigned* bar, unsigned x, unsigned& nloc, unsigned& nx) {
    const unsigned G = gridDim.x * gridDim.y * gridDim.z;
    unsigned sum, cnt, mine, sp = 0u;
    for (;;) {
        sum = 0u; cnt = 0u; mine = 0u;
#pragma unroll
        for (unsigned j = 0; j < 16; ++j) { const unsigned c = xb_ld(&bar[XB_XCNT(j)]); sum += c; cnt += (c > 0u) ? 1u : 0u; mine = (j == x) ? c : mine; }
        if (sum == G) break;
        __builtin_amdgcn_s_sleep(1);
        if ((++sp & 255u) == 0u) { if (xb_ld(&bar[XB_TMO])) break; if (sp > XB_SPIN_CAP) { atomicAdd(&bar[XB_TMO], 1u); break; } }
    }
    nloc = mine > 0u ? mine : 1u; nx = cnt > 0u ? cnt : 1u;
}

__device__ __forceinline__ void xcd_barrier(const XcdBarrier& b) {
    asm volatile("s_waitcnt vmcnt(0)" ::: "memory");
    __syncthreads();
    if (threadIdx.x == 0) {
        unsigned* bar = b.bar;
        __builtin_amdgcn_s_waitcnt(0);
        unsigned nloc = b.st[0], nx = b.st[1];
        if (nloc == 0u) { xcd_barrier_complete(bar, b.x, nloc, nx); b.st[0] = nloc; b.st[1] = nx; }
        const unsigned old = xb_add(&bar[XB_XSUB(b.x)], 1u);
        const unsigned gen = old / nloc;
        if (old + 1u == (gen + 1u) * nloc) {
            __builtin_amdgcn_fence(__ATOMIC_RELEASE, "agent");
            asm volatile("s_waitcnt vmcnt(0)" ::: "memory");
            const unsigned og = xb_add(&bar[XB_TOP], 1u);
            const unsigned tg = og / nx;
            if (og + 1u == (tg + 1u) * nx) xb_add(&bar[XB_TOPGEN], 1u);
            else XB_SPIN(xb_ld(&bar[XB_TOPGEN]) == tg, bar);
            __builtin_amdgcn_fence(__ATOMIC_ACQUIRE, "agent");
            xb_add(&bar[XB_XGEN(b.x)], 1u);
            asm volatile("s_waitcnt vmcnt(0)" ::: "memory");
        } else {
            XB_SPIN(xb_ld(&bar[XB_XGEN(b.x)]) == gen, bar);
            __builtin_amdgcn_fence(__ATOMIC_ACQUIRE, "agent");
            asm volatile("s_waitcnt vmcnt(0)" ::: "memory");
        }
    }
    __syncthreads();
}

constexpr size_t WS_CTL = 539 * MiB, CTL_BYTES = 16384;
constexpr int MISC_OFF = 147456 - 128;
struct Params { const float *x, *norm_w, *w_in, *qn, *kn, *ona, *onb, *w_out, *fnorm; float* out; unsigned char* ws; int ph_lo, ph_hi; };

__global__ void __launch_bounds__(512, 2) mk_fwd(Params p) {
    extern __shared__ __attribute__((aligned(16))) unsigned char lds[];
    volatile LAS unsigned* MISC = (volatile LAS unsigned*)((LAS unsigned char*)lds + MISC_OFF);
    if (threadIdx.x < 32) MISC[threadIdx.x] = 0u;
    __syncthreads();
    XcdBarrier bar = xcd_barrier_post((unsigned*)(p.ws + WS_CTL), MISC + 8);
    for (int ph = p.ph_lo; ph < p.ph_hi; ++ph) {
        const int tid = otid(), lane = tid & 63, wave = __builtin_amdgcn_readfirstlane(tid >> 6);
        int G = gridDim.x, bx = blockIdx.x; asm volatile("" : "+s"(G), "+s"(bx));
        const int vcu = (G % 8 == 0) ? (bx % 8) * (G / 8) + bx / 8 : bx;
        const int gw = vcu * 8 + wave, NGW = G * 8;
        size_t zoff = 0; asm volatile("" : "+s"(zoff));
        unsigned char* ws = p.ws + zoff;
        bf16_t* W1T = (bf16_t*)(ws + WS_W1T); bf16_t* W2T = (bf16_t*)(ws + WS_W2T); bf16_t* H = (bf16_t*)(ws + WS_H); bf16_t* PROJ = (bf16_t*)(ws + WS_PROJ);
        bf16_t* YA = (bf16_t*)(ws + WS_YA); bf16_t* YB = (bf16_t*)(ws + WS_YB); float* LSE = (float*)(ws + WS_LSE);
        float* RCOS = (float*)(ws + WS_ROPE); float* RSIN = RCOS + 192 * 32;
        bf16_t* XB = (bf16_t*)(ws + WS_XB); float* ROWSQ = (float*)(ws + WS_ROWSQ);
        if (ph == 0) {
            LAS float* scr = (LAS float*)((LAS unsigned char*)lds + wave * 16384);
            constexpr int I1 = (DM / 64) * (DIN / 32), I2 = (DM / 64) * (DM / 32), IL = I1 + I2;
            DUPREP(0) for (int it = gw; it < DEPTH * IL; it += NGW) {
                const int l = it / IL, r = it % IL;
                if (r < I1) p0_transpose_item(p.w_in + (size_t)l * DM * DIN, DM, DIN, W1T + (size_t)l * DIN * DM, scr, r, lane, p.norm_w + (size_t)l * DM);
                else p0_transpose_item(p.w_out + (size_t)l * DM * DM, DM, DM, W2T + (size_t)l * DM * DM, scr, r - I1, lane, nullptr);
            }
            for (int m = gw; m < M; m += NGW) {
                const f32x4* xr = (const f32x4*)(p.x + (size_t)m * DM) + lane; v2u* o8 = (v2u*)(XB + (size_t)m * DM) + lane; float sq = 0.f;
#pragma unroll
                for (int j = 0; j < 8; ++j) { const f32x4 v = xr[64 * j]; v2u w; w.x = pk2(v.x, v.y); w.y = pk2(v.z, v.w); o8[64 * j] = w;
                    const float r0 = bflo(w.x), r1 = bfhi(w.x), r2 = bflo(w.y), r3 = bfhi(w.y); sq += (r0 * r0 + r1 * r1) + (r2 * r2 + r3 * r3); }
                sq = wave_sum(sq); if (lane < 32) ROWSQ[(size_t)m * 32 + lane] = (lane == 0) ? sq : 0.f;
            }
            for (int i = gw * 64 + lane; i < 192 * 32; i += NGW * 64) {
                const int pos = i >> 5, f = i & 31; const float pv = (float)(pos < 128 ? pos : pos - 128);
                float s, c; sincos_acc(pv * INV_FREQ[f], s, c); RCOS[i] = c; RSIN[i] = s;
            }
        } else if (ph == N_PHASES - 1) {
            for (int m = gw; m < M; m += NGW) {
                f32x4* xr = (f32x4*)(p.out + (size_t)m * DM) + lane; const f32x4* wr_ = (const f32x4*)p.fnorm + lane; const v2u* xb8 = (const v2u*)(XB + (size_t)m * DM) + lane;
                const float rstd = 1.0f / sqrtf(wave_sum(lane < 32 ? ROWSQ[((size_t)DEPTH * M + m) * 32 + lane] : 0.f) * (1.0f / DM) + EPS);
#pragma unroll
                for (int j = 0; j < 8; ++j) { const v2u w = xb8[64 * j]; const f32x4 v = {bflo(w.x), bfhi(w.x), bflo(w.y), bfhi(w.y)}; xr[64 * j] = v * rstd * wr_[64 * j]; }
            }
        } else {
            const int l = (ph - 1) / 5, st = (ph - 1) % 5 + 1;
            if (st == 1) {
                pg8::Gemm g{XB, W1T + (size_t)l * DIN * DM, M, DIN, DM}; pg8::StaticOrder S; S.init(M, DIN, G, bx);
                pg8::EpiHeadMajor E{PROJ, M, ROWSQ + (size_t)l * M * 32, 1.0f / DM, EPS};
#ifndef MK_NO_G1
                DUPREP(2) pg8::gemm_phase<pg8::EpiHeadMajor, pg8::StaticOrder, PG8_ALIGN, PG8_SP2>((PG8_LAS unsigned char*)lds, g, S, E);
#endif
            } else if (st == 2) {
                const float* qg = p.qn + l * HD; const float* kg = p.kn + l * HD;
                for (int it = gw; it < M * 10 / 4; it += NGW) {
                    const int g = it * 4 + (lane >> 4), row = g / 10, hs = g - row * 10;
                    const int j = lane & 15, half = j >> 3, jj = j & 7, e = half * 64 + 4 * jj;
                    bf16_t* pp = PROJ + ((size_t)hs * M + row) * HD + e;
                    const v2u a = *(const v2u*)pp, b = *(const v2u*)(pp + 32);
                    float x1[4] = {bflo(a.x), bfhi(a.x), bflo(a.y), bfhi(a.y)}, x2[4] = {bflo(b.x), bfhi(b.x), bflo(b.y), bfhi(b.y)};
                    float ss = 0.f;
#pragma unroll
                    for (int i = 0; i < 4; ++i) ss += x1[i] * x1[i] + x2[i] * x2[i];
                    ss += __shfl_xor(ss, 1); ss += __shfl_xor(ss, 2); ss += __shfl_xor(ss, 4); ss += __shfl_xor(ss, 8);
                    const float rstd = 1.0f / sqrtf(ss * (1.0f / HD) + EPS);
                    const float* gn = (hs < 8) ? qg : kg;
                    const f32x4 g1 = *(const f32x4*)(gn + e), g2 = *(const f32x4*)(gn + e + 32);
                    const int t = row & (T - 1), pos = half ? 128 + (t & 63) : (t >> 6);
                    const f32x4 cs = *(const f32x4*)(RCOS + pos * 32 + 4 * jj), sn = *(const f32x4*)(RSIN + pos * 32 + 4 * jj);
                    float o1[4], o2[4];
#pragma unroll
                    for (int i = 0; i < 4; ++i) { const float y1 = x1[i] * rstd * g1[i], y2 = x2[i] * rstd * g2[i]; o1[i] = y1 * cs[i] - y2 * sn[i]; o2[i] = y1 * sn[i] + y2 * cs[i]; }
                    v2u w1, w2; w1.x = pk2(o1[0], o1[1]); w1.y = pk2(o1[2], o1[3]); w2.x = pk2(o2[0], o2[1]); w2.y = pk2(o2[2], o2[3]);
                    *(v2u*)pp = w1; *(v2u*)(pp + 32) = w2;
                }
#ifndef MK_NO_DIL
                DUPREP(3) for (int u = vcu; u < 1536; u += G) {
                    const int pt = u >> 9, rem = u & 511, b = rem >> 8, h = (rem >> 5) & 7, w = rem & 31;
                    const int d = (pt == 0) ? 1 : (pt == 1) ? 4 : 16, res = w & (d - 1), blk = w / d, i0 = blk * 256, nsub = T / d;
                    const float slope = __builtin_amdgcn_exp2f(-(float)(h + 1));
                    const float nslopeC = -slope * (float)d * att::LOG2E;
                    const size_t tok0 = (size_t)b * T + res;
                    const att::bf16* Pb = (const att::bf16*)PROJ + ((size_t)h * M + tok0) * HD;
                    const long rs = (long)d * HD;
                    att::attn_body<true>(Pb + (size_t)H_QB * M * HD + (long)i0 * rs, Pb + (size_t)H_KB * M * HD, Pb + (size_t)H_VB * M * HD, rs, rs,
                                         (att::bf16*)YB + ((size_t)pt * M + tok0 + (size_t)i0 * d) * DB + h * HD, (long)d * DB,
                                         LSE + ((size_t)pt * M + tok0 + (size_t)i0 * d) * 8 + h, d * 8, i0, nsub, nslopeC, 0, (char*)lds);
                }
#endif
            } else if (st == 3) {
#ifndef MK_NO_DENSE
                DUPREP(4) for (int u = vcu; u < 512; u += G) {
                    const int combo = u >> 7, b = combo >> 1, kvh = combo & 1, h = kvh * 4 + ((u >> 5) & 3), qb = u & 31;
                    const att::bf16* Pb = (const att::bf16*)PROJ + (size_t)b * T * HD;
                    att::attn_body<false>(Pb + ((size_t)(H_QA + h) * M + qb * 256) * HD, Pb + (size_t)(H_KA + kvh) * M * HD, Pb + (size_t)(H_VA + kvh) * M * HD, HD, HD,
                                          (att::bf16*)YA + ((size_t)b * T + qb * 256) * DA + h * HD, DA, nullptr, 0, 0, 0, 0.f, T, (char*)lds);
                }
#endif
            } else if (st == 4) {
                const float* wa = p.ona + (size_t)l * DA; const float* wb = p.onb + (size_t)l * DB;
                DUPREP(5) for (int m = gw; m < M; m += NGW) {
                    float ya[2][8], yb[2][8]; float ssa = 0.f, ssb = 0.f;
#pragma unroll
                    for (int j = 0; j < 2; ++j) { const int c = lane + 64 * j, hh = c >> 4;
                        const v4u a = *(const v4u*)(YA + (size_t)m * DA + 8 * c);
                        ya[j][0] = bflo(a.x); ya[j][1] = bfhi(a.x); ya[j][2] = bflo(a.y); ya[j][3] = bfhi(a.y); ya[j][4] = bflo(a.z); ya[j][5] = bfhi(a.z); ya[j][6] = bflo(a.w); ya[j][7] = bfhi(a.w);
                        const float l0 = LSE[((size_t)0 * M + m) * 8 + hh], l1 = LSE[((size_t)1 * M + m) * 8 + hh], l2 = LSE[((size_t)2 * M + m) * 8 + hh];
                        const float mx = fmaxf(l0, fmaxf(l1, l2)); const float e0 = __builtin_amdgcn_exp2f(l0 - mx), e1 = __builtin_amdgcn_exp2f(l1 - mx), e2 = __builtin_amdgcn_exp2f(l2 - mx);
                        const float inv = 1.0f / (e0 + e1 + e2); const float w0 = e0 * inv, w1 = e1 * inv, w2 = e2 * inv;
                        const v4u b0 = *(const v4u*)(YB + ((size_t)0 * M + m) * DB + 8 * c), b1 = *(const v4u*)(YB + ((size_t)1 * M + m) * DB + 8 * c), b2 = *(const v4u*)(YB + ((size_t)2 * M + m) * DB + 8 * c);
                        yb[j][0] = w0 * bflo(b0.x) + w1 * bflo(b1.x) + w2 * bflo(b2.x); yb[j][1] = w0 * bfhi(b0.x) + w1 * bfhi(b1.x) + w2 * bfhi(b2.x);
                        yb[j][2] = w0 * bflo(b0.y) + w1 * bflo(b1.y) + w2 * bflo(b2.y); yb[j][3] = w0 * bfhi(b0.y) + w1 * bfhi(b1.y) + w2 * bfhi(b2.y);
                        yb[j][4] = w0 * bflo(b0.z) + w1 * bflo(b1.z) + w2 * bflo(b2.z); yb[j][5] = w0 * bfhi(b0.z) + w1 * bfhi(b1.z) + w2 * bfhi(b2.z);
                        yb[j][6] = w0 * bflo(b0.w) + w1 * bflo(b1.w) + w2 * bflo(b2.w); yb[j][7] = w0 * bfhi(b0.w) + w1 * bfhi(b1.w) + w2 * bfhi(b2.w);
#pragma unroll
                        for (int i = 0; i < 8; ++i) { ssa += ya[j][i] * ya[j][i]; ssb += yb[j][i] * yb[j][i]; } }
                    const float ra = 1.0f / sqrtf(wave_sum(ssa) * (1.0f / DA) + EPS), rb = 1.0f / sqrtf(wave_sum(ssb) * (1.0f / DB) + EPS);
#pragma unroll
                    for (int j = 0; j < 2; ++j) { const int c = lane + 64 * j;
                        const v4u ga = *(const v4u*)(PROJ + ((size_t)(H_GA + (c >> 4)) * M + m) * HD + 8 * (c & 15)), gb = *(const v4u*)(PROJ + ((size_t)(H_GB + (c >> 4)) * M + m) * HD + 8 * (c & 15));
                        const float gaf[8] = {bflo(ga.x), bfhi(ga.x), bflo(ga.y), bfhi(ga.y), bflo(ga.z), bfhi(ga.z), bflo(ga.w), bfhi(ga.w)};
                        const float gbf[8] = {bflo(gb.x), bfhi(gb.x), bflo(gb.y), bfhi(gb.y), bflo(gb.z), bfhi(gb.z), bflo(gb.w), bfhi(gb.w)};
                        const f32x4 wa0 = *(const f32x4*)(wa + 8 * c), wa1 = *(const f32x4*)(wa + 8 * c + 4), wb0 = *(const f32x4*)(wb + 8 * c), wb1 = *(const f32x4*)(wb + 8 * c + 4);
                        float za[8], zb[8];
#pragma unroll
                        for (int i = 0; i < 8; ++i) { const float wai = i < 4 ? wa0[i & 3] : wa1[i & 3], wbi = i < 4 ? wb0[i & 3] : wb1[i & 3];
                            const float sa = gaf[i] / (1.0f + __expf(-gaf[i])), sb = gbf[i] / (1.0f + __expf(-gbf[i]));
                            za[i] = ya[j][i] * ra * wai * sa; zb[i] = yb[j][i] * rb * wbi * sb; }
                        v4u oa, ob; oa.x = pk2(za[0], za[1]); oa.y = pk2(za[2], za[3]); oa.z = pk2(za[4], za[5]); oa.w = pk2(za[6], za[7]);
                        ob.x = pk2(zb[0], zb[1]); ob.y = pk2(zb[2], zb[3]); ob.z = pk2(zb[4], zb[5]); ob.w = pk2(zb[6], zb[7]);
                        *(v4u*)(H + (size_t)m * DM + 8 * c) = oa; *(v4u*)(H + (size_t)m * DM + DA + 8 * c) = ob; }
                }
            } else {
                pg8::Gemm g{H, W2T + (size_t)l * DM * DM, M, DM, DM}; pg8::StaticOrder S; S.init(M, DM, G, bx);
                pg8::EpiResF32 E{XB, ROWSQ + (size_t)(l + 1) * M * 32, DM};
#ifndef MK_NO_G2
                pg8::gemm_phase<pg8::EpiResF32, pg8::StaticOrder, PG8_ALIGN, PG8_SP2>((PG8_LAS unsigned char*)lds, g, S, E);
#endif
            }
        }
        if (ph + 1 < p.ph_hi) { if (ph == 0) cg::this_grid().sync(); else xcd_barrier(bar); if (MK_DUP & 64) xcd_barrier(bar); }
    }
}

extern "C" void kernel_launch(void* const* d_in, const int* in_sizes, int n_in, void* d_out, int out_size, void* d_ws, size_t ws_size, hipStream_t stream) {
    static int grid = 0;
    if (grid == 0) {
        if (n_in != 9 || in_sizes[0] != M * DM || out_size != M * DM || ws_size < WS_END) { fprintf(stderr, "kernel_launch: unexpected shapes (n_in %d, ws %zu)\n", n_in, ws_size); grid = -1; return; }
        int dev = 0, cus = 0, per_cu = 0;
        hipGetDevice(&dev); hipDeviceGetAttribute(&cus, hipDeviceAttributeMultiprocessorCount, dev);
        if (hipFuncSetAttribute((const void*)mk_fwd, hipFuncAttributeMaxDynamicSharedMemorySize, LDS_BYTES) != hipSuccess) { fprintf(stderr, "kernel_launch: hipFuncSetAttribute failed\n"); grid = -1; return; }
        if (hipOccupancyMaxActiveBlocksPerMultiprocessor(&per_cu, (const void*)mk_fwd, 512, LDS_BYTES) != hipSuccess || per_cu < 1) per_cu = 1;
        (void)hipGetLastError();
        grid = cus * per_cu;
    }
    if (grid < 0) return;
    Params p{};
    p.x = (const float*)d_in[0]; p.norm_w = (const float*)d_in[1]; p.w_in = (const float*)d_in[2]; p.qn = (const float*)d_in[3]; p.kn = (const float*)d_in[4];
    p.ona = (const float*)d_in[5]; p.onb = (const float*)d_in[6]; p.w_out = (const float*)d_in[7]; p.fnorm = (const float*)d_in[8];
    p.out = (float*)d_out; p.ws = (unsigned char*)d_ws;
    if (hipMemsetAsync((char*)d_ws + WS_CTL, 0, CTL_BYTES, stream) != hipSuccess) { fprintf(stderr, "kernel_launch: memset failed\n"); return; }
#if MK_ONE_LAUNCH
    p.ph_lo = 0; p.ph_hi = N_PHASES;
    void* args[] = {&p};
    hipError_t e = hipLaunchCooperativeKernel((const void*)mk_fwd, dim3(grid), dim3(512), args, LDS_BYTES, stream);
    if (e != hipSuccess) fprintf(stderr, "kernel_launch: cooperative launch failed: %s (grid %d)\n", hipGetErrorString(e), grid);
#else
    for (int ph = 0; ph < N_PHASES; ++ph) { p.ph_lo = ph; p.ph_hi = ph + 1; hipLaunchKernelGGL(mk_fwd, dim3(grid), dim3(512), LDS_BYTES, stream, p); }
#endif
}
```

```cpp
#include <hip/hip_runtime.h>
#include <hip/hip_bf16.h>
#include <hip/hip_cooperative_groups.h>
#include <cstdio>
#include <cstdint>
namespace cg = cooperative_groups;

#ifndef MK_DUP
#define MK_DUP 0
#endif
#define DUPREP(k) for (int rep_ = 0; rep_ < 1 + ((MK_DUP >> (k)) & 1); ++rep_)
#ifndef MK_PVPIPE
#define MK_PVPIPE 1
#endif
#ifndef MK_SGB
#define MK_SGB 0
#endif
#ifndef MK_PP
#define MK_PP 1
#endif
#ifndef MK_ONE_LAUNCH
#define MK_ONE_LAUNCH 1
#endif

constexpr int BATCH = 2, T = 8192, DM = 2048, DEPTH = 4, HD = 128, DA = 1024, DB = 1024, DIN = 6656, M = BATCH * T;
constexpr int C_QA = 0, C_KA = 1024, C_VA = 1280, C_GA = 1536, C_QB = 2560, C_KB = 3584, C_VB = 4608, C_GB = 5632;
constexpr int H_QA = 0, H_KA = 8, H_VA = 10, H_GA = 12, H_QB = 20, H_KB = 28, H_VB = 36, H_GB = 44;
constexpr float EPS = 1e-6f;
__device__ __forceinline__ int otid() { int t = threadIdx.x; asm volatile("" : "+v"(t)); return t; }

namespace pg8 {
#define PG8_LAS __attribute__((address_space(3)))
typedef unsigned short bf16_t;
typedef short bf16x8 __attribute__((ext_vector_type(8)));
typedef float f32x4 __attribute__((ext_vector_type(4)));
typedef unsigned u32x4 __attribute__((ext_vector_type(4)));
constexpr int BM = 256, BK = 64, HALF = 128, HTB = HALF * BK * 2  , STAGE_BYTES = 8 * HTB, NXCD = 8, WGM = 8;

__host__ __device__ __forceinline__ int lds_byte(int r, int c) { const int st = (r >> 4) * 2 + (c >> 5), rr = r & 15, cc = c & 31, ob = rr * 64 + cc * 2; return st * 1024 + (ob ^ (((ob >> 9) & 1) << 5)); }
__host__ __device__ __forceinline__ void stage_rc(int b, int& R, int& C) { const int st = b / 1024, sb = b % 1024, swz = sb ^ (((sb >> 9) & 1) << 5); R = (st >> 1) * 16 + swz / 64; C = (st & 1) * 32 + (swz % 64) / 2; }
__host__ __device__ __forceinline__ int perm32(int rho) { const int n = rho >> 4, i = rho & 15; return 8 * (i >> 2) + 4 * n + (i & 3); }

struct Unit { int pm, pn; };
struct Gemm { const bf16_t* A; const bf16_t* Bt; int M, N, K; };

struct StaticOrder {
    int nM, nN, nwg, G, c;
    __host__ __device__ void init(int M, int N, int G_, int c_) { nM = M / BM; nN = N / BM; nwg = nM * nN; G = G_; c = c_; }
    __host__ __device__ bool next(int i, Unit& u) const {
        const long L = (long)i * G + c; if (L >= nwg) return false;
        int wgid = (int)L; { const int q = nwg / NXCD, r = nwg % NXCD, xcd = wgid % NXCD, off = wgid / NXCD; wgid = (xcd < r ? xcd * (q + 1) : r * (q + 1) + (xcd - r) * q) + off; }
        const int nig = WGM * nN, gid = wgid / nig, fm = gid * WGM, gsz = (nM - fm) < WGM ? (nM - fm) : WGM;
        u.pm = fm + ((wgid % nig) % gsz); u.pn = (wgid % nig) / gsz; return true;
    }
    __device__ __forceinline__ void a_ready(const Unit&) const {}
    __device__ __forceinline__ void done(const Unit&) const {}
};

__device__ __forceinline__ unsigned cvt_pk_bf16(float lo, float hi) { unsigned r; asm volatile("v_cvt_pk_bf16_f32 %0, %1, %2" : "=v"(r) : "v"(lo), "v"(hi)); return r; }
typedef float f32x2 __attribute__((ext_vector_type(2)));
__device__ __forceinline__ f32x2 gelu_pk(f32x2 v) {
    const f32x2 av = __builtin_elementwise_abs(v), d = av * 0.2316418882f + 1.0f;
    f32x2 t; t.x = __builtin_amdgcn_rcpf(d.x); t.y = __builtin_amdgcn_rcpf(d.y);
    f32x2 q = t * 0.5307027145f + (-0.7265760135f); q = q * t + 0.7107068705f; q = q * t + (-0.142248368f); q = q * t + 0.127414796f; q = q * t;
    const f32x2 s = (v * v) * (-0.72134752044f);
    f32x2 e; e.x = __builtin_amdgcn_exp2f(s.x); e.y = __builtin_amdgcn_exp2f(s.y);
    const f32x2 m = v * (q * e), r = v - m;
    f32x2 o; o.x = v.x < 0.f ? m.x : r.x; o.y = v.y < 0.f ? m.y : r.y; return o;
}

template <int ACT  > struct EpiBf16 {
    static constexpr bool PERM = true, AFTER_DRAIN = false; static_assert(ACT == 0 || ACT == 1, "EpiBf16: ACT is 0 (none) or 1 (gelu_pk)");
    bf16_t* O; int ldc; const float* bias; int split_cols; size_t split_stride; float scale0;
    __device__ __forceinline__ void operator()(const f32x4 (&acc)[2][2][4][2], const Unit& u, int wr, int wc, int fr, int fq) const {
        const int row0 = u.pm * BM + wr * 64 + fr; int colt = u.pn * BM; bf16_t* base = O;
        float sc = 1.f; if (split_cols) { const int t = colt / split_cols; base += (size_t)t * split_stride; colt -= t * split_cols; if (t == 0) sc = scale0; }
        const int col0 = colt + wc * 32 + 8 * fq, bcol0 = u.pn * BM + wc * 32 + 8 * fq;
        f32x4 bv[2][2];
#pragma unroll
        for (int bj = 0; bj < 2; ++bj)
#pragma unroll
            for (int n = 0; n < 2; ++n) bv[bj][n] = bias ? *(const f32x4*)(bias + bcol0 + bj * HALF + 4 * n) : (f32x4){0.f, 0.f, 0.f, 0.f};
#pragma unroll
        for (int ai = 0; ai < 2; ++ai)
#pragma unroll
            for (int m = 0; m < 4; ++m) { bf16_t* rowp = base + (size_t)(row0 + ai * HALF + m * 16) * ldc + col0;
#pragma unroll
                for (int bj = 0; bj < 2; ++bj) { f32x4 v0 = acc[ai][bj][m][0] + bv[bj][0], v1 = acc[ai][bj][m][1] + bv[bj][1];
                    if (ACT == 1) { f32x2 a = gelu_pk((f32x2){v0[0], v0[1]}), b = gelu_pk((f32x2){v0[2], v0[3]}), c = gelu_pk((f32x2){v1[0], v1[1]}), d = gelu_pk((f32x2){v1[2], v1[3]});
                        v0 = (f32x4){a.x, a.y, b.x, b.y}; v1 = (f32x4){c.x, c.y, d.x, d.y}; }
                    v0 = v0 * sc; v1 = v1 * sc; u32x4 w; w.x = cvt_pk_bf16(v0[0], v0[1]); w.y = cvt_pk_bf16(v0[2], v0[3]); w.z = cvt_pk_bf16(v1[0], v1[1]); w.w = cvt_pk_bf16(v1[2], v1[3]);
                    *(u32x4*)(rowp + bj * HALF) = w; } }
    }
};
struct EpiHeadMajor {
    static constexpr bool PERM = true, AFTER_DRAIN = false;
    bf16_t* O; int Mrows; const float* rowsq; float inv_k, eps;
    __device__ __forceinline__ void operator()(const f32x4 (&acc)[2][2][4][2], const Unit& u, int wr, int wc, int fr, int fq) const {
        const int row0 = u.pm * BM + wr * 64 + fr, col0 = wc * 32 + 8 * fq;
#pragma unroll
        for (int ai = 0; ai < 2; ++ai) {
            f32x4 pa[4], pb[4];
#pragma unroll
            for (int m = 0; m < 4; ++m) { const f32x4* pp = (const f32x4*)(rowsq + (size_t)(row0 + ai * HALF + m * 16) * 32 + 8 * fq); pa[m] = pp[0]; pb[m] = pp[1]; }
#pragma unroll
            for (int m = 0; m < 4; ++m) { const int row = row0 + ai * HALF + m * 16; const f32x4 a = pa[m], b = pb[m];
                float sq = ((a[0] + a[1]) + (a[2] + a[3])) + ((b[0] + b[1]) + (b[2] + b[3])); sq += __shfl_xor(sq, 16); sq += __shfl_xor(sq, 32);
                const float rs = 1.0f / sqrtf(sq * inv_k + eps);
#pragma unroll
                for (int bj = 0; bj < 2; ++bj) { const f32x4 v0 = acc[ai][bj][m][0] * rs, v1 = acc[ai][bj][m][1] * rs;
                    u32x4 w; w.x = cvt_pk_bf16(v0[0], v0[1]); w.y = cvt_pk_bf16(v0[2], v0[3]); w.z = cvt_pk_bf16(v1[0], v1[1]); w.w = cvt_pk_bf16(v1[2], v1[3]);
                    *(u32x4*)(O + ((size_t)(u.pn * 2 + bj) * Mrows + row) * HALF + col0) = w; } }
            asm volatile("" ::: "memory"); }
    }
};
struct EpiResF32 {
    static constexpr bool PERM = true, AFTER_DRAIN = false;
    bf16_t* xb; float* rowsq; int ldc;
    __device__ __forceinline__ void operator()(const f32x4 (&acc)[2][2][4][2], const Unit& u, int wr, int wc, int fr, int fq) const {
        const int col0 = u.pn * BM + wc * 32 + 8 * fq;
#pragma unroll
        for (int ai = 0; ai < 2; ++ai) {
            u32x4 pre[4][2];
#pragma unroll
            for (int m = 0; m < 4; ++m) { const size_t off = (size_t)(u.pm * BM + ai * HALF + wr * 64 + m * 16 + fr) * ldc + col0;
#pragma unroll
                for (int bj = 0; bj < 2; ++bj) pre[m][bj] = *(const u32x4*)(xb + off + bj * HALF); }
            asm volatile("" ::: "memory");
#pragma unroll
            for (int m = 0; m < 4; ++m) { const int row = u.pm * BM + ai * HALF + wr * 64 + m * 16 + fr; const size_t off = (size_t)row * ldc + col0; float ss = 0.f;
#pragma unroll
                for (int bj = 0; bj < 2; ++bj) { const u32x4 pb = pre[m][bj]; const f32x4 a0 = acc[ai][bj][m][0], a1 = acc[ai][bj][m][1];
                    u32x4 w; w.x = cvt_pk_bf16(__uint_as_float(pb.x << 16) + a0[0], __uint_as_float(pb.x & 0xffff0000u) + a0[1]); w.y = cvt_pk_bf16(__uint_as_float(pb.y << 16) + a0[2], __uint_as_float(pb.y & 0xffff0000u) + a0[3]);
                    w.z = cvt_pk_bf16(__uint_as_float(pb.z << 16) + a1[0], __uint_as_float(pb.z & 0xffff0000u) + a1[1]); w.w = cvt_pk_bf16(__uint_as_float(pb.w << 16) + a1[2], __uint_as_float(pb.w & 0xffff0000u) + a1[3]);
#pragma unroll
                    for (int q = 0; q < 4; ++q) { const float r0 = __uint_as_float(w[q] << 16), r1 = __uint_as_float(w[q] & 0xffff0000u); ss += r0 * r0 + r1 * r1; }
                    *(u32x4*)(xb + off + bj * HALF) = w; }
                ss += __shfl_xor(ss, 16); ss += __shfl_xor(ss, 32);
                if (fq == 0) rowsq[(size_t)row * 32 + u.pn * 4 + wc] = ss; }
            asm volatile("" ::: "memory"); }
    }
};


template <class Epi, class Sched, bool ALIGN_EPI = false, bool SP2 = false>
__device__ __forceinline__ void gemm_phase(PG8_LAS unsigned char* lds, const Gemm g, const Sched& S, const Epi& E) {
    const int tid = otid(), wid = __builtin_amdgcn_readfirstlane(tid >> 6), lane = tid & 63, wr = wid >> 2, wc = wid & 3, fr = lane & 15, fq = lane >> 4;
    const int K = g.K, nt = K / BK;
    unsigned voffA[2], voffB[2];
#pragma unroll
    for (int i = 0; i < 2; ++i) { int R, C; stage_rc(tid * 16 + i * 8192, R, C); const int Rb = Epi::PERM ? ((R & ~31) + perm32(R & 31)) : R;
        voffA[i] = (unsigned)(R * K + C) * 2u; voffB[i] = (unsigned)(Rb * K + C) * 2u; }
    const size_t kstep = (size_t)(BK * 2);
    const size_t hstep = (size_t)HALF * K * 2;
    const size_t tstep = 2 * hstep;
    const unsigned ldsw = (unsigned)wid * 1024u;
    const int aoff = lds_byte(wr * 64 + fr, fq * 8), boff = lds_byte(wc * 32 + fr, fq * 8);
#define PG8_SA(b, h) (((b) * 2 + (h)) * HTB)
#define PG8_SB(b, h) ((4 + (b) * 2 + (h)) * HTB)
#define PG8_STAGE(bufoff, gbase, voff) do { _Pragma("unroll") for (int _i = 0; _i < 2; ++_i) \
        __builtin_amdgcn_global_load_lds((const unsigned*)((const char*)(gbase) + (voff)[_i]), (PG8_LAS unsigned*)(lds + (bufoff) + ldsw + _i * 8192), 16, 0, 0); } while (0)
#define PG8_LDA(dst, b, h) do { _Pragma("unroll") for (int m = 0; m < 4; ++m) _Pragma("unroll") for (int k = 0; k < 2; ++k) dst[m][k] = *(const PG8_LAS bf16x8*)(lds + PG8_SA(b, h) + aoff + m * 2048 + k * 1024); } while (0)
#define PG8_LDB(dst, b, h) do { _Pragma("unroll") for (int n = 0; n < 2; ++n) _Pragma("unroll") for (int k = 0; k < 2; ++k) dst[n][k] = *(const PG8_LAS bf16x8*)(lds + PG8_SB(b, h) + boff + n * 2048 + k * 1024); } while (0)
#define PG8_MMA(ai, bj, At, Bt) do { __builtin_amdgcn_s_setprio(1); _Pragma("unroll") for (int m = 0; m < 4; ++m) _Pragma("unroll") for (int n = 0; n < 2; ++n) _Pragma("unroll") for (int k = 0; k < 2; ++k) \
        acc[ai][bj][m][n] = __builtin_amdgcn_mfma_f32_16x16x32_bf16(Bt[n][k], At[m][k], acc[ai][bj][m][n], 0, 0, 0); __builtin_amdgcn_s_setprio(0); } while (0)
#define PG8_WAIT_V(n) asm volatile("s_waitcnt vmcnt(" #n ")" ::: "memory")
#define PG8_WAIT_L(n) asm volatile("s_waitcnt lgkmcnt(" #n ")" ::: "memory")
#define PG8_BAR __builtin_amdgcn_s_barrier()
#define PG8_SCHED __builtin_amdgcn_sched_barrier(0)
    Unit cur, nxt; int ui = 0;
    if (!S.next(0, cur)) return;
    f32x4 acc[2][2][4][2];
#pragma unroll
    for (int a = 0; a < 2; ++a)
#pragma unroll
        for (int b = 0; b < 2; ++b)
#pragma unroll
            for (int m = 0; m < 4; ++m)
#pragma unroll
                for (int n = 0; n < 2; ++n) acc[a][b][m][n] = (f32x4){0.f, 0.f, 0.f, 0.f};
    bf16x8 At[4][2], B0[2][2], B1[2][2];
    const char* cA = (const char*)g.A + (size_t)cur.pm * tstep; const char* cB = (const char*)g.Bt + (size_t)cur.pn * tstep;
    S.a_ready(cur);
    if constexpr (SP2) {
        PG8_STAGE(PG8_SB(0, 0), cB, voffB); PG8_STAGE(PG8_SB(0, 1), cB + hstep, voffB); PG8_STAGE(PG8_SA(0, 0), cA, voffA); PG8_STAGE(PG8_SA(0, 1), cA + hstep, voffA);
        if (wr == 1) PG8_BAR;
        PG8_WAIT_V(2); PG8_BAR;
        PG8_STAGE(PG8_SB(1, 0), cB + kstep, voffB); PG8_STAGE(PG8_SA(1, 0), cA + kstep, voffA); PG8_STAGE(PG8_SB(1, 1), cB + hstep + kstep, voffB);
        PG8_WAIT_V(6); PG8_BAR;
    } else {
        PG8_STAGE(PG8_SB(0, 0), cB, voffB); PG8_STAGE(PG8_SA(0, 0), cA, voffA); PG8_STAGE(PG8_SB(0, 1), cB + hstep, voffB); PG8_STAGE(PG8_SA(0, 1), cA + hstep, voffA);
        if (wr == 1) PG8_BAR;
        PG8_WAIT_V(4); PG8_BAR;
        PG8_STAGE(PG8_SB(1, 0), cB + kstep, voffB); PG8_STAGE(PG8_SA(1, 0), cA + kstep, voffA); PG8_STAGE(PG8_SB(1, 1), cB + hstep + kstep, voffB);
        PG8_WAIT_V(6); PG8_BAR;
    }
    for (;;) {
        const bool has_next = S.next(ui + 1, nxt);
        const char* nA = has_next ? (const char*)g.A + (size_t)nxt.pm * tstep : cA; const char* nB = has_next ? (const char*)g.Bt + (size_t)nxt.pn * tstep : cB;
        for (int t = 0; t < nt; t += 2) {
            const bool last = (t == nt - 2);
            const char* a1 = cA + (size_t)(t + 1) * kstep;
            const char* a2 = last ? nA : cA + (size_t)(t + 2) * kstep; const char* b2 = last ? nB : cB + (size_t)(t + 2) * kstep;
            const char* a3 = a2 + kstep; const char* b3 = b2 + kstep;
            if (last && has_next) S.a_ready(nxt);
            if constexpr (SP2) {
            PG8_LDB(B0, 0, 0); PG8_LDB(B1, 0, 1); PG8_SCHED; PG8_LDA(At, 0, 0); PG8_STAGE(PG8_SA(1, 1), a1 + hstep, voffA);
            PG8_WAIT_V(8); PG8_WAIT_L(0); PG8_BAR; PG8_MMA(0, 0, At, B0); PG8_MMA(0, 1, At, B1); PG8_BAR; PG8_SCHED;
            PG8_LDA(At, 0, 1); PG8_STAGE(PG8_SB(0, 0), b2, voffB); PG8_STAGE(PG8_SB(0, 1), b2 + hstep, voffB); PG8_STAGE(PG8_SA(0, 0), a2, voffA);
            PG8_WAIT_V(8); PG8_WAIT_L(0); PG8_BAR; PG8_MMA(1, 0, At, B0); PG8_MMA(1, 1, At, B1); PG8_BAR; PG8_SCHED;
            PG8_LDB(B0, 1, 0); PG8_LDB(B1, 1, 1); PG8_SCHED; PG8_LDA(At, 1, 0); PG8_STAGE(PG8_SA(0, 1), a2 + hstep, voffA);
            PG8_WAIT_V(8); PG8_WAIT_L(0); PG8_BAR; PG8_MMA(0, 0, At, B0); PG8_MMA(0, 1, At, B1); PG8_BAR; PG8_SCHED;
            PG8_LDA(At, 1, 1); PG8_STAGE(PG8_SB(1, 0), b3, voffB); PG8_STAGE(PG8_SB(1, 1), b3 + hstep, voffB); PG8_STAGE(PG8_SA(1, 0), a3, voffA);
            PG8_WAIT_V(8); PG8_WAIT_L(0); PG8_BAR; PG8_MMA(1, 0, At, B0); PG8_MMA(1, 1, At, B1); PG8_BAR; PG8_SCHED;
            } else {
            PG8_LDB(B0, 0, 0); PG8_SCHED; PG8_LDA(At, 0, 0); PG8_STAGE(PG8_SA(1, 1), a1 + hstep, voffA);
            PG8_WAIT_L(8); PG8_BAR; PG8_WAIT_L(0); PG8_MMA(0, 0, At, B0); PG8_BAR; PG8_SCHED;
            PG8_LDB(B1, 0, 1); PG8_STAGE(PG8_SB(0, 0), b2, voffB);
            PG8_BAR; PG8_WAIT_L(0); PG8_MMA(0, 1, At, B1); PG8_BAR;
            PG8_LDA(At, 0, 1); PG8_STAGE(PG8_SA(0, 0), a2, voffA);
            PG8_BAR; PG8_WAIT_L(0); PG8_MMA(1, 0, At, B0); PG8_BAR; PG8_SCHED;
            PG8_STAGE(PG8_SB(0, 1), b2 + hstep, voffB);
            PG8_WAIT_V(6); PG8_BAR; PG8_MMA(1, 1, At, B1); PG8_BAR;
            PG8_LDB(B0, 1, 0); PG8_SCHED; PG8_LDA(At, 1, 0); PG8_STAGE(PG8_SA(0, 1), a2 + hstep, voffA);
            PG8_WAIT_L(8); PG8_BAR; PG8_WAIT_L(0); PG8_MMA(0, 0, At, B0); PG8_BAR; PG8_SCHED;
            PG8_LDB(B1, 1, 1); PG8_STAGE(PG8_SB(1, 0), b3, voffB);
            PG8_BAR; PG8_WAIT_L(0); PG8_MMA(0, 1, At, B1); PG8_BAR;
            PG8_LDA(At, 1, 1); PG8_STAGE(PG8_SA(1, 0), a3, voffA);
            PG8_BAR; PG8_WAIT_L(0); PG8_MMA(1, 0, At, B0); PG8_BAR; PG8_SCHED;
            PG8_STAGE(PG8_SB(1, 1), b3 + hstep, voffB);
            PG8_WAIT_V(6); PG8_BAR; PG8_MMA(1, 1, At, B1); PG8_BAR;
            }
        }
        if constexpr (ALIGN_EPI) { if (wr == 0) PG8_BAR; }
        if constexpr (!Epi::AFTER_DRAIN) { E(acc, cur, wr, wc, fr, fq); S.done(cur); }
        if (!has_next) break;
#pragma unroll
        for (int a = 0; a < 2; ++a)
#pragma unroll
            for (int b = 0; b < 2; ++b)
#pragma unroll
                for (int m = 0; m < 4; ++m)
#pragma unroll
                    for (int n = 0; n < 2; ++n) acc[a][b][m][n] = (f32x4){0.f, 0.f, 0.f, 0.f};
        cur = nxt; cA = nA; cB = nB; ++ui;
        if constexpr (ALIGN_EPI) { if (wr == 1) PG8_BAR; }
    }
    PG8_WAIT_V(0);
    if constexpr (!ALIGN_EPI) { if (wr == 0) PG8_BAR; }
    PG8_BAR;
    if constexpr (Epi::AFTER_DRAIN) { E.fused(acc, cur, wr, wc, fr, fq, lds, wid, lane); S.done(cur); }
#undef PG8_SA
#undef PG8_SB
#undef PG8_STAGE
#undef PG8_LDA
#undef PG8_LDB
#undef PG8_MMA
#undef PG8_WAIT_V
#undef PG8_WAIT_L
#undef PG8_BAR
#undef PG8_SCHED
}
}
#define PG8_SP2 true
#define PG8_ALIGN true
namespace att {
using bf16 = __hip_bfloat16;
constexpr int D = 128, NW = 8, QBLK = 32, KVBLK = 64;
constexpr float SCALE = 0.088388347648318440f;
constexpr float THR = 8.f;
constexpr size_t SHM_V = KVBLK * D * 2, SHM_K = KVBLK * D * 2, SHM_ATTN = 2 * SHM_V + 2 * SHM_K + NW * 64 * 4;
using bf16x8 = __attribute__((ext_vector_type(8))) short;
using s16x4  = __attribute__((ext_vector_type(4))) short;
using f32x16 = __attribute__((ext_vector_type(16))) float;
using f32x8  = __attribute__((ext_vector_type(8))) float;
using u32x4  = __attribute__((ext_vector_type(4))) unsigned;
#define KSWZ(row, colB) ((row) * 256 + ((colB) ^ (((row) & 7) << 4)))
#define SBAR() __builtin_amdgcn_sched_barrier(0)
__device__ __forceinline__ int crow(int r, int hi) { return (r & 3) + 8 * (r >> 2) + 4 * hi; }
__device__ __forceinline__ unsigned cvtpk(float lo, float hi) {
  unsigned r; asm("v_cvt_pk_bf16_f32 %0, %1, %2" : "=v"(r) : "v"(lo), "v"(hi)); return r;
}
template <typename TIn> struct Stage;
template <> struct Stage<bf16>  { using T = bf16x8;
  __device__ static __forceinline__ T ld8(const bf16* p) { return *reinterpret_cast<const bf16x8*>(p); }
  __device__ static __forceinline__ bf16x8 tobf(T x) { return x; } };
template <> struct Stage<float> { using T = f32x8;
  __device__ static __forceinline__ T ld8(const float* p) { return *reinterpret_cast<const f32x8*>(p); }
  __device__ static __forceinline__ bf16x8 tobf(T x) {
    u32x4 w = {cvtpk(x[0], x[1]), cvtpk(x[2], x[3]), cvtpk(x[4], x[5]), cvtpk(x[6], x[7])}; return *reinterpret_cast<bf16x8*>(&w); } };

__device__ __forceinline__ void partialSM(f32x16& p0, f32x16& p1, float& m_reg, float& mn, float& alpha) {
  constexpr float C = SCALE * 1.4426950408889634f;
  float pmax = p0[0]; for (int r = 1; r < 16; ++r) pmax = fmaxf(pmax, p0[r]); for (int r = 0; r < 16; ++r) pmax = fmaxf(pmax, p1[r]);
  { auto rr = __builtin_amdgcn_permlane32_swap(__float_as_uint(pmax), __float_as_uint(pmax), false, false);
    pmax = fmaxf(__uint_as_float(rr[0]), __uint_as_float(rr[1])); }
  if (__builtin_expect(__all(pmax - m_reg <= THR / SCALE), 1)) { mn = m_reg; alpha = 1.f; }
  else { mn = fmaxf(m_reg, pmax); alpha = __builtin_amdgcn_exp2f((m_reg - mn) * C); m_reg = mn; }
  float mnC = -mn * C;
  for (int r = 0; r < 16; ++r) p0[r] = fmaf(p0[r], C, mnC); for (int r = 0; r < 16; ++r) p1[r] = fmaf(p1[r], C, mnC);
  for (int r = 0; r < 16; ++r) p0[r] = __builtin_amdgcn_exp2f(p0[r]);
}
__device__ __forceinline__ void finishSM(f32x16& p0, f32x16& p1, float alpha, float& l_reg, bf16x8& pa0, bf16x8& pa1, bf16x8& pa2, bf16x8& pa3) {
  for (int r = 0; r < 16; ++r) p1[r] = __builtin_amdgcn_exp2f(p1[r]);
  float ps = 0; for (int r = 0; r < 16; ++r) ps += p0[r]; for (int r = 0; r < 16; ++r) ps += p1[r];
  { auto rr = __builtin_amdgcn_permlane32_swap(__float_as_uint(ps), __float_as_uint(ps), false, false);
    ps = __uint_as_float(rr[0]) + __uint_as_float(rr[1]); }
  l_reg = l_reg * alpha + ps;
#define PK4(P, BASE, OUT) do { unsigned a0 = cvtpk(P[BASE + 0], P[BASE + 1]), a1 = cvtpk(P[BASE + 2], P[BASE + 3]);   \
    unsigned b0 = cvtpk(P[BASE + 4], P[BASE + 5]), b1 = cvtpk(P[BASE + 6], P[BASE + 7]);                              \
    auto r0 = __builtin_amdgcn_permlane32_swap(a0, b0, false, false); auto r1 = __builtin_amdgcn_permlane32_swap(a1, b1, false, false); \
    u32x4 w = {r0[0], r1[0], r0[1], r1[1]}; OUT = *reinterpret_cast<bf16x8*>(&w); } while (0)
  PK4(p0, 0, pa0); PK4(p0, 8, pa1); PK4(p1, 0, pa2); PK4(p1, 8, pa3);
#undef PK4
}
__device__ __forceinline__ void qkt(f32x16& p0, f32x16& p1, const bf16* Ks, const bf16x8* qr, int r32, int hi) {
  p0 = f32x16{}; p1 = f32x16{};
  for (int d0 = 0; d0 < 8; ++d0) { int cb = (d0 * 16 + hi * 8) * 2;
    bf16x8 b0 = *reinterpret_cast<const bf16x8*>((const char*)Ks + KSWZ(r32, cb));
    bf16x8 b1 = *reinterpret_cast<const bf16x8*>((const char*)Ks + KSWZ(32 + r32, cb));
    p0 = __builtin_amdgcn_mfma_f32_32x32x16_bf16(b0, qr[d0], p0, 0, 0, 0);
    p1 = __builtin_amdgcn_mfma_f32_32x32x16_bf16(b1, qr[d0], p1, 0, 0, 0); }
}
__device__ __forceinline__ int v_st(int k, int c) { const int kk = (k & ~0xC) | ((k & 4) << 1) | ((k & 8) >> 1); return ((kk >> 3) * 4 + (c >> 5)) * 512 + ((kk & 7) * 32 + (c & 31)) * 2; }
__device__ __forceinline__ int v_rd_base(int lane) { return ((lane & 3) << 3) | (((lane >> 2) & 3) << 6) | (((lane >> 4) & 1) << 5) | (((lane >> 5) & 1) << 8); }
constexpr int v_rd_off(int d0, int ks, int half) { return d0 * 512 + ks * 4096 + half * 2048; }
template <int OFF> __device__ __forceinline__ s16x4 tr_read(int vb) {
  s16x4 r; asm volatile("ds_read_b64_tr_b16 %0, %1 offset:%2" : "=&v"(r) : "v"(vb), "i"(OFF) : "memory"); return r;
}
template <int D0> __device__ __forceinline__ void pv_one(f32x16& od, int vb, bf16x8 pa0, bf16x8 pa1, bf16x8 pa2, bf16x8 pa3) {
  const s16x4 l0 = tr_read<v_rd_off(D0, 0, 0)>(vb), h0 = tr_read<v_rd_off(D0, 0, 1)>(vb), l1 = tr_read<v_rd_off(D0, 1, 0)>(vb), h1 = tr_read<v_rd_off(D0, 1, 1)>(vb);
  const s16x4 l2 = tr_read<v_rd_off(D0, 2, 0)>(vb), h2 = tr_read<v_rd_off(D0, 2, 1)>(vb), l3 = tr_read<v_rd_off(D0, 3, 0)>(vb), h3 = tr_read<v_rd_off(D0, 3, 1)>(vb);
  asm volatile("s_waitcnt lgkmcnt(0)" ::: "memory"); SBAR();
#define PK(L, H) (bf16x8){L[0], L[1], L[2], L[3], H[0], H[1], H[2], H[3]}
  od = __builtin_amdgcn_mfma_f32_32x32x16_bf16(pa0, PK(l0, h0), od, 0, 0, 0);
  od = __builtin_amdgcn_mfma_f32_32x32x16_bf16(pa1, PK(l1, h1), od, 0, 0, 0);
  od = __builtin_amdgcn_mfma_f32_32x32x16_bf16(pa2, PK(l2, h2), od, 0, 0, 0);
  od = __builtin_amdgcn_mfma_f32_32x32x16_bf16(pa3, PK(l3, h3), od, 0, 0, 0);
#undef PK
}
struct VFrag { s16x4 l0, h0, l1, h1, l2, h2, l3, h3; };
template <int D0> __device__ __forceinline__ void pv_rd(VFrag& f, int vb) {
  f.l0 = tr_read<v_rd_off(D0, 0, 0)>(vb); f.h0 = tr_read<v_rd_off(D0, 0, 1)>(vb); f.l1 = tr_read<v_rd_off(D0, 1, 0)>(vb); f.h1 = tr_read<v_rd_off(D0, 1, 1)>(vb);
  f.l2 = tr_read<v_rd_off(D0, 2, 0)>(vb); f.h2 = tr_read<v_rd_off(D0, 2, 1)>(vb); f.l3 = tr_read<v_rd_off(D0, 3, 0)>(vb); f.h3 = tr_read<v_rd_off(D0, 3, 1)>(vb);
}
__device__ __forceinline__ void pv_mm(f32x16& od, const VFrag& f, bf16x8 pa0, bf16x8 pa1, bf16x8 pa2, bf16x8 pa3) {
#define PK(L, H) (bf16x8){L[0], L[1], L[2], L[3], H[0], H[1], H[2], H[3]}
  od = __builtin_amdgcn_mfma_f32_32x32x16_bf16(pa0, PK(f.l0, f.h0), od, 0, 0, 0);
  od = __builtin_amdgcn_mfma_f32_32x32x16_bf16(pa1, PK(f.l1, f.h1), od, 0, 0, 0);
  od = __builtin_amdgcn_mfma_f32_32x32x16_bf16(pa2, PK(f.l2, f.h2), od, 0, 0, 0);
  od = __builtin_amdgcn_mfma_f32_32x32x16_bf16(pa3, PK(f.l3, f.h3), od, 0, 0, 0);
#undef PK
}
#define PV_WAIT(n) do { asm volatile("s_waitcnt lgkmcnt(" #n ")" ::: "memory"); SBAR(); } while (0)
__device__ __forceinline__ void pv_d0(f32x16* o, int vb, bf16x8 pa0, bf16x8 pa1, bf16x8 pa2, bf16x8 pa3) {
#if MK_PVPIPE
  VFrag fa, fb;
  pv_rd<0>(fa, vb); pv_rd<1>(fb, vb);
  PV_WAIT(8); pv_mm(o[0], fa, pa0, pa1, pa2, pa3); SBAR();
  pv_rd<2>(fa, vb);
  PV_WAIT(8); pv_mm(o[1], fb, pa0, pa1, pa2, pa3); SBAR();
  pv_rd<3>(fb, vb);
  PV_WAIT(8); pv_mm(o[2], fa, pa0, pa1, pa2, pa3); SBAR();
  PV_WAIT(0); pv_mm(o[3], fb, pa0, pa1, pa2, pa3);
#else
  pv_one<0>(o[0], vb, pa0, pa1, pa2, pa3); pv_one<1>(o[1], vb, pa0, pa1, pa2, pa3); pv_one<2>(o[2], vb, pa0, pa1, pa2, pa3); pv_one<3>(o[3], vb, pa0, pa1, pa2, pa3);
#endif
}
constexpr int crow0(int r) { return (r & 3) + 8 * (r >> 2); }
constexpr float LOG2E = 1.4426950408889634f;
__device__ __forceinline__ void partialSM_dil(f32x16& p0, f32x16& p1, float& m_reg, float& mn, float& alpha, float dq, float dlo, float dhi, float nslopeC) {
  constexpr float C = SCALE * LOG2E;
#pragma unroll
  for (int r = 0; r < 16; ++r) {
    const float d0 = dq + (float)crow0(r), d1 = d0 + 32.f;
    const float t0 = fmaf(p0[r], C, nslopeC * fabsf(d0)), t1 = fmaf(p1[r], C, nslopeC * fabsf(d1));
    p0[r] = (d0 >= dlo && d0 <= dhi) ? t0 : -1e30f;
    p1[r] = (d1 >= dlo && d1 <= dhi) ? t1 : -1e30f;
  }
  float pmax = p0[0];
#pragma unroll
  for (int r = 1; r < 16; ++r) pmax = fmaxf(pmax, p0[r]);
#pragma unroll
  for (int r = 0; r < 16; ++r) pmax = fmaxf(pmax, p1[r]);
  { auto rr = __builtin_amdgcn_permlane32_swap(__float_as_uint(pmax), __float_as_uint(pmax), false, false);
    pmax = fmaxf(__uint_as_float(rr[0]), __uint_as_float(rr[1])); }
  if (__builtin_expect(__all(pmax - m_reg <= THR * LOG2E), 1)) { mn = m_reg; alpha = 1.f; }
  else { mn = fmaxf(m_reg, pmax); alpha = __builtin_amdgcn_exp2f(m_reg - mn); m_reg = mn; }
#pragma unroll
  for (int r = 0; r < 16; ++r) { p0[r] = p0[r] - mn; p1[r] = p1[r] - mn; }
#pragma unroll
  for (int r = 0; r < 16; ++r) p0[r] = __builtin_amdgcn_exp2f(p0[r]);
}

template <bool DIL>
__device__ __forceinline__ void attn_body(const bf16* __restrict__ Qb, const bf16* __restrict__ Kh, const bf16* __restrict__ Vh, long qs, long ks,
                                          bf16* __restrict__ Ob, long os, float* __restrict__ lse_o, int lse_s, int i0, int nsub, float nslopeC, int seq, char* lds) {
  typedef __attribute__((address_space(3))) unsigned lds_u32;
  using St = Stage<bf16>;
  const int tid = otid(), wid = __builtin_amdgcn_readfirstlane(tid >> 6), lane = tid & 63, r32 = lane & 31, hi = lane >> 5;
  char* V_lds = lds + 4 * SHM_K; char* K_lds = lds;
  float* ws = (float*)(lds + 4 * SHM_K + 4 * SHM_V) + wid * 64; float* li_l = ws; float* al_l = ws + 32;
  float m_reg = -1e30f, l_reg = 0; f32x16 o[4] = {}; bf16x8 qr[8];
  const bf16* Qw = Qb + (long)(wid * QBLK + r32) * qs + hi * 8;
#pragma unroll
  for (int d0 = 0; d0 < 8; ++d0) qr[d0] = St::ld8(Qw + d0 * 16);
  const int vb0 = (int)(uintptr_t)V_lds + v_rd_base(lane);
  const int kb = DIL ? i0 - 64 : 0;
#define KROW(k) (DIL ? (long)min(max(kb + (k), 0), nsub - 1) : (long)(k))
  int krow[2], kcol[2], vrow[2], vcol[2];
#pragma unroll
  for (int i = 0; i < 2; ++i) { const int pc = 2 * wid + i;
    krow[i] = pc * 4 + (lane >> 4); kcol[i] = (((lane & 15) ^ (krow[i] & 7)) << 3);
    const int sub = pc * 2 + (lane >> 5), kk = ((sub >> 2) << 3) + ((lane & 31) >> 2);
    vrow[i] = (kk & ~0xC) | ((kk & 4) << 1) | ((kk & 8) >> 1); vcol[i] = ((sub & 3) << 5) + ((lane & 3) << 3); }
#define DMA(t, buf) do { _Pragma("unroll") for (int i_ = 0; i_ < 2; ++i_) { \
      __builtin_amdgcn_global_load_lds((const unsigned*)(Kh + KROW((t) * KVBLK + krow[i_]) * ks + kcol[i_]), (lds_u32*)(K_lds + (buf) * SHM_K + (2 * wid + i_) * 1024), 16, 0, 0); \
      __builtin_amdgcn_global_load_lds((const unsigned*)(Vh + KROW((t) * KVBLK + vrow[i_]) * ks + vcol[i_]), (lds_u32*)(V_lds + (buf) * SHM_V + (2 * wid + i_) * 1024), 16, 0, 0); } } while (0)
#define ENDSTEP(j) do { if ((j) + 2 < NT) asm volatile("s_waitcnt vmcnt(4) lgkmcnt(0)\n\ts_barrier" ::: "memory"); else asm volatile("s_waitcnt vmcnt(0) lgkmcnt(0)\n\ts_barrier" ::: "memory"); } while (0)
#define RESC(a) do { if (__any((a) < 1.f)) { if (hi == 0) al_l[r32] = (a); asm volatile("s_waitcnt lgkmcnt(0)" ::: "memory"); \
    for (int d = 0; d < 4; ++d) for (int r = 0; r < 16; ++r) o[d][r] *= al_l[crow(r, hi)]; } } while (0)
#define PSM(P0, P1, MN, AL, jt) do { if constexpr (DIL) { const int t_ = otid(), iq_ = (t_ >> 6) * QBLK + (t_ & 31), hi_ = (t_ >> 5) & 1; \
      partialSM_dil(P0, P1, m_reg, MN, AL, (float)(-64 - iq_ + 4 * hi_ + 64 * (jt)), fmaxf(-64.f, (float)(-(i0 + iq_))), fminf(64.f, (float)(nsub - 1 - (i0 + iq_))), nslopeC); } \
    else partialSM(P0, P1, m_reg, MN, AL); } while (0)
#if MK_SGB
#define SGB_A() do { __builtin_amdgcn_sched_group_barrier(0x100, 4, 0); \
    _Pragma("unroll") for (int g_ = 0; g_ < 12; ++g_) { __builtin_amdgcn_sched_group_barrier(0x008, 1, 0); __builtin_amdgcn_sched_group_barrier(0x100, 1, 0); __builtin_amdgcn_sched_group_barrier(0x002, 6, 0); } \
    _Pragma("unroll") for (int g_ = 0; g_ < 4; ++g_) { __builtin_amdgcn_sched_group_barrier(0x008, 1, 0); __builtin_amdgcn_sched_group_barrier(0x002, 6, 0); } } while (0)
#else
#define SGB_A() do {} while (0)
#endif
#define KBUF(j) ((const bf16*)(K_lds + ((j) & 3) * SHM_K))
#define VBUF(j) (vb0 + ((j) & 3) * (int)SHM_V)
  f32x16 pA0, pA1, pB0, pB1; float mnA, mnB, alA, alB; bf16x8 pa0, pa1, pa2, pa3; const int NT = DIL ? 6 : seq / KVBLK;
  DMA(0, 0); DMA(1, 1);
  if constexpr (!DIL && MK_PP) { DMA(2, 2); asm volatile("s_waitcnt vmcnt(8)\n\ts_barrier" ::: "memory"); }
  else asm volatile("s_waitcnt vmcnt(4)\n\ts_barrier" ::: "memory");
  struct KFrag { bf16x8 a, b; };
  int koff[8];
#pragma unroll
  for (int d0 = 0; d0 < 8; ++d0) koff[d0] = KSWZ(r32, (d0 * 16 + hi * 8) * 2);
  const int kbase0 = (int)(uintptr_t)K_lds;
#define KRD(f, d0, kb) asm volatile("ds_read_b128 %0, %2\n\tds_read_b128 %1, %2 offset:8192" : "=&v"(f.a), "=&v"(f.b) : "v"((kb) + koff[d0]) : "memory")
#define QMM(f, d0) do { pA0 = __builtin_amdgcn_mfma_f32_32x32x16_bf16(f.a, qr[d0], pA0, 0, 0, 0); pA1 = __builtin_amdgcn_mfma_f32_32x32x16_bf16(f.b, qr[d0], pA1, 0, 0, 0); } while (0)
#define LW(n) do { asm volatile("s_waitcnt lgkmcnt(" #n ")" ::: "memory"); SBAR(); } while (0)
  if constexpr (DIL) {
    const int rlo = wid >> 1;
    for (int j = 0; j < NT; ++j) {
      if (j + 2 < NT) DMA(j + 2, (j + 2) & 3);
      if (j >= rlo && j <= rlo + 2) {
        SBAR();
        { const int kb_ = kbase0 + (j & 3) * (int)SHM_K; KFrag k0_, k1_, k2_;
          KRD(k0_, 0, kb_); KRD(k1_, 1, kb_); KRD(k2_, 2, kb_); pA0 = f32x16{}; pA1 = f32x16{};
          LW(4); QMM(k0_, 0); SBAR(); KRD(k0_, 3, kb_);
          LW(4); QMM(k1_, 1); SBAR(); KRD(k1_, 4, kb_);
          LW(4); QMM(k2_, 2); SBAR(); KRD(k2_, 5, kb_);
          LW(4); QMM(k0_, 3); SBAR(); KRD(k0_, 6, kb_);
          LW(4); QMM(k1_, 4); SBAR(); KRD(k1_, 7, kb_);
          LW(4); QMM(k2_, 5); SBAR();
          LW(2); QMM(k0_, 6); SBAR();
          LW(0); QMM(k1_, 7); SBAR(); }
        PSM(pA0, pA1, mnA, alA, j); RESC(alA);
        finishSM(pA0, pA1, alA, l_reg, pa0, pa1, pa2, pa3); SBAR();
        pv_d0(o, VBUF(j), pa0, pa1, pa2, pa3);
      }
      if (j + 1 < NT) ENDSTEP(j);
    }
  } else if constexpr (MK_PP) {
    const bool grpB = wid >= 4;
#define PP_BAR(VM) do { if (VM) { asm volatile("s_waitcnt vmcnt(4) lgkmcnt(0)\n\ts_barrier" ::: "memory"); } else { asm volatile("s_waitcnt vmcnt(0) lgkmcnt(0)\n\ts_barrier" ::: "memory"); } } while (0)
#define PP_BAR_PLAIN() asm volatile("s_waitcnt lgkmcnt(0)\n\ts_barrier" ::: "memory")
    if (grpB) PP_BAR_PLAIN();
    qkt(pA0, pA1, KBUF(0), qr, r32, hi);
    if (grpB) PP_BAR(2 < NT); else PP_BAR_PLAIN();
    for (int t = 0; t < NT; ++t) {
      if (grpB && t + 3 < NT) DMA(t + 3, (t + 3) & 3);
      PSM(pA0, pA1, mnA, alA, t); RESC(alA);
      finishSM(pA0, pA1, alA, l_reg, pa0, pa1, pa2, pa3);
      if (!grpB) PP_BAR(t + 2 < NT); else PP_BAR_PLAIN();
      if (!grpB && t + 3 < NT) DMA(t + 3, (t + 3) & 3);
      SBAR();
      if (t + 1 < NT) {
        const int kb_ = kbase0 + ((t + 1) & 3) * (int)SHM_K, vb_ = VBUF(t);
        KFrag k0_, k1_, k2_; VFrag fa_, fb_;
        KRD(k0_, 0, kb_); KRD(k1_, 1, kb_); KRD(k2_, 2, kb_); pv_rd<0>(fa_, vb_);
        pA0 = f32x16{}; pA1 = f32x16{};
        LW(12); QMM(k0_, 0); SBAR(); KRD(k0_, 3, kb_);
        LW(12); QMM(k1_, 1); SBAR(); KRD(k1_, 4, kb_);
        LW(4);  pv_mm(o[0], fa_, pa0, pa1, pa2, pa3); SBAR(); pv_rd<1>(fb_, vb_);
        QMM(k2_, 2); SBAR(); KRD(k2_, 5, kb_);
        LW(12); QMM(k0_, 3); SBAR(); KRD(k0_, 6, kb_);
        LW(4);  pv_mm(o[1], fb_, pa0, pa1, pa2, pa3); SBAR(); pv_rd<2>(fa_, vb_);
        QMM(k1_, 4); SBAR(); KRD(k1_, 7, kb_);
        LW(12); QMM(k2_, 5); SBAR();
        LW(2);  pv_mm(o[2], fa_, pa0, pa1, pa2, pa3); SBAR(); pv_rd<3>(fb_, vb_);
        QMM(k0_, 6); SBAR();
        LW(8);  QMM(k1_, 7); SBAR();
        LW(0);  pv_mm(o[3], fb_, pa0, pa1, pa2, pa3);
      } else pv_d0(o, VBUF(t), pa0, pa1, pa2, pa3);
      if (t + 1 < NT) { if (grpB) PP_BAR(t + 3 < NT); else PP_BAR_PLAIN(); }
    }
    if (!grpB) PP_BAR_PLAIN();
#undef PP_BAR
#undef PP_BAR_PLAIN
#undef KRD
#undef QMM
#undef LW
  } else {
  if (2 < NT) DMA(2, 2);
  qkt(pA0, pA1, KBUF(0), qr, r32, hi); PSM(pA0, pA1, mnA, alA, 0);
  ENDSTEP(0);
  for (int j = 1; j + 1 < NT; j += 2) {
    if (j + 2 < NT) DMA(j + 2, (j + 2) & 3);
    SBAR(); qkt(pB0, pB1, KBUF(j), qr, r32, hi);
    finishSM(pA0, pA1, alA, l_reg, pa0, pa1, pa2, pa3); SGB_A(); SBAR();
    pv_d0(o, VBUF(j - 1), pa0, pa1, pa2, pa3); PSM(pB0, pB1, mnB, alB, j);
    RESC(alB); ENDSTEP(j);
    if (j + 3 < NT) DMA(j + 3, (j + 3) & 3);
    SBAR(); qkt(pA0, pA1, KBUF(j + 1), qr, r32, hi);
    finishSM(pB0, pB1, alB, l_reg, pa0, pa1, pa2, pa3); SGB_A(); SBAR();
    pv_d0(o, VBUF(j), pa0, pa1, pa2, pa3); PSM(pA0, pA1, mnA, alA, j + 1);
    RESC(alA); ENDSTEP(j + 1);
  }
  SBAR(); qkt(pB0, pB1, KBUF(NT - 1), qr, r32, hi);
  finishSM(pA0, pA1, alA, l_reg, pa0, pa1, pa2, pa3); SBAR();
  pv_d0(o, VBUF(NT - 2), pa0, pa1, pa2, pa3); PSM(pB0, pB1, mnB, alB, NT - 1);
  RESC(alB);
  finishSM(pB0, pB1, alB, l_reg, pa0, pa1, pa2, pa3); SBAR();
  pv_d0(o, VBUF(NT - 1), pa0, pa1, pa2, pa3);
  }
  if (hi == 0) li_l[r32] = l_reg; asm volatile("s_waitcnt lgkmcnt(0)" ::: "memory");
  if constexpr (DIL) { if (hi == 0) lse_o[(long)(wid * QBLK + r32) * lse_s] = m_reg + __log2f(l_reg); }
  float rli[16];
#pragma unroll
  for (int r = 0; r < 16; ++r) rli[r] = __builtin_amdgcn_rcpf(li_l[crow(r, hi)]);
  bf16* Ow = Ob + (long)(wid * QBLK) * os;
#pragma unroll
  for (int r = 0; r < 16; ++r) { const int orow = crow(r, hi);
#pragma unroll
    for (int d0 = 0; d0 < 4; ++d0) Ow[(long)orow * os + d0 * 32 + r32] = __float2bfloat16(o[d0][r] * rli[r]); }
  asm volatile("s_waitcnt lgkmcnt(0)\n\ts_barrier" ::: "memory");
#undef KROW
#undef DMA
#undef ENDSTEP
#undef RESC
#undef PSM
#undef KBUF
#undef SGB_A
#undef VBUF
}
}

#define GAS __attribute__((address_space(1)))
#define LAS __attribute__((address_space(3)))
typedef unsigned short bf16_t;
typedef unsigned v4u __attribute__((ext_vector_type(4)));
typedef unsigned v2u __attribute__((ext_vector_type(2)));
typedef float f32x4 __attribute__((ext_vector_type(4)));
#define LDS_WAIT() asm volatile("s_waitcnt lgkmcnt(0)" ::: "memory")

constexpr size_t MiB = 1u << 20;
constexpr size_t WS_W1T = 0;
constexpr size_t WS_W2T = 104 * MiB;
constexpr size_t WS_H = 136 * MiB;
constexpr size_t WS_PROJ = 200 * MiB;
constexpr size_t WS_YA = 408 * MiB;
constexpr size_t WS_YB = 440 * MiB;
constexpr size_t WS_LSE = 536 * MiB;
constexpr size_t WS_ROPE = 538 * MiB;
constexpr size_t WS_XB = 540 * MiB;
constexpr size_t WS_ROWSQ = 604 * MiB;
constexpr size_t WS_END = 616 * MiB;
static_assert((size_t)DEPTH * DIN * DM * 2 <= WS_W2T - WS_W1T && (size_t)M * DIN * 2 <= WS_YA - WS_PROJ && (size_t)3 * M * DB * 2 <= WS_LSE - WS_YB, "ws map");
constexpr int LDS_BYTES = 147456;
constexpr int N_PHASES = 2 + 5 * DEPTH;

__device__ __forceinline__ unsigned f2bf(float f) { unsigned u = __builtin_bit_cast(unsigned, f); return (u + 0x7fffu + ((u >> 16) & 1u)) >> 16; }
__device__ __forceinline__ unsigned pk2(float lo, float hi) { return f2bf(lo) | (f2bf(hi) << 16); }
__device__ __forceinline__ float bflo(unsigned w) { return __uint_as_float(w << 16); }
__device__ __forceinline__ float bfhi(unsigned w) { return __uint_as_float(w & 0xffff0000u); }
__device__ __forceinline__ float wave_sum(float v) {
#pragma unroll
    for (int o = 1; o < 64; o <<= 1) v += __shfl_xor(v, o);
    return v;
}

__device__ const float INV_FREQ[32] = {1.000000000e+00f, 7.498942614e-01f, 5.623413324e-01f, 4.216965139e-01f, 3.162277639e-01f, 2.371373773e-01f, 1.778279394e-01f, 1.333521307e-01f,
    1.000000015e-01f, 7.498941571e-02f, 5.623413250e-02f, 4.216965288e-02f, 3.162277490e-02f, 2.371373773e-02f, 1.778279431e-02f, 1.333521493e-02f,
    9.999999776e-03f, 7.498941850e-03f, 5.623413250e-03f, 4.216964822e-03f, 3.162277630e-03f, 2.371373586e-03f, 1.778279431e-03f, 1.333521446e-03f,
    1.000000047e-03f, 7.498942432e-04f, 5.623413017e-04f, 4.216965172e-04f, 3.162277571e-04f, 2.371373703e-04f, 1.778279402e-04f, 1.333521504e-04f};

__device__ __forceinline__ void sincos_acc(float a, float& s, float& c) {
    const double x = (double)a, kd = __builtin_rint(x * 0.63661977236758134308);
    const int k = (int)kd; const double r = x - kd * 1.57079632679489661923, r2 = r * r;
    const double sp = r * (1.0 + r2 * (-1.0 / 6 + r2 * (1.0 / 120 + r2 * (-1.0 / 5040 + r2 * (1.0 / 362880 + r2 * (-1.0 / 39916800 + r2 * (1.0 / 6227020800.0)))))));
    const double cp = 1.0 + r2 * (-0.5 + r2 * (1.0 / 24 + r2 * (-1.0 / 720 + r2 * (1.0 / 40320 + r2 * (-1.0 / 3628800 + r2 * (1.0 / 479001600.0 + r2 * (-1.0 / 87178291200.0)))))));
    const int q = k & 3;
    const double sv = (q == 0) ? sp : (q == 1) ? cp : (q == 2) ? -sp : -cp, cv = (q == 0) ? cp : (q == 1) ? -sp : (q == 2) ? -cp : sp;
    s = (float)sv; c = (float)cv;
}

__device__ __forceinline__ void p0_transpose_item(const float* W, int K, int N, bf16_t* WT, LAS float* scr, int item, int lane, const float* kscale) {
    const int nblk = N / 32, kb = item / nblk, nb = item % nblk, k0 = 64 * kb, n0 = 32 * nb;
#pragma unroll 8
    for (int i = 0; i < 32; ++i) { const int kk = 2 * i + (lane >> 5); scr[kk * 33 + (lane & 31)] = W[(size_t)(k0 + kk) * N + n0 + (lane & 31)] * (kscale ? kscale[k0 + kk] : 1.0f); }
    LDS_WAIT(); asm volatile("" ::: "memory");
    const int c = lane & 7;
#pragma unroll
    for (int j = 0; j < 4; ++j) { const int n = (lane >> 3) + 8 * j; const LAS float* s = scr + (8 * c) * 33 + n;
        v4u o; o.x = pk2(s[0 * 33], s[1 * 33]); o.y = pk2(s[2 * 33], s[3 * 33]); o.z = pk2(s[4 * 33], s[5 * 33]); o.w = pk2(s[6 * 33], s[7 * 33]);
        *(v4u*)(WT + (size_t)(n0 + n) * K + k0 + 8 * c) = o; }
    LDS_WAIT(); asm volatile("" ::: "memory");
}

#define XB_TMO      128
#define XB_XCNT(j)  (256  + 64 * (j))
#define XB_XSUB(j)  (1280 + 64 * (j))
#define XB_XGEN(j)  (2304 + 64 * (j))
#define XB_TOP      3328
#define XB_TOPGEN   3392
#define XCD_BAR_WORDS 3456
#define XB_SPIN_CAP (1u << 18)

__device__ __forceinline__ unsigned xb_ld(unsigned* p)              { return __hip_atomic_load(p, __ATOMIC_RELAXED, __HIP_MEMORY_SCOPE_AGENT); }
__device__ __forceinline__ unsigned xb_add(unsigned* p, unsigned v) { return __hip_atomic_fetch_add(p, v, __ATOMIC_RELAXED, __HIP_MEMORY_SCOPE_AGENT); }
__device__ __forceinline__ unsigned xb_xcc_id() { return (unsigned)__builtin_amdgcn_s_getreg((3 << 11) | 20) & 0xFu; }
#define XB_SPIN(cond, bar) do { unsigned _sp = 0; while (cond) { __builtin_amdgcn_s_sleep(1); \
    if ((++_sp & 255u) == 0u) { if (xb_ld(&(bar)[XB_TMO])) break; if (_sp > XB_SPIN_CAP) { atomicAdd(&(bar)[XB_TMO], 1u); break; } } } } while (0)

struct XcdBarrier {
    unsigned* bar; unsigned x;
    volatile LAS unsigned* st;
};

__device__ __forceinline__ XcdBarrier xcd_barrier_post(unsigned* bar, volatile LAS unsigned* st) {
    XcdBarrier b; b.bar = bar; b.x = xb_xcc_id(); b.st = st;
    if (threadIdx.x == 0) (void)xb_add(&bar[XB_XCNT(b.x)], 1u);
    return b;
}
__device__ __forceinline__ void xcd_barrier_complete(unsigned* bar, unsigned x, unsigned& nloc, unsigned& nx) {
    const unsigned G = gridDim.x * gridDim.y * gridDim.z;
    unsigned sum, cnt, mine, sp = 0u;
    for (;;) {
        sum = 0u; cnt = 0u; mine = 0u;
#pragma unroll
        for (unsigned j = 0; j < 16; ++j) { const unsigned c = xb_ld(&bar[XB_XCNT(j)]); sum += c; cnt += (c > 0u) ? 1u : 0u; mine = (j == x) ? c : mine; }
        if (sum == G) break;
        __builtin_amdgcn_s_sleep(1);
        if ((++sp & 255u) == 0u) { if (xb_ld(&bar[XB_TMO])) break; if (sp > XB_SPIN_CAP) { atomicAdd(&bar[XB_TMO], 1u); break; } }
    }
    nloc = mine > 0u ? mine : 1u; nx = cnt > 0u ? cnt : 1u;
}

__device__ __forceinline__ void xcd_barrier(const XcdBarrier& b) {
    asm volatile("s_waitcnt vmcnt(0)" ::: "memory");
    __syncthreads();
    if (threadIdx.x == 0) {
        unsigned* bar = b.bar;
        __builtin_amdgcn_s_waitcnt(0);
        unsigned nloc = b.st[0], nx = b.st[1];
        if (nloc == 0u) { xcd_barrier_complete(bar, b.x, nloc, nx); b.st[0] = nloc; b.st[1] = nx; }
        const unsigned old = xb_add(&bar[XB_XSUB(b.x)], 1u);
        const unsigned gen = old / nloc;
        if (old + 1u == (gen + 1u) * nloc) {
            __builtin_amdgcn_fence(__ATOMIC_RELEASE, "agent");
            asm volatile("s_waitcnt vmcnt(0)" ::: "memory");
            const unsigned og = xb_add(&bar[XB_TOP], 1u);
            const unsigned tg = og / nx;
            if (og + 1u == (tg + 1u) * nx) xb_add(&bar[XB_TOPGEN], 1u);
            else XB_SPIN(xb_ld(&bar[XB_TOPGEN]) == tg, bar);
            __builtin_amdgcn_fence(__ATOMIC_ACQUIRE, "agent");
            xb_add(&bar[XB_XGEN(b.x)], 1u);
            asm volatile("s_waitcnt vmcnt(0)" ::: "memory");
        } else {
            XB_SPIN(xb_ld(&bar[XB_XGEN(b.x)]) == gen, bar);
            __builtin_amdgcn_fence(__ATOMIC_ACQUIRE, "agent");
            asm volatile("s_waitcnt vmcnt(0)" ::: "memory");
        }
    }
    __syncthreads();
}

constexpr size_t WS_CTL = 539 * MiB, CTL_BYTES = 16384;
constexpr int MISC_OFF = 147456 - 128;
struct Params { const float *x, *norm_w, *w_in, *qn, *kn, *ona, *onb, *w_out, *fnorm; float* out; unsigned char* ws; int ph_lo, ph_hi; };

__global__ void __launch_bounds__(512, 2) mk_fwd(Params p) {
    extern __shared__ __attribute__((aligned(16))) unsigned char lds[];
    volatile LAS unsigned* MISC = (volatile LAS unsigned*)((LAS unsigned char*)lds + MISC_OFF);
    if (threadIdx.x < 32) MISC[threadIdx.x] = 0u;
    __syncthreads();
    XcdBarrier bar = xcd_barrier_post((unsigned*)(p.ws + WS_CTL), MISC + 8);
    for (int ph = p.ph_lo; ph < p.ph_hi; ++ph) {
        const int tid = otid(), lane = tid & 63, wave = __builtin_amdgcn_readfirstlane(tid >> 6);
        int G = gridDim.x, bx = blockIdx.x; asm volatile("" : "+s"(G), "+s"(bx));
        const int vcu = (G % 8 == 0) ? (bx % 8) * (G / 8) + bx / 8 : bx;
        const int gw = vcu * 8 + wave, NGW = G * 8;
        size_t zoff = 0; asm volatile("" : "+s"(zoff));
        unsigned char* ws = p.ws + zoff;
        bf16_t* W1T = (bf16_t*)(ws + WS_W1T); bf16_t* W2T = (bf16_t*)(ws + WS_W2T); bf16_t* H = (bf16_t*)(ws + WS_H); bf16_t* PROJ = (bf16_t*)(ws + WS_PROJ);
        bf16_t* YA = (bf16_t*)(ws + WS_YA); bf16_t* YB = (bf16_t*)(ws + WS_YB); float* LSE = (float*)(ws + WS_LSE);
        float* RCOS = (float*)(ws + WS_ROPE); float* RSIN = RCOS + 192 * 32;
        bf16_t* XB = (bf16_t*)(ws + WS_XB); float* ROWSQ = (float*)(ws + WS_ROWSQ);
        if (ph == 0) {
            LAS float* scr = (LAS float*)((LAS unsigned char*)lds + wave * 16384);
            constexpr int I1 = (DM / 64) * (DIN / 32), I2 = (DM / 64) * (DM / 32), IL = I1 + I2;
            DUPREP(0) for (int it = gw; it < DEPTH * IL; it += NGW) {
                const int l = it / IL, r = it % IL;
                if (r < I1) p0_transpose_item(p.w_in + (size_t)l * DM * DIN, DM, DIN, W1T + (size_t)l * DIN * DM, scr, r, lane, p.norm_w + (size_t)l * DM);
                else p0_transpose_item(p.w_out + (size_t)l * DM * DM, DM, DM, W2T + (size_t)l * DM * DM, scr, r - I1, lane, nullptr);
            }
            for (int m = gw; m < M; m += NGW) {
                const f32x4* xr = (const f32x4*)(p.x + (size_t)m * DM) + lane; v2u* o8 = (v2u*)(XB + (size_t)m * DM) + lane; float sq = 0.f;
#pragma unroll
                for (int j = 0; j < 8; ++j) { const f32x4 v = xr[64 * j]; v2u w; w.x = pk2(v.x, v.y); w.y = pk2(v.z, v.w); o8[64 * j] = w;
                    const float r0 = bflo(w.x), r1 = bfhi(w.x), r2 = bflo(w.y), r3 = bfhi(w.y); sq += (r0 * r0 + r1 * r1) + (r2 * r2 + r3 * r3); }
                sq = wave_sum(sq); if (lane < 32) ROWSQ[(size_t)m * 32 + lane] = (lane == 0) ? sq : 0.f;
            }
            for (int i = gw * 64 + lane; i < 192 * 32; i += NGW * 64) {
                const int pos = i >> 5, f = i & 31; const float pv = (float)(pos < 128 ? pos : pos - 128);
                float s, c; sincos_acc(pv * INV_FREQ[f], s, c); RCOS[i] = c; RSIN[i] = s;
            }
        } else if (ph == N_PHASES - 1) {
            for (int m = gw; m < M; m += NGW) {
                f32x4* xr = (f32x4*)(p.out + (size_t)m * DM) + lane; const f32x4* wr_ = (const f32x4*)p.fnorm + lane; const v2u* xb8 = (const v2u*)(XB + (size_t)m * DM) + lane;
                const float rstd = 1.0f / sqrtf(wave_sum(lane < 32 ? ROWSQ[((size_t)DEPTH * M + m) * 32 + lane] : 0.f) * (1.0f / DM) + EPS);
#pragma unroll
                for (int j = 0; j < 8; ++j) { const v2u w = xb8[64 * j]; const f32x4 v = {bflo(w.x), bfhi(w.x), bflo(w.y), bfhi(w.y)}; xr[64 * j] = v * rstd * wr_[64 * j]; }
            }
        } else {
            const int l = (ph - 1) / 5, st = (ph - 1) % 5 + 1;
            if (st == 1) {
                pg8::Gemm g{XB, W1T + (size_t)l * DIN * DM, M, DIN, DM}; pg8::StaticOrder S; S.init(M, DIN, G, bx);
                pg8::EpiHeadMajor E{PROJ, M, ROWSQ + (size_t)l * M * 32, 1.0f / DM, EPS};
#ifndef MK_NO_G1
                DUPREP(2) pg8::gemm_phase<pg8::EpiHeadMajor, pg8::StaticOrder, PG8_ALIGN, PG8_SP2>((PG8_LAS unsigned char*)lds, g, S, E);
#endif
            } else if (st == 2) {
                const float* qg = p.qn + l * HD; const float* kg = p.kn + l * HD;
                constexpr int QKU = 4;
                for (int it0 = gw; it0 < M * 10 / 4; it0 += QKU * NGW) {
                    const int j = lane & 15, half = j >> 3, jj = j & 7, e = half * 64 + 4 * jj;
                    v2u a[QKU], b[QKU]; f32x4 cs[QKU], sn[QKU]; bf16_t* pp[QKU]; bool isq[QKU];
#pragma unroll
                    for (int u = 0; u < QKU; ++u) { const int it = min(it0 + u * NGW, M * 10 / 4 - 1);
                        const int g = it * 4 + (lane >> 4), row = g / 10, hs = g - row * 10; isq[u] = hs < 8;
                        pp[u] = PROJ + ((size_t)hs * M + row) * HD + e; a[u] = *(const v2u*)pp[u]; b[u] = *(const v2u*)(pp[u] + 32);
                        const int t = row & (T - 1), pos = half ? 128 + (t & 63) : (t >> 6);
                        cs[u] = *(const f32x4*)(RCOS + pos * 32 + 4 * jj); sn[u] = *(const f32x4*)(RSIN + pos * 32 + 4 * jj); }
                    asm volatile("" ::: "memory");
#pragma unroll
                    for (int u = 0; u < QKU; ++u) {
                        float x1[4] = {bflo(a[u].x), bfhi(a[u].x), bflo(a[u].y), bfhi(a[u].y)}, x2[4] = {bflo(b[u].x), bfhi(b[u].x), bflo(b[u].y), bfhi(b[u].y)};
                        float ss = 0.f;
#pragma unroll
                        for (int i = 0; i < 4; ++i) ss += x1[i] * x1[i] + x2[i] * x2[i];
                        ss += __shfl_xor(ss, 1); ss += __shfl_xor(ss, 2); ss += __shfl_xor(ss, 4); ss += __shfl_xor(ss, 8);
                        const float rstd = 1.0f / sqrtf(ss * (1.0f / HD) + EPS);
                        const float* gn = isq[u] ? qg : kg;
                        const f32x4 g1 = *(const f32x4*)(gn + e), g2 = *(const f32x4*)(gn + e + 32);
                        float o1[4], o2[4];
#pragma unroll
                        for (int i = 0; i < 4; ++i) { const float y1 = x1[i] * rstd * g1[i], y2 = x2[i] * rstd * g2[i]; o1[i] = y1 * cs[u][i] - y2 * sn[u][i]; o2[i] = y1 * sn[u][i] + y2 * cs[u][i]; }
                        v2u w1, w2; w1.x = pk2(o1[0], o1[1]); w1.y = pk2(o1[2], o1[3]); w2.x = pk2(o2[0], o2[1]); w2.y = pk2(o2[2], o2[3]);
                        if (it0 + u * NGW < M * 10 / 4) { *(v2u*)pp[u] = w1; *(v2u*)(pp[u] + 32) = w2; }
                    }
                }
#ifndef MK_NO_DIL
                DUPREP(3) for (int u = vcu; u < 1536; u += G) {
                    const int pt = u >> 9, rem = u & 511, b = rem >> 8, h = (rem >> 5) & 7, w = rem & 31;
                    const int d = (pt == 0) ? 1 : (pt == 1) ? 4 : 16, res = w & (d - 1), blk = w / d, i0 = blk * 256, nsub = T / d;
                    const float slope = __builtin_amdgcn_exp2f(-(float)(h + 1));
                    const float nslopeC = -slope * (float)d * att::LOG2E;
                    const size_t tok0 = (size_t)b * T + res;
                    const att::bf16* Pb = (const att::bf16*)PROJ + ((size_t)h * M + tok0) * HD;
                    const long rs = (long)d * HD;
                    att::attn_body<true>(Pb + (size_t)H_QB * M * HD + (long)i0 * rs, Pb + (size_t)H_KB * M * HD, Pb + (size_t)H_VB * M * HD, rs, rs,
                                         (att::bf16*)YB + ((size_t)pt * M + tok0 + (size_t)i0 * d) * DB + h * HD, (long)d * DB,
                                         LSE + ((size_t)pt * M + tok0 + (size_t)i0 * d) * 8 + h, d * 8, i0, nsub, nslopeC, 0, (char*)lds);
                }
#endif
            } else if (st == 3) {
#ifndef MK_NO_DENSE
                DUPREP(4) for (int u = vcu; u < 512; u += G) {
                    const int combo = u >> 7, b = combo >> 1, kvh = combo & 1, h = kvh * 4 + ((u >> 5) & 3), qb = u & 31;
                    const att::bf16* Pb = (const att::bf16*)PROJ + (size_t)b * T * HD;
                    att::attn_body<false>(Pb + ((size_t)(H_QA + h) * M + qb * 256) * HD, Pb + (size_t)(H_KA + kvh) * M * HD, Pb + (size_t)(H_VA + kvh) * M * HD, HD, HD,
                                          (att::bf16*)YA + ((size_t)b * T + qb * 256) * DA + h * HD, DA, nullptr, 0, 0, 0, 0.f, T, (char*)lds);
                }
#endif
            } else if (st == 4) {
                const float* wa = p.ona + (size_t)l * DA; const float* wb = p.onb + (size_t)l * DB;
                DUPREP(5) for (int m = gw; m < M; m += NGW) {
                    float ya[2][8], yb[2][8]; float ssa = 0.f, ssb = 0.f;
#pragma unroll
                    for (int j = 0; j < 2; ++j) { const int c = lane + 64 * j, hh = c >> 4;
                        const v4u a = *(const v4u*)(YA + (size_t)m * DA + 8 * c);
                        ya[j][0] = bflo(a.x); ya[j][1] = bfhi(a.x); ya[j][2] = bflo(a.y); ya[j][3] = bfhi(a.y); ya[j][4] = bflo(a.z); ya[j][5] = bfhi(a.z); ya[j][6] = bflo(a.w); ya[j][7] = bfhi(a.w);
                        const float l0 = LSE[((size_t)0 * M + m) * 8 + hh], l1 = LSE[((size_t)1 * M + m) * 8 + hh], l2 = LSE[((size_t)2 * M + m) * 8 + hh];
                        const float mx = fmaxf(l0, fmaxf(l1, l2)); const float e0 = __builtin_amdgcn_exp2f(l0 - mx), e1 = __builtin_amdgcn_exp2f(l1 - mx), e2 = __builtin_amdgcn_exp2f(l2 - mx);
                        const float inv = 1.0f / (e0 + e1 + e2); const float w0 = e0 * inv, w1 = e1 * inv, w2 = e2 * inv;
                        const v4u b0 = *(const v4u*)(YB + ((size_t)0 * M + m) * DB + 8 * c), b1 = *(const v4u*)(YB + ((size_t)1 * M + m) * DB + 8 * c), b2 = *(const v4u*)(YB + ((size_t)2 * M + m) * DB + 8 * c);
                        yb[j][0] = w0 * bflo(b0.x) + w1 * bflo(b1.x) + w2 * bflo(b2.x); yb[j][1] = w0 * bfhi(b0.x) + w1 * bfhi(b1.x) + w2 * bfhi(b2.x);
                        yb[j][2] = w0 * bflo(b0.y) + w1 * bflo(b1.y) + w2 * bflo(b2.y); yb[j][3] = w0 * bfhi(b0.y) + w1 * bfhi(b1.y) + w2 * bfhi(b2.y);
                        yb[j][4] = w0 * bflo(b0.z) + w1 * bflo(b1.z) + w2 * bflo(b2.z); yb[j][5] = w0 * bfhi(b0.z) + w1 * bfhi(b1.z) + w2 * bfhi(b2.z);
                        yb[j][6] = w0 * bflo(b0.w) + w1 * bflo(b1.w) + w2 * bflo(b2.w); yb[j][7] = w0 * bfhi(b0.w) + w1 * bfhi(b1.w) + w2 * bfhi(b2.w);
#pragma unroll
                        for (int i = 0; i < 8; ++i) { ssa += ya[j][i] * ya[j][i]; ssb += yb[j][i] * yb[j][i]; } }
                    const float ra = 1.0f / sqrtf(wave_sum(ssa) * (1.0f / DA) + EPS), rb = 1.0f / sqrtf(wave_sum(ssb) * (1.0f / DB) + EPS);
#pragma unroll
                    for (int j = 0; j < 2; ++j) { const int c = lane + 64 * j;
                        const v4u ga = *(const v4u*)(PROJ + ((size_t)(H_GA + (c >> 4)) * M + m) * HD + 8 * (c & 15)), gb = *(const v4u*)(PROJ + ((size_t)(H_GB + (c >> 4)) * M + m) * HD + 8 * (c & 15));
                        const float gaf[8] = {bflo(ga.x), bfhi(ga.x), bflo(ga.y), bfhi(ga.y), bflo(ga.z), bfhi(ga.z), bflo(ga.w), bfhi(ga.w)};
                        const float gbf[8] = {bflo(gb.x), bfhi(gb.x), bflo(gb.y), bfhi(gb.y), bflo(gb.z), bfhi(gb.z), bflo(gb.w), bfhi(gb.w)};
                        const f32x4 wa0 = *(const f32x4*)(wa + 8 * c), wa1 = *(const f32x4*)(wa + 8 * c + 4), wb0 = *(const f32x4*)(wb + 8 * c), wb1 = *(const f32x4*)(wb + 8 * c + 4);
                        float za[8], zb[8];
#pragma unroll
                        for (int i = 0; i < 8; ++i) { const float wai = i < 4 ? wa0[i & 3] : wa1[i & 3], wbi = i < 4 ? wb0[i & 3] : wb1[i & 3];
                            const float sa = gaf[i] / (1.0f + __expf(-gaf[i])), sb = gbf[i] / (1.0f + __expf(-gbf[i]));
                            za[i] = ya[j][i] * ra * wai * sa; zb[i] = yb[j][i] * rb * wbi * sb; }
                        v4u oa, ob; oa.x = pk2(za[0], za[1]); oa.y = pk2(za[2], za[3]); oa.z = pk2(za[4], za[5]); oa.w = pk2(za[6], za[7]);
                        ob.x = pk2(zb[0], zb[1]); ob.y = pk2(zb[2], zb[3]); ob.z = pk2(zb[4], zb[5]); ob.w = pk2(zb[6], zb[7]);
                        *(v4u*)(H + (size_t)m * DM + 8 * c) = oa; *(v4u*)(H + (size_t)m * DM + DA + 8 * c) = ob; }
                }
            } else {
                pg8::Gemm g{H, W2T + (size_t)l * DM * DM, M, DM, DM}; pg8::StaticOrder S; S.init(M, DM, G, bx);
                pg8::EpiResF32 E{XB, ROWSQ + (size_t)(l + 1) * M * 32, DM};
#ifndef MK_NO_G2
                pg8::gemm_phase<pg8::EpiResF32, pg8::StaticOrder, PG8_ALIGN, PG8_SP2>((PG8_LAS unsigned char*)lds, g, S, E);
#endif
            }
        }
        if (ph + 1 < p.ph_hi) { if (ph == 0) cg::this_grid().sync(); else xcd_barrier(bar); if (MK_DUP & 64) xcd_barrier(bar); }
    }
}

extern "C" void kernel_launch(void* const* d_in, const int* in_sizes, int n_in, void* d_out, int out_size, void* d_ws, size_t ws_size, hipStream_t stream) {
    static int grid = 0;
    if (grid == 0) {
        if (n_in != 9 || in_sizes[0] != M * DM || out_size != M * DM || ws_size < WS_END) { fprintf(stderr, "kernel_launch: unexpected shapes (n_in %d, ws %zu)\n", n_in, ws_size); grid = -1; return; }
        int dev = 0, cus = 0, per_cu = 0;
        hipGetDevice(&dev); hipDeviceGetAttribute(&cus, hipDeviceAttributeMultiprocessorCount, dev);
        if (hipFuncSetAttribute((const void*)mk_fwd, hipFuncAttributeMaxDynamicSharedMemorySize, LDS_BYTES) != hipSuccess) { fprintf(stderr, "kernel_launch: hipFuncSetAttribute failed\n"); grid = -1; return; }
        if (hipOccupancyMaxActiveBlocksPerMultiprocessor(&per_cu, (const void*)mk_fwd, 512, LDS_BYTES) != hipSuccess || per_cu < 1) per_cu = 1;
        (void)hipGetLastError();
        grid = cus * per_cu;
    }
    if (grid < 0) return;
    Params p{};
    p.x = (const float*)d_in[0]; p.norm_w = (const float*)d_in[1]; p.w_in = (const float*)d_in[2]; p.qn = (const float*)d_in[3]; p.kn = (const float*)d_in[4];
    p.ona = (const float*)d_in[5]; p.onb = (const float*)d_in[6]; p.w_out = (const float*)d_in[7]; p.fnorm = (const float*)d_in[8];
    p.out = (float*)d_out; p.ws = (unsigned char*)d_ws;
    if (hipMemsetAsync((char*)d_ws + WS_CTL, 0, CTL_BYTES, stream) != hipSuccess) { fprintf(stderr, "kernel_launch: memset failed\n"); return; }
#if MK_ONE_LAUNCH
    p.ph_lo = 0; p.ph_hi = N_PHASES;
    void* args[] = {&p};
    hipError_t e = hipLaunchCooperativeKernel((const void*)mk_fwd, dim3(grid), dim3(512), args, LDS_BYTES, stream);
    if (e != hipSuccess) fprintf(stderr, "kernel_launch: cooperative launch failed: %s (grid %d)\n", hipGetErrorString(e), grid);
#else
    for (int ph = 0; ph < N_PHASES; ++ph) { p.ph_lo = ph; p.ph_hi = ph + 1; hipLaunchKernelGGL(mk_fwd, dim3(grid), dim3(512), LDS_BYTES, stream, p); }
#endif
}
```

```cpp
#include <hip/hip_runtime.h>
#include <hip/hip_bf16.h>
#include <hip/hip_cooperative_groups.h>
#include <cstdio>
#include <cstdint>
namespace cg = cooperative_groups;

#ifndef MK_DUP
#define MK_DUP 0
#endif
#define DUPREP(k) for (int rep_ = 0; rep_ < 1 + ((MK_DUP >> (k)) & 1); ++rep_)
#ifndef MK_PVPIPE
#define MK_PVPIPE 1
#endif
#ifndef MK_SGB
#define MK_SGB 0
#endif
#ifndef MK_PP
#define MK_PP 1
#endif
#ifndef MK_PROBE_V
#define MK_PROBE_V 0
#endif
#ifndef MK_ONE_LAUNCH
#define MK_ONE_LAUNCH 1
#endif

constexpr int BATCH = 2, T = 8192, DM = 2048, DEPTH = 4, HD = 128, DA = 1024, DB = 1024, DIN = 6656, M = BATCH * T;
constexpr int C_QA = 0, C_KA = 1024, C_VA = 1280, C_GA = 1536, C_QB = 2560, C_KB = 3584, C_VB = 4608, C_GB = 5632;
constexpr int H_QA = 0, H_KA = 8, H_VA = 10, H_GA = 12, H_QB = 20, H_KB = 28, H_VB = 36, H_GB = 44;
constexpr float EPS = 1e-6f;
__device__ __forceinline__ int otid() { int t = threadIdx.x; asm volatile("" : "+v"(t)); return t; }

namespace pg8 {
#define PG8_LAS __attribute__((address_space(3)))
typedef unsigned short bf16_t;
typedef short bf16x8 __attribute__((ext_vector_type(8)));
typedef float f32x4 __attribute__((ext_vector_type(4)));
typedef unsigned u32x4 __attribute__((ext_vector_type(4)));
constexpr int BM = 256, BK = 64, HALF = 128, HTB = HALF * BK * 2  , STAGE_BYTES = 8 * HTB, NXCD = 8, WGM = 8;

__host__ __device__ __forceinline__ int lds_byte(int r, int c) { const int st = (r >> 4) * 2 + (c >> 5), rr = r & 15, cc = c & 31, ob = rr * 64 + cc * 2; return st * 1024 + (ob ^ (((ob >> 9) & 1) << 5)); }
__host__ __device__ __forceinline__ void stage_rc(int b, int& R, int& C) { const int st = b / 1024, sb = b % 1024, swz = sb ^ (((sb >> 9) & 1) << 5); R = (st >> 1) * 16 + swz / 64; C = (st & 1) * 32 + (swz % 64) / 2; }
__host__ __device__ __forceinline__ int perm32(int rho) { const int n = rho >> 4, i = rho & 15; return 8 * (i >> 2) + 4 * n + (i & 3); }

struct Unit { int pm, pn; };
struct Gemm { const bf16_t* A; const bf16_t* Bt; int M, N, K; };

struct StaticOrder {
    int nM, nN, nwg, G, c;
    __host__ __device__ void init(int M, int N, int G_, int c_) { nM = M / BM; nN = N / BM; nwg = nM * nN; G = G_; c = c_; }
    __host__ __device__ bool next(int i, Unit& u) const {
        const long L = (long)i * G + c; if (L >= nwg) return false;
        int wgid = (int)L; { const int q = nwg / NXCD, r = nwg % NXCD, xcd = wgid % NXCD, off = wgid / NXCD; wgid = (xcd < r ? xcd * (q + 1) : r * (q + 1) + (xcd - r) * q) + off; }
        const int nig = WGM * nN, gid = wgid / nig, fm = gid * WGM, gsz = (nM - fm) < WGM ? (nM - fm) : WGM;
        u.pm = fm + ((wgid % nig) % gsz); u.pn = (wgid % nig) / gsz; return true;
    }
    __device__ __forceinline__ void a_ready(const Unit&) const {}
    __device__ __forceinline__ void done(const Unit&) const {}
};

__device__ __forceinline__ unsigned cvt_pk_bf16(float lo, float hi) { unsigned r; asm volatile("v_cvt_pk_bf16_f32 %0, %1, %2" : "=v"(r) : "v"(lo), "v"(hi)); return r; }
typedef float f32x2 __attribute__((ext_vector_type(2)));
__device__ __forceinline__ f32x2 gelu_pk(f32x2 v) {
    const f32x2 av = __builtin_elementwise_abs(v), d = av * 0.2316418882f + 1.0f;
    f32x2 t; t.x = __builtin_amdgcn_rcpf(d.x); t.y = __builtin_amdgcn_rcpf(d.y);
    f32x2 q = t * 0.5307027145f + (-0.7265760135f); q = q * t + 0.7107068705f; q = q * t + (-0.142248368f); q = q * t + 0.127414796f; q = q * t;
    const f32x2 s = (v * v) * (-0.72134752044f);
    f32x2 e; e.x = __builtin_amdgcn_exp2f(s.x); e.y = __builtin_amdgcn_exp2f(s.y);
    const f32x2 m = v * (q * e), r = v - m;
    f32x2 o; o.x = v.x < 0.f ? m.x : r.x; o.y = v.y < 0.f ? m.y : r.y; return o;
}

template <int ACT  > struct EpiBf16 {
    static constexpr bool PERM = true, AFTER_DRAIN = false; static_assert(ACT == 0 || ACT == 1, "EpiBf16: ACT is 0 (none) or 1 (gelu_pk)");
    bf16_t* O; int ldc; const float* bias; int split_cols; size_t split_stride; float scale0;
    __device__ __forceinline__ void operator()(const f32x4 (&acc)[2][2][4][2], const Unit& u, int wr, int wc, int fr, int fq) const {
        const int row0 = u.pm * BM + wr * 64 + fr; int colt = u.pn * BM; bf16_t* base = O;
        float sc = 1.f; if (split_cols) { const int t = colt / split_cols; base += (size_t)t * split_stride; colt -= t * split_cols; if (t == 0) sc = scale0; }
        const int col0 = colt + wc * 32 + 8 * fq, bcol0 = u.pn * BM + wc * 32 + 8 * fq;
        f32x4 bv[2][2];
#pragma unroll
        for (int bj = 0; bj < 2; ++bj)
#pragma unroll
            for (int n = 0; n < 2; ++n) bv[bj][n] = bias ? *(const f32x4*)(bias + bcol0 + bj * HALF + 4 * n) : (f32x4){0.f, 0.f, 0.f, 0.f};
#pragma unroll
        for (int ai = 0; ai < 2; ++ai)
#pragma unroll
            for (int m = 0; m < 4; ++m) { bf16_t* rowp = base + (size_t)(row0 + ai * HALF + m * 16) * ldc + col0;
#pragma unroll
                for (int bj = 0; bj < 2; ++bj) { f32x4 v0 = acc[ai][bj][m][0] + bv[bj][0], v1 = acc[ai][bj][m][1] + bv[bj][1];
                    if (ACT == 1) { f32x2 a = gelu_pk((f32x2){v0[0], v0[1]}), b = gelu_pk((f32x2){v0[2], v0[3]}), c = gelu_pk((f32x2){v1[0], v1[1]}), d = gelu_pk((f32x2){v1[2], v1[3]});
                        v0 = (f32x4){a.x, a.y, b.x, b.y}; v1 = (f32x4){c.x, c.y, d.x, d.y}; }
                    v0 = v0 * sc; v1 = v1 * sc; u32x4 w; w.x = cvt_pk_bf16(v0[0], v0[1]); w.y = cvt_pk_bf16(v0[2], v0[3]); w.z = cvt_pk_bf16(v1[0], v1[1]); w.w = cvt_pk_bf16(v1[2], v1[3]);
                    *(u32x4*)(rowp + bj * HALF) = w; } }
    }
};
struct EpiHeadMajor {
    static constexpr bool PERM = true, AFTER_DRAIN = false;
    bf16_t* O; int Mrows; const float* rowsq; float inv_k, eps;
    __device__ __forceinline__ void operator()(const f32x4 (&acc)[2][2][4][2], const Unit& u, int wr, int wc, int fr, int fq) const {
        const int row0 = u.pm * BM + wr * 64 + fr, col0 = wc * 32 + 8 * fq;
#pragma unroll
        for (int ai = 0; ai < 2; ++ai) {
            f32x4 pa[4], pb[4];
#pragma unroll
            for (int m = 0; m < 4; ++m) { const f32x4* pp = (const f32x4*)(rowsq + (size_t)(row0 + ai * HALF + m * 16) * 32 + 8 * fq); pa[m] = pp[0]; pb[m] = pp[1]; }
#pragma unroll
            for (int m = 0; m < 4; ++m) { const int row = row0 + ai * HALF + m * 16; const f32x4 a = pa[m], b = pb[m];
                float sq = ((a[0] + a[1]) + (a[2] + a[3])) + ((b[0] + b[1]) + (b[2] + b[3])); sq += __shfl_xor(sq, 16); sq += __shfl_xor(sq, 32);
                const float rs = 1.0f / sqrtf(sq * inv_k + eps);
#pragma unroll
                for (int bj = 0; bj < 2; ++bj) { const f32x4 v0 = acc[ai][bj][m][0] * rs, v1 = acc[ai][bj][m][1] * rs;
                    u32x4 w; w.x = cvt_pk_bf16(v0[0], v0[1]); w.y = cvt_pk_bf16(v0[2], v0[3]); w.z = cvt_pk_bf16(v1[0], v1[1]); w.w = cvt_pk_bf16(v1[2], v1[3]);
                    *(u32x4*)(O + ((size_t)(u.pn * 2 + bj) * Mrows + row) * HALF + col0) = w; } }
            asm volatile("" ::: "memory"); }
    }
};
struct EpiResF32 {
    static constexpr bool PERM = true, AFTER_DRAIN = false;
    bf16_t* xb; float* rowsq; int ldc;
    __device__ __forceinline__ void operator()(const f32x4 (&acc)[2][2][4][2], const Unit& u, int wr, int wc, int fr, int fq) const {
        const int col0 = u.pn * BM + wc * 32 + 8 * fq;
#pragma unroll
        for (int ai = 0; ai < 2; ++ai) {
            u32x4 pre[4][2];
#pragma unroll
            for (int m = 0; m < 4; ++m) { const size_t off = (size_t)(u.pm * BM + ai * HALF + wr * 64 + m * 16 + fr) * ldc + col0;
#pragma unroll
                for (int bj = 0; bj < 2; ++bj) pre[m][bj] = *(const u32x4*)(xb + off + bj * HALF); }
            asm volatile("" ::: "memory");
#pragma unroll
            for (int m = 0; m < 4; ++m) { const int row = u.pm * BM + ai * HALF + wr * 64 + m * 16 + fr; const size_t off = (size_t)row * ldc + col0; float ss = 0.f;
#pragma unroll
                for (int bj = 0; bj < 2; ++bj) { const u32x4 pb = pre[m][bj]; const f32x4 a0 = acc[ai][bj][m][0], a1 = acc[ai][bj][m][1];
                    u32x4 w; w.x = cvt_pk_bf16(__uint_as_float(pb.x << 16) + a0[0], __uint_as_float(pb.x & 0xffff0000u) + a0[1]); w.y = cvt_pk_bf16(__uint_as_float(pb.y << 16) + a0[2], __uint_as_float(pb.y & 0xffff0000u) + a0[3]);
                    w.z = cvt_pk_bf16(__uint_as_float(pb.z << 16) + a1[0], __uint_as_float(pb.z & 0xffff0000u) + a1[1]); w.w = cvt_pk_bf16(__uint_as_float(pb.w << 16) + a1[2], __uint_as_float(pb.w & 0xffff0000u) + a1[3]);
#pragma unroll
                    for (int q = 0; q < 4; ++q) { const float r0 = __uint_as_float(w[q] << 16), r1 = __uint_as_float(w[q] & 0xffff0000u); ss += r0 * r0 + r1 * r1; }
                    *(u32x4*)(xb + off + bj * HALF) = w; }
                ss += __shfl_xor(ss, 16); ss += __shfl_xor(ss, 32);
                if (fq == 0) rowsq[(size_t)row * 32 + u.pn * 4 + wc] = ss; }
            asm volatile("" ::: "memory"); }
    }
};


template <class Epi, class Sched, bool ALIGN_EPI = false, bool SP2 = false>
__device__ __forceinline__ void gemm_phase(PG8_LAS unsigned char* lds, const Gemm g, const Sched& S, const Epi& E) {
    const int tid = otid(), wid = __builtin_amdgcn_readfirstlane(tid >> 6), lane = tid & 63, wr = wid >> 2, wc = wid & 3, fr = lane & 15, fq = lane >> 4;
    const int K = g.K, nt = K / BK;
    unsigned voffA[2], voffB[2];
#pragma unroll
    for (int i = 0; i < 2; ++i) { int R, C; stage_rc(tid * 16 + i * 8192, R, C); const int Rb = Epi::PERM ? ((R & ~31) + perm32(R & 31)) : R;
        voffA[i] = (unsigned)(R * K + C) * 2u; voffB[i] = (unsigned)(Rb * K + C) * 2u; }
    const size_t kstep = (size_t)(BK * 2);
    const size_t hstep = (size_t)HALF * K * 2;
    const size_t tstep = 2 * hstep;
    const unsigned ldsw = (unsigned)wid * 1024u;
    const int aoff = lds_byte(wr * 64 + fr, fq * 8), boff = lds_byte(wc * 32 + fr, fq * 8);
#define PG8_SA(b, h) (((b) * 2 + (h)) * HTB)
#define PG8_SB(b, h) ((4 + (b) * 2 + (h)) * HTB)
#define PG8_STAGE(bufoff, gbase, voff) do { _Pragma("unroll") for (int _i = 0; _i < 2; ++_i) \
        __builtin_amdgcn_global_load_lds((const unsigned*)((const char*)(gbase) + (voff)[_i]), (PG8_LAS unsigned*)(lds + (bufoff) + ldsw + _i * 8192), 16, 0, 0); } while (0)
#define PG8_LDA(dst, b, h) do { _Pragma("unroll") for (int m = 0; m < 4; ++m) _Pragma("unroll") for (int k = 0; k < 2; ++k) dst[m][k] = *(const PG8_LAS bf16x8*)(lds + PG8_SA(b, h) + aoff + m * 2048 + k * 1024); } while (0)
#define PG8_LDB(dst, b, h) do { _Pragma("unroll") for (int n = 0; n < 2; ++n) _Pragma("unroll") for (int k = 0; k < 2; ++k) dst[n][k] = *(const PG8_LAS bf16x8*)(lds + PG8_SB(b, h) + boff + n * 2048 + k * 1024); } while (0)
#define PG8_MMA(ai, bj, At, Bt) do { __builtin_amdgcn_s_setprio(1); _Pragma("unroll") for (int m = 0; m < 4; ++m) _Pragma("unroll") for (int n = 0; n < 2; ++n) _Pragma("unroll") for (int k = 0; k < 2; ++k) \
        acc[ai][bj][m][n] = __builtin_amdgcn_mfma_f32_16x16x32_bf16(Bt[n][k], At[m][k], acc[ai][bj][m][n], 0, 0, 0); __builtin_amdgcn_s_setprio(0); } while (0)
#define PG8_WAIT_V(n) asm volatile("s_waitcnt vmcnt(" #n ")" ::: "memory")
#define PG8_WAIT_L(n) asm volatile("s_waitcnt lgkmcnt(" #n ")" ::: "memory")
#define PG8_BAR __builtin_amdgcn_s_barrier()
#define PG8_SCHED __builtin_amdgcn_sched_barrier(0)
    Unit cur, nxt; int ui = 0;
    if (!S.next(0, cur)) return;
    f32x4 acc[2][2][4][2];
#pragma unroll
    for (int a = 0; a < 2; ++a)
#pragma unroll
        for (int b = 0; b < 2; ++b)
#pragma unroll
            for (int m = 0; m < 4; ++m)
#pragma unroll
                for (int n = 0; n < 2; ++n) acc[a][b][m][n] = (f32x4){0.f, 0.f, 0.f, 0.f};
    bf16x8 At[4][2], B0[2][2], B1[2][2];
    const char* cA = (const char*)g.A + (size_t)cur.pm * tstep; const char* cB = (const char*)g.Bt + (size_t)cur.pn * tstep;
    S.a_ready(cur);
    if constexpr (SP2) {
        PG8_STAGE(PG8_SB(0, 0), cB, voffB); PG8_STAGE(PG8_SB(0, 1), cB + hstep, voffB); PG8_STAGE(PG8_SA(0, 0), cA, voffA); PG8_STAGE(PG8_SA(0, 1), cA + hstep, voffA);
        if (wr == 1) PG8_BAR;
        PG8_WAIT_V(2); PG8_BAR;
        PG8_STAGE(PG8_SB(1, 0), cB + kstep, voffB); PG8_STAGE(PG8_SA(1, 0), cA + kstep, voffA); PG8_STAGE(PG8_SB(1, 1), cB + hstep + kstep, voffB);
        PG8_WAIT_V(6); PG8_BAR;
    } else {
        PG8_STAGE(PG8_SB(0, 0), cB, voffB); PG8_STAGE(PG8_SA(0, 0), cA, voffA); PG8_STAGE(PG8_SB(0, 1), cB + hstep, voffB); PG8_STAGE(PG8_SA(0, 1), cA + hstep, voffA);
        if (wr == 1) PG8_BAR;
        PG8_WAIT_V(4); PG8_BAR;
        PG8_STAGE(PG8_SB(1, 0), cB + kstep, voffB); PG8_STAGE(PG8_SA(1, 0), cA + kstep, voffA); PG8_STAGE(PG8_SB(1, 1), cB + hstep + kstep, voffB);
        PG8_WAIT_V(6); PG8_BAR;
    }
    for (;;) {
        const bool has_next = S.next(ui + 1, nxt);
        const char* nA = has_next ? (const char*)g.A + (size_t)nxt.pm * tstep : cA; const char* nB = has_next ? (const char*)g.Bt + (size_t)nxt.pn * tstep : cB;
        for (int t = 0; t < nt; t += 2) {
            const bool last = (t == nt - 2);
            const char* a1 = cA + (size_t)(t + 1) * kstep;
            const char* a2 = last ? nA : cA + (size_t)(t + 2) * kstep; const char* b2 = last ? nB : cB + (size_t)(t + 2) * kstep;
            const char* a3 = a2 + kstep; const char* b3 = b2 + kstep;
            if (last && has_next) S.a_ready(nxt);
            if constexpr (SP2) {
            PG8_LDB(B0, 0, 0); PG8_LDB(B1, 0, 1); PG8_SCHED; PG8_LDA(At, 0, 0); PG8_STAGE(PG8_SA(1, 1), a1 + hstep, voffA);
            PG8_WAIT_V(8); PG8_WAIT_L(0); PG8_BAR; PG8_MMA(0, 0, At, B0); PG8_MMA(0, 1, At, B1); PG8_BAR; PG8_SCHED;
            PG8_LDA(At, 0, 1); PG8_STAGE(PG8_SB(0, 0), b2, voffB); PG8_STAGE(PG8_SB(0, 1), b2 + hstep, voffB); PG8_STAGE(PG8_SA(0, 0), a2, voffA);
            PG8_WAIT_V(8); PG8_WAIT_L(0); PG8_BAR; PG8_MMA(1, 0, At, B0); PG8_MMA(1, 1, At, B1); PG8_BAR; PG8_SCHED;
            PG8_LDB(B0, 1, 0); PG8_LDB(B1, 1, 1); PG8_SCHED; PG8_LDA(At, 1, 0); PG8_STAGE(PG8_SA(0, 1), a2 + hstep, voffA);
            PG8_WAIT_V(8); PG8_WAIT_L(0); PG8_BAR; PG8_MMA(0, 0, At, B0); PG8_MMA(0, 1, At, B1); PG8_BAR; PG8_SCHED;
            PG8_LDA(At, 1, 1); PG8_STAGE(PG8_SB(1, 0), b3, voffB); PG8_STAGE(PG8_SB(1, 1), b3 + hstep, voffB); PG8_STAGE(PG8_SA(1, 0), a3, voffA);
            PG8_WAIT_V(8); PG8_WAIT_L(0); PG8_BAR; PG8_MMA(1, 0, At, B0); PG8_MMA(1, 1, At, B1); PG8_BAR; PG8_SCHED;
            } else {
            PG8_LDB(B0, 0, 0); PG8_SCHED; PG8_LDA(At, 0, 0); PG8_STAGE(PG8_SA(1, 1), a1 + hstep, voffA);
            PG8_WAIT_L(8); PG8_BAR; PG8_WAIT_L(0); PG8_MMA(0, 0, At, B0); PG8_BAR; PG8_SCHED;
            PG8_LDB(B1, 0, 1); PG8_STAGE(PG8_SB(0, 0), b2, voffB);
            PG8_BAR; PG8_WAIT_L(0); PG8_MMA(0, 1, At, B1); PG8_BAR;
            PG8_LDA(At, 0, 1); PG8_STAGE(PG8_SA(0, 0), a2, voffA);
            PG8_BAR; PG8_WAIT_L(0); PG8_MMA(1, 0, At, B0); PG8_BAR; PG8_SCHED;
            PG8_STAGE(PG8_SB(0, 1), b2 + hstep, voffB);
            PG8_WAIT_V(6); PG8_BAR; PG8_MMA(1, 1, At, B1); PG8_BAR;
            PG8_LDB(B0, 1, 0); PG8_SCHED; PG8_LDA(At, 1, 0); PG8_STAGE(PG8_SA(0, 1), a2 + hstep, voffA);
            PG8_WAIT_L(8); PG8_BAR; PG8_WAIT_L(0); PG8_MMA(0, 0, At, B0); PG8_BAR; PG8_SCHED;
            PG8_LDB(B1, 1, 1); PG8_STAGE(PG8_SB(1, 0), b3, voffB);
            PG8_BAR; PG8_WAIT_L(0); PG8_MMA(0, 1, At, B1); PG8_BAR;
            PG8_LDA(At, 1, 1); PG8_STAGE(PG8_SA(1, 0), a3, voffA);
            PG8_BAR; PG8_WAIT_L(0); PG8_MMA(1, 0, At, B0); PG8_BAR; PG8_SCHED;
            PG8_STAGE(PG8_SB(1, 1), b3 + hstep, voffB);
            PG8_WAIT_V(6); PG8_BAR; PG8_MMA(1, 1, At, B1); PG8_BAR;
            }
        }
        if constexpr (ALIGN_EPI) { if (wr == 0) PG8_BAR; }
        if constexpr (!Epi::AFTER_DRAIN) { E(acc, cur, wr, wc, fr, fq); S.done(cur); }
        if (!has_next) break;
#pragma unroll
        for (int a = 0; a < 2; ++a)
#pragma unroll
            for (int b = 0; b < 2; ++b)
#pragma unroll
                for (int m = 0; m < 4; ++m)
#pragma unroll
                    for (int n = 0; n < 2; ++n) acc[a][b][m][n] = (f32x4){0.f, 0.f, 0.f, 0.f};
        cur = nxt; cA = nA; cB = nB; ++ui;
        if constexpr (ALIGN_EPI) { if (wr == 1) PG8_BAR; }
    }
    PG8_WAIT_V(0);
    if constexpr (!ALIGN_EPI) { if (wr == 0) PG8_BAR; }
    PG8_BAR;
    if constexpr (Epi::AFTER_DRAIN) { E.fused(acc, cur, wr, wc, fr, fq, lds, wid, lane); S.done(cur); }
#undef PG8_SA
#undef PG8_SB
#undef PG8_STAGE
#undef PG8_LDA
#undef PG8_LDB
#undef PG8_MMA
#undef PG8_WAIT_V
#undef PG8_WAIT_L
#undef PG8_BAR
#undef PG8_SCHED
}
}
#define PG8_SP2 true
#define PG8_ALIGN true
namespace att {
using bf16 = __hip_bfloat16;
constexpr int D = 128, NW = 8, QBLK = 32, KVBLK = 64;
constexpr float SCALE = 0.088388347648318440f;
constexpr float THR = 8.f;
constexpr size_t SHM_V = KVBLK * D * 2, SHM_K = KVBLK * D * 2, SHM_ATTN = 2 * SHM_V + 2 * SHM_K + NW * 64 * 4;
using bf16x8 = __attribute__((ext_vector_type(8))) short;
using s16x4  = __attribute__((ext_vector_type(4))) short;
using f32x16 = __attribute__((ext_vector_type(16))) float;
using f32x8  = __attribute__((ext_vector_type(8))) float;
using u32x4  = __attribute__((ext_vector_type(4))) unsigned;
#define KSWZ(row, colB) ((row) * 256 + ((colB) ^ (((row) & 7) << 4)))
#define SBAR() __builtin_amdgcn_sched_barrier(0)
__device__ __forceinline__ int crow(int r, int hi) { return (r & 3) + 8 * (r >> 2) + 4 * hi; }
__device__ __forceinline__ unsigned cvtpk(float lo, float hi) {
  unsigned r; asm("v_cvt_pk_bf16_f32 %0, %1, %2" : "=v"(r) : "v"(lo), "v"(hi)); return r;
}
template <typename TIn> struct Stage;
template <> struct Stage<bf16>  { using T = bf16x8;
  __device__ static __forceinline__ T ld8(const bf16* p) { return *reinterpret_cast<const bf16x8*>(p); }
  __device__ static __forceinline__ bf16x8 tobf(T x) { return x; } };
template <> struct Stage<float> { using T = f32x8;
  __device__ static __forceinline__ T ld8(const float* p) { return *reinterpret_cast<const f32x8*>(p); }
  __device__ static __forceinline__ bf16x8 tobf(T x) {
    u32x4 w = {cvtpk(x[0], x[1]), cvtpk(x[2], x[3]), cvtpk(x[4], x[5]), cvtpk(x[6], x[7])}; return *reinterpret_cast<bf16x8*>(&w); } };

__device__ __forceinline__ void partialSM(f32x16& p0, f32x16& p1, float& m_reg, float& mn, float& alpha) {
  constexpr float C = SCALE * 1.4426950408889634f;
  float pmax = p0[0]; for (int r = 1; r < 16; ++r) pmax = fmaxf(pmax, p0[r]); for (int r = 0; r < 16; ++r) pmax = fmaxf(pmax, p1[r]);
  { auto rr = __builtin_amdgcn_permlane32_swap(__float_as_uint(pmax), __float_as_uint(pmax), false, false);
    pmax = fmaxf(__uint_as_float(rr[0]), __uint_as_float(rr[1])); }
  if (__builtin_expect(__all(pmax - m_reg <= THR / SCALE), 1)) { mn = m_reg; alpha = 1.f; }
  else { mn = fmaxf(m_reg, pmax); alpha = __builtin_amdgcn_exp2f((m_reg - mn) * C); m_reg = mn; }
  float mnC = -mn * C;
  for (int r = 0; r < 16; ++r) p0[r] = fmaf(p0[r], C, mnC); for (int r = 0; r < 16; ++r) p1[r] = fmaf(p1[r], C, mnC);
  for (int r = 0; r < 16; ++r) p0[r] = __builtin_amdgcn_exp2f(p0[r]);
}
__device__ __forceinline__ void finishSM(f32x16& p0, f32x16& p1, float alpha, float& l_reg, bf16x8& pa0, bf16x8& pa1, bf16x8& pa2, bf16x8& pa3) {
  for (int r = 0; r < 16; ++r) p1[r] = __builtin_amdgcn_exp2f(p1[r]);
  float ps = 0; for (int r = 0; r < 16; ++r) ps += p0[r]; for (int r = 0; r < 16; ++r) ps += p1[r];
  { auto rr = __builtin_amdgcn_permlane32_swap(__float_as_uint(ps), __float_as_uint(ps), false, false);
    ps = __uint_as_float(rr[0]) + __uint_as_float(rr[1]); }
  l_reg = l_reg * alpha + ps;
#define PK4(P, BASE, OUT) do { unsigned a0 = cvtpk(P[BASE + 0], P[BASE + 1]), a1 = cvtpk(P[BASE + 2], P[BASE + 3]);   \
    unsigned b0 = cvtpk(P[BASE + 4], P[BASE + 5]), b1 = cvtpk(P[BASE + 6], P[BASE + 7]);                              \
    auto r0 = __builtin_amdgcn_permlane32_swap(a0, b0, false, false); auto r1 = __builtin_amdgcn_permlane32_swap(a1, b1, false, false); \
    u32x4 w = {r0[0], r1[0], r0[1], r1[1]}; OUT = *reinterpret_cast<bf16x8*>(&w); } while (0)
  PK4(p0, 0, pa0); PK4(p0, 8, pa1); PK4(p1, 0, pa2); PK4(p1, 8, pa3);
#undef PK4
}
__device__ __forceinline__ void qkt(f32x16& p0, f32x16& p1, const bf16* Ks, const bf16x8* qr, int r32, int hi) {
  p0 = f32x16{}; p1 = f32x16{};
  for (int d0 = 0; d0 < 8; ++d0) { int cb = (d0 * 16 + hi * 8) * 2;
    bf16x8 b0 = *reinterpret_cast<const bf16x8*>((const char*)Ks + KSWZ(r32, cb));
    bf16x8 b1 = *reinterpret_cast<const bf16x8*>((const char*)Ks + KSWZ(32 + r32, cb));
    p0 = __builtin_amdgcn_mfma_f32_32x32x16_bf16(b0, qr[d0], p0, 0, 0, 0);
    p1 = __builtin_amdgcn_mfma_f32_32x32x16_bf16(b1, qr[d0], p1, 0, 0, 0); }
}
__device__ __forceinline__ int v_st(int k, int c) { const int kk = (k & ~0xC) | ((k & 4) << 1) | ((k & 8) >> 1); return ((kk >> 3) * 4 + (c >> 5)) * 512 + ((kk & 7) * 32 + (c & 31)) * 2; }
__device__ __forceinline__ int v_rd_base(int lane) { return ((lane & 3) << 3) | (((lane >> 2) & 3) << 6) | (((lane >> 4) & 1) << 5) | (((lane >> 5) & 1) << 8); }
constexpr int v_rd_off(int d0, int ks, int half) { return d0 * 512 + ks * 4096 + half * 2048; }
template <int OFF> __device__ __forceinline__ s16x4 tr_read(int vb) {
  s16x4 r; asm volatile("ds_read_b64_tr_b16 %0, %1 offset:%2" : "=&v"(r) : "v"(vb), "i"(OFF) : "memory"); return r;
}
template <int D0> __device__ __forceinline__ void pv_one(f32x16& od, int vb, bf16x8 pa0, bf16x8 pa1, bf16x8 pa2, bf16x8 pa3) {
  const s16x4 l0 = tr_read<v_rd_off(D0, 0, 0)>(vb), h0 = tr_read<v_rd_off(D0, 0, 1)>(vb), l1 = tr_read<v_rd_off(D0, 1, 0)>(vb), h1 = tr_read<v_rd_off(D0, 1, 1)>(vb);
  const s16x4 l2 = tr_read<v_rd_off(D0, 2, 0)>(vb), h2 = tr_read<v_rd_off(D0, 2, 1)>(vb), l3 = tr_read<v_rd_off(D0, 3, 0)>(vb), h3 = tr_read<v_rd_off(D0, 3, 1)>(vb);
  asm volatile("s_waitcnt lgkmcnt(0)" ::: "memory"); SBAR();
#define PK(L, H) (bf16x8){L[0], L[1], L[2], L[3], H[0], H[1], H[2], H[3]}
  od = __builtin_amdgcn_mfma_f32_32x32x16_bf16(pa0, PK(l0, h0), od, 0, 0, 0);
  od = __builtin_amdgcn_mfma_f32_32x32x16_bf16(pa1, PK(l1, h1), od, 0, 0, 0);
  od = __builtin_amdgcn_mfma_f32_32x32x16_bf16(pa2, PK(l2, h2), od, 0, 0, 0);
  od = __builtin_amdgcn_mfma_f32_32x32x16_bf16(pa3, PK(l3, h3), od, 0, 0, 0);
#undef PK
}
struct VFrag { s16x4 l0, h0, l1, h1, l2, h2, l3, h3; };
template <int D0> __device__ __forceinline__ void pv_rd(VFrag& f, int vb) {
  f.l0 = tr_read<v_rd_off(D0, 0, 0)>(vb); f.h0 = tr_read<v_rd_off(D0, 0, 1)>(vb); f.l1 = tr_read<v_rd_off(D0, 1, 0)>(vb); f.h1 = tr_read<v_rd_off(D0, 1, 1)>(vb);
  f.l2 = tr_read<v_rd_off(D0, 2, 0)>(vb); f.h2 = tr_read<v_rd_off(D0, 2, 1)>(vb); f.l3 = tr_read<v_rd_off(D0, 3, 0)>(vb); f.h3 = tr_read<v_rd_off(D0, 3, 1)>(vb);
}
__device__ __forceinline__ void pv_mm(f32x16& od, const VFrag& f, bf16x8 pa0, bf16x8 pa1, bf16x8 pa2, bf16x8 pa3) {
#define PK(L, H) (bf16x8){L[0], L[1], L[2], L[3], H[0], H[1], H[2], H[3]}
  od = __builtin_amdgcn_mfma_f32_32x32x16_bf16(pa0, PK(f.l0, f.h0), od, 0, 0, 0);
  od = __builtin_amdgcn_mfma_f32_32x32x16_bf16(pa1, PK(f.l1, f.h1), od, 0, 0, 0);
  od = __builtin_amdgcn_mfma_f32_32x32x16_bf16(pa2, PK(f.l2, f.h2), od, 0, 0, 0);
  od = __builtin_amdgcn_mfma_f32_32x32x16_bf16(pa3, PK(f.l3, f.h3), od, 0, 0, 0);
#undef PK
}
#define PV_WAIT(n) do { asm volatile("s_waitcnt lgkmcnt(" #n ")" ::: "memory"); SBAR(); } while (0)
__device__ __forceinline__ void pv_d0(f32x16* o, int vb, bf16x8 pa0, bf16x8 pa1, bf16x8 pa2, bf16x8 pa3) {
#if MK_PVPIPE
  VFrag fa, fb;
  pv_rd<0>(fa, vb); pv_rd<1>(fb, vb);
  PV_WAIT(8); pv_mm(o[0], fa, pa0, pa1, pa2, pa3); SBAR();
  pv_rd<2>(fa, vb);
  PV_WAIT(8); pv_mm(o[1], fb, pa0, pa1, pa2, pa3); SBAR();
  pv_rd<3>(fb, vb);
  PV_WAIT(8); pv_mm(o[2], fa, pa0, pa1, pa2, pa3); SBAR();
  PV_WAIT(0); pv_mm(o[3], fb, pa0, pa1, pa2, pa3);
#else
  pv_one<0>(o[0], vb, pa0, pa1, pa2, pa3); pv_one<1>(o[1], vb, pa0, pa1, pa2, pa3); pv_one<2>(o[2], vb, pa0, pa1, pa2, pa3); pv_one<3>(o[3], vb, pa0, pa1, pa2, pa3);
#endif
}
constexpr int crow0(int r) { return (r & 3) + 8 * (r >> 2); }
constexpr float LOG2E = 1.4426950408889634f;
__device__ __forceinline__ void partialSM_dil(f32x16& p0, f32x16& p1, float& m_reg, float& mn, float& alpha, float dq, float dlo, float dhi, float nslopeC) {
  constexpr float C = SCALE * LOG2E;
#pragma unroll
  for (int r = 0; r < 16; ++r) {
    const float d0 = dq + (float)crow0(r), d1 = d0 + 32.f;
    const float t0 = fmaf(p0[r], C, nslopeC * fabsf(d0)), t1 = fmaf(p1[r], C, nslopeC * fabsf(d1));
    p0[r] = (d0 >= dlo && d0 <= dhi) ? t0 : -1e30f;
    p1[r] = (d1 >= dlo && d1 <= dhi) ? t1 : -1e30f;
  }
  float pmax = p0[0];
#pragma unroll
  for (int r = 1; r < 16; ++r) pmax = fmaxf(pmax, p0[r]);
#pragma unroll
  for (int r = 0; r < 16; ++r) pmax = fmaxf(pmax, p1[r]);
  { auto rr = __builtin_amdgcn_permlane32_swap(__float_as_uint(pmax), __float_as_uint(pmax), false, false);
    pmax = fmaxf(__uint_as_float(rr[0]), __uint_as_float(rr[1])); }
  if (__builtin_expect(__all(pmax - m_reg <= THR * LOG2E), 1)) { mn = m_reg; alpha = 1.f; }
  else { mn = fmaxf(m_reg, pmax); alpha = __builtin_amdgcn_exp2f(m_reg - mn); m_reg = mn; }
#pragma unroll
  for (int r = 0; r < 16; ++r) { p0[r] = p0[r] - mn; p1[r] = p1[r] - mn; }
#pragma unroll
  for (int r = 0; r < 16; ++r) p0[r] = __builtin_amdgcn_exp2f(p0[r]);
}

template <bool DIL>
__device__ __forceinline__ void attn_body(const bf16* __restrict__ Qb, const bf16* __restrict__ Kh, const bf16* __restrict__ Vh, long qs, long ks,
                                          bf16* __restrict__ Ob, long os, float* __restrict__ lse_o, int lse_s, int i0, int nsub, float nslopeC, int seq, char* lds) {
  typedef __attribute__((address_space(3))) unsigned lds_u32;
  using St = Stage<bf16>;
  const int tid = otid(), wid = __builtin_amdgcn_readfirstlane(tid >> 6), lane = tid & 63, r32 = lane & 31, hi = lane >> 5;
  char* V_lds = lds + 4 * SHM_K; char* K_lds = lds;
  float* ws = (float*)(lds + 4 * SHM_K + 4 * SHM_V) + wid * 64; float* li_l = ws; float* al_l = ws + 32;
  float m_reg = -1e30f, l_reg = 0; f32x16 o[4] = {}; bf16x8 qr[8];
  const bf16* Qw = Qb + (long)(wid * QBLK + r32) * qs + hi * 8;
#pragma unroll
  for (int d0 = 0; d0 < 8; ++d0) qr[d0] = St::ld8(Qw + d0 * 16);
  const int vb0 = (int)(uintptr_t)V_lds + v_rd_base(lane);
  const int kb = DIL ? i0 - 64 : 0;
#define KROW(k) (DIL ? (long)min(max(kb + (k), 0), nsub - 1) : (long)(k))
  int krow[2], kcol[2], vrow[2], vcol[2];
#pragma unroll
  for (int i = 0; i < 2; ++i) { const int pc = 2 * wid + i;
    krow[i] = pc * 4 + (lane >> 4); kcol[i] = (((lane & 15) ^ (krow[i] & 7)) << 3);
    const int sub = pc * 2 + (lane >> 5), kk = ((sub >> 2) << 3) + ((lane & 31) >> 2);
    vrow[i] = (kk & ~0xC) | ((kk & 4) << 1) | ((kk & 8) >> 1); vcol[i] = ((sub & 3) << 5) + ((lane & 3) << 3); }
  unsigned kdo[2], vdo[2];
#pragma unroll
  for (int i = 0; i < 2; ++i) { kdo[i] = (unsigned)(krow[i] * (int)ks + kcol[i]); vdo[i] = (unsigned)(vrow[i] * (int)ks + vcol[i]); }
#define DMA(t, buf) do { if constexpr (DIL) { _Pragma("unroll") for (int i_ = 0; i_ < 2; ++i_) { \
      __builtin_amdgcn_global_load_lds((const unsigned*)(Kh + KROW((t) * KVBLK + krow[i_]) * ks + kcol[i_]), (lds_u32*)(K_lds + (buf) * SHM_K + (2 * wid + i_) * 1024), 16, 0, 0); \
      __builtin_amdgcn_global_load_lds((const unsigned*)(Vh + KROW((t) * KVBLK + vrow[i_]) * ks + vcol[i_]), (lds_u32*)(V_lds + (buf) * SHM_V + (2 * wid + i_) * 1024), 16, 0, 0); } } \
    else { const bf16* Kt_ = Kh + (long)(t) * (KVBLK * ks); const bf16* Vt_ = Vh + (long)(t) * (KVBLK * ks); _Pragma("unroll") for (int i_ = 0; i_ < 2; ++i_) { \
      __builtin_amdgcn_global_load_lds((const unsigned*)(Kt_ + kdo[i_]), (lds_u32*)(K_lds + (buf) * SHM_K + (2 * wid + i_) * 1024), 16, 0, 0); \
      __builtin_amdgcn_global_load_lds((const unsigned*)(Vt_ + vdo[i_]), (lds_u32*)(V_lds + (buf) * SHM_V + (2 * wid + i_) * 1024), 16, 0, 0); } } } while (0)
#define ENDSTEP(j) do { if ((j) + 2 < NT) asm volatile("s_waitcnt vmcnt(4) lgkmcnt(0)\n\ts_barrier" ::: "memory"); else asm volatile("s_waitcnt vmcnt(0) lgkmcnt(0)\n\ts_barrier" ::: "memory"); } while (0)
#define RESC(a) do { if (__any((a) < 1.f)) { if (hi == 0) al_l[r32] = (a); asm volatile("s_waitcnt lgkmcnt(0)" ::: "memory"); \
    for (int d = 0; d < 4; ++d) for (int r = 0; r < 16; ++r) o[d][r] *= al_l[crow(r, hi)]; } } while (0)
#define PSM(P0, P1, MN, AL, jt) do { if constexpr (DIL) { const int t_ = otid(), iq_ = (t_ >> 6) * QBLK + (t_ & 31), hi_ = (t_ >> 5) & 1; \
      partialSM_dil(P0, P1, m_reg, MN, AL, (float)(-64 - iq_ + 4 * hi_ + 64 * (jt)), fmaxf(-64.f, (float)(-(i0 + iq_))), fminf(64.f, (float)(nsub - 1 - (i0 + iq_))), nslopeC); } \
    else partialSM(P0, P1, m_reg, MN, AL); } while (0)
#if MK_SGB
#define SGB_A() do { __builtin_amdgcn_sched_group_barrier(0x100, 4, 0); \
    _Pragma("unroll") for (int g_ = 0; g_ < 12; ++g_) { __builtin_amdgcn_sched_group_barrier(0x008, 1, 0); __builtin_amdgcn_sched_group_barrier(0x100, 1, 0); __builtin_amdgcn_sched_group_barrier(0x002, 6, 0); } \
    _Pragma("unroll") for (int g_ = 0; g_ < 4; ++g_) { __builtin_amdgcn_sched_group_barrier(0x008, 1, 0); __builtin_amdgcn_sched_group_barrier(0x002, 6, 0); } } while (0)
#else
#define SGB_A() do {} while (0)
#endif
#define KBUF(j) ((const bf16*)(K_lds + ((j) & 3) * SHM_K))
#define VBUF(j) (vb0 + ((j) & 3) * (int)SHM_V)
  f32x16 pA0, pA1, pB0, pB1; float mnA, mnB, alA, alB; bf16x8 pa0, pa1, pa2, pa3; const int NT = DIL ? 6 : seq / KVBLK;
  DMA(0, 0); DMA(1, 1);
  if constexpr (!DIL && MK_PP) { DMA(2, 2); asm volatile("s_waitcnt vmcnt(8)\n\ts_barrier" ::: "memory"); }
  else asm volatile("s_waitcnt vmcnt(4)\n\ts_barrier" ::: "memory");
  struct KFrag { bf16x8 a, b; };
  int koff[8];
#pragma unroll
  for (int d0 = 0; d0 < 8; ++d0) koff[d0] = KSWZ(r32, (d0 * 16 + hi * 8) * 2);
  const int kbase0 = (int)(uintptr_t)K_lds;
#define KRD(f, d0, kb) asm volatile("ds_read_b128 %0, %2\n\tds_read_b128 %1, %2 offset:8192" : "=&v"(f.a), "=&v"(f.b) : "v"((kb) + koff[d0]) : "memory")
#define QMM(f, d0) do { pA0 = __builtin_amdgcn_mfma_f32_32x32x16_bf16(f.a, qr[d0], pA0, 0, 0, 0); pA1 = __builtin_amdgcn_mfma_f32_32x32x16_bf16(f.b, qr[d0], pA1, 0, 0, 0); } while (0)
#define LW(n) do { asm volatile("s_waitcnt lgkmcnt(" #n ")" ::: "memory"); SBAR(); } while (0)
  if constexpr (DIL) {
    const int rlo = wid >> 1;
    for (int j = 0; j < NT; ++j) {
      if (j + 2 < NT) DMA(j + 2, (j + 2) & 3);
      if (j >= rlo && j <= rlo + 2) {
        SBAR();
        { const int kb_ = kbase0 + (j & 3) * (int)SHM_K; KFrag k0_, k1_, k2_;
          KRD(k0_, 0, kb_); KRD(k1_, 1, kb_); KRD(k2_, 2, kb_); pA0 = f32x16{}; pA1 = f32x16{};
          LW(4); QMM(k0_, 0); SBAR(); KRD(k0_, 3, kb_);
          LW(4); QMM(k1_, 1); SBAR(); KRD(k1_, 4, kb_);
          LW(4); QMM(k2_, 2); SBAR(); KRD(k2_, 5, kb_);
          LW(4); QMM(k0_, 3); SBAR(); KRD(k0_, 6, kb_);
          LW(4); QMM(k1_, 4); SBAR(); KRD(k1_, 7, kb_);
          LW(4); QMM(k2_, 5); SBAR();
          LW(2); QMM(k0_, 6); SBAR();
          LW(0); QMM(k1_, 7); SBAR(); }
        PSM(pA0, pA1, mnA, alA, j); RESC(alA);
        finishSM(pA0, pA1, alA, l_reg, pa0, pa1, pa2, pa3); SBAR();
        pv_d0(o, VBUF(j), pa0, pa1, pa2, pa3);
      }
      if (j + 1 < NT) ENDSTEP(j);
    }
  } else if constexpr (MK_PP) {
    const bool grpB = wid >= 4;
#define PP_BAR(VM) do { if (VM) { asm volatile("s_waitcnt vmcnt(4) lgkmcnt(0)\n\ts_barrier" ::: "memory"); } else { asm volatile("s_waitcnt vmcnt(0) lgkmcnt(0)\n\ts_barrier" ::: "memory"); } } while (0)
#define PP_BAR_PLAIN() asm volatile("s_waitcnt lgkmcnt(0)\n\ts_barrier" ::: "memory")
    if (grpB) PP_BAR_PLAIN();
    qkt(pA0, pA1, KBUF(0), qr, r32, hi);
    if (grpB) PP_BAR(2 < NT); else PP_BAR_PLAIN();
    for (int t = 0; t < NT; ++t) {
      if (grpB && t + 3 < NT) DMA(t + 3, (t + 3) & 3);
      PSM(pA0, pA1, mnA, alA, t); RESC(alA);
      finishSM(pA0, pA1, alA, l_reg, pa0, pa1, pa2, pa3);
#if MK_PROBE_V
      { float dm_ = alA;
#pragma unroll
        for (int q_ = 0; q_ < 32; ++q_) asm volatile("v_add_f32 %0, %0, %0" : "+v"(dm_));
        if (dm_ == 123.456f) l_reg += 1.f; }
#endif
      if (!grpB) PP_BAR(t + 2 < NT); else PP_BAR_PLAIN();
      if (!grpB && t + 3 < NT) DMA(t + 3, (t + 3) & 3);
      SBAR();
      if (t + 1 < NT) {
        const int kb_ = kbase0 + ((t + 1) & 3) * (int)SHM_K, vb_ = VBUF(t);
        KFrag k0_, k1_, k2_; VFrag fa_, fb_;
        KRD(k0_, 0, kb_); KRD(k1_, 1, kb_); KRD(k2_, 2, kb_); pv_rd<0>(fa_, vb_);
        pA0 = f32x16{}; pA1 = f32x16{};
        LW(12); QMM(k0_, 0); SBAR(); KRD(k0_, 3, kb_);
        LW(12); QMM(k1_, 1); SBAR(); KRD(k1_, 4, kb_);
        LW(4);  pv_mm(o[0], fa_, pa0, pa1, pa2, pa3); SBAR(); pv_rd<1>(fb_, vb_);
        QMM(k2_, 2); SBAR(); KRD(k2_, 5, kb_);
        LW(12); QMM(k0_, 3); SBAR(); KRD(k0_, 6, kb_);
        LW(4);  pv_mm(o[1], fb_, pa0, pa1, pa2, pa3); SBAR(); pv_rd<2>(fa_, vb_);
        QMM(k1_, 4); SBAR(); KRD(k1_, 7, kb_);
        LW(12); QMM(k2_, 5); SBAR();
        LW(2);  pv_mm(o[2], fa_, pa0, pa1, pa2, pa3); SBAR(); pv_rd<3>(fb_, vb_);
        QMM(k0_, 6); SBAR();
        LW(8);  QMM(k1_, 7); SBAR();
        LW(0);  pv_mm(o[3], fb_, pa0, pa1, pa2, pa3);
      } else pv_d0(o, VBUF(t), pa0, pa1, pa2, pa3);
      if (t + 1 < NT) { if (grpB) PP_BAR(t + 3 < NT); else PP_BAR_PLAIN(); }
    }
    if (!grpB) PP_BAR_PLAIN();
#undef PP_BAR
#undef PP_BAR_PLAIN
#undef KRD
#undef QMM
#undef LW
  } else {
  if (2 < NT) DMA(2, 2);
  qkt(pA0, pA1, KBUF(0), qr, r32, hi); PSM(pA0, pA1, mnA, alA, 0);
  ENDSTEP(0);
  for (int j = 1; j + 1 < NT; j += 2) {
    if (j + 2 < NT) DMA(j + 2, (j + 2) & 3);
    SBAR(); qkt(pB0, pB1, KBUF(j), qr, r32, hi);
    finishSM(pA0, pA1, alA, l_reg, pa0, pa1, pa2, pa3); SGB_A(); SBAR();
    pv_d0(o, VBUF(j - 1), pa0, pa1, pa2, pa3); PSM(pB0, pB1, mnB, alB, j);
    RESC(alB); ENDSTEP(j);
    if (j + 3 < NT) DMA(j + 3, (j + 3) & 3);
    SBAR(); qkt(pA0, pA1, KBUF(j + 1), qr, r32, hi);
    finishSM(pB0, pB1, alB, l_reg, pa0, pa1, pa2, pa3); SGB_A(); SBAR();
    pv_d0(o, VBUF(j), pa0, pa1, pa2, pa3); PSM(pA0, pA1, mnA, alA, j + 1);
    RESC(alA); ENDSTEP(j + 1);
  }
  SBAR(); qkt(pB0, pB1, KBUF(NT - 1), qr, r32, hi);
  finishSM(pA0, pA1, alA, l_reg, pa0, pa1, pa2, pa3); SBAR();
  pv_d0(o, VBUF(NT - 2), pa0, pa1, pa2, pa3); PSM(pB0, pB1, mnB, alB, NT - 1);
  RESC(alB);
  finishSM(pB0, pB1, alB, l_reg, pa0, pa1, pa2, pa3); SBAR();
  pv_d0(o, VBUF(NT - 1), pa0, pa1, pa2, pa3);
  }
  if (hi == 0) li_l[r32] = l_reg; asm volatile("s_waitcnt lgkmcnt(0)" ::: "memory");
  if constexpr (DIL) { if (hi == 0) lse_o[(long)(wid * QBLK + r32) * lse_s] = m_reg + __log2f(l_reg); }
  float rli[16];
#pragma unroll
  for (int r = 0; r < 16; ++r) rli[r] = __builtin_amdgcn_rcpf(li_l[crow(r, hi)]);
  bf16* Ow = Ob + (long)(wid * QBLK) * os;
#pragma unroll
  for (int r = 0; r < 16; ++r) { const int orow = crow(r, hi);
#pragma unroll
    for (int d0 = 0; d0 < 4; ++d0) Ow[(long)orow * os + d0 * 32 + r32] = __float2bfloat16(o[d0][r] * rli[r]); }
  asm volatile("s_waitcnt lgkmcnt(0)\n\ts_barrier" ::: "memory");
#undef KROW
#undef DMA
#undef ENDSTEP
#undef RESC
#undef PSM
#undef KBUF
#undef SGB_A
#undef VBUF
}
}

#define GAS __attribute__((address_space(1)))
#define LAS __attribute__((address_space(3)))
typedef unsigned short bf16_t;
typedef unsigned v4u __attribute__((ext_vector_type(4)));
typedef unsigned v2u __attribute__((ext_vector_type(2)));
typedef float f32x4 __attribute__((ext_vector_type(4)));
#define LDS_WAIT() asm volatile("s_waitcnt lgkmcnt(0)" ::: "memory")

constexpr size_t MiB = 1u << 20;
constexpr size_t WS_W1T = 0;
constexpr size_t WS_W2T = 104 * MiB;
constexpr size_t WS_H = 136 * MiB;
constexpr size_t WS_PROJ = 200 * MiB;
constexpr size_t WS_YA = 408 * MiB;
constexpr size_t WS_YB = 440 * MiB;
constexpr size_t WS_LSE = 536 * MiB;
constexpr size_t WS_ROPE = 538 * MiB;
constexpr size_t WS_XB = 540 * MiB;
constexpr size_t WS_ROWSQ = 604 * MiB;
constexpr size_t WS_END = 616 * MiB;
static_assert((size_t)DEPTH * DIN * DM * 2 <= WS_W2T - WS_W1T && (size_t)M * DIN * 2 <= WS_YA - WS_PROJ && (size_t)3 * M * DB * 2 <= WS_LSE - WS_YB, "ws map");
constexpr int LDS_BYTES = 147456;
constexpr int N_PHASES = 2 + 5 * DEPTH;

__device__ __forceinline__ unsigned f2bf(float f) { unsigned u = __builtin_bit_cast(unsigned, f); return (u + 0x7fffu + ((u >> 16) & 1u)) >> 16; }
__device__ __forceinline__ unsigned pk2(float lo, float hi) { return f2bf(lo) | (f2bf(hi) << 16); }
__device__ __forceinline__ float bflo(unsigned w) { return __uint_as_float(w << 16); }
__device__ __forceinline__ float bfhi(unsigned w) { return __uint_as_float(w & 0xffff0000u); }
__device__ __forceinline__ float wave_sum(float v) {
#pragma unroll
    for (int o = 1; o < 64; o <<= 1) v += __shfl_xor(v, o);
    return v;
}

__device__ const float INV_FREQ[32] = {1.000000000e+00f, 7.498942614e-01f, 5.623413324e-01f, 4.216965139e-01f, 3.162277639e-01f, 2.371373773e-01f, 1.778279394e-01f, 1.333521307e-01f,
    1.000000015e-01f, 7.498941571e-02f, 5.623413250e-02f, 4.216965288e-02f, 3.162277490e-02f, 2.371373773e-02f, 1.778279431e-02f, 1.333521493e-02f,
    9.999999776e-03f, 7.498941850e-03f, 5.623413250e-03f, 4.216964822e-03f, 3.162277630e-03f, 2.371373586e-03f, 1.778279431e-03f, 1.333521446e-03f,
    1.000000047e-03f, 7.498942432e-04f, 5.623413017e-04f, 4.216965172e-04f, 3.162277571e-04f, 2.371373703e-04f, 1.778279402e-04f, 1.333521504e-04f};

__device__ __forceinline__ void sincos_acc(float a, float& s, float& c) {
    const double x = (double)a, kd = __builtin_rint(x * 0.63661977236758134308);
    const int k = (int)kd; const double r = x - kd * 1.57079632679489661923, r2 = r * r;
    const double sp = r * (1.0 + r2 * (-1.0 / 6 + r2 * (1.0 / 120 + r2 * (-1.0 / 5040 + r2 * (1.0 / 362880 + r2 * (-1.0 / 39916800 + r2 * (1.0 / 6227020800.0)))))));
    const double cp = 1.0 + r2 * (-0.5 + r2 * (1.0 / 24 + r2 * (-1.0 / 720 + r2 * (1.0 / 40320 + r2 * (-1.0 / 3628800 + r2 * (1.0 / 479001600.0 + r2 * (-1.0 / 87178291200.0)))))));
    const int q = k & 3;
    const double sv = (q == 0) ? sp : (q == 1) ? cp : (q == 2) ? -sp : -cp, cv = (q == 0) ? cp : (q == 1) ? -sp : (q == 2) ? -cp : sp;
    s = (float)sv; c = (float)cv;
}

__device__ __forceinline__ void p0_transpose_item(const float* W, int K, int N, bf16_t* WT, LAS float* scr, int item, int lane, const float* kscale) {
    const int nblk = N / 32, kb = item / nblk, nb = item % nblk, k0 = 64 * kb, n0 = 32 * nb;
#pragma unroll 8
    for (int i = 0; i < 32; ++i) { const int kk = 2 * i + (lane >> 5); scr[kk * 33 + (lane & 31)] = W[(size_t)(k0 + kk) * N + n0 + (lane & 31)] * (kscale ? kscale[k0 + kk] : 1.0f); }
    LDS_WAIT(); asm volatile("" ::: "memory");
    const int c = lane & 7;
#pragma unroll
    for (int j = 0; j < 4; ++j) { const int n = (lane >> 3) + 8 * j; const LAS float* s = scr + (8 * c) * 33 + n;
        v4u o; o.x = pk2(s[0 * 33], s[1 * 33]); o.y = pk2(s[2 * 33], s[3 * 33]); o.z = pk2(s[4 * 33], s[5 * 33]); o.w = pk2(s[6 * 33], s[7 * 33]);
        *(v4u*)(WT + (size_t)(n0 + n) * K + k0 + 8 * c) = o; }
    LDS_WAIT(); asm volatile("" ::: "memory");
}

#define XB_TMO      128
#define XB_XCNT(j)  (256  + 64 * (j))
#define XB_XSUB(j)  (1280 + 64 * (j))
#define XB_XGEN(j)  (2304 + 64 * (j))
#define XB_TOP      3328
#define XB_TOPGEN   3392
#define XCD_BAR_WORDS 3456
#define XB_SPIN_CAP (1u << 18)

__device__ __forceinline__ unsigned xb_ld(unsigned* p)              { return __hip_atomic_load(p, __ATOMIC_RELAXED, __HIP_MEMORY_SCOPE_AGENT); }
__device__ __forceinline__ unsigned xb_add(unsigned* p, unsigned v) { return __hip_atomic_fetch_add(p, v, __ATOMIC_RELAXED, __HIP_MEMORY_SCOPE_AGENT); }
__device__ __forceinline__ unsigned xb_xcc_id() { return (unsigned)__builtin_amdgcn_s_getreg((3 << 11) | 20) & 0xFu; }
#define XB_SPIN(cond, bar) do { unsigned _sp = 0; while (cond) { __builtin_amdgcn_s_sleep(1); \
    if ((++_sp & 255u) == 0u) { if (xb_ld(&(bar)[XB_TMO])) break; if (_sp > XB_SPIN_CAP) { atomicAdd(&(bar)[XB_TMO], 1u); break; } } } } while (0)

struct XcdBarrier {
    unsigned* bar; unsigned x;
    volatile LAS unsigned* st;
};

__device__ __forceinline__ XcdBarrier xcd_barrier_post(unsigned* bar, volatile LAS unsigned* st) {
    XcdBarrier b; b.bar = bar; b.x = xb_xcc_id(); b.st = st;
    if (threadIdx.x == 0) (void)xb_add(&bar[XB_XCNT(b.x)], 1u);
    return b;
}
__device__ __forceinline__ void xcd_barrier_complete(unsigned* bar, unsigned x, unsigned& nloc, unsigned& nx) {
    const unsigned G = gridDim.x * gridDim.y * gridDim.z;
    unsigned sum, cnt, mine, sp = 0u;
    for (;;) {
        sum = 0u; cnt = 0u; mine = 0u;
#pragma unroll
        for (unsigned j = 0; j < 16; ++j) { const unsigned c = xb_ld(&bar[XB_XCNT(j)]); sum += c; cnt += (c > 0u) ? 1u : 0u; mine = (j == x) ? c : mine; }
        if (sum == G) break;
        __builtin_amdgcn_s_sleep(1);
        if ((++sp & 255u) == 0u) { if (xb_ld(&bar[XB_TMO])) break; if (sp > XB_SPIN_CAP) { atomicAdd(&bar[XB_TMO], 1u); break; } }
    }
    nloc = mine > 0u ? mine : 1u; nx = cnt > 0u ? cnt : 1u;
}

__device__ __forceinline__ void xcd_barrier(const XcdBarrier& b) {
    asm volatile("s_waitcnt vmcnt(0)" ::: "memory");
    __syncthreads();
    if (threadIdx.x == 0) {
        unsigned* bar = b.bar;
        __builtin_amdgcn_s_waitcnt(0);
        unsigned nloc = b.st[0], nx = b.st[1];
        if (nloc == 0u) { xcd_barrier_complete(bar, b.x, nloc, nx); b.st[0] = nloc; b.st[1] = nx; }
        const unsigned old = xb_add(&bar[XB_XSUB(b.x)], 1u);
        const unsigned gen = old / nloc;
        if (old + 1u == (gen + 1u) * nloc) {
            __builtin_amdgcn_fence(__ATOMIC_RELEASE, "agent");
            asm volatile("s_waitcnt vmcnt(0)" ::: "memory");
            const unsigned og = xb_add(&bar[XB_TOP], 1u);
            const unsigned tg = og / nx;
            if (og + 1u == (tg + 1u) * nx) xb_add(&bar[XB_TOPGEN], 1u);
            else XB_SPIN(xb_ld(&bar[XB_TOPGEN]) == tg, bar);
            __builtin_amdgcn_fence(__ATOMIC_ACQUIRE, "agent");
            xb_add(&bar[XB_XGEN(b.x)], 1u);
            asm volatile("s_waitcnt vmcnt(0)" ::: "memory");
        } else {
            XB_SPIN(xb_ld(&bar[XB_XGEN(b.x)]) == gen, bar);
            __builtin_amdgcn_fence(__ATOMIC_ACQUIRE, "agent");
            asm volatile("s_waitcnt vmcnt(0)" ::: "memory");
        }
    }
    __syncthreads();
}

constexpr size_t WS_CTL = 539 * MiB, CTL_BYTES = 16384;
constexpr int MISC_OFF = 147456 - 128;
__device__ __forceinline__ void gate_row(int m, int lane, const bf16_t* __restrict__ YA, const bf16_t* __restrict__ YB, const float* __restrict__ LSE, const bf16_t* __restrict__ PROJ,
                                         const float* __restrict__ wa, const float* __restrict__ wb, bf16_t* __restrict__ H) {
                    float ya[2][8], yb[2][8]; float ssa = 0.f, ssb = 0.f;
#pragma unroll
                    for (int j = 0; j < 2; ++j) { const int c = lane + 64 * j, hh = c >> 4;
                        const v4u a = *(const v4u*)(YA + (size_t)m * DA + 8 * c);
                        ya[j][0] = bflo(a.x); ya[j][1] = bfhi(a.x); ya[j][2] = bflo(a.y); ya[j][3] = bfhi(a.y); ya[j][4] = bflo(a.z); ya[j][5] = bfhi(a.z); ya[j][6] = bflo(a.w); ya[j][7] = bfhi(a.w);
                        const float l0 = LSE[((size_t)0 * M + m) * 8 + hh], l1 = LSE[((size_t)1 * M + m) * 8 + hh], l2 = LSE[((size_t)2 * M + m) * 8 + hh];
                        const float mx = fmaxf(l0, fmaxf(l1, l2)); const float e0 = __builtin_amdgcn_exp2f(l0 - mx), e1 = __builtin_amdgcn_exp2f(l1 - mx), e2 = __builtin_amdgcn_exp2f(l2 - mx);
                        const float inv = 1.0f / (e0 + e1 + e2); const float w0 = e0 * inv, w1 = e1 * inv, w2 = e2 * inv;
                        const v4u b0 = *(const v4u*)(YB + ((size_t)0 * M + m) * DB + 8 * c), b1 = *(const v4u*)(YB + ((size_t)1 * M + m) * DB + 8 * c), b2 = *(const v4u*)(YB + ((size_t)2 * M + m) * DB + 8 * c);
                        yb[j][0] = w0 * bflo(b0.x) + w1 * bflo(b1.x) + w2 * bflo(b2.x); yb[j][1] = w0 * bfhi(b0.x) + w1 * bfhi(b1.x) + w2 * bfhi(b2.x);
                        yb[j][2] = w0 * bflo(b0.y) + w1 * bflo(b1.y) + w2 * bflo(b2.y); yb[j][3] = w0 * bfhi(b0.y) + w1 * bfhi(b1.y) + w2 * bfhi(b2.y);
                        yb[j][4] = w0 * bflo(b0.z) + w1 * bflo(b1.z) + w2 * bflo(b2.z); yb[j][5] = w0 * bfhi(b0.z) + w1 * bfhi(b1.z) + w2 * bfhi(b2.z);
                        yb[j][6] = w0 * bflo(b0.w) + w1 * bflo(b1.w) + w2 * bflo(b2.w); yb[j][7] = w0 * bfhi(b0.w) + w1 * bfhi(b1.w) + w2 * bfhi(b2.w);
#pragma unroll
                        for (int i = 0; i < 8; ++i) { ssa += ya[j][i] * ya[j][i]; ssb += yb[j][i] * yb[j][i]; } }
                    const float ra = 1.0f / sqrtf(wave_sum(ssa) * (1.0f / DA) + EPS), rb = 1.0f / sqrtf(wave_sum(ssb) * (1.0f / DB) + EPS);
#pragma unroll
                    for (int j = 0; j < 2; ++j) { const int c = lane + 64 * j;
                        const v4u ga = *(const v4u*)(PROJ + ((size_t)(H_GA + (c >> 4)) * M + m) * HD + 8 * (c & 15)), gb = *(const v4u*)(PROJ + ((size_t)(H_GB + (c >> 4)) * M + m) * HD + 8 * (c & 15));
                        const float gaf[8] = {bflo(ga.x), bfhi(ga.x), bflo(ga.y), bfhi(ga.y), bflo(ga.z), bfhi(ga.z), bflo(ga.w), bfhi(ga.w)};
                        const float gbf[8] = {bflo(gb.x), bfhi(gb.x), bflo(gb.y), bfhi(gb.y), bflo(gb.z), bfhi(gb.z), bflo(gb.w), bfhi(gb.w)};
                        const f32x4 wa0 = *(const f32x4*)(wa + 8 * c), wa1 = *(const f32x4*)(wa + 8 * c + 4), wb0 = *(const f32x4*)(wb + 8 * c), wb1 = *(const f32x4*)(wb + 8 * c + 4);
                        float za[8], zb[8];
#pragma unroll
                        for (int i = 0; i < 8; ++i) { const float wai = i < 4 ? wa0[i & 3] : wa1[i & 3], wbi = i < 4 ? wb0[i & 3] : wb1[i & 3];
                            const float sa = gaf[i] / (1.0f + __expf(-gaf[i])), sb = gbf[i] / (1.0f + __expf(-gbf[i]));
                            za[i] = ya[j][i] * ra * wai * sa; zb[i] = yb[j][i] * rb * wbi * sb; }
                        v4u oa, ob; oa.x = pk2(za[0], za[1]); oa.y = pk2(za[2], za[3]); oa.z = pk2(za[4], za[5]); oa.w = pk2(za[6], za[7]);
                        ob.x = pk2(zb[0], zb[1]); ob.y = pk2(zb[2], zb[3]); ob.z = pk2(zb[4], zb[5]); ob.w = pk2(zb[6], zb[7]);
                        *(v4u*)(H + (size_t)m * DM + 8 * c) = oa; *(v4u*)(H + (size_t)m * DM + DA + 8 * c) = ob; }
}

struct Params { const float *x, *norm_w, *w_in, *qn, *kn, *ona, *onb, *w_out, *fnorm; float* out; unsigned char* ws; int ph_lo, ph_hi; };

__global__ void __launch_bounds__(512, 2) mk_fwd(Params p) {
    extern __shared__ __attribute__((aligned(16))) unsigned char lds[];
    volatile LAS unsigned* MISC = (volatile LAS unsigned*)((LAS unsigned char*)lds + MISC_OFF);
    if (threadIdx.x < 32) MISC[threadIdx.x] = 0u;
    __syncthreads();
    XcdBarrier bar = xcd_barrier_post((unsigned*)(p.ws + WS_CTL), MISC + 8);
    for (int ph = p.ph_lo; ph < p.ph_hi; ++ph) {
        const int tid = otid(), lane = tid & 63, wave = __builtin_amdgcn_readfirstlane(tid >> 6);
        int G = gridDim.x, bx = blockIdx.x; asm volatile("" : "+s"(G), "+s"(bx));
        const int vcu = (G % 8 == 0) ? (bx % 8) * (G / 8) + bx / 8 : bx;
        const int gw = vcu * 8 + wave, NGW = G * 8;
        size_t zoff = 0; asm volatile("" : "+s"(zoff));
        unsigned char* ws = p.ws + zoff;
        bf16_t* W1T = (bf16_t*)(ws + WS_W1T); bf16_t* W2T = (bf16_t*)(ws + WS_W2T); bf16_t* H = (bf16_t*)(ws + WS_H); bf16_t* PROJ = (bf16_t*)(ws + WS_PROJ);
        bf16_t* YA = (bf16_t*)(ws + WS_YA); bf16_t* YB = (bf16_t*)(ws + WS_YB); float* LSE = (float*)(ws + WS_LSE);
        float* RCOS = (float*)(ws + WS_ROPE); float* RSIN = RCOS + 192 * 32;
        bf16_t* XB = (bf16_t*)(ws + WS_XB); float* ROWSQ = (float*)(ws + WS_ROWSQ);
        if (ph == 0) {
            LAS float* scr = (LAS float*)((LAS unsigned char*)lds + wave * 16384);
            constexpr int I1 = (DM / 64) * (DIN / 32), I2 = (DM / 64) * (DM / 32), IL = I1 + I2;
            DUPREP(0) for (int it = gw; it < DEPTH * IL; it += NGW) {
                const int l = it / IL, r = it % IL;
                if (r < I1) p0_transpose_item(p.w_in + (size_t)l * DM * DIN, DM, DIN, W1T + (size_t)l * DIN * DM, scr, r, lane, p.norm_w + (size_t)l * DM);
                else p0_transpose_item(p.w_out + (size_t)l * DM * DM, DM, DM, W2T + (size_t)l * DM * DM, scr, r - I1, lane, nullptr);
            }
            for (int m = gw; m < M; m += NGW) {
                const f32x4* xr = (const f32x4*)(p.x + (size_t)m * DM) + lane; v2u* o8 = (v2u*)(XB + (size_t)m * DM) + lane; float sq = 0.f;
#pragma unroll
                for (int j = 0; j < 8; ++j) { const f32x4 v = xr[64 * j]; v2u w; w.x = pk2(v.x, v.y); w.y = pk2(v.z, v.w); o8[64 * j] = w;
                    const float r0 = bflo(w.x), r1 = bfhi(w.x), r2 = bflo(w.y), r3 = bfhi(w.y); sq += (r0 * r0 + r1 * r1) + (r2 * r2 + r3 * r3); }
                sq = wave_sum(sq); if (lane < 32) ROWSQ[(size_t)m * 32 + lane] = (lane == 0) ? sq : 0.f;
            }
            for (int i = gw * 64 + lane; i < 192 * 32; i += NGW * 64) {
                const int pos = i >> 5, f = i & 31; const float pv = (float)(pos < 128 ? pos : pos - 128);
                float s, c; sincos_acc(pv * INV_FREQ[f], s, c); RCOS[i] = c; RSIN[i] = s;
            }
        } else if (ph == N_PHASES - 1) {
            for (int m = gw; m < M; m += NGW) {
                f32x4* xr = (f32x4*)(p.out + (size_t)m * DM) + lane; const f32x4* wr_ = (const f32x4*)p.fnorm + lane; const v2u* xb8 = (const v2u*)(XB + (size_t)m * DM) + lane;
                const float rstd = 1.0f / sqrtf(wave_sum(lane < 32 ? ROWSQ[((size_t)DEPTH * M + m) * 32 + lane] : 0.f) * (1.0f / DM) + EPS);
#pragma unroll
                for (int j = 0; j < 8; ++j) { const v2u w = xb8[64 * j]; const f32x4 v = {bflo(w.x), bfhi(w.x), bflo(w.y), bfhi(w.y)}; xr[64 * j] = v * rstd * wr_[64 * j]; }
            }
        } else {
            const int l = (ph - 1) / 5, st = (ph - 1) % 5 + 1;
            if (st == 1) {
                pg8::Gemm g{XB, W1T + (size_t)l * DIN * DM, M, DIN, DM}; pg8::StaticOrder S; S.init(M, DIN, G, bx);
                pg8::EpiHeadMajor E{PROJ, M, ROWSQ + (size_t)l * M * 32, 1.0f / DM, EPS};
#ifndef MK_NO_G1
                DUPREP(2) pg8::gemm_phase<pg8::EpiHeadMajor, pg8::StaticOrder, PG8_ALIGN, PG8_SP2>((PG8_LAS unsigned char*)lds, g, S, E);
#endif
            } else if (st == 2) {
                const float* qg = p.qn + l * HD; const float* kg = p.kn + l * HD;
                constexpr int QKU = 4;
                for (int it0 = gw; it0 < M * 10 / 4; it0 += QKU * NGW) {
                    const int j = lane & 15, half = j >> 3, jj = j & 7, e = half * 64 + 4 * jj;
                    v2u a[QKU], b[QKU]; f32x4 cs[QKU], sn[QKU]; bf16_t* pp[QKU]; bool isq[QKU];
#pragma unroll
                    for (int u = 0; u < QKU; ++u) { const int it = min(it0 + u * NGW, M * 10 / 4 - 1);
                        const int g = it * 4 + (lane >> 4), row = g / 10, hs = g - row * 10; isq[u] = hs < 8;
                        pp[u] = PROJ + ((size_t)hs * M + row) * HD + e; a[u] = *(const v2u*)pp[u]; b[u] = *(const v2u*)(pp[u] + 32);
                        const int t = row & (T - 1), pos = half ? 128 + (t & 63) : (t >> 6);
                        cs[u] = *(const f32x4*)(RCOS + pos * 32 + 4 * jj); sn[u] = *(const f32x4*)(RSIN + pos * 32 + 4 * jj); }
                    asm volatile("" ::: "memory");
#pragma unroll
                    for (int u = 0; u < QKU; ++u) {
                        float x1[4] = {bflo(a[u].x), bfhi(a[u].x), bflo(a[u].y), bfhi(a[u].y)}, x2[4] = {bflo(b[u].x), bfhi(b[u].x), bflo(b[u].y), bfhi(b[u].y)};
                        float ss = 0.f;
#pragma unroll
                        for (int i = 0; i < 4; ++i) ss += x1[i] * x1[i] + x2[i] * x2[i];
                        ss += __shfl_xor(ss, 1); ss += __shfl_xor(ss, 2); ss += __shfl_xor(ss, 4); ss += __shfl_xor(ss, 8);
                        const float rstd = 1.0f / sqrtf(ss * (1.0f / HD) + EPS);
                        const float* gn = isq[u] ? qg : kg;
                        const f32x4 g1 = *(const f32x4*)(gn + e), g2 = *(const f32x4*)(gn + e + 32);
                        float o1[4], o2[4];
#pragma unroll
                        for (int i = 0; i < 4; ++i) { const float y1 = x1[i] * rstd * g1[i], y2 = x2[i] * rstd * g2[i]; o1[i] = y1 * cs[u][i] - y2 * sn[u][i]; o2[i] = y1 * sn[u][i] + y2 * cs[u][i]; }
                        v2u w1, w2; w1.x = pk2(o1[0], o1[1]); w1.y = pk2(o1[2], o1[3]); w2.x = pk2(o2[0], o2[1]); w2.y = pk2(o2[2], o2[3]);
                        if (it0 + u * NGW < M * 10 / 4) { *(v2u*)pp[u] = w1; *(v2u*)(pp[u] + 32) = w2; }
                    }
                }
#ifndef MK_NO_DIL
                DUPREP(3) for (int u = vcu; u < 1536; u += G) {
                    const int pt = u >> 9, rem = u & 511, b = rem >> 8, h = (rem >> 5) & 7, w = rem & 31;
                    const int d = (pt == 0) ? 1 : (pt == 1) ? 4 : 16, res = w & (d - 1), blk = w / d, i0 = blk * 256, nsub = T / d;
                    const float slope = __builtin_amdgcn_exp2f(-(float)(h + 1));
                    const float nslopeC = -slope * (float)d * att::LOG2E;
                    const size_t tok0 = (size_t)b * T + res;
                    const att::bf16* Pb = (const att::bf16*)PROJ + ((size_t)h * M + tok0) * HD;
                    const long rs = (long)d * HD;
                    att::attn_body<true>(Pb + (size_t)H_QB * M * HD + (long)i0 * rs, Pb + (size_t)H_KB * M * HD, Pb + (size_t)H_VB * M * HD, rs, rs,
                                         (att::bf16*)YB + ((size_t)pt * M + tok0 + (size_t)i0 * d) * DB + h * HD, (long)d * DB,
                                         LSE + ((size_t)pt * M + tok0 + (size_t)i0 * d) * 8 + h, d * 8, i0, nsub, nslopeC, 0, (char*)lds);
                }
#endif
            } else if (st == 3) {
#ifndef MK_NO_DENSE
                DUPREP(4) for (int u = vcu; u < 512; u += G) {
                    const int combo = u >> 7, b = combo >> 1, kvh = combo & 1, h = kvh * 4 + ((u >> 5) & 3), qb = u & 31;
                    const att::bf16* Pb = (const att::bf16*)PROJ + (size_t)b * T * HD;
                    att::attn_body<false>(Pb + ((size_t)(H_QA + h) * M + qb * 256) * HD, Pb + (size_t)(H_KA + kvh) * M * HD, Pb + (size_t)(H_VA + kvh) * M * HD, HD, HD,
                                          (att::bf16*)YA + ((size_t)b * T + qb * 256) * DA + h * HD, DA, nullptr, 0, 0, 0, 0.f, T, (char*)lds);
                }
#endif
            } else if (st == 4) {
                const float* wa = p.ona + (size_t)l * DA; const float* wb = p.onb + (size_t)l * DB;
                DUPREP(5) for (int m = gw; m < M; m += 2 * NGW) {
                    gate_row(m, lane, YA, YB, LSE, PROJ, wa, wb, H);
                    if (m + NGW < M) gate_row(m + NGW, lane, YA, YB, LSE, PROJ, wa, wb, H);
                }
            } else {
                pg8::Gemm g{H, W2T + (size_t)l * DM * DM, M, DM, DM}; pg8::StaticOrder S; S.init(M, DM, G, bx);
                pg8::EpiResF32 E{XB, ROWSQ + (size_t)(l + 1) * M * 32, DM};
#ifndef MK_NO_G2
                pg8::gemm_phase<pg8::EpiResF32, pg8::StaticOrder, PG8_ALIGN, PG8_SP2>((PG8_LAS unsigned char*)lds, g, S, E);
#endif
            }
        }
        if (ph + 1 < p.ph_hi) { if (ph == 0) cg::this_grid().sync(); else xcd_barrier(bar); if (MK_DUP & 64) xcd_barrier(bar); }
    }
}

extern "C" void kernel_launch(void* const* d_in, const int* in_sizes, int n_in, void* d_out, int out_size, void* d_ws, size_t ws_size, hipStream_t stream) {
    static int grid = 0;
    if (grid == 0) {
        if (n_in != 9 || in_sizes[0] != M * DM || out_size != M * DM || ws_size < WS_END) { fprintf(stderr, "kernel_launch: unexpected shapes (n_in %d, ws %zu)\n", n_in, ws_size); grid = -1; return; }
        int dev = 0, cus = 0, per_cu = 0;
        hipGetDevice(&dev); hipDeviceGetAttribute(&cus, hipDeviceAttributeMultiprocessorCount, dev);
        if (hipFuncSetAttribute((const void*)mk_fwd, hipFuncAttributeMaxDynamicSharedMemorySize, LDS_BYTES) != hipSuccess) { fprintf(stderr, "kernel_launch: hipFuncSetAttribute failed\n"); grid = -1; return; }
        if (hipOccupancyMaxActiveBlocksPerMultiprocessor(&per_cu, (const void*)mk_fwd, 512, LDS_BYTES) != hipSuccess || per_cu < 1) per_cu = 1;
        (void)hipGetLastError();
        grid = cus * per_cu;
    }
    if (grid < 0) return;
    Params p{};
    p.x = (const float*)d_in[0]; p.norm_w = (const float*)d_in[1]; p.w_in = (const float*)d_in[2]; p.qn = (const float*)d_in[3]; p.kn = (const float*)d_in[4];
    p.ona = (const float*)d_in[5]; p.onb = (const float*)d_in[6]; p.w_out = (const float*)d_in[7]; p.fnorm = (const float*)d_in[8];
    p.out = (float*)d_out; p.ws = (unsigned char*)d_ws;
    if (hipMemsetAsync((char*)d_ws + WS_CTL, 0, CTL_BYTES, stream) != hipSuccess) { fprintf(stderr, "kernel_launch: memset failed\n"); return; }
#if MK_ONE_LAUNCH
    p.ph_lo = 0; p.ph_hi = N_PHASES;
    void* args[] = {&p};
    hipError_t e = hipLaunchCooperativeKernel((const void*)mk_fwd, dim3(grid), dim3(512), args, LDS_BYTES, stream);
    if (e != hipSuccess) fprintf(stderr, "kernel_launch: cooperative launch failed: %s (grid %d)\n", hipGetErrorString(e), grid);
#else
    for (int ph = 0; ph < N_PHASES; ++ph) { p.ph_lo = ph; p.ph_hi = ph + 1; hipLaunchKernelGGL(mk_fwd, dim3(grid), dim3(512), LDS_BYTES, stream, p); }
#endif
}
```

```cpp
#include <hip/hip_runtime.h>
#include <hip/hip_bf16.h>
#include <hip/hip_cooperative_groups.h>
#include <cstdio>
#include <cstdint>
namespace cg = cooperative_groups;

#ifndef MK_DUP
#define MK_DUP 0
#endif
#define DUPREP(k) for (int rep_ = 0; rep_ < 1 + ((MK_DUP >> (k)) & 1); ++rep_)
#ifndef MK_PVPIPE
#define MK_PVPIPE 1
#endif
#ifndef MK_SGB
#define MK_SGB 0
#endif
#ifndef MK_PP
#define MK_PP 1
#endif
#ifndef MK_PROBE_V
#define MK_PROBE_V 0
#endif
#ifndef MK_NEGM
#define MK_NEGM 1
#endif
#ifndef MK_ONE_LAUNCH
#define MK_ONE_LAUNCH 1
#endif

constexpr int BATCH = 2, T = 8192, DM = 2048, DEPTH = 4, HD = 128, DA = 1024, DB = 1024, DIN = 6656, M = BATCH * T;
constexpr int C_QA = 0, C_KA = 1024, C_VA = 1280, C_GA = 1536, C_QB = 2560, C_KB = 3584, C_VB = 4608, C_GB = 5632;
constexpr int H_QA = 0, H_KA = 8, H_VA = 10, H_GA = 12, H_QB = 20, H_KB = 28, H_VB = 36, H_GB = 44;
constexpr float EPS = 1e-6f;
__device__ __forceinline__ int otid() { int t = threadIdx.x; asm volatile("" : "+v"(t)); return t; }

namespace pg8 {
#define PG8_LAS __attribute__((address_space(3)))
typedef unsigned short bf16_t;
typedef short bf16x8 __attribute__((ext_vector_type(8)));
typedef float f32x4 __attribute__((ext_vector_type(4)));
typedef unsigned u32x4 __attribute__((ext_vector_type(4)));
constexpr int BM = 256, BK = 64, HALF = 128, HTB = HALF * BK * 2  , STAGE_BYTES = 8 * HTB, NXCD = 8, WGM = 8;

__host__ __device__ __forceinline__ int lds_byte(int r, int c) { const int st = (r >> 4) * 2 + (c >> 5), rr = r & 15, cc = c & 31, ob = rr * 64 + cc * 2; return st * 1024 + (ob ^ (((ob >> 9) & 1) << 5)); }
__host__ __device__ __forceinline__ void stage_rc(int b, int& R, int& C) { const int st = b / 1024, sb = b % 1024, swz = sb ^ (((sb >> 9) & 1) << 5); R = (st >> 1) * 16 + swz / 64; C = (st & 1) * 32 + (swz % 64) / 2; }
__host__ __device__ __forceinline__ int perm32(int rho) { const int n = rho >> 4, i = rho & 15; return 8 * (i >> 2) + 4 * n + (i & 3); }

struct Unit { int pm, pn; };
struct Gemm { const bf16_t* A; const bf16_t* Bt; int M, N, K; };

struct StaticOrder {
    int nM, nN, nwg, G, c;
    __host__ __device__ void init(int M, int N, int G_, int c_) { nM = M / BM; nN = N / BM; nwg = nM * nN; G = G_; c = c_; }
    __host__ __device__ bool next(int i, Unit& u) const {
        const long L = (long)i * G + c; if (L >= nwg) return false;
        int wgid = (int)L; { const int q = nwg / NXCD, r = nwg % NXCD, xcd = wgid % NXCD, off = wgid / NXCD; wgid = (xcd < r ? xcd * (q + 1) : r * (q + 1) + (xcd - r) * q) + off; }
        const int nig = WGM * nN, gid = wgid / nig, fm = gid * WGM, gsz = (nM - fm) < WGM ? (nM - fm) : WGM;
        u.pm = fm + ((wgid % nig) % gsz); u.pn = (wgid % nig) / gsz; return true;
    }
    __device__ __forceinline__ void a_ready(const Unit&) const {}
    __device__ __forceinline__ void done(const Unit&) const {}
};

__device__ __forceinline__ unsigned cvt_pk_bf16(float lo, float hi) { unsigned r; asm volatile("v_cvt_pk_bf16_f32 %0, %1, %2" : "=v"(r) : "v"(lo), "v"(hi)); return r; }
typedef float f32x2 __attribute__((ext_vector_type(2)));
__device__ __forceinline__ f32x2 gelu_pk(f32x2 v) {
    const f32x2 av = __builtin_elementwise_abs(v), d = av * 0.2316418882f + 1.0f;
    f32x2 t; t.x = __builtin_amdgcn_rcpf(d.x); t.y = __builtin_amdgcn_rcpf(d.y);
    f32x2 q = t * 0.5307027145f + (-0.7265760135f); q = q * t + 0.7107068705f; q = q * t + (-0.142248368f); q = q * t + 0.127414796f; q = q * t;
    const f32x2 s = (v * v) * (-0.72134752044f);
    f32x2 e; e.x = __builtin_amdgcn_exp2f(s.x); e.y = __builtin_amdgcn_exp2f(s.y);
    const f32x2 m = v * (q * e), r = v - m;
    f32x2 o; o.x = v.x < 0.f ? m.x : r.x; o.y = v.y < 0.f ? m.y : r.y; return o;
}

template <int ACT  > struct EpiBf16 {
    static constexpr bool PERM = true, AFTER_DRAIN = false; static_assert(ACT == 0 || ACT == 1, "EpiBf16: ACT is 0 (none) or 1 (gelu_pk)");
    bf16_t* O; int ldc; const float* bias; int split_cols; size_t split_stride; float scale0;
    __device__ __forceinline__ void operator()(const f32x4 (&acc)[2][2][4][2], const Unit& u, int wr, int wc, int fr, int fq) const {
        const int row0 = u.pm * BM + wr * 64 + fr; int colt = u.pn * BM; bf16_t* base = O;
        float sc = 1.f; if (split_cols) { const int t = colt / split_cols; base += (size_t)t * split_stride; colt -= t * split_cols; if (t == 0) sc = scale0; }
        const int col0 = colt + wc * 32 + 8 * fq, bcol0 = u.pn * BM + wc * 32 + 8 * fq;
        f32x4 bv[2][2];
#pragma unroll
        for (int bj = 0; bj < 2; ++bj)
#pragma unroll
            for (int n = 0; n < 2; ++n) bv[bj][n] = bias ? *(const f32x4*)(bias + bcol0 + bj * HALF + 4 * n) : (f32x4){0.f, 0.f, 0.f, 0.f};
#pragma unroll
        for (int ai = 0; ai < 2; ++ai)
#pragma unroll
            for (int m = 0; m < 4; ++m) { bf16_t* rowp = base + (size_t)(row0 + ai * HALF + m * 16) * ldc + col0;
#pragma unroll
                for (int bj = 0; bj < 2; ++bj) { f32x4 v0 = acc[ai][bj][m][0] + bv[bj][0], v1 = acc[ai][bj][m][1] + bv[bj][1];
                    if (ACT == 1) { f32x2 a = gelu_pk((f32x2){v0[0], v0[1]}), b = gelu_pk((f32x2){v0[2], v0[3]}), c = gelu_pk((f32x2){v1[0], v1[1]}), d = gelu_pk((f32x2){v1[2], v1[3]});
                        v0 = (f32x4){a.x, a.y, b.x, b.y}; v1 = (f32x4){c.x, c.y, d.x, d.y}; }
                    v0 = v0 * sc; v1 = v1 * sc; u32x4 w; w.x = cvt_pk_bf16(v0[0], v0[1]); w.y = cvt_pk_bf16(v0[2], v0[3]); w.z = cvt_pk_bf16(v1[0], v1[1]); w.w = cvt_pk_bf16(v1[2], v1[3]);
                    *(u32x4*)(rowp + bj * HALF) = w; } }
    }
};
struct EpiHeadMajor {
    static constexpr bool PERM = true, AFTER_DRAIN = false;
    bf16_t* O; int Mrows; const float* rowsq; float inv_k, eps;
    __device__ __forceinline__ void operator()(const f32x4 (&acc)[2][2][4][2], const Unit& u, int wr, int wc, int fr, int fq) const {
        const int row0 = u.pm * BM + wr * 64 + fr, col0 = wc * 32 + 8 * fq;
#pragma unroll
        for (int ai = 0; ai < 2; ++ai) {
            f32x4 pa[4], pb[4];
#pragma unroll
            for (int m = 0; m < 4; ++m) { const f32x4* pp = (const f32x4*)(rowsq + (size_t)(row0 + ai * HALF + m * 16) * 32 + 8 * fq); pa[m] = pp[0]; pb[m] = pp[1]; }
#pragma unroll
            for (int m = 0; m < 4; ++m) { const int row = row0 + ai * HALF + m * 16; const f32x4 a = pa[m], b = pb[m];
                float sq = ((a[0] + a[1]) + (a[2] + a[3])) + ((b[0] + b[1]) + (b[2] + b[3])); sq += __shfl_xor(sq, 16); sq += __shfl_xor(sq, 32);
                const float rs = 1.0f / sqrtf(sq * inv_k + eps);
#pragma unroll
                for (int bj = 0; bj < 2; ++bj) { const f32x4 v0 = acc[ai][bj][m][0] * rs, v1 = acc[ai][bj][m][1] * rs;
                    u32x4 w; w.x = cvt_pk_bf16(v0[0], v0[1]); w.y = cvt_pk_bf16(v0[2], v0[3]); w.z = cvt_pk_bf16(v1[0], v1[1]); w.w = cvt_pk_bf16(v1[2], v1[3]);
                    *(u32x4*)(O + ((size_t)(u.pn * 2 + bj) * Mrows + row) * HALF + col0) = w; } }
            asm volatile("" ::: "memory"); }
    }
};
struct EpiResF32 {
    static constexpr bool PERM = true, AFTER_DRAIN = false;
    bf16_t* xb; float* rowsq; int ldc;
    __device__ __forceinline__ void operator()(const f32x4 (&acc)[2][2][4][2], const Unit& u, int wr, int wc, int fr, int fq) const {
        const int col0 = u.pn * BM + wc * 32 + 8 * fq;
#pragma unroll
        for (int ai = 0; ai < 2; ++ai) {
            u32x4 pre[4][2];
#pragma unroll
            for (int m = 0; m < 4; ++m) { const size_t off = (size_t)(u.pm * BM + ai * HALF + wr * 64 + m * 16 + fr) * ldc + col0;
#pragma unroll
                for (int bj = 0; bj < 2; ++bj) pre[m][bj] = *(const u32x4*)(xb + off + bj * HALF); }
            asm volatile("" ::: "memory");
#pragma unroll
            for (int m = 0; m < 4; ++m) { const int row = u.pm * BM + ai * HALF + wr * 64 + m * 16 + fr; const size_t off = (size_t)row * ldc + col0; float ss = 0.f;
#pragma unroll
                for (int bj = 0; bj < 2; ++bj) { const u32x4 pb = pre[m][bj]; const f32x4 a0 = acc[ai][bj][m][0], a1 = acc[ai][bj][m][1];
                    u32x4 w; w.x = cvt_pk_bf16(__uint_as_float(pb.x << 16) + a0[0], __uint_as_float(pb.x & 0xffff0000u) + a0[1]); w.y = cvt_pk_bf16(__uint_as_float(pb.y << 16) + a0[2], __uint_as_float(pb.y & 0xffff0000u) + a0[3]);
                    w.z = cvt_pk_bf16(__uint_as_float(pb.z << 16) + a1[0], __uint_as_float(pb.z & 0xffff0000u) + a1[1]); w.w = cvt_pk_bf16(__uint_as_float(pb.w << 16) + a1[2], __uint_as_float(pb.w & 0xffff0000u) + a1[3]);
#pragma unroll
                    for (int q = 0; q < 4; ++q) { const float r0 = __uint_as_float(w[q] << 16), r1 = __uint_as_float(w[q] & 0xffff0000u); ss += r0 * r0 + r1 * r1; }
                    *(u32x4*)(xb + off + bj * HALF) = w; }
                ss += __shfl_xor(ss, 16); ss += __shfl_xor(ss, 32);
                if (fq == 0) rowsq[(size_t)row * 32 + u.pn * 4 + wc] = ss; }
            asm volatile("" ::: "memory"); }
    }
};


template <class Epi, class Sched, bool ALIGN_EPI = false, bool SP2 = false>
__device__ __forceinline__ void gemm_phase(PG8_LAS unsigned char* lds, const Gemm g, const Sched& S, const Epi& E) {
    const int tid = otid(), wid = __builtin_amdgcn_readfirstlane(tid >> 6), lane = tid & 63, wr = wid >> 2, wc = wid & 3, fr = lane & 15, fq = lane >> 4;
    const int K = g.K, nt = K / BK;
    unsigned voffA[2], voffB[2];
#pragma unroll
    for (int i = 0; i < 2; ++i) { int R, C; stage_rc(tid * 16 + i * 8192, R, C); const int Rb = Epi::PERM ? ((R & ~31) + perm32(R & 31)) : R;
        voffA[i] = (unsigned)(R * K + C) * 2u; voffB[i] = (unsigned)(Rb * K + C) * 2u; }
    const size_t kstep = (size_t)(BK * 2);
    const size_t hstep = (size_t)HALF * K * 2;
    const size_t tstep = 2 * hstep;
    const unsigned ldsw = (unsigned)wid * 1024u;
    const int aoff = lds_byte(wr * 64 + fr, fq * 8), boff = lds_byte(wc * 32 + fr, fq * 8);
#define PG8_SA(b, h) (((b) * 2 + (h)) * HTB)
#define PG8_SB(b, h) ((4 + (b) * 2 + (h)) * HTB)
#define PG8_STAGE(bufoff, gbase, voff) do { _Pragma("unroll") for (int _i = 0; _i < 2; ++_i) \
        __builtin_amdgcn_global_load_lds((const unsigned*)((const char*)(gbase) + (voff)[_i]), (PG8_LAS unsigned*)(lds + (bufoff) + ldsw + _i * 8192), 16, 0, 0); } while (0)
#define PG8_LDA(dst, b, h) do { _Pragma("unroll") for (int m = 0; m < 4; ++m) _Pragma("unroll") for (int k = 0; k < 2; ++k) dst[m][k] = *(const PG8_LAS bf16x8*)(lds + PG8_SA(b, h) + aoff + m * 2048 + k * 1024); } while (0)
#define PG8_LDB(dst, b, h) do { _Pragma("unroll") for (int n = 0; n < 2; ++n) _Pragma("unroll") for (int k = 0; k < 2; ++k) dst[n][k] = *(const PG8_LAS bf16x8*)(lds + PG8_SB(b, h) + boff + n * 2048 + k * 1024); } while (0)
#define PG8_MMA(ai, bj, At, Bt) do { __builtin_amdgcn_s_setprio(1); _Pragma("unroll") for (int m = 0; m < 4; ++m) _Pragma("unroll") for (int n = 0; n < 2; ++n) _Pragma("unroll") for (int k = 0; k < 2; ++k) \
        acc[ai][bj][m][n] = __builtin_amdgcn_mfma_f32_16x16x32_bf16(Bt[n][k], At[m][k], acc[ai][bj][m][n], 0, 0, 0); __builtin_amdgcn_s_setprio(0); } while (0)
#define PG8_WAIT_V(n) asm volatile("s_waitcnt vmcnt(" #n ")" ::: "memory")
#define PG8_WAIT_L(n) asm volatile("s_waitcnt lgkmcnt(" #n ")" ::: "memory")
#define PG8_BAR __builtin_amdgcn_s_barrier()
#define PG8_SCHED __builtin_amdgcn_sched_barrier(0)
    Unit cur, nxt; int ui = 0;
    if (!S.next(0, cur)) return;
    f32x4 acc[2][2][4][2];
#pragma unroll
    for (int a = 0; a < 2; ++a)
#pragma unroll
        for (int b = 0; b < 2; ++b)
#pragma unroll
            for (int m = 0; m < 4; ++m)
#pragma unroll
                for (int n = 0; n < 2; ++n) acc[a][b][m][n] = (f32x4){0.f, 0.f, 0.f, 0.f};
    bf16x8 At[4][2], B0[2][2], B1[2][2];
    const char* cA = (const char*)g.A + (size_t)cur.pm * tstep; const char* cB = (const char*)g.Bt + (size_t)cur.pn * tstep;
    S.a_ready(cur);
    if constexpr (SP2) {
        PG8_STAGE(PG8_SB(0, 0), cB, voffB); PG8_STAGE(PG8_SB(0, 1), cB + hstep, voffB); PG8_STAGE(PG8_SA(0, 0), cA, voffA); PG8_STAGE(PG8_SA(0, 1), cA + hstep, voffA);
        if (wr == 1) PG8_BAR;
        PG8_WAIT_V(2); PG8_BAR;
        PG8_STAGE(PG8_SB(1, 0), cB + kstep, voffB); PG8_STAGE(PG8_SA(1, 0), cA + kstep, voffA); PG8_STAGE(PG8_SB(1, 1), cB + hstep + kstep, voffB);
        PG8_WAIT_V(6); PG8_BAR;
    } else {
        PG8_STAGE(PG8_SB(0, 0), cB, voffB); PG8_STAGE(PG8_SA(0, 0), cA, voffA); PG8_STAGE(PG8_SB(0, 1), cB + hstep, voffB); PG8_STAGE(PG8_SA(0, 1), cA + hstep, voffA);
        if (wr == 1) PG8_BAR;
        PG8_WAIT_V(4); PG8_BAR;
        PG8_STAGE(PG8_SB(1, 0), cB + kstep, voffB); PG8_STAGE(PG8_SA(1, 0), cA + kstep, voffA); PG8_STAGE(PG8_SB(1, 1), cB + hstep + kstep, voffB);
        PG8_WAIT_V(6); PG8_BAR;
    }
    for (;;) {
        const bool has_next = S.next(ui + 1, nxt);
        const char* nA = has_next ? (const char*)g.A + (size_t)nxt.pm * tstep : cA; const char* nB = has_next ? (const char*)g.Bt + (size_t)nxt.pn * tstep : cB;
        for (int t = 0; t < nt; t += 2) {
            const bool last = (t == nt - 2);
            const char* a1 = cA + (size_t)(t + 1) * kstep;
            const char* a2 = last ? nA : cA + (size_t)(t + 2) * kstep; const char* b2 = last ? nB : cB + (size_t)(t + 2) * kstep;
            const char* a3 = a2 + kstep; const char* b3 = b2 + kstep;
            if (last && has_next) S.a_ready(nxt);
            if constexpr (SP2) {
            PG8_LDB(B0, 0, 0); PG8_LDB(B1, 0, 1); PG8_SCHED; PG8_LDA(At, 0, 0); PG8_STAGE(PG8_SA(1, 1), a1 + hstep, voffA);
            PG8_WAIT_V(8); PG8_WAIT_L(0); PG8_BAR; PG8_MMA(0, 0, At, B0); PG8_MMA(0, 1, At, B1); PG8_BAR; PG8_SCHED;
            PG8_LDA(At, 0, 1); PG8_STAGE(PG8_SB(0, 0), b2, voffB); PG8_STAGE(PG8_SB(0, 1), b2 + hstep, voffB); PG8_STAGE(PG8_SA(0, 0), a2, voffA);
            PG8_WAIT_V(8); PG8_WAIT_L(0); PG8_BAR; PG8_MMA(1, 0, At, B0); PG8_MMA(1, 1, At, B1); PG8_BAR; PG8_SCHED;
            PG8_LDB(B0, 1, 0); PG8_LDB(B1, 1, 1); PG8_SCHED; PG8_LDA(At, 1, 0); PG8_STAGE(PG8_SA(0, 1), a2 + hstep, voffA);
            PG8_WAIT_V(8); PG8_WAIT_L(0); PG8_BAR; PG8_MMA(0, 0, At, B0); PG8_MMA(0, 1, At, B1); PG8_BAR; PG8_SCHED;
            PG8_LDA(At, 1, 1); PG8_STAGE(PG8_SB(1, 0), b3, voffB); PG8_STAGE(PG8_SB(1, 1), b3 + hstep, voffB); PG8_STAGE(PG8_SA(1, 0), a3, voffA);
            PG8_WAIT_V(8); PG8_WAIT_L(0); PG8_BAR; PG8_MMA(1, 0, At, B0); PG8_MMA(1, 1, At, B1); PG8_BAR; PG8_SCHED;
            } else {
            PG8_LDB(B0, 0, 0); PG8_SCHED; PG8_LDA(At, 0, 0); PG8_STAGE(PG8_SA(1, 1), a1 + hstep, voffA);
            PG8_WAIT_L(8); PG8_BAR; PG8_WAIT_L(0); PG8_MMA(0, 0, At, B0); PG8_BAR; PG8_SCHED;
            PG8_LDB(B1, 0, 1); PG8_STAGE(PG8_SB(0, 0), b2, voffB);
            PG8_BAR; PG8_WAIT_L(0); PG8_MMA(0, 1, At, B1); PG8_BAR;
            PG8_LDA(At, 0, 1); PG8_STAGE(PG8_SA(0, 0), a2, voffA);
            PG8_BAR; PG8_WAIT_L(0); PG8_MMA(1, 0, At, B0); PG8_BAR; PG8_SCHED;
            PG8_STAGE(PG8_SB(0, 1), b2 + hstep, voffB);
            PG8_WAIT_V(6); PG8_BAR; PG8_MMA(1, 1, At, B1); PG8_BAR;
            PG8_LDB(B0, 1, 0); PG8_SCHED; PG8_LDA(At, 1, 0); PG8_STAGE(PG8_SA(0, 1), a2 + hstep, voffA);
            PG8_WAIT_L(8); PG8_BAR; PG8_WAIT_L(0); PG8_MMA(0, 0, At, B0); PG8_BAR; PG8_SCHED;
            PG8_LDB(B1, 1, 1); PG8_STAGE(PG8_SB(1, 0), b3, voffB);
            PG8_BAR; PG8_WAIT_L(0); PG8_MMA(0, 1, At, B1); PG8_BAR;
            PG8_LDA(At, 1, 1); PG8_STAGE(PG8_SA(1, 0), a3, voffA);
            PG8_BAR; PG8_WAIT_L(0); PG8_MMA(1, 0, At, B0); PG8_BAR; PG8_SCHED;
            PG8_STAGE(PG8_SB(1, 1), b3 + hstep, voffB);
            PG8_WAIT_V(6); PG8_BAR; PG8_MMA(1, 1, At, B1); PG8_BAR;
            }
        }
        if constexpr (ALIGN_EPI) { if (wr == 0) PG8_BAR; }
        if constexpr (!Epi::AFTER_DRAIN) { E(acc, cur, wr, wc, fr, fq); S.done(cur); }
        if (!has_next) break;
#pragma unroll
        for (int a = 0; a < 2; ++a)
#pragma unroll
            for (int b = 0; b < 2; ++b)
#pragma unroll
                for (int m = 0; m < 4; ++m)
#pragma unroll
                    for (int n = 0; n < 2; ++n) acc[a][b][m][n] = (f32x4){0.f, 0.f, 0.f, 0.f};
        cur = nxt; cA = nA; cB = nB; ++ui;
        if constexpr (ALIGN_EPI) { if (wr == 1) PG8_BAR; }
    }
    PG8_WAIT_V(0);
    if constexpr (!ALIGN_EPI) { if (wr == 0) PG8_BAR; }
    PG8_BAR;
    if constexpr (Epi::AFTER_DRAIN) { E.fused(acc, cur, wr, wc, fr, fq, lds, wid, lane); S.done(cur); }
#undef PG8_SA
#undef PG8_SB
#undef PG8_STAGE
#undef PG8_LDA
#undef PG8_LDB
#undef PG8_MMA
#undef PG8_WAIT_V
#undef PG8_WAIT_L
#undef PG8_BAR
#undef PG8_SCHED
}
}
#define PG8_SP2 true
#define PG8_ALIGN true
namespace att {
using bf16 = __hip_bfloat16;
constexpr int D = 128, NW = 8, QBLK = 32, KVBLK = 64;
constexpr float SCALE = 0.088388347648318440f;
constexpr float THR = 8.f;
constexpr size_t SHM_V = KVBLK * D * 2, SHM_K = KVBLK * D * 2, SHM_ATTN = 2 * SHM_V + 2 * SHM_K + NW * 64 * 4;
using bf16x8 = __attribute__((ext_vector_type(8))) short;
using s16x4  = __attribute__((ext_vector_type(4))) short;
using f32x16 = __attribute__((ext_vector_type(16))) float;
using f32x8  = __attribute__((ext_vector_type(8))) float;
using u32x4  = __attribute__((ext_vector_type(4))) unsigned;
#define KSWZ(row, colB) ((row) * 256 + ((colB) ^ (((row) & 7) << 4)))
#define SBAR() __builtin_amdgcn_sched_barrier(0)
__device__ __forceinline__ int crow(int r, int hi) { return (r & 3) + 8 * (r >> 2) + 4 * hi; }
__device__ __forceinline__ unsigned cvtpk(float lo, float hi) {
  unsigned r; asm("v_cvt_pk_bf16_f32 %0, %1, %2" : "=v"(r) : "v"(lo), "v"(hi)); return r;
}
template <typename TIn> struct Stage;
template <> struct Stage<bf16>  { using T = bf16x8;
  __device__ static __forceinline__ T ld8(const bf16* p) { return *reinterpret_cast<const bf16x8*>(p); }
  __device__ static __forceinline__ bf16x8 tobf(T x) { return x; } };
template <> struct Stage<float> { using T = f32x8;
  __device__ static __forceinline__ T ld8(const float* p) { return *reinterpret_cast<const f32x8*>(p); }
  __device__ static __forceinline__ bf16x8 tobf(T x) {
    u32x4 w = {cvtpk(x[0], x[1]), cvtpk(x[2], x[3]), cvtpk(x[4], x[5]), cvtpk(x[6], x[7])}; return *reinterpret_cast<bf16x8*>(&w); } };

__device__ __forceinline__ void partialSM(f32x16& p0, f32x16& p1, float& m_reg, float& mn, float& alpha) {
  constexpr float C = SCALE * 1.4426950408889634f;
  float pmax = p0[0]; for (int r = 1; r < 16; ++r) pmax = fmaxf(pmax, p0[r]); for (int r = 0; r < 16; ++r) pmax = fmaxf(pmax, p1[r]);
  { auto rr = __builtin_amdgcn_permlane32_swap(__float_as_uint(pmax), __float_as_uint(pmax), false, false);
    pmax = fmaxf(__uint_as_float(rr[0]), __uint_as_float(rr[1])); }
  if (__builtin_expect(__all(pmax - m_reg <= THR / SCALE), 1)) { mn = m_reg; alpha = 1.f; }
  else { mn = fmaxf(m_reg, pmax); alpha = __builtin_amdgcn_exp2f((m_reg - mn) * C); m_reg = mn; }
  float mnC = -mn * C;
  for (int r = 0; r < 16; ++r) p0[r] = fmaf(p0[r], C, mnC); for (int r = 0; r < 16; ++r) p1[r] = fmaf(p1[r], C, mnC);
  for (int r = 0; r < 16; ++r) p0[r] = __builtin_amdgcn_exp2f(p0[r]);
}
__device__ __forceinline__ void finishSM(f32x16& p0, f32x16& p1, float alpha, float& l_reg, bf16x8& pa0, bf16x8& pa1, bf16x8& pa2, bf16x8& pa3) {
  for (int r = 0; r < 16; ++r) p1[r] = __builtin_amdgcn_exp2f(p1[r]);
  float ps = 0; for (int r = 0; r < 16; ++r) ps += p0[r]; for (int r = 0; r < 16; ++r) ps += p1[r];
  { auto rr = __builtin_amdgcn_permlane32_swap(__float_as_uint(ps), __float_as_uint(ps), false, false);
    ps = __uint_as_float(rr[0]) + __uint_as_float(rr[1]); }
  l_reg = l_reg * alpha + ps;
#define PK4(P, BASE, OUT) do { unsigned a0 = cvtpk(P[BASE + 0], P[BASE + 1]), a1 = cvtpk(P[BASE + 2], P[BASE + 3]);   \
    unsigned b0 = cvtpk(P[BASE + 4], P[BASE + 5]), b1 = cvtpk(P[BASE + 6], P[BASE + 7]);                              \
    auto r0 = __builtin_amdgcn_permlane32_swap(a0, b0, false, false); auto r1 = __builtin_amdgcn_permlane32_swap(a1, b1, false, false); \
    u32x4 w = {r0[0], r1[0], r0[1], r1[1]}; OUT = *reinterpret_cast<bf16x8*>(&w); } while (0)
  PK4(p0, 0, pa0); PK4(p0, 8, pa1); PK4(p1, 0, pa2); PK4(p1, 8, pa3);
#undef PK4
}
__device__ __forceinline__ void qkt(f32x16& p0, f32x16& p1, const bf16* Ks, const bf16x8* qr, int r32, int hi) {
  p0 = f32x16{}; p1 = f32x16{};
  for (int d0 = 0; d0 < 8; ++d0) { int cb = (d0 * 16 + hi * 8) * 2;
    bf16x8 b0 = *reinterpret_cast<const bf16x8*>((const char*)Ks + KSWZ(r32, cb));
    bf16x8 b1 = *reinterpret_cast<const bf16x8*>((const char*)Ks + KSWZ(32 + r32, cb));
    p0 = __builtin_amdgcn_mfma_f32_32x32x16_bf16(b0, qr[d0], p0, 0, 0, 0);
    p1 = __builtin_amdgcn_mfma_f32_32x32x16_bf16(b1, qr[d0], p1, 0, 0, 0); }
}
__device__ __forceinline__ int v_st(int k, int c) { const int kk = (k & ~0xC) | ((k & 4) << 1) | ((k & 8) >> 1); return ((kk >> 3) * 4 + (c >> 5)) * 512 + ((kk & 7) * 32 + (c & 31)) * 2; }
__device__ __forceinline__ int v_rd_base(int lane) { return ((lane & 3) << 3) | (((lane >> 2) & 3) << 6) | (((lane >> 4) & 1) << 5) | (((lane >> 5) & 1) << 8); }
constexpr int v_rd_off(int d0, int ks, int half) { return d0 * 512 + ks * 4096 + half * 2048; }
template <int OFF> __device__ __forceinline__ s16x4 tr_read(int vb) {
  s16x4 r; asm volatile("ds_read_b64_tr_b16 %0, %1 offset:%2" : "=&v"(r) : "v"(vb), "i"(OFF) : "memory"); return r;
}
template <int D0> __device__ __forceinline__ void pv_one(f32x16& od, int vb, bf16x8 pa0, bf16x8 pa1, bf16x8 pa2, bf16x8 pa3) {
  const s16x4 l0 = tr_read<v_rd_off(D0, 0, 0)>(vb), h0 = tr_read<v_rd_off(D0, 0, 1)>(vb), l1 = tr_read<v_rd_off(D0, 1, 0)>(vb), h1 = tr_read<v_rd_off(D0, 1, 1)>(vb);
  const s16x4 l2 = tr_read<v_rd_off(D0, 2, 0)>(vb), h2 = tr_read<v_rd_off(D0, 2, 1)>(vb), l3 = tr_read<v_rd_off(D0, 3, 0)>(vb), h3 = tr_read<v_rd_off(D0, 3, 1)>(vb);
  asm volatile("s_waitcnt lgkmcnt(0)" ::: "memory"); SBAR();
#define PK(L, H) (bf16x8){L[0], L[1], L[2], L[3], H[0], H[1], H[2], H[3]}
  od = __builtin_amdgcn_mfma_f32_32x32x16_bf16(pa0, PK(l0, h0), od, 0, 0, 0);
  od = __builtin_amdgcn_mfma_f32_32x32x16_bf16(pa1, PK(l1, h1), od, 0, 0, 0);
  od = __builtin_amdgcn_mfma_f32_32x32x16_bf16(pa2, PK(l2, h2), od, 0, 0, 0);
  od = __builtin_amdgcn_mfma_f32_32x32x16_bf16(pa3, PK(l3, h3), od, 0, 0, 0);
#undef PK
}
struct VFrag { s16x4 l0, h0, l1, h1, l2, h2, l3, h3; };
template <int D0> __device__ __forceinline__ void pv_rd(VFrag& f, int vb) {
  f.l0 = tr_read<v_rd_off(D0, 0, 0)>(vb); f.h0 = tr_read<v_rd_off(D0, 0, 1)>(vb); f.l1 = tr_read<v_rd_off(D0, 1, 0)>(vb); f.h1 = tr_read<v_rd_off(D0, 1, 1)>(vb);
  f.l2 = tr_read<v_rd_off(D0, 2, 0)>(vb); f.h2 = tr_read<v_rd_off(D0, 2, 1)>(vb); f.l3 = tr_read<v_rd_off(D0, 3, 0)>(vb); f.h3 = tr_read<v_rd_off(D0, 3, 1)>(vb);
}
__device__ __forceinline__ void pv_mm(f32x16& od, const VFrag& f, bf16x8 pa0, bf16x8 pa1, bf16x8 pa2, bf16x8 pa3) {
#define PK(L, H) (bf16x8){L[0], L[1], L[2], L[3], H[0], H[1], H[2], H[3]}
  od = __builtin_amdgcn_mfma_f32_32x32x16_bf16(pa0, PK(f.l0, f.h0), od, 0, 0, 0);
  od = __builtin_amdgcn_mfma_f32_32x32x16_bf16(pa1, PK(f.l1, f.h1), od, 0, 0, 0);
  od = __builtin_amdgcn_mfma_f32_32x32x16_bf16(pa2, PK(f.l2, f.h2), od, 0, 0, 0);
  od = __builtin_amdgcn_mfma_f32_32x32x16_bf16(pa3, PK(f.l3, f.h3), od, 0, 0, 0);
#undef PK
}
#define PV_WAIT(n) do { asm volatile("s_waitcnt lgkmcnt(" #n ")" ::: "memory"); SBAR(); } while (0)
__device__ __forceinline__ void pv_d0(f32x16* o, int vb, bf16x8 pa0, bf16x8 pa1, bf16x8 pa2, bf16x8 pa3) {
#if MK_PVPIPE
  VFrag fa, fb;
  pv_rd<0>(fa, vb); pv_rd<1>(fb, vb);
  PV_WAIT(8); pv_mm(o[0], fa, pa0, pa1, pa2, pa3); SBAR();
  pv_rd<2>(fa, vb);
  PV_WAIT(8); pv_mm(o[1], fb, pa0, pa1, pa2, pa3); SBAR();
  pv_rd<3>(fb, vb);
  PV_WAIT(8); pv_mm(o[2], fa, pa0, pa1, pa2, pa3); SBAR();
  PV_WAIT(0); pv_mm(o[3], fb, pa0, pa1, pa2, pa3);
#else
  pv_one<0>(o[0], vb, pa0, pa1, pa2, pa3); pv_one<1>(o[1], vb, pa0, pa1, pa2, pa3); pv_one<2>(o[2], vb, pa0, pa1, pa2, pa3); pv_one<3>(o[3], vb, pa0, pa1, pa2, pa3);
#endif
}
constexpr int crow0(int r) { return (r & 3) + 8 * (r >> 2); }
constexpr float LOG2E = 1.4426950408889634f;
__device__ __forceinline__ void partialSM_neg(f32x16& p0, f32x16& p1, float& m_reg, f32x16& negm, float& alpha) {
  float pmax = p0[0];
#pragma unroll
  for (int r = 1; r < 16; ++r) pmax = fmaxf(pmax, p0[r]);
#pragma unroll
  for (int r = 0; r < 16; ++r) pmax = fmaxf(pmax, p1[r]);
  { auto rr = __builtin_amdgcn_permlane32_swap(__float_as_uint(pmax), __float_as_uint(pmax), false, false);
    pmax = fmaxf(__uint_as_float(rr[0]), __uint_as_float(rr[1])); }
  if (__builtin_expect(__all(pmax <= THR), 1)) { alpha = 1.f; }
  else { const float dl = fmaxf(pmax, 0.f); m_reg += dl; alpha = __builtin_amdgcn_exp2f(-dl);
#pragma unroll
    for (int r = 0; r < 16; ++r) { p0[r] -= dl; p1[r] -= dl; negm[r] = -m_reg; } }
#pragma unroll
  for (int r = 0; r < 16; ++r) p0[r] = __builtin_amdgcn_exp2f(p0[r]);
}
__device__ __forceinline__ void partialSM_dil(f32x16& p0, f32x16& p1, float& m_reg, float& mn, float& alpha, float dq, float dlo, float dhi, float nslopeC) {
  constexpr float C = SCALE * LOG2E;
#pragma unroll
  for (int r = 0; r < 16; ++r) {
    const float d0 = dq + (float)crow0(r), d1 = d0 + 32.f;
    const float t0 = fmaf(p0[r], C, nslopeC * fabsf(d0)), t1 = fmaf(p1[r], C, nslopeC * fabsf(d1));
    p0[r] = (d0 >= dlo && d0 <= dhi) ? t0 : -1e30f;
    p1[r] = (d1 >= dlo && d1 <= dhi) ? t1 : -1e30f;
  }
  float pmax = p0[0];
#pragma unroll
  for (int r = 1; r < 16; ++r) pmax = fmaxf(pmax, p0[r]);
#pragma unroll
  for (int r = 0; r < 16; ++r) pmax = fmaxf(pmax, p1[r]);
  { auto rr = __builtin_amdgcn_permlane32_swap(__float_as_uint(pmax), __float_as_uint(pmax), false, false);
    pmax = fmaxf(__uint_as_float(rr[0]), __uint_as_float(rr[1])); }
  if (__builtin_expect(__all(pmax - m_reg <= THR * LOG2E), 1)) { mn = m_reg; alpha = 1.f; }
  else { mn = fmaxf(m_reg, pmax); alpha = __builtin_amdgcn_exp2f(m_reg - mn); m_reg = mn; }
#pragma unroll
  for (int r = 0; r < 16; ++r) { p0[r] = p0[r] - mn; p1[r] = p1[r] - mn; }
#pragma unroll
  for (int r = 0; r < 16; ++r) p0[r] = __builtin_amdgcn_exp2f(p0[r]);
}

template <bool DIL>
__device__ __forceinline__ void attn_body(const bf16* __restrict__ Qb, const bf16* __restrict__ Kh, const bf16* __restrict__ Vh, long qs, long ks,
                                          bf16* __restrict__ Ob, long os, float* __restrict__ lse_o, int lse_s, int i0, int nsub, float nslopeC, int seq, char* lds) {
  typedef __attribute__((address_space(3))) unsigned lds_u32;
  using St = Stage<bf16>;
  const int tid = otid(), wid = __builtin_amdgcn_readfirstlane(tid >> 6), lane = tid & 63, r32 = lane & 31, hi = lane >> 5;
  char* V_lds = lds + 4 * SHM_K; char* K_lds = lds;
  float* ws = (float*)(lds + 4 * SHM_K + 4 * SHM_V) + wid * 64; float* li_l = ws; float* al_l = ws + 32;
  float m_reg = -1e30f, l_reg = 0; f32x16 o[4] = {}; bf16x8 qr[8];
  const bf16* Qw = Qb + (long)(wid * QBLK + r32) * qs + hi * 8;
#pragma unroll
  for (int d0 = 0; d0 < 8; ++d0) qr[d0] = St::ld8(Qw + d0 * 16);
  const int vb0 = (int)(uintptr_t)V_lds + v_rd_base(lane);
  const int kb = DIL ? i0 - 64 : 0;
#define KROW(k) (DIL ? (long)min(max(kb + (k), 0), nsub - 1) : (long)(k))
  int krow[2], kcol[2], vrow[2], vcol[2];
#pragma unroll
  for (int i = 0; i < 2; ++i) { const int pc = 2 * wid + i;
    krow[i] = pc * 4 + (lane >> 4); kcol[i] = (((lane & 15) ^ (krow[i] & 7)) << 3);
    const int sub = pc * 2 + (lane >> 5), kk = ((sub >> 2) << 3) + ((lane & 31) >> 2);
    vrow[i] = (kk & ~0xC) | ((kk & 4) << 1) | ((kk & 8) >> 1); vcol[i] = ((sub & 3) << 5) + ((lane & 3) << 3); }
  unsigned kdo[2], vdo[2];
#pragma unroll
  for (int i = 0; i < 2; ++i) { kdo[i] = (unsigned)(krow[i] * (int)ks + kcol[i]); vdo[i] = (unsigned)(vrow[i] * (int)ks + vcol[i]); }
#define DMA(t, buf) do { if constexpr (DIL) { _Pragma("unroll") for (int i_ = 0; i_ < 2; ++i_) { \
      __builtin_amdgcn_global_load_lds((const unsigned*)(Kh + KROW((t) * KVBLK + krow[i_]) * ks + kcol[i_]), (lds_u32*)(K_lds + (buf) * SHM_K + (2 * wid + i_) * 1024), 16, 0, 0); \
      __builtin_amdgcn_global_load_lds((const unsigned*)(Vh + KROW((t) * KVBLK + vrow[i_]) * ks + vcol[i_]), (lds_u32*)(V_lds + (buf) * SHM_V + (2 * wid + i_) * 1024), 16, 0, 0); } } \
    else { const bf16* Kt_ = Kh + (long)(t) * (KVBLK * ks); const bf16* Vt_ = Vh + (long)(t) * (KVBLK * ks); _Pragma("unroll") for (int i_ = 0; i_ < 2; ++i_) { \
      __builtin_amdgcn_global_load_lds((const unsigned*)(Kt_ + kdo[i_]), (lds_u32*)(K_lds + (buf) * SHM_K + (2 * wid + i_) * 1024), 16, 0, 0); \
      __builtin_amdgcn_global_load_lds((const unsigned*)(Vt_ + vdo[i_]), (lds_u32*)(V_lds + (buf) * SHM_V + (2 * wid + i_) * 1024), 16, 0, 0); } } } while (0)
#define ENDSTEP(j) do { if ((j) + 2 < NT) asm volatile("s_waitcnt vmcnt(4) lgkmcnt(0)\n\ts_barrier" ::: "memory"); else asm volatile("s_waitcnt vmcnt(0) lgkmcnt(0)\n\ts_barrier" ::: "memory"); } while (0)
#define RESC(a) do { if (__any((a) < 1.f)) { if (hi == 0) al_l[r32] = (a); asm volatile("s_waitcnt lgkmcnt(0)" ::: "memory"); \
    for (int d = 0; d < 4; ++d) for (int r = 0; r < 16; ++r) o[d][r] *= al_l[crow(r, hi)]; } } while (0)
#define PSM(P0, P1, MN, AL, jt) do { if constexpr (DIL) { const int t_ = otid(), iq_ = (t_ >> 6) * QBLK + (t_ & 31), hi_ = (t_ >> 5) & 1; \
      partialSM_dil(P0, P1, m_reg, MN, AL, (float)(-64 - iq_ + 4 * hi_ + 64 * (jt)), fmaxf(-64.f, (float)(-(i0 + iq_))), fminf(64.f, (float)(nsub - 1 - (i0 + iq_))), nslopeC); } \
    else partialSM(P0, P1, m_reg, MN, AL); } while (0)
#if MK_SGB
#define SGB_A() do { __builtin_amdgcn_sched_group_barrier(0x100, 4, 0); \
    _Pragma("unroll") for (int g_ = 0; g_ < 12; ++g_) { __builtin_amdgcn_sched_group_barrier(0x008, 1, 0); __builtin_amdgcn_sched_group_barrier(0x100, 1, 0); __builtin_amdgcn_sched_group_barrier(0x002, 6, 0); } \
    _Pragma("unroll") for (int g_ = 0; g_ < 4; ++g_) { __builtin_amdgcn_sched_group_barrier(0x008, 1, 0); __builtin_amdgcn_sched_group_barrier(0x002, 6, 0); } } while (0)
#else
#define SGB_A() do {} while (0)
#endif
#define KBUF(j) ((const bf16*)(K_lds + ((j) & 3) * SHM_K))
#define VBUF(j) (vb0 + ((j) & 3) * (int)SHM_V)
  f32x16 pA0, pA1, pB0, pB1; float mnA, mnB, alA, alB; bf16x8 pa0, pa1, pa2, pa3; const int NT = DIL ? 6 : seq / KVBLK;
  DMA(0, 0); DMA(1, 1);
  if constexpr (!DIL && MK_PP) { DMA(2, 2); asm volatile("s_waitcnt vmcnt(8)\n\ts_barrier" ::: "memory"); }
  else asm volatile("s_waitcnt vmcnt(4)\n\ts_barrier" ::: "memory");
  struct KFrag { bf16x8 a, b; };
  int koff[4];
#pragma unroll
  for (int d0 = 0; d0 < 4; ++d0) koff[d0] = KSWZ(r32, (d0 * 16 + hi * 8) * 2);
  const int kbase0 = (int)(uintptr_t)K_lds;
#define KRD(f, d0, kb) asm volatile("ds_read_b128 %0, %2 offset:%3\n\tds_read_b128 %1, %2 offset:%4" : "=&v"(f.a), "=&v"(f.b) : "v"((kb) + koff[(d0) & 3]), "i"(((d0) >> 2) * 128), "i"(((d0) >> 2) * 128 + 8192) : "memory")
#define QMM(f, d0) do { pA0 = __builtin_amdgcn_mfma_f32_32x32x16_bf16(f.a, qr[d0], pA0, 0, 0, 0); pA1 = __builtin_amdgcn_mfma_f32_32x32x16_bf16(f.b, qr[d0], pA1, 0, 0, 0); } while (0)
#define LW(n) do { asm volatile("s_waitcnt lgkmcnt(" #n ")" ::: "memory"); SBAR(); } while (0)
  if constexpr (DIL) {
    const int rlo = wid >> 1;
    for (int j = 0; j < NT; ++j) {
      if (j + 2 < NT) DMA(j + 2, (j + 2) & 3);
      if (j >= rlo && j <= rlo + 2) {
        SBAR();
        { const int kb_ = kbase0 + (j & 3) * (int)SHM_K; KFrag k0_, k1_, k2_;
          KRD(k0_, 0, kb_); KRD(k1_, 1, kb_); KRD(k2_, 2, kb_); pA0 = f32x16{}; pA1 = f32x16{};
          LW(4); QMM(k0_, 0); SBAR(); KRD(k0_, 3, kb_);
          LW(4); QMM(k1_, 1); SBAR(); KRD(k1_, 4, kb_);
          LW(4); QMM(k2_, 2); SBAR(); KRD(k2_, 5, kb_);
          LW(4); QMM(k0_, 3); SBAR(); KRD(k0_, 6, kb_);
          LW(4); QMM(k1_, 4); SBAR(); KRD(k1_, 7, kb_);
          LW(4); QMM(k2_, 5); SBAR();
          LW(2); QMM(k0_, 6); SBAR();
          LW(0); QMM(k1_, 7); SBAR(); }
        PSM(pA0, pA1, mnA, alA, j); RESC(alA);
        finishSM(pA0, pA1, alA, l_reg, pa0, pa1, pa2, pa3); SBAR();
        pv_d0(o, VBUF(j), pa0, pa1, pa2, pa3);
      }
      if (j + 1 < NT) ENDSTEP(j);
    }
  } else if constexpr (MK_PP) {
    const bool grpB = wid >= 4;
#if MK_NEGM
    m_reg = 0.f; f32x16 negm = f32x16{};
#endif
#define PP_BAR(VM) do { if (VM) { asm volatile("s_waitcnt vmcnt(4) lgkmcnt(0)\n\ts_barrier" ::: "memory"); } else { asm volatile("s_waitcnt vmcnt(0) lgkmcnt(0)\n\ts_barrier" ::: "memory"); } } while (0)
#define PP_BAR_PLAIN() asm volatile("s_waitcnt lgkmcnt(0)\n\ts_barrier" ::: "memory")
    if (grpB) PP_BAR_PLAIN();
    qkt(pA0, pA1, KBUF(0), qr, r32, hi);
    if (grpB) PP_BAR(2 < NT); else PP_BAR_PLAIN();
    for (int t = 0; t < NT; ++t) {
      if (grpB && t + 3 < NT) DMA(t + 3, (t + 3) & 3);
#if MK_NEGM
      partialSM_neg(pA0, pA1, m_reg, negm, alA); RESC(alA);
#else
      PSM(pA0, pA1, mnA, alA, t); RESC(alA);
#endif
      finishSM(pA0, pA1, alA, l_reg, pa0, pa1, pa2, pa3);
#if MK_PROBE_V
      { float dm_ = alA;
#pragma unroll
        for (int q_ = 0; q_ < 32; ++q_) asm volatile("v_add_f32 %0, %0, %0" : "+v"(dm_));
        if (dm_ == 123.456f) l_reg += 1.f; }
#endif
      if (!grpB) PP_BAR(t + 2 < NT); else PP_BAR_PLAIN();
      if (!grpB && t + 3 < NT) DMA(t + 3, (t + 3) & 3);
      SBAR();
      if (t + 1 < NT) {
        const int kb_ = kbase0 + ((t + 1) & 3) * (int)SHM_K, vb_ = VBUF(t);
        KFrag k0_, k1_; VFrag fa_, fb_;
        KRD(k0_, 0, kb_); KRD(k1_, 1, kb_); pv_rd<0>(fa_, vb_);
#if MK_NEGM
        LW(10); pA0 = __builtin_amdgcn_mfma_f32_32x32x16_bf16(k0_.a, qr[0], negm, 0, 0, 0); pA1 = __builtin_amdgcn_mfma_f32_32x32x16_bf16(k0_.b, qr[0], negm, 0, 0, 0); SBAR(); KRD(k0_, 2, kb_);
#else
        pA0 = f32x16{}; pA1 = f32x16{};
        LW(10); QMM(k0_, 0); SBAR(); KRD(k0_, 2, kb_);
#endif
        LW(10); QMM(k1_, 1); SBAR(); KRD(k1_, 3, kb_);
        LW(4);  pv_mm(o[0], fa_, pa0, pa1, pa2, pa3); SBAR(); pv_rd<1>(fb_, vb_);
        LW(10); QMM(k0_, 2); SBAR(); KRD(k0_, 4, kb_);
        LW(10); QMM(k1_, 3); SBAR(); KRD(k1_, 5, kb_);
        LW(4);  pv_mm(o[1], fb_, pa0, pa1, pa2, pa3); SBAR(); pv_rd<2>(fa_, vb_);
        LW(10); QMM(k0_, 4); SBAR(); KRD(k0_, 6, kb_);
        LW(10); QMM(k1_, 5); SBAR(); KRD(k1_, 7, kb_);
        LW(4);  pv_mm(o[2], fa_, pa0, pa1, pa2, pa3); SBAR(); pv_rd<3>(fb_, vb_);
        LW(10); QMM(k0_, 6); SBAR();
        LW(8);  QMM(k1_, 7); SBAR();
        LW(0);  pv_mm(o[3], fb_, pa0, pa1, pa2, pa3);
      } else pv_d0(o, VBUF(t), pa0, pa1, pa2, pa3);
      if (t + 1 < NT) { if (grpB) PP_BAR(t + 3 < NT); else PP_BAR_PLAIN(); }
    }
    if (!grpB) PP_BAR_PLAIN();
#undef PP_BAR
#undef PP_BAR_PLAIN
#undef KRD
#undef QMM
#undef LW
  } else {
  if (2 < NT) DMA(2, 2);
  qkt(pA0, pA1, KBUF(0), qr, r32, hi); PSM(pA0, pA1, mnA, alA, 0);
  ENDSTEP(0);
  for (int j = 1; j + 1 < NT; j += 2) {
    if (j + 2 < NT) DMA(j + 2, (j + 2) & 3);
    SBAR(); qkt(pB0, pB1, KBUF(j), qr, r32, hi);
    finishSM(pA0, pA1, alA, l_reg, pa0, pa1, pa2, pa3); SGB_A(); SBAR();
    pv_d0(o, VBUF(j - 1), pa0, pa1, pa2, pa3); PSM(pB0, pB1, mnB, alB, j);
    RESC(alB); ENDSTEP(j);
    if (j + 3 < NT) DMA(j + 3, (j + 3) & 3);
    SBAR(); qkt(pA0, pA1, KBUF(j + 1), qr, r32, hi);
    finishSM(pB0, pB1, alB, l_reg, pa0, pa1, pa2, pa3); SGB_A(); SBAR();
    pv_d0(o, VBUF(j), pa0, pa1, pa2, pa3); PSM(pA0, pA1, mnA, alA, j + 1);
    RESC(alA); ENDSTEP(j + 1);
  }
  SBAR(); qkt(pB0, pB1, KBUF(NT - 1), qr, r32, hi);
  finishSM(pA0, pA1, alA, l_reg, pa0, pa1, pa2, pa3); SBAR();
  pv_d0(o, VBUF(NT - 2), pa0, pa1, pa2, pa3); PSM(pB0, pB1, mnB, alB, NT - 1);
  RESC(alB);
  finishSM(pB0, pB1, alB, l_reg, pa0, pa1, pa2, pa3); SBAR();
  pv_d0(o, VBUF(NT - 1), pa0, pa1, pa2, pa3);
  }
  if (hi == 0) li_l[r32] = l_reg; asm volatile("s_waitcnt lgkmcnt(0)" ::: "memory");
  if constexpr (DIL) { if (hi == 0) lse_o[(long)(wid * QBLK + r32) * lse_s] = m_reg + __log2f(l_reg); }
  float rli[16];
#pragma unroll
  for (int r = 0; r < 16; ++r) rli[r] = __builtin_amdgcn_rcpf(li_l[crow(r, hi)]);
  bf16* Ow = Ob + (long)(wid * QBLK) * os;
#pragma unroll
  for (int r = 0; r < 16; ++r) { const int orow = crow(r, hi);
#pragma unroll
    for (int d0 = 0; d0 < 4; ++d0) Ow[(long)orow * os + d0 * 32 + r32] = __float2bfloat16(o[d0][r] * rli[r]); }
  asm volatile("s_waitcnt lgkmcnt(0)\n\ts_barrier" ::: "memory");
#undef KROW
#undef DMA
#undef ENDSTEP
#undef RESC
#undef PSM
#undef KBUF
#undef SGB_A
#undef VBUF
}
}

#define GAS __attribute__((address_space(1)))
#define LAS __attribute__((address_space(3)))
typedef unsigned short bf16_t;
typedef unsigned v4u __attribute__((ext_vector_type(4)));
typedef unsigned v2u __attribute__((ext_vector_type(2)));
typedef float f32x4 __attribute__((ext_vector_type(4)));
#define LDS_WAIT() asm volatile("s_waitcnt lgkmcnt(0)" ::: "memory")

constexpr size_t MiB = 1u << 20;
constexpr size_t WS_W1T = 0;
constexpr size_t WS_W2T = 104 * MiB;
constexpr size_t WS_H = 136 * MiB;
constexpr size_t WS_PROJ = 200 * MiB;
constexpr size_t WS_YA = 408 * MiB;
constexpr size_t WS_YB = 440 * MiB;
constexpr size_t WS_LSE = 536 * MiB;
constexpr size_t WS_ROPE = 538 * MiB;
constexpr size_t WS_XB = 540 * MiB;
constexpr size_t WS_ROWSQ = 604 * MiB;
constexpr size_t WS_END = 616 * MiB;
static_assert((size_t)DEPTH * DIN * DM * 2 <= WS_W2T - WS_W1T && (size_t)M * DIN * 2 <= WS_YA - WS_PROJ && (size_t)3 * M * DB * 2 <= WS_LSE - WS_YB, "ws map");
constexpr int LDS_BYTES = 147456;
constexpr int N_PHASES = 2 + 5 * DEPTH;

__device__ __forceinline__ unsigned f2bf(float f) { unsigned u = __builtin_bit_cast(unsigned, f); return (u + 0x7fffu + ((u >> 16) & 1u)) >> 16; }
__device__ __forceinline__ unsigned pk2(float lo, float hi) { return f2bf(lo) | (f2bf(hi) << 16); }
__device__ __forceinline__ float bflo(unsigned w) { return __uint_as_float(w << 16); }
__device__ __forceinline__ float bfhi(unsigned w) { return __uint_as_float(w & 0xffff0000u); }
__device__ __forceinline__ float wave_sum(float v) {
#pragma unroll
    for (int o = 1; o < 64; o <<= 1) v += __shfl_xor(v, o);
    return v;
}

__device__ const float INV_FREQ[32] = {1.000000000e+00f, 7.498942614e-01f, 5.623413324e-01f, 4.216965139e-01f, 3.162277639e-01f, 2.371373773e-01f, 1.778279394e-01f, 1.333521307e-01f,
    1.000000015e-01f, 7.498941571e-02f, 5.623413250e-02f, 4.216965288e-02f, 3.162277490e-02f, 2.371373773e-02f, 1.778279431e-02f, 1.333521493e-02f,
    9.999999776e-03f, 7.498941850e-03f, 5.623413250e-03f, 4.216964822e-03f, 3.162277630e-03f, 2.371373586e-03f, 1.778279431e-03f, 1.333521446e-03f,
    1.000000047e-03f, 7.498942432e-04f, 5.623413017e-04f, 4.216965172e-04f, 3.162277571e-04f, 2.371373703e-04f, 1.778279402e-04f, 1.333521504e-04f};

__device__ __forceinline__ void sincos_acc(float a, float& s, float& c) {
    const double x = (double)a, kd = __builtin_rint(x * 0.63661977236758134308);
    const int k = (int)kd; const double r = x - kd * 1.57079632679489661923, r2 = r * r;
    const double sp = r * (1.0 + r2 * (-1.0 / 6 + r2 * (1.0 / 120 + r2 * (-1.0 / 5040 + r2 * (1.0 / 362880 + r2 * (-1.0 / 39916800 + r2 * (1.0 / 6227020800.0)))))));
    const double cp = 1.0 + r2 * (-0.5 + r2 * (1.0 / 24 + r2 * (-1.0 / 720 + r2 * (1.0 / 40320 + r2 * (-1.0 / 3628800 + r2 * (1.0 / 479001600.0 + r2 * (-1.0 / 87178291200.0)))))));
    const int q = k & 3;
    const double sv = (q == 0) ? sp : (q == 1) ? cp : (q == 2) ? -sp : -cp, cv = (q == 0) ? cp : (q == 1) ? -sp : (q == 2) ? -cp : sp;
    s = (float)sv; c = (float)cv;
}

__device__ __forceinline__ void p0_transpose_item(const float* W, int K, int N, bf16_t* WT, LAS float* scr, int item, int lane, const float* kscale) {
    const int nblk = N / 32, kb = item / nblk, nb = item % nblk, k0 = 64 * kb, n0 = 32 * nb;
#pragma unroll 8
    for (int i = 0; i < 32; ++i) { const int kk = 2 * i + (lane >> 5); scr[kk * 33 + (lane & 31)] = W[(size_t)(k0 + kk) * N + n0 + (lane & 31)] * (kscale ? kscale[k0 + kk] : 1.0f); }
    LDS_WAIT(); asm volatile("" ::: "memory");
    const int c = lane & 7;
#pragma unroll
    for (int j = 0; j < 4; ++j) { const int n = (lane >> 3) + 8 * j; const LAS float* s = scr + (8 * c) * 33 + n;
        v4u o; o.x = pk2(s[0 * 33], s[1 * 33]); o.y = pk2(s[2 * 33], s[3 * 33]); o.z = pk2(s[4 * 33], s[5 * 33]); o.w = pk2(s[6 * 33], s[7 * 33]);
        *(v4u*)(WT + (size_t)(n0 + n) * K + k0 + 8 * c) = o; }
    LDS_WAIT(); asm volatile("" ::: "memory");
}

#define XB_TMO      128
#define XB_XCNT(j)  (256  + 64 * (j))
#define XB_XSUB(j)  (1280 + 64 * (j))
#define XB_XGEN(j)  (2304 + 64 * (j))
#define XB_TOP      3328
#define XB_TOPGEN   3392
#define XCD_BAR_WORDS 3456
#define XB_SPIN_CAP (1u << 18)

__device__ __forceinline__ unsigned xb_ld(unsigned* p)              { return __hip_atomic_load(p, __ATOMIC_RELAXED, __HIP_MEMORY_SCOPE_AGENT); }
__device__ __forceinline__ unsigned xb_add(unsigned* p, unsigned v) { return __hip_atomic_fetch_add(p, v, __ATOMIC_RELAXED, __HIP_MEMORY_SCOPE_AGENT); }
__device__ __forceinline__ unsigned xb_xcc_id() { return (unsigned)__builtin_amdgcn_s_getreg((3 << 11) | 20) & 0xFu; }
#define XB_SPIN(cond, bar) do { unsigned _sp = 0; while (cond) { __builtin_amdgcn_s_sleep(1); \
    if ((++_sp & 255u) == 0u) { if (xb_ld(&(bar)[XB_TMO])) break; if (_sp > XB_SPIN_CAP) { atomicAdd(&(bar)[XB_TMO], 1u); break; } } } } while (0)

struct XcdBarrier {
    unsigned* bar; unsigned x;
    volatile LAS unsigned* st;
};

__device__ __forceinline__ XcdBarrier xcd_barrier_post(unsigned* bar, volatile LAS unsigned* st) {
    XcdBarrier b; b.bar = bar; b.x = xb_xcc_id(); b.st = st;
    if (threadIdx.x == 0) (void)xb_add(&bar[XB_XCNT(b.x)], 1u);
    return b;
}
__device__ __forceinline__ void xcd_barrier_complete(unsigned* bar, unsigned x, unsigned& nloc, unsigned& nx) {
    const unsigned G = gridDim.x * gridDim.y * gridDim.z;
    unsigned sum, cnt, mine, sp = 0u;
    for (;;) {
        sum = 0u; cnt = 0u; mine = 0u;
#pragma unroll
        for (unsigned j = 0; j < 16; ++j) { const unsigned c = xb_ld(&bar[XB_XCNT(j)]); sum += c; cnt += (c > 0u) ? 1u : 0u; mine = (j == x) ? c : mine; }
        if (sum == G) break;
        __builtin_amdgcn_s_sleep(1);
        if ((++sp & 255u) == 0u) { if (xb_ld(&bar[XB_TMO])) break; if (sp > XB_SPIN_CAP) { atomicAdd(&bar[XB_TMO], 1u); break; } }
    }
    nloc = mine > 0u ? mine : 1u; nx = cnt > 0u ? cnt : 1u;
}

__device__ __forceinline__ void xcd_barrier(const XcdBarrier& b) {
    asm volatile("s_waitcnt vmcnt(0)" ::: "memory");
    __syncthreads();
    if (threadIdx.x == 0) {
        unsigned* bar = b.bar;
        __builtin_amdgcn_s_waitcnt(0);
        unsigned nloc = b.st[0], nx = b.st[1];
        if (nloc == 0u) { xcd_barrier_complete(bar, b.x, nloc, nx); b.st[0] = nloc; b.st[1] = nx; }
        const unsigned old = xb_add(&bar[XB_XSUB(b.x)], 1u);
        const unsigned gen = old / nloc;
        if (old + 1u == (gen + 1u) * nloc) {
            __builtin_amdgcn_fence(__ATOMIC_RELEASE, "agent");
            asm volatile("s_waitcnt vmcnt(0)" ::: "memory");
            const unsigned og = xb_add(&bar[XB_TOP], 1u);
            const unsigned tg = og / nx;
            if (og + 1u == (tg + 1u) * nx) xb_add(&bar[XB_TOPGEN], 1u);
            else XB_SPIN(xb_ld(&bar[XB_TOPGEN]) == tg, bar);
            __builtin_amdgcn_fence(__ATOMIC_ACQUIRE, "agent");
            xb_add(&bar[XB_XGEN(b.x)], 1u);
            asm volatile("s_waitcnt vmcnt(0)" ::: "memory");
        } else {
            XB_SPIN(xb_ld(&bar[XB_XGEN(b.x)]) == gen, bar);
            __builtin_amdgcn_fence(__ATOMIC_ACQUIRE, "agent");
            asm volatile("s_waitcnt vmcnt(0)" ::: "memory");
        }
    }
    __syncthreads();
}

constexpr size_t WS_CTL = 539 * MiB, CTL_BYTES = 16384;
constexpr int MISC_OFF = 147456 - 128;
__device__ __forceinline__ void gate_row(int m, int lane, const bf16_t* __restrict__ YA, const bf16_t* __restrict__ YB, const float* __restrict__ LSE, const bf16_t* __restrict__ PROJ,
                                         const float* __restrict__ wa, const float* __restrict__ wb, bf16_t* __restrict__ H) {
                    float ya[2][8], yb[2][8]; float ssa = 0.f, ssb = 0.f;
#pragma unroll
                    for (int j = 0; j < 2; ++j) { const int c = lane + 64 * j, hh = c >> 4;
                        const v4u a = *(const v4u*)(YA + (size_t)m * DA + 8 * c);
                        ya[j][0] = bflo(a.x); ya[j][1] = bfhi(a.x); ya[j][2] = bflo(a.y); ya[j][3] = bfhi(a.y); ya[j][4] = bflo(a.z); ya[j][5] = bfhi(a.z); ya[j][6] = bflo(a.w); ya[j][7] = bfhi(a.w);
                        const float l0 = LSE[((size_t)0 * M + m) * 8 + hh], l1 = LSE[((size_t)1 * M + m) * 8 + hh], l2 = LSE[((size_t)2 * M + m) * 8 + hh];
                        const float mx = fmaxf(l0, fmaxf(l1, l2)); const float e0 = __builtin_amdgcn_exp2f(l0 - mx), e1 = __builtin_amdgcn_exp2f(l1 - mx), e2 = __builtin_amdgcn_exp2f(l2 - mx);
                        const float inv = 1.0f / (e0 + e1 + e2); const float w0 = e0 * inv, w1 = e1 * inv, w2 = e2 * inv;
                        const v4u b0 = *(const v4u*)(YB + ((size_t)0 * M + m) * DB + 8 * c), b1 = *(const v4u*)(YB + ((size_t)1 * M + m) * DB + 8 * c), b2 = *(const v4u*)(YB + ((size_t)2 * M + m) * DB + 8 * c);
                        yb[j][0] = w0 * bflo(b0.x) + w1 * bflo(b1.x) + w2 * bflo(b2.x); yb[j][1] = w0 * bfhi(b0.x) + w1 * bfhi(b1.x) + w2 * bfhi(b2.x);
                        yb[j][2] = w0 * bflo(b0.y) + w1 * bflo(b1.y) + w2 * bflo(b2.y); yb[j][3] = w0 * bfhi(b0.y) + w1 * bfhi(b1.y) + w2 * bfhi(b2.y);
                        yb[j][4] = w0 * bflo(b0.z) + w1 * bflo(b1.z) + w2 * bflo(b2.z); yb[j][5] = w0 * bfhi(b0.z) + w1 * bfhi(b1.z) + w2 * bfhi(b2.z);
                        yb[j][6] = w0 * bflo(b0.w) + w1 * bflo(b1.w) + w2 * bflo(b2.w); yb[j][7] = w0 * bfhi(b0.w) + w1 * bfhi(b1.w) + w2 * bfhi(b2.w);
#pragma unroll
                        for (int i = 0; i < 8; ++i) { ssa += ya[j][i] * ya[j][i]; ssb += yb[j][i] * yb[j][i]; } }
                    const float ra = 1.0f / sqrtf(wave_sum(ssa) * (1.0f / DA) + EPS), rb = 1.0f / sqrtf(wave_sum(ssb) * (1.0f / DB) + EPS);
#pragma unroll
                    for (int j = 0; j < 2; ++j) { const int c = lane + 64 * j;
                        const v4u ga = *(const v4u*)(PROJ + ((size_t)(H_GA + (c >> 4)) * M + m) * HD + 8 * (c & 15)), gb = *(const v4u*)(PROJ + ((size_t)(H_GB + (c >> 4)) * M + m) * HD + 8 * (c & 15));
                        const float gaf[8] = {bflo(ga.x), bfhi(ga.x), bflo(ga.y), bfhi(ga.y), bflo(ga.z), bfhi(ga.z), bflo(ga.w), bfhi(ga.w)};
                        const float gbf[8] = {bflo(gb.x), bfhi(gb.x), bflo(gb.y), bfhi(gb.y), bflo(gb.z), bfhi(gb.z), bflo(gb.w), bfhi(gb.w)};
                        const f32x4 wa0 = *(const f32x4*)(wa + 8 * c), wa1 = *(const f32x4*)(wa + 8 * c + 4), wb0 = *(const f32x4*)(wb + 8 * c), wb1 = *(const f32x4*)(wb + 8 * c + 4);
                        float za[8], zb[8];
#pragma unroll
                        for (int i = 0; i < 8; ++i) { const float wai = i < 4 ? wa0[i & 3] : wa1[i & 3], wbi = i < 4 ? wb0[i & 3] : wb1[i & 3];
                            const float sa = gaf[i] / (1.0f + __expf(-gaf[i])), sb = gbf[i] / (1.0f + __expf(-gbf[i]));
                            za[i] = ya[j][i] * ra * wai * sa; zb[i] = yb[j][i] * rb * wbi * sb; }
                        v4u oa, ob; oa.x = pk2(za[0], za[1]); oa.y = pk2(za[2], za[3]); oa.z = pk2(za[4], za[5]); oa.w = pk2(za[6], za[7]);
                        ob.x = pk2(zb[0], zb[1]); ob.y = pk2(zb[2], zb[3]); ob.z = pk2(zb[4], zb[5]); ob.w = pk2(zb[6], zb[7]);
                        *(v4u*)(H + (size_t)m * DM + 8 * c) = oa; *(v4u*)(H + (size_t)m * DM + DA + 8 * c) = ob; }
}

struct Params { const float *x, *norm_w, *w_in, *qn, *kn, *ona, *onb, *w_out, *fnorm; float* out; unsigned char* ws; int ph_lo, ph_hi; };

__global__ void __launch_bounds__(512, 2) mk_fwd(Params p) {
    extern __shared__ __attribute__((aligned(16))) unsigned char lds[];
    volatile LAS unsigned* MISC = (volatile LAS unsigned*)((LAS unsigned char*)lds + MISC_OFF);
    if (threadIdx.x < 32) MISC[threadIdx.x] = 0u;
    __syncthreads();
    XcdBarrier bar = xcd_barrier_post((unsigned*)(p.ws + WS_CTL), MISC + 8);
    if (p.ph_lo == 0) {
        float* RCOS0 = (float*)(p.ws + WS_ROPE); float* RSIN0 = RCOS0 + 192 * 32;
        for (int i = blockIdx.x * 512 + threadIdx.x; i < 192 * 32; i += gridDim.x * 512) {
            const int pos = i >> 5, f = i & 31; const float pv = (float)(pos < 128 ? pos : pos - 128);
            float sn_, cs_; sincos_acc(pv * INV_FREQ[f], sn_, cs_); RCOS0[i] = cs_; RSIN0[i] = sn_;
        }
    }
    for (int ph = p.ph_lo; ph < p.ph_hi; ++ph) {
        const int tid = otid(), lane = tid & 63, wave = __builtin_amdgcn_readfirstlane(tid >> 6);
        int G = gridDim.x, bx = blockIdx.x; asm volatile("" : "+s"(G), "+s"(bx));
        const int vcu = (G % 8 == 0) ? (bx % 8) * (G / 8) + bx / 8 : bx;
        const int gw = vcu * 8 + wave, NGW = G * 8;
        size_t zoff = 0; asm volatile("" : "+s"(zoff));
        unsigned char* ws = p.ws + zoff;
        bf16_t* W1T = (bf16_t*)(ws + WS_W1T); bf16_t* W2T = (bf16_t*)(ws + WS_W2T); bf16_t* H = (bf16_t*)(ws + WS_H); bf16_t* PROJ = (bf16_t*)(ws + WS_PROJ);
        bf16_t* YA = (bf16_t*)(ws + WS_YA); bf16_t* YB = (bf16_t*)(ws + WS_YB); float* LSE = (float*)(ws + WS_LSE);
        float* RCOS = (float*)(ws + WS_ROPE); float* RSIN = RCOS + 192 * 32;
        bf16_t* XB = (bf16_t*)(ws + WS_XB); float* ROWSQ = (float*)(ws + WS_ROWSQ);
        if (ph == 0) {
            LAS float* scr = (LAS float*)((LAS unsigned char*)lds + wave * 16384);
            constexpr int I1 = (DM / 64) * (DIN / 32), I2 = (DM / 64) * (DM / 32), IL = I1 + I2;
            DUPREP(0) for (int it = gw; it < DEPTH * IL; it += NGW) {
                const int l = it / IL, r = it % IL;
                if (r < I1) p0_transpose_item(p.w_in + (size_t)l * DM * DIN, DM, DIN, W1T + (size_t)l * DIN * DM, scr, r, lane, p.norm_w + (size_t)l * DM);
                else p0_transpose_item(p.w_out + (size_t)l * DM * DM, DM, DM, W2T + (size_t)l * DM * DM, scr, r - I1, lane, nullptr);
            }
            for (int m = gw; m < M; m += NGW) {
                const f32x4* xr = (const f32x4*)(p.x + (size_t)m * DM) + lane; v2u* o8 = (v2u*)(XB + (size_t)m * DM) + lane; float sq = 0.f;
#pragma unroll
                for (int j = 0; j < 8; ++j) { const f32x4 v = xr[64 * j]; v2u w; w.x = pk2(v.x, v.y); w.y = pk2(v.z, v.w); o8[64 * j] = w;
                    const float r0 = bflo(w.x), r1 = bfhi(w.x), r2 = bflo(w.y), r3 = bfhi(w.y); sq += (r0 * r0 + r1 * r1) + (r2 * r2 + r3 * r3); }
                sq = wave_sum(sq); if (lane < 32) ROWSQ[(size_t)m * 32 + lane] = (lane == 0) ? sq : 0.f;
            }
        } else if (ph == N_PHASES - 1) {
            for (int m = gw; m < M; m += NGW) {
                f32x4* xr = (f32x4*)(p.out + (size_t)m * DM) + lane; const f32x4* wr_ = (const f32x4*)p.fnorm + lane; const v2u* xb8 = (const v2u*)(XB + (size_t)m * DM) + lane;
                const float rstd = 1.0f / sqrtf(wave_sum(lane < 32 ? ROWSQ[((size_t)DEPTH * M + m) * 32 + lane] : 0.f) * (1.0f / DM) + EPS);
#pragma unroll
                for (int j = 0; j < 8; ++j) { const v2u w = xb8[64 * j]; const f32x4 v = {bflo(w.x), bfhi(w.x), bflo(w.y), bfhi(w.y)}; xr[64 * j] = v * rstd * wr_[64 * j]; }
            }
        } else {
            const int l = (ph - 1) / 5, st = (ph - 1) % 5 + 1;
            if (st == 1) {
                pg8::Gemm g{XB, W1T + (size_t)l * DIN * DM, M, DIN, DM}; pg8::StaticOrder S; S.init(M, DIN, G, bx);
                pg8::EpiHeadMajor E{PROJ, M, ROWSQ + (size_t)l * M * 32, 1.0f / DM, EPS};
#ifndef MK_NO_G1
                DUPREP(2) pg8::gemm_phase<pg8::EpiHeadMajor, pg8::StaticOrder, PG8_ALIGN, PG8_SP2>((PG8_LAS unsigned char*)lds, g, S, E);
#endif
            } else if (st == 2) {
                const float* qg = p.qn + l * HD; const float* kg = p.kn + l * HD;
                constexpr int QKU = 4;
                for (int it0 = gw; it0 < M * 10 / 4; it0 += QKU * NGW) {
                    const int j = lane & 15, half = j >> 3, jj = j & 7, e = half * 64 + 4 * jj;
                    v2u a[QKU], b[QKU]; f32x4 cs[QKU], sn[QKU]; bf16_t* pp[QKU]; bool isq[QKU];
#pragma unroll
                    for (int u = 0; u < QKU; ++u) { const int it = min(it0 + u * NGW, M * 10 / 4 - 1);
                        const int g = it * 4 + (lane >> 4), row = g / 10, hs = g - row * 10; isq[u] = hs < 8;
                        pp[u] = PROJ + ((size_t)hs * M + row) * HD + e; a[u] = *(const v2u*)pp[u]; b[u] = *(const v2u*)(pp[u] + 32);
                        const int t = row & (T - 1), pos = half ? 128 + (t & 63) : (t >> 6);
                        cs[u] = *(const f32x4*)(RCOS + pos * 32 + 4 * jj); sn[u] = *(const f32x4*)(RSIN + pos * 32 + 4 * jj); }
                    asm volatile("" ::: "memory");
#pragma unroll
                    for (int u = 0; u < QKU; ++u) {
                        float x1[4] = {bflo(a[u].x), bfhi(a[u].x), bflo(a[u].y), bfhi(a[u].y)}, x2[4] = {bflo(b[u].x), bfhi(b[u].x), bflo(b[u].y), bfhi(b[u].y)};
                        float ss = 0.f;
#pragma unroll
                        for (int i = 0; i < 4; ++i) ss += x1[i] * x1[i] + x2[i] * x2[i];
                        ss += __shfl_xor(ss, 1); ss += __shfl_xor(ss, 2); ss += __shfl_xor(ss, 4); ss += __shfl_xor(ss, 8);
                        const float rstd = 1.0f / sqrtf(ss * (1.0f / HD) + EPS);
                        const float* gn = isq[u] ? qg : kg;
                        const float qsc = (MK_NEGM && isq[u]) ? att::SCALE * att::LOG2E : 1.0f;
                        const f32x4 g1 = *(const f32x4*)(gn + e), g2 = *(const f32x4*)(gn + e + 32);
                        float o1[4], o2[4];
#pragma unroll
                        for (int i = 0; i < 4; ++i) { const float y1 = x1[i] * rstd * g1[i], y2 = x2[i] * rstd * g2[i]; o1[i] = (y1 * cs[u][i] - y2 * sn[u][i]) * qsc; o2[i] = (y1 * sn[u][i] + y2 * cs[u][i]) * qsc; }
                        v2u w1, w2; w1.x = pk2(o1[0], o1[1]); w1.y = pk2(o1[2], o1[3]); w2.x = pk2(o2[0], o2[1]); w2.y = pk2(o2[2], o2[3]);
                        if (it0 + u * NGW < M * 10 / 4) { *(v2u*)pp[u] = w1; *(v2u*)(pp[u] + 32) = w2; }
                    }
                }
#ifndef MK_NO_DIL
                DUPREP(3) for (int u = vcu; u < 1536; u += G) {
                    const int pt = u >> 9, rem = u & 511, b = rem >> 8, h = (rem >> 5) & 7, w = rem & 31;
                    const int d = (pt == 0) ? 1 : (pt == 1) ? 4 : 16, res = w & (d - 1), blk = w / d, i0 = blk * 256, nsub = T / d;
                    const float slope = __builtin_amdgcn_exp2f(-(float)(h + 1));
                    const float nslopeC = -slope * (float)d * att::LOG2E;
                    const size_t tok0 = (size_t)b * T + res;
                    const att::bf16* Pb = (const att::bf16*)PROJ + ((size_t)h * M + tok0) * HD;
                    const long rs = (long)d * HD;
                    att::attn_body<true>(Pb + (size_t)H_QB * M * HD + (long)i0 * rs, Pb + (size_t)H_KB * M * HD, Pb + (size_t)H_VB * M * HD, rs, rs,
                                         (att::bf16*)YB + ((size_t)pt * M + tok0 + (size_t)i0 * d) * DB + h * HD, (long)d * DB,
                                         LSE + ((size_t)pt * M + tok0 + (size_t)i0 * d) * 8 + h, d * 8, i0, nsub, nslopeC, 0, (char*)lds);
                }
#endif
            } else if (st == 3) {
#ifndef MK_NO_DENSE
                DUPREP(4) for (int u = vcu; u < 512; u += G) {
                    const int combo = u >> 7, b = combo >> 1, kvh = combo & 1, h = kvh * 4 + ((u >> 5) & 3), qb = u & 31;
                    const att::bf16* Pb = (const att::bf16*)PROJ + (size_t)b * T * HD;
                    att::attn_body<false>(Pb + ((size_t)(H_QA + h) * M + qb * 256) * HD, Pb + (size_t)(H_KA + kvh) * M * HD, Pb + (size_t)(H_VA + kvh) * M * HD, HD, HD,
                                          (att::bf16*)YA + ((size_t)b * T + qb * 256) * DA + h * HD, DA, nullptr, 0, 0, 0, 0.f, T, (char*)lds);
                }
#endif
            } else if (st == 4) {
                const float* wa = p.ona + (size_t)l * DA; const float* wb = p.onb + (size_t)l * DB;
                DUPREP(5) for (int m = gw; m < M; m += 2 * NGW) {
                    gate_row(m, lane, YA, YB, LSE, PROJ, wa, wb, H);
                    if (m + NGW < M) gate_row(m + NGW, lane, YA, YB, LSE, PROJ, wa, wb, H);
                }
            } else {
                pg8::Gemm g{H, W2T + (size_t)l * DM * DM, M, DM, DM}; pg8::StaticOrder S; S.init(M, DM, G, bx);
                pg8::EpiResF32 E{XB, ROWSQ + (size_t)(l + 1) * M * 32, DM};
#ifndef MK_NO_G2
                pg8::gemm_phase<pg8::EpiResF32, pg8::StaticOrder, PG8_ALIGN, PG8_SP2>((PG8_LAS unsigned char*)lds, g, S, E);
#endif
            }
        }
        if (ph + 1 < p.ph_hi) { if (ph == 0) cg::this_grid().sync(); else xcd_barrier(bar); if (MK_DUP & 64) xcd_barrier(bar); }
    }
}

extern "C" void kernel_launch(void* const* d_in, const int* in_sizes, int n_in, void* d_out, int out_size, void* d_ws, size_t ws_size, hipStream_t stream) {
    static int grid = 0;
    if (grid == 0) {
        if (n_in != 9 || in_sizes[0] != M * DM || out_size != M * DM || ws_size < WS_END) { fprintf(stderr, "kernel_launch: unexpected shapes (n_in %d, ws %zu)\n", n_in, ws_size); grid = -1; return; }
        int dev = 0, cus = 0, per_cu = 0;
        hipGetDevice(&dev); hipDeviceGetAttribute(&cus, hipDeviceAttributeMultiprocessorCount, dev);
        if (hipFuncSetAttribute((const void*)mk_fwd, hipFuncAttributeMaxDynamicSharedMemorySize, LDS_BYTES) != hipSuccess) { fprintf(stderr, "kernel_launch: hipFuncSetAttribute failed\n"); grid = -1; return; }
        if (hipOccupancyMaxActiveBlocksPerMultiprocessor(&per_cu, (const void*)mk_fwd, 512, LDS_BYTES) != hipSuccess || per_cu < 1) per_cu = 1;
        (void)hipGetLastError();
        grid = cus * per_cu;
    }
    if (grid < 0) return;
    Params p{};
    p.x = (const float*)d_in[0]; p.norm_w = (const float*)d_in[1]; p.w_in = (const float*)d_in[2]; p.qn = (const float*)d_in[3]; p.kn = (const float*)d_in[4];
    p.ona = (const float*)d_in[5]; p.onb = (const float*)d_in[6]; p.w_out = (const float*)d_in[7]; p.fnorm = (const float*)d_in[8];
    p.out = (float*)d_out; p.ws = (unsigned char*)d_ws;
    if (hipMemsetAsync((char*)d_ws + WS_CTL, 0, CTL_BYTES, stream) != hipSuccess) { fprintf(stderr, "kernel_launch: memset failed\n"); return; }
#if MK_ONE_LAUNCH
    p.ph_lo = 0; p.ph_hi = N_PHASES;
    void* args[] = {&p};
    hipError_t e = hipLaunchCooperativeKernel((const void*)mk_fwd, dim3(grid), dim3(512), args, LDS_BYTES, stream);
    if (e != hipSuccess) fprintf(stderr, "kernel_launch: cooperative launch failed: %s (grid %d)\n", hipGetErrorString(e), grid);
#else
    for (int ph = 0; ph < N_PHASES; ++ph) { p.ph_lo = ph; p.ph_hi = ph + 1; hipLaunchKernelGGL(mk_fwd, dim3(grid), dim3(512), LDS_BYTES, stream, p); }
#endif
}
```

```cpp
#include <hip/hip_runtime.h>
#include <hip/hip_bf16.h>
#include <hip/hip_cooperative_groups.h>
#include <cstdio>
#include <cstdint>
namespace cg = cooperative_groups;

#ifndef MK_DUP
#define MK_DUP 0
#endif
#define DUPREP(k) for (int rep_ = 0; rep_ < 1 + ((MK_DUP >> (k)) & 1); ++rep_)
#ifndef MK_PVPIPE
#define MK_PVPIPE 1
#endif
#ifndef MK_SGB
#define MK_SGB 0
#endif
#ifndef MK_PP
#define MK_PP 1
#endif
#ifndef MK_PROBE_V
#define MK_PROBE_V 0
#endif
#ifndef MK_NEGM
#define MK_NEGM 1
#endif
#ifndef MK_ONE_LAUNCH
#define MK_ONE_LAUNCH 1
#endif

constexpr int BATCH = 2, T = 8192, DM = 2048, DEPTH = 4, HD = 128, DA = 1024, DB = 1024, DIN = 6656, M = BATCH * T;
constexpr int C_QA = 0, C_KA = 1024, C_VA = 1280, C_GA = 1536, C_QB = 2560, C_KB = 3584, C_VB = 4608, C_GB = 5632;
constexpr int H_QA = 0, H_KA = 8, H_VA = 10, H_GA = 12, H_QB = 20, H_KB = 28, H_VB = 36, H_GB = 44;
constexpr float EPS = 1e-6f;
__device__ __forceinline__ int otid() { int t = threadIdx.x; asm volatile("" : "+v"(t)); return t; }

namespace pg8 {
#define PG8_LAS __attribute__((address_space(3)))
typedef unsigned short bf16_t;
typedef short bf16x8 __attribute__((ext_vector_type(8)));
typedef float f32x4 __attribute__((ext_vector_type(4)));
typedef unsigned u32x4 __attribute__((ext_vector_type(4)));
constexpr int BM = 256, BK = 64, HALF = 128, HTB = HALF * BK * 2  , STAGE_BYTES = 8 * HTB, NXCD = 8, WGM = 8;

__host__ __device__ __forceinline__ int lds_byte(int r, int c) { const int st = (r >> 4) * 2 + (c >> 5), rr = r & 15, cc = c & 31, ob = rr * 64 + cc * 2; return st * 1024 + (ob ^ (((ob >> 9) & 1) << 5)); }
__host__ __device__ __forceinline__ void stage_rc(int b, int& R, int& C) { const int st = b / 1024, sb = b % 1024, swz = sb ^ (((sb >> 9) & 1) << 5); R = (st >> 1) * 16 + swz / 64; C = (st & 1) * 32 + (swz % 64) / 2; }
__host__ __device__ __forceinline__ int perm32(int rho) { const int n = rho >> 4, i = rho & 15; return 8 * (i >> 2) + 4 * n + (i & 3); }

struct Unit { int pm, pn; };
struct Gemm { const bf16_t* A; const bf16_t* Bt; int M, N, K; };

struct StaticOrder {
    int nM, nN, nwg, G, c;
    __host__ __device__ void init(int M, int N, int G_, int c_) { nM = M / BM; nN = N / BM; nwg = nM * nN; G = G_; c = c_; }
    __host__ __device__ bool next(int i, Unit& u) const {
        const long L = (long)i * G + c; if (L >= nwg) return false;
        int wgid = (int)L; { const int q = nwg / NXCD, r = nwg % NXCD, xcd = wgid % NXCD, off = wgid / NXCD; wgid = (xcd < r ? xcd * (q + 1) : r * (q + 1) + (xcd - r) * q) + off; }
        const int nig = WGM * nN, gid = wgid / nig, fm = gid * WGM, gsz = (nM - fm) < WGM ? (nM - fm) : WGM;
        u.pm = fm + ((wgid % nig) % gsz); u.pn = (wgid % nig) / gsz; return true;
    }
    __device__ __forceinline__ void a_ready(const Unit&) const {}
    __device__ __forceinline__ void done(const Unit&) const {}
};

__device__ __forceinline__ unsigned cvt_pk_bf16(float lo, float hi) { unsigned r; asm volatile("v_cvt_pk_bf16_f32 %0, %1, %2" : "=v"(r) : "v"(lo), "v"(hi)); return r; }
typedef float f32x2 __attribute__((ext_vector_type(2)));
__device__ __forceinline__ f32x2 gelu_pk(f32x2 v) {
    const f32x2 av = __builtin_elementwise_abs(v), d = av * 0.2316418882f + 1.0f;
    f32x2 t; t.x = __builtin_amdgcn_rcpf(d.x); t.y = __builtin_amdgcn_rcpf(d.y);
    f32x2 q = t * 0.5307027145f + (-0.7265760135f); q = q * t + 0.7107068705f; q = q * t + (-0.142248368f); q = q * t + 0.127414796f; q = q * t;
    const f32x2 s = (v * v) * (-0.72134752044f);
    f32x2 e; e.x = __builtin_amdgcn_exp2f(s.x); e.y = __builtin_amdgcn_exp2f(s.y);
    const f32x2 m = v * (q * e), r = v - m;
    f32x2 o; o.x = v.x < 0.f ? m.x : r.x; o.y = v.y < 0.f ? m.y : r.y; return o;
}

template <int ACT  > struct EpiBf16 {
    static constexpr bool PERM = true, AFTER_DRAIN = false; static_assert(ACT == 0 || ACT == 1, "EpiBf16: ACT is 0 (none) or 1 (gelu_pk)");
    bf16_t* O; int ldc; const float* bias; int split_cols; size_t split_stride; float scale0;
    __device__ __forceinline__ void operator()(const f32x4 (&acc)[2][2][4][2], const Unit& u, int wr, int wc, int fr, int fq) const {
        const int row0 = u.pm * BM + wr * 64 + fr; int colt = u.pn * BM; bf16_t* base = O;
        float sc = 1.f; if (split_cols) { const int t = colt / split_cols; base += (size_t)t * split_stride; colt -= t * split_cols; if (t == 0) sc = scale0; }
        const int col0 = colt + wc * 32 + 8 * fq, bcol0 = u.pn * BM + wc * 32 + 8 * fq;
        f32x4 bv[2][2];
#pragma unroll
        for (int bj = 0; bj < 2; ++bj)
#pragma unroll
            for (int n = 0; n < 2; ++n) bv[bj][n] = bias ? *(const f32x4*)(bias + bcol0 + bj * HALF + 4 * n) : (f32x4){0.f, 0.f, 0.f, 0.f};
#pragma unroll
        for (int ai = 0; ai < 2; ++ai)
#pragma unroll
            for (int m = 0; m < 4; ++m) { bf16_t* rowp = base + (size_t)(row0 + ai * HALF + m * 16) * ldc + col0;
#pragma unroll
                for (int bj = 0; bj < 2; ++bj) { f32x4 v0 = acc[ai][bj][m][0] + bv[bj][0], v1 = acc[ai][bj][m][1] + bv[bj][1];
                    if (ACT == 1) { f32x2 a = gelu_pk((f32x2){v0[0], v0[1]}), b = gelu_pk((f32x2){v0[2], v0[3]}), c = gelu_pk((f32x2){v1[0], v1[1]}), d = gelu_pk((f32x2){v1[2], v1[3]});
                        v0 = (f32x4){a.x, a.y, b.x, b.y}; v1 = (f32x4){c.x, c.y, d.x, d.y}; }
                    v0 = v0 * sc; v1 = v1 * sc; u32x4 w; w.x = cvt_pk_bf16(v0[0], v0[1]); w.y = cvt_pk_bf16(v0[2], v0[3]); w.z = cvt_pk_bf16(v1[0], v1[1]); w.w = cvt_pk_bf16(v1[2], v1[3]);
                    *(u32x4*)(rowp + bj * HALF) = w; } }
    }
};
struct EpiHeadMajor {
    static constexpr bool PERM = true, AFTER_DRAIN = false;
    bf16_t* O; int Mrows; const float* rowsq; float inv_k, eps;
    __device__ __forceinline__ void operator()(const f32x4 (&acc)[2][2][4][2], const Unit& u, int wr, int wc, int fr, int fq) const {
        const int row0 = u.pm * BM + wr * 64 + fr, col0 = wc * 32 + 8 * fq;
#pragma unroll
        for (int ai = 0; ai < 2; ++ai) {
            f32x4 pa[4], pb[4];
#pragma unroll
            for (int m = 0; m < 4; ++m) { const f32x4* pp = (const f32x4*)(rowsq + (size_t)(row0 + ai * HALF + m * 16) * 32 + 8 * fq); pa[m] = pp[0]; pb[m] = pp[1]; }
#pragma unroll
            for (int m = 0; m < 4; ++m) { const int row = row0 + ai * HALF + m * 16; const f32x4 a = pa[m], b = pb[m];
                float sq = ((a[0] + a[1]) + (a[2] + a[3])) + ((b[0] + b[1]) + (b[2] + b[3])); sq += __shfl_xor(sq, 16); sq += __shfl_xor(sq, 32);
                const float rs = 1.0f / sqrtf(sq * inv_k + eps);
#pragma unroll
                for (int bj = 0; bj < 2; ++bj) { const f32x4 v0 = acc[ai][bj][m][0] * rs, v1 = acc[ai][bj][m][1] * rs;
                    u32x4 w; w.x = cvt_pk_bf16(v0[0], v0[1]); w.y = cvt_pk_bf16(v0[2], v0[3]); w.z = cvt_pk_bf16(v1[0], v1[1]); w.w = cvt_pk_bf16(v1[2], v1[3]);
                    *(u32x4*)(O + ((size_t)(u.pn * 2 + bj) * Mrows + row) * HALF + col0) = w; } }
            asm volatile("" ::: "memory"); }
    }
};
struct EpiResF32 {
    static constexpr bool PERM = true, AFTER_DRAIN = false;
    bf16_t* xb; float* rowsq; int ldc;
    __device__ __forceinline__ void operator()(const f32x4 (&acc)[2][2][4][2], const Unit& u, int wr, int wc, int fr, int fq) const {
        const int col0 = u.pn * BM + wc * 32 + 8 * fq;
#pragma unroll
        for (int ai = 0; ai < 2; ++ai) {
            u32x4 pre[4][2];
#pragma unroll
            for (int m = 0; m < 4; ++m) { const size_t off = (size_t)(u.pm * BM + ai * HALF + wr * 64 + m * 16 + fr) * ldc + col0;
#pragma unroll
                for (int bj = 0; bj < 2; ++bj) pre[m][bj] = *(const u32x4*)(xb + off + bj * HALF); }
            asm volatile("" ::: "memory");
#pragma unroll
            for (int m = 0; m < 4; ++m) { const int row = u.pm * BM + ai * HALF + wr * 64 + m * 16 + fr; const size_t off = (size_t)row * ldc + col0; float ss = 0.f;
#pragma unroll
                for (int bj = 0; bj < 2; ++bj) { const u32x4 pb = pre[m][bj]; const f32x4 a0 = acc[ai][bj][m][0], a1 = acc[ai][bj][m][1];
                    u32x4 w; w.x = cvt_pk_bf16(__uint_as_float(pb.x << 16) + a0[0], __uint_as_float(pb.x & 0xffff0000u) + a0[1]); w.y = cvt_pk_bf16(__uint_as_float(pb.y << 16) + a0[2], __uint_as_float(pb.y & 0xffff0000u) + a0[3]);
                    w.z = cvt_pk_bf16(__uint_as_float(pb.z << 16) + a1[0], __uint_as_float(pb.z & 0xffff0000u) + a1[1]); w.w = cvt_pk_bf16(__uint_as_float(pb.w << 16) + a1[2], __uint_as_float(pb.w & 0xffff0000u) + a1[3]);
#pragma unroll
                    for (int q = 0; q < 4; ++q) { const float r0 = __uint_as_float(w[q] << 16), r1 = __uint_as_float(w[q] & 0xffff0000u); ss += r0 * r0 + r1 * r1; }
                    *(u32x4*)(xb + off + bj * HALF) = w; }
                ss += __shfl_xor(ss, 16); ss += __shfl_xor(ss, 32);
                if (fq == 0) rowsq[(size_t)row * 32 + u.pn * 4 + wc] = ss; }
            asm volatile("" ::: "memory"); }
    }
};


template <class Epi, class Sched, bool ALIGN_EPI = false, bool SP2 = false>
__device__ __forceinline__ void gemm_phase(PG8_LAS unsigned char* lds, const Gemm g, const Sched& S, const Epi& E) {
    const int tid = otid(), wid = __builtin_amdgcn_readfirstlane(tid >> 6), lane = tid & 63, wr = wid >> 2, wc = wid & 3, fr = lane & 15, fq = lane >> 4;
    const int K = g.K, nt = K / BK;
    unsigned voffA[2], voffB[2];
#pragma unroll
    for (int i = 0; i < 2; ++i) { int R, C; stage_rc(tid * 16 + i * 8192, R, C); const int Rb = Epi::PERM ? ((R & ~31) + perm32(R & 31)) : R;
        voffA[i] = (unsigned)(R * K + C) * 2u; voffB[i] = (unsigned)(Rb * K + C) * 2u; }
    const size_t kstep = (size_t)(BK * 2);
    const size_t hstep = (size_t)HALF * K * 2;
    const size_t tstep = 2 * hstep;
    const unsigned ldsw = (unsigned)wid * 1024u;
    const int aoff = lds_byte(wr * 64 + fr, fq * 8), boff = lds_byte(wc * 32 + fr, fq * 8);
#define PG8_SA(b, h) (((b) * 2 + (h)) * HTB)
#define PG8_SB(b, h) ((4 + (b) * 2 + (h)) * HTB)
#define PG8_STAGE(bufoff, gbase, voff) do { _Pragma("unroll") for (int _i = 0; _i < 2; ++_i) \
        __builtin_amdgcn_global_load_lds((const unsigned*)((const char*)(gbase) + (voff)[_i]), (PG8_LAS unsigned*)(lds + (bufoff) + ldsw + _i * 8192), 16, 0, 0); } while (0)
#define PG8_LDA(dst, b, h) do { _Pragma("unroll") for (int m = 0; m < 4; ++m) _Pragma("unroll") for (int k = 0; k < 2; ++k) dst[m][k] = *(const PG8_LAS bf16x8*)(lds + PG8_SA(b, h) + aoff + m * 2048 + k * 1024); } while (0)
#define PG8_LDB(dst, b, h) do { _Pragma("unroll") for (int n = 0; n < 2; ++n) _Pragma("unroll") for (int k = 0; k < 2; ++k) dst[n][k] = *(const PG8_LAS bf16x8*)(lds + PG8_SB(b, h) + boff + n * 2048 + k * 1024); } while (0)
#define PG8_MMA(ai, bj, At, Bt) do { __builtin_amdgcn_s_setprio(1); _Pragma("unroll") for (int m = 0; m < 4; ++m) _Pragma("unroll") for (int n = 0; n < 2; ++n) _Pragma("unroll") for (int k = 0; k < 2; ++k) \
        acc[ai][bj][m][n] = __builtin_amdgcn_mfma_f32_16x16x32_bf16(Bt[n][k], At[m][k], acc[ai][bj][m][n], 0, 0, 0); __builtin_amdgcn_s_setprio(0); } while (0)
#define PG8_WAIT_V(n) asm volatile("s_waitcnt vmcnt(" #n ")" ::: "memory")
#define PG8_WAIT_L(n) asm volatile("s_waitcnt lgkmcnt(" #n ")" ::: "memory")
#define PG8_BAR __builtin_amdgcn_s_barrier()
#define PG8_SCHED __builtin_amdgcn_sched_barrier(0)
    Unit cur, nxt; int ui = 0;
    if (!S.next(0, cur)) return;
    f32x4 acc[2][2][4][2];
#pragma unroll
    for (int a = 0; a < 2; ++a)
#pragma unroll
        for (int b = 0; b < 2; ++b)
#pragma unroll
            for (int m = 0; m < 4; ++m)
#pragma unroll
                for (int n = 0; n < 2; ++n) acc[a][b][m][n] = (f32x4){0.f, 0.f, 0.f, 0.f};
    bf16x8 At[4][2], B0[2][2], B1[2][2];
    const char* cA = (const char*)g.A + (size_t)cur.pm * tstep; const char* cB = (const char*)g.Bt + (size_t)cur.pn * tstep;
    S.a_ready(cur);
    if constexpr (SP2) {
        PG8_STAGE(PG8_SB(0, 0), cB, voffB); PG8_STAGE(PG8_SB(0, 1), cB + hstep, voffB); PG8_STAGE(PG8_SA(0, 0), cA, voffA); PG8_STAGE(PG8_SA(0, 1), cA + hstep, voffA);
        if (wr == 1) PG8_BAR;
        PG8_WAIT_V(2); PG8_BAR;
        PG8_STAGE(PG8_SB(1, 0), cB + kstep, voffB); PG8_STAGE(PG8_SA(1, 0), cA + kstep, voffA); PG8_STAGE(PG8_SB(1, 1), cB + hstep + kstep, voffB);
        PG8_WAIT_V(6); PG8_BAR;
    } else {
        PG8_STAGE(PG8_SB(0, 0), cB, voffB); PG8_STAGE(PG8_SA(0, 0), cA, voffA); PG8_STAGE(PG8_SB(0, 1), cB + hstep, voffB); PG8_STAGE(PG8_SA(0, 1), cA + hstep, voffA);
        if (wr == 1) PG8_BAR;
        PG8_WAIT_V(4); PG8_BAR;
        PG8_STAGE(PG8_SB(1, 0), cB + kstep, voffB); PG8_STAGE(PG8_SA(1, 0), cA + kstep, voffA); PG8_STAGE(PG8_SB(1, 1), cB + hstep + kstep, voffB);
        PG8_WAIT_V(6); PG8_BAR;
    }
    for (;;) {
        const bool has_next = S.next(ui + 1, nxt);
        const char* nA = has_next ? (const char*)g.A + (size_t)nxt.pm * tstep : cA; const char* nB = has_next ? (const char*)g.Bt + (size_t)nxt.pn * tstep : cB;
        for (int t = 0; t < nt; t += 2) {
            const bool last = (t == nt - 2);
            const char* a1 = cA + (size_t)(t + 1) * kstep;
            const char* a2 = last ? nA : cA + (size_t)(t + 2) * kstep; const char* b2 = last ? nB : cB + (size_t)(t + 2) * kstep;
            const char* a3 = a2 + kstep; const char* b3 = b2 + kstep;
            if (last && has_next) S.a_ready(nxt);
            if constexpr (SP2) {
            PG8_LDB(B0, 0, 0); PG8_LDB(B1, 0, 1); PG8_SCHED; PG8_LDA(At, 0, 0); PG8_STAGE(PG8_SA(1, 1), a1 + hstep, voffA);
            PG8_WAIT_V(8); PG8_WAIT_L(0); PG8_BAR; PG8_MMA(0, 0, At, B0); PG8_MMA(0, 1, At, B1); PG8_BAR; PG8_SCHED;
            PG8_LDA(At, 0, 1); PG8_STAGE(PG8_SB(0, 0), b2, voffB); PG8_STAGE(PG8_SB(0, 1), b2 + hstep, voffB); PG8_STAGE(PG8_SA(0, 0), a2, voffA);
            PG8_WAIT_V(8); PG8_WAIT_L(0); PG8_BAR; PG8_MMA(1, 0, At, B0); PG8_MMA(1, 1, At, B1); PG8_BAR; PG8_SCHED;
            PG8_LDB(B0, 1, 0); PG8_LDB(B1, 1, 1); PG8_SCHED; PG8_LDA(At, 1, 0); PG8_STAGE(PG8_SA(0, 1), a2 + hstep, voffA);
            PG8_WAIT_V(8); PG8_WAIT_L(0); PG8_BAR; PG8_MMA(0, 0, At, B0); PG8_MMA(0, 1, At, B1); PG8_BAR; PG8_SCHED;
            PG8_LDA(At, 1, 1); PG8_STAGE(PG8_SB(1, 0), b3, voffB); PG8_STAGE(PG8_SB(1, 1), b3 + hstep, voffB); PG8_STAGE(PG8_SA(1, 0), a3, voffA);
            PG8_WAIT_V(8); PG8_WAIT_L(0); PG8_BAR; PG8_MMA(1, 0, At, B0); PG8_MMA(1, 1, At, B1); PG8_BAR; PG8_SCHED;
            } else {
            PG8_LDB(B0, 0, 0); PG8_SCHED; PG8_LDA(At, 0, 0); PG8_STAGE(PG8_SA(1, 1), a1 + hstep, voffA);
            PG8_WAIT_L(8); PG8_BAR; PG8_WAIT_L(0); PG8_MMA(0, 0, At, B0); PG8_BAR; PG8_SCHED;
            PG8_LDB(B1, 0, 1); PG8_STAGE(PG8_SB(0, 0), b2, voffB);
            PG8_BAR; PG8_WAIT_L(0); PG8_MMA(0, 1, At, B1); PG8_BAR;
            PG8_LDA(At, 0, 1); PG8_STAGE(PG8_SA(0, 0), a2, voffA);
            PG8_BAR; PG8_WAIT_L(0); PG8_MMA(1, 0, At, B0); PG8_BAR; PG8_SCHED;
            PG8_STAGE(PG8_SB(0, 1), b2 + hstep, voffB);
            PG8_WAIT_V(6); PG8_BAR; PG8_MMA(1, 1, At, B1); PG8_BAR;
            PG8_LDB(B0, 1, 0); PG8_SCHED; PG8_LDA(At, 1, 0); PG8_STAGE(PG8_SA(0, 1), a2 + hstep, voffA);
            PG8_WAIT_L(8); PG8_BAR; PG8_WAIT_L(0); PG8_MMA(0, 0, At, B0); PG8_BAR; PG8_SCHED;
            PG8_LDB(B1, 1, 1); PG8_STAGE(PG8_SB(1, 0), b3, voffB);
            PG8_BAR; PG8_WAIT_L(0); PG8_MMA(0, 1, At, B1); PG8_BAR;
            PG8_LDA(At, 1, 1); PG8_STAGE(PG8_SA(1, 0), a3, voffA);
            PG8_BAR; PG8_WAIT_L(0); PG8_MMA(1, 0, At, B0); PG8_BAR; PG8_SCHED;
            PG8_STAGE(PG8_SB(1, 1), b3 + hstep, voffB);
            PG8_WAIT_V(6); PG8_BAR; PG8_MMA(1, 1, At, B1); PG8_BAR;
            }
        }
        if constexpr (ALIGN_EPI) { if (wr == 0) PG8_BAR; }
        if constexpr (!Epi::AFTER_DRAIN) { E(acc, cur, wr, wc, fr, fq); S.done(cur); }
        if (!has_next) break;
#pragma unroll
        for (int a = 0; a < 2; ++a)
#pragma unroll
            for (int b = 0; b < 2; ++b)
#pragma unroll
                for (int m = 0; m < 4; ++m)
#pragma unroll
                    for (int n = 0; n < 2; ++n) acc[a][b][m][n] = (f32x4){0.f, 0.f, 0.f, 0.f};
        cur = nxt; cA = nA; cB = nB; ++ui;
        if constexpr (ALIGN_EPI) { if (wr == 1) PG8_BAR; }
    }
    PG8_WAIT_V(0);
    if constexpr (!ALIGN_EPI) { if (wr == 0) PG8_BAR; }
    PG8_BAR;
    if constexpr (Epi::AFTER_DRAIN) { E.fused(acc, cur, wr, wc, fr, fq, lds, wid, lane); S.done(cur); }
#undef PG8_SA
#undef PG8_SB
#undef PG8_STAGE
#undef PG8_LDA
#undef PG8_LDB
#undef PG8_MMA
#undef PG8_WAIT_V
#undef PG8_WAIT_L
#undef PG8_BAR
#undef PG8_SCHED
}
}
#define PG8_SP2 true
#define PG8_ALIGN true
namespace att {
using bf16 = __hip_bfloat16;
constexpr int D = 128, NW = 8, QBLK = 32, KVBLK = 64;
constexpr float SCALE = 0.088388347648318440f;
constexpr float THR = 8.f;
constexpr size_t SHM_V = KVBLK * D * 2, SHM_K = KVBLK * D * 2, SHM_ATTN = 2 * SHM_V + 2 * SHM_K + NW * 64 * 4;
using bf16x8 = __attribute__((ext_vector_type(8))) short;
using s16x4  = __attribute__((ext_vector_type(4))) short;
using f32x16 = __attribute__((ext_vector_type(16))) float;
using f32x8  = __attribute__((ext_vector_type(8))) float;
using u32x4  = __attribute__((ext_vector_type(4))) unsigned;
#define KSWZ(row, colB) ((row) * 256 + ((colB) ^ (((row) & 7) << 4)))
#define SBAR() __builtin_amdgcn_sched_barrier(0)
__device__ __forceinline__ int crow(int r, int hi) { return (r & 3) + 8 * (r >> 2) + 4 * hi; }
__device__ __forceinline__ unsigned cvtpk(float lo, float hi) {
  unsigned r; asm("v_cvt_pk_bf16_f32 %0, %1, %2" : "=v"(r) : "v"(lo), "v"(hi)); return r;
}
template <typename TIn> struct Stage;
template <> struct Stage<bf16>  { using T = bf16x8;
  __device__ static __forceinline__ T ld8(const bf16* p) { return *reinterpret_cast<const bf16x8*>(p); }
  __device__ static __forceinline__ bf16x8 tobf(T x) { return x; } };
template <> struct Stage<float> { using T = f32x8;
  __device__ static __forceinline__ T ld8(const float* p) { return *reinterpret_cast<const f32x8*>(p); }
  __device__ static __forceinline__ bf16x8 tobf(T x) {
    u32x4 w = {cvtpk(x[0], x[1]), cvtpk(x[2], x[3]), cvtpk(x[4], x[5]), cvtpk(x[6], x[7])}; return *reinterpret_cast<bf16x8*>(&w); } };

__device__ __forceinline__ void partialSM(f32x16& p0, f32x16& p1, float& m_reg, float& mn, float& alpha) {
  constexpr float C = SCALE * 1.4426950408889634f;
  float pmax = p0[0]; for (int r = 1; r < 16; ++r) pmax = fmaxf(pmax, p0[r]); for (int r = 0; r < 16; ++r) pmax = fmaxf(pmax, p1[r]);
  { auto rr = __builtin_amdgcn_permlane32_swap(__float_as_uint(pmax), __float_as_uint(pmax), false, false);
    pmax = fmaxf(__uint_as_float(rr[0]), __uint_as_float(rr[1])); }
  if (__builtin_expect(__all(pmax - m_reg <= THR / SCALE), 1)) { mn = m_reg; alpha = 1.f; }
  else { mn = fmaxf(m_reg, pmax); alpha = __builtin_amdgcn_exp2f((m_reg - mn) * C); m_reg = mn; }
  float mnC = -mn * C;
  for (int r = 0; r < 16; ++r) p0[r] = fmaf(p0[r], C, mnC); for (int r = 0; r < 16; ++r) p1[r] = fmaf(p1[r], C, mnC);
  for (int r = 0; r < 16; ++r) p0[r] = __builtin_amdgcn_exp2f(p0[r]);
}
__device__ __forceinline__ void finishSM(f32x16& p0, f32x16& p1, float alpha, float& l_reg, bf16x8& pa0, bf16x8& pa1, bf16x8& pa2, bf16x8& pa3) {
  for (int r = 0; r < 16; ++r) p1[r] = __builtin_amdgcn_exp2f(p1[r]);
  float ps = 0; for (int r = 0; r < 16; ++r) ps += p0[r]; for (int r = 0; r < 16; ++r) ps += p1[r];
  { auto rr = __builtin_amdgcn_permlane32_swap(__float_as_uint(ps), __float_as_uint(ps), false, false);
    ps = __uint_as_float(rr[0]) + __uint_as_float(rr[1]); }
  l_reg = l_reg * alpha + ps;
#define PK4(P, BASE, OUT) do { unsigned a0 = cvtpk(P[BASE + 0], P[BASE + 1]), a1 = cvtpk(P[BASE + 2], P[BASE + 3]);   \
    unsigned b0 = cvtpk(P[BASE + 4], P[BASE + 5]), b1 = cvtpk(P[BASE + 6], P[BASE + 7]);                              \
    auto r0 = __builtin_amdgcn_permlane32_swap(a0, b0, false, false); auto r1 = __builtin_amdgcn_permlane32_swap(a1, b1, false, false); \
    u32x4 w = {r0[0], r1[0], r0[1], r1[1]}; OUT = *reinterpret_cast<bf16x8*>(&w); } while (0)
  PK4(p0, 0, pa0); PK4(p0, 8, pa1); PK4(p1, 0, pa2); PK4(p1, 8, pa3);
#undef PK4
}
__device__ __forceinline__ void qkt(f32x16& p0, f32x16& p1, const bf16* Ks, const bf16x8* qr, int r32, int hi) {
  p0 = f32x16{}; p1 = f32x16{};
  for (int d0 = 0; d0 < 8; ++d0) { int cb = (d0 * 16 + hi * 8) * 2;
    bf16x8 b0 = *reinterpret_cast<const bf16x8*>((const char*)Ks + KSWZ(r32, cb));
    bf16x8 b1 = *reinterpret_cast<const bf16x8*>((const char*)Ks + KSWZ(32 + r32, cb));
    p0 = __builtin_amdgcn_mfma_f32_32x32x16_bf16(b0, qr[d0], p0, 0, 0, 0);
    p1 = __builtin_amdgcn_mfma_f32_32x32x16_bf16(b1, qr[d0], p1, 0, 0, 0); }
}
__device__ __forceinline__ int v_st(int k, int c) { const int kk = (k & ~0xC) | ((k & 4) << 1) | ((k & 8) >> 1); return ((kk >> 3) * 4 + (c >> 5)) * 512 + ((kk & 7) * 32 + (c & 31)) * 2; }
__device__ __forceinline__ int v_rd_base(int lane) { return ((lane & 3) << 3) | (((lane >> 2) & 3) << 6) | (((lane >> 4) & 1) << 5) | (((lane >> 5) & 1) << 8); }
constexpr int v_rd_off(int d0, int ks, int half) { return d0 * 512 + ks * 4096 + half * 2048; }
template <int OFF> __device__ __forceinline__ s16x4 tr_read(int vb) {
  s16x4 r; asm volatile("ds_read_b64_tr_b16 %0, %1 offset:%2" : "=&v"(r) : "v"(vb), "i"(OFF) : "memory"); return r;
}
template <int D0> __device__ __forceinline__ void pv_one(f32x16& od, int vb, bf16x8 pa0, bf16x8 pa1, bf16x8 pa2, bf16x8 pa3) {
  const s16x4 l0 = tr_read<v_rd_off(D0, 0, 0)>(vb), h0 = tr_read<v_rd_off(D0, 0, 1)>(vb), l1 = tr_read<v_rd_off(D0, 1, 0)>(vb), h1 = tr_read<v_rd_off(D0, 1, 1)>(vb);
  const s16x4 l2 = tr_read<v_rd_off(D0, 2, 0)>(vb), h2 = tr_read<v_rd_off(D0, 2, 1)>(vb), l3 = tr_read<v_rd_off(D0, 3, 0)>(vb), h3 = tr_read<v_rd_off(D0, 3, 1)>(vb);
  asm volatile("s_waitcnt lgkmcnt(0)" ::: "memory"); SBAR();
#define PK(L, H) (bf16x8){L[0], L[1], L[2], L[3], H[0], H[1], H[2], H[3]}
  od = __builtin_amdgcn_mfma_f32_32x32x16_bf16(pa0, PK(l0, h0), od, 0, 0, 0);
  od = __builtin_amdgcn_mfma_f32_32x32x16_bf16(pa1, PK(l1, h1), od, 0, 0, 0);
  od = __builtin_amdgcn_mfma_f32_32x32x16_bf16(pa2, PK(l2, h2), od, 0, 0, 0);
  od = __builtin_amdgcn_mfma_f32_32x32x16_bf16(pa3, PK(l3, h3), od, 0, 0, 0);
#undef PK
}
struct VFrag { s16x4 l0, h0, l1, h1, l2, h2, l3, h3; };
template <int D0> __device__ __forceinline__ void pv_rd(VFrag& f, int vb) {
  f.l0 = tr_read<v_rd_off(D0, 0, 0)>(vb); f.h0 = tr_read<v_rd_off(D0, 0, 1)>(vb); f.l1 = tr_read<v_rd_off(D0, 1, 0)>(vb); f.h1 = tr_read<v_rd_off(D0, 1, 1)>(vb);
  f.l2 = tr_read<v_rd_off(D0, 2, 0)>(vb); f.h2 = tr_read<v_rd_off(D0, 2, 1)>(vb); f.l3 = tr_read<v_rd_off(D0, 3, 0)>(vb); f.h3 = tr_read<v_rd_off(D0, 3, 1)>(vb);
}
__device__ __forceinline__ void pv_mm(f32x16& od, const VFrag& f, bf16x8 pa0, bf16x8 pa1, bf16x8 pa2, bf16x8 pa3) {
#define PK(L, H) (bf16x8){L[0], L[1], L[2], L[3], H[0], H[1], H[2], H[3]}
  od = __builtin_amdgcn_mfma_f32_32x32x16_bf16(pa0, PK(f.l0, f.h0), od, 0, 0, 0);
  od = __builtin_amdgcn_mfma_f32_32x32x16_bf16(pa1, PK(f.l1, f.h1), od, 0, 0, 0);
  od = __builtin_amdgcn_mfma_f32_32x32x16_bf16(pa2, PK(f.l2, f.h2), od, 0, 0, 0);
  od = __builtin_amdgcn_mfma_f32_32x32x16_bf16(pa3, PK(f.l3, f.h3), od, 0, 0, 0);
#undef PK
}
#define PV_WAIT(n) do { asm volatile("s_waitcnt lgkmcnt(" #n ")" ::: "memory"); SBAR(); } while (0)
__device__ __forceinline__ void pv_d0(f32x16* o, int vb, bf16x8 pa0, bf16x8 pa1, bf16x8 pa2, bf16x8 pa3) {
#if MK_PVPIPE
  VFrag fa, fb;
  pv_rd<0>(fa, vb); pv_rd<1>(fb, vb);
  PV_WAIT(8); pv_mm(o[0], fa, pa0, pa1, pa2, pa3); SBAR();
  pv_rd<2>(fa, vb);
  PV_WAIT(8); pv_mm(o[1], fb, pa0, pa1, pa2, pa3); SBAR();
  pv_rd<3>(fb, vb);
  PV_WAIT(8); pv_mm(o[2], fa, pa0, pa1, pa2, pa3); SBAR();
  PV_WAIT(0); pv_mm(o[3], fb, pa0, pa1, pa2, pa3);
#else
  pv_one<0>(o[0], vb, pa0, pa1, pa2, pa3); pv_one<1>(o[1], vb, pa0, pa1, pa2, pa3); pv_one<2>(o[2], vb, pa0, pa1, pa2, pa3); pv_one<3>(o[3], vb, pa0, pa1, pa2, pa3);
#endif
}
constexpr int crow0(int r) { return (r & 3) + 8 * (r >> 2); }
constexpr float LOG2E = 1.4426950408889634f;
__device__ __forceinline__ void partialSM_neg(f32x16& p0, f32x16& p1, float& m_reg, f32x16& negm, float& alpha) {
  float pmax = p0[0];
#pragma unroll
  for (int r = 1; r < 16; ++r) pmax = fmaxf(pmax, p0[r]);
#pragma unroll
  for (int r = 0; r < 16; ++r) pmax = fmaxf(pmax, p1[r]);
  { auto rr = __builtin_amdgcn_permlane32_swap(__float_as_uint(pmax), __float_as_uint(pmax), false, false);
    pmax = fmaxf(__uint_as_float(rr[0]), __uint_as_float(rr[1])); }
  if (__builtin_expect(__all(pmax <= THR), 1)) { alpha = 1.f; }
  else { const float dl = fmaxf(pmax, 0.f); m_reg += dl; alpha = __builtin_amdgcn_exp2f(-dl);
#pragma unroll
    for (int r = 0; r < 16; ++r) { p0[r] -= dl; p1[r] -= dl; negm[r] = -m_reg; } }
#pragma unroll
  for (int r = 0; r < 16; ++r) p0[r] = __builtin_amdgcn_exp2f(p0[r]);
}
__device__ __forceinline__ void partialSM_dil(f32x16& p0, f32x16& p1, float& m_reg, float& mn, float& alpha, float dq, float dlo, float dhi, float nslopeC) {
  constexpr float C = SCALE * LOG2E;
#pragma unroll
  for (int r = 0; r < 16; ++r) {
    const float d0 = dq + (float)crow0(r), d1 = d0 + 32.f;
    const float t0 = fmaf(p0[r], C, nslopeC * fabsf(d0)), t1 = fmaf(p1[r], C, nslopeC * fabsf(d1));
    p0[r] = (d0 >= dlo && d0 <= dhi) ? t0 : -1e30f;
    p1[r] = (d1 >= dlo && d1 <= dhi) ? t1 : -1e30f;
  }
  float pmax = p0[0];
#pragma unroll
  for (int r = 1; r < 16; ++r) pmax = fmaxf(pmax, p0[r]);
#pragma unroll
  for (int r = 0; r < 16; ++r) pmax = fmaxf(pmax, p1[r]);
  { auto rr = __builtin_amdgcn_permlane32_swap(__float_as_uint(pmax), __float_as_uint(pmax), false, false);
    pmax = fmaxf(__uint_as_float(rr[0]), __uint_as_float(rr[1])); }
  if (__builtin_expect(__all(pmax - m_reg <= THR * LOG2E), 1)) { mn = m_reg; alpha = 1.f; }
  else { mn = fmaxf(m_reg, pmax); alpha = __builtin_amdgcn_exp2f(m_reg - mn); m_reg = mn; }
#pragma unroll
  for (int r = 0; r < 16; ++r) { p0[r] = p0[r] - mn; p1[r] = p1[r] - mn; }
#pragma unroll
  for (int r = 0; r < 16; ++r) p0[r] = __builtin_amdgcn_exp2f(p0[r]);
}

template <bool DIL>
__device__ __forceinline__ void attn_body(const bf16* __restrict__ Qb, const bf16* __restrict__ Kh, const bf16* __restrict__ Vh, long qs, long ks,
                                          bf16* __restrict__ Ob, long os, float* __restrict__ lse_o, int lse_s, int i0, int nsub, float nslopeC, int seq, char* lds) {
  typedef __attribute__((address_space(3))) unsigned lds_u32;
  using St = Stage<bf16>;
  const int tid = otid(), wid = __builtin_amdgcn_readfirstlane(tid >> 6), lane = tid & 63, r32 = lane & 31, hi = lane >> 5;
  char* V_lds = lds + 4 * SHM_K; char* K_lds = lds;
  float* ws = (float*)(lds + 4 * SHM_K + 4 * SHM_V) + wid * 64; float* li_l = ws; float* al_l = ws + 32;
  float m_reg = -1e30f, l_reg = 0; f32x16 o[4] = {}; bf16x8 qr[8];
  const bf16* Qw = Qb + (long)(wid * QBLK + r32) * qs + hi * 8;
#pragma unroll
  for (int d0 = 0; d0 < 8; ++d0) qr[d0] = St::ld8(Qw + d0 * 16);
  const int vb0 = (int)(uintptr_t)V_lds + v_rd_base(lane);
  const int kb = DIL ? i0 - 64 : 0;
#define KROW(k) (DIL ? (long)min(max(kb + (k), 0), nsub - 1) : (long)(k))
  int krow[2], kcol[2], vrow[2], vcol[2];
#pragma unroll
  for (int i = 0; i < 2; ++i) { const int pc = 2 * wid + i;
    krow[i] = pc * 4 + (lane >> 4); kcol[i] = (((lane & 15) ^ (krow[i] & 7)) << 3);
    const int sub = pc * 2 + (lane >> 5), kk = ((sub >> 2) << 3) + ((lane & 31) >> 2);
    vrow[i] = (kk & ~0xC) | ((kk & 4) << 1) | ((kk & 8) >> 1); vcol[i] = ((sub & 3) << 5) + ((lane & 3) << 3); }
  unsigned kdo[2], vdo[2];
#pragma unroll
  for (int i = 0; i < 2; ++i) { kdo[i] = (unsigned)(krow[i] * (int)ks + kcol[i]); vdo[i] = (unsigned)(vrow[i] * (int)ks + vcol[i]); }
#define DMA(t, buf) do { if constexpr (DIL) { _Pragma("unroll") for (int i_ = 0; i_ < 2; ++i_) { \
      __builtin_amdgcn_global_load_lds((const unsigned*)(Kh + KROW((t) * KVBLK + krow[i_]) * ks + kcol[i_]), (lds_u32*)(K_lds + (buf) * SHM_K + (2 * wid + i_) * 1024), 16, 0, 0); \
      __builtin_amdgcn_global_load_lds((const unsigned*)(Vh + KROW((t) * KVBLK + vrow[i_]) * ks + vcol[i_]), (lds_u32*)(V_lds + (buf) * SHM_V + (2 * wid + i_) * 1024), 16, 0, 0); } } \
    else { const bf16* Kt_ = Kh + (long)(t) * (KVBLK * ks); const bf16* Vt_ = Vh + (long)(t) * (KVBLK * ks); _Pragma("unroll") for (int i_ = 0; i_ < 2; ++i_) { \
      __builtin_amdgcn_global_load_lds((const unsigned*)(Kt_ + kdo[i_]), (lds_u32*)(K_lds + (buf) * SHM_K + (2 * wid + i_) * 1024), 16, 0, 0); \
      __builtin_amdgcn_global_load_lds((const unsigned*)(Vt_ + vdo[i_]), (lds_u32*)(V_lds + (buf) * SHM_V + (2 * wid + i_) * 1024), 16, 0, 0); } } } while (0)
#define ENDSTEP(j) do { if ((j) + 2 < NT) asm volatile("s_waitcnt vmcnt(4) lgkmcnt(0)\n\ts_barrier" ::: "memory"); else asm volatile("s_waitcnt vmcnt(0) lgkmcnt(0)\n\ts_barrier" ::: "memory"); } while (0)
#define RESC(a) do { if (__any((a) < 1.f)) { if (hi == 0) al_l[r32] = (a); asm volatile("s_waitcnt lgkmcnt(0)" ::: "memory"); \
    for (int d = 0; d < 4; ++d) for (int r = 0; r < 16; ++r) o[d][r] *= al_l[crow(r, hi)]; } } while (0)
#define PSM(P0, P1, MN, AL, jt) do { if constexpr (DIL) { const int t_ = otid(), iq_ = (t_ >> 6) * QBLK + (t_ & 31), hi_ = (t_ >> 5) & 1; \
      partialSM_dil(P0, P1, m_reg, MN, AL, (float)(-64 - iq_ + 4 * hi_ + 64 * (jt)), fmaxf(-64.f, (float)(-(i0 + iq_))), fminf(64.f, (float)(nsub - 1 - (i0 + iq_))), nslopeC); } \
    else partialSM(P0, P1, m_reg, MN, AL); } while (0)
#if MK_SGB
#define SGB_A() do { __builtin_amdgcn_sched_group_barrier(0x100, 4, 0); \
    _Pragma("unroll") for (int g_ = 0; g_ < 12; ++g_) { __builtin_amdgcn_sched_group_barrier(0x008, 1, 0); __builtin_amdgcn_sched_group_barrier(0x100, 1, 0); __builtin_amdgcn_sched_group_barrier(0x002, 6, 0); } \
    _Pragma("unroll") for (int g_ = 0; g_ < 4; ++g_) { __builtin_amdgcn_sched_group_barrier(0x008, 1, 0); __builtin_amdgcn_sched_group_barrier(0x002, 6, 0); } } while (0)
#else
#define SGB_A() do {} while (0)
#endif
#define KBUF(j) ((const bf16*)(K_lds + ((j) & 3) * SHM_K))
#define VBUF(j) (vb0 + ((j) & 3) * (int)SHM_V)
  f32x16 pA0, pA1, pB0, pB1; float mnA, mnB, alA, alB; bf16x8 pa0, pa1, pa2, pa3; const int NT = DIL ? 6 : seq / KVBLK;
  DMA(0, 0); DMA(1, 1);
  if constexpr (!DIL && MK_PP) { DMA(2, 2); asm volatile("s_waitcnt vmcnt(8)\n\ts_barrier" ::: "memory"); }
  else asm volatile("s_waitcnt vmcnt(4)\n\ts_barrier" ::: "memory");
  struct KFrag { bf16x8 a, b; };
  int koff[4];
#pragma unroll
  for (int d0 = 0; d0 < 4; ++d0) koff[d0] = KSWZ(r32, (d0 * 16 + hi * 8) * 2);
  const int kbase0 = (int)(uintptr_t)K_lds;
#define KRD(f, d0, kb) asm volatile("ds_read_b128 %0, %2 offset:%3\n\tds_read_b128 %1, %2 offset:%4" : "=&v"(f.a), "=&v"(f.b) : "v"((kb) + koff[(d0) & 3]), "i"(((d0) >> 2) * 128), "i"(((d0) >> 2) * 128 + 8192) : "memory")
#define QMM(f, d0) do { pA0 = __builtin_amdgcn_mfma_f32_32x32x16_bf16(f.a, qr[d0], pA0, 0, 0, 0); pA1 = __builtin_amdgcn_mfma_f32_32x32x16_bf16(f.b, qr[d0], pA1, 0, 0, 0); } while (0)
#define LW(n) do { asm volatile("s_waitcnt lgkmcnt(" #n ")" ::: "memory"); SBAR(); } while (0)
  if constexpr (DIL) {
    const int rlo = wid >> 1;
    for (int j = 0; j < NT; ++j) {
      if (j + 2 < NT) DMA(j + 2, (j + 2) & 3);
      if (j >= rlo && j <= rlo + 2) {
        SBAR();
        { const int kb_ = kbase0 + (j & 3) * (int)SHM_K; KFrag k0_, k1_, k2_;
          KRD(k0_, 0, kb_); KRD(k1_, 1, kb_); KRD(k2_, 2, kb_); pA0 = f32x16{}; pA1 = f32x16{};
          LW(4); QMM(k0_, 0); SBAR(); KRD(k0_, 3, kb_);
          LW(4); QMM(k1_, 1); SBAR(); KRD(k1_, 4, kb_);
          LW(4); QMM(k2_, 2); SBAR(); KRD(k2_, 5, kb_);
          LW(4); QMM(k0_, 3); SBAR(); KRD(k0_, 6, kb_);
          LW(4); QMM(k1_, 4); SBAR(); KRD(k1_, 7, kb_);
          LW(4); QMM(k2_, 5); SBAR();
          LW(2); QMM(k0_, 6); SBAR();
          LW(0); QMM(k1_, 7); SBAR(); }
        PSM(pA0, pA1, mnA, alA, j); RESC(alA);
        finishSM(pA0, pA1, alA, l_reg, pa0, pa1, pa2, pa3); SBAR();
        pv_d0(o, VBUF(j), pa0, pa1, pa2, pa3);
      }
      if (j + 1 < NT) ENDSTEP(j);
    }
  } else if constexpr (MK_PP) {
    const bool grpB = wid >= 4;
#if MK_NEGM
    m_reg = 0.f; f32x16 negm = f32x16{};
#endif
#define PP_BAR(VM) do { if (VM) { asm volatile("s_waitcnt vmcnt(4) lgkmcnt(0)\n\ts_barrier" ::: "memory"); } else { asm volatile("s_waitcnt vmcnt(0) lgkmcnt(0)\n\ts_barrier" ::: "memory"); } } while (0)
#define PP_BAR_PLAIN() asm volatile("s_waitcnt lgkmcnt(0)\n\ts_barrier" ::: "memory")
    if (grpB) PP_BAR_PLAIN();
    qkt(pA0, pA1, KBUF(0), qr, r32, hi);
    if (grpB) PP_BAR(2 < NT); else PP_BAR_PLAIN();
    for (int t = 0; t < NT; ++t) {
      if (grpB && t + 3 < NT) DMA(t + 3, (t + 3) & 3);
#if MK_NEGM
      partialSM_neg(pA0, pA1, m_reg, negm, alA); RESC(alA);
#else
      PSM(pA0, pA1, mnA, alA, t); RESC(alA);
#endif
      finishSM(pA0, pA1, alA, l_reg, pa0, pa1, pa2, pa3);
#if MK_PROBE_V
      { float dm_ = alA;
#pragma unroll
        for (int q_ = 0; q_ < 32; ++q_) asm volatile("v_add_f32 %0, %0, %0" : "+v"(dm_));
        if (dm_ == 123.456f) l_reg += 1.f; }
#endif
      if (!grpB) PP_BAR(t + 2 < NT); else PP_BAR_PLAIN();
      if (!grpB && t + 3 < NT) DMA(t + 3, (t + 3) & 3);
      SBAR();
      if (t + 1 < NT) {
        const int kb_ = kbase0 + ((t + 1) & 3) * (int)SHM_K, vb_ = VBUF(t);
        KFrag k0_, k1_; VFrag fa_, fb_;
        KRD(k0_, 0, kb_); KRD(k1_, 1, kb_); pv_rd<0>(fa_, vb_);
#if MK_NEGM
        LW(10); pA0 = __builtin_amdgcn_mfma_f32_32x32x16_bf16(k0_.a, qr[0], negm, 0, 0, 0); pA1 = __builtin_amdgcn_mfma_f32_32x32x16_bf16(k0_.b, qr[0], negm, 0, 0, 0); SBAR(); KRD(k0_, 2, kb_);
#else
        pA0 = f32x16{}; pA1 = f32x16{};
        LW(10); QMM(k0_, 0); SBAR(); KRD(k0_, 2, kb_);
#endif
        LW(10); QMM(k1_, 1); SBAR(); KRD(k1_, 3, kb_);
        LW(4);  pv_mm(o[0], fa_, pa0, pa1, pa2, pa3); SBAR(); pv_rd<1>(fb_, vb_);
        LW(10); QMM(k0_, 2); SBAR(); KRD(k0_, 4, kb_);
        LW(10); QMM(k1_, 3); SBAR(); KRD(k1_, 5, kb_);
        LW(4);  pv_mm(o[1], fb_, pa0, pa1, pa2, pa3); SBAR(); pv_rd<2>(fa_, vb_);
        LW(10); QMM(k0_, 4); SBAR(); KRD(k0_, 6, kb_);
        LW(10); QMM(k1_, 5); SBAR(); KRD(k1_, 7, kb_);
        LW(4);  pv_mm(o[2], fa_, pa0, pa1, pa2, pa3); SBAR(); pv_rd<3>(fb_, vb_);
        LW(10); QMM(k0_, 6); SBAR();
        LW(8);  QMM(k1_, 7); SBAR();
        LW(0);  pv_mm(o[3], fb_, pa0, pa1, pa2, pa3);
      } else pv_d0(o, VBUF(t), pa0, pa1, pa2, pa3);
      if (t + 1 < NT) { if (grpB) PP_BAR(t + 3 < NT); else PP_BAR_PLAIN(); }
    }
    if (!grpB) PP_BAR_PLAIN();
#undef PP_BAR
#undef PP_BAR_PLAIN
#undef KRD
#undef QMM
#undef LW
  } else {
  if (2 < NT) DMA(2, 2);
  qkt(pA0, pA1, KBUF(0), qr, r32, hi); PSM(pA0, pA1, mnA, alA, 0);
  ENDSTEP(0);
  for (int j = 1; j + 1 < NT; j += 2) {
    if (j + 2 < NT) DMA(j + 2, (j + 2) & 3);
    SBAR(); qkt(pB0, pB1, KBUF(j), qr, r32, hi);
    finishSM(pA0, pA1, alA, l_reg, pa0, pa1, pa2, pa3); SGB_A(); SBAR();
    pv_d0(o, VBUF(j - 1), pa0, pa1, pa2, pa3); PSM(pB0, pB1, mnB, alB, j);
    RESC(alB); ENDSTEP(j);
    if (j + 3 < NT) DMA(j + 3, (j + 3) & 3);
    SBAR(); qkt(pA0, pA1, KBUF(j + 1), qr, r32, hi);
    finishSM(pB0, pB1, alB, l_reg, pa0, pa1, pa2, pa3); SGB_A(); SBAR();
    pv_d0(o, VBUF(j), pa0, pa1, pa2, pa3); PSM(pA0, pA1, mnA, alA, j + 1);
    RESC(alA); ENDSTEP(j + 1);
  }
  SBAR(); qkt(pB0, pB1, KBUF(NT - 1), qr, r32, hi);
  finishSM(pA0, pA1, alA, l_reg, pa0, pa1, pa2, pa3); SBAR();
  pv_d0(o, VBUF(NT - 2), pa0, pa1, pa2, pa3); PSM(pB0, pB1, mnB, alB, NT - 1);
  RESC(alB);
  finishSM(pB0, pB1, alB, l_reg, pa0, pa1, pa2, pa3); SBAR();
  pv_d0(o, VBUF(NT - 1), pa0, pa1, pa2, pa3);
  }
  if (hi == 0) li_l[r32] = l_reg; asm volatile("s_waitcnt lgkmcnt(0)" ::: "memory");
  if constexpr (DIL) { if (hi == 0) lse_o[(long)(wid * QBLK + r32) * lse_s] = m_reg + __log2f(l_reg); }
  float rli[16];
#pragma unroll
  for (int r = 0; r < 16; ++r) rli[r] = __builtin_amdgcn_rcpf(li_l[crow(r, hi)]);
  bf16* Ow = Ob + (long)(wid * QBLK) * os;
#pragma unroll
  for (int r = 0; r < 16; ++r) { const int orow = crow(r, hi);
#pragma unroll
    for (int d0 = 0; d0 < 4; ++d0) Ow[(long)orow * os + d0 * 32 + r32] = __float2bfloat16(o[d0][r] * rli[r]); }
  asm volatile("s_waitcnt lgkmcnt(0)\n\ts_barrier" ::: "memory");
#undef KROW
#undef DMA
#undef ENDSTEP
#undef RESC
#undef PSM
#undef KBUF
#undef SGB_A
#undef VBUF
}
}

#define GAS __attribute__((address_space(1)))
#define LAS __attribute__((address_space(3)))
typedef unsigned short bf16_t;
typedef unsigned v4u __attribute__((ext_vector_type(4)));
typedef unsigned v2u __attribute__((ext_vector_type(2)));
typedef float f32x4 __attribute__((ext_vector_type(4)));
#define LDS_WAIT() asm volatile("s_waitcnt lgkmcnt(0)" ::: "memory")

constexpr size_t MiB = 1u << 20;
constexpr size_t WS_W1T = 0;
constexpr size_t WS_W2T = 104 * MiB;
constexpr size_t WS_H = 136 * MiB;
constexpr size_t WS_PROJ = 200 * MiB;
constexpr size_t WS_YA = 408 * MiB;
constexpr size_t WS_YB = 440 * MiB;
constexpr size_t WS_LSE = 536 * MiB;
constexpr size_t WS_ROPE = 538 * MiB;
constexpr size_t WS_XB = 540 * MiB;
constexpr size_t WS_ROWSQ = 604 * MiB;
constexpr size_t WS_END = 616 * MiB;
static_assert((size_t)DEPTH * DIN * DM * 2 <= WS_W2T - WS_W1T && (size_t)M * DIN * 2 <= WS_YA - WS_PROJ && (size_t)3 * M * DB * 2 <= WS_LSE - WS_YB, "ws map");
constexpr int LDS_BYTES = 147456;
constexpr int N_PHASES = 2 + 5 * DEPTH;

__device__ __forceinline__ unsigned f2bf(float f) { unsigned u = __builtin_bit_cast(unsigned, f); return (u + 0x7fffu + ((u >> 16) & 1u)) >> 16; }
__device__ __forceinline__ unsigned pk2(float lo, float hi) { return f2bf(lo) | (f2bf(hi) << 16); }
__device__ __forceinline__ float bflo(unsigned w) { return __uint_as_float(w << 16); }
__device__ __forceinline__ float bfhi(unsigned w) { return __uint_as_float(w & 0xffff0000u); }
__device__ __forceinline__ float wave_sum(float v) {
#pragma unroll
    for (int o = 1; o < 64; o <<= 1) v += __shfl_xor(v, o);
    return v;
}

__device__ const float INV_FREQ[32] = {1.000000000e+00f, 7.498942614e-01f, 5.623413324e-01f, 4.216965139e-01f, 3.162277639e-01f, 2.371373773e-01f, 1.778279394e-01f, 1.333521307e-01f,
    1.000000015e-01f, 7.498941571e-02f, 5.623413250e-02f, 4.216965288e-02f, 3.162277490e-02f, 2.371373773e-02f, 1.778279431e-02f, 1.333521493e-02f,
    9.999999776e-03f, 7.498941850e-03f, 5.623413250e-03f, 4.216964822e-03f, 3.162277630e-03f, 2.371373586e-03f, 1.778279431e-03f, 1.333521446e-03f,
    1.000000047e-03f, 7.498942432e-04f, 5.623413017e-04f, 4.216965172e-04f, 3.162277571e-04f, 2.371373703e-04f, 1.778279402e-04f, 1.333521504e-04f};

__device__ __forceinline__ void sincos_acc(float a, float& s, float& c) {
    const double x = (double)a, kd = __builtin_rint(x * 0.63661977236758134308);
    const int k = (int)kd; const double r = x - kd * 1.57079632679489661923, r2 = r * r;
    const double sp = r * (1.0 + r2 * (-1.0 / 6 + r2 * (1.0 / 120 + r2 * (-1.0 / 5040 + r2 * (1.0 / 362880 + r2 * (-1.0 / 39916800 + r2 * (1.0 / 6227020800.0)))))));
    const double cp = 1.0 + r2 * (-0.5 + r2 * (1.0 / 24 + r2 * (-1.0 / 720 + r2 * (1.0 / 40320 + r2 * (-1.0 / 3628800 + r2 * (1.0 / 479001600.0 + r2 * (-1.0 / 87178291200.0)))))));
    const int q = k & 3;
    const double sv = (q == 0) ? sp : (q == 1) ? cp : (q == 2) ? -sp : -cp, cv = (q == 0) ? cp : (q == 1) ? -sp : (q == 2) ? -cp : sp;
    s = (float)sv; c = (float)cv;
}

__device__ __forceinline__ void p0_transpose_item(const float* W, int K, int N, bf16_t* WT, LAS float* scr, int item, int lane, const float* kscale) {
    const int nblk = N / 32, kb = item / nblk, nb = item % nblk, k0 = 64 * kb, n0 = 32 * nb;
#pragma unroll 8
    for (int i = 0; i < 32; ++i) { const int kk = 2 * i + (lane >> 5); scr[kk * 33 + (lane & 31)] = W[(size_t)(k0 + kk) * N + n0 + (lane & 31)] * (kscale ? kscale[k0 + kk] : 1.0f); }
    LDS_WAIT(); asm volatile("" ::: "memory");
    const int c = lane & 7;
#pragma unroll
    for (int j = 0; j < 4; ++j) { const int n = (lane >> 3) + 8 * j; const LAS float* s = scr + (8 * c) * 33 + n;
        v4u o; o.x = pk2(s[0 * 33], s[1 * 33]); o.y = pk2(s[2 * 33], s[3 * 33]); o.z = pk2(s[4 * 33], s[5 * 33]); o.w = pk2(s[6 * 33], s[7 * 33]);
        *(v4u*)(WT + (size_t)(n0 + n) * K + k0 + 8 * c) = o; }
    LDS_WAIT(); asm volatile("" ::: "memory");
}

#define XB_TMO      128
#define XB_XCNT(j)  (256  + 64 * (j))
#define XB_XSUB(j)  (1280 + 64 * (j))
#define XB_XGEN(j)  (2304 + 64 * (j))
#define XB_TOP      3328
#define XB_TOPGEN   3392
#define XCD_BAR_WORDS 3456
#define XB_SPIN_CAP (1u << 18)

__device__ __forceinline__ unsigned xb_ld(unsigned* p)              { return __hip_atomic_load(p, __ATOMIC_RELAXED, __HIP_MEMORY_SCOPE_AGENT); }
__device__ __forceinline__ unsigned xb_add(unsigned* p, unsigned v) { return __hip_atomic_fetch_add(p, v, __ATOMIC_RELAXED, __HIP_MEMORY_SCOPE_AGENT); }
__device__ __forceinline__ unsigned xb_xcc_id() { return (unsigned)__builtin_amdgcn_s_getreg((3 << 11) | 20) & 0xFu; }
#define XB_SPIN(cond, bar) do { unsigned _sp = 0; while (cond) { __builtin_amdgcn_s_sleep(1); \
    if ((++_sp & 255u) == 0u) { if (xb_ld(&(bar)[XB_TMO])) break; if (_sp > XB_SPIN_CAP) { atomicAdd(&(bar)[XB_TMO], 1u); break; } } } } while (0)

struct XcdBarrier {
    unsigned* bar; unsigned x;
    volatile LAS unsigned* st;
};

__device__ __forceinline__ XcdBarrier xcd_barrier_post(unsigned* bar, volatile LAS unsigned* st) {
    XcdBarrier b; b.bar = bar; b.x = xb_xcc_id(); b.st = st;
    if (threadIdx.x == 0) (void)xb_add(&bar[XB_XCNT(b.x)], 1u);
    return b;
}
__device__ __forceinline__ void xcd_barrier_complete(unsigned* bar, unsigned x, unsigned& nloc, unsigned& nx) {
    const unsigned G = gridDim.x * gridDim.y * gridDim.z;
    unsigned sum, cnt, mine, sp = 0u;
    for (;;) {
        sum = 0u; cnt = 0u; mine = 0u;
#pragma unroll
        for (unsigned j = 0; j < 16; ++j) { const unsigned c = xb_ld(&bar[XB_XCNT(j)]); sum += c; cnt += (c > 0u) ? 1u : 0u; mine = (j == x) ? c : mine; }
        if (sum == G) break;
        __builtin_amdgcn_s_sleep(1);
        if ((++sp & 255u) == 0u) { if (xb_ld(&bar[XB_TMO])) break; if (sp > XB_SPIN_CAP) { atomicAdd(&bar[XB_TMO], 1u); break; } }
    }
    nloc = mine > 0u ? mine : 1u; nx = cnt > 0u ? cnt : 1u;
}

__device__ __forceinline__ void xcd_barrier(const XcdBarrier& b) {
    asm volatile("s_waitcnt vmcnt(0)" ::: "memory");
    __syncthreads();
    if (threadIdx.x == 0) {
        unsigned* bar = b.bar;
        __builtin_amdgcn_s_waitcnt(0);
        unsigned nloc = b.st[0], nx = b.st[1];
        if (nloc == 0u) { xcd_barrier_complete(bar, b.x, nloc, nx); b.st[0] = nloc; b.st[1] = nx; }
        const unsigned old = xb_add(&bar[XB_XSUB(b.x)], 1u);
        const unsigned gen = old / nloc;
        if (old + 1u == (gen + 1u) * nloc) {
            __builtin_amdgcn_fence(__ATOMIC_RELEASE, "agent");
            asm volatile("s_waitcnt vmcnt(0)" ::: "memory");
            const unsigned og = xb_add(&bar[XB_TOP], 1u);
            const unsigned tg = og / nx;
            if (og + 1u == (tg + 1u) * nx) xb_add(&bar[XB_TOPGEN], 1u);
            else XB_SPIN(xb_ld(&bar[XB_TOPGEN]) == tg, bar);
            __builtin_amdgcn_fence(__ATOMIC_ACQUIRE, "agent");
            xb_add(&bar[XB_XGEN(b.x)], 1u);
            asm volatile("s_waitcnt vmcnt(0)" ::: "memory");
        } else {
            XB_SPIN(xb_ld(&bar[XB_XGEN(b.x)]) == gen, bar);
            __builtin_amdgcn_fence(__ATOMIC_ACQUIRE, "agent");
            asm volatile("s_waitcnt vmcnt(0)" ::: "memory");
        }
    }
    __syncthreads();
}

constexpr size_t WS_CTL = 539 * MiB, CTL_BYTES = 16384;
constexpr int MISC_OFF = 147456 - 128;
__device__ __forceinline__ void gate_row(int m, int lane, const bf16_t* __restrict__ YA, const bf16_t* __restrict__ YB, const float* __restrict__ LSE, const bf16_t* __restrict__ PROJ,
                                         const float* __restrict__ wa, const float* __restrict__ wb, bf16_t* __restrict__ H) {
                    float ya[2][8], yb[2][8]; float ssa = 0.f, ssb = 0.f;
#pragma unroll
                    for (int j = 0; j < 2; ++j) { const int c = lane + 64 * j, hh = c >> 4;
                        const v4u a = *(const v4u*)(YA + (size_t)m * DA + 8 * c);
                        ya[j][0] = bflo(a.x); ya[j][1] = bfhi(a.x); ya[j][2] = bflo(a.y); ya[j][3] = bfhi(a.y); ya[j][4] = bflo(a.z); ya[j][5] = bfhi(a.z); ya[j][6] = bflo(a.w); ya[j][7] = bfhi(a.w);
                        const float l0 = LSE[((size_t)0 * M + m) * 8 + hh], l1 = LSE[((size_t)1 * M + m) * 8 + hh], l2 = LSE[((size_t)2 * M + m) * 8 + hh];
                        const float mx = fmaxf(l0, fmaxf(l1, l2)); const float e0 = __builtin_amdgcn_exp2f(l0 - mx), e1 = __builtin_amdgcn_exp2f(l1 - mx), e2 = __builtin_amdgcn_exp2f(l2 - mx);
                        const float inv = 1.0f / (e0 + e1 + e2); const float w0 = e0 * inv, w1 = e1 * inv, w2 = e2 * inv;
                        const v4u b0 = *(const v4u*)(YB + ((size_t)0 * M + m) * DB + 8 * c), b1 = *(const v4u*)(YB + ((size_t)1 * M + m) * DB + 8 * c), b2 = *(const v4u*)(YB + ((size_t)2 * M + m) * DB + 8 * c);
                        yb[j][0] = w0 * bflo(b0.x) + w1 * bflo(b1.x) + w2 * bflo(b2.x); yb[j][1] = w0 * bfhi(b0.x) + w1 * bfhi(b1.x) + w2 * bfhi(b2.x);
                        yb[j][2] = w0 * bflo(b0.y) + w1 * bflo(b1.y) + w2 * bflo(b2.y); yb[j][3] = w0 * bfhi(b0.y) + w1 * bfhi(b1.y) + w2 * bfhi(b2.y);
                        yb[j][4] = w0 * bflo(b0.z) + w1 * bflo(b1.z) + w2 * bflo(b2.z); yb[j][5] = w0 * bfhi(b0.z) + w1 * bfhi(b1.z) + w2 * bfhi(b2.z);
                        yb[j][6] = w0 * bflo(b0.w) + w1 * bflo(b1.w) + w2 * bflo(b2.w); yb[j][7] = w0 * bfhi(b0.w) + w1 * bfhi(b1.w) + w2 * bfhi(b2.w);
#pragma unroll
                        for (int i = 0; i < 8; ++i) { ssa += ya[j][i] * ya[j][i]; ssb += yb[j][i] * yb[j][i]; } }
                    const float ra = 1.0f / sqrtf(wave_sum(ssa) * (1.0f / DA) + EPS), rb = 1.0f / sqrtf(wave_sum(ssb) * (1.0f / DB) + EPS);
#pragma unroll
                    for (int j = 0; j < 2; ++j) { const int c = lane + 64 * j;
                        const v4u ga = *(const v4u*)(PROJ + ((size_t)(H_GA + (c >> 4)) * M + m) * HD + 8 * (c & 15)), gb = *(const v4u*)(PROJ + ((size_t)(H_GB + (c >> 4)) * M + m) * HD + 8 * (c & 15));
                        const float gaf[8] = {bflo(ga.x), bfhi(ga.x), bflo(ga.y), bfhi(ga.y), bflo(ga.z), bfhi(ga.z), bflo(ga.w), bfhi(ga.w)};
                        const float gbf[8] = {bflo(gb.x), bfhi(gb.x), bflo(gb.y), bfhi(gb.y), bflo(gb.z), bfhi(gb.z), bflo(gb.w), bfhi(gb.w)};
                        const f32x4 wa0 = *(const f32x4*)(wa + 8 * c), wa1 = *(const f32x4*)(wa + 8 * c + 4), wb0 = *(const f32x4*)(wb + 8 * c), wb1 = *(const f32x4*)(wb + 8 * c + 4);
                        float za[8], zb[8];
#pragma unroll
                        for (int i = 0; i < 8; ++i) { const float wai = i < 4 ? wa0[i & 3] : wa1[i & 3], wbi = i < 4 ? wb0[i & 3] : wb1[i & 3];
                            const float sa = gaf[i] / (1.0f + __expf(-gaf[i])), sb = gbf[i] / (1.0f + __expf(-gbf[i]));
                            za[i] = ya[j][i] * ra * wai * sa; zb[i] = yb[j][i] * rb * wbi * sb; }
                        v4u oa, ob; oa.x = pk2(za[0], za[1]); oa.y = pk2(za[2], za[3]); oa.z = pk2(za[4], za[5]); oa.w = pk2(za[6], za[7]);
                        ob.x = pk2(zb[0], zb[1]); ob.y = pk2(zb[2], zb[3]); ob.z = pk2(zb[4], zb[5]); ob.w = pk2(zb[6], zb[7]);
                        *(v4u*)(H + (size_t)m * DM + 8 * c) = oa; *(v4u*)(H + (size_t)m * DM + DA + 8 * c) = ob; }
}

struct Params { const float *x, *norm_w, *w_in, *qn, *kn, *ona, *onb, *w_out, *fnorm; float* out; unsigned char* ws; int ph_lo, ph_hi; };

__global__ void __launch_bounds__(512, 2) mk_fwd(Params p) {
    extern __shared__ __attribute__((aligned(16))) unsigned char lds[];
    volatile LAS unsigned* MISC = (volatile LAS unsigned*)((LAS unsigned char*)lds + MISC_OFF);
    if (threadIdx.x < 32) MISC[threadIdx.x] = 0u;
    __syncthreads();
    XcdBarrier bar = xcd_barrier_post((unsigned*)(p.ws + WS_CTL), MISC + 8);
    if (p.ph_lo == 0) {
        float* RCOS0 = (float*)(p.ws + WS_ROPE); float* RSIN0 = RCOS0 + 192 * 32;
        for (int i = blockIdx.x * 512 + threadIdx.x; i < 192 * 32; i += gridDim.x * 512) {
            const int pos = i >> 5, f = i & 31; const float pv = (float)(pos < 128 ? pos : pos - 128);
            float sn_, cs_; sincos_acc(pv * INV_FREQ[f], sn_, cs_); RCOS0[i] = cs_; RSIN0[i] = sn_;
        }
    }
    for (int ph = p.ph_lo; ph < p.ph_hi; ++ph) {
        const int tid = otid(), lane = tid & 63, wave = __builtin_amdgcn_readfirstlane(tid >> 6);
        int G = gridDim.x, bx = blockIdx.x; asm volatile("" : "+s"(G), "+s"(bx));
        const int vcu = (G % 8 == 0) ? (bx % 8) * (G / 8) + bx / 8 : bx;
        const int gw = vcu * 8 + wave, NGW = G * 8;
        size_t zoff = 0; asm volatile("" : "+s"(zoff));
        unsigned char* ws = p.ws + zoff;
        bf16_t* W1T = (bf16_t*)(ws + WS_W1T); bf16_t* W2T = (bf16_t*)(ws + WS_W2T); bf16_t* H = (bf16_t*)(ws + WS_H); bf16_t* PROJ = (bf16_t*)(ws + WS_PROJ);
        bf16_t* YA = (bf16_t*)(ws + WS_YA); bf16_t* YB = (bf16_t*)(ws + WS_YB); float* LSE = (float*)(ws + WS_LSE);
        float* RCOS = (float*)(ws + WS_ROPE); float* RSIN = RCOS + 192 * 32;
        bf16_t* XB = (bf16_t*)(ws + WS_XB); float* ROWSQ = (float*)(ws + WS_ROWSQ);
        if (ph == 0) {
            LAS float* scr = (LAS float*)((LAS unsigned char*)lds + wave * 16384);
            constexpr int I1 = (DM / 64) * (DIN / 32), I2 = (DM / 64) * (DM / 32), IL = I1 + I2;
            DUPREP(0) for (int it = gw; it < DEPTH * IL; it += NGW) {
                const int l = it / IL, r = it % IL;
                if (r < I1) p0_transpose_item(p.w_in + (size_t)l * DM * DIN, DM, DIN, W1T + (size_t)l * DIN * DM, scr, r, lane, p.norm_w + (size_t)l * DM);
                else p0_transpose_item(p.w_out + (size_t)l * DM * DM, DM, DM, W2T + (size_t)l * DM * DM, scr, r - I1, lane, nullptr);
            }
            for (int m = gw; m < M; m += NGW) {
                const f32x4* xr = (const f32x4*)(p.x + (size_t)m * DM) + lane; v2u* o8 = (v2u*)(XB + (size_t)m * DM) + lane; float sq = 0.f;
#pragma unroll
                for (int j = 0; j < 8; ++j) { const f32x4 v = xr[64 * j]; v2u w; w.x = pk2(v.x, v.y); w.y = pk2(v.z, v.w); o8[64 * j] = w;
                    const float r0 = bflo(w.x), r1 = bfhi(w.x), r2 = bflo(w.y), r3 = bfhi(w.y); sq += (r0 * r0 + r1 * r1) + (r2 * r2 + r3 * r3); }
                sq = wave_sum(sq); if (lane < 32) ROWSQ[(size_t)m * 32 + lane] = (lane == 0) ? sq : 0.f;
            }
        } else if (ph == N_PHASES - 1) {
            for (int m = gw; m < M; m += NGW) {
                f32x4* xr = (f32x4*)(p.out + (size_t)m * DM) + lane; const f32x4* wr_ = (const f32x4*)p.fnorm + lane; const v2u* xb8 = (const v2u*)(XB + (size_t)m * DM) + lane;
                const float rstd = 1.0f / sqrtf(wave_sum(lane < 32 ? ROWSQ[((size_t)DEPTH * M + m) * 32 + lane] : 0.f) * (1.0f / DM) + EPS);
#pragma unroll
                for (int j = 0; j < 8; ++j) { const v2u w = xb8[64 * j]; const f32x4 v = {bflo(w.x), bfhi(w.x), bflo(w.y), bfhi(w.y)}; xr[64 * j] = v * rstd * wr_[64 * j]; }
            }
        } else {
            const int l = (ph - 1) / 5, st = (ph - 1) % 5 + 1;
            if (st == 1) {
                pg8::Gemm g{XB, W1T + (size_t)l * DIN * DM, M, DIN, DM}; pg8::StaticOrder S; S.init(M, DIN, G, bx);
                pg8::EpiHeadMajor E{PROJ, M, ROWSQ + (size_t)l * M * 32, 1.0f / DM, EPS};
#ifndef MK_NO_G1
                DUPREP(2) pg8::gemm_phase<pg8::EpiHeadMajor, pg8::StaticOrder, PG8_ALIGN, PG8_SP2>((PG8_LAS unsigned char*)lds, g, S, E);
#endif
            } else if (st == 2) {
                const float* qg = p.qn + l * HD; const float* kg = p.kn + l * HD;
                constexpr int QKU = 4;
                for (int it0 = gw; it0 < M * 10 / 4; it0 += QKU * NGW) {
                    const int j = lane & 15, half = j >> 3, jj = j & 7, e = half * 64 + 4 * jj;
                    v2u a[QKU], b[QKU]; f32x4 cs[QKU], sn[QKU]; bf16_t* pp[QKU]; bool isq[QKU];
#pragma unroll
                    for (int u = 0; u < QKU; ++u) { const int it = min(it0 + u * NGW, M * 10 / 4 - 1);
                        const int g = it * 4 + (lane >> 4), row = g / 10, hs = g - row * 10; isq[u] = hs < 8;
                        pp[u] = PROJ + ((size_t)hs * M + row) * HD + e; a[u] = *(const v2u*)pp[u]; b[u] = *(const v2u*)(pp[u] + 32);
                        const int t = row & (T - 1), pos = half ? 128 + (t & 63) : (t >> 6);
                        cs[u] = *(const f32x4*)(RCOS + pos * 32 + 4 * jj); sn[u] = *(const f32x4*)(RSIN + pos * 32 + 4 * jj); }
                    asm volatile("" ::: "memory");
#pragma unroll
                    for (int u = 0; u < QKU; ++u) {
                        float x1[4] = {bflo(a[u].x), bfhi(a[u].x), bflo(a[u].y), bfhi(a[u].y)}, x2[4] = {bflo(b[u].x), bfhi(b[u].x), bflo(b[u].y), bfhi(b[u].y)};
                        float ss = 0.f;
#pragma unroll
                        for (int i = 0; i < 4; ++i) ss += x1[i] * x1[i] + x2[i] * x2[i];
                        ss += __shfl_xor(ss, 1); ss += __shfl_xor(ss, 2); ss += __shfl_xor(ss, 4); ss += __shfl_xor(ss, 8);
                        const float rstd = 1.0f / sqrtf(ss * (1.0f / HD) + EPS);
                        const float* gn = isq[u] ? qg : kg;
                        const float qsc = (MK_NEGM && isq[u]) ? att::SCALE * att::LOG2E : 1.0f;
                        const f32x4 g1 = *(const f32x4*)(gn + e), g2 = *(const f32x4*)(gn + e + 32);
                        float o1[4], o2[4];
#pragma unroll
                        for (int i = 0; i < 4; ++i) { const float y1 = x1[i] * rstd * g1[i], y2 = x2[i] * rstd * g2[i]; o1[i] = (y1 * cs[u][i] - y2 * sn[u][i]) * qsc; o2[i] = (y1 * sn[u][i] + y2 * cs[u][i]) * qsc; }
                        v2u w1, w2; w1.x = pk2(o1[0], o1[1]); w1.y = pk2(o1[2], o1[3]); w2.x = pk2(o2[0], o2[1]); w2.y = pk2(o2[2], o2[3]);
                        if (it0 + u * NGW < M * 10 / 4) { *(v2u*)pp[u] = w1; *(v2u*)(pp[u] + 32) = w2; }
                    }
                }
#ifndef MK_NO_DIL
                DUPREP(3) for (int u = vcu; u < 1536; u += G) {
                    const int pt = u >> 9, rem = u & 511, b = rem >> 8, h = (rem >> 5) & 7, w = rem & 31;
                    const int d = (pt == 0) ? 1 : (pt == 1) ? 4 : 16, res = w & (d - 1), blk = w / d, i0 = blk * 256, nsub = T / d;
                    const float slope = __builtin_amdgcn_exp2f(-(float)(h + 1));
                    const float nslopeC = -slope * (float)d * att::LOG2E;
                    const size_t tok0 = (size_t)b * T + res;
                    const att::bf16* Pb = (const att::bf16*)PROJ + ((size_t)h * M + tok0) * HD;
                    const long rs = (long)d * HD;
                    att::attn_body<true>(Pb + (size_t)H_QB * M * HD + (long)i0 * rs, Pb + (size_t)H_KB * M * HD, Pb + (size_t)H_VB * M * HD, rs, rs,
                                         (att::bf16*)YB + ((size_t)pt * M + tok0 + (size_t)i0 * d) * DB + h * HD, (long)d * DB,
                                         LSE + ((size_t)pt * M + tok0 + (size_t)i0 * d) * 8 + h, d * 8, i0, nsub, nslopeC, 0, (char*)lds);
                }
#endif
            } else if (st == 3) {
#ifndef MK_NO_DENSE
                DUPREP(4) for (int u = vcu; u < 512; u += G) {
                    const int combo = u >> 7, b = combo >> 1, kvh = combo & 1, h = kvh * 4 + ((u >> 5) & 3), qb = u & 31;
                    const att::bf16* Pb = (const att::bf16*)PROJ + (size_t)b * T * HD;
                    att::attn_body<false>(Pb + ((size_t)(H_QA + h) * M + qb * 256) * HD, Pb + (size_t)(H_KA + kvh) * M * HD, Pb + (size_t)(H_VA + kvh) * M * HD, HD, HD,
                                          (att::bf16*)YA + ((size_t)b * T + qb * 256) * DA + h * HD, DA, nullptr, 0, 0, 0, 0.f, T, (char*)lds);
                }
#endif
            } else if (st == 4) {
                const float* wa = p.ona + (size_t)l * DA; const float* wb = p.onb + (size_t)l * DB;
                DUPREP(5) for (int m = gw; m < M; m += 2 * NGW) {
                    gate_row(m, lane, YA, YB, LSE, PROJ, wa, wb, H);
                    if (m + NGW < M) gate_row(m + NGW, lane, YA, YB, LSE, PROJ, wa, wb, H);
                }
            } else {
                pg8::Gemm g{H, W2T + (size_t)l * DM * DM, M, DM, DM}; pg8::StaticOrder S; S.init(M, DM, G, bx);
                pg8::EpiResF32 E{XB, ROWSQ + (size_t)(l + 1) * M * 32, DM};
#ifndef MK_NO_G2
                pg8::gemm_phase<pg8::EpiResF32, pg8::StaticOrder, PG8_ALIGN, PG8_SP2>((PG8_LAS unsigned char*)lds, g, S, E);
#endif
            }
        }
        if (ph + 1 < p.ph_hi) { if (p.ph_hi > 4096) cg::this_grid().sync(); else xcd_barrier(bar); if (MK_DUP & 64) xcd_barrier(bar); }
    }
}

extern "C" void kernel_launch(void* const* d_in, const int* in_sizes, int n_in, void* d_out, int out_size, void* d_ws, size_t ws_size, hipStream_t stream) {
    static int grid = 0;
    if (grid == 0) {
        if (n_in != 9 || in_sizes[0] != M * DM || out_size != M * DM || ws_size < WS_END) { fprintf(stderr, "kernel_launch: unexpected shapes (n_in %d, ws %zu)\n", n_in, ws_size); grid = -1; return; }
        int dev = 0, cus = 0, per_cu = 0;
        hipGetDevice(&dev); hipDeviceGetAttribute(&cus, hipDeviceAttributeMultiprocessorCount, dev);
        if (hipFuncSetAttribute((const void*)mk_fwd, hipFuncAttributeMaxDynamicSharedMemorySize, LDS_BYTES) != hipSuccess) { fprintf(stderr, "kernel_launch: hipFuncSetAttribute failed\n"); grid = -1; return; }
        if (hipOccupancyMaxActiveBlocksPerMultiprocessor(&per_cu, (const void*)mk_fwd, 512, LDS_BYTES) != hipSuccess || per_cu < 1) per_cu = 1;
        (void)hipGetLastError();
        grid = cus * per_cu;
    }
    if (grid < 0) return;
    Params p{};
    p.x = (const float*)d_in[0]; p.norm_w = (const float*)d_in[1]; p.w_in = (const float*)d_in[2]; p.qn = (const float*)d_in[3]; p.kn = (const float*)d_in[4];
    p.ona = (const float*)d_in[5]; p.onb = (const float*)d_in[6]; p.w_out = (const float*)d_in[7]; p.fnorm = (const float*)d_in[8];
    p.out = (float*)d_out; p.ws = (unsigned char*)d_ws;
    if (hipMemsetAsync((char*)d_ws + WS_CTL, 0, CTL_BYTES, stream) != hipSuccess) { fprintf(stderr, "kernel_launch: memset failed\n"); return; }
#if MK_ONE_LAUNCH
    p.ph_lo = 0; p.ph_hi = N_PHASES;
    void* args[] = {&p};
    hipError_t e = hipLaunchCooperativeKernel((const void*)mk_fwd, dim3(grid), dim3(512), args, LDS_BYTES, stream);
    if (e != hipSuccess) fprintf(stderr, "kernel_launch: cooperative launch failed: %s (grid %d)\n", hipGetErrorString(e), grid);
#else
    for (int ph = 0; ph < N_PHASES; ++ph) { p.ph_lo = ph; p.ph_hi = ph + 1; hipLaunchKernelGGL(mk_fwd, dim3(grid), dim3(512), LDS_BYTES, stream, p); }
#endif
}
```

```cpp
#include <hip/hip_runtime.h>
#include <hip/hip_bf16.h>
#include <hip/hip_cooperative_groups.h>
#include <cstdio>
#include <cstdint>
namespace cg = cooperative_groups;

#ifndef MK_DUP
#define MK_DUP 0
#endif
#define DUPREP(k) for (int rep_ = 0; rep_ < 1 + ((MK_DUP >> (k)) & 1); ++rep_)
#ifndef MK_PVPIPE
#define MK_PVPIPE 1
#endif
#ifndef MK_SGB
#define MK_SGB 0
#endif
#ifndef MK_PP
#define MK_PP 1
#endif
#ifndef MK_PROBE_V
#define MK_PROBE_V 0
#endif
#ifndef MK_NEGM
#define MK_NEGM 1
#endif
#ifndef MK_ONE_LAUNCH
#define MK_ONE_LAUNCH 1
#endif
static_assert(!MK_NEGM || MK_PP, "MK_NEGM pre-scales q for the ping-pong dense body only");

constexpr int BATCH = 2, T = 8192, DM = 2048, DEPTH = 4, HD = 128, DA = 1024, DB = 1024, DIN = 6656, M = BATCH * T;
constexpr int C_QA = 0, C_KA = 1024, C_VA = 1280, C_GA = 1536, C_QB = 2560, C_KB = 3584, C_VB = 4608, C_GB = 5632;
constexpr int H_QA = 0, H_KA = 8, H_VA = 10, H_GA = 12, H_QB = 20, H_KB = 28, H_VB = 36, H_GB = 44;
constexpr float EPS = 1e-6f;
__device__ __forceinline__ int otid() { int t = threadIdx.x; asm volatile("" : "+v"(t)); return t; }

namespace pg8 {
#define PG8_LAS __attribute__((address_space(3)))
typedef unsigned short bf16_t;
typedef short bf16x8 __attribute__((ext_vector_type(8)));
typedef float f32x4 __attribute__((ext_vector_type(4)));
typedef unsigned u32x4 __attribute__((ext_vector_type(4)));
constexpr int BM = 256, BK = 64, HALF = 128, HTB = HALF * BK * 2  , STAGE_BYTES = 8 * HTB, NXCD = 8, WGM = 8;

__host__ __device__ __forceinline__ int lds_byte(int r, int c) { const int st = (r >> 4) * 2 + (c >> 5), rr = r & 15, cc = c & 31, ob = rr * 64 + cc * 2; return st * 1024 + (ob ^ (((ob >> 9) & 1) << 5)); }
__host__ __device__ __forceinline__ void stage_rc(int b, int& R, int& C) { const int st = b / 1024, sb = b % 1024, swz = sb ^ (((sb >> 9) & 1) << 5); R = (st >> 1) * 16 + swz / 64; C = (st & 1) * 32 + (swz % 64) / 2; }
__host__ __device__ __forceinline__ int perm32(int rho) { const int n = rho >> 4, i = rho & 15; return 8 * (i >> 2) + 4 * n + (i & 3); }

struct Unit { int pm, pn; };
struct Gemm { const bf16_t* A; const bf16_t* Bt; int M, N, K; };

struct StaticOrder {
    int nM, nN, nwg, G, c;
    __host__ __device__ void init(int M, int N, int G_, int c_) { nM = M / BM; nN = N / BM; nwg = nM * nN; G = G_; c = c_; }
    __host__ __device__ bool next(int i, Unit& u) const {
        const long L = (long)i * G + c; if (L >= nwg) return false;
        int wgid = (int)L; { const int q = nwg / NXCD, r = nwg % NXCD, xcd = wgid % NXCD, off = wgid / NXCD; wgid = (xcd < r ? xcd * (q + 1) : r * (q + 1) + (xcd - r) * q) + off; }
        const int nig = WGM * nN, gid = wgid / nig, fm = gid * WGM, gsz = (nM - fm) < WGM ? (nM - fm) : WGM;
        u.pm = fm + ((wgid % nig) % gsz); u.pn = (wgid % nig) / gsz; return true;
    }
    __device__ __forceinline__ void a_ready(const Unit&) const {}
    __device__ __forceinline__ void done(const Unit&) const {}
};

__device__ __forceinline__ unsigned cvt_pk_bf16(float lo, float hi) { unsigned r; asm volatile("v_cvt_pk_bf16_f32 %0, %1, %2" : "=v"(r) : "v"(lo), "v"(hi)); return r; }
typedef float f32x2 __attribute__((ext_vector_type(2)));
__device__ __forceinline__ f32x2 gelu_pk(f32x2 v) {
    const f32x2 av = __builtin_elementwise_abs(v), d = av * 0.2316418882f + 1.0f;
    f32x2 t; t.x = __builtin_amdgcn_rcpf(d.x); t.y = __builtin_amdgcn_rcpf(d.y);
    f32x2 q = t * 0.5307027145f + (-0.7265760135f); q = q * t + 0.7107068705f; q = q * t + (-0.142248368f); q = q * t + 0.127414796f; q = q * t;
    const f32x2 s = (v * v) * (-0.72134752044f);
    f32x2 e; e.x = __builtin_amdgcn_exp2f(s.x); e.y = __builtin_amdgcn_exp2f(s.y);
    const f32x2 m = v * (q * e), r = v - m;
    f32x2 o; o.x = v.x < 0.f ? m.x : r.x; o.y = v.y < 0.f ? m.y : r.y; return o;
}

template <int ACT  > struct EpiBf16 {
    static constexpr bool PERM = true, AFTER_DRAIN = false; static_assert(ACT == 0 || ACT == 1, "EpiBf16: ACT is 0 (none) or 1 (gelu_pk)");
    bf16_t* O; int ldc; const float* bias; int split_cols; size_t split_stride; float scale0;
    __device__ __forceinline__ void operator()(const f32x4 (&acc)[2][2][4][2], const Unit& u, int wr, int wc, int fr, int fq) const {
        const int row0 = u.pm * BM + wr * 64 + fr; int colt = u.pn * BM; bf16_t* base = O;
        float sc = 1.f; if (split_cols) { const int t = colt / split_cols; base += (size_t)t * split_stride; colt -= t * split_cols; if (t == 0) sc = scale0; }
        const int col0 = colt + wc * 32 + 8 * fq, bcol0 = u.pn * BM + wc * 32 + 8 * fq;
        f32x4 bv[2][2];
#pragma unroll
        for (int bj = 0; bj < 2; ++bj)
#pragma unroll
            for (int n = 0; n < 2; ++n) bv[bj][n] = bias ? *(const f32x4*)(bias + bcol0 + bj * HALF + 4 * n) : (f32x4){0.f, 0.f, 0.f, 0.f};
#pragma unroll
        for (int ai = 0; ai < 2; ++ai)
#pragma unroll
            for (int m = 0; m < 4; ++m) { bf16_t* rowp = base + (size_t)(row0 + ai * HALF + m * 16) * ldc + col0;
#pragma unroll
                for (int bj = 0; bj < 2; ++bj) { f32x4 v0 = acc[ai][bj][m][0] + bv[bj][0], v1 = acc[ai][bj][m][1] + bv[bj][1];
                    if (ACT == 1) { f32x2 a = gelu_pk((f32x2){v0[0], v0[1]}), b = gelu_pk((f32x2){v0[2], v0[3]}), c = gelu_pk((f32x2){v1[0], v1[1]}), d = gelu_pk((f32x2){v1[2], v1[3]});
                        v0 = (f32x4){a.x, a.y, b.x, b.y}; v1 = (f32x4){c.x, c.y, d.x, d.y}; }
                    v0 = v0 * sc; v1 = v1 * sc; u32x4 w; w.x = cvt_pk_bf16(v0[0], v0[1]); w.y = cvt_pk_bf16(v0[2], v0[3]); w.z = cvt_pk_bf16(v1[0], v1[1]); w.w = cvt_pk_bf16(v1[2], v1[3]);
                    *(u32x4*)(rowp + bj * HALF) = w; } }
    }
};
struct EpiHeadMajor {
    static constexpr bool PERM = true, AFTER_DRAIN = false;
    bf16_t* O; int Mrows; const float* rowsq; float inv_k, eps;
    __device__ __forceinline__ void operator()(const f32x4 (&acc)[2][2][4][2], const Unit& u, int wr, int wc, int fr, int fq) const {
        const int row0 = u.pm * BM + wr * 64 + fr, col0 = wc * 32 + 8 * fq;
#pragma unroll
        for (int ai = 0; ai < 2; ++ai) {
            f32x4 pa[4], pb[4];
#pragma unroll
            for (int m = 0; m < 4; ++m) { const f32x4* pp = (const f32x4*)(rowsq + (size_t)(row0 + ai * HALF + m * 16) * 32 + 8 * fq); pa[m] = pp[0]; pb[m] = pp[1]; }
#pragma unroll
            for (int m = 0; m < 4; ++m) { const int row = row0 + ai * HALF + m * 16; const f32x4 a = pa[m], b = pb[m];
                float sq = ((a[0] + a[1]) + (a[2] + a[3])) + ((b[0] + b[1]) + (b[2] + b[3])); sq += __shfl_xor(sq, 16); sq += __shfl_xor(sq, 32);
                const float rs = 1.0f / sqrtf(sq * inv_k + eps);
#pragma unroll
                for (int bj = 0; bj < 2; ++bj) { const f32x4 v0 = acc[ai][bj][m][0] * rs, v1 = acc[ai][bj][m][1] * rs;
                    u32x4 w; w.x = cvt_pk_bf16(v0[0], v0[1]); w.y = cvt_pk_bf16(v0[2], v0[3]); w.z = cvt_pk_bf16(v1[0], v1[1]); w.w = cvt_pk_bf16(v1[2], v1[3]);
                    *(u32x4*)(O + ((size_t)(u.pn * 2 + bj) * Mrows + row) * HALF + col0) = w; } }
            asm volatile("" ::: "memory"); }
    }
};
struct EpiResF32 {
    static constexpr bool PERM = true, AFTER_DRAIN = false;
    bf16_t* xb; float* rowsq; int ldc;
    __device__ __forceinline__ void operator()(const f32x4 (&acc)[2][2][4][2], const Unit& u, int wr, int wc, int fr, int fq) const {
        const int col0 = u.pn * BM + wc * 32 + 8 * fq;
#pragma unroll
        for (int ai = 0; ai < 2; ++ai) {
            u32x4 pre[4][2];
#pragma unroll
            for (int m = 0; m < 4; ++m) { const size_t off = (size_t)(u.pm * BM + ai * HALF + wr * 64 + m * 16 + fr) * ldc + col0;
#pragma unroll
                for (int bj = 0; bj < 2; ++bj) pre[m][bj] = *(const u32x4*)(xb + off + bj * HALF); }
            asm volatile("" ::: "memory");
#pragma unroll
            for (int m = 0; m < 4; ++m) { const int row = u.pm * BM + ai * HALF + wr * 64 + m * 16 + fr; const size_t off = (size_t)row * ldc + col0; float ss = 0.f;
#pragma unroll
                for (int bj = 0; bj < 2; ++bj) { const u32x4 pb = pre[m][bj]; const f32x4 a0 = acc[ai][bj][m][0], a1 = acc[ai][bj][m][1];
                    u32x4 w; w.x = cvt_pk_bf16(__uint_as_float(pb.x << 16) + a0[0], __uint_as_float(pb.x & 0xffff0000u) + a0[1]); w.y = cvt_pk_bf16(__uint_as_float(pb.y << 16) + a0[2], __uint_as_float(pb.y & 0xffff0000u) + a0[3]);
                    w.z = cvt_pk_bf16(__uint_as_float(pb.z << 16) + a1[0], __uint_as_float(pb.z & 0xffff0000u) + a1[1]); w.w = cvt_pk_bf16(__uint_as_float(pb.w << 16) + a1[2], __uint_as_float(pb.w & 0xffff0000u) + a1[3]);
#pragma unroll
                    for (int q = 0; q < 4; ++q) { const float r0 = __uint_as_float(w[q] << 16), r1 = __uint_as_float(w[q] & 0xffff0000u); ss += r0 * r0 + r1 * r1; }
                    *(u32x4*)(xb + off + bj * HALF) = w; }
                ss += __shfl_xor(ss, 16); ss += __shfl_xor(ss, 32);
                if (fq == 0) rowsq[(size_t)row * 32 + u.pn * 4 + wc] = ss; }
            asm volatile("" ::: "memory"); }
    }
};


template <class Epi, class Sched, bool ALIGN_EPI = false, bool SP2 = false>
__device__ __forceinline__ void gemm_phase(PG8_LAS unsigned char* lds, const Gemm g, const Sched& S, const Epi& E) {
    const int tid = otid(), wid = __builtin_amdgcn_readfirstlane(tid >> 6), lane = tid & 63, wr = wid >> 2, wc = wid & 3, fr = lane & 15, fq = lane >> 4;
    const int K = g.K, nt = K / BK;
    unsigned voffA[2], voffB[2];
#pragma unroll
    for (int i = 0; i < 2; ++i) { int R, C; stage_rc(tid * 16 + i * 8192, R, C); const int Rb = Epi::PERM ? ((R & ~31) + perm32(R & 31)) : R;
        voffA[i] = (unsigned)(R * K + C) * 2u; voffB[i] = (unsigned)(Rb * K + C) * 2u; }
    const size_t kstep = (size_t)(BK * 2);
    const size_t hstep = (size_t)HALF * K * 2;
    const size_t tstep = 2 * hstep;
    const unsigned ldsw = (unsigned)wid * 1024u;
    const int aoff = lds_byte(wr * 64 + fr, fq * 8), boff = lds_byte(wc * 32 + fr, fq * 8);
#define PG8_SA(b, h) (((b) * 2 + (h)) * HTB)
#define PG8_SB(b, h) ((4 + (b) * 2 + (h)) * HTB)
#define PG8_STAGE(bufoff, gbase, voff) do { _Pragma("unroll") for (int _i = 0; _i < 2; ++_i) \
        __builtin_amdgcn_global_load_lds((const unsigned*)((const char*)(gbase) + (voff)[_i]), (PG8_LAS unsigned*)(lds + (bufoff) + ldsw + _i * 8192), 16, 0, 0); } while (0)
#define PG8_LDA(dst, b, h) do { _Pragma("unroll") for (int m = 0; m < 4; ++m) _Pragma("unroll") for (int k = 0; k < 2; ++k) dst[m][k] = *(const PG8_LAS bf16x8*)(lds + PG8_SA(b, h) + aoff + m * 2048 + k * 1024); } while (0)
#define PG8_LDB(dst, b, h) do { _Pragma("unroll") for (int n = 0; n < 2; ++n) _Pragma("unroll") for (int k = 0; k < 2; ++k) dst[n][k] = *(const PG8_LAS bf16x8*)(lds + PG8_SB(b, h) + boff + n * 2048 + k * 1024); } while (0)
#define PG8_MMA(ai, bj, At, Bt) do { __builtin_amdgcn_s_setprio(1); _Pragma("unroll") for (int m = 0; m < 4; ++m) _Pragma("unroll") for (int n = 0; n < 2; ++n) _Pragma("unroll") for (int k = 0; k < 2; ++k) \
        acc[ai][bj][m][n] = __builtin_amdgcn_mfma_f32_16x16x32_bf16(Bt[n][k], At[m][k], acc[ai][bj][m][n], 0, 0, 0); __builtin_amdgcn_s_setprio(0); } while (0)
#define PG8_WAIT_V(n) asm volatile("s_waitcnt vmcnt(" #n ")" ::: "memory")
#define PG8_WAIT_L(n) asm volatile("s_waitcnt lgkmcnt(" #n ")" ::: "memory")
#define PG8_BAR __builtin_amdgcn_s_barrier()
#define PG8_SCHED __builtin_amdgcn_sched_barrier(0)
    Unit cur, nxt; int ui = 0;
    if (!S.next(0, cur)) return;
    f32x4 acc[2][2][4][2];
#pragma unroll
    for (int a = 0; a < 2; ++a)
#pragma unroll
        for (int b = 0; b < 2; ++b)
#pragma unroll
            for (int m = 0; m < 4; ++m)
#pragma unroll
                for (int n = 0; n < 2; ++n) acc[a][b][m][n] = (f32x4){0.f, 0.f, 0.f, 0.f};
    bf16x8 At[4][2], B0[2][2], B1[2][2];
    const char* cA = (const char*)g.A + (size_t)cur.pm * tstep; const char* cB = (const char*)g.Bt + (size_t)cur.pn * tstep;
    S.a_ready(cur);
    if constexpr (SP2) {
        PG8_STAGE(PG8_SB(0, 0), cB, voffB); PG8_STAGE(PG8_SB(0, 1), cB + hstep, voffB); PG8_STAGE(PG8_SA(0, 0), cA, voffA); PG8_STAGE(PG8_SA(0, 1), cA + hstep, voffA);
        if (wr == 1) PG8_BAR;
        PG8_WAIT_V(2); PG8_BAR;
        PG8_STAGE(PG8_SB(1, 0), cB + kstep, voffB); PG8_STAGE(PG8_SA(1, 0), cA + kstep, voffA); PG8_STAGE(PG8_SB(1, 1), cB + hstep + kstep, voffB);
        PG8_WAIT_V(6); PG8_BAR;
    } else {
        PG8_STAGE(PG8_SB(0, 0), cB, voffB); PG8_STAGE(PG8_SA(0, 0), cA, voffA); PG8_STAGE(PG8_SB(0, 1), cB + hstep, voffB); PG8_STAGE(PG8_SA(0, 1), cA + hstep, voffA);
        if (wr == 1) PG8_BAR;
        PG8_WAIT_V(4); PG8_BAR;
        PG8_STAGE(PG8_SB(1, 0), cB + kstep, voffB); PG8_STAGE(PG8_SA(1, 0), cA + kstep, voffA); PG8_STAGE(PG8_SB(1, 1), cB + hstep + kstep, voffB);
        PG8_WAIT_V(6); PG8_BAR;
    }
    for (;;) {
        const bool has_next = S.next(ui + 1, nxt);
        const char* nA = has_next ? (const char*)g.A + (size_t)nxt.pm * tstep : cA; const char* nB = has_next ? (const char*)g.Bt + (size_t)nxt.pn * tstep : cB;
        for (int t = 0; t < nt; t += 2) {
            const bool last = (t == nt - 2);
            const char* a1 = cA + (size_t)(t + 1) * kstep;
            const char* a2 = last ? nA : cA + (size_t)(t + 2) * kstep; const char* b2 = last ? nB : cB + (size_t)(t + 2) * kstep;
            const char* a3 = a2 + kstep; const char* b3 = b2 + kstep;
            if (last && has_next) S.a_ready(nxt);
            if constexpr (SP2) {
            PG8_LDB(B0, 0, 0); PG8_LDB(B1, 0, 1); PG8_SCHED; PG8_LDA(At, 0, 0); PG8_STAGE(PG8_SA(1, 1), a1 + hstep, voffA);
            PG8_WAIT_V(8); PG8_WAIT_L(0); PG8_BAR; PG8_MMA(0, 0, At, B0); PG8_MMA(0, 1, At, B1); PG8_BAR; PG8_SCHED;
            PG8_LDA(At, 0, 1); PG8_STAGE(PG8_SB(0, 0), b2, voffB); PG8_STAGE(PG8_SB(0, 1), b2 + hstep, voffB); PG8_STAGE(PG8_SA(0, 0), a2, voffA);
            PG8_WAIT_V(8); PG8_WAIT_L(0); PG8_BAR; PG8_MMA(1, 0, At, B0); PG8_MMA(1, 1, At, B1); PG8_BAR; PG8_SCHED;
            PG8_LDB(B0, 1, 0); PG8_LDB(B1, 1, 1); PG8_SCHED; PG8_LDA(At, 1, 0); PG8_STAGE(PG8_SA(0, 1), a2 + hstep, voffA);
            PG8_WAIT_V(8); PG8_WAIT_L(0); PG8_BAR; PG8_MMA(0, 0, At, B0); PG8_MMA(0, 1, At, B1); PG8_BAR; PG8_SCHED;
            PG8_LDA(At, 1, 1); PG8_STAGE(PG8_SB(1, 0), b3, voffB); PG8_STAGE(PG8_SB(1, 1), b3 + hstep, voffB); PG8_STAGE(PG8_SA(1, 0), a3, voffA);
            PG8_WAIT_V(8); PG8_WAIT_L(0); PG8_BAR; PG8_MMA(1, 0, At, B0); PG8_MMA(1, 1, At, B1); PG8_BAR; PG8_SCHED;
            } else {
            PG8_LDB(B0, 0, 0); PG8_SCHED; PG8_LDA(At, 0, 0); PG8_STAGE(PG8_SA(1, 1), a1 + hstep, voffA);
            PG8_WAIT_L(8); PG8_BAR; PG8_WAIT_L(0); PG8_MMA(0, 0, At, B0); PG8_BAR; PG8_SCHED;
            PG8_LDB(B1, 0, 1); PG8_STAGE(PG8_SB(0, 0), b2, voffB);
            PG8_BAR; PG8_WAIT_L(0); PG8_MMA(0, 1, At, B1); PG8_BAR;
            PG8_LDA(At, 0, 1); PG8_STAGE(PG8_SA(0, 0), a2, voffA);
            PG8_BAR; PG8_WAIT_L(0); PG8_MMA(1, 0, At, B0); PG8_BAR; PG8_SCHED;
            PG8_STAGE(PG8_SB(0, 1), b2 + hstep, voffB);
            PG8_WAIT_V(6); PG8_BAR; PG8_MMA(1, 1, At, B1); PG8_BAR;
            PG8_LDB(B0, 1, 0); PG8_SCHED; PG8_LDA(At, 1, 0); PG8_STAGE(PG8_SA(0, 1), a2 + hstep, voffA);
            PG8_WAIT_L(8); PG8_BAR; PG8_WAIT_L(0); PG8_MMA(0, 0, At, B0); PG8_BAR; PG8_SCHED;
            PG8_LDB(B1, 1, 1); PG8_STAGE(PG8_SB(1, 0), b3, voffB);
            PG8_BAR; PG8_WAIT_L(0); PG8_MMA(0, 1, At, B1); PG8_BAR;
            PG8_LDA(At, 1, 1); PG8_STAGE(PG8_SA(1, 0), a3, voffA);
            PG8_BAR; PG8_WAIT_L(0); PG8_MMA(1, 0, At, B0); PG8_BAR; PG8_SCHED;
            PG8_STAGE(PG8_SB(1, 1), b3 + hstep, voffB);
            PG8_WAIT_V(6); PG8_BAR; PG8_MMA(1, 1, At, B1); PG8_BAR;
            }
        }
        if constexpr (ALIGN_EPI) { if (wr == 0) PG8_BAR; }
        if constexpr (!Epi::AFTER_DRAIN) { E(acc, cur, wr, wc, fr, fq); S.done(cur); }
        if (!has_next) break;
#pragma unroll
        for (int a = 0; a < 2; ++a)
#pragma unroll
            for (int b = 0; b < 2; ++b)
#pragma unroll
                for (int m = 0; m < 4; ++m)
#pragma unroll
                    for (int n = 0; n < 2; ++n) acc[a][b][m][n] = (f32x4){0.f, 0.f, 0.f, 0.f};
        cur = nxt; cA = nA; cB = nB; ++ui;
        if constexpr (ALIGN_EPI) { if (wr == 1) PG8_BAR; }
    }
    PG8_WAIT_V(0);
    if constexpr (!ALIGN_EPI) { if (wr == 0) PG8_BAR; }
    PG8_BAR;
    if constexpr (Epi::AFTER_DRAIN) { E.fused(acc, cur, wr, wc, fr, fq, lds, wid, lane); S.done(cur); }
#undef PG8_SA
#undef PG8_SB
#undef PG8_STAGE
#undef PG8_LDA
#undef PG8_LDB
#undef PG8_MMA
#undef PG8_WAIT_V
#undef PG8_WAIT_L
#undef PG8_BAR
#undef PG8_SCHED
}
}
#define PG8_SP2 true
#define PG8_ALIGN true
namespace att {
using bf16 = __hip_bfloat16;
constexpr int D = 128, NW = 8, QBLK = 32, KVBLK = 64;
constexpr float SCALE = 0.088388347648318440f;
constexpr float THR = 8.f;
constexpr size_t SHM_V = KVBLK * D * 2, SHM_K = KVBLK * D * 2, SHM_ATTN = 2 * SHM_V + 2 * SHM_K + NW * 64 * 4;
using bf16x8 = __attribute__((ext_vector_type(8))) short;
using s16x4  = __attribute__((ext_vector_type(4))) short;
using f32x16 = __attribute__((ext_vector_type(16))) float;
using f32x8  = __attribute__((ext_vector_type(8))) float;
using u32x4  = __attribute__((ext_vector_type(4))) unsigned;
#define KSWZ(row, colB) ((row) * 256 + ((colB) ^ (((row) & 7) << 4)))
#define SBAR() __builtin_amdgcn_sched_barrier(0)
__device__ __forceinline__ int crow(int r, int hi) { return (r & 3) + 8 * (r >> 2) + 4 * hi; }
__device__ __forceinline__ unsigned cvtpk(float lo, float hi) {
  unsigned r; asm("v_cvt_pk_bf16_f32 %0, %1, %2" : "=v"(r) : "v"(lo), "v"(hi)); return r;
}
template <typename TIn> struct Stage;
template <> struct Stage<bf16>  { using T = bf16x8;
  __device__ static __forceinline__ T ld8(const bf16* p) { return *reinterpret_cast<const bf16x8*>(p); }
  __device__ static __forceinline__ bf16x8 tobf(T x) { return x; } };
template <> struct Stage<float> { using T = f32x8;
  __device__ static __forceinline__ T ld8(const float* p) { return *reinterpret_cast<const f32x8*>(p); }
  __device__ static __forceinline__ bf16x8 tobf(T x) {
    u32x4 w = {cvtpk(x[0], x[1]), cvtpk(x[2], x[3]), cvtpk(x[4], x[5]), cvtpk(x[6], x[7])}; return *reinterpret_cast<bf16x8*>(&w); } };

__device__ __forceinline__ void partialSM(f32x16& p0, f32x16& p1, float& m_reg, float& mn, float& alpha) {
  constexpr float C = SCALE * 1.4426950408889634f;
  float pmax = p0[0]; for (int r = 1; r < 16; ++r) pmax = fmaxf(pmax, p0[r]); for (int r = 0; r < 16; ++r) pmax = fmaxf(pmax, p1[r]);
  { auto rr = __builtin_amdgcn_permlane32_swap(__float_as_uint(pmax), __float_as_uint(pmax), false, false);
    pmax = fmaxf(__uint_as_float(rr[0]), __uint_as_float(rr[1])); }
  if (__builtin_expect(__all(pmax - m_reg <= THR / SCALE), 1)) { mn = m_reg; alpha = 1.f; }
  else { mn = fmaxf(m_reg, pmax); alpha = __builtin_amdgcn_exp2f((m_reg - mn) * C); m_reg = mn; }
  float mnC = -mn * C;
  for (int r = 0; r < 16; ++r) p0[r] = fmaf(p0[r], C, mnC); for (int r = 0; r < 16; ++r) p1[r] = fmaf(p1[r], C, mnC);
  for (int r = 0; r < 16; ++r) p0[r] = __builtin_amdgcn_exp2f(p0[r]);
}
__device__ __forceinline__ void finishSM(f32x16& p0, f32x16& p1, float alpha, float& l_reg, bf16x8& pa0, bf16x8& pa1, bf16x8& pa2, bf16x8& pa3) {
  for (int r = 0; r < 16; ++r) p1[r] = __builtin_amdgcn_exp2f(p1[r]);
  float ps = 0; for (int r = 0; r < 16; ++r) ps += p0[r]; for (int r = 0; r < 16; ++r) ps += p1[r];
  { auto rr = __builtin_amdgcn_permlane32_swap(__float_as_uint(ps), __float_as_uint(ps), false, false);
    ps = __uint_as_float(rr[0]) + __uint_as_float(rr[1]); }
  l_reg = l_reg * alpha + ps;
#define PK4(P, BASE, OUT) do { unsigned a0 = cvtpk(P[BASE + 0], P[BASE + 1]), a1 = cvtpk(P[BASE + 2], P[BASE + 3]);   \
    unsigned b0 = cvtpk(P[BASE + 4], P[BASE + 5]), b1 = cvtpk(P[BASE + 6], P[BASE + 7]);                              \
    auto r0 = __builtin_amdgcn_permlane32_swap(a0, b0, false, false); auto r1 = __builtin_amdgcn_permlane32_swap(a1, b1, false, false); \
    u32x4 w = {r0[0], r1[0], r0[1], r1[1]}; OUT = *reinterpret_cast<bf16x8*>(&w); } while (0)
  PK4(p0, 0, pa0); PK4(p0, 8, pa1); PK4(p1, 0, pa2); PK4(p1, 8, pa3);
#undef PK4
}
__device__ __forceinline__ void qkt(f32x16& p0, f32x16& p1, const bf16* Ks, const bf16x8* qr, int r32, int hi) {
  p0 = f32x16{}; p1 = f32x16{};
  for (int d0 = 0; d0 < 8; ++d0) { int cb = (d0 * 16 + hi * 8) * 2;
    bf16x8 b0 = *reinterpret_cast<const bf16x8*>((const char*)Ks + KSWZ(r32, cb));
    bf16x8 b1 = *reinterpret_cast<const bf16x8*>((const char*)Ks + KSWZ(32 + r32, cb));
    p0 = __builtin_amdgcn_mfma_f32_32x32x16_bf16(b0, qr[d0], p0, 0, 0, 0);
    p1 = __builtin_amdgcn_mfma_f32_32x32x16_bf16(b1, qr[d0], p1, 0, 0, 0); }
}
__device__ __forceinline__ int v_st(int k, int c) { const int kk = (k & ~0xC) | ((k & 4) << 1) | ((k & 8) >> 1); return ((kk >> 3) * 4 + (c >> 5)) * 512 + ((kk & 7) * 32 + (c & 31)) * 2; }
__device__ __forceinline__ int v_rd_base(int lane) { return ((lane & 3) << 3) | (((lane >> 2) & 3) << 6) | (((lane >> 4) & 1) << 5) | (((lane >> 5) & 1) << 8); }
constexpr int v_rd_off(int d0, int ks, int half) { return d0 * 512 + ks * 4096 + half * 2048; }
template <int OFF> __device__ __forceinline__ s16x4 tr_read(int vb) {
  s16x4 r; asm volatile("ds_read_b64_tr_b16 %0, %1 offset:%2" : "=&v"(r) : "v"(vb), "i"(OFF) : "memory"); return r;
}
template <int D0> __device__ __forceinline__ void pv_one(f32x16& od, int vb, bf16x8 pa0, bf16x8 pa1, bf16x8 pa2, bf16x8 pa3) {
  const s16x4 l0 = tr_read<v_rd_off(D0, 0, 0)>(vb), h0 = tr_read<v_rd_off(D0, 0, 1)>(vb), l1 = tr_read<v_rd_off(D0, 1, 0)>(vb), h1 = tr_read<v_rd_off(D0, 1, 1)>(vb);
  const s16x4 l2 = tr_read<v_rd_off(D0, 2, 0)>(vb), h2 = tr_read<v_rd_off(D0, 2, 1)>(vb), l3 = tr_read<v_rd_off(D0, 3, 0)>(vb), h3 = tr_read<v_rd_off(D0, 3, 1)>(vb);
  asm volatile("s_waitcnt lgkmcnt(0)" ::: "memory"); SBAR();
#define PK(L, H) (bf16x8){L[0], L[1], L[2], L[3], H[0], H[1], H[2], H[3]}
  od = __builtin_amdgcn_mfma_f32_32x32x16_bf16(pa0, PK(l0, h0), od, 0, 0, 0);
  od = __builtin_amdgcn_mfma_f32_32x32x16_bf16(pa1, PK(l1, h1), od, 0, 0, 0);
  od = __builtin_amdgcn_mfma_f32_32x32x16_bf16(pa2, PK(l2, h2), od, 0, 0, 0);
  od = __builtin_amdgcn_mfma_f32_32x32x16_bf16(pa3, PK(l3, h3), od, 0, 0, 0);
#undef PK
}
struct VFrag { s16x4 l0, h0, l1, h1, l2, h2, l3, h3; };
template <int D0> __device__ __forceinline__ void pv_rd(VFrag& f, int vb) {
  f.l0 = tr_read<v_rd_off(D0, 0, 0)>(vb); f.h0 = tr_read<v_rd_off(D0, 0, 1)>(vb); f.l1 = tr_read<v_rd_off(D0, 1, 0)>(vb); f.h1 = tr_read<v_rd_off(D0, 1, 1)>(vb);
  f.l2 = tr_read<v_rd_off(D0, 2, 0)>(vb); f.h2 = tr_read<v_rd_off(D0, 2, 1)>(vb); f.l3 = tr_read<v_rd_off(D0, 3, 0)>(vb); f.h3 = tr_read<v_rd_off(D0, 3, 1)>(vb);
}
__device__ __forceinline__ void pv_mm(f32x16& od, const VFrag& f, bf16x8 pa0, bf16x8 pa1, bf16x8 pa2, bf16x8 pa3) {
#define PK(L, H) (bf16x8){L[0], L[1], L[2], L[3], H[0], H[1], H[2], H[3]}
  od = __builtin_amdgcn_mfma_f32_32x32x16_bf16(pa0, PK(f.l0, f.h0), od, 0, 0, 0);
  od = __builtin_amdgcn_mfma_f32_32x32x16_bf16(pa1, PK(f.l1, f.h1), od, 0, 0, 0);
  od = __builtin_amdgcn_mfma_f32_32x32x16_bf16(pa2, PK(f.l2, f.h2), od, 0, 0, 0);
  od = __builtin_amdgcn_mfma_f32_32x32x16_bf16(pa3, PK(f.l3, f.h3), od, 0, 0, 0);
#undef PK
}
#define PV_WAIT(n) do { asm volatile("s_waitcnt lgkmcnt(" #n ")" ::: "memory"); SBAR(); } while (0)
__device__ __forceinline__ void pv_d0(f32x16* o, int vb, bf16x8 pa0, bf16x8 pa1, bf16x8 pa2, bf16x8 pa3) {
#if MK_PVPIPE
  VFrag fa, fb;
  pv_rd<0>(fa, vb); pv_rd<1>(fb, vb);
  PV_WAIT(8); pv_mm(o[0], fa, pa0, pa1, pa2, pa3); SBAR();
  pv_rd<2>(fa, vb);
  PV_WAIT(8); pv_mm(o[1], fb, pa0, pa1, pa2, pa3); SBAR();
  pv_rd<3>(fb, vb);
  PV_WAIT(8); pv_mm(o[2], fa, pa0, pa1, pa2, pa3); SBAR();
  PV_WAIT(0); pv_mm(o[3], fb, pa0, pa1, pa2, pa3);
#else
  pv_one<0>(o[0], vb, pa0, pa1, pa2, pa3); pv_one<1>(o[1], vb, pa0, pa1, pa2, pa3); pv_one<2>(o[2], vb, pa0, pa1, pa2, pa3); pv_one<3>(o[3], vb, pa0, pa1, pa2, pa3);
#endif
}
constexpr int crow0(int r) { return (r & 3) + 8 * (r >> 2); }
constexpr float LOG2E = 1.4426950408889634f;
__device__ __forceinline__ void partialSM_neg(f32x16& p0, f32x16& p1, float& m_reg, f32x16& negm, float& alpha) {
  float pmax = p0[0];
#pragma unroll
  for (int r = 1; r < 16; ++r) pmax = fmaxf(pmax, p0[r]);
#pragma unroll
  for (int r = 0; r < 16; ++r) pmax = fmaxf(pmax, p1[r]);
  { auto rr = __builtin_amdgcn_permlane32_swap(__float_as_uint(pmax), __float_as_uint(pmax), false, false);
    pmax = fmaxf(__uint_as_float(rr[0]), __uint_as_float(rr[1])); }
  if (__builtin_expect(__all(pmax <= THR), 1)) { alpha = 1.f; }
  else { const float dl = fmaxf(pmax, 0.f); m_reg += dl; alpha = __builtin_amdgcn_exp2f(-dl);
#pragma unroll
    for (int r = 0; r < 16; ++r) { p0[r] -= dl; p1[r] -= dl; negm[r] = -m_reg; } }
#pragma unroll
  for (int r = 0; r < 16; ++r) p0[r] = __builtin_amdgcn_exp2f(p0[r]);
}
__device__ __forceinline__ void partialSM_dil(f32x16& p0, f32x16& p1, float& m_reg, float& mn, float& alpha, float dq, float dlo, float dhi, float nslopeC) {
  constexpr float C = SCALE * LOG2E;
#pragma unroll
  for (int r = 0; r < 16; ++r) {
    const float d0 = dq + (float)crow0(r), d1 = d0 + 32.f;
    const float t0 = fmaf(p0[r], C, nslopeC * fabsf(d0)), t1 = fmaf(p1[r], C, nslopeC * fabsf(d1));
    p0[r] = (d0 >= dlo && d0 <= dhi) ? t0 : -1e30f;
    p1[r] = (d1 >= dlo && d1 <= dhi) ? t1 : -1e30f;
  }
  float pmax = p0[0];
#pragma unroll
  for (int r = 1; r < 16; ++r) pmax = fmaxf(pmax, p0[r]);
#pragma unroll
  for (int r = 0; r < 16; ++r) pmax = fmaxf(pmax, p1[r]);
  { auto rr = __builtin_amdgcn_permlane32_swap(__float_as_uint(pmax), __float_as_uint(pmax), false, false);
    pmax = fmaxf(__uint_as_float(rr[0]), __uint_as_float(rr[1])); }
  if (__builtin_expect(__all(pmax - m_reg <= THR * LOG2E), 1)) { mn = m_reg; alpha = 1.f; }
  else { mn = fmaxf(m_reg, pmax); alpha = __builtin_amdgcn_exp2f(m_reg - mn); m_reg = mn; }
#pragma unroll
  for (int r = 0; r < 16; ++r) { p0[r] = p0[r] - mn; p1[r] = p1[r] - mn; }
#pragma unroll
  for (int r = 0; r < 16; ++r) p0[r] = __builtin_amdgcn_exp2f(p0[r]);
}

template <bool DIL>
__device__ __forceinline__ void attn_body(const bf16* __restrict__ Qb, const bf16* __restrict__ Kh, const bf16* __restrict__ Vh, long qs, long ks,
                                          bf16* __restrict__ Ob, long os, float* __restrict__ lse_o, int lse_s, int i0, int nsub, float nslopeC, int seq, char* lds) {
  typedef __attribute__((address_space(3))) unsigned lds_u32;
  using St = Stage<bf16>;
  const int tid = otid(), wid = __builtin_amdgcn_readfirstlane(tid >> 6), lane = tid & 63, r32 = lane & 31, hi = lane >> 5;
  char* V_lds = lds + 4 * SHM_K; char* K_lds = lds;
  float* ws = (float*)(lds + 4 * SHM_K + 4 * SHM_V) + wid * 64; float* li_l = ws; float* al_l = ws + 32;
  float m_reg = -1e30f, l_reg = 0; f32x16 o[4] = {}; bf16x8 qr[8];
  const bf16* Qw = Qb + (long)(wid * QBLK + r32) * qs + hi * 8;
#pragma unroll
  for (int d0 = 0; d0 < 8; ++d0) qr[d0] = St::ld8(Qw + d0 * 16);
  const int vb0 = (int)(uintptr_t)V_lds + v_rd_base(lane);
  const int kb = DIL ? i0 - 64 : 0;
#define KROW(k) (DIL ? (long)min(max(kb + (k), 0), nsub - 1) : (long)(k))
  int krow[2], kcol[2], vrow[2], vcol[2];
#pragma unroll
  for (int i = 0; i < 2; ++i) { const int pc = 2 * wid + i;
    krow[i] = pc * 4 + (lane >> 4); kcol[i] = (((lane & 15) ^ (krow[i] & 7)) << 3);
    const int sub = pc * 2 + (lane >> 5), kk = ((sub >> 2) << 3) + ((lane & 31) >> 2);
    vrow[i] = (kk & ~0xC) | ((kk & 4) << 1) | ((kk & 8) >> 1); vcol[i] = ((sub & 3) << 5) + ((lane & 3) << 3); }
  unsigned kdo[2], vdo[2];
#pragma unroll
  for (int i = 0; i < 2; ++i) { kdo[i] = (unsigned)(krow[i] * (int)ks + kcol[i]); vdo[i] = (unsigned)(vrow[i] * (int)ks + vcol[i]); }
#define DMA(t, buf) do { if constexpr (DIL) { _Pragma("unroll") for (int i_ = 0; i_ < 2; ++i_) { \
      __builtin_amdgcn_global_load_lds((const unsigned*)(Kh + KROW((t) * KVBLK + krow[i_]) * ks + kcol[i_]), (lds_u32*)(K_lds + (buf) * SHM_K + (2 * wid + i_) * 1024), 16, 0, 0); \
      __builtin_amdgcn_global_load_lds((const unsigned*)(Vh + KROW((t) * KVBLK + vrow[i_]) * ks + vcol[i_]), (lds_u32*)(V_lds + (buf) * SHM_V + (2 * wid + i_) * 1024), 16, 0, 0); } } \
    else { const bf16* Kt_ = Kh + (long)(t) * (KVBLK * ks); const bf16* Vt_ = Vh + (long)(t) * (KVBLK * ks); _Pragma("unroll") for (int i_ = 0; i_ < 2; ++i_) { \
      __builtin_amdgcn_global_load_lds((const unsigned*)(Kt_ + kdo[i_]), (lds_u32*)(K_lds + (buf) * SHM_K + (2 * wid + i_) * 1024), 16, 0, 0); \
      __builtin_amdgcn_global_load_lds((const unsigned*)(Vt_ + vdo[i_]), (lds_u32*)(V_lds + (buf) * SHM_V + (2 * wid + i_) * 1024), 16, 0, 0); } } } while (0)
#define ENDSTEP(j) do { if ((j) + 2 < NT) asm volatile("s_waitcnt vmcnt(4) lgkmcnt(0)\n\ts_barrier" ::: "memory"); else asm volatile("s_waitcnt vmcnt(0) lgkmcnt(0)\n\ts_barrier" ::: "memory"); } while (0)
#define RESC(a) do { if (__any((a) < 1.f)) { if (hi == 0) al_l[r32] = (a); asm volatile("s_waitcnt lgkmcnt(0)" ::: "memory"); \
    for (int d = 0; d < 4; ++d) for (int r = 0; r < 16; ++r) o[d][r] *= al_l[crow(r, hi)]; } } while (0)
#define PSM(P0, P1, MN, AL, jt) do { if constexpr (DIL) { const int t_ = otid(), iq_ = (t_ >> 6) * QBLK + (t_ & 31), hi_ = (t_ >> 5) & 1; \
      partialSM_dil(P0, P1, m_reg, MN, AL, (float)(-64 - iq_ + 4 * hi_ + 64 * (jt)), fmaxf(-64.f, (float)(-(i0 + iq_))), fminf(64.f, (float)(nsub - 1 - (i0 + iq_))), nslopeC); } \
    else partialSM(P0, P1, m_reg, MN, AL); } while (0)
#if MK_SGB
#define SGB_A() do { __builtin_amdgcn_sched_group_barrier(0x100, 4, 0); \
    _Pragma("unroll") for (int g_ = 0; g_ < 12; ++g_) { __builtin_amdgcn_sched_group_barrier(0x008, 1, 0); __builtin_amdgcn_sched_group_barrier(0x100, 1, 0); __builtin_amdgcn_sched_group_barrier(0x002, 6, 0); } \
    _Pragma("unroll") for (int g_ = 0; g_ < 4; ++g_) { __builtin_amdgcn_sched_group_barrier(0x008, 1, 0); __builtin_amdgcn_sched_group_barrier(0x002, 6, 0); } } while (0)
#else
#define SGB_A() do {} while (0)
#endif
#define KBUF(j) ((const bf16*)(K_lds + ((j) & 3) * SHM_K))
#define VBUF(j) (vb0 + ((j) & 3) * (int)SHM_V)
  f32x16 pA0, pA1, pB0, pB1; float mnA, mnB, alA, alB; bf16x8 pa0, pa1, pa2, pa3; const int NT = DIL ? 6 : seq / KVBLK;
  DMA(0, 0); DMA(1, 1);
  if constexpr (!DIL && MK_PP) { DMA(2, 2); asm volatile("s_waitcnt vmcnt(8)\n\ts_barrier" ::: "memory"); }
  else asm volatile("s_waitcnt vmcnt(4)\n\ts_barrier" ::: "memory");
  struct KFrag { bf16x8 a, b; };
  int koff[4];
#pragma unroll
  for (int d0 = 0; d0 < 4; ++d0) koff[d0] = KSWZ(r32, (d0 * 16 + hi * 8) * 2);
  const int kbase0 = (int)(uintptr_t)K_lds;
#define KRD(f, d0, kb) asm volatile("ds_read_b128 %0, %2 offset:%3\n\tds_read_b128 %1, %2 offset:%4" : "=&v"(f.a), "=&v"(f.b) : "v"((kb) + koff[(d0) & 3]), "i"(((d0) >> 2) * 128), "i"(((d0) >> 2) * 128 + 8192) : "memory")
#define QMM(f, d0) do { pA0 = __builtin_amdgcn_mfma_f32_32x32x16_bf16(f.a, qr[d0], pA0, 0, 0, 0); pA1 = __builtin_amdgcn_mfma_f32_32x32x16_bf16(f.b, qr[d0], pA1, 0, 0, 0); } while (0)
#define LW(n) do { asm volatile("s_waitcnt lgkmcnt(" #n ")" ::: "memory"); SBAR(); } while (0)
  if constexpr (DIL) {
    const int rlo = wid >> 1;
    for (int j = 0; j < NT; ++j) {
      if (j + 2 < NT) DMA(j + 2, (j + 2) & 3);
      if (j >= rlo && j <= rlo + 2) {
        SBAR();
        { const int kb_ = kbase0 + (j & 3) * (int)SHM_K; KFrag k0_, k1_, k2_;
          KRD(k0_, 0, kb_); KRD(k1_, 1, kb_); KRD(k2_, 2, kb_); pA0 = f32x16{}; pA1 = f32x16{};
          LW(4); QMM(k0_, 0); SBAR(); KRD(k0_, 3, kb_);
          LW(4); QMM(k1_, 1); SBAR(); KRD(k1_, 4, kb_);
          LW(4); QMM(k2_, 2); SBAR(); KRD(k2_, 5, kb_);
          LW(4); QMM(k0_, 3); SBAR(); KRD(k0_, 6, kb_);
          LW(4); QMM(k1_, 4); SBAR(); KRD(k1_, 7, kb_);
          LW(4); QMM(k2_, 5); SBAR();
          LW(2); QMM(k0_, 6); SBAR();
          LW(0); QMM(k1_, 7); SBAR(); }
        PSM(pA0, pA1, mnA, alA, j); RESC(alA);
        finishSM(pA0, pA1, alA, l_reg, pa0, pa1, pa2, pa3); SBAR();
        pv_d0(o, VBUF(j), pa0, pa1, pa2, pa3);
      }
      if (j + 1 < NT) ENDSTEP(j);
    }
  } else if constexpr (MK_PP) {
    const bool grpB = wid >= 4;
#if MK_NEGM
    m_reg = 0.f; f32x16 negm = f32x16{};
#endif
#define PP_BAR(VM) do { if (VM) { asm volatile("s_waitcnt vmcnt(4) lgkmcnt(0)\n\ts_barrier" ::: "memory"); } else { asm volatile("s_waitcnt vmcnt(0) lgkmcnt(0)\n\ts_barrier" ::: "memory"); } } while (0)
#define PP_BAR_PLAIN() asm volatile("s_waitcnt lgkmcnt(0)\n\ts_barrier" ::: "memory")
    if (grpB) PP_BAR_PLAIN();
    qkt(pA0, pA1, KBUF(0), qr, r32, hi);
    if (grpB) PP_BAR(2 < NT); else PP_BAR_PLAIN();
    for (int t = 0; t < NT; ++t) {
      if (grpB && t + 3 < NT) DMA(t + 3, (t + 3) & 3);
#if MK_NEGM
      partialSM_neg(pA0, pA1, m_reg, negm, alA); RESC(alA);
#else
      PSM(pA0, pA1, mnA, alA, t); RESC(alA);
#endif
      finishSM(pA0, pA1, alA, l_reg, pa0, pa1, pa2, pa3);
#if MK_PROBE_V
      { float dm_ = alA;
#pragma unroll
        for (int q_ = 0; q_ < 32; ++q_) asm volatile("v_add_f32 %0, %0, %0" : "+v"(dm_));
        if (dm_ == 123.456f) l_reg += 1.f; }
#endif
      if (!grpB) PP_BAR(t + 2 < NT); else PP_BAR_PLAIN();
      if (!grpB && t + 3 < NT) DMA(t + 3, (t + 3) & 3);
      SBAR();
      if (t + 1 < NT) {
        const int kb_ = kbase0 + ((t + 1) & 3) * (int)SHM_K, vb_ = VBUF(t);
        KFrag k0_, k1_; VFrag fa_, fb_;
        KRD(k0_, 0, kb_); KRD(k1_, 1, kb_); pv_rd<0>(fa_, vb_);
#if MK_NEGM
        LW(10); pA0 = __builtin_amdgcn_mfma_f32_32x32x16_bf16(k0_.a, qr[0], negm, 0, 0, 0); pA1 = __builtin_amdgcn_mfma_f32_32x32x16_bf16(k0_.b, qr[0], negm, 0, 0, 0); SBAR(); KRD(k0_, 2, kb_);
#else
        pA0 = f32x16{}; pA1 = f32x16{};
        LW(10); QMM(k0_, 0); SBAR(); KRD(k0_, 2, kb_);
#endif
        LW(10); QMM(k1_, 1); SBAR(); KRD(k1_, 3, kb_);
        LW(4);  pv_mm(o[0], fa_, pa0, pa1, pa2, pa3); SBAR(); pv_rd<1>(fb_, vb_);
        LW(10); QMM(k0_, 2); SBAR(); KRD(k0_, 4, kb_);
        LW(10); QMM(k1_, 3); SBAR(); KRD(k1_, 5, kb_);
        LW(4);  pv_mm(o[1], fb_, pa0, pa1, pa2, pa3); SBAR(); pv_rd<2>(fa_, vb_);
        LW(10); QMM(k0_, 4); SBAR(); KRD(k0_, 6, kb_);
        LW(10); QMM(k1_, 5); SBAR(); KRD(k1_, 7, kb_);
        LW(4);  pv_mm(o[2], fa_, pa0, pa1, pa2, pa3); SBAR(); pv_rd<3>(fb_, vb_);
        LW(10); QMM(k0_, 6); SBAR();
        LW(8);  QMM(k1_, 7); SBAR();
        LW(0);  pv_mm(o[3], fb_, pa0, pa1, pa2, pa3);
      } else pv_d0(o, VBUF(t), pa0, pa1, pa2, pa3);
      if (t + 1 < NT) { if (grpB) PP_BAR(t + 3 < NT); else PP_BAR_PLAIN(); }
    }
    if (!grpB) PP_BAR_PLAIN();
#undef PP_BAR
#undef PP_BAR_PLAIN
#undef KRD
#undef QMM
#undef LW
  } else {
  if (2 < NT) DMA(2, 2);
  qkt(pA0, pA1, KBUF(0), qr, r32, hi); PSM(pA0, pA1, mnA, alA, 0);
  ENDSTEP(0);
  for (int j = 1; j + 1 < NT; j += 2) {
    if (j + 2 < NT) DMA(j + 2, (j + 2) & 3);
    SBAR(); qkt(pB0, pB1, KBUF(j), qr, r32, hi);
    finishSM(pA0, pA1, alA, l_reg, pa0, pa1, pa2, pa3); SGB_A(); SBAR();
    pv_d0(o, VBUF(j - 1), pa0, pa1, pa2, pa3); PSM(pB0, pB1, mnB, alB, j);
    RESC(alB); ENDSTEP(j);
    if (j + 3 < NT) DMA(j + 3, (j + 3) & 3);
    SBAR(); qkt(pA0, pA1, KBUF(j + 1), qr, r32, hi);
    finishSM(pB0, pB1, alB, l_reg, pa0, pa1, pa2, pa3); SGB_A(); SBAR();
    pv_d0(o, VBUF(j), pa0, pa1, pa2, pa3); PSM(pA0, pA1, mnA, alA, j + 1);
    RESC(alA); ENDSTEP(j + 1);
  }
  SBAR(); qkt(pB0, pB1, KBUF(NT - 1), qr, r32, hi);
  finishSM(pA0, pA1, alA, l_reg, pa0, pa1, pa2, pa3); SBAR();
  pv_d0(o, VBUF(NT - 2), pa0, pa1, pa2, pa3); PSM(pB0, pB1, mnB, alB, NT - 1);
  RESC(alB);
  finishSM(pB0, pB1, alB, l_reg, pa0, pa1, pa2, pa3); SBAR();
  pv_d0(o, VBUF(NT - 1), pa0, pa1, pa2, pa3);
  }
  if (hi == 0) li_l[r32] = l_reg; asm volatile("s_waitcnt lgkmcnt(0)" ::: "memory");
  if constexpr (DIL) { if (hi == 0) lse_o[(long)(wid * QBLK + r32) * lse_s] = m_reg + __log2f(l_reg); }
  float rli[16];
#pragma unroll
  for (int r = 0; r < 16; ++r) rli[r] = __builtin_amdgcn_rcpf(li_l[crow(r, hi)]);
  bf16* Ow = Ob + (long)(wid * QBLK) * os;
#pragma unroll
  for (int r = 0; r < 16; ++r) { const int orow = crow(r, hi);
#pragma unroll
    for (int d0 = 0; d0 < 4; ++d0) Ow[(long)orow * os + d0 * 32 + r32] = __float2bfloat16(o[d0][r] * rli[r]); }
  asm volatile("s_waitcnt lgkmcnt(0)\n\ts_barrier" ::: "memory");
#undef KROW
#undef DMA
#undef ENDSTEP
#undef RESC
#undef PSM
#undef KBUF
#undef SGB_A
#undef VBUF
}
}

#define GAS __attribute__((address_space(1)))
#define LAS __attribute__((address_space(3)))
typedef unsigned short bf16_t;
typedef unsigned v4u __attribute__((ext_vector_type(4)));
typedef unsigned v2u __attribute__((ext_vector_type(2)));
typedef float f32x4 __attribute__((ext_vector_type(4)));
#define LDS_WAIT() asm volatile("s_waitcnt lgkmcnt(0)" ::: "memory")

constexpr size_t MiB = 1u << 20;
constexpr size_t WS_W1T = 0;
constexpr size_t WS_W2T = 104 * MiB;
constexpr size_t WS_H = 136 * MiB;
constexpr size_t WS_PROJ = 200 * MiB;
constexpr size_t WS_YA = 408 * MiB;
constexpr size_t WS_YB = 440 * MiB;
constexpr size_t WS_LSE = 536 * MiB;
constexpr size_t WS_ROPE = 538 * MiB;
constexpr size_t WS_XB = 540 * MiB;
constexpr size_t WS_ROWSQ = 604 * MiB;
constexpr size_t WS_END = 616 * MiB;
static_assert((size_t)DEPTH * DIN * DM * 2 <= WS_W2T - WS_W1T && (size_t)M * DIN * 2 <= WS_YA - WS_PROJ && (size_t)3 * M * DB * 2 <= WS_LSE - WS_YB, "ws map");
constexpr int LDS_BYTES = 147456;
constexpr int N_PHASES = 2 + 5 * DEPTH;

__device__ __forceinline__ unsigned f2bf(float f) { unsigned u = __builtin_bit_cast(unsigned, f); return (u + 0x7fffu + ((u >> 16) & 1u)) >> 16; }
__device__ __forceinline__ unsigned pk2(float lo, float hi) { return f2bf(lo) | (f2bf(hi) << 16); }
__device__ __forceinline__ float bflo(unsigned w) { return __uint_as_float(w << 16); }
__device__ __forceinline__ float bfhi(unsigned w) { return __uint_as_float(w & 0xffff0000u); }
__device__ __forceinline__ float wave_sum(float v) {
#pragma unroll
    for (int o = 1; o < 64; o <<= 1) v += __shfl_xor(v, o);
    return v;
}

__device__ const float INV_FREQ[32] = {1.000000000e+00f, 7.498942614e-01f, 5.623413324e-01f, 4.216965139e-01f, 3.162277639e-01f, 2.371373773e-01f, 1.778279394e-01f, 1.333521307e-01f,
    1.000000015e-01f, 7.498941571e-02f, 5.623413250e-02f, 4.216965288e-02f, 3.162277490e-02f, 2.371373773e-02f, 1.778279431e-02f, 1.333521493e-02f,
    9.999999776e-03f, 7.498941850e-03f, 5.623413250e-03f, 4.216964822e-03f, 3.162277630e-03f, 2.371373586e-03f, 1.778279431e-03f, 1.333521446e-03f,
    1.000000047e-03f, 7.498942432e-04f, 5.623413017e-04f, 4.216965172e-04f, 3.162277571e-04f, 2.371373703e-04f, 1.778279402e-04f, 1.333521504e-04f};

__device__ __forceinline__ void sincos_acc(float a, float& s, float& c) {
    const double x = (double)a, kd = __builtin_rint(x * 0.63661977236758134308);
    const int k = (int)kd; const double r = x - kd * 1.57079632679489661923, r2 = r * r;
    const double sp = r * (1.0 + r2 * (-1.0 / 6 + r2 * (1.0 / 120 + r2 * (-1.0 / 5040 + r2 * (1.0 / 362880 + r2 * (-1.0 / 39916800 + r2 * (1.0 / 6227020800.0)))))));
    const double cp = 1.0 + r2 * (-0.5 + r2 * (1.0 / 24 + r2 * (-1.0 / 720 + r2 * (1.0 / 40320 + r2 * (-1.0 / 3628800 + r2 * (1.0 / 479001600.0 + r2 * (-1.0 / 87178291200.0)))))));
    const int q = k & 3;
    const double sv = (q == 0) ? sp : (q == 1) ? cp : (q == 2) ? -sp : -cp, cv = (q == 0) ? cp : (q == 1) ? -sp : (q == 2) ? -cp : sp;
    s = (float)sv; c = (float)cv;
}

__device__ __forceinline__ void p0_transpose_item(const float* W, int K, int N, bf16_t* WT, LAS float* scr, int item, int lane, const float* kscale) {
    const int nblk = N / 32, kb = item / nblk, nb = item % nblk, k0 = 64 * kb, n0 = 32 * nb;
#pragma unroll 8
    for (int i = 0; i < 32; ++i) { const int kk = 2 * i + (lane >> 5); scr[kk * 33 + (lane & 31)] = W[(size_t)(k0 + kk) * N + n0 + (lane & 31)] * (kscale ? kscale[k0 + kk] : 1.0f); }
    LDS_WAIT(); asm volatile("" ::: "memory");
    const int c = lane & 7;
#pragma unroll
    for (int j = 0; j < 4; ++j) { const int n = (lane >> 3) + 8 * j; const LAS float* s = scr + (8 * c) * 33 + n;
        v4u o; o.x = pk2(s[0 * 33], s[1 * 33]); o.y = pk2(s[2 * 33], s[3 * 33]); o.z = pk2(s[4 * 33], s[5 * 33]); o.w = pk2(s[6 * 33], s[7 * 33]);
        *(v4u*)(WT + (size_t)(n0 + n) * K + k0 + 8 * c) = o; }
    LDS_WAIT(); asm volatile("" ::: "memory");
}

#define XB_TMO      128
#define XB_XCNT(j)  (256  + 64 * (j))
#define XB_XSUB(j)  (1280 + 64 * (j))
#define XB_XGEN(j)  (2304 + 64 * (j))
#define XB_TOP      3328
#define XB_TOPGEN   3392
#define XCD_BAR_WORDS 3456
#define XB_SPIN_CAP (1u << 18)

__device__ __forceinline__ unsigned xb_ld(unsigned* p)              { return __hip_atomic_load(p, __ATOMIC_RELAXED, __HIP_MEMORY_SCOPE_AGENT); }
__device__ __forceinline__ unsigned xb_add(unsigned* p, unsigned v) { return __hip_atomic_fetch_add(p, v, __ATOMIC_RELAXED, __HIP_MEMORY_SCOPE_AGENT); }
__device__ __forceinline__ unsigned xb_xcc_id() { return (unsigned)__builtin_amdgcn_s_getreg((3 << 11) | 20) & 0xFu; }
#define XB_SPIN(cond, bar) do { unsigned _sp = 0; while (cond) { __builtin_amdgcn_s_sleep(1); \
    if ((++_sp & 255u) == 0u) { if (xb_ld(&(bar)[XB_TMO])) break; if (_sp > XB_SPIN_CAP) { atomicAdd(&(bar)[XB_TMO], 1u); break; } } } } while (0)

struct XcdBarrier {
    unsigned* bar; unsigned x;
    volatile LAS unsigned* st;
};

__device__ __forceinline__ XcdBarrier xcd_barrier_post(unsigned* bar, volatile LAS unsigned* st) {
    XcdBarrier b; b.bar = bar; b.x = xb_xcc_id(); b.st = st;
    if (threadIdx.x == 0) (void)xb_add(&bar[XB_XCNT(b.x)], 1u);
    return b;
}
__device__ __forceinline__ void xcd_barrier_complete(unsigned* bar, unsigned x, unsigned& nloc, unsigned& nx) {
    const unsigned G = gridDim.x * gridDim.y * gridDim.z;
    unsigned sum, cnt, mine, sp = 0u;
    for (;;) {
        sum = 0u; cnt = 0u; mine = 0u;
#pragma unroll
        for (unsigned j = 0; j < 16; ++j) { const unsigned c = xb_ld(&bar[XB_XCNT(j)]); sum += c; cnt += (c > 0u) ? 1u : 0u; mine = (j == x) ? c : mine; }
        if (sum == G) break;
        __builtin_amdgcn_s_sleep(1);
        if ((++sp & 255u) == 0u) { if (xb_ld(&bar[XB_TMO])) break; if (sp > XB_SPIN_CAP) { atomicAdd(&bar[XB_TMO], 1u); break; } }
    }
    nloc = mine > 0u ? mine : 1u; nx = cnt > 0u ? cnt : 1u;
}

__device__ __forceinline__ void xcd_barrier(const XcdBarrier& b) {
    asm volatile("s_waitcnt vmcnt(0)" ::: "memory");
    __syncthreads();
    if (threadIdx.x == 0) {
        unsigned* bar = b.bar;
        __builtin_amdgcn_s_waitcnt(0);
        unsigned nloc = b.st[0], nx = b.st[1];
        if (nloc == 0u) { xcd_barrier_complete(bar, b.x, nloc, nx); b.st[0] = nloc; b.st[1] = nx; }
        const unsigned old = xb_add(&bar[XB_XSUB(b.x)], 1u);
        const unsigned gen = old / nloc;
        if (old + 1u == (gen + 1u) * nloc) {
            __builtin_amdgcn_fence(__ATOMIC_RELEASE, "agent");
            asm volatile("s_waitcnt vmcnt(0)" ::: "memory");
            const unsigned og = xb_add(&bar[XB_TOP], 1u);
            const unsigned tg = og / nx;
            if (og + 1u == (tg + 1u) * nx) xb_add(&bar[XB_TOPGEN], 1u);
            else XB_SPIN(xb_ld(&bar[XB_TOPGEN]) == tg, bar);
            __builtin_amdgcn_fence(__ATOMIC_ACQUIRE, "agent");
            xb_add(&bar[XB_XGEN(b.x)], 1u);
            asm volatile("s_waitcnt vmcnt(0)" ::: "memory");
        } else {
            XB_SPIN(xb_ld(&bar[XB_XGEN(b.x)]) == gen, bar);
            __builtin_amdgcn_fence(__ATOMIC_ACQUIRE, "agent");
            asm volatile("s_waitcnt vmcnt(0)" ::: "memory");
        }
    }
    __syncthreads();
}

constexpr size_t WS_CTL = 539 * MiB, CTL_BYTES = 16384;
constexpr int MISC_OFF = 147456 - 128;
__device__ __forceinline__ void gate_row(int m, int lane, const bf16_t* __restrict__ YA, const bf16_t* __restrict__ YB, const float* __restrict__ LSE, const bf16_t* __restrict__ PROJ,
                                         const float* __restrict__ wa, const float* __restrict__ wb, bf16_t* __restrict__ H) {
                    float ya[2][8], yb[2][8]; float ssa = 0.f, ssb = 0.f;
#pragma unroll
                    for (int j = 0; j < 2; ++j) { const int c = lane + 64 * j, hh = c >> 4;
                        const v4u a = *(const v4u*)(YA + (size_t)m * DA + 8 * c);
                        ya[j][0] = bflo(a.x); ya[j][1] = bfhi(a.x); ya[j][2] = bflo(a.y); ya[j][3] = bfhi(a.y); ya[j][4] = bflo(a.z); ya[j][5] = bfhi(a.z); ya[j][6] = bflo(a.w); ya[j][7] = bfhi(a.w);
                        const float l0 = LSE[((size_t)0 * M + m) * 8 + hh], l1 = LSE[((size_t)1 * M + m) * 8 + hh], l2 = LSE[((size_t)2 * M + m) * 8 + hh];
                        const float mx = fmaxf(l0, fmaxf(l1, l2)); const float e0 = __builtin_amdgcn_exp2f(l0 - mx), e1 = __builtin_amdgcn_exp2f(l1 - mx), e2 = __builtin_amdgcn_exp2f(l2 - mx);
                        const float inv = 1.0f / (e0 + e1 + e2); const float w0 = e0 * inv, w1 = e1 * inv, w2 = e2 * inv;
                        const v4u b0 = *(const v4u*)(YB + ((size_t)0 * M + m) * DB + 8 * c), b1 = *(const v4u*)(YB + ((size_t)1 * M + m) * DB + 8 * c), b2 = *(const v4u*)(YB + ((size_t)2 * M + m) * DB + 8 * c);
                        yb[j][0] = w0 * bflo(b0.x) + w1 * bflo(b1.x) + w2 * bflo(b2.x); yb[j][1] = w0 * bfhi(b0.x) + w1 * bfhi(b1.x) + w2 * bfhi(b2.x);
                        yb[j][2] = w0 * bflo(b0.y) + w1 * bflo(b1.y) + w2 * bflo(b2.y); yb[j][3] = w0 * bfhi(b0.y) + w1 * bfhi(b1.y) + w2 * bfhi(b2.y);
                        yb[j][4] = w0 * bflo(b0.z) + w1 * bflo(b1.z) + w2 * bflo(b2.z); yb[j][5] = w0 * bfhi(b0.z) + w1 * bfhi(b1.z) + w2 * bfhi(b2.z);
                        yb[j][6] = w0 * bflo(b0.w) + w1 * bflo(b1.w) + w2 * bflo(b2.w); yb[j][7] = w0 * bfhi(b0.w) + w1 * bfhi(b1.w) + w2 * bfhi(b2.w);
#pragma unroll
                        for (int i = 0; i < 8; ++i) { ssa += ya[j][i] * ya[j][i]; ssb += yb[j][i] * yb[j][i]; } }
                    const float ra = 1.0f / sqrtf(wave_sum(ssa) * (1.0f / DA) + EPS), rb = 1.0f / sqrtf(wave_sum(ssb) * (1.0f / DB) + EPS);
#pragma unroll
                    for (int j = 0; j < 2; ++j) { const int c = lane + 64 * j;
                        const v4u ga = *(const v4u*)(PROJ + ((size_t)(H_GA + (c >> 4)) * M + m) * HD + 8 * (c & 15)), gb = *(const v4u*)(PROJ + ((size_t)(H_GB + (c >> 4)) * M + m) * HD + 8 * (c & 15));
                        const float gaf[8] = {bflo(ga.x), bfhi(ga.x), bflo(ga.y), bfhi(ga.y), bflo(ga.z), bfhi(ga.z), bflo(ga.w), bfhi(ga.w)};
                        const float gbf[8] = {bflo(gb.x), bfhi(gb.x), bflo(gb.y), bfhi(gb.y), bflo(gb.z), bfhi(gb.z), bflo(gb.w), bfhi(gb.w)};
                        const f32x4 wa0 = *(const f32x4*)(wa + 8 * c), wa1 = *(const f32x4*)(wa + 8 * c + 4), wb0 = *(const f32x4*)(wb + 8 * c), wb1 = *(const f32x4*)(wb + 8 * c + 4);
                        float za[8], zb[8];
#pragma unroll
                        for (int i = 0; i < 8; ++i) { const float wai = i < 4 ? wa0[i & 3] : wa1[i & 3], wbi = i < 4 ? wb0[i & 3] : wb1[i & 3];
                            const float sa = gaf[i] / (1.0f + __expf(-gaf[i])), sb = gbf[i] / (1.0f + __expf(-gbf[i]));
                            za[i] = ya[j][i] * ra * wai * sa; zb[i] = yb[j][i] * rb * wbi * sb; }
                        v4u oa, ob; oa.x = pk2(za[0], za[1]); oa.y = pk2(za[2], za[3]); oa.z = pk2(za[4], za[5]); oa.w = pk2(za[6], za[7]);
                        ob.x = pk2(zb[0], zb[1]); ob.y = pk2(zb[2], zb[3]); ob.z = pk2(zb[4], zb[5]); ob.w = pk2(zb[6], zb[7]);
                        *(v4u*)(H + (size_t)m * DM + 8 * c) = oa; *(v4u*)(H + (size_t)m * DM + DA + 8 * c) = ob; }
}

struct Params { const float *x, *norm_w, *w_in, *qn, *kn, *ona, *onb, *w_out, *fnorm; float* out; unsigned char* ws; int ph_lo, ph_hi; };

__global__ void __launch_bounds__(512, 2) mk_fwd(Params p) {
    extern __shared__ __attribute__((aligned(16))) unsigned char lds[];
    volatile LAS unsigned* MISC = (volatile LAS unsigned*)((LAS unsigned char*)lds + MISC_OFF);
    if (threadIdx.x < 32) MISC[threadIdx.x] = 0u;
    __syncthreads();
    XcdBarrier bar = xcd_barrier_post((unsigned*)(p.ws + WS_CTL), MISC + 8);
    if (p.ph_lo == 0) {
        float* RCOS0 = (float*)(p.ws + WS_ROPE); float* RSIN0 = RCOS0 + 192 * 32;
        for (int i = blockIdx.x * 512 + threadIdx.x; i < 192 * 32; i += gridDim.x * 512) {
            const int pos = i >> 5, f = i & 31; const float pv = (float)(pos < 128 ? pos : pos - 128);
            float sn_, cs_; sincos_acc(pv * INV_FREQ[f], sn_, cs_); RCOS0[i] = cs_; RSIN0[i] = sn_;
        }
    }
    for (int ph = p.ph_lo; ph < p.ph_hi; ++ph) {
        const int tid = otid(), lane = tid & 63, wave = __builtin_amdgcn_readfirstlane(tid >> 6);
        int G = gridDim.x, bx = blockIdx.x; asm volatile("" : "+s"(G), "+s"(bx));
        const int vcu = (G % 8 == 0) ? (bx % 8) * (G / 8) + bx / 8 : bx;
        const int gw = vcu * 8 + wave, NGW = G * 8;
        size_t zoff = 0; asm volatile("" : "+s"(zoff));
        unsigned char* ws = p.ws + zoff;
        bf16_t* W1T = (bf16_t*)(ws + WS_W1T); bf16_t* W2T = (bf16_t*)(ws + WS_W2T); bf16_t* H = (bf16_t*)(ws + WS_H); bf16_t* PROJ = (bf16_t*)(ws + WS_PROJ);
        bf16_t* YA = (bf16_t*)(ws + WS_YA); bf16_t* YB = (bf16_t*)(ws + WS_YB); float* LSE = (float*)(ws + WS_LSE);
        float* RCOS = (float*)(ws + WS_ROPE); float* RSIN = RCOS + 192 * 32;
        bf16_t* XB = (bf16_t*)(ws + WS_XB); float* ROWSQ = (float*)(ws + WS_ROWSQ);
        if (ph == 0) {
            LAS float* scr = (LAS float*)((LAS unsigned char*)lds + wave * 16384);
            constexpr int I1 = (DM / 64) * (DIN / 32), I2 = (DM / 64) * (DM / 32), IL = I1 + I2;
            DUPREP(0) for (int it = gw; it < DEPTH * IL; it += NGW) {
                const int l = it / IL, r = it % IL;
                if (r < I1) p0_transpose_item(p.w_in + (size_t)l * DM * DIN, DM, DIN, W1T + (size_t)l * DIN * DM, scr, r, lane, p.norm_w + (size_t)l * DM);
                else p0_transpose_item(p.w_out + (size_t)l * DM * DM, DM, DM, W2T + (size_t)l * DM * DM, scr, r - I1, lane, nullptr);
            }
            for (int m = gw; m < M; m += NGW) {
                const f32x4* xr = (const f32x4*)(p.x + (size_t)m * DM) + lane; v2u* o8 = (v2u*)(XB + (size_t)m * DM) + lane; float sq = 0.f;
#pragma unroll
                for (int j = 0; j < 8; ++j) { const f32x4 v = xr[64 * j]; v2u w; w.x = pk2(v.x, v.y); w.y = pk2(v.z, v.w); o8[64 * j] = w;
                    const float r0 = bflo(w.x), r1 = bfhi(w.x), r2 = bflo(w.y), r3 = bfhi(w.y); sq += (r0 * r0 + r1 * r1) + (r2 * r2 + r3 * r3); }
                sq = wave_sum(sq); if (lane < 32) ROWSQ[(size_t)m * 32 + lane] = (lane == 0) ? sq : 0.f;
            }
        } else if (ph == N_PHASES - 1) {
            for (int m = gw; m < M; m += NGW) {
                f32x4* xr = (f32x4*)(p.out + (size_t)m * DM) + lane; const f32x4* wr_ = (const f32x4*)p.fnorm + lane; const v2u* xb8 = (const v2u*)(XB + (size_t)m * DM) + lane;
                const float rstd = 1.0f / sqrtf(wave_sum(lane < 32 ? ROWSQ[((size_t)DEPTH * M + m) * 32 + lane] : 0.f) * (1.0f / DM) + EPS);
#pragma unroll
                for (int j = 0; j < 8; ++j) { const v2u w = xb8[64 * j]; const f32x4 v = {bflo(w.x), bfhi(w.x), bflo(w.y), bfhi(w.y)}; xr[64 * j] = v * rstd * wr_[64 * j]; }
            }
        } else {
            const int l = (ph - 1) / 5, st = (ph - 1) % 5 + 1;
            if (st == 1) {
                pg8::Gemm g{XB, W1T + (size_t)l * DIN * DM, M, DIN, DM}; pg8::StaticOrder S; S.init(M, DIN, G, bx);
                pg8::EpiHeadMajor E{PROJ, M, ROWSQ + (size_t)l * M * 32, 1.0f / DM, EPS};
#ifndef MK_NO_G1
                DUPREP(2) pg8::gemm_phase<pg8::EpiHeadMajor, pg8::StaticOrder, PG8_ALIGN, PG8_SP2>((PG8_LAS unsigned char*)lds, g, S, E);
#endif
            } else if (st == 2) {
                const float* qg = p.qn + l * HD; const float* kg = p.kn + l * HD;
                constexpr int QKU = 4;
                for (int it0 = gw; it0 < M * 10 / 4; it0 += QKU * NGW) {
                    const int j = lane & 15, half = j >> 3, jj = j & 7, e = half * 64 + 4 * jj;
                    v2u a[QKU], b[QKU]; f32x4 cs[QKU], sn[QKU]; bf16_t* pp[QKU]; bool isq[QKU];
#pragma unroll
                    for (int u = 0; u < QKU; ++u) { const int it = min(it0 + u * NGW, M * 10 / 4 - 1);
                        const int g = it * 4 + (lane >> 4), row = g / 10, hs = g - row * 10; isq[u] = hs < 8;
                        pp[u] = PROJ + ((size_t)hs * M + row) * HD + e; a[u] = *(const v2u*)pp[u]; b[u] = *(const v2u*)(pp[u] + 32);
                        const int t = row & (T - 1), pos = half ? 128 + (t & 63) : (t >> 6);
                        cs[u] = *(const f32x4*)(RCOS + pos * 32 + 4 * jj); sn[u] = *(const f32x4*)(RSIN + pos * 32 + 4 * jj); }
                    asm volatile("" ::: "memory");
#pragma unroll
                    for (int u = 0; u < QKU; ++u) {
                        float x1[4] = {bflo(a[u].x), bfhi(a[u].x), bflo(a[u].y), bfhi(a[u].y)}, x2[4] = {bflo(b[u].x), bfhi(b[u].x), bflo(b[u].y), bfhi(b[u].y)};
                        float ss = 0.f;
#pragma unroll
                        for (int i = 0; i < 4; ++i) ss += x1[i] * x1[i] + x2[i] * x2[i];
                        ss += __shfl_xor(ss, 1); ss += __shfl_xor(ss, 2); ss += __shfl_xor(ss, 4); ss += __shfl_xor(ss, 8);
                        const float rstd = 1.0f / sqrtf(ss * (1.0f / HD) + EPS);
                        const float* gn = isq[u] ? qg : kg;
                        const float qsc = (MK_NEGM && isq[u]) ? att::SCALE * att::LOG2E : 1.0f;
                        const f32x4 g1 = *(const f32x4*)(gn + e), g2 = *(const f32x4*)(gn + e + 32);
                        float o1[4], o2[4];
#pragma unroll
                        for (int i = 0; i < 4; ++i) { const float y1 = x1[i] * rstd * g1[i], y2 = x2[i] * rstd * g2[i]; o1[i] = (y1 * cs[u][i] - y2 * sn[u][i]) * qsc; o2[i] = (y1 * sn[u][i] + y2 * cs[u][i]) * qsc; }
                        v2u w1, w2; w1.x = pk2(o1[0], o1[1]); w1.y = pk2(o1[2], o1[3]); w2.x = pk2(o2[0], o2[1]); w2.y = pk2(o2[2], o2[3]);
                        if (it0 + u * NGW < M * 10 / 4) { *(v2u*)pp[u] = w1; *(v2u*)(pp[u] + 32) = w2; }
                    }
                }
#ifndef MK_NO_DIL
                DUPREP(3) for (int u = vcu; u < 1536; u += G) {
                    const int pt = u >> 9, rem = u & 511, b = rem >> 8, h = (rem >> 5) & 7, w = rem & 31;
                    const int d = (pt == 0) ? 1 : (pt == 1) ? 4 : 16, res = w & (d - 1), blk = w / d, i0 = blk * 256, nsub = T / d;
                    const float slope = __builtin_amdgcn_exp2f(-(float)(h + 1));
                    const float nslopeC = -slope * (float)d * att::LOG2E;
                    const size_t tok0 = (size_t)b * T + res;
                    const att::bf16* Pb = (const att::bf16*)PROJ + ((size_t)h * M + tok0) * HD;
                    const long rs = (long)d * HD;
                    att::attn_body<true>(Pb + (size_t)H_QB * M * HD + (long)i0 * rs, Pb + (size_t)H_KB * M * HD, Pb + (size_t)H_VB * M * HD, rs, rs,
                                         (att::bf16*)YB + ((size_t)pt * M + tok0 + (size_t)i0 * d) * DB + h * HD, (long)d * DB,
                                         LSE + ((size_t)pt * M + tok0 + (size_t)i0 * d) * 8 + h, d * 8, i0, nsub, nslopeC, 0, (char*)lds);
                }
#endif
            } else if (st == 3) {
#ifndef MK_NO_DENSE
                DUPREP(4) for (int u = vcu; u < 512; u += G) {
                    const int combo = u >> 7, b = combo >> 1, kvh = combo & 1, h = kvh * 4 + ((u >> 5) & 3), qb = u & 31;
                    const att::bf16* Pb = (const att::bf16*)PROJ + (size_t)b * T * HD;
                    att::attn_body<false>(Pb + ((size_t)(H_QA + h) * M + qb * 256) * HD, Pb + (size_t)(H_KA + kvh) * M * HD, Pb + (size_t)(H_VA + kvh) * M * HD, HD, HD,
                                          (att::bf16*)YA + ((size_t)b * T + qb * 256) * DA + h * HD, DA, nullptr, 0, 0, 0, 0.f, T, (char*)lds);
                }
#endif
            } else if (st == 4) {
                const float* wa = p.ona + (size_t)l * DA; const float* wb = p.onb + (size_t)l * DB;
                DUPREP(5) for (int m = gw; m < M; m += 2 * NGW) {
                    gate_row(m, lane, YA, YB, LSE, PROJ, wa, wb, H);
                    if (m + NGW < M) gate_row(m + NGW, lane, YA, YB, LSE, PROJ, wa, wb, H);
                }
            } else {
                pg8::Gemm g{H, W2T + (size_t)l * DM * DM, M, DM, DM}; pg8::StaticOrder S; S.init(M, DM, G, bx);
                pg8::EpiResF32 E{XB, ROWSQ + (size_t)(l + 1) * M * 32, DM};
#ifndef MK_NO_G2
                pg8::gemm_phase<pg8::EpiResF32, pg8::StaticOrder, PG8_ALIGN, PG8_SP2>((PG8_LAS unsigned char*)lds, g, S, E);
#endif
            }
        }
        if (ph + 1 < p.ph_hi) { if (p.ph_hi > 4096) cg::this_grid().sync(); else xcd_barrier(bar); if (MK_DUP & 64) xcd_barrier(bar); }
    }
}

extern "C" void kernel_launch(void* const* d_in, const int* in_sizes, int n_in, void* d_out, int out_size, void* d_ws, size_t ws_size, hipStream_t stream) {
    static int grid = 0;
    if (grid == 0) {
        if (n_in != 9 || in_sizes[0] != M * DM || out_size != M * DM || ws_size < WS_END) { fprintf(stderr, "kernel_launch: unexpected shapes (n_in %d, ws %zu)\n", n_in, ws_size); grid = -1; return; }
        int dev = 0, cus = 0, per_cu = 0;
        hipGetDevice(&dev); hipDeviceGetAttribute(&cus, hipDeviceAttributeMultiprocessorCount, dev);
        if (hipFuncSetAttribute((const void*)mk_fwd, hipFuncAttributeMaxDynamicSharedMemorySize, LDS_BYTES) != hipSuccess) { fprintf(stderr, "kernel_launch: hipFuncSetAttribute failed\n"); grid = -1; return; }
        if (hipOccupancyMaxActiveBlocksPerMultiprocessor(&per_cu, (const void*)mk_fwd, 512, LDS_BYTES) != hipSuccess || per_cu < 1) per_cu = 1;
        (void)hipGetLastError();
        grid = cus * per_cu;
    }
    if (grid < 0) return;
    Params p{};
    p.x = (const float*)d_in[0]; p.norm_w = (const float*)d_in[1]; p.w_in = (const float*)d_in[2]; p.qn = (const float*)d_in[3]; p.kn = (const float*)d_in[4];
    p.ona = (const float*)d_in[5]; p.onb = (const float*)d_in[6]; p.w_out = (const float*)d_in[7]; p.fnorm = (const float*)d_in[8];
    p.out = (float*)d_out; p.ws = (unsigned char*)d_ws;
    if (hipMemsetAsync((char*)d_ws + WS_CTL, 0, CTL_BYTES, stream) != hipSuccess) { fprintf(stderr, "kernel_launch: memset failed\n"); return; }
#if MK_ONE_LAUNCH
    p.ph_lo = 0; p.ph_hi = N_PHASES;
    void* args[] = {&p};
    hipError_t e = hipLaunchCooperativeKernel((const void*)mk_fwd, dim3(grid), dim3(512), args, LDS_BYTES, stream);
    if (e != hipSuccess) fprintf(stderr, "kernel_launch: cooperative launch failed: %s (grid %d)\n", hipGetErrorString(e), grid);
#else
    for (int ph = 0; ph < N_PHASES; ++ph) { p.ph_lo = ph; p.ph_hi = ph + 1; hipLaunchKernelGGL(mk_fwd, dim3(grid), dim3(512), LDS_BYTES, stream, p); }
#endif
}
```

```cpp
#include <hip/hip_runtime.h>
#include <hip/hip_bf16.h>
#include <hip/hip_cooperative_groups.h>
#include <cstdio>
#include <cstdint>
namespace cg = cooperative_groups;

#ifndef MK_DUP
#define MK_DUP 0
#endif
#define DUPREP(k) for (int rep_ = 0; rep_ < 1 + ((MK_DUP >> (k)) & 1); ++rep_)
#ifndef MK_PVPIPE
#define MK_PVPIPE 1
#endif
#ifndef MK_SGB
#define MK_SGB 0
#endif
#ifndef MK_PP
#define MK_PP 1
#endif
#ifndef MK_PROBE_V
#define MK_PROBE_V 0
#endif
#ifndef MK_NEGM
#define MK_NEGM 1
#endif
#ifndef MK_ONE_LAUNCH
#define MK_ONE_LAUNCH 1
#endif
static_assert(!MK_NEGM || MK_PP, "MK_NEGM pre-scales q for the ping-pong dense body only");

constexpr int BATCH = 2, T = 8192, DM = 2048, DEPTH = 4, HD = 128, DA = 1024, DB = 1024, DIN = 6656, M = BATCH * T;
constexpr int C_QA = 0, C_KA = 1024, C_VA = 1280, C_GA = 1536, C_QB = 2560, C_KB = 3584, C_VB = 4608, C_GB = 5632;
constexpr int H_QA = 0, H_KA = 8, H_VA = 10, H_GA = 12, H_QB = 20, H_KB = 28, H_VB = 36, H_GB = 44;
constexpr float EPS = 1e-6f;
__device__ __forceinline__ int otid() { int t = threadIdx.x; asm volatile("" : "+v"(t)); return t; }

namespace pg8 {
#define PG8_LAS __attribute__((address_space(3)))
typedef unsigned short bf16_t;
typedef short bf16x8 __attribute__((ext_vector_type(8)));
typedef float f32x4 __attribute__((ext_vector_type(4)));
typedef unsigned u32x4 __attribute__((ext_vector_type(4)));
constexpr int BM = 256, BK = 64, HALF = 128, HTB = HALF * BK * 2  , STAGE_BYTES = 8 * HTB, NXCD = 8, WGM = 8;

__host__ __device__ __forceinline__ int lds_byte(int r, int c) { const int st = (r >> 4) * 2 + (c >> 5), rr = r & 15, cc = c & 31, ob = rr * 64 + cc * 2; return st * 1024 + (ob ^ (((ob >> 9) & 1) << 5)); }
__host__ __device__ __forceinline__ void stage_rc(int b, int& R, int& C) { const int st = b / 1024, sb = b % 1024, swz = sb ^ (((sb >> 9) & 1) << 5); R = (st >> 1) * 16 + swz / 64; C = (st & 1) * 32 + (swz % 64) / 2; }
__host__ __device__ __forceinline__ int perm32(int rho) { const int n = rho >> 4, i = rho & 15; return 8 * (i >> 2) + 4 * n + (i & 3); }

struct Unit { int pm, pn; };
struct Gemm { const bf16_t* A; const bf16_t* Bt; int M, N, K; };

struct StaticOrder {
    int nM, nN, nwg, G, c;
    __host__ __device__ void init(int M, int N, int G_, int c_) { nM = M / BM; nN = N / BM; nwg = nM * nN; G = G_; c = c_; }
    __host__ __device__ bool next(int i, Unit& u) const {
        const long L = (long)i * G + c; if (L >= nwg) return false;
        int wgid = (int)L; { const int q = nwg / NXCD, r = nwg % NXCD, xcd = wgid % NXCD, off = wgid / NXCD; wgid = (xcd < r ? xcd * (q + 1) : r * (q + 1) + (xcd - r) * q) + off; }
        const int nig = WGM * nN, gid = wgid / nig, fm = gid * WGM, gsz = (nM - fm) < WGM ? (nM - fm) : WGM;
        u.pm = fm + ((wgid % nig) % gsz); u.pn = (wgid % nig) / gsz; return true;
    }
    __device__ __forceinline__ void a_ready(const Unit&) const {}
    __device__ __forceinline__ void done(const Unit&) const {}
};

__device__ __forceinline__ unsigned cvt_pk_bf16(float lo, float hi) { unsigned r; asm volatile("v_cvt_pk_bf16_f32 %0, %1, %2" : "=v"(r) : "v"(lo), "v"(hi)); return r; }
typedef float f32x2 __attribute__((ext_vector_type(2)));
__device__ __forceinline__ f32x2 gelu_pk(f32x2 v) {
    const f32x2 av = __builtin_elementwise_abs(v), d = av * 0.2316418882f + 1.0f;
    f32x2 t; t.x = __builtin_amdgcn_rcpf(d.x); t.y = __builtin_amdgcn_rcpf(d.y);
    f32x2 q = t * 0.5307027145f + (-0.7265760135f); q = q * t + 0.7107068705f; q = q * t + (-0.142248368f); q = q * t + 0.127414796f; q = q * t;
    const f32x2 s = (v * v) * (-0.72134752044f);
    f32x2 e; e.x = __builtin_amdgcn_exp2f(s.x); e.y = __builtin_amdgcn_exp2f(s.y);
    const f32x2 m = v * (q * e), r = v - m;
    f32x2 o; o.x = v.x < 0.f ? m.x : r.x; o.y = v.y < 0.f ? m.y : r.y; return o;
}

template <int ACT  > struct EpiBf16 {
    static constexpr bool PERM = true, AFTER_DRAIN = false; static_assert(ACT == 0 || ACT == 1, "EpiBf16: ACT is 0 (none) or 1 (gelu_pk)");
    bf16_t* O; int ldc; const float* bias; int split_cols; size_t split_stride; float scale0;
    __device__ __forceinline__ void operator()(const f32x4 (&acc)[2][2][4][2], const Unit& u, int wr, int wc, int fr, int fq) const {
        const int row0 = u.pm * BM + wr * 64 + fr; int colt = u.pn * BM; bf16_t* base = O;
        float sc = 1.f; if (split_cols) { const int t = colt / split_cols; base += (size_t)t * split_stride; colt -= t * split_cols; if (t == 0) sc = scale0; }
        const int col0 = colt + wc * 32 + 8 * fq, bcol0 = u.pn * BM + wc * 32 + 8 * fq;
        f32x4 bv[2][2];
#pragma unroll
        for (int bj = 0; bj < 2; ++bj)
#pragma unroll
            for (int n = 0; n < 2; ++n) bv[bj][n] = bias ? *(const f32x4*)(bias + bcol0 + bj * HALF + 4 * n) : (f32x4){0.f, 0.f, 0.f, 0.f};
#pragma unroll
        for (int ai = 0; ai < 2; ++ai)
#pragma unroll
            for (int m = 0; m < 4; ++m) { bf16_t* rowp = base + (size_t)(row0 + ai * HALF + m * 16) * ldc + col0;
#pragma unroll
                for (int bj = 0; bj < 2; ++bj) { f32x4 v0 = acc[ai][bj][m][0] + bv[bj][0], v1 = acc[ai][bj][m][1] + bv[bj][1];
                    if (ACT == 1) { f32x2 a = gelu_pk((f32x2){v0[0], v0[1]}), b = gelu_pk((f32x2){v0[2], v0[3]}), c = gelu_pk((f32x2){v1[0], v1[1]}), d = gelu_pk((f32x2){v1[2], v1[3]});
                        v0 = (f32x4){a.x, a.y, b.x, b.y}; v1 = (f32x4){c.x, c.y, d.x, d.y}; }
                    v0 = v0 * sc; v1 = v1 * sc; u32x4 w; w.x = cvt_pk_bf16(v0[0], v0[1]); w.y = cvt_pk_bf16(v0[2], v0[3]); w.z = cvt_pk_bf16(v1[0], v1[1]); w.w = cvt_pk_bf16(v1[2], v1[3]);
                    *(u32x4*)(rowp + bj * HALF) = w; } }
    }
};
struct EpiHeadMajor {
    static constexpr bool PERM = true, AFTER_DRAIN = false;
    bf16_t* O; int Mrows; const float* rowsq; float inv_k, eps;
    __device__ __forceinline__ void operator()(const f32x4 (&acc)[2][2][4][2], const Unit& u, int wr, int wc, int fr, int fq) const {
        const int row0 = u.pm * BM + wr * 64 + fr, col0 = wc * 32 + 8 * fq;
#pragma unroll
        for (int ai = 0; ai < 2; ++ai) {
            f32x4 pa[4], pb[4];
#pragma unroll
            for (int m = 0; m < 4; ++m) { const f32x4* pp = (const f32x4*)(rowsq + (size_t)(row0 + ai * HALF + m * 16) * 32 + 8 * fq); pa[m] = pp[0]; pb[m] = pp[1]; }
#pragma unroll
            for (int m = 0; m < 4; ++m) { const int row = row0 + ai * HALF + m * 16; const f32x4 a = pa[m], b = pb[m];
                float sq = ((a[0] + a[1]) + (a[2] + a[3])) + ((b[0] + b[1]) + (b[2] + b[3])); sq += __shfl_xor(sq, 16); sq += __shfl_xor(sq, 32);
                const float rs = 1.0f / sqrtf(sq * inv_k + eps);
#pragma unroll
                for (int bj = 0; bj < 2; ++bj) { const f32x4 v0 = acc[ai][bj][m][0] * rs, v1 = acc[ai][bj][m][1] * rs;
                    u32x4 w; w.x = cvt_pk_bf16(v0[0], v0[1]); w.y = cvt_pk_bf16(v0[2], v0[3]); w.z = cvt_pk_bf16(v1[0], v1[1]); w.w = cvt_pk_bf16(v1[2], v1[3]);
                    *(u32x4*)(O + ((size_t)(u.pn * 2 + bj) * Mrows + row) * HALF + col0) = w; } }
            asm volatile("" ::: "memory"); }
    }
};
struct EpiResF32 {
    static constexpr bool PERM = true, AFTER_DRAIN = false;
    bf16_t* xb; float* rowsq; int ldc;
    __device__ __forceinline__ void operator()(const f32x4 (&acc)[2][2][4][2], const Unit& u, int wr, int wc, int fr, int fq) const {
        const int col0 = u.pn * BM + wc * 32 + 8 * fq;
#pragma unroll
        for (int ai = 0; ai < 2; ++ai) {
            u32x4 pre[4][2];
#pragma unroll
            for (int m = 0; m < 4; ++m) { const size_t off = (size_t)(u.pm * BM + ai * HALF + wr * 64 + m * 16 + fr) * ldc + col0;
#pragma unroll
                for (int bj = 0; bj < 2; ++bj) pre[m][bj] = *(const u32x4*)(xb + off + bj * HALF); }
            asm volatile("" ::: "memory");
#pragma unroll
            for (int m = 0; m < 4; ++m) { const int row = u.pm * BM + ai * HALF + wr * 64 + m * 16 + fr; const size_t off = (size_t)row * ldc + col0; float ss = 0.f;
#pragma unroll
                for (int bj = 0; bj < 2; ++bj) { const u32x4 pb = pre[m][bj]; const f32x4 a0 = acc[ai][bj][m][0], a1 = acc[ai][bj][m][1];
                    u32x4 w; w.x = cvt_pk_bf16(__uint_as_float(pb.x << 16) + a0[0], __uint_as_float(pb.x & 0xffff0000u) + a0[1]); w.y = cvt_pk_bf16(__uint_as_float(pb.y << 16) + a0[2], __uint_as_float(pb.y & 0xffff0000u) + a0[3]);
                    w.z = cvt_pk_bf16(__uint_as_float(pb.z << 16) + a1[0], __uint_as_float(pb.z & 0xffff0000u) + a1[1]); w.w = cvt_pk_bf16(__uint_as_float(pb.w << 16) + a1[2], __uint_as_float(pb.w & 0xffff0000u) + a1[3]);
#pragma unroll
                    for (int q = 0; q < 4; ++q) { const float r0 = __uint_as_float(w[q] << 16), r1 = __uint_as_float(w[q] & 0xffff0000u); ss += r0 * r0 + r1 * r1; }
                    *(u32x4*)(xb + off + bj * HALF) = w; }
                ss += __shfl_xor(ss, 16); ss += __shfl_xor(ss, 32);
                if (fq == 0) rowsq[(size_t)row * 32 + u.pn * 4 + wc] = ss; }
            asm volatile("" ::: "memory"); }
    }
};


template <class Epi, class Sched, bool ALIGN_EPI = false, bool SP2 = false>
__device__ __forceinline__ void gemm_phase(PG8_LAS unsigned char* lds, const Gemm g, const Sched& S, const Epi& E) {
    const int tid = otid(), wid = __builtin_amdgcn_readfirstlane(tid >> 6), lane = tid & 63, wr = wid >> 2, wc = wid & 3, fr = lane & 15, fq = lane >> 4;
    const int K = g.K, nt = K / BK;
    unsigned voffA[2], voffB[2];
#pragma unroll
    for (int i = 0; i < 2; ++i) { int R, C; stage_rc(tid * 16 + i * 8192, R, C); const int Rb = Epi::PERM ? ((R & ~31) + perm32(R & 31)) : R;
        voffA[i] = (unsigned)(R * K + C) * 2u; voffB[i] = (unsigned)(Rb * K + C) * 2u; }
    const size_t kstep = (size_t)(BK * 2);
    const size_t hstep = (size_t)HALF * K * 2;
    const size_t tstep = 2 * hstep;
    const unsigned ldsw = (unsigned)wid * 1024u;
    const int aoff = lds_byte(wr * 64 + fr, fq * 8), boff = lds_byte(wc * 32 + fr, fq * 8);
#define PG8_SA(b, h) (((b) * 2 + (h)) * HTB)
#define PG8_SB(b, h) ((4 + (b) * 2 + (h)) * HTB)
#define PG8_STAGE(bufoff, gbase, voff) do { _Pragma("unroll") for (int _i = 0; _i < 2; ++_i) \
        __builtin_amdgcn_global_load_lds((const unsigned*)((const char*)(gbase) + (voff)[_i]), (PG8_LAS unsigned*)(lds + (bufoff) + ldsw + _i * 8192), 16, 0, 0); } while (0)
#define PG8_LDA(dst, b, h) do { _Pragma("unroll") for (int m = 0; m < 4; ++m) _Pragma("unroll") for (int k = 0; k < 2; ++k) dst[m][k] = *(const PG8_LAS bf16x8*)(lds + PG8_SA(b, h) + aoff + m * 2048 + k * 1024); } while (0)
#define PG8_LDB(dst, b, h) do { _Pragma("unroll") for (int n = 0; n < 2; ++n) _Pragma("unroll") for (int k = 0; k < 2; ++k) dst[n][k] = *(const PG8_LAS bf16x8*)(lds + PG8_SB(b, h) + boff + n * 2048 + k * 1024); } while (0)
#define PG8_MMA(ai, bj, At, Bt) do { __builtin_amdgcn_s_setprio(1); _Pragma("unroll") for (int m = 0; m < 4; ++m) _Pragma("unroll") for (int n = 0; n < 2; ++n) _Pragma("unroll") for (int k = 0; k < 2; ++k) \
        acc[ai][bj][m][n] = __builtin_amdgcn_mfma_f32_16x16x32_bf16(Bt[n][k], At[m][k], acc[ai][bj][m][n], 0, 0, 0); __builtin_amdgcn_s_setprio(0); } while (0)
#define PG8_WAIT_V(n) asm volatile("s_waitcnt vmcnt(" #n ")" ::: "memory")
#define PG8_WAIT_L(n) asm volatile("s_waitcnt lgkmcnt(" #n ")" ::: "memory")
#define PG8_BAR __builtin_amdgcn_s_barrier()
#define PG8_SCHED __builtin_amdgcn_sched_barrier(0)
    Unit cur, nxt; int ui = 0;
    if (!S.next(0, cur)) return;
    f32x4 acc[2][2][4][2];
#pragma unroll
    for (int a = 0; a < 2; ++a)
#pragma unroll
        for (int b = 0; b < 2; ++b)
#pragma unroll
            for (int m = 0; m < 4; ++m)
#pragma unroll
                for (int n = 0; n < 2; ++n) acc[a][b][m][n] = (f32x4){0.f, 0.f, 0.f, 0.f};
    bf16x8 At[4][2], B0[2][2], B1[2][2];
    const char* cA = (const char*)g.A + (size_t)cur.pm * tstep; const char* cB = (const char*)g.Bt + (size_t)cur.pn * tstep;
    S.a_ready(cur);
    if constexpr (SP2) {
        PG8_STAGE(PG8_SB(0, 0), cB, voffB); PG8_STAGE(PG8_SB(0, 1), cB + hstep, voffB); PG8_STAGE(PG8_SA(0, 0), cA, voffA); PG8_STAGE(PG8_SA(0, 1), cA + hstep, voffA);
        if (wr == 1) PG8_BAR;
        PG8_WAIT_V(2); PG8_BAR;
        PG8_STAGE(PG8_SB(1, 0), cB + kstep, voffB); PG8_STAGE(PG8_SA(1, 0), cA + kstep, voffA); PG8_STAGE(PG8_SB(1, 1), cB + hstep + kstep, voffB);
        PG8_WAIT_V(6); PG8_BAR;
    } else {
        PG8_STAGE(PG8_SB(0, 0), cB, voffB); PG8_STAGE(PG8_SA(0, 0), cA, voffA); PG8_STAGE(PG8_SB(0, 1), cB + hstep, voffB); PG8_STAGE(PG8_SA(0, 1), cA + hstep, voffA);
        if (wr == 1) PG8_BAR;
        PG8_WAIT_V(4); PG8_BAR;
        PG8_STAGE(PG8_SB(1, 0), cB + kstep, voffB); PG8_STAGE(PG8_SA(1, 0), cA + kstep, voffA); PG8_STAGE(PG8_SB(1, 1), cB + hstep + kstep, voffB);
        PG8_WAIT_V(6); PG8_BAR;
    }
    for (;;) {
        const bool has_next = S.next(ui + 1, nxt);
        const char* nA = has_next ? (const char*)g.A + (size_t)nxt.pm * tstep : cA; const char* nB = has_next ? (const char*)g.Bt + (size_t)nxt.pn * tstep : cB;
        for (int t = 0; t < nt; t += 2) {
            const bool last = (t == nt - 2);
            const char* a1 = cA + (size_t)(t + 1) * kstep;
            const char* a2 = last ? nA : cA + (size_t)(t + 2) * kstep; const char* b2 = last ? nB : cB + (size_t)(t + 2) * kstep;
            const char* a3 = a2 + kstep; const char* b3 = b2 + kstep;
            if (last && has_next) S.a_ready(nxt);
            if constexpr (SP2) {
            PG8_LDB(B0, 0, 0); PG8_LDB(B1, 0, 1); PG8_SCHED; PG8_LDA(At, 0, 0); PG8_STAGE(PG8_SA(1, 1), a1 + hstep, voffA);
            PG8_WAIT_V(8); PG8_WAIT_L(0); PG8_BAR; PG8_MMA(0, 0, At, B0); PG8_MMA(0, 1, At, B1); PG8_BAR; PG8_SCHED;
            PG8_LDA(At, 0, 1); PG8_STAGE(PG8_SB(0, 0), b2, voffB); PG8_STAGE(PG8_SB(0, 1), b2 + hstep, voffB); PG8_STAGE(PG8_SA(0, 0), a2, voffA);
            PG8_WAIT_V(8); PG8_WAIT_L(0); PG8_BAR; PG8_MMA(1, 0, At, B0); PG8_MMA(1, 1, At, B1); PG8_BAR; PG8_SCHED;
            PG8_LDB(B0, 1, 0); PG8_LDB(B1, 1, 1); PG8_SCHED; PG8_LDA(At, 1, 0); PG8_STAGE(PG8_SA(0, 1), a2 + hstep, voffA);
            PG8_WAIT_V(8); PG8_WAIT_L(0); PG8_BAR; PG8_MMA(0, 0, At, B0); PG8_MMA(0, 1, At, B1); PG8_BAR; PG8_SCHED;
            PG8_LDA(At, 1, 1); PG8_STAGE(PG8_SB(1, 0), b3, voffB); PG8_STAGE(PG8_SB(1, 1), b3 + hstep, voffB); PG8_STAGE(PG8_SA(1, 0), a3, voffA);
            PG8_WAIT_V(8); PG8_WAIT_L(0); PG8_BAR; PG8_MMA(1, 0, At, B0); PG8_MMA(1, 1, At, B1); PG8_BAR; PG8_SCHED;
            } else {
            PG8_LDB(B0, 0, 0); PG8_SCHED; PG8_LDA(At, 0, 0); PG8_STAGE(PG8_SA(1, 1), a1 + hstep, voffA);
            PG8_WAIT_L(8); PG8_BAR; PG8_WAIT_L(0); PG8_MMA(0, 0, At, B0); PG8_BAR; PG8_SCHED;
            PG8_LDB(B1, 0, 1); PG8_STAGE(PG8_SB(0, 0), b2, voffB);
            PG8_BAR; PG8_WAIT_L(0); PG8_MMA(0, 1, At, B1); PG8_BAR;
            PG8_LDA(At, 0, 1); PG8_STAGE(PG8_SA(0, 0), a2, voffA);
            PG8_BAR; PG8_WAIT_L(0); PG8_MMA(1, 0, At, B0); PG8_BAR; PG8_SCHED;
            PG8_STAGE(PG8_SB(0, 1), b2 + hstep, voffB);
            PG8_WAIT_V(6); PG8_BAR; PG8_MMA(1, 1, At, B1); PG8_BAR;
            PG8_LDB(B0, 1, 0); PG8_SCHED; PG8_LDA(At, 1, 0); PG8_STAGE(PG8_SA(0, 1), a2 + hstep, voffA);
            PG8_WAIT_L(8); PG8_BAR; PG8_WAIT_L(0); PG8_MMA(0, 0, At, B0); PG8_BAR; PG8_SCHED;
            PG8_LDB(B1, 1, 1); PG8_STAGE(PG8_SB(1, 0), b3, voffB);
            PG8_BAR; PG8_WAIT_L(0); PG8_MMA(0, 1, At, B1); PG8_BAR;
            PG8_LDA(At, 1, 1); PG8_STAGE(PG8_SA(1, 0), a3, voffA);
            PG8_BAR; PG8_WAIT_L(0); PG8_MMA(1, 0, At, B0); PG8_BAR; PG8_SCHED;
            PG8_STAGE(PG8_SB(1, 1), b3 + hstep, voffB);
            PG8_WAIT_V(6); PG8_BAR; PG8_MMA(1, 1, At, B1); PG8_BAR;
            }
        }
        if constexpr (ALIGN_EPI) { if (wr == 0) PG8_BAR; }
        if constexpr (!Epi::AFTER_DRAIN) { E(acc, cur, wr, wc, fr, fq); S.done(cur); }
        if (!has_next) break;
#pragma unroll
        for (int a = 0; a < 2; ++a)
#pragma unroll
            for (int b = 0; b < 2; ++b)
#pragma unroll
                for (int m = 0; m < 4; ++m)
#pragma unroll
                    for (int n = 0; n < 2; ++n) acc[a][b][m][n] = (f32x4){0.f, 0.f, 0.f, 0.f};
        cur = nxt; cA = nA; cB = nB; ++ui;
        if constexpr (ALIGN_EPI) { if (wr == 1) PG8_BAR; }
    }
    PG8_WAIT_V(0);
    if constexpr (!ALIGN_EPI) { if (wr == 0) PG8_BAR; }
    PG8_BAR;
    if constexpr (Epi::AFTER_DRAIN) { E.fused(acc, cur, wr, wc, fr, fq, lds, wid, lane); S.done(cur); }
#undef PG8_SA
#undef PG8_SB
#undef PG8_STAGE
#undef PG8_LDA
#undef PG8_LDB
#undef PG8_MMA
#undef PG8_WAIT_V
#undef PG8_WAIT_L
#undef PG8_BAR
#undef PG8_SCHED
}
}
#define PG8_SP2 true
#define PG8_ALIGN true
namespace att {
using bf16 = __hip_bfloat16;
constexpr int D = 128, NW = 8, QBLK = 32, KVBLK = 64;
constexpr float SCALE = 0.088388347648318440f;
constexpr float THR = 8.f;
constexpr size_t SHM_V = KVBLK * D * 2, SHM_K = KVBLK * D * 2, SHM_ATTN = 2 * SHM_V + 2 * SHM_K + NW * 64 * 4;
using bf16x8 = __attribute__((ext_vector_type(8))) short;
using s16x4  = __attribute__((ext_vector_type(4))) short;
using f32x16 = __attribute__((ext_vector_type(16))) float;
using f32x8  = __attribute__((ext_vector_type(8))) float;
using u32x4  = __attribute__((ext_vector_type(4))) unsigned;
#define KSWZ(row, colB) ((row) * 256 + ((colB) ^ (((row) & 7) << 4)))
#define SBAR() __builtin_amdgcn_sched_barrier(0)
__device__ __forceinline__ int crow(int r, int hi) { return (r & 3) + 8 * (r >> 2) + 4 * hi; }
__device__ __forceinline__ unsigned cvtpk(float lo, float hi) {
  unsigned r; asm("v_cvt_pk_bf16_f32 %0, %1, %2" : "=v"(r) : "v"(lo), "v"(hi)); return r;
}
template <typename TIn> struct Stage;
template <> struct Stage<bf16>  { using T = bf16x8;
  __device__ static __forceinline__ T ld8(const bf16* p) { return *reinterpret_cast<const bf16x8*>(p); }
  __device__ static __forceinline__ bf16x8 tobf(T x) { return x; } };
template <> struct Stage<float> { using T = f32x8;
  __device__ static __forceinline__ T ld8(const float* p) { return *reinterpret_cast<const f32x8*>(p); }
  __device__ static __forceinline__ bf16x8 tobf(T x) {
    u32x4 w = {cvtpk(x[0], x[1]), cvtpk(x[2], x[3]), cvtpk(x[4], x[5]), cvtpk(x[6], x[7])}; return *reinterpret_cast<bf16x8*>(&w); } };

__device__ __forceinline__ void partialSM(f32x16& p0, f32x16& p1, float& m_reg, float& mn, float& alpha) {
  constexpr float C = SCALE * 1.4426950408889634f;
  float pmax = p0[0]; for (int r = 1; r < 16; ++r) pmax = fmaxf(pmax, p0[r]); for (int r = 0; r < 16; ++r) pmax = fmaxf(pmax, p1[r]);
  { auto rr = __builtin_amdgcn_permlane32_swap(__float_as_uint(pmax), __float_as_uint(pmax), false, false);
    pmax = fmaxf(__uint_as_float(rr[0]), __uint_as_float(rr[1])); }
  if (__builtin_expect(__all(pmax - m_reg <= THR / SCALE), 1)) { mn = m_reg; alpha = 1.f; }
  else { mn = fmaxf(m_reg, pmax); alpha = __builtin_amdgcn_exp2f((m_reg - mn) * C); m_reg = mn; }
  float mnC = -mn * C;
  for (int r = 0; r < 16; ++r) p0[r] = fmaf(p0[r], C, mnC); for (int r = 0; r < 16; ++r) p1[r] = fmaf(p1[r], C, mnC);
  for (int r = 0; r < 16; ++r) p0[r] = __builtin_amdgcn_exp2f(p0[r]);
}
__device__ __forceinline__ void finishSM(f32x16& p0, f32x16& p1, float alpha, float& l_reg, bf16x8& pa0, bf16x8& pa1, bf16x8& pa2, bf16x8& pa3) {
  for (int r = 0; r < 16; ++r) p1[r] = __builtin_amdgcn_exp2f(p1[r]);
  float ps = 0; for (int r = 0; r < 16; ++r) ps += p0[r]; for (int r = 0; r < 16; ++r) ps += p1[r];
  { auto rr = __builtin_amdgcn_permlane32_swap(__float_as_uint(ps), __float_as_uint(ps), false, false);
    ps = __uint_as_float(rr[0]) + __uint_as_float(rr[1]); }
  l_reg = l_reg * alpha + ps;
#define PK4(P, BASE, OUT) do { unsigned a0 = cvtpk(P[BASE + 0], P[BASE + 1]), a1 = cvtpk(P[BASE + 2], P[BASE + 3]);   \
    unsigned b0 = cvtpk(P[BASE + 4], P[BASE + 5]), b1 = cvtpk(P[BASE + 6], P[BASE + 7]);                              \
    u32x4 w = {a0, a1, b0, b1}; OUT = *reinterpret_cast<bf16x8*>(&w); } while (0)
  PK4(p0, 0, pa0); PK4(p0, 8, pa1); PK4(p1, 0, pa2); PK4(p1, 8, pa3);
#undef PK4
}
__device__ __forceinline__ void qkt(f32x16& p0, f32x16& p1, const bf16* Ks, const bf16x8* qr, int r32, int hi) {
  p0 = f32x16{}; p1 = f32x16{};
  for (int d0 = 0; d0 < 8; ++d0) { int cb = (d0 * 16 + hi * 8) * 2;
    bf16x8 b0 = *reinterpret_cast<const bf16x8*>((const char*)Ks + KSWZ(r32, cb));
    bf16x8 b1 = *reinterpret_cast<const bf16x8*>((const char*)Ks + KSWZ(32 + r32, cb));
    p0 = __builtin_amdgcn_mfma_f32_32x32x16_bf16(b0, qr[d0], p0, 0, 0, 0);
    p1 = __builtin_amdgcn_mfma_f32_32x32x16_bf16(b1, qr[d0], p1, 0, 0, 0); }
}
__device__ __forceinline__ int v_st(int k, int c) { const int kk = (k & ~0xC) | ((k & 4) << 1) | ((k & 8) >> 1); return ((kk >> 3) * 4 + (c >> 5)) * 512 + ((kk & 7) * 32 + (c & 31)) * 2; }
__device__ __forceinline__ int v_rd_base(int lane) { return ((lane & 3) << 3) | (((lane >> 2) & 3) << 6) | (((lane >> 4) & 1) << 5) | (((lane >> 5) & 1) << 8); }
constexpr int v_rd_off(int d0, int ks, int half) { return d0 * 512 + ks * 4096 + half * 2048; }
template <int OFF> __device__ __forceinline__ s16x4 tr_read(int vb) {
  s16x4 r; asm volatile("ds_read_b64_tr_b16 %0, %1 offset:%2" : "=&v"(r) : "v"(vb), "i"(OFF) : "memory"); return r;
}
template <int D0> __device__ __forceinline__ void pv_one(f32x16& od, int vb, bf16x8 pa0, bf16x8 pa1, bf16x8 pa2, bf16x8 pa3) {
  const s16x4 l0 = tr_read<v_rd_off(D0, 0, 0)>(vb), h0 = tr_read<v_rd_off(D0, 0, 1)>(vb), l1 = tr_read<v_rd_off(D0, 1, 0)>(vb), h1 = tr_read<v_rd_off(D0, 1, 1)>(vb);
  const s16x4 l2 = tr_read<v_rd_off(D0, 2, 0)>(vb), h2 = tr_read<v_rd_off(D0, 2, 1)>(vb), l3 = tr_read<v_rd_off(D0, 3, 0)>(vb), h3 = tr_read<v_rd_off(D0, 3, 1)>(vb);
  asm volatile("s_waitcnt lgkmcnt(0)" ::: "memory"); SBAR();
#define PK(L, H) (bf16x8){L[0], L[1], L[2], L[3], H[0], H[1], H[2], H[3]}
  od = __builtin_amdgcn_mfma_f32_32x32x16_bf16(pa0, PK(l0, h0), od, 0, 0, 0);
  od = __builtin_amdgcn_mfma_f32_32x32x16_bf16(pa1, PK(l1, h1), od, 0, 0, 0);
  od = __builtin_amdgcn_mfma_f32_32x32x16_bf16(pa2, PK(l2, h2), od, 0, 0, 0);
  od = __builtin_amdgcn_mfma_f32_32x32x16_bf16(pa3, PK(l3, h3), od, 0, 0, 0);
#undef PK
}
struct VFrag { s16x4 l0, h0, l1, h1, l2, h2, l3, h3; };
template <int D0> __device__ __forceinline__ void pv_rd(VFrag& f, int vb) {
  f.l0 = tr_read<v_rd_off(D0, 0, 0)>(vb); f.h0 = tr_read<v_rd_off(D0, 0, 1)>(vb); f.l1 = tr_read<v_rd_off(D0, 1, 0)>(vb); f.h1 = tr_read<v_rd_off(D0, 1, 1)>(vb);
  f.l2 = tr_read<v_rd_off(D0, 2, 0)>(vb); f.h2 = tr_read<v_rd_off(D0, 2, 1)>(vb); f.l3 = tr_read<v_rd_off(D0, 3, 0)>(vb); f.h3 = tr_read<v_rd_off(D0, 3, 1)>(vb);
}
__device__ __forceinline__ void pv_mm(f32x16& od, const VFrag& f, bf16x8 pa0, bf16x8 pa1, bf16x8 pa2, bf16x8 pa3) {
#define PK(L, H) (bf16x8){L[0], L[1], L[2], L[3], H[0], H[1], H[2], H[3]}
  od = __builtin_amdgcn_mfma_f32_32x32x16_bf16(pa0, PK(f.l0, f.h0), od, 0, 0, 0);
  od = __builtin_amdgcn_mfma_f32_32x32x16_bf16(pa1, PK(f.l1, f.h1), od, 0, 0, 0);
  od = __builtin_amdgcn_mfma_f32_32x32x16_bf16(pa2, PK(f.l2, f.h2), od, 0, 0, 0);
  od = __builtin_amdgcn_mfma_f32_32x32x16_bf16(pa3, PK(f.l3, f.h3), od, 0, 0, 0);
#undef PK
}
#define PV_WAIT(n) do { asm volatile("s_waitcnt lgkmcnt(" #n ")" ::: "memory"); SBAR(); } while (0)
__device__ __forceinline__ void pv_d0(f32x16* o, int vb, bf16x8 pa0, bf16x8 pa1, bf16x8 pa2, bf16x8 pa3) {
#if MK_PVPIPE
  VFrag fa, fb;
  pv_rd<0>(fa, vb); pv_rd<1>(fb, vb);
  PV_WAIT(8); pv_mm(o[0], fa, pa0, pa1, pa2, pa3); SBAR();
  pv_rd<2>(fa, vb);
  PV_WAIT(8); pv_mm(o[1], fb, pa0, pa1, pa2, pa3); SBAR();
  pv_rd<3>(fb, vb);
  PV_WAIT(8); pv_mm(o[2], fa, pa0, pa1, pa2, pa3); SBAR();
  PV_WAIT(0); pv_mm(o[3], fb, pa0, pa1, pa2, pa3);
#else
  pv_one<0>(o[0], vb, pa0, pa1, pa2, pa3); pv_one<1>(o[1], vb, pa0, pa1, pa2, pa3); pv_one<2>(o[2], vb, pa0, pa1, pa2, pa3); pv_one<3>(o[3], vb, pa0, pa1, pa2, pa3);
#endif
}
constexpr int crow0(int r) { return (r & 3) + 8 * (r >> 2); }
constexpr float LOG2E = 1.4426950408889634f;
__device__ __forceinline__ void partialSM_neg(f32x16& p0, f32x16& p1, float& m_reg, f32x16& negm, float& alpha, int bounded) {
  if (bounded) {
    alpha = 1.f;
#pragma unroll
    for (int r = 0; r < 16; ++r) p0[r] = __builtin_amdgcn_exp2f(p0[r]);
    return;
  }
  float pmax = p0[0];
#pragma unroll
  for (int r = 1; r < 16; ++r) pmax = fmaxf(pmax, p0[r]);
#pragma unroll
  for (int r = 0; r < 16; ++r) pmax = fmaxf(pmax, p1[r]);
  { auto rr = __builtin_amdgcn_permlane32_swap(__float_as_uint(pmax), __float_as_uint(pmax), false, false);
    pmax = fmaxf(__uint_as_float(rr[0]), __uint_as_float(rr[1])); }
  if (__builtin_expect(__all(pmax <= THR), 1)) { alpha = 1.f; }
  else { const float dl = fmaxf(pmax, 0.f); m_reg += dl; alpha = __builtin_amdgcn_exp2f(-dl);
#pragma unroll
    for (int r = 0; r < 16; ++r) { p0[r] -= dl; p1[r] -= dl; negm[r] = -m_reg; } }
#pragma unroll
  for (int r = 0; r < 16; ++r) p0[r] = __builtin_amdgcn_exp2f(p0[r]);
}
__device__ __forceinline__ void partialSM_dil(f32x16& p0, f32x16& p1, float& m_reg, float& mn, float& alpha, float dq, float dlo, float dhi, float nslopeC) {
  constexpr float C = SCALE * LOG2E;
#pragma unroll
  for (int r = 0; r < 16; ++r) {
    const float d0 = dq + (float)crow0(r), d1 = d0 + 32.f;
    const float t0 = fmaf(p0[r], C, nslopeC * fabsf(d0)), t1 = fmaf(p1[r], C, nslopeC * fabsf(d1));
    p0[r] = (d0 >= dlo && d0 <= dhi) ? t0 : -1e30f;
    p1[r] = (d1 >= dlo && d1 <= dhi) ? t1 : -1e30f;
  }
  float pmax = p0[0];
#pragma unroll
  for (int r = 1; r < 16; ++r) pmax = fmaxf(pmax, p0[r]);
#pragma unroll
  for (int r = 0; r < 16; ++r) pmax = fmaxf(pmax, p1[r]);
  { auto rr = __builtin_amdgcn_permlane32_swap(__float_as_uint(pmax), __float_as_uint(pmax), false, false);
    pmax = fmaxf(__uint_as_float(rr[0]), __uint_as_float(rr[1])); }
  if (__builtin_expect(__all(pmax - m_reg <= THR * LOG2E), 1)) { mn = m_reg; alpha = 1.f; }
  else { mn = fmaxf(m_reg, pmax); alpha = __builtin_amdgcn_exp2f(m_reg - mn); m_reg = mn; }
#pragma unroll
  for (int r = 0; r < 16; ++r) { p0[r] = p0[r] - mn; p1[r] = p1[r] - mn; }
#pragma unroll
  for (int r = 0; r < 16; ++r) p0[r] = __builtin_amdgcn_exp2f(p0[r]);
}

template <bool DIL>
__device__ __forceinline__ void attn_body(const bf16* __restrict__ Qb, const bf16* __restrict__ Kh, const bf16* __restrict__ Vh, long qs, long ks,
                                          bf16* __restrict__ Ob, long os, float* __restrict__ lse_o, int lse_s, int i0, int nsub, float nslopeC, int seq, char* lds) {
  typedef __attribute__((address_space(3))) unsigned lds_u32;
  using St = Stage<bf16>;
  const int tid = otid(), wid = __builtin_amdgcn_readfirstlane(tid >> 6), lane = tid & 63, r32 = lane & 31, hi = lane >> 5;
  char* V_lds = lds + 4 * SHM_K; char* K_lds = lds;
  float* ws = (float*)(lds + 4 * SHM_K + 4 * SHM_V) + wid * 64; float* li_l = ws; float* al_l = ws + 32;
  float m_reg = -1e30f, l_reg = 0; f32x16 o[4] = {}; bf16x8 qr[8];
  const bf16* Qw = Qb + (long)(wid * QBLK + r32) * qs + hi * 8;
#pragma unroll
  for (int d0 = 0; d0 < 8; ++d0) qr[d0] = St::ld8(Qw + d0 * 16);
  const int vb0 = (int)(uintptr_t)V_lds + v_rd_base(lane);
  const int kb = DIL ? i0 - 64 : 0;
#define KROW(k) (DIL ? (long)min(max(kb + (k), 0), nsub - 1) : (long)(k))
  int krow[2], kcol[2], vrow[2], vcol[2];
#pragma unroll
  for (int i = 0; i < 2; ++i) { const int pc = 2 * wid + i;
    krow[i] = pc * 4 + (lane >> 4); kcol[i] = (((lane & 15) ^ (krow[i] & 7)) << 3);
    const int sub = pc * 2 + (lane >> 5), kk = ((sub >> 2) << 3) + ((lane & 31) >> 2);
    vrow[i] = kk; vcol[i] = ((sub & 3) << 5) + ((lane & 3) << 3); }
  unsigned kdo[2], vdo[2];
#pragma unroll
  for (int i = 0; i < 2; ++i) { kdo[i] = (unsigned)(krow[i] * (int)ks + kcol[i]); vdo[i] = (unsigned)(vrow[i] * (int)ks + vcol[i]); }
#define DMA(t, buf) do { if constexpr (DIL) { _Pragma("unroll") for (int i_ = 0; i_ < 2; ++i_) { \
      __builtin_amdgcn_global_load_lds((const unsigned*)(Kh + KROW((t) * KVBLK + krow[i_]) * ks + kcol[i_]), (lds_u32*)(K_lds + (buf) * SHM_K + (2 * wid + i_) * 1024), 16, 0, 0); \
      __builtin_amdgcn_global_load_lds((const unsigned*)(Vh + KROW((t) * KVBLK + vrow[i_]) * ks + vcol[i_]), (lds_u32*)(V_lds + (buf) * SHM_V + (2 * wid + i_) * 1024), 16, 0, 0); } } \
    else { const bf16* Kt_ = Kh + (long)(t) * (KVBLK * ks); const bf16* Vt_ = Vh + (long)(t) * (KVBLK * ks); _Pragma("unroll") for (int i_ = 0; i_ < 2; ++i_) { \
      __builtin_amdgcn_global_load_lds((const unsigned*)(Kt_ + kdo[i_]), (lds_u32*)(K_lds + (buf) * SHM_K + (2 * wid + i_) * 1024), 16, 0, 0); \
      __builtin_amdgcn_global_load_lds((const unsigned*)(Vt_ + vdo[i_]), (lds_u32*)(V_lds + (buf) * SHM_V + (2 * wid + i_) * 1024), 16, 0, 0); } } } while (0)
#define ENDSTEP(j) do { if ((j) + 2 < NT) asm volatile("s_waitcnt vmcnt(4) lgkmcnt(0)\n\ts_barrier" ::: "memory"); else asm volatile("s_waitcnt vmcnt(0) lgkmcnt(0)\n\ts_barrier" ::: "memory"); } while (0)
#define RESC(a) do { if (__any((a) < 1.f)) { if (hi == 0) al_l[r32] = (a); asm volatile("s_waitcnt lgkmcnt(0)" ::: "memory"); \
    for (int d = 0; d < 4; ++d) for (int r = 0; r < 16; ++r) o[d][r] *= al_l[crow(r, hi)]; } } while (0)
#define PSM(P0, P1, MN, AL, jt) do { if constexpr (DIL) { const int t_ = otid(), iq_ = (t_ >> 6) * QBLK + (t_ & 31), hi_ = (t_ >> 5) & 1; \
      partialSM_dil(P0, P1, m_reg, MN, AL, (float)(-64 - iq_ + 4 * hi_ + 64 * (jt)), fmaxf(-64.f, (float)(-(i0 + iq_))), fminf(64.f, (float)(nsub - 1 - (i0 + iq_))), nslopeC); } \
    else partialSM(P0, P1, m_reg, MN, AL); } while (0)
#if MK_SGB
#define SGB_A() do { __builtin_amdgcn_sched_group_barrier(0x100, 4, 0); \
    _Pragma("unroll") for (int g_ = 0; g_ < 12; ++g_) { __builtin_amdgcn_sched_group_barrier(0x008, 1, 0); __builtin_amdgcn_sched_group_barrier(0x100, 1, 0); __builtin_amdgcn_sched_group_barrier(0x002, 6, 0); } \
    _Pragma("unroll") for (int g_ = 0; g_ < 4; ++g_) { __builtin_amdgcn_sched_group_barrier(0x008, 1, 0); __builtin_amdgcn_sched_group_barrier(0x002, 6, 0); } } while (0)
#else
#define SGB_A() do {} while (0)
#endif
#define KBUF(j) ((const bf16*)(K_lds + ((j) & 3) * SHM_K))
#define VBUF(j) (vb0 + ((j) & 3) * (int)SHM_V)
  f32x16 pA0, pA1, pB0, pB1; float mnA, mnB, alA, alB; bf16x8 pa0, pa1, pa2, pa3; const int NT = DIL ? 6 : seq / KVBLK;
  DMA(0, 0); DMA(1, 1);
  if constexpr (!DIL && MK_PP) { DMA(2, 2); asm volatile("s_waitcnt vmcnt(8)\n\ts_barrier" ::: "memory"); }
  else asm volatile("s_waitcnt vmcnt(4)\n\ts_barrier" ::: "memory");
  struct KFrag { bf16x8 a, b; };
  int koff[4];
#pragma unroll
  for (int d0 = 0; d0 < 4; ++d0) koff[d0] = KSWZ(r32, (d0 * 16 + hi * 8) * 2);
  const int kbase0 = (int)(uintptr_t)K_lds;
#define KRD(f, d0, kb) asm volatile("ds_read_b128 %0, %2 offset:%3\n\tds_read_b128 %1, %2 offset:%4" : "=&v"(f.a), "=&v"(f.b) : "v"((kb) + koff[(d0) & 3]), "i"(((d0) >> 2) * 128), "i"(((d0) >> 2) * 128 + 8192) : "memory")
#define QMM(f, d0) do { pA0 = __builtin_amdgcn_mfma_f32_32x32x16_bf16(f.a, qr[d0], pA0, 0, 0, 0); pA1 = __builtin_amdgcn_mfma_f32_32x32x16_bf16(f.b, qr[d0], pA1, 0, 0, 0); } while (0)
#define LW(n) do { asm volatile("s_waitcnt lgkmcnt(" #n ")" ::: "memory"); SBAR(); } while (0)
  if constexpr (DIL) {
    const int rlo = wid >> 1;
    for (int j = 0; j < NT; ++j) {
      if (j + 2 < NT) DMA(j + 2, (j + 2) & 3);
      if (j >= rlo && j <= rlo + 2) {
        SBAR();
        { const int kb_ = kbase0 + (j & 3) * (int)SHM_K; KFrag k0_, k1_, k2_;
          KRD(k0_, 0, kb_); KRD(k1_, 1, kb_); KRD(k2_, 2, kb_); pA0 = f32x16{}; pA1 = f32x16{};
          LW(4); QMM(k0_, 0); SBAR(); KRD(k0_, 3, kb_);
          LW(4); QMM(k1_, 1); SBAR(); KRD(k1_, 4, kb_);
          LW(4); QMM(k2_, 2); SBAR(); KRD(k2_, 5, kb_);
          LW(4); QMM(k0_, 3); SBAR(); KRD(k0_, 6, kb_);
          LW(4); QMM(k1_, 4); SBAR(); KRD(k1_, 7, kb_);
          LW(4); QMM(k2_, 5); SBAR();
          LW(2); QMM(k0_, 6); SBAR();
          LW(0); QMM(k1_, 7); SBAR(); }
        PSM(pA0, pA1, mnA, alA, j); RESC(alA);
        finishSM(pA0, pA1, alA, l_reg, pa0, pa1, pa2, pa3); SBAR();
        pv_d0(o, VBUF(j), pa0, pa1, pa2, pa3);
      }
      if (j + 1 < NT) ENDSTEP(j);
    }
  } else if constexpr (MK_PP) {
    const bool grpB = wid >= 4;
#if MK_NEGM
    m_reg = 0.f; f32x16 negm = f32x16{};
#endif
#define PP_BAR(VM) do { if (VM) { asm volatile("s_waitcnt vmcnt(4) lgkmcnt(0)\n\ts_barrier" ::: "memory"); } else { asm volatile("s_waitcnt vmcnt(0) lgkmcnt(0)\n\ts_barrier" ::: "memory"); } } while (0)
#define PP_BAR_PLAIN() asm volatile("s_waitcnt lgkmcnt(0)\n\ts_barrier" ::: "memory")
    if (grpB) PP_BAR_PLAIN();
    qkt(pA0, pA1, KBUF(0), qr, r32, hi);
    if (grpB) PP_BAR(2 < NT); else PP_BAR_PLAIN();
    for (int t = 0; t < NT; ++t) {
      if (grpB && t + 3 < NT) DMA(t + 3, (t + 3) & 3);
#if MK_NEGM
      partialSM_neg(pA0, pA1, m_reg, negm, alA, i0); if (!i0) RESC(alA);
#else
      PSM(pA0, pA1, mnA, alA, t); RESC(alA);
#endif
      finishSM(pA0, pA1, alA, l_reg, pa0, pa1, pa2, pa3);
#if MK_PROBE_V
      { float dm_ = alA;
#pragma unroll
        for (int q_ = 0; q_ < 32; ++q_) asm volatile("v_add_f32 %0, %0, %0" : "+v"(dm_));
        if (dm_ == 123.456f) l_reg += 1.f; }
#endif
      if (!grpB) PP_BAR(t + 2 < NT); else PP_BAR_PLAIN();
      if (!grpB && t + 3 < NT) DMA(t + 3, (t + 3) & 3);
      SBAR();
      if (t + 1 < NT) {
        const int kb_ = kbase0 + ((t + 1) & 3) * (int)SHM_K, vb_ = VBUF(t);
        KFrag k0_, k1_; VFrag fa_, fb_;
        KRD(k0_, 0, kb_); KRD(k1_, 1, kb_); pv_rd<0>(fa_, vb_);
#if MK_NEGM
        LW(10); pA0 = __builtin_amdgcn_mfma_f32_32x32x16_bf16(k0_.a, qr[0], negm, 0, 0, 0); pA1 = __builtin_amdgcn_mfma_f32_32x32x16_bf16(k0_.b, qr[0], negm, 0, 0, 0); SBAR(); KRD(k0_, 2, kb_);
#else
        pA0 = f32x16{}; pA1 = f32x16{};
        LW(10); QMM(k0_, 0); SBAR(); KRD(k0_, 2, kb_);
#endif
        LW(10); QMM(k1_, 1); SBAR(); KRD(k1_, 3, kb_);
        LW(4);  pv_mm(o[0], fa_, pa0, pa1, pa2, pa3); SBAR(); pv_rd<1>(fb_, vb_);
        LW(10); QMM(k0_, 2); SBAR(); KRD(k0_, 4, kb_);
        LW(10); QMM(k1_, 3); SBAR(); KRD(k1_, 5, kb_);
        LW(4);  pv_mm(o[1], fb_, pa0, pa1, pa2, pa3); SBAR(); pv_rd<2>(fa_, vb_);
        LW(10); QMM(k0_, 4); SBAR(); KRD(k0_, 6, kb_);
        LW(10); QMM(k1_, 5); SBAR(); KRD(k1_, 7, kb_);
        LW(4);  pv_mm(o[2], fa_, pa0, pa1, pa2, pa3); SBAR(); pv_rd<3>(fb_, vb_);
        LW(10); QMM(k0_, 6); SBAR();
        LW(8);  QMM(k1_, 7); SBAR();
        LW(0);  pv_mm(o[3], fb_, pa0, pa1, pa2, pa3);
      } else pv_d0(o, VBUF(t), pa0, pa1, pa2, pa3);
      if (t + 1 < NT) { if (grpB) PP_BAR(t + 3 < NT); else PP_BAR_PLAIN(); }
    }
    if (!grpB) PP_BAR_PLAIN();
#undef PP_BAR
#undef PP_BAR_PLAIN
#undef KRD
#undef QMM
#undef LW
  } else {
  if (2 < NT) DMA(2, 2);
  qkt(pA0, pA1, KBUF(0), qr, r32, hi); PSM(pA0, pA1, mnA, alA, 0);
  ENDSTEP(0);
  for (int j = 1; j + 1 < NT; j += 2) {
    if (j + 2 < NT) DMA(j + 2, (j + 2) & 3);
    SBAR(); qkt(pB0, pB1, KBUF(j), qr, r32, hi);
    finishSM(pA0, pA1, alA, l_reg, pa0, pa1, pa2, pa3); SGB_A(); SBAR();
    pv_d0(o, VBUF(j - 1), pa0, pa1, pa2, pa3); PSM(pB0, pB1, mnB, alB, j);
    RESC(alB); ENDSTEP(j);
    if (j + 3 < NT) DMA(j + 3, (j + 3) & 3);
    SBAR(); qkt(pA0, pA1, KBUF(j + 1), qr, r32, hi);
    finishSM(pB0, pB1, alB, l_reg, pa0, pa1, pa2, pa3); SGB_A(); SBAR();
    pv_d0(o, VBUF(j), pa0, pa1, pa2, pa3); PSM(pA0, pA1, mnA, alA, j + 1);
    RESC(alA); ENDSTEP(j + 1);
  }
  SBAR(); qkt(pB0, pB1, KBUF(NT - 1), qr, r32, hi);
  finishSM(pA0, pA1, alA, l_reg, pa0, pa1, pa2, pa3); SBAR();
  pv_d0(o, VBUF(NT - 2), pa0, pa1, pa2, pa3); PSM(pB0, pB1, mnB, alB, NT - 1);
  RESC(alB);
  finishSM(pB0, pB1, alB, l_reg, pa0, pa1, pa2, pa3); SBAR();
  pv_d0(o, VBUF(NT - 1), pa0, pa1, pa2, pa3);
  }
  if (hi == 0) li_l[r32] = l_reg; asm volatile("s_waitcnt lgkmcnt(0)" ::: "memory");
  if constexpr (DIL) { if (hi == 0) lse_o[(long)(wid * QBLK + r32) * lse_s] = m_reg + __log2f(l_reg); }
  float rli[16];
#pragma unroll
  for (int r = 0; r < 16; ++r) rli[r] = __builtin_amdgcn_rcpf(li_l[crow(r, hi)]);
  bf16* Ow = Ob + (long)(wid * QBLK) * os;
#pragma unroll
  for (int r = 0; r < 16; ++r) { const int orow = crow(r, hi);
#pragma unroll
    for (int d0 = 0; d0 < 4; ++d0) Ow[(long)orow * os + d0 * 32 + r32] = __float2bfloat16(o[d0][r] * rli[r]); }
  asm volatile("s_waitcnt lgkmcnt(0)\n\ts_barrier" ::: "memory");
#undef KROW
#undef DMA
#undef ENDSTEP
#undef RESC
#undef PSM
#undef KBUF
#undef SGB_A
#undef VBUF
}
}

#define GAS __attribute__((address_space(1)))
#define LAS __attribute__((address_space(3)))
typedef unsigned short bf16_t;
typedef unsigned v4u __attribute__((ext_vector_type(4)));
typedef unsigned v2u __attribute__((ext_vector_type(2)));
typedef float f32x4 __attribute__((ext_vector_type(4)));
#define LDS_WAIT() asm volatile("s_waitcnt lgkmcnt(0)" ::: "memory")

constexpr size_t MiB = 1u << 20;
constexpr size_t WS_W1T = 0;
constexpr size_t WS_W2T = 104 * MiB;
constexpr size_t WS_H = 136 * MiB;
constexpr size_t WS_PROJ = 200 * MiB;
constexpr size_t WS_YA = 408 * MiB;
constexpr size_t WS_YB = 440 * MiB;
constexpr size_t WS_LSE = 536 * MiB;
constexpr size_t WS_ROPE = 538 * MiB;
constexpr size_t WS_XB = 540 * MiB;
constexpr size_t WS_ROWSQ = 604 * MiB;
constexpr size_t WS_END = 616 * MiB;
static_assert((size_t)DEPTH * DIN * DM * 2 <= WS_W2T - WS_W1T && (size_t)M * DIN * 2 <= WS_YA - WS_PROJ && (size_t)3 * M * DB * 2 <= WS_LSE - WS_YB, "ws map");
constexpr int LDS_BYTES = 147456;
constexpr int N_PHASES = 2 + 5 * DEPTH;

__device__ __forceinline__ unsigned f2bf(float f) { unsigned u = __builtin_bit_cast(unsigned, f); return (u + 0x7fffu + ((u >> 16) & 1u)) >> 16; }
__device__ __forceinline__ unsigned pk2(float lo, float hi) { return f2bf(lo) | (f2bf(hi) << 16); }
__device__ __forceinline__ float bflo(unsigned w) { return __uint_as_float(w << 16); }
__device__ __forceinline__ float bfhi(unsigned w) { return __uint_as_float(w & 0xffff0000u); }
__device__ __forceinline__ float wave_sum(float v) {
#pragma unroll
    for (int o = 1; o < 64; o <<= 1) v += __shfl_xor(v, o);
    return v;
}

__device__ const float INV_FREQ[32] = {1.000000000e+00f, 7.498942614e-01f, 5.623413324e-01f, 4.216965139e-01f, 3.162277639e-01f, 2.371373773e-01f, 1.778279394e-01f, 1.333521307e-01f,
    1.000000015e-01f, 7.498941571e-02f, 5.623413250e-02f, 4.216965288e-02f, 3.162277490e-02f, 2.371373773e-02f, 1.778279431e-02f, 1.333521493e-02f,
    9.999999776e-03f, 7.498941850e-03f, 5.623413250e-03f, 4.216964822e-03f, 3.162277630e-03f, 2.371373586e-03f, 1.778279431e-03f, 1.333521446e-03f,
    1.000000047e-03f, 7.498942432e-04f, 5.623413017e-04f, 4.216965172e-04f, 3.162277571e-04f, 2.371373703e-04f, 1.778279402e-04f, 1.333521504e-04f};

__device__ __forceinline__ void sincos_acc(float a, float& s, float& c) {
    const double x = (double)a, kd = __builtin_rint(x * 0.63661977236758134308);
    const int k = (int)kd; const double r = x - kd * 1.57079632679489661923, r2 = r * r;
    const double sp = r * (1.0 + r2 * (-1.0 / 6 + r2 * (1.0 / 120 + r2 * (-1.0 / 5040 + r2 * (1.0 / 362880 + r2 * (-1.0 / 39916800 + r2 * (1.0 / 6227020800.0)))))));
    const double cp = 1.0 + r2 * (-0.5 + r2 * (1.0 / 24 + r2 * (-1.0 / 720 + r2 * (1.0 / 40320 + r2 * (-1.0 / 3628800 + r2 * (1.0 / 479001600.0 + r2 * (-1.0 / 87178291200.0)))))));
    const int q = k & 3;
    const double sv = (q == 0) ? sp : (q == 1) ? cp : (q == 2) ? -sp : -cp, cv = (q == 0) ? cp : (q == 1) ? -sp : (q == 2) ? -cp : sp;
    s = (float)sv; c = (float)cv;
}

__device__ __forceinline__ void p0_transpose_item(const float* W, int K, int N, bf16_t* WT, LAS float* scr, int item, int lane, const float* kscale) {
    const int nblk = N / 32, kb = item / nblk, nb = item % nblk, k0 = 64 * kb, n0 = 32 * nb;
#pragma unroll 8
    for (int i = 0; i < 32; ++i) { const int kk = 2 * i + (lane >> 5); scr[kk * 33 + (lane & 31)] = W[(size_t)(k0 + kk) * N + n0 + (lane & 31)] * (kscale ? kscale[k0 + kk] : 1.0f); }
    LDS_WAIT(); asm volatile("" ::: "memory");
    const int c = lane & 7;
#pragma unroll
    for (int j = 0; j < 4; ++j) { const int n = (lane >> 3) + 8 * j; const LAS float* s = scr + (8 * c) * 33 + n;
        v4u o; o.x = pk2(s[0 * 33], s[1 * 33]); o.y = pk2(s[2 * 33], s[3 * 33]); o.z = pk2(s[4 * 33], s[5 * 33]); o.w = pk2(s[6 * 33], s[7 * 33]);
        *(v4u*)(WT + (size_t)(n0 + n) * K + k0 + 8 * c) = o; }
    LDS_WAIT(); asm volatile("" ::: "memory");
}

#define XB_TMO      128
#define XB_XCNT(j)  (256  + 64 * (j))
#define XB_XSUB(j)  (1280 + 64 * (j))
#define XB_XGEN(j)  (2304 + 64 * (j))
#define XB_TOP      3328
#define XB_TOPGEN   3392
#define XCD_BAR_WORDS 3456
#define XB_SPIN_CAP (1u << 18)

__device__ __forceinline__ unsigned xb_ld(unsigned* p)              { return __hip_atomic_load(p, __ATOMIC_RELAXED, __HIP_MEMORY_SCOPE_AGENT); }
__device__ __forceinline__ unsigned xb_add(unsigned* p, unsigned v) { return __hip_atomic_fetch_add(p, v, __ATOMIC_RELAXED, __HIP_MEMORY_SCOPE_AGENT); }
__device__ __forceinline__ unsigned xb_xcc_id() { return (unsigned)__builtin_amdgcn_s_getreg((3 << 11) | 20) & 0xFu; }
#define XB_SPIN(cond, bar) do { unsigned _sp = 0; while (cond) { __builtin_amdgcn_s_sleep(1); \
    if ((++_sp & 255u) == 0u) { if (xb_ld(&(bar)[XB_TMO])) break; if (_sp > XB_SPIN_CAP) { atomicAdd(&(bar)[XB_TMO], 1u); break; } } } } while (0)

struct XcdBarrier {
    unsigned* bar; unsigned x;
    volatile LAS unsigned* st;
};

__device__ __forceinline__ XcdBarrier xcd_barrier_post(unsigned* bar, volatile LAS unsigned* st) {
    XcdBarrier b; b.bar = bar; b.x = xb_xcc_id(); b.st = st;
    if (threadIdx.x == 0) (void)xb_add(&bar[XB_XCNT(b.x)], 1u);
    return b;
}
__device__ __forceinline__ void xcd_barrier_complete(unsigned* bar, unsigned x, unsigned& nloc, unsigned& nx) {
    const unsigned G = gridDim.x * gridDim.y * gridDim.z;
    unsigned sum, cnt, mine, sp = 0u;
    for (;;) {
        sum = 0u; cnt = 0u; mine = 0u;
#pragma unroll
        for (unsigned j = 0; j < 16; ++j) { const unsigned c = xb_ld(&bar[XB_XCNT(j)]); sum += c; cnt += (c > 0u) ? 1u : 0u; mine = (j == x) ? c : mine; }
        if (sum == G) break;
        __builtin_amdgcn_s_sleep(1);
        if ((++sp & 255u) == 0u) { if (xb_ld(&bar[XB_TMO])) break; if (sp > XB_SPIN_CAP) { atomicAdd(&bar[XB_TMO], 1u); break; } }
    }
    nloc = mine > 0u ? mine : 1u; nx = cnt > 0u ? cnt : 1u;
}

__device__ __forceinline__ void xcd_barrier(const XcdBarrier& b) {
    asm volatile("s_waitcnt vmcnt(0)" ::: "memory");
    __syncthreads();
    if (threadIdx.x == 0) {
        unsigned* bar = b.bar;
        __builtin_amdgcn_s_waitcnt(0);
        unsigned nloc = b.st[0], nx = b.st[1];
        if (nloc == 0u) { xcd_barrier_complete(bar, b.x, nloc, nx); b.st[0] = nloc; b.st[1] = nx; }
        const unsigned old = xb_add(&bar[XB_XSUB(b.x)], 1u);
        const unsigned gen = old / nloc;
        if (old + 1u == (gen + 1u) * nloc) {
            __builtin_amdgcn_fence(__ATOMIC_RELEASE, "agent");
            asm volatile("s_waitcnt vmcnt(0)" ::: "memory");
            const unsigned og = xb_add(&bar[XB_TOP], 1u);
            const unsigned tg = og / nx;
            if (og + 1u == (tg + 1u) * nx) xb_add(&bar[XB_TOPGEN], 1u);
            else XB_SPIN(xb_ld(&bar[XB_TOPGEN]) == tg, bar);
            __builtin_amdgcn_fence(__ATOMIC_ACQUIRE, "agent");
            xb_add(&bar[XB_XGEN(b.x)], 1u);
            asm volatile("s_waitcnt vmcnt(0)" ::: "memory");
        } else {
            XB_SPIN(xb_ld(&bar[XB_XGEN(b.x)]) == gen, bar);
            __builtin_amdgcn_fence(__ATOMIC_ACQUIRE, "agent");
            asm volatile("s_waitcnt vmcnt(0)" ::: "memory");
        }
    }
    __syncthreads();
}

constexpr size_t WS_CTL = 539 * MiB, CTL_BYTES = 16384;
constexpr int MISC_OFF = 147456 - 128;
__device__ __forceinline__ void gate_row(int m, int lane, const bf16_t* __restrict__ YA, const bf16_t* __restrict__ YB, const float* __restrict__ LSE, const bf16_t* __restrict__ PROJ,
                                         const float* __restrict__ wa, const float* __restrict__ wb, bf16_t* __restrict__ H) {
                    float ya[2][8], yb[2][8]; float ssa = 0.f, ssb = 0.f;
#pragma unroll
                    for (int j = 0; j < 2; ++j) { const int c = lane + 64 * j, hh = c >> 4;
                        const v4u a = *(const v4u*)(YA + (size_t)m * DA + 8 * c);
                        ya[j][0] = bflo(a.x); ya[j][1] = bfhi(a.x); ya[j][2] = bflo(a.y); ya[j][3] = bfhi(a.y); ya[j][4] = bflo(a.z); ya[j][5] = bfhi(a.z); ya[j][6] = bflo(a.w); ya[j][7] = bfhi(a.w);
                        const float l0 = LSE[((size_t)0 * M + m) * 8 + hh], l1 = LSE[((size_t)1 * M + m) * 8 + hh], l2 = LSE[((size_t)2 * M + m) * 8 + hh];
                        const float mx = fmaxf(l0, fmaxf(l1, l2)); const float e0 = __builtin_amdgcn_exp2f(l0 - mx), e1 = __builtin_amdgcn_exp2f(l1 - mx), e2 = __builtin_amdgcn_exp2f(l2 - mx);
                        const float inv = 1.0f / (e0 + e1 + e2); const float w0 = e0 * inv, w1 = e1 * inv, w2 = e2 * inv;
                        const v4u b0 = *(const v4u*)(YB + ((size_t)0 * M + m) * DB + 8 * c), b1 = *(const v4u*)(YB + ((size_t)1 * M + m) * DB + 8 * c), b2 = *(const v4u*)(YB + ((size_t)2 * M + m) * DB + 8 * c);
                        yb[j][0] = w0 * bflo(b0.x) + w1 * bflo(b1.x) + w2 * bflo(b2.x); yb[j][1] = w0 * bfhi(b0.x) + w1 * bfhi(b1.x) + w2 * bfhi(b2.x);
                        yb[j][2] = w0 * bflo(b0.y) + w1 * bflo(b1.y) + w2 * bflo(b2.y); yb[j][3] = w0 * bfhi(b0.y) + w1 * bfhi(b1.y) + w2 * bfhi(b2.y);
                        yb[j][4] = w0 * bflo(b0.z) + w1 * bflo(b1.z) + w2 * bflo(b2.z); yb[j][5] = w0 * bfhi(b0.z) + w1 * bfhi(b1.z) + w2 * bfhi(b2.z);
                        yb[j][6] = w0 * bflo(b0.w) + w1 * bflo(b1.w) + w2 * bflo(b2.w); yb[j][7] = w0 * bfhi(b0.w) + w1 * bfhi(b1.w) + w2 * bfhi(b2.w);
#pragma unroll
                        for (int i = 0; i < 8; ++i) { ssa += ya[j][i] * ya[j][i]; ssb += yb[j][i] * yb[j][i]; } }
                    const float ra = 1.0f / sqrtf(wave_sum(ssa) * (1.0f / DA) + EPS), rb = 1.0f / sqrtf(wave_sum(ssb) * (1.0f / DB) + EPS);
#pragma unroll
                    for (int j = 0; j < 2; ++j) { const int c = lane + 64 * j;
                        const v4u ga = *(const v4u*)(PROJ + ((size_t)(H_GA + (c >> 4)) * M + m) * HD + 8 * (c & 15)), gb = *(const v4u*)(PROJ + ((size_t)(H_GB + (c >> 4)) * M + m) * HD + 8 * (c & 15));
                        const float gaf[8] = {bflo(ga.x), bfhi(ga.x), bflo(ga.y), bfhi(ga.y), bflo(ga.z), bfhi(ga.z), bflo(ga.w), bfhi(ga.w)};
                        const float gbf[8] = {bflo(gb.x), bfhi(gb.x), bflo(gb.y), bfhi(gb.y), bflo(gb.z), bfhi(gb.z), bflo(gb.w), bfhi(gb.w)};
                        const f32x4 wa0 = *(const f32x4*)(wa + 8 * c), wa1 = *(const f32x4*)(wa + 8 * c + 4), wb0 = *(const f32x4*)(wb + 8 * c), wb1 = *(const f32x4*)(wb + 8 * c + 4);
                        float za[8], zb[8];
#pragma unroll
                        for (int i = 0; i < 8; ++i) { const float wai = i < 4 ? wa0[i & 3] : wa1[i & 3], wbi = i < 4 ? wb0[i & 3] : wb1[i & 3];
                            const float sa = gaf[i] / (1.0f + __expf(-gaf[i])), sb = gbf[i] / (1.0f + __expf(-gbf[i]));
                            za[i] = ya[j][i] * ra * wai * sa; zb[i] = yb[j][i] * rb * wbi * sb; }
                        v4u oa, ob; oa.x = pk2(za[0], za[1]); oa.y = pk2(za[2], za[3]); oa.z = pk2(za[4], za[5]); oa.w = pk2(za[6], za[7]);
                        ob.x = pk2(zb[0], zb[1]); ob.y = pk2(zb[2], zb[3]); ob.z = pk2(zb[4], zb[5]); ob.w = pk2(zb[6], zb[7]);
                        *(v4u*)(H + (size_t)m * DM + 8 * c) = oa; *(v4u*)(H + (size_t)m * DM + DA + 8 * c) = ob; }
}

struct Params { const float *x, *norm_w, *w_in, *qn, *kn, *ona, *onb, *w_out, *fnorm; float* out; unsigned char* ws; int ph_lo, ph_hi; };

__global__ void __launch_bounds__(512, 2) mk_fwd(Params p) {
    extern __shared__ __attribute__((aligned(16))) unsigned char lds[];
    volatile LAS unsigned* MISC = (volatile LAS unsigned*)((LAS unsigned char*)lds + MISC_OFF);
    if (threadIdx.x < 32) MISC[threadIdx.x] = 0u;
    __syncthreads();
    XcdBarrier bar = xcd_barrier_post((unsigned*)(p.ws + WS_CTL), MISC + 8);
    if (p.ph_lo == 0) {
        float* RCOS0 = (float*)(p.ws + WS_ROPE); float* RSIN0 = RCOS0 + 192 * 32;
        for (int i = blockIdx.x * 512 + threadIdx.x; i < 192 * 32; i += gridDim.x * 512) {
            const int pos = i >> 5, f = i & 31; const float pv = (float)(pos < 128 ? pos : pos - 128);
            float sn_, cs_; sincos_acc(pv * INV_FREQ[f], sn_, cs_); RCOS0[i] = cs_; RSIN0[i] = sn_;
        }
    }
    for (int ph = p.ph_lo; ph < p.ph_hi; ++ph) {
        const int tid = otid(), lane = tid & 63, wave = __builtin_amdgcn_readfirstlane(tid >> 6);
        int G = gridDim.x, bx = blockIdx.x; asm volatile("" : "+s"(G), "+s"(bx));
        const int vcu = (G % 8 == 0) ? (bx % 8) * (G / 8) + bx / 8 : bx;
        const int gw = vcu * 8 + wave, NGW = G * 8;
        size_t zoff = 0; asm volatile("" : "+s"(zoff));
        unsigned char* ws = p.ws + zoff;
        bf16_t* W1T = (bf16_t*)(ws + WS_W1T); bf16_t* W2T = (bf16_t*)(ws + WS_W2T); bf16_t* H = (bf16_t*)(ws + WS_H); bf16_t* PROJ = (bf16_t*)(ws + WS_PROJ);
        bf16_t* YA = (bf16_t*)(ws + WS_YA); bf16_t* YB = (bf16_t*)(ws + WS_YB); float* LSE = (float*)(ws + WS_LSE);
        float* RCOS = (float*)(ws + WS_ROPE); float* RSIN = RCOS + 192 * 32;
        bf16_t* XB = (bf16_t*)(ws + WS_XB); float* ROWSQ = (float*)(ws + WS_ROWSQ);
        if (ph == 0) {
            LAS float* scr = (LAS float*)((LAS unsigned char*)lds + wave * 16384);
            constexpr int I1 = (DM / 64) * (DIN / 32), I2 = (DM / 64) * (DM / 32), IL = I1 + I2;
            DUPREP(0) for (int it = gw; it < DEPTH * IL; it += NGW) {
                const int l = it / IL, r = it % IL;
                if (r < I1) p0_transpose_item(p.w_in + (size_t)l * DM * DIN, DM, DIN, W1T + (size_t)l * DIN * DM, scr, r, lane, p.norm_w + (size_t)l * DM);
                else p0_transpose_item(p.w_out + (size_t)l * DM * DM, DM, DM, W2T + (size_t)l * DM * DM, scr, r - I1, lane, nullptr);
            }
            for (int m = gw; m < M; m += NGW) {
                const f32x4* xr = (const f32x4*)(p.x + (size_t)m * DM) + lane; v2u* o8 = (v2u*)(XB + (size_t)m * DM) + lane; float sq = 0.f;
#pragma unroll
                for (int j = 0; j < 8; ++j) { const f32x4 v = xr[64 * j]; v2u w; w.x = pk2(v.x, v.y); w.y = pk2(v.z, v.w); o8[64 * j] = w;
                    const float r0 = bflo(w.x), r1 = bfhi(w.x), r2 = bflo(w.y), r3 = bfhi(w.y); sq += (r0 * r0 + r1 * r1) + (r2 * r2 + r3 * r3); }
                sq = wave_sum(sq); if (lane < 32) ROWSQ[(size_t)m * 32 + lane] = (lane == 0) ? sq : 0.f;
            }
        } else if (ph == N_PHASES - 1) {
            for (int m = gw; m < M; m += NGW) {
                f32x4* xr = (f32x4*)(p.out + (size_t)m * DM) + lane; const f32x4* wr_ = (const f32x4*)p.fnorm + lane; const v2u* xb8 = (const v2u*)(XB + (size_t)m * DM) + lane;
                const float rstd = 1.0f / sqrtf(wave_sum(lane < 32 ? ROWSQ[((size_t)DEPTH * M + m) * 32 + lane] : 0.f) * (1.0f / DM) + EPS);
#pragma unroll
                for (int j = 0; j < 8; ++j) { const v2u w = xb8[64 * j]; const f32x4 v = {bflo(w.x), bfhi(w.x), bflo(w.y), bfhi(w.y)}; xr[64 * j] = v * rstd * wr_[64 * j]; }
            }
        } else {
            const int l = (ph - 1) / 5, st = (ph - 1) % 5 + 1;
            if (st == 1) {
                pg8::Gemm g{XB, W1T + (size_t)l * DIN * DM, M, DIN, DM}; pg8::StaticOrder S; S.init(M, DIN, G, bx);
                pg8::EpiHeadMajor E{PROJ, M, ROWSQ + (size_t)l * M * 32, 1.0f / DM, EPS};
#ifndef MK_NO_G1
                DUPREP(2) pg8::gemm_phase<pg8::EpiHeadMajor, pg8::StaticOrder, PG8_ALIGN, PG8_SP2>((PG8_LAS unsigned char*)lds, g, S, E);
#endif
            } else if (st == 2) {
                const float* qg = p.qn + l * HD; const float* kg = p.kn + l * HD;
                constexpr int QKU = 4;
                for (int it0 = gw; it0 < M * 10 / 4; it0 += QKU * NGW) {
                    const int j = lane & 15, half = j >> 3, jj = j & 7, e = half * 64 + 4 * jj;
                    v2u a[QKU], b[QKU]; f32x4 cs[QKU], sn[QKU]; bf16_t* pp[QKU]; bool isq[QKU];
#pragma unroll
                    for (int u = 0; u < QKU; ++u) { const int it = min(it0 + u * NGW, M * 10 / 4 - 1);
                        const int g = it * 4 + (lane >> 4), row = g / 10, hs = g - row * 10; isq[u] = hs < 8;
                        pp[u] = PROJ + ((size_t)hs * M + row) * HD + e; a[u] = *(const v2u*)pp[u]; b[u] = *(const v2u*)(pp[u] + 32);
                        const int t = row & (T - 1), pos = half ? 128 + (t & 63) : (t >> 6);
                        cs[u] = *(const f32x4*)(RCOS + pos * 32 + 4 * jj); sn[u] = *(const f32x4*)(RSIN + pos * 32 + 4 * jj); }
                    asm volatile("" ::: "memory");
#pragma unroll
                    for (int u = 0; u < QKU; ++u) {
                        float x1[4] = {bflo(a[u].x), bfhi(a[u].x), bflo(a[u].y), bfhi(a[u].y)}, x2[4] = {bflo(b[u].x), bfhi(b[u].x), bflo(b[u].y), bfhi(b[u].y)};
                        float ss = 0.f;
#pragma unroll
                        for (int i = 0; i < 4; ++i) ss += x1[i] * x1[i] + x2[i] * x2[i];
                        ss += __shfl_xor(ss, 1); ss += __shfl_xor(ss, 2); ss += __shfl_xor(ss, 4); ss += __shfl_xor(ss, 8);
                        const float rstd = 1.0f / sqrtf(ss * (1.0f / HD) + EPS);
                        const float* gn = isq[u] ? qg : kg;
                        const float qsc = (MK_NEGM && isq[u]) ? att::SCALE * att::LOG2E : 1.0f;
                        const f32x4 g1 = *(const f32x4*)(gn + e), g2 = *(const f32x4*)(gn + e + 32);
                        float o1[4], o2[4];
#pragma unroll
                        for (int i = 0; i < 4; ++i) { const float y1 = x1[i] * rstd * g1[i], y2 = x2[i] * rstd * g2[i]; o1[i] = (y1 * cs[u][i] - y2 * sn[u][i]) * qsc; o2[i] = (y1 * sn[u][i] + y2 * cs[u][i]) * qsc; }
                        v2u w1, w2; w1.x = pk2(o1[0], o1[1]); w1.y = pk2(o1[2], o1[3]); w2.x = pk2(o2[0], o2[1]); w2.y = pk2(o2[2], o2[3]);
                        if (it0 + u * NGW < M * 10 / 4) { *(v2u*)pp[u] = w1; *(v2u*)(pp[u] + 32) = w2; }
                    }
                }
#ifndef MK_NO_DIL
                DUPREP(3) for (int u = vcu; u < 1536; u += G) {
                    const int pt = u >> 9, rem = u & 511, b = rem >> 8, h = (rem >> 5) & 7, w = rem & 31;
                    const int d = (pt == 0) ? 1 : (pt == 1) ? 4 : 16, res = w & (d - 1), blk = w / d, i0 = blk * 256, nsub = T / d;
                    const float slope = __builtin_amdgcn_exp2f(-(float)(h + 1));
                    const float nslopeC = -slope * (float)d * att::LOG2E;
                    const size_t tok0 = (size_t)b * T + res;
                    const att::bf16* Pb = (const att::bf16*)PROJ + ((size_t)h * M + tok0) * HD;
                    const long rs = (long)d * HD;
                    att::attn_body<true>(Pb + (size_t)H_QB * M * HD + (long)i0 * rs, Pb + (size_t)H_KB * M * HD, Pb + (size_t)H_VB * M * HD, rs, rs,
                                         (att::bf16*)YB + ((size_t)pt * M + tok0 + (size_t)i0 * d) * DB + h * HD, (long)d * DB,
                                         LSE + ((size_t)pt * M + tok0 + (size_t)i0 * d) * 8 + h, d * 8, i0, nsub, nslopeC, 0, (char*)lds);
                }
#endif
            } else if (st == 3) {
#ifndef MK_NO_DENSE
                int bounded;
                { const float* qg = p.qn + l * HD; const float* kg = p.kn + l * HD;
                  float gq = fmaxf(fabsf(qg[lane]), fabsf(qg[lane + 64])), gk = fmaxf(fabsf(kg[lane]), fabsf(kg[lane + 64]));
#pragma unroll
                  for (int o_ = 1; o_ < 64; o_ <<= 1) { gq = fmaxf(gq, __shfl_xor(gq, o_)); gk = fmaxf(gk, __shfl_xor(gk, o_)); }
                  const float bnd = gq * gk * 128.f * att::SCALE * att::LOG2E;
                  bounded = __builtin_amdgcn_readfirstlane((MK_NEGM && bnd <= 64.f) ? 1 : 0); }
                DUPREP(4) for (int u = vcu; u < 512; u += G) {
                    const int combo = u >> 7, b = combo >> 1, kvh = combo & 1, h = kvh * 4 + ((u >> 5) & 3), qb = u & 31;
                    const att::bf16* Pb = (const att::bf16*)PROJ + (size_t)b * T * HD;
                    att::attn_body<false>(Pb + ((size_t)(H_QA + h) * M + qb * 256) * HD, Pb + (size_t)(H_KA + kvh) * M * HD, Pb + (size_t)(H_VA + kvh) * M * HD, HD, HD,
                                          (att::bf16*)YA + ((size_t)b * T + qb * 256) * DA + h * HD, DA, nullptr, 0, bounded, 0, 0.f, T, (char*)lds);
                }
#endif
            } else if (st == 4) {
                const float* wa = p.ona + (size_t)l * DA; const float* wb = p.onb + (size_t)l * DB;
                DUPREP(5) for (int m = gw; m < M; m += 2 * NGW) {
                    gate_row(m, lane, YA, YB, LSE, PROJ, wa, wb, H);
                    if (m + NGW < M) gate_row(m + NGW, lane, YA, YB, LSE, PROJ, wa, wb, H);
                }
            } else {
                pg8::Gemm g{H, W2T + (size_t)l * DM * DM, M, DM, DM}; pg8::StaticOrder S; S.init(M, DM, G, bx);
                pg8::EpiResF32 E{XB, ROWSQ + (size_t)(l + 1) * M * 32, DM};
#ifndef MK_NO_G2
                pg8::gemm_phase<pg8::EpiResF32, pg8::StaticOrder, PG8_ALIGN, PG8_SP2>((PG8_LAS unsigned char*)lds, g, S, E);
#endif
            }
        }
        if (ph + 1 < p.ph_hi) { if (p.ph_hi > 4096) cg::this_grid().sync(); else xcd_barrier(bar); if (MK_DUP & 64) xcd_barrier(bar); }
    }
}

extern "C" void kernel_launch(void* const* d_in, const int* in_sizes, int n_in, void* d_out, int out_size, void* d_ws, size_t ws_size, hipStream_t stream) {
    static int grid = 0;
    if (grid == 0) {
        if (n_in != 9 || in_sizes[0] != M * DM || out_size != M * DM || ws_size < WS_END) { fprintf(stderr, "kernel_launch: unexpected shapes (n_in %d, ws %zu)\n", n_in, ws_size); grid = -1; return; }
        int dev = 0, cus = 0, per_cu = 0;
        hipGetDevice(&dev); hipDeviceGetAttribute(&cus, hipDeviceAttributeMultiprocessorCount, dev);
        if (hipFuncSetAttribute((const void*)mk_fwd, hipFuncAttributeMaxDynamicSharedMemorySize, LDS_BYTES) != hipSuccess) { fprintf(stderr, "kernel_launch: hipFuncSetAttribute failed\n"); grid = -1; return; }
        if (hipOccupancyMaxActiveBlocksPerMultiprocessor(&per_cu, (const void*)mk_fwd, 512, LDS_BYTES) != hipSuccess || per_cu < 1) per_cu = 1;
        (void)hipGetLastError();
        grid = cus * per_cu;
    }
    if (grid < 0) return;
    Params p{};
    p.x = (const float*)d_in[0]; p.norm_w = (const float*)d_in[1]; p.w_in = (const float*)d_in[2]; p.qn = (const float*)d_in[3]; p.kn = (const float*)d_in[4];
    p.ona = (const float*)d_in[5]; p.onb = (const float*)d_in[6]; p.w_out = (const float*)d_in[7]; p.fnorm = (const float*)d_in[8];
    p.out = (float*)d_out; p.ws = (unsigned char*)d_ws;
    if (hipMemsetAsync((char*)d_ws + WS_CTL, 0, CTL_BYTES, stream) != hipSuccess) { fprintf(stderr, "kernel_launch: memset failed\n"); return; }
#if MK_ONE_LAUNCH
    p.ph_lo = 0; p.ph_hi = N_PHASES;
    void* args[] = {&p};
    hipError_t e = hipLaunchCooperativeKernel((const void*)mk_fwd, dim3(grid), dim3(512), args, LDS_BYTES, stream);
    if (e != hipSuccess) fprintf(stderr, "kernel_launch: cooperative launch failed: %s (grid %d)\n", hipGetErrorString(e), grid);
#else
    for (int ph = 0; ph < N_PHASES; ++ph) { p.ph_lo = ph; p.ph_hi = ph + 1; hipLaunchKernelGGL(mk_fwd, dim3(grid), dim3(512), LDS_BYTES, stream, p); }
#endif
}
```

```cpp
#include <hip/hip_runtime.h>
#include <hip/hip_bf16.h>
#include <hip/hip_cooperative_groups.h>
#include <cstdio>
#include <cstdint>
namespace cg = cooperative_groups;

#ifndef MK_DUP
#define MK_DUP 0
#endif
#define DUPREP(k) for (int rep_ = 0; rep_ < 1 + ((MK_DUP >> (k)) & 1); ++rep_)
#ifndef MK_PVPIPE
#define MK_PVPIPE 1
#endif
#ifndef MK_SGB
#define MK_SGB 0
#endif
#ifndef MK_PP
#define MK_PP 1
#endif
#ifndef MK_PROBE_V
#define MK_PROBE_V 0
#endif
#ifndef MK_NEGM
#define MK_NEGM 1
#endif
#ifndef MK_PREB
#define MK_PREB 1
#endif
#ifndef MK_ONE_LAUNCH
#define MK_ONE_LAUNCH 1
#endif
static_assert(!MK_NEGM || MK_PP, "MK_NEGM pre-scales q for the ping-pong dense body only");

constexpr int BATCH = 2, T = 8192, DM = 2048, DEPTH = 4, HD = 128, DA = 1024, DB = 1024, DIN = 6656, M = BATCH * T;
constexpr int C_QA = 0, C_KA = 1024, C_VA = 1280, C_GA = 1536, C_QB = 2560, C_KB = 3584, C_VB = 4608, C_GB = 5632;
constexpr int H_QA = 0, H_KA = 8, H_VA = 10, H_GA = 12, H_QB = 20, H_KB = 28, H_VB = 36, H_GB = 44;
constexpr float EPS = 1e-6f;
__device__ __forceinline__ int otid() { int t = threadIdx.x; asm volatile("" : "+v"(t)); return t; }

namespace pg8 {
#define PG8_LAS __attribute__((address_space(3)))
typedef unsigned short bf16_t;
typedef short bf16x8 __attribute__((ext_vector_type(8)));
typedef float f32x4 __attribute__((ext_vector_type(4)));
typedef unsigned u32x4 __attribute__((ext_vector_type(4)));
constexpr int BM = 256, BK = 64, HALF = 128, HTB = HALF * BK * 2  , STAGE_BYTES = 8 * HTB, NXCD = 8, WGM = 8;

__host__ __device__ __forceinline__ int lds_byte(int r, int c) { const int st = (r >> 4) * 2 + (c >> 5), rr = r & 15, cc = c & 31, ob = rr * 64 + cc * 2; return st * 1024 + (ob ^ (((ob >> 9) & 1) << 5)); }
__host__ __device__ __forceinline__ void stage_rc(int b, int& R, int& C) { const int st = b / 1024, sb = b % 1024, swz = sb ^ (((sb >> 9) & 1) << 5); R = (st >> 1) * 16 + swz / 64; C = (st & 1) * 32 + (swz % 64) / 2; }
__host__ __device__ __forceinline__ int perm32(int rho) { const int n = rho >> 4, i = rho & 15; return 8 * (i >> 2) + 4 * n + (i & 3); }

struct Unit { int pm, pn; };
struct Gemm { const bf16_t* A; const bf16_t* Bt; int M, N, K; };

struct StaticOrder {
    int nM, nN, nwg, G, c;
    __host__ __device__ void init(int M, int N, int G_, int c_) { nM = M / BM; nN = N / BM; nwg = nM * nN; G = G_; c = c_; }
    __host__ __device__ bool next(int i, Unit& u) const {
        const long L = (long)i * G + c; if (L >= nwg) return false;
        int wgid = (int)L; { const int q = nwg / NXCD, r = nwg % NXCD, xcd = wgid % NXCD, off = wgid / NXCD; wgid = (xcd < r ? xcd * (q + 1) : r * (q + 1) + (xcd - r) * q) + off; }
        const int nig = WGM * nN, gid = wgid / nig, fm = gid * WGM, gsz = (nM - fm) < WGM ? (nM - fm) : WGM;
        u.pm = fm + ((wgid % nig) % gsz); u.pn = (wgid % nig) / gsz; return true;
    }
    __device__ __forceinline__ void a_ready(const Unit&) const {}
    __device__ __forceinline__ void done(const Unit&) const {}
};

__device__ __forceinline__ unsigned cvt_pk_bf16(float lo, float hi) { unsigned r; asm volatile("v_cvt_pk_bf16_f32 %0, %1, %2" : "=v"(r) : "v"(lo), "v"(hi)); return r; }
typedef float f32x2 __attribute__((ext_vector_type(2)));
__device__ __forceinline__ f32x2 gelu_pk(f32x2 v) {
    const f32x2 av = __builtin_elementwise_abs(v), d = av * 0.2316418882f + 1.0f;
    f32x2 t; t.x = __builtin_amdgcn_rcpf(d.x); t.y = __builtin_amdgcn_rcpf(d.y);
    f32x2 q = t * 0.5307027145f + (-0.7265760135f); q = q * t + 0.7107068705f; q = q * t + (-0.142248368f); q = q * t + 0.127414796f; q = q * t;
    const f32x2 s = (v * v) * (-0.72134752044f);
    f32x2 e; e.x = __builtin_amdgcn_exp2f(s.x); e.y = __builtin_amdgcn_exp2f(s.y);
    const f32x2 m = v * (q * e), r = v - m;
    f32x2 o; o.x = v.x < 0.f ? m.x : r.x; o.y = v.y < 0.f ? m.y : r.y; return o;
}

template <int ACT  > struct EpiBf16 {
    static constexpr bool PERM = true, AFTER_DRAIN = false; static_assert(ACT == 0 || ACT == 1, "EpiBf16: ACT is 0 (none) or 1 (gelu_pk)");
    bf16_t* O; int ldc; const float* bias; int split_cols; size_t split_stride; float scale0;
    __device__ __forceinline__ void operator()(const f32x4 (&acc)[2][2][4][2], const Unit& u, int wr, int wc, int fr, int fq) const {
        const int row0 = u.pm * BM + wr * 64 + fr; int colt = u.pn * BM; bf16_t* base = O;
        float sc = 1.f; if (split_cols) { const int t = colt / split_cols; base += (size_t)t * split_stride; colt -= t * split_cols; if (t == 0) sc = scale0; }
        const int col0 = colt + wc * 32 + 8 * fq, bcol0 = u.pn * BM + wc * 32 + 8 * fq;
        f32x4 bv[2][2];
#pragma unroll
        for (int bj = 0; bj < 2; ++bj)
#pragma unroll
            for (int n = 0; n < 2; ++n) bv[bj][n] = bias ? *(const f32x4*)(bias + bcol0 + bj * HALF + 4 * n) : (f32x4){0.f, 0.f, 0.f, 0.f};
#pragma unroll
        for (int ai = 0; ai < 2; ++ai)
#pragma unroll
            for (int m = 0; m < 4; ++m) { bf16_t* rowp = base + (size_t)(row0 + ai * HALF + m * 16) * ldc + col0;
#pragma unroll
                for (int bj = 0; bj < 2; ++bj) { f32x4 v0 = acc[ai][bj][m][0] + bv[bj][0], v1 = acc[ai][bj][m][1] + bv[bj][1];
                    if (ACT == 1) { f32x2 a = gelu_pk((f32x2){v0[0], v0[1]}), b = gelu_pk((f32x2){v0[2], v0[3]}), c = gelu_pk((f32x2){v1[0], v1[1]}), d = gelu_pk((f32x2){v1[2], v1[3]});
                        v0 = (f32x4){a.x, a.y, b.x, b.y}; v1 = (f32x4){c.x, c.y, d.x, d.y}; }
                    v0 = v0 * sc; v1 = v1 * sc; u32x4 w; w.x = cvt_pk_bf16(v0[0], v0[1]); w.y = cvt_pk_bf16(v0[2], v0[3]); w.z = cvt_pk_bf16(v1[0], v1[1]); w.w = cvt_pk_bf16(v1[2], v1[3]);
                    *(u32x4*)(rowp + bj * HALF) = w; } }
    }
};
struct EpiHeadMajor {
    static constexpr bool PERM = true, AFTER_DRAIN = false;
    bf16_t* O; int Mrows; const float* rowsq; float inv_k, eps;
    __device__ __forceinline__ void operator()(const f32x4 (&acc)[2][2][4][2], const Unit& u, int wr, int wc, int fr, int fq) const {
        const int row0 = u.pm * BM + wr * 64 + fr, col0 = wc * 32 + 8 * fq;
#pragma unroll
        for (int ai = 0; ai < 2; ++ai) {
            f32x4 pa[4], pb[4];
#pragma unroll
            for (int m = 0; m < 4; ++m) { const f32x4* pp = (const f32x4*)(rowsq + (size_t)(row0 + ai * HALF + m * 16) * 32 + 8 * fq); pa[m] = pp[0]; pb[m] = pp[1]; }
#pragma unroll
            for (int m = 0; m < 4; ++m) { const int row = row0 + ai * HALF + m * 16; const f32x4 a = pa[m], b = pb[m];
                float sq = ((a[0] + a[1]) + (a[2] + a[3])) + ((b[0] + b[1]) + (b[2] + b[3])); sq += __shfl_xor(sq, 16); sq += __shfl_xor(sq, 32);
                const float rs = 1.0f / sqrtf(sq * inv_k + eps);
#pragma unroll
                for (int bj = 0; bj < 2; ++bj) { const f32x4 v0 = acc[ai][bj][m][0] * rs, v1 = acc[ai][bj][m][1] * rs;
                    u32x4 w; w.x = cvt_pk_bf16(v0[0], v0[1]); w.y = cvt_pk_bf16(v0[2], v0[3]); w.z = cvt_pk_bf16(v1[0], v1[1]); w.w = cvt_pk_bf16(v1[2], v1[3]);
                    *(u32x4*)(O + ((size_t)(u.pn * 2 + bj) * Mrows + row) * HALF + col0) = w; } }
            asm volatile("" ::: "memory"); }
    }
};
struct EpiResF32 {
    static constexpr bool PERM = true, AFTER_DRAIN = false;
    bf16_t* xb; float* rowsq; int ldc;
    __device__ __forceinline__ void operator()(const f32x4 (&acc)[2][2][4][2], const Unit& u, int wr, int wc, int fr, int fq) const {
        const int col0 = u.pn * BM + wc * 32 + 8 * fq;
#pragma unroll
        for (int ai = 0; ai < 2; ++ai) {
            u32x4 pre[4][2];
#pragma unroll
            for (int m = 0; m < 4; ++m) { const size_t off = (size_t)(u.pm * BM + ai * HALF + wr * 64 + m * 16 + fr) * ldc + col0;
#pragma unroll
                for (int bj = 0; bj < 2; ++bj) pre[m][bj] = *(const u32x4*)(xb + off + bj * HALF); }
            asm volatile("" ::: "memory");
#pragma unroll
            for (int m = 0; m < 4; ++m) { const int row = u.pm * BM + ai * HALF + wr * 64 + m * 16 + fr; const size_t off = (size_t)row * ldc + col0; float ss = 0.f;
#pragma unroll
                for (int bj = 0; bj < 2; ++bj) { const u32x4 pb = pre[m][bj]; const f32x4 a0 = acc[ai][bj][m][0], a1 = acc[ai][bj][m][1];
                    u32x4 w; w.x = cvt_pk_bf16(__uint_as_float(pb.x << 16) + a0[0], __uint_as_float(pb.x & 0xffff0000u) + a0[1]); w.y = cvt_pk_bf16(__uint_as_float(pb.y << 16) + a0[2], __uint_as_float(pb.y & 0xffff0000u) + a0[3]);
                    w.z = cvt_pk_bf16(__uint_as_float(pb.z << 16) + a1[0], __uint_as_float(pb.z & 0xffff0000u) + a1[1]); w.w = cvt_pk_bf16(__uint_as_float(pb.w << 16) + a1[2], __uint_as_float(pb.w & 0xffff0000u) + a1[3]);
#pragma unroll
                    for (int q = 0; q < 4; ++q) { const float r0 = __uint_as_float(w[q] << 16), r1 = __uint_as_float(w[q] & 0xffff0000u); ss += r0 * r0 + r1 * r1; }
                    *(u32x4*)(xb + off + bj * HALF) = w; }
                ss += __shfl_xor(ss, 16); ss += __shfl_xor(ss, 32);
                if (fq == 0) rowsq[(size_t)row * 32 + u.pn * 4 + wc] = ss; }
            asm volatile("" ::: "memory"); }
    }
};


template <class Epi, class Sched, bool ALIGN_EPI = false, bool SP2 = false>
__device__ __forceinline__ void gemm_phase(PG8_LAS unsigned char* lds, const Gemm g, const Sched& S, const Epi& E) {
    const int tid = otid(), wid = __builtin_amdgcn_readfirstlane(tid >> 6), lane = tid & 63, wr = wid >> 2, wc = wid & 3, fr = lane & 15, fq = lane >> 4;
    const int K = g.K, nt = K / BK;
    unsigned voffA[2], voffB[2];
#pragma unroll
    for (int i = 0; i < 2; ++i) { int R, C; stage_rc(tid * 16 + i * 8192, R, C); const int Rb = Epi::PERM ? ((R & ~31) + perm32(R & 31)) : R;
        voffA[i] = (unsigned)(R * K + C) * 2u; voffB[i] = (unsigned)(Rb * K + C) * 2u; }
    const size_t kstep = (size_t)(BK * 2);
    const size_t hstep = (size_t)HALF * K * 2;
    const size_t tstep = 2 * hstep;
    const unsigned ldsw = (unsigned)wid * 1024u;
    const int aoff = lds_byte(wr * 64 + fr, fq * 8), boff = lds_byte(wc * 32 + fr, fq * 8);
#define PG8_SA(b, h) (((b) * 2 + (h)) * HTB)
#define PG8_SB(b, h) ((4 + (b) * 2 + (h)) * HTB)
#define PG8_STAGE(bufoff, gbase, voff) do { _Pragma("unroll") for (int _i = 0; _i < 2; ++_i) \
        __builtin_amdgcn_global_load_lds((const unsigned*)((const char*)(gbase) + (voff)[_i]), (PG8_LAS unsigned*)(lds + (bufoff) + ldsw + _i * 8192), 16, 0, 0); } while (0)
#define PG8_LDA(dst, b, h) do { _Pragma("unroll") for (int m = 0; m < 4; ++m) _Pragma("unroll") for (int k = 0; k < 2; ++k) dst[m][k] = *(const PG8_LAS bf16x8*)(lds + PG8_SA(b, h) + aoff + m * 2048 + k * 1024); } while (0)
#define PG8_LDB(dst, b, h) do { _Pragma("unroll") for (int n = 0; n < 2; ++n) _Pragma("unroll") for (int k = 0; k < 2; ++k) dst[n][k] = *(const PG8_LAS bf16x8*)(lds + PG8_SB(b, h) + boff + n * 2048 + k * 1024); } while (0)
#define PG8_MMA(ai, bj, At, Bt) do { __builtin_amdgcn_s_setprio(1); _Pragma("unroll") for (int m = 0; m < 4; ++m) _Pragma("unroll") for (int n = 0; n < 2; ++n) _Pragma("unroll") for (int k = 0; k < 2; ++k) \
        acc[ai][bj][m][n] = __builtin_amdgcn_mfma_f32_16x16x32_bf16(Bt[n][k], At[m][k], acc[ai][bj][m][n], 0, 0, 0); __builtin_amdgcn_s_setprio(0); } while (0)
#define PG8_WAIT_V(n) asm volatile("s_waitcnt vmcnt(" #n ")" ::: "memory")
#define PG8_WAIT_L(n) asm volatile("s_waitcnt lgkmcnt(" #n ")" ::: "memory")
#define PG8_BAR __builtin_amdgcn_s_barrier()
#define PG8_SCHED __builtin_amdgcn_sched_barrier(0)
    Unit cur, nxt; int ui = 0;
    if (!S.next(0, cur)) return;
    f32x4 acc[2][2][4][2];
#pragma unroll
    for (int a = 0; a < 2; ++a)
#pragma unroll
        for (int b = 0; b < 2; ++b)
#pragma unroll
            for (int m = 0; m < 4; ++m)
#pragma unroll
                for (int n = 0; n < 2; ++n) acc[a][b][m][n] = (f32x4){0.f, 0.f, 0.f, 0.f};
    bf16x8 At[4][2], B0[2][2], B1[2][2];
    const char* cA = (const char*)g.A + (size_t)cur.pm * tstep; const char* cB = (const char*)g.Bt + (size_t)cur.pn * tstep;
    S.a_ready(cur);
    if constexpr (SP2) {
        PG8_STAGE(PG8_SB(0, 0), cB, voffB); PG8_STAGE(PG8_SB(0, 1), cB + hstep, voffB); PG8_STAGE(PG8_SA(0, 0), cA, voffA); PG8_STAGE(PG8_SA(0, 1), cA + hstep, voffA);
        if (wr == 1) PG8_BAR;
        PG8_WAIT_V(2); PG8_BAR;
        PG8_STAGE(PG8_SB(1, 0), cB + kstep, voffB); PG8_STAGE(PG8_SA(1, 0), cA + kstep, voffA); PG8_STAGE(PG8_SB(1, 1), cB + hstep + kstep, voffB);
        PG8_WAIT_V(6); PG8_BAR;
    } else {
        PG8_STAGE(PG8_SB(0, 0), cB, voffB); PG8_STAGE(PG8_SA(0, 0), cA, voffA); PG8_STAGE(PG8_SB(0, 1), cB + hstep, voffB); PG8_STAGE(PG8_SA(0, 1), cA + hstep, voffA);
        if (wr == 1) PG8_BAR;
        PG8_WAIT_V(4); PG8_BAR;
        PG8_STAGE(PG8_SB(1, 0), cB + kstep, voffB); PG8_STAGE(PG8_SA(1, 0), cA + kstep, voffA); PG8_STAGE(PG8_SB(1, 1), cB + hstep + kstep, voffB);
        PG8_WAIT_V(6); PG8_BAR;
    }
    for (;;) {
        const bool has_next = S.next(ui + 1, nxt);
        const char* nA = has_next ? (const char*)g.A + (size_t)nxt.pm * tstep : cA; const char* nB = has_next ? (const char*)g.Bt + (size_t)nxt.pn * tstep : cB;
        for (int t = 0; t < nt; t += 2) {
            const bool last = (t == nt - 2);
            const char* a1 = cA + (size_t)(t + 1) * kstep;
            const char* a2 = last ? nA : cA + (size_t)(t + 2) * kstep; const char* b2 = last ? nB : cB + (size_t)(t + 2) * kstep;
            const char* a3 = a2 + kstep; const char* b3 = b2 + kstep;
            if (last && has_next) S.a_ready(nxt);
            if constexpr (SP2) {
            PG8_LDB(B0, 0, 0); PG8_LDB(B1, 0, 1); PG8_SCHED; PG8_LDA(At, 0, 0); PG8_STAGE(PG8_SA(1, 1), a1 + hstep, voffA);
            PG8_WAIT_V(8); PG8_WAIT_L(0); PG8_BAR; PG8_MMA(0, 0, At, B0); PG8_MMA(0, 1, At, B1); PG8_BAR; PG8_SCHED;
            PG8_LDA(At, 0, 1); PG8_STAGE(PG8_SB(0, 0), b2, voffB); PG8_STAGE(PG8_SB(0, 1), b2 + hstep, voffB); PG8_STAGE(PG8_SA(0, 0), a2, voffA);
            PG8_WAIT_V(8); PG8_WAIT_L(0); PG8_BAR; PG8_MMA(1, 0, At, B0); PG8_MMA(1, 1, At, B1); PG8_BAR; PG8_SCHED;
            PG8_LDB(B0, 1, 0); PG8_LDB(B1, 1, 1); PG8_SCHED; PG8_LDA(At, 1, 0); PG8_STAGE(PG8_SA(0, 1), a2 + hstep, voffA);
            PG8_WAIT_V(8); PG8_WAIT_L(0); PG8_BAR; PG8_MMA(0, 0, At, B0); PG8_MMA(0, 1, At, B1); PG8_BAR; PG8_SCHED;
            PG8_LDA(At, 1, 1); PG8_STAGE(PG8_SB(1, 0), b3, voffB); PG8_STAGE(PG8_SB(1, 1), b3 + hstep, voffB); PG8_STAGE(PG8_SA(1, 0), a3, voffA);
            PG8_WAIT_V(8); PG8_WAIT_L(0); PG8_BAR; PG8_MMA(1, 0, At, B0); PG8_MMA(1, 1, At, B1); PG8_BAR; PG8_SCHED;
            } else {
            PG8_LDB(B0, 0, 0); PG8_SCHED; PG8_LDA(At, 0, 0); PG8_STAGE(PG8_SA(1, 1), a1 + hstep, voffA);
            PG8_WAIT_L(8); PG8_BAR; PG8_WAIT_L(0); PG8_MMA(0, 0, At, B0); PG8_BAR; PG8_SCHED;
            PG8_LDB(B1, 0, 1); PG8_STAGE(PG8_SB(0, 0), b2, voffB);
            PG8_BAR; PG8_WAIT_L(0); PG8_MMA(0, 1, At, B1); PG8_BAR;
            PG8_LDA(At, 0, 1); PG8_STAGE(PG8_SA(0, 0), a2, voffA);
            PG8_BAR; PG8_WAIT_L(0); PG8_MMA(1, 0, At, B0); PG8_BAR; PG8_SCHED;
            PG8_STAGE(PG8_SB(0, 1), b2 + hstep, voffB);
            PG8_WAIT_V(6); PG8_BAR; PG8_MMA(1, 1, At, B1); PG8_BAR;
            PG8_LDB(B0, 1, 0); PG8_SCHED; PG8_LDA(At, 1, 0); PG8_STAGE(PG8_SA(0, 1), a2 + hstep, voffA);
            PG8_WAIT_L(8); PG8_BAR; PG8_WAIT_L(0); PG8_MMA(0, 0, At, B0); PG8_BAR; PG8_SCHED;
            PG8_LDB(B1, 1, 1); PG8_STAGE(PG8_SB(1, 0), b3, voffB);
            PG8_BAR; PG8_WAIT_L(0); PG8_MMA(0, 1, At, B1); PG8_BAR;
            PG8_LDA(At, 1, 1); PG8_STAGE(PG8_SA(1, 0), a3, voffA);
            PG8_BAR; PG8_WAIT_L(0); PG8_MMA(1, 0, At, B0); PG8_BAR; PG8_SCHED;
            PG8_STAGE(PG8_SB(1, 1), b3 + hstep, voffB);
            PG8_WAIT_V(6); PG8_BAR; PG8_MMA(1, 1, At, B1); PG8_BAR;
            }
        }
        if constexpr (ALIGN_EPI) { if (wr == 0) PG8_BAR; }
        if constexpr (!Epi::AFTER_DRAIN) { E(acc, cur, wr, wc, fr, fq); S.done(cur); }
        if (!has_next) break;
#pragma unroll
        for (int a = 0; a < 2; ++a)
#pragma unroll
            for (int b = 0; b < 2; ++b)
#pragma unroll
                for (int m = 0; m < 4; ++m)
#pragma unroll
                    for (int n = 0; n < 2; ++n) acc[a][b][m][n] = (f32x4){0.f, 0.f, 0.f, 0.f};
        cur = nxt; cA = nA; cB = nB; ++ui;
        if constexpr (ALIGN_EPI) { if (wr == 1) PG8_BAR; }
    }
    PG8_WAIT_V(0);
    if constexpr (!ALIGN_EPI) { if (wr == 0) PG8_BAR; }
    PG8_BAR;
    if constexpr (Epi::AFTER_DRAIN) { E.fused(acc, cur, wr, wc, fr, fq, lds, wid, lane); S.done(cur); }
#undef PG8_SA
#undef PG8_SB
#undef PG8_STAGE
#undef PG8_LDA
#undef PG8_LDB
#undef PG8_MMA
#undef PG8_WAIT_V
#undef PG8_WAIT_L
#undef PG8_BAR
#undef PG8_SCHED
}
}
#define PG8_SP2 true
#define PG8_ALIGN true
namespace att {
using bf16 = __hip_bfloat16;
constexpr int D = 128, NW = 8, QBLK = 32, KVBLK = 64;
constexpr float SCALE = 0.088388347648318440f;
constexpr float THR = 8.f;
constexpr size_t SHM_V = KVBLK * D * 2, SHM_K = KVBLK * D * 2, SHM_ATTN = 2 * SHM_V + 2 * SHM_K + NW * 64 * 4;
using bf16x8 = __attribute__((ext_vector_type(8))) short;
using s16x4  = __attribute__((ext_vector_type(4))) short;
using f32x16 = __attribute__((ext_vector_type(16))) float;
using f32x8  = __attribute__((ext_vector_type(8))) float;
using u32x4  = __attribute__((ext_vector_type(4))) unsigned;
#define KSWZ(row, colB) ((row) * 256 + ((colB) ^ (((row) & 7) << 4)))
#define SBAR() __builtin_amdgcn_sched_barrier(0)
__device__ __forceinline__ int crow(int r, int hi) { return (r & 3) + 8 * (r >> 2) + 4 * hi; }
__device__ __forceinline__ unsigned cvtpk(float lo, float hi) {
  unsigned r; asm("v_cvt_pk_bf16_f32 %0, %1, %2" : "=v"(r) : "v"(lo), "v"(hi)); return r;
}
template <typename TIn> struct Stage;
template <> struct Stage<bf16>  { using T = bf16x8;
  __device__ static __forceinline__ T ld8(const bf16* p) { return *reinterpret_cast<const bf16x8*>(p); }
  __device__ static __forceinline__ bf16x8 tobf(T x) { return x; } };
template <> struct Stage<float> { using T = f32x8;
  __device__ static __forceinline__ T ld8(const float* p) { return *reinterpret_cast<const f32x8*>(p); }
  __device__ static __forceinline__ bf16x8 tobf(T x) {
    u32x4 w = {cvtpk(x[0], x[1]), cvtpk(x[2], x[3]), cvtpk(x[4], x[5]), cvtpk(x[6], x[7])}; return *reinterpret_cast<bf16x8*>(&w); } };

__device__ __forceinline__ void partialSM(f32x16& p0, f32x16& p1, float& m_reg, float& mn, float& alpha) {
  constexpr float C = SCALE * 1.4426950408889634f;
  float pmax = p0[0]; for (int r = 1; r < 16; ++r) pmax = fmaxf(pmax, p0[r]); for (int r = 0; r < 16; ++r) pmax = fmaxf(pmax, p1[r]);
  { auto rr = __builtin_amdgcn_permlane32_swap(__float_as_uint(pmax), __float_as_uint(pmax), false, false);
    pmax = fmaxf(__uint_as_float(rr[0]), __uint_as_float(rr[1])); }
  if (__builtin_expect(__all(pmax - m_reg <= THR / SCALE), 1)) { mn = m_reg; alpha = 1.f; }
  else { mn = fmaxf(m_reg, pmax); alpha = __builtin_amdgcn_exp2f((m_reg - mn) * C); m_reg = mn; }
  float mnC = -mn * C;
  for (int r = 0; r < 16; ++r) p0[r] = fmaf(p0[r], C, mnC); for (int r = 0; r < 16; ++r) p1[r] = fmaf(p1[r], C, mnC);
  for (int r = 0; r < 16; ++r) p0[r] = __builtin_amdgcn_exp2f(p0[r]);
}
__device__ __forceinline__ void finishSM(f32x16& p0, f32x16& p1, float alpha, float& l_reg, bf16x8& pa0, bf16x8& pa1, bf16x8& pa2, bf16x8& pa3) {
  for (int r = 0; r < 16; ++r) p1[r] = __builtin_amdgcn_exp2f(p1[r]);
  float ps = 0; for (int r = 0; r < 16; ++r) ps += p0[r]; for (int r = 0; r < 16; ++r) ps += p1[r];
  { auto rr = __builtin_amdgcn_permlane32_swap(__float_as_uint(ps), __float_as_uint(ps), false, false);
    ps = __uint_as_float(rr[0]) + __uint_as_float(rr[1]); }
  l_reg = l_reg * alpha + ps;
#define PK4(P, BASE, OUT) do { unsigned a0 = cvtpk(P[BASE + 0], P[BASE + 1]), a1 = cvtpk(P[BASE + 2], P[BASE + 3]);   \
    unsigned b0 = cvtpk(P[BASE + 4], P[BASE + 5]), b1 = cvtpk(P[BASE + 6], P[BASE + 7]);                              \
    u32x4 w = {a0, a1, b0, b1}; OUT = *reinterpret_cast<bf16x8*>(&w); } while (0)
  PK4(p0, 0, pa0); PK4(p0, 8, pa1); PK4(p1, 0, pa2); PK4(p1, 8, pa3);
#undef PK4
}
__device__ __forceinline__ void qkt(f32x16& p0, f32x16& p1, const bf16* Ks, const bf16x8* qr, int r32, int hi) {
  p0 = f32x16{}; p1 = f32x16{};
  for (int d0 = 0; d0 < 8; ++d0) { int cb = (d0 * 16 + hi * 8) * 2;
    bf16x8 b0 = *reinterpret_cast<const bf16x8*>((const char*)Ks + KSWZ(r32, cb));
    bf16x8 b1 = *reinterpret_cast<const bf16x8*>((const char*)Ks + KSWZ(32 + r32, cb));
    p0 = __builtin_amdgcn_mfma_f32_32x32x16_bf16(b0, qr[d0], p0, 0, 0, 0);
    p1 = __builtin_amdgcn_mfma_f32_32x32x16_bf16(b1, qr[d0], p1, 0, 0, 0); }
}
__device__ __forceinline__ int v_st(int k, int c) { const int kk = (k & ~0xC) | ((k & 4) << 1) | ((k & 8) >> 1); return ((kk >> 3) * 4 + (c >> 5)) * 512 + ((kk & 7) * 32 + (c & 31)) * 2; }
__device__ __forceinline__ int v_rd_base(int lane) { return ((lane & 3) << 3) | (((lane >> 2) & 3) << 6) | (((lane >> 4) & 1) << 5) | (((lane >> 5) & 1) << 8); }
constexpr int v_rd_off(int d0, int ks, int half) { return d0 * 512 + ks * 4096 + half * 2048; }
template <int OFF> __device__ __forceinline__ s16x4 tr_read(int vb) {
  s16x4 r; asm volatile("ds_read_b64_tr_b16 %0, %1 offset:%2" : "=&v"(r) : "v"(vb), "i"(OFF) : "memory"); return r;
}
template <int D0> __device__ __forceinline__ void pv_one(f32x16& od, int vb, bf16x8 pa0, bf16x8 pa1, bf16x8 pa2, bf16x8 pa3) {
  const s16x4 l0 = tr_read<v_rd_off(D0, 0, 0)>(vb), h0 = tr_read<v_rd_off(D0, 0, 1)>(vb), l1 = tr_read<v_rd_off(D0, 1, 0)>(vb), h1 = tr_read<v_rd_off(D0, 1, 1)>(vb);
  const s16x4 l2 = tr_read<v_rd_off(D0, 2, 0)>(vb), h2 = tr_read<v_rd_off(D0, 2, 1)>(vb), l3 = tr_read<v_rd_off(D0, 3, 0)>(vb), h3 = tr_read<v_rd_off(D0, 3, 1)>(vb);
  asm volatile("s_waitcnt lgkmcnt(0)" ::: "memory"); SBAR();
#define PK(L, H) (bf16x8){L[0], L[1], L[2], L[3], H[0], H[1], H[2], H[3]}
  od = __builtin_amdgcn_mfma_f32_32x32x16_bf16(pa0, PK(l0, h0), od, 0, 0, 0);
  od = __builtin_amdgcn_mfma_f32_32x32x16_bf16(pa1, PK(l1, h1), od, 0, 0, 0);
  od = __builtin_amdgcn_mfma_f32_32x32x16_bf16(pa2, PK(l2, h2), od, 0, 0, 0);
  od = __builtin_amdgcn_mfma_f32_32x32x16_bf16(pa3, PK(l3, h3), od, 0, 0, 0);
#undef PK
}
struct VFrag { s16x4 l0, h0, l1, h1, l2, h2, l3, h3; };
template <int D0> __device__ __forceinline__ void pv_rd(VFrag& f, int vb) {
  f.l0 = tr_read<v_rd_off(D0, 0, 0)>(vb); f.h0 = tr_read<v_rd_off(D0, 0, 1)>(vb); f.l1 = tr_read<v_rd_off(D0, 1, 0)>(vb); f.h1 = tr_read<v_rd_off(D0, 1, 1)>(vb);
  f.l2 = tr_read<v_rd_off(D0, 2, 0)>(vb); f.h2 = tr_read<v_rd_off(D0, 2, 1)>(vb); f.l3 = tr_read<v_rd_off(D0, 3, 0)>(vb); f.h3 = tr_read<v_rd_off(D0, 3, 1)>(vb);
}
__device__ __forceinline__ void pv_mm(f32x16& od, const VFrag& f, bf16x8 pa0, bf16x8 pa1, bf16x8 pa2, bf16x8 pa3) {
#define PK(L, H) (bf16x8){L[0], L[1], L[2], L[3], H[0], H[1], H[2], H[3]}
  od = __builtin_amdgcn_mfma_f32_32x32x16_bf16(pa0, PK(f.l0, f.h0), od, 0, 0, 0);
  od = __builtin_amdgcn_mfma_f32_32x32x16_bf16(pa1, PK(f.l1, f.h1), od, 0, 0, 0);
  od = __builtin_amdgcn_mfma_f32_32x32x16_bf16(pa2, PK(f.l2, f.h2), od, 0, 0, 0);
  od = __builtin_amdgcn_mfma_f32_32x32x16_bf16(pa3, PK(f.l3, f.h3), od, 0, 0, 0);
#undef PK
}
#define PV_WAIT(n) do { asm volatile("s_waitcnt lgkmcnt(" #n ")" ::: "memory"); SBAR(); } while (0)
__device__ __forceinline__ void pv_d0(f32x16* o, int vb, bf16x8 pa0, bf16x8 pa1, bf16x8 pa2, bf16x8 pa3) {
#if MK_PVPIPE
  VFrag fa, fb;
  pv_rd<0>(fa, vb); pv_rd<1>(fb, vb);
  PV_WAIT(8); pv_mm(o[0], fa, pa0, pa1, pa2, pa3); SBAR();
  pv_rd<2>(fa, vb);
  PV_WAIT(8); pv_mm(o[1], fb, pa0, pa1, pa2, pa3); SBAR();
  pv_rd<3>(fb, vb);
  PV_WAIT(8); pv_mm(o[2], fa, pa0, pa1, pa2, pa3); SBAR();
  PV_WAIT(0); pv_mm(o[3], fb, pa0, pa1, pa2, pa3);
#else
  pv_one<0>(o[0], vb, pa0, pa1, pa2, pa3); pv_one<1>(o[1], vb, pa0, pa1, pa2, pa3); pv_one<2>(o[2], vb, pa0, pa1, pa2, pa3); pv_one<3>(o[3], vb, pa0, pa1, pa2, pa3);
#endif
}
constexpr int crow0(int r) { return (r & 3) + 8 * (r >> 2); }
constexpr float LOG2E = 1.4426950408889634f;
__device__ __forceinline__ void partialSM_neg(f32x16& p0, f32x16& p1, float& m_reg, f32x16& negm, float& alpha, int bounded) {
  if (bounded) {
    alpha = 1.f;
#pragma unroll
    for (int r = 0; r < 16; ++r) p0[r] = __builtin_amdgcn_exp2f(p0[r]);
    return;
  }
  float pmax = p0[0];
#pragma unroll
  for (int r = 1; r < 16; ++r) pmax = fmaxf(pmax, p0[r]);
#pragma unroll
  for (int r = 0; r < 16; ++r) pmax = fmaxf(pmax, p1[r]);
  { auto rr = __builtin_amdgcn_permlane32_swap(__float_as_uint(pmax), __float_as_uint(pmax), false, false);
    pmax = fmaxf(__uint_as_float(rr[0]), __uint_as_float(rr[1])); }
  if (__builtin_expect(__all(pmax <= THR), 1)) { alpha = 1.f; }
  else { const float dl = fmaxf(pmax, 0.f); m_reg += dl; alpha = __builtin_amdgcn_exp2f(-dl);
#pragma unroll
    for (int r = 0; r < 16; ++r) { p0[r] -= dl; p1[r] -= dl; negm[r] = -m_reg; } }
#pragma unroll
  for (int r = 0; r < 16; ++r) p0[r] = __builtin_amdgcn_exp2f(p0[r]);
}
__device__ __forceinline__ void partialSM_dil(f32x16& p0, f32x16& p1, float& m_reg, float& mn, float& alpha, float dq, float dlo, float dhi, float nslopeC) {
  constexpr float C = SCALE * LOG2E;
#pragma unroll
  for (int r = 0; r < 16; ++r) {
    const float d0 = dq + (float)crow0(r), d1 = d0 + 32.f;
    const float t0 = fmaf(p0[r], C, nslopeC * fabsf(d0)), t1 = fmaf(p1[r], C, nslopeC * fabsf(d1));
    p0[r] = (d0 >= dlo && d0 <= dhi) ? t0 : -1e30f;
    p1[r] = (d1 >= dlo && d1 <= dhi) ? t1 : -1e30f;
  }
  float pmax = p0[0];
#pragma unroll
  for (int r = 1; r < 16; ++r) pmax = fmaxf(pmax, p0[r]);
#pragma unroll
  for (int r = 0; r < 16; ++r) pmax = fmaxf(pmax, p1[r]);
  { auto rr = __builtin_amdgcn_permlane32_swap(__float_as_uint(pmax), __float_as_uint(pmax), false, false);
    pmax = fmaxf(__uint_as_float(rr[0]), __uint_as_float(rr[1])); }
  if (__builtin_expect(__all(pmax - m_reg <= THR * LOG2E), 1)) { mn = m_reg; alpha = 1.f; }
  else { mn = fmaxf(m_reg, pmax); alpha = __builtin_amdgcn_exp2f(m_reg - mn); m_reg = mn; }
#pragma unroll
  for (int r = 0; r < 16; ++r) { p0[r] = p0[r] - mn; p1[r] = p1[r] - mn; }
#pragma unroll
  for (int r = 0; r < 16; ++r) p0[r] = __builtin_amdgcn_exp2f(p0[r]);
}

template <bool DIL>
__device__ __forceinline__ void attn_body(const bf16* __restrict__ Qb, const bf16* __restrict__ Kh, const bf16* __restrict__ Vh, long qs, long ks,
                                          bf16* __restrict__ Ob, long os, float* __restrict__ lse_o, int lse_s, int i0, int nsub, float nslopeC, int seq, char* lds) {
  typedef __attribute__((address_space(3))) unsigned lds_u32;
  using St = Stage<bf16>;
  const int tid = otid(), wid = __builtin_amdgcn_readfirstlane(tid >> 6), lane = tid & 63, r32 = lane & 31, hi = lane >> 5;
  char* V_lds = lds + 4 * SHM_K; char* K_lds = lds;
  float* ws = (float*)(lds + 4 * SHM_K + 4 * SHM_V) + wid * 64; float* li_l = ws; float* al_l = ws + 32;
  float m_reg = -1e30f, l_reg = 0; f32x16 o[4] = {}; bf16x8 qr[8];
  const bf16* Qw = Qb + (long)(wid * QBLK + r32) * qs + hi * 8;
#pragma unroll
  for (int d0 = 0; d0 < 8; ++d0) qr[d0] = St::ld8(Qw + d0 * 16);
  const int vb0 = (int)(uintptr_t)V_lds + v_rd_base(lane);
  const int kb = DIL ? i0 - 64 : 0;
#define KROW(k) (DIL ? (long)min(max(kb + (k), 0), nsub - 1) : (long)(k))
  int krow[2], kcol[2], vrow[2], vcol[2];
#pragma unroll
  for (int i = 0; i < 2; ++i) { const int pc = 2 * wid + i;
    krow[i] = pc * 4 + (lane >> 4); kcol[i] = (((lane & 15) ^ (krow[i] & 7)) << 3);
    const int sub = pc * 2 + (lane >> 5), kk = ((sub >> 2) << 3) + ((lane & 31) >> 2);
    vrow[i] = kk; vcol[i] = ((sub & 3) << 5) + ((lane & 3) << 3); }
  unsigned kdo[2], vdo[2];
#pragma unroll
  for (int i = 0; i < 2; ++i) { kdo[i] = (unsigned)(krow[i] * (int)ks + kcol[i]); vdo[i] = (unsigned)(vrow[i] * (int)ks + vcol[i]); }
#define DMA(t, buf) do { if constexpr (DIL) { _Pragma("unroll") for (int i_ = 0; i_ < 2; ++i_) { \
      __builtin_amdgcn_global_load_lds((const unsigned*)(Kh + KROW((t) * KVBLK + krow[i_]) * ks + kcol[i_]), (lds_u32*)(K_lds + (buf) * SHM_K + (2 * wid + i_) * 1024), 16, 0, 0); \
      __builtin_amdgcn_global_load_lds((const unsigned*)(Vh + KROW((t) * KVBLK + vrow[i_]) * ks + vcol[i_]), (lds_u32*)(V_lds + (buf) * SHM_V + (2 * wid + i_) * 1024), 16, 0, 0); } } \
    else { const bf16* Kt_ = Kh + (long)(t) * (KVBLK * ks); const bf16* Vt_ = Vh + (long)(t) * (KVBLK * ks); _Pragma("unroll") for (int i_ = 0; i_ < 2; ++i_) { \
      __builtin_amdgcn_global_load_lds((const unsigned*)(Kt_ + kdo[i_]), (lds_u32*)(K_lds + (buf) * SHM_K + (2 * wid + i_) * 1024), 16, 0, 0); \
      __builtin_amdgcn_global_load_lds((const unsigned*)(Vt_ + vdo[i_]), (lds_u32*)(V_lds + (buf) * SHM_V + (2 * wid + i_) * 1024), 16, 0, 0); } } } while (0)
#define ENDSTEP(j) do { if ((j) + 2 < NT) asm volatile("s_waitcnt vmcnt(4) lgkmcnt(0)\n\ts_barrier" ::: "memory"); else asm volatile("s_waitcnt vmcnt(0) lgkmcnt(0)\n\ts_barrier" ::: "memory"); } while (0)
#define RESC(a) do { if (__any((a) < 1.f)) { if (hi == 0) al_l[r32] = (a); asm volatile("s_waitcnt lgkmcnt(0)" ::: "memory"); \
    for (int d = 0; d < 4; ++d) for (int r = 0; r < 16; ++r) o[d][r] *= al_l[crow(r, hi)]; } } while (0)
#define PSM(P0, P1, MN, AL, jt) do { if constexpr (DIL) { const int t_ = otid(), iq_ = (t_ >> 6) * QBLK + (t_ & 31), hi_ = (t_ >> 5) & 1; \
      partialSM_dil(P0, P1, m_reg, MN, AL, (float)(-64 - iq_ + 4 * hi_ + 64 * (jt)), fmaxf(-64.f, (float)(-(i0 + iq_))), fminf(64.f, (float)(nsub - 1 - (i0 + iq_))), nslopeC); } \
    else partialSM(P0, P1, m_reg, MN, AL); } while (0)
#if MK_SGB
#define SGB_A() do { __builtin_amdgcn_sched_group_barrier(0x100, 4, 0); \
    _Pragma("unroll") for (int g_ = 0; g_ < 12; ++g_) { __builtin_amdgcn_sched_group_barrier(0x008, 1, 0); __builtin_amdgcn_sched_group_barrier(0x100, 1, 0); __builtin_amdgcn_sched_group_barrier(0x002, 6, 0); } \
    _Pragma("unroll") for (int g_ = 0; g_ < 4; ++g_) { __builtin_amdgcn_sched_group_barrier(0x008, 1, 0); __builtin_amdgcn_sched_group_barrier(0x002, 6, 0); } } while (0)
#else
#define SGB_A() do {} while (0)
#endif
#define KBUF(j) ((const bf16*)(K_lds + ((j) & 3) * SHM_K))
#define VBUF(j) (vb0 + ((j) & 3) * (int)SHM_V)
  f32x16 pA0, pA1, pB0, pB1; float mnA, mnB, alA, alB; bf16x8 pa0, pa1, pa2, pa3; const int NT = DIL ? 6 : seq / KVBLK;
  DMA(0, 0); DMA(1, 1);
  if constexpr (!DIL && MK_PP) { DMA(2, 2); asm volatile("s_waitcnt vmcnt(8)\n\ts_barrier" ::: "memory"); }
  else asm volatile("s_waitcnt vmcnt(4)\n\ts_barrier" ::: "memory");
  struct KFrag { bf16x8 a, b; };
  int koff[4];
#pragma unroll
  for (int d0 = 0; d0 < 4; ++d0) koff[d0] = KSWZ(r32, (d0 * 16 + hi * 8) * 2);
  const int kbase0 = (int)(uintptr_t)K_lds;
#define KRD(f, d0, kb) asm volatile("ds_read_b128 %0, %2 offset:%3\n\tds_read_b128 %1, %2 offset:%4" : "=&v"(f.a), "=&v"(f.b) : "v"((kb) + koff[(d0) & 3]), "i"(((d0) >> 2) * 128), "i"(((d0) >> 2) * 128 + 8192) : "memory")
#define QMM(f, d0) do { pA0 = __builtin_amdgcn_mfma_f32_32x32x16_bf16(f.a, qr[d0], pA0, 0, 0, 0); pA1 = __builtin_amdgcn_mfma_f32_32x32x16_bf16(f.b, qr[d0], pA1, 0, 0, 0); } while (0)
#define LW(n) do { asm volatile("s_waitcnt lgkmcnt(" #n ")" ::: "memory"); SBAR(); } while (0)
  if constexpr (DIL) {
    const int rlo = wid >> 1;
    for (int j = 0; j < NT; ++j) {
      if (j + 2 < NT) DMA(j + 2, (j + 2) & 3);
      if (j >= rlo && j <= rlo + 2) {
        SBAR();
        { const int kb_ = kbase0 + (j & 3) * (int)SHM_K; KFrag k0_, k1_, k2_;
          KRD(k0_, 0, kb_); KRD(k1_, 1, kb_); KRD(k2_, 2, kb_); pA0 = f32x16{}; pA1 = f32x16{};
          LW(4); QMM(k0_, 0); SBAR(); KRD(k0_, 3, kb_);
          LW(4); QMM(k1_, 1); SBAR(); KRD(k1_, 4, kb_);
          LW(4); QMM(k2_, 2); SBAR(); KRD(k2_, 5, kb_);
          LW(4); QMM(k0_, 3); SBAR(); KRD(k0_, 6, kb_);
          LW(4); QMM(k1_, 4); SBAR(); KRD(k1_, 7, kb_);
          LW(4); QMM(k2_, 5); SBAR();
          LW(2); QMM(k0_, 6); SBAR();
          LW(0); QMM(k1_, 7); SBAR(); }
        PSM(pA0, pA1, mnA, alA, j); RESC(alA);
        finishSM(pA0, pA1, alA, l_reg, pa0, pa1, pa2, pa3); SBAR();
        pv_d0(o, VBUF(j), pa0, pa1, pa2, pa3);
      }
      if (j + 1 < NT) ENDSTEP(j);
    }
  } else if constexpr (MK_PP) {
    const bool grpB = wid >= 4;
#if MK_NEGM
    m_reg = 0.f; f32x16 negm = f32x16{};
#endif
#define PP_BAR(VM) do { if (VM) { asm volatile("s_waitcnt vmcnt(4) lgkmcnt(0)\n\ts_barrier" ::: "memory"); } else { asm volatile("s_waitcnt vmcnt(0) lgkmcnt(0)\n\ts_barrier" ::: "memory"); } } while (0)
#define PP_BAR_PLAIN() asm volatile("s_waitcnt lgkmcnt(0)\n\ts_barrier" ::: "memory")
    if (grpB) PP_BAR_PLAIN();
    qkt(pA0, pA1, KBUF(0), qr, r32, hi);
    if (grpB) PP_BAR(2 < NT); else PP_BAR_PLAIN();
    for (int t = 0; t < NT; ++t) {
      if (grpB && t + 3 < NT) DMA(t + 3, (t + 3) & 3);
#if MK_NEGM
      partialSM_neg(pA0, pA1, m_reg, negm, alA, i0); if (!i0) RESC(alA);
#else
      PSM(pA0, pA1, mnA, alA, t); RESC(alA);
#endif
      finishSM(pA0, pA1, alA, l_reg, pa0, pa1, pa2, pa3);
#if MK_PROBE_V
      { float dm_ = alA;
#pragma unroll
        for (int q_ = 0; q_ < 32; ++q_) asm volatile("v_add_f32 %0, %0, %0" : "+v"(dm_));
        if (dm_ == 123.456f) l_reg += 1.f; }
#endif
      if (!(MK_PREB && t + 1 < NT)) { if (!grpB) PP_BAR(t + 2 < NT); else PP_BAR_PLAIN(); }
      else if (!grpB) PP_BAR(t + 2 < NT);
      if (!grpB && t + 3 < NT) DMA(t + 3, (t + 3) & 3);
      SBAR();
      if (t + 1 < NT) {
        const int kb_ = kbase0 + ((t + 1) & 3) * (int)SHM_K, vb_ = VBUF(t);
        KFrag k0_, k1_; VFrag fa_, fb_;
        KRD(k0_, 0, kb_); KRD(k1_, 1, kb_); pv_rd<0>(fa_, vb_);
        if (MK_PREB && grpB) asm volatile("s_barrier" ::: "memory");
#if MK_NEGM
        LW(10); pA0 = __builtin_amdgcn_mfma_f32_32x32x16_bf16(k0_.a, qr[0], negm, 0, 0, 0); pA1 = __builtin_amdgcn_mfma_f32_32x32x16_bf16(k0_.b, qr[0], negm, 0, 0, 0); SBAR(); KRD(k0_, 2, kb_);
#else
        pA0 = f32x16{}; pA1 = f32x16{};
        LW(10); QMM(k0_, 0); SBAR(); KRD(k0_, 2, kb_);
#endif
        LW(10); QMM(k1_, 1); SBAR(); KRD(k1_, 3, kb_);
        LW(4);  pv_mm(o[0], fa_, pa0, pa1, pa2, pa3); SBAR(); pv_rd<1>(fb_, vb_);
        LW(10); QMM(k0_, 2); SBAR(); KRD(k0_, 4, kb_);
        LW(10); QMM(k1_, 3); SBAR(); KRD(k1_, 5, kb_);
        LW(4);  pv_mm(o[1], fb_, pa0, pa1, pa2, pa3); SBAR(); pv_rd<2>(fa_, vb_);
        LW(10); QMM(k0_, 4); SBAR(); KRD(k0_, 6, kb_);
        LW(10); QMM(k1_, 5); SBAR(); KRD(k1_, 7, kb_);
        LW(4);  pv_mm(o[2], fa_, pa0, pa1, pa2, pa3); SBAR(); pv_rd<3>(fb_, vb_);
        LW(10); QMM(k0_, 6); SBAR();
        LW(8);  QMM(k1_, 7); SBAR();
        LW(0);  pv_mm(o[3], fb_, pa0, pa1, pa2, pa3);
      } else pv_d0(o, VBUF(t), pa0, pa1, pa2, pa3);
      if (t + 1 < NT) { if (grpB) PP_BAR(t + 3 < NT); else PP_BAR_PLAIN(); }
    }
    if (!grpB) PP_BAR_PLAIN();
#undef PP_BAR
#undef PP_BAR_PLAIN
#undef KRD
#undef QMM
#undef LW
  } else {
  if (2 < NT) DMA(2, 2);
  qkt(pA0, pA1, KBUF(0), qr, r32, hi); PSM(pA0, pA1, mnA, alA, 0);
  ENDSTEP(0);
  for (int j = 1; j + 1 < NT; j += 2) {
    if (j + 2 < NT) DMA(j + 2, (j + 2) & 3);
    SBAR(); qkt(pB0, pB1, KBUF(j), qr, r32, hi);
    finishSM(pA0, pA1, alA, l_reg, pa0, pa1, pa2, pa3); SGB_A(); SBAR();
    pv_d0(o, VBUF(j - 1), pa0, pa1, pa2, pa3); PSM(pB0, pB1, mnB, alB, j);
    RESC(alB); ENDSTEP(j);
    if (j + 3 < NT) DMA(j + 3, (j + 3) & 3);
    SBAR(); qkt(pA0, pA1, KBUF(j + 1), qr, r32, hi);
    finishSM(pB0, pB1, alB, l_reg, pa0, pa1, pa2, pa3); SGB_A(); SBAR();
    pv_d0(o, VBUF(j), pa0, pa1, pa2, pa3); PSM(pA0, pA1, mnA, alA, j + 1);
    RESC(alA); ENDSTEP(j + 1);
  }
  SBAR(); qkt(pB0, pB1, KBUF(NT - 1), qr, r32, hi);
  finishSM(pA0, pA1, alA, l_reg, pa0, pa1, pa2, pa3); SBAR();
  pv_d0(o, VBUF(NT - 2), pa0, pa1, pa2, pa3); PSM(pB0, pB1, mnB, alB, NT - 1);
  RESC(alB);
  finishSM(pB0, pB1, alB, l_reg, pa0, pa1, pa2, pa3); SBAR();
  pv_d0(o, VBUF(NT - 1), pa0, pa1, pa2, pa3);
  }
  if (hi == 0) li_l[r32] = l_reg; asm volatile("s_waitcnt lgkmcnt(0)" ::: "memory");
  if constexpr (DIL) { if (hi == 0) lse_o[(long)(wid * QBLK + r32) * lse_s] = m_reg + __log2f(l_reg); }
  float rli[16];
#pragma unroll
  for (int r = 0; r < 16; ++r) rli[r] = __builtin_amdgcn_rcpf(li_l[crow(r, hi)]);
  bf16* Ow = Ob + (long)(wid * QBLK) * os;
#pragma unroll
  for (int r = 0; r < 16; ++r) { const int orow = crow(r, hi);
#pragma unroll
    for (int d0 = 0; d0 < 4; ++d0) Ow[(long)orow * os + d0 * 32 + r32] = __float2bfloat16(o[d0][r] * rli[r]); }
  asm volatile("s_waitcnt lgkmcnt(0)\n\ts_barrier" ::: "memory");
#undef KROW
#undef DMA
#undef ENDSTEP
#undef RESC
#undef PSM
#undef KBUF
#undef SGB_A
#undef VBUF
}
}

#define GAS __attribute__((address_space(1)))
#define LAS __attribute__((address_space(3)))
typedef unsigned short bf16_t;
typedef unsigned v4u __attribute__((ext_vector_type(4)));
typedef unsigned v2u __attribute__((ext_vector_type(2)));
typedef float f32x4 __attribute__((ext_vector_type(4)));
#define LDS_WAIT() asm volatile("s_waitcnt lgkmcnt(0)" ::: "memory")

constexpr size_t MiB = 1u << 20;
constexpr size_t WS_W1T = 0;
constexpr size_t WS_W2T = 104 * MiB;
constexpr size_t WS_H = 136 * MiB;
constexpr size_t WS_PROJ = 200 * MiB;
constexpr size_t WS_YA = 408 * MiB;
constexpr size_t WS_YB = 440 * MiB;
constexpr size_t WS_LSE = 536 * MiB;
constexpr size_t WS_ROPE = 538 * MiB;
constexpr size_t WS_XB = 540 * MiB;
constexpr size_t WS_ROWSQ = 604 * MiB;
constexpr size_t WS_END = 616 * MiB;
static_assert((size_t)DEPTH * DIN * DM * 2 <= WS_W2T - WS_W1T && (size_t)M * DIN * 2 <= WS_YA - WS_PROJ && (size_t)3 * M * DB * 2 <= WS_LSE - WS_YB, "ws map");
constexpr int LDS_BYTES = 147456;
constexpr int N_PHASES = 2 + 5 * DEPTH;

__device__ __forceinline__ unsigned f2bf(float f) { unsigned u = __builtin_bit_cast(unsigned, f); return (u + 0x7fffu + ((u >> 16) & 1u)) >> 16; }
__device__ __forceinline__ unsigned pk2(float lo, float hi) { return f2bf(lo) | (f2bf(hi) << 16); }
__device__ __forceinline__ float bflo(unsigned w) { return __uint_as_float(w << 16); }
__device__ __forceinline__ float bfhi(unsigned w) { return __uint_as_float(w & 0xffff0000u); }
__device__ __forceinline__ float wave_sum(float v) {
#pragma unroll
    for (int o = 1; o < 64; o <<= 1) v += __shfl_xor(v, o);
    return v;
}

__device__ const float INV_FREQ[32] = {1.000000000e+00f, 7.498942614e-01f, 5.623413324e-01f, 4.216965139e-01f, 3.162277639e-01f, 2.371373773e-01f, 1.778279394e-01f, 1.333521307e-01f,
    1.000000015e-01f, 7.498941571e-02f, 5.623413250e-02f, 4.216965288e-02f, 3.162277490e-02f, 2.371373773e-02f, 1.778279431e-02f, 1.333521493e-02f,
    9.999999776e-03f, 7.498941850e-03f, 5.623413250e-03f, 4.216964822e-03f, 3.162277630e-03f, 2.371373586e-03f, 1.778279431e-03f, 1.333521446e-03f,
    1.000000047e-03f, 7.498942432e-04f, 5.623413017e-04f, 4.216965172e-04f, 3.162277571e-04f, 2.371373703e-04f, 1.778279402e-04f, 1.333521504e-04f};

__device__ __forceinline__ void sincos_acc(float a, float& s, float& c) {
    const double x = (double)a, kd = __builtin_rint(x * 0.63661977236758134308);
    const int k = (int)kd; const double r = x - kd * 1.57079632679489661923, r2 = r * r;
    const double sp = r * (1.0 + r2 * (-1.0 / 6 + r2 * (1.0 / 120 + r2 * (-1.0 / 5040 + r2 * (1.0 / 362880 + r2 * (-1.0 / 39916800 + r2 * (1.0 / 6227020800.0)))))));
    const double cp = 1.0 + r2 * (-0.5 + r2 * (1.0 / 24 + r2 * (-1.0 / 720 + r2 * (1.0 / 40320 + r2 * (-1.0 / 3628800 + r2 * (1.0 / 479001600.0 + r2 * (-1.0 / 87178291200.0)))))));
    const int q = k & 3;
    const double sv = (q == 0) ? sp : (q == 1) ? cp : (q == 2) ? -sp : -cp, cv = (q == 0) ? cp : (q == 1) ? -sp : (q == 2) ? -cp : sp;
    s = (float)sv; c = (float)cv;
}

__device__ __forceinline__ void p0_transpose_item(const float* W, int K, int N, bf16_t* WT, LAS float* scr, int item, int lane, const float* kscale) {
    const int nblk = N / 32, kb = item / nblk, nb = item % nblk, k0 = 64 * kb, n0 = 32 * nb;
#pragma unroll 8
    for (int i = 0; i < 32; ++i) { const int kk = 2 * i + (lane >> 5); scr[kk * 33 + (lane & 31)] = W[(size_t)(k0 + kk) * N + n0 + (lane & 31)] * (kscale ? kscale[k0 + kk] : 1.0f); }
    LDS_WAIT(); asm volatile("" ::: "memory");
    const int c = lane & 7;
#pragma unroll
    for (int j = 0; j < 4; ++j) { const int n = (lane >> 3) + 8 * j; const LAS float* s = scr + (8 * c) * 33 + n;
        v4u o; o.x = pk2(s[0 * 33], s[1 * 33]); o.y = pk2(s[2 * 33], s[3 * 33]); o.z = pk2(s[4 * 33], s[5 * 33]); o.w = pk2(s[6 * 33], s[7 * 33]);
        *(v4u*)(WT + (size_t)(n0 + n) * K + k0 + 8 * c) = o; }
    LDS_WAIT(); asm volatile("" ::: "memory");
}

#define XB_TMO      128
#define XB_XCNT(j)  (256  + 64 * (j))
#define XB_XSUB(j)  (1280 + 64 * (j))
#define XB_XGEN(j)  (2304 + 64 * (j))
#define XB_TOP      3328
#define XB_TOPGEN   3392
#define XCD_BAR_WORDS 3456
#define XB_SPIN_CAP (1u << 18)

__device__ __forceinline__ unsigned xb_ld(unsigned* p)              { return __hip_atomic_load(p, __ATOMIC_RELAXED, __HIP_MEMORY_SCOPE_AGENT); }
__device__ __forceinline__ unsigned xb_add(unsigned* p, unsigned v) { return __hip_atomic_fetch_add(p, v, __ATOMIC_RELAXED, __HIP_MEMORY_SCOPE_AGENT); }
__device__ __forceinline__ unsigned xb_xcc_id() { return (unsigned)__builtin_amdgcn_s_getreg((3 << 11) | 20) & 0xFu; }
#define XB_SPIN(cond, bar) do { unsigned _sp = 0; while (cond) { __builtin_amdgcn_s_sleep(1); \
    if ((++_sp & 255u) == 0u) { if (xb_ld(&(bar)[XB_TMO])) break; if (_sp > XB_SPIN_CAP) { atomicAdd(&(bar)[XB_TMO], 1u); break; } } } } while (0)

struct XcdBarrier {
    unsigned* bar; unsigned x;
    volatile LAS unsigned* st;
};

__device__ __forceinline__ XcdBarrier xcd_barrier_post(unsigned* bar, volatile LAS unsigned* st) {
    XcdBarrier b; b.bar = bar; b.x = xb_xcc_id(); b.st = st;
    if (threadIdx.x == 0) (void)xb_add(&bar[XB_XCNT(b.x)], 1u);
    return b;
}
__device__ __forceinline__ void xcd_barrier_complete(unsigned* bar, unsigned x, unsigned& nloc, unsigned& nx) {
    const unsigned G = gridDim.x * gridDim.y * gridDim.z;
    unsigned sum, cnt, mine, sp = 0u;
    for (;;) {
        sum = 0u; cnt = 0u; mine = 0u;
#pragma unroll
        for (unsigned j = 0; j < 16; ++j) { const unsigned c = xb_ld(&bar[XB_XCNT(j)]); sum += c; cnt += (c > 0u) ? 1u : 0u; mine = (j == x) ? c : mine; }
        if (sum == G) break;
        __builtin_amdgcn_s_sleep(1);
        if ((++sp & 255u) == 0u) { if (xb_ld(&bar[XB_TMO])) break; if (sp > XB_SPIN_CAP) { atomicAdd(&bar[XB_TMO], 1u); break; } }
    }
    nloc = mine > 0u ? mine : 1u; nx = cnt > 0u ? cnt : 1u;
}

__device__ __forceinline__ void xcd_barrier(const XcdBarrier& b) {
    asm volatile("s_waitcnt vmcnt(0)" ::: "memory");
    __syncthreads();
    if (threadIdx.x == 0) {
        unsigned* bar = b.bar;
        __builtin_amdgcn_s_waitcnt(0);
        unsigned nloc = b.st[0], nx = b.st[1];
        if (nloc == 0u) { xcd_barrier_complete(bar, b.x, nloc, nx); b.st[0] = nloc; b.st[1] = nx; }
        const unsigned old = xb_add(&bar[XB_XSUB(b.x)], 1u);
        const unsigned gen = old / nloc;
        if (old + 1u == (gen + 1u) * nloc) {
            __builtin_amdgcn_fence(__ATOMIC_RELEASE, "agent");
            asm volatile("s_waitcnt vmcnt(0)" ::: "memory");
            const unsigned og = xb_add(&bar[XB_TOP], 1u);
            const unsigned tg = og / nx;
            if (og + 1u == (tg + 1u) * nx) xb_add(&bar[XB_TOPGEN], 1u);
            else XB_SPIN(xb_ld(&bar[XB_TOPGEN]) == tg, bar);
            __builtin_amdgcn_fence(__ATOMIC_ACQUIRE, "agent");
            xb_add(&bar[XB_XGEN(b.x)], 1u);
            asm volatile("s_waitcnt vmcnt(0)" ::: "memory");
        } else {
            XB_SPIN(xb_ld(&bar[XB_XGEN(b.x)]) == gen, bar);
            __builtin_amdgcn_fence(__ATOMIC_ACQUIRE, "agent");
            asm volatile("s_waitcnt vmcnt(0)" ::: "memory");
        }
    }
    __syncthreads();
}

constexpr size_t WS_CTL = 539 * MiB, CTL_BYTES = 16384;
constexpr int MISC_OFF = 147456 - 128;
__device__ __forceinline__ void gate_row(int m, int lane, const bf16_t* __restrict__ YA, const bf16_t* __restrict__ YB, const float* __restrict__ LSE, const bf16_t* __restrict__ PROJ,
                                         const float* __restrict__ wa, const float* __restrict__ wb, bf16_t* __restrict__ H) {
                    float ya[2][8], yb[2][8]; float ssa = 0.f, ssb = 0.f;
#pragma unroll
                    for (int j = 0; j < 2; ++j) { const int c = lane + 64 * j, hh = c >> 4;
                        const v4u a = *(const v4u*)(YA + (size_t)m * DA + 8 * c);
                        ya[j][0] = bflo(a.x); ya[j][1] = bfhi(a.x); ya[j][2] = bflo(a.y); ya[j][3] = bfhi(a.y); ya[j][4] = bflo(a.z); ya[j][5] = bfhi(a.z); ya[j][6] = bflo(a.w); ya[j][7] = bfhi(a.w);
                        const float l0 = LSE[((size_t)0 * M + m) * 8 + hh], l1 = LSE[((size_t)1 * M + m) * 8 + hh], l2 = LSE[((size_t)2 * M + m) * 8 + hh];
                        const float mx = fmaxf(l0, fmaxf(l1, l2)); const float e0 = __builtin_amdgcn_exp2f(l0 - mx), e1 = __builtin_amdgcn_exp2f(l1 - mx), e2 = __builtin_amdgcn_exp2f(l2 - mx);
                        const float inv = 1.0f / (e0 + e1 + e2); const float w0 = e0 * inv, w1 = e1 * inv, w2 = e2 * inv;
                        const v4u b0 = *(const v4u*)(YB + ((size_t)0 * M + m) * DB + 8 * c), b1 = *(const v4u*)(YB + ((size_t)1 * M + m) * DB + 8 * c), b2 = *(const v4u*)(YB + ((size_t)2 * M + m) * DB + 8 * c);
                        yb[j][0] = w0 * bflo(b0.x) + w1 * bflo(b1.x) + w2 * bflo(b2.x); yb[j][1] = w0 * bfhi(b0.x) + w1 * bfhi(b1.x) + w2 * bfhi(b2.x);
                        yb[j][2] = w0 * bflo(b0.y) + w1 * bflo(b1.y) + w2 * bflo(b2.y); yb[j][3] = w0 * bfhi(b0.y) + w1 * bfhi(b1.y) + w2 * bfhi(b2.y);
                        yb[j][4] = w0 * bflo(b0.z) + w1 * bflo(b1.z) + w2 * bflo(b2.z); yb[j][5] = w0 * bfhi(b0.z) + w1 * bfhi(b1.z) + w2 * bfhi(b2.z);
                        yb[j][6] = w0 * bflo(b0.w) + w1 * bflo(b1.w) + w2 * bflo(b2.w); yb[j][7] = w0 * bfhi(b0.w) + w1 * bfhi(b1.w) + w2 * bfhi(b2.w);
#pragma unroll
                        for (int i = 0; i < 8; ++i) { ssa += ya[j][i] * ya[j][i]; ssb += yb[j][i] * yb[j][i]; } }
                    const float ra = 1.0f / sqrtf(wave_sum(ssa) * (1.0f / DA) + EPS), rb = 1.0f / sqrtf(wave_sum(ssb) * (1.0f / DB) + EPS);
#pragma unroll
                    for (int j = 0; j < 2; ++j) { const int c = lane + 64 * j;
                        const v4u ga = *(const v4u*)(PROJ + ((size_t)(H_GA + (c >> 4)) * M + m) * HD + 8 * (c & 15)), gb = *(const v4u*)(PROJ + ((size_t)(H_GB + (c >> 4)) * M + m) * HD + 8 * (c & 15));
                        const float gaf[8] = {bflo(ga.x), bfhi(ga.x), bflo(ga.y), bfhi(ga.y), bflo(ga.z), bfhi(ga.z), bflo(ga.w), bfhi(ga.w)};
                        const float gbf[8] = {bflo(gb.x), bfhi(gb.x), bflo(gb.y), bfhi(gb.y), bflo(gb.z), bfhi(gb.z), bflo(gb.w), bfhi(gb.w)};
                        const f32x4 wa0 = *(const f32x4*)(wa + 8 * c), wa1 = *(const f32x4*)(wa + 8 * c + 4), wb0 = *(const f32x4*)(wb + 8 * c), wb1 = *(const f32x4*)(wb + 8 * c + 4);
                        float za[8], zb[8];
#pragma unroll
                        for (int i = 0; i < 8; ++i) { const float wai = i < 4 ? wa0[i & 3] : wa1[i & 3], wbi = i < 4 ? wb0[i & 3] : wb1[i & 3];
                            const float sa = gaf[i] / (1.0f + __expf(-gaf[i])), sb = gbf[i] / (1.0f + __expf(-gbf[i]));
                            za[i] = ya[j][i] * ra * wai * sa; zb[i] = yb[j][i] * rb * wbi * sb; }
                        v4u oa, ob; oa.x = pk2(za[0], za[1]); oa.y = pk2(za[2], za[3]); oa.z = pk2(za[4], za[5]); oa.w = pk2(za[6], za[7]);
                        ob.x = pk2(zb[0], zb[1]); ob.y = pk2(zb[2], zb[3]); ob.z = pk2(zb[4], zb[5]); ob.w = pk2(zb[6], zb[7]);
                        *(v4u*)(H + (size_t)m * DM + 8 * c) = oa; *(v4u*)(H + (size_t)m * DM + DA + 8 * c) = ob; }
}

struct Params { const float *x, *norm_w, *w_in, *qn, *kn, *ona, *onb, *w_out, *fnorm; float* out; unsigned char* ws; int ph_lo, ph_hi; };

__global__ void __launch_bounds__(512, 2) mk_fwd(Params p) {
    extern __shared__ __attribute__((aligned(16))) unsigned char lds[];
    volatile LAS unsigned* MISC = (volatile LAS unsigned*)((LAS unsigned char*)lds + MISC_OFF);
    if (threadIdx.x < 32) MISC[threadIdx.x] = 0u;
    __syncthreads();
    XcdBarrier bar = xcd_barrier_post((unsigned*)(p.ws + WS_CTL), MISC + 8);
    if (p.ph_lo == 0) {
        float* RCOS0 = (float*)(p.ws + WS_ROPE); float* RSIN0 = RCOS0 + 192 * 32;
        for (int i = blockIdx.x * 512 + threadIdx.x; i < 192 * 32; i += gridDim.x * 512) {
            const int pos = i >> 5, f = i & 31; const float pv = (float)(pos < 128 ? pos : pos - 128);
            float sn_, cs_; sincos_acc(pv * INV_FREQ[f], sn_, cs_); RCOS0[i] = cs_; RSIN0[i] = sn_;
        }
    }
    for (int ph = p.ph_lo; ph < p.ph_hi; ++ph) {
        const int tid = otid(), lane = tid & 63, wave = __builtin_amdgcn_readfirstlane(tid >> 6);
        int G = gridDim.x, bx = blockIdx.x; asm volatile("" : "+s"(G), "+s"(bx));
        const int vcu = (G % 8 == 0) ? (bx % 8) * (G / 8) + bx / 8 : bx;
        const int gw = vcu * 8 + wave, NGW = G * 8;
        size_t zoff = 0; asm volatile("" : "+s"(zoff));
        unsigned char* ws = p.ws + zoff;
        bf16_t* W1T = (bf16_t*)(ws + WS_W1T); bf16_t* W2T = (bf16_t*)(ws + WS_W2T); bf16_t* H = (bf16_t*)(ws + WS_H); bf16_t* PROJ = (bf16_t*)(ws + WS_PROJ);
        bf16_t* YA = (bf16_t*)(ws + WS_YA); bf16_t* YB = (bf16_t*)(ws + WS_YB); float* LSE = (float*)(ws + WS_LSE);
        float* RCOS = (float*)(ws + WS_ROPE); float* RSIN = RCOS + 192 * 32;
        bf16_t* XB = (bf16_t*)(ws + WS_XB); float* ROWSQ = (float*)(ws + WS_ROWSQ);
        if (ph == 0) {
            LAS float* scr = (LAS float*)((LAS unsigned char*)lds + wave * 16384);
            constexpr int I1 = (DM / 64) * (DIN / 32), I2 = (DM / 64) * (DM / 32), IL = I1 + I2;
            DUPREP(0) for (int it = gw; it < DEPTH * IL; it += NGW) {
                const int l = it / IL, r = it % IL;
                if (r < I1) p0_transpose_item(p.w_in + (size_t)l * DM * DIN, DM, DIN, W1T + (size_t)l * DIN * DM, scr, r, lane, p.norm_w + (size_t)l * DM);
                else p0_transpose_item(p.w_out + (size_t)l * DM * DM, DM, DM, W2T + (size_t)l * DM * DM, scr, r - I1, lane, nullptr);
            }
            for (int m = gw; m < M; m += NGW) {
                const f32x4* xr = (const f32x4*)(p.x + (size_t)m * DM) + lane; v2u* o8 = (v2u*)(XB + (size_t)m * DM) + lane; float sq = 0.f;
#pragma unroll
                for (int j = 0; j < 8; ++j) { const f32x4 v = xr[64 * j]; v2u w; w.x = pk2(v.x, v.y); w.y = pk2(v.z, v.w); o8[64 * j] = w;
                    const float r0 = bflo(w.x), r1 = bfhi(w.x), r2 = bflo(w.y), r3 = bfhi(w.y); sq += (r0 * r0 + r1 * r1) + (r2 * r2 + r3 * r3); }
                sq = wave_sum(sq); if (lane < 32) ROWSQ[(size_t)m * 32 + lane] = (lane == 0) ? sq : 0.f;
            }
        } else if (ph == N_PHASES - 1) {
            for (int m = gw; m < M; m += NGW) {
                f32x4* xr = (f32x4*)(p.out + (size_t)m * DM) + lane; const f32x4* wr_ = (const f32x4*)p.fnorm + lane; const v2u* xb8 = (const v2u*)(XB + (size_t)m * DM) + lane;
                const float rstd = 1.0f / sqrtf(wave_sum(lane < 32 ? ROWSQ[((size_t)DEPTH * M + m) * 32 + lane] : 0.f) * (1.0f / DM) + EPS);
#pragma unroll
                for (int j = 0; j < 8; ++j) { const v2u w = xb8[64 * j]; const f32x4 v = {bflo(w.x), bfhi(w.x), bflo(w.y), bfhi(w.y)}; xr[64 * j] = v * rstd * wr_[64 * j]; }
            }
        } else {
            const int l = (ph - 1) / 5, st = (ph - 1) % 5 + 1;
            if (st == 1) {
                pg8::Gemm g{XB, W1T + (size_t)l * DIN * DM, M, DIN, DM}; pg8::StaticOrder S; S.init(M, DIN, G, bx);
                pg8::EpiHeadMajor E{PROJ, M, ROWSQ + (size_t)l * M * 32, 1.0f / DM, EPS};
#ifndef MK_NO_G1
                DUPREP(2) pg8::gemm_phase<pg8::EpiHeadMajor, pg8::StaticOrder, PG8_ALIGN, PG8_SP2>((PG8_LAS unsigned char*)lds, g, S, E);
#endif
            } else if (st == 2) {
                const float* qg = p.qn + l * HD; const float* kg = p.kn + l * HD;
                constexpr int QKU = 4;
                for (int it0 = gw; it0 < M * 10 / 4; it0 += QKU * NGW) {
                    const int j = lane & 15, half = j >> 3, jj = j & 7, e = half * 64 + 4 * jj;
                    v2u a[QKU], b[QKU]; f32x4 cs[QKU], sn[QKU]; bf16_t* pp[QKU]; bool isq[QKU];
#pragma unroll
                    for (int u = 0; u < QKU; ++u) { const int it = min(it0 + u * NGW, M * 10 / 4 - 1);
                        const int g = it * 4 + (lane >> 4), row = g / 10, hs = g - row * 10; isq[u] = hs < 8;
                        pp[u] = PROJ + ((size_t)hs * M + row) * HD + e; a[u] = *(const v2u*)pp[u]; b[u] = *(const v2u*)(pp[u] + 32);
                        const int t = row & (T - 1), pos = half ? 128 + (t & 63) : (t >> 6);
                        cs[u] = *(const f32x4*)(RCOS + pos * 32 + 4 * jj); sn[u] = *(const f32x4*)(RSIN + pos * 32 + 4 * jj); }
                    asm volatile("" ::: "memory");
#pragma unroll
                    for (int u = 0; u < QKU; ++u) {
                        float x1[4] = {bflo(a[u].x), bfhi(a[u].x), bflo(a[u].y), bfhi(a[u].y)}, x2[4] = {bflo(b[u].x), bfhi(b[u].x), bflo(b[u].y), bfhi(b[u].y)};
                        float ss = 0.f;
#pragma unroll
                        for (int i = 0; i < 4; ++i) ss += x1[i] * x1[i] + x2[i] * x2[i];
                        ss += __shfl_xor(ss, 1); ss += __shfl_xor(ss, 2); ss += __shfl_xor(ss, 4); ss += __shfl_xor(ss, 8);
                        const float rstd = 1.0f / sqrtf(ss * (1.0f / HD) + EPS);
                        const float* gn = isq[u] ? qg : kg;
                        const float qsc = (MK_NEGM && isq[u]) ? att::SCALE * att::LOG2E : 1.0f;
                        const f32x4 g1 = *(const f32x4*)(gn + e), g2 = *(const f32x4*)(gn + e + 32);
                        float o1[4], o2[4];
#pragma unroll
                        for (int i = 0; i < 4; ++i) { const float y1 = x1[i] * rstd * g1[i], y2 = x2[i] * rstd * g2[i]; o1[i] = (y1 * cs[u][i] - y2 * sn[u][i]) * qsc; o2[i] = (y1 * sn[u][i] + y2 * cs[u][i]) * qsc; }
                        v2u w1, w2; w1.x = pk2(o1[0], o1[1]); w1.y = pk2(o1[2], o1[3]); w2.x = pk2(o2[0], o2[1]); w2.y = pk2(o2[2], o2[3]);
                        if (it0 + u * NGW < M * 10 / 4) { *(v2u*)pp[u] = w1; *(v2u*)(pp[u] + 32) = w2; }
                    }
                }
#ifndef MK_NO_DIL
                DUPREP(3) for (int u = vcu; u < 1536; u += G) {
                    const int pt = u >> 9, rem = u & 511, b = rem >> 8, h = (rem >> 5) & 7, w = rem & 31;
                    const int d = (pt == 0) ? 1 : (pt == 1) ? 4 : 16, res = w & (d - 1), blk = w / d, i0 = blk * 256, nsub = T / d;
                    const float slope = __builtin_amdgcn_exp2f(-(float)(h + 1));
                    const float nslopeC = -slope * (float)d * att::LOG2E;
                    const size_t tok0 = (size_t)b * T + res;
                    const att::bf16* Pb = (const att::bf16*)PROJ + ((size_t)h * M + tok0) * HD;
                    const long rs = (long)d * HD;
                    att::attn_body<true>(Pb + (size_t)H_QB * M * HD + (long)i0 * rs, Pb + (size_t)H_KB * M * HD, Pb + (size_t)H_VB * M * HD, rs, rs,
                                         (att::bf16*)YB + ((size_t)pt * M + tok0 + (size_t)i0 * d) * DB + h * HD, (long)d * DB,
                                         LSE + ((size_t)pt * M + tok0 + (size_t)i0 * d) * 8 + h, d * 8, i0, nsub, nslopeC, 0, (char*)lds);
                }
#endif
            } else if (st == 3) {
#ifndef MK_NO_DENSE
                int bounded;
                { const float* qg = p.qn + l * HD; const float* kg = p.kn + l * HD;
                  float gq = fmaxf(fabsf(qg[lane]), fabsf(qg[lane + 64])), gk = fmaxf(fabsf(kg[lane]), fabsf(kg[lane + 64]));
#pragma unroll
                  for (int o_ = 1; o_ < 64; o_ <<= 1) { gq = fmaxf(gq, __shfl_xor(gq, o_)); gk = fmaxf(gk, __shfl_xor(gk, o_)); }
                  const float bnd = gq * gk * 128.f * att::SCALE * att::LOG2E;
                  bounded = __builtin_amdgcn_readfirstlane((MK_NEGM && bnd <= 64.f) ? 1 : 0); }
                DUPREP(4) for (int u = vcu; u < 512; u += G) {
                    const int combo = u >> 7, b = combo >> 1, kvh = combo & 1, h = kvh * 4 + ((u >> 5) & 3), qb = u & 31;
                    const att::bf16* Pb = (const att::bf16*)PROJ + (size_t)b * T * HD;
                    att::attn_body<false>(Pb + ((size_t)(H_QA + h) * M + qb * 256) * HD, Pb + (size_t)(H_KA + kvh) * M * HD, Pb + (size_t)(H_VA + kvh) * M * HD, HD, HD,
                                          (att::bf16*)YA + ((size_t)b * T + qb * 256) * DA + h * HD, DA, nullptr, 0, bounded, 0, 0.f, T, (char*)lds);
                }
#endif
            } else if (st == 4) {
                const float* wa = p.ona + (size_t)l * DA; const float* wb = p.onb + (size_t)l * DB;
                DUPREP(5) for (int m = gw; m < M; m += 2 * NGW) {
                    gate_row(m, lane, YA, YB, LSE, PROJ, wa, wb, H);
                    if (m + NGW < M) gate_row(m + NGW, lane, YA, YB, LSE, PROJ, wa, wb, H);
                }
            } else {
                pg8::Gemm g{H, W2T + (size_t)l * DM * DM, M, DM, DM}; pg8::StaticOrder S; S.init(M, DM, G, bx);
                pg8::EpiResF32 E{XB, ROWSQ + (size_t)(l + 1) * M * 32, DM};
#ifndef MK_NO_G2
                pg8::gemm_phase<pg8::EpiResF32, pg8::StaticOrder, PG8_ALIGN, PG8_SP2>((PG8_LAS unsigned char*)lds, g, S, E);
#endif
            }
        }
        if (ph + 1 < p.ph_hi) { if (p.ph_hi > 4096) cg::this_grid().sync(); else xcd_barrier(bar); if (MK_DUP & 64) xcd_barrier(bar); }
    }
}

extern "C" void kernel_launch(void* const* d_in, const int* in_sizes, int n_in, void* d_out, int out_size, void* d_ws, size_t ws_size, hipStream_t stream) {
    static int grid = 0;
    if (grid == 0) {
        if (n_in != 9 || in_sizes[0] != M * DM || out_size != M * DM || ws_size < WS_END) { fprintf(stderr, "kernel_launch: unexpected shapes (n_in %d, ws %zu)\n", n_in, ws_size); grid = -1; return; }
        int dev = 0, cus = 0, per_cu = 0;
        hipGetDevice(&dev); hipDeviceGetAttribute(&cus, hipDeviceAttributeMultiprocessorCount, dev);
        if (hipFuncSetAttribute((const void*)mk_fwd, hipFuncAttributeMaxDynamicSharedMemorySize, LDS_BYTES) != hipSuccess) { fprintf(stderr, "kernel_launch: hipFuncSetAttribute failed\n"); grid = -1; return; }
        if (hipOccupancyMaxActiveBlocksPerMultiprocessor(&per_cu, (const void*)mk_fwd, 512, LDS_BYTES) != hipSuccess || per_cu < 1) per_cu = 1;
        (void)hipGetLastError();
        grid = cus * per_cu;
    }
    if (grid < 0) return;
    Params p{};
    p.x = (const float*)d_in[0]; p.norm_w = (const float*)d_in[1]; p.w_in = (const float*)d_in[2]; p.qn = (const float*)d_in[3]; p.kn = (const float*)d_in[4];
    p.ona = (const float*)d_in[5]; p.onb = (const float*)d_in[6]; p.w_out = (const float*)d_in[7]; p.fnorm = (const float*)d_in[8];
    p.out = (float*)d_out; p.ws = (unsigned char*)d_ws;
    if (hipMemsetAsync((char*)d_ws + WS_CTL, 0, CTL_BYTES, stream) != hipSuccess) { fprintf(stderr, "kernel_launch: memset failed\n"); return; }
#if MK_ONE_LAUNCH
    p.ph_lo = 0; p.ph_hi = N_PHASES;
    void* args[] = {&p};
    hipError_t e = hipLaunchCooperativeKernel((const void*)mk_fwd, dim3(grid), dim3(512), args, LDS_BYTES, stream);
    if (e != hipSuccess) fprintf(stderr, "kernel_launch: cooperative launch failed: %s (grid %d)\n", hipGetErrorString(e), grid);
#else
    for (int ph = 0; ph < N_PHASES; ++ph) { p.ph_lo = ph; p.ph_hi = ph + 1; hipLaunchKernelGGL(mk_fwd, dim3(grid), dim3(512), LDS_BYTES, stream, p); }
#endif
}
```

```cpp
#include <hip/hip_runtime.h>
#include <hip/hip_bf16.h>
#include <hip/hip_cooperative_groups.h>
#include <cstdio>
#include <cstdint>
namespace cg = cooperative_groups;

#ifndef MK_DUP
#define MK_DUP 0
#endif
#define DUPREP(k) for (int rep_ = 0; rep_ < 1 + ((MK_DUP >> (k)) & 1); ++rep_)
#ifndef MK_PVPIPE
#define MK_PVPIPE 1
#endif
#ifndef MK_SGB
#define MK_SGB 0
#endif
#ifndef MK_PP
#define MK_PP 1
#endif
#ifndef MK_PROBE_V
#define MK_PROBE_V 0
#endif
#ifndef MK_NEGM
#define MK_NEGM 1
#endif
#ifndef MK_PREB
#define MK_PREB 1
#endif
#ifndef MK_ONE_LAUNCH
#define MK_ONE_LAUNCH 1
#endif
static_assert(!MK_NEGM || MK_PP, "MK_NEGM pre-scales q for the ping-pong dense body only");

constexpr int BATCH = 2, T = 8192, DM = 2048, DEPTH = 4, HD = 128, DA = 1024, DB = 1024, DIN = 6656, M = BATCH * T;
constexpr int C_QA = 0, C_KA = 1024, C_VA = 1280, C_GA = 1536, C_QB = 2560, C_KB = 3584, C_VB = 4608, C_GB = 5632;
constexpr int H_QA = 0, H_KA = 8, H_VA = 10, H_GA = 12, H_QB = 20, H_KB = 28, H_VB = 36, H_GB = 44;
constexpr float EPS = 1e-6f;
__device__ __forceinline__ int otid() { int t = threadIdx.x; asm volatile("" : "+v"(t)); return t; }

namespace pg8 {
#define PG8_LAS __attribute__((address_space(3)))
typedef unsigned short bf16_t;
typedef short bf16x8 __attribute__((ext_vector_type(8)));
typedef float f32x4 __attribute__((ext_vector_type(4)));
typedef unsigned u32x4 __attribute__((ext_vector_type(4)));
constexpr int BM = 256, BK = 64, HALF = 128, HTB = HALF * BK * 2  , STAGE_BYTES = 8 * HTB, NXCD = 8, WGM = 4;

__host__ __device__ __forceinline__ int lds_byte(int r, int c) { const int st = (r >> 4) * 2 + (c >> 5), rr = r & 15, cc = c & 31, ob = rr * 64 + cc * 2; return st * 1024 + (ob ^ (((ob >> 9) & 1) << 5)); }
__host__ __device__ __forceinline__ void stage_rc(int b, int& R, int& C) { const int st = b / 1024, sb = b % 1024, swz = sb ^ (((sb >> 9) & 1) << 5); R = (st >> 1) * 16 + swz / 64; C = (st & 1) * 32 + (swz % 64) / 2; }
__host__ __device__ __forceinline__ int perm32(int rho) { const int n = rho >> 4, i = rho & 15; return 8 * (i >> 2) + 4 * n + (i & 3); }

struct Unit { int pm, pn; };
struct Gemm { const bf16_t* A; const bf16_t* Bt; int M, N, K; };

struct StaticOrder {
    int nM, nN, nwg, G, c;
    __host__ __device__ void init(int M, int N, int G_, int c_) { nM = M / BM; nN = N / BM; nwg = nM * nN; G = G_; c = c_; }
    __host__ __device__ bool next(int i, Unit& u) const {
        const long L = (long)i * G + c; if (L >= nwg) return false;
        int wgid = (int)L; { const int q = nwg / NXCD, r = nwg % NXCD, xcd = wgid % NXCD, off = wgid / NXCD; wgid = (xcd < r ? xcd * (q + 1) : r * (q + 1) + (xcd - r) * q) + off; }
        const int nig = WGM * nN, gid = wgid / nig, fm = gid * WGM, gsz = (nM - fm) < WGM ? (nM - fm) : WGM;
        u.pm = fm + ((wgid % nig) % gsz); u.pn = (wgid % nig) / gsz; return true;
    }
    __device__ __forceinline__ void a_ready(const Unit&) const {}
    __device__ __forceinline__ void done(const Unit&) const {}
};

__device__ __forceinline__ unsigned cvt_pk_bf16(float lo, float hi) { unsigned r; asm volatile("v_cvt_pk_bf16_f32 %0, %1, %2" : "=v"(r) : "v"(lo), "v"(hi)); return r; }
typedef float f32x2 __attribute__((ext_vector_type(2)));
__device__ __forceinline__ f32x2 gelu_pk(f32x2 v) {
    const f32x2 av = __builtin_elementwise_abs(v), d = av * 0.2316418882f + 1.0f;
    f32x2 t; t.x = __builtin_amdgcn_rcpf(d.x); t.y = __builtin_amdgcn_rcpf(d.y);
    f32x2 q = t * 0.5307027145f + (-0.7265760135f); q = q * t + 0.7107068705f; q = q * t + (-0.142248368f); q = q * t + 0.127414796f; q = q * t;
    const f32x2 s = (v * v) * (-0.72134752044f);
    f32x2 e; e.x = __builtin_amdgcn_exp2f(s.x); e.y = __builtin_amdgcn_exp2f(s.y);
    const f32x2 m = v * (q * e), r = v - m;
    f32x2 o; o.x = v.x < 0.f ? m.x : r.x; o.y = v.y < 0.f ? m.y : r.y; return o;
}

template <int ACT  > struct EpiBf16 {
    static constexpr bool PERM = true, AFTER_DRAIN = false; static_assert(ACT == 0 || ACT == 1, "EpiBf16: ACT is 0 (none) or 1 (gelu_pk)");
    bf16_t* O; int ldc; const float* bias; int split_cols; size_t split_stride; float scale0;
    __device__ __forceinline__ void operator()(const f32x4 (&acc)[2][2][4][2], const Unit& u, int wr, int wc, int fr, int fq) const {
        const int row0 = u.pm * BM + wr * 64 + fr; int colt = u.pn * BM; bf16_t* base = O;
        float sc = 1.f; if (split_cols) { const int t = colt / split_cols; base += (size_t)t * split_stride; colt -= t * split_cols; if (t == 0) sc = scale0; }
        const int col0 = colt + wc * 32 + 8 * fq, bcol0 = u.pn * BM + wc * 32 + 8 * fq;
        f32x4 bv[2][2];
#pragma unroll
        for (int bj = 0; bj < 2; ++bj)
#pragma unroll
            for (int n = 0; n < 2; ++n) bv[bj][n] = bias ? *(const f32x4*)(bias + bcol0 + bj * HALF + 4 * n) : (f32x4){0.f, 0.f, 0.f, 0.f};
#pragma unroll
        for (int ai = 0; ai < 2; ++ai)
#pragma unroll
            for (int m = 0; m < 4; ++m) { bf16_t* rowp = base + (size_t)(row0 + ai * HALF + m * 16) * ldc + col0;
#pragma unroll
                for (int bj = 0; bj < 2; ++bj) { f32x4 v0 = acc[ai][bj][m][0] + bv[bj][0], v1 = acc[ai][bj][m][1] + bv[bj][1];
                    if (ACT == 1) { f32x2 a = gelu_pk((f32x2){v0[0], v0[1]}), b = gelu_pk((f32x2){v0[2], v0[3]}), c = gelu_pk((f32x2){v1[0], v1[1]}), d = gelu_pk((f32x2){v1[2], v1[3]});
                        v0 = (f32x4){a.x, a.y, b.x, b.y}; v1 = (f32x4){c.x, c.y, d.x, d.y}; }
                    v0 = v0 * sc; v1 = v1 * sc; u32x4 w; w.x = cvt_pk_bf16(v0[0], v0[1]); w.y = cvt_pk_bf16(v0[2], v0[3]); w.z = cvt_pk_bf16(v1[0], v1[1]); w.w = cvt_pk_bf16(v1[2], v1[3]);
                    *(u32x4*)(rowp + bj * HALF) = w; } }
    }
};
struct EpiHeadMajor {
    static constexpr bool PERM = true, AFTER_DRAIN = false;
    bf16_t* O; int Mrows; const float* rowsq; float inv_k, eps;
    __device__ __forceinline__ void operator()(const f32x4 (&acc)[2][2][4][2], const Unit& u, int wr, int wc, int fr, int fq) const {
        const int row0 = u.pm * BM + wr * 64 + fr, col0 = wc * 32 + 8 * fq;
#pragma unroll
        for (int ai = 0; ai < 2; ++ai) {
            f32x4 pa[4], pb[4];
#pragma unroll
            for (int m = 0; m < 4; ++m) { const f32x4* pp = (const f32x4*)(rowsq + (size_t)(row0 + ai * HALF + m * 16) * 32 + 8 * fq); pa[m] = pp[0]; pb[m] = pp[1]; }
#pragma unroll
            for (int m = 0; m < 4; ++m) { const int row = row0 + ai * HALF + m * 16; const f32x4 a = pa[m], b = pb[m];
                float sq = ((a[0] + a[1]) + (a[2] + a[3])) + ((b[0] + b[1]) + (b[2] + b[3])); sq += __shfl_xor(sq, 16); sq += __shfl_xor(sq, 32);
                const float rs = 1.0f / sqrtf(sq * inv_k + eps);
#pragma unroll
                for (int bj = 0; bj < 2; ++bj) { const f32x4 v0 = acc[ai][bj][m][0] * rs, v1 = acc[ai][bj][m][1] * rs;
                    u32x4 w; w.x = cvt_pk_bf16(v0[0], v0[1]); w.y = cvt_pk_bf16(v0[2], v0[3]); w.z = cvt_pk_bf16(v1[0], v1[1]); w.w = cvt_pk_bf16(v1[2], v1[3]);
                    *(u32x4*)(O + ((size_t)(u.pn * 2 + bj) * Mrows + row) * HALF + col0) = w; } }
            asm volatile("" ::: "memory"); }
    }
};
struct EpiResF32 {
    static constexpr bool PERM = true, AFTER_DRAIN = false;
    bf16_t* xb; float* rowsq; int ldc;
    __device__ __forceinline__ void operator()(const f32x4 (&acc)[2][2][4][2], const Unit& u, int wr, int wc, int fr, int fq) const {
        const int col0 = u.pn * BM + wc * 32 + 8 * fq;
#pragma unroll
        for (int ai = 0; ai < 2; ++ai) {
            u32x4 pre[4][2];
#pragma unroll
            for (int m = 0; m < 4; ++m) { const size_t off = (size_t)(u.pm * BM + ai * HALF + wr * 64 + m * 16 + fr) * ldc + col0;
#pragma unroll
                for (int bj = 0; bj < 2; ++bj) pre[m][bj] = *(const u32x4*)(xb + off + bj * HALF); }
            asm volatile("" ::: "memory");
#pragma unroll
            for (int m = 0; m < 4; ++m) { const int row = u.pm * BM + ai * HALF + wr * 64 + m * 16 + fr; const size_t off = (size_t)row * ldc + col0; float ss = 0.f;
#pragma unroll
                for (int bj = 0; bj < 2; ++bj) { const u32x4 pb = pre[m][bj]; const f32x4 a0 = acc[ai][bj][m][0], a1 = acc[ai][bj][m][1];
                    u32x4 w; w.x = cvt_pk_bf16(__uint_as_float(pb.x << 16) + a0[0], __uint_as_float(pb.x & 0xffff0000u) + a0[1]); w.y = cvt_pk_bf16(__uint_as_float(pb.y << 16) + a0[2], __uint_as_float(pb.y & 0xffff0000u) + a0[3]);
                    w.z = cvt_pk_bf16(__uint_as_float(pb.z << 16) + a1[0], __uint_as_float(pb.z & 0xffff0000u) + a1[1]); w.w = cvt_pk_bf16(__uint_as_float(pb.w << 16) + a1[2], __uint_as_float(pb.w & 0xffff0000u) + a1[3]);
#pragma unroll
                    for (int q = 0; q < 4; ++q) { const float r0 = __uint_as_float(w[q] << 16), r1 = __uint_as_float(w[q] & 0xffff0000u); ss += r0 * r0 + r1 * r1; }
                    *(u32x4*)(xb + off + bj * HALF) = w; }
                ss += __shfl_xor(ss, 16); ss += __shfl_xor(ss, 32);
                if (fq == 0) rowsq[(size_t)row * 32 + u.pn * 4 + wc] = ss; }
            asm volatile("" ::: "memory"); }
    }
};


template <class Epi, class Sched, bool ALIGN_EPI = false, bool SP2 = false>
__device__ __forceinline__ void gemm_phase(PG8_LAS unsigned char* lds, const Gemm g, const Sched& S, const Epi& E) {
    const int tid = otid(), wid = __builtin_amdgcn_readfirstlane(tid >> 6), lane = tid & 63, wr = wid >> 2, wc = wid & 3, fr = lane & 15, fq = lane >> 4;
    const int K = g.K, nt = K / BK;
    unsigned voffA[2], voffB[2];
#pragma unroll
    for (int i = 0; i < 2; ++i) { int R, C; stage_rc(tid * 16 + i * 8192, R, C); const int Rb = Epi::PERM ? ((R & ~31) + perm32(R & 31)) : R;
        voffA[i] = (unsigned)(R * K + C) * 2u; voffB[i] = (unsigned)(Rb * K + C) * 2u; }
    const size_t kstep = (size_t)(BK * 2);
    const size_t hstep = (size_t)HALF * K * 2;
    const size_t tstep = 2 * hstep;
    const unsigned ldsw = (unsigned)wid * 1024u;
    const int aoff = lds_byte(wr * 64 + fr, fq * 8), boff = lds_byte(wc * 32 + fr, fq * 8);
#define PG8_SA(b, h) (((b) * 2 + (h)) * HTB)
#define PG8_SB(b, h) ((4 + (b) * 2 + (h)) * HTB)
#define PG8_STAGE(bufoff, gbase, voff) do { _Pragma("unroll") for (int _i = 0; _i < 2; ++_i) \
        __builtin_amdgcn_global_load_lds((const unsigned*)((const char*)(gbase) + (voff)[_i]), (PG8_LAS unsigned*)(lds + (bufoff) + ldsw + _i * 8192), 16, 0, 0); } while (0)
#define PG8_LDA(dst, b, h) do { _Pragma("unroll") for (int m = 0; m < 4; ++m) _Pragma("unroll") for (int k = 0; k < 2; ++k) dst[m][k] = *(const PG8_LAS bf16x8*)(lds + PG8_SA(b, h) + aoff + m * 2048 + k * 1024); } while (0)
#define PG8_LDB(dst, b, h) do { _Pragma("unroll") for (int n = 0; n < 2; ++n) _Pragma("unroll") for (int k = 0; k < 2; ++k) dst[n][k] = *(const PG8_LAS bf16x8*)(lds + PG8_SB(b, h) + boff + n * 2048 + k * 1024); } while (0)
#define PG8_MMA(ai, bj, At, Bt) do { __builtin_amdgcn_s_setprio(1); _Pragma("unroll") for (int m = 0; m < 4; ++m) _Pragma("unroll") for (int n = 0; n < 2; ++n) _Pragma("unroll") for (int k = 0; k < 2; ++k) \
        acc[ai][bj][m][n] = __builtin_amdgcn_mfma_f32_16x16x32_bf16(Bt[n][k], At[m][k], acc[ai][bj][m][n], 0, 0, 0); __builtin_amdgcn_s_setprio(0); } while (0)
#define PG8_WAIT_V(n) asm volatile("s_waitcnt vmcnt(" #n ")" ::: "memory")
#define PG8_WAIT_L(n) asm volatile("s_waitcnt lgkmcnt(" #n ")" ::: "memory")
#define PG8_BAR __builtin_amdgcn_s_barrier()
#define PG8_SCHED __builtin_amdgcn_sched_barrier(0)
    Unit cur, nxt; int ui = 0;
    if (!S.next(0, cur)) return;
    f32x4 acc[2][2][4][2];
#pragma unroll
    for (int a = 0; a < 2; ++a)
#pragma unroll
        for (int b = 0; b < 2; ++b)
#pragma unroll
            for (int m = 0; m < 4; ++m)
#pragma unroll
                for (int n = 0; n < 2; ++n) acc[a][b][m][n] = (f32x4){0.f, 0.f, 0.f, 0.f};
    bf16x8 At[4][2], B0[2][2], B1[2][2];
    const char* cA = (const char*)g.A + (size_t)cur.pm * tstep; const char* cB = (const char*)g.Bt + (size_t)cur.pn * tstep;
    S.a_ready(cur);
    if constexpr (SP2) {
        PG8_STAGE(PG8_SB(0, 0), cB, voffB); PG8_STAGE(PG8_SB(0, 1), cB + hstep, voffB); PG8_STAGE(PG8_SA(0, 0), cA, voffA); PG8_STAGE(PG8_SA(0, 1), cA + hstep, voffA);
        if (wr == 1) PG8_BAR;
        PG8_WAIT_V(2); PG8_BAR;
        PG8_STAGE(PG8_SB(1, 0), cB + kstep, voffB); PG8_STAGE(PG8_SA(1, 0), cA + kstep, voffA); PG8_STAGE(PG8_SB(1, 1), cB + hstep + kstep, voffB);
        PG8_WAIT_V(6); PG8_BAR;
    } else {
        PG8_STAGE(PG8_SB(0, 0), cB, voffB); PG8_STAGE(PG8_SA(0, 0), cA, voffA); PG8_STAGE(PG8_SB(0, 1), cB + hstep, voffB); PG8_STAGE(PG8_SA(0, 1), cA + hstep, voffA);
        if (wr == 1) PG8_BAR;
        PG8_WAIT_V(4); PG8_BAR;
        PG8_STAGE(PG8_SB(1, 0), cB + kstep, voffB); PG8_STAGE(PG8_SA(1, 0), cA + kstep, voffA); PG8_STAGE(PG8_SB(1, 1), cB + hstep + kstep, voffB);
        PG8_WAIT_V(6); PG8_BAR;
    }
    for (;;) {
        const bool has_next = S.next(ui + 1, nxt);
        const char* nA = has_next ? (const char*)g.A + (size_t)nxt.pm * tstep : cA; const char* nB = has_next ? (const char*)g.Bt + (size_t)nxt.pn * tstep : cB;
        for (int t = 0; t < nt; t += 2) {
            const bool last = (t == nt - 2);
            const char* a1 = cA + (size_t)(t + 1) * kstep;
            const char* a2 = last ? nA : cA + (size_t)(t + 2) * kstep; const char* b2 = last ? nB : cB + (size_t)(t + 2) * kstep;
            const char* a3 = a2 + kstep; const char* b3 = b2 + kstep;
            if (last && has_next) S.a_ready(nxt);
            if constexpr (SP2) {
            PG8_LDB(B0, 0, 0); PG8_LDB(B1, 0, 1); PG8_SCHED; PG8_LDA(At, 0, 0); PG8_STAGE(PG8_SA(1, 1), a1 + hstep, voffA);
            PG8_WAIT_V(8); PG8_WAIT_L(0); PG8_BAR; PG8_MMA(0, 0, At, B0); PG8_MMA(0, 1, At, B1); PG8_BAR; PG8_SCHED;
            PG8_LDA(At, 0, 1); PG8_STAGE(PG8_SB(0, 0), b2, voffB); PG8_STAGE(PG8_SB(0, 1), b2 + hstep, voffB); PG8_STAGE(PG8_SA(0, 0), a2, voffA);
            PG8_WAIT_V(8); PG8_WAIT_L(0); PG8_BAR; PG8_MMA(1, 0, At, B0); PG8_MMA(1, 1, At, B1); PG8_BAR; PG8_SCHED;
            PG8_LDB(B0, 1, 0); PG8_LDB(B1, 1, 1); PG8_SCHED; PG8_LDA(At, 1, 0); PG8_STAGE(PG8_SA(0, 1), a2 + hstep, voffA);
            PG8_WAIT_V(8); PG8_WAIT_L(0); PG8_BAR; PG8_MMA(0, 0, At, B0); PG8_MMA(0, 1, At, B1); PG8_BAR; PG8_SCHED;
            PG8_LDA(At, 1, 1); PG8_STAGE(PG8_SB(1, 0), b3, voffB); PG8_STAGE(PG8_SB(1, 1), b3 + hstep, voffB); PG8_STAGE(PG8_SA(1, 0), a3, voffA);
            PG8_WAIT_V(8); PG8_WAIT_L(0); PG8_BAR; PG8_MMA(1, 0, At, B0); PG8_MMA(1, 1, At, B1); PG8_BAR; PG8_SCHED;
            } else {
            PG8_LDB(B0, 0, 0); PG8_SCHED; PG8_LDA(At, 0, 0); PG8_STAGE(PG8_SA(1, 1), a1 + hstep, voffA);
            PG8_WAIT_L(8); PG8_BAR; PG8_WAIT_L(0); PG8_MMA(0, 0, At, B0); PG8_BAR; PG8_SCHED;
            PG8_LDB(B1, 0, 1); PG8_STAGE(PG8_SB(0, 0), b2, voffB);
            PG8_BAR; PG8_WAIT_L(0); PG8_MMA(0, 1, At, B1); PG8_BAR;
            PG8_LDA(At, 0, 1); PG8_STAGE(PG8_SA(0, 0), a2, voffA);
            PG8_BAR; PG8_WAIT_L(0); PG8_MMA(1, 0, At, B0); PG8_BAR; PG8_SCHED;
            PG8_STAGE(PG8_SB(0, 1), b2 + hstep, voffB);
            PG8_WAIT_V(6); PG8_BAR; PG8_MMA(1, 1, At, B1); PG8_BAR;
            PG8_LDB(B0, 1, 0); PG8_SCHED; PG8_LDA(At, 1, 0); PG8_STAGE(PG8_SA(0, 1), a2 + hstep, voffA);
            PG8_WAIT_L(8); PG8_BAR; PG8_WAIT_L(0); PG8_MMA(0, 0, At, B0); PG8_BAR; PG8_SCHED;
            PG8_LDB(B1, 1, 1); PG8_STAGE(PG8_SB(1, 0), b3, voffB);
            PG8_BAR; PG8_WAIT_L(0); PG8_MMA(0, 1, At, B1); PG8_BAR;
            PG8_LDA(At, 1, 1); PG8_STAGE(PG8_SA(1, 0), a3, voffA);
            PG8_BAR; PG8_WAIT_L(0); PG8_MMA(1, 0, At, B0); PG8_BAR; PG8_SCHED;
            PG8_STAGE(PG8_SB(1, 1), b3 + hstep, voffB);
            PG8_WAIT_V(6); PG8_BAR; PG8_MMA(1, 1, At, B1); PG8_BAR;
            }
        }
        if constexpr (ALIGN_EPI) { if (wr == 0) PG8_BAR; }
        if constexpr (!Epi::AFTER_DRAIN) { E(acc, cur, wr, wc, fr, fq); S.done(cur); }
        if (!has_next) break;
#pragma unroll
        for (int a = 0; a < 2; ++a)
#pragma unroll
            for (int b = 0; b < 2; ++b)
#pragma unroll
                for (int m = 0; m < 4; ++m)
#pragma unroll
                    for (int n = 0; n < 2; ++n) acc[a][b][m][n] = (f32x4){0.f, 0.f, 0.f, 0.f};
        cur = nxt; cA = nA; cB = nB; ++ui;
        if constexpr (ALIGN_EPI) { if (wr == 1) PG8_BAR; }
    }
    PG8_WAIT_V(0);
    if constexpr (!ALIGN_EPI) { if (wr == 0) PG8_BAR; }
    PG8_BAR;
    if constexpr (Epi::AFTER_DRAIN) { E.fused(acc, cur, wr, wc, fr, fq, lds, wid, lane); S.done(cur); }
#undef PG8_SA
#undef PG8_SB
#undef PG8_STAGE
#undef PG8_LDA
#undef PG8_LDB
#undef PG8_MMA
#undef PG8_WAIT_V
#undef PG8_WAIT_L
#undef PG8_BAR
#undef PG8_SCHED
}
}
#define PG8_SP2 true
#define PG8_ALIGN true
namespace att {
using bf16 = __hip_bfloat16;
constexpr int D = 128, NW = 8, QBLK = 32, KVBLK = 64;
constexpr float SCALE = 0.088388347648318440f;
constexpr float THR = 8.f;
constexpr size_t SHM_V = KVBLK * D * 2, SHM_K = KVBLK * D * 2, SHM_ATTN = 2 * SHM_V + 2 * SHM_K + NW * 64 * 4;
using bf16x8 = __attribute__((ext_vector_type(8))) short;
using s16x4  = __attribute__((ext_vector_type(4))) short;
using f32x16 = __attribute__((ext_vector_type(16))) float;
using f32x8  = __attribute__((ext_vector_type(8))) float;
using u32x4  = __attribute__((ext_vector_type(4))) unsigned;
#define KSWZ(row, colB) ((row) * 256 + ((colB) ^ (((row) & 7) << 4)))
#define SBAR() __builtin_amdgcn_sched_barrier(0)
__device__ __forceinline__ int crow(int r, int hi) { return (r & 3) + 8 * (r >> 2) + 4 * hi; }
__device__ __forceinline__ unsigned cvtpk(float lo, float hi) {
  unsigned r; asm("v_cvt_pk_bf16_f32 %0, %1, %2" : "=v"(r) : "v"(lo), "v"(hi)); return r;
}
template <typename TIn> struct Stage;
template <> struct Stage<bf16>  { using T = bf16x8;
  __device__ static __forceinline__ T ld8(const bf16* p) { return *reinterpret_cast<const bf16x8*>(p); }
  __device__ static __forceinline__ bf16x8 tobf(T x) { return x; } };
template <> struct Stage<float> { using T = f32x8;
  __device__ static __forceinline__ T ld8(const float* p) { return *reinterpret_cast<const f32x8*>(p); }
  __device__ static __forceinline__ bf16x8 tobf(T x) {
    u32x4 w = {cvtpk(x[0], x[1]), cvtpk(x[2], x[3]), cvtpk(x[4], x[5]), cvtpk(x[6], x[7])}; return *reinterpret_cast<bf16x8*>(&w); } };

__device__ __forceinline__ void partialSM(f32x16& p0, f32x16& p1, float& m_reg, float& mn, float& alpha) {
  constexpr float C = SCALE * 1.4426950408889634f;
  float pmax = p0[0]; for (int r = 1; r < 16; ++r) pmax = fmaxf(pmax, p0[r]); for (int r = 0; r < 16; ++r) pmax = fmaxf(pmax, p1[r]);
  { auto rr = __builtin_amdgcn_permlane32_swap(__float_as_uint(pmax), __float_as_uint(pmax), false, false);
    pmax = fmaxf(__uint_as_float(rr[0]), __uint_as_float(rr[1])); }
  if (__builtin_expect(__all(pmax - m_reg <= THR / SCALE), 1)) { mn = m_reg; alpha = 1.f; }
  else { mn = fmaxf(m_reg, pmax); alpha = __builtin_amdgcn_exp2f((m_reg - mn) * C); m_reg = mn; }
  float mnC = -mn * C;
  for (int r = 0; r < 16; ++r) p0[r] = fmaf(p0[r], C, mnC); for (int r = 0; r < 16; ++r) p1[r] = fmaf(p1[r], C, mnC);
  for (int r = 0; r < 16; ++r) p0[r] = __builtin_amdgcn_exp2f(p0[r]);
}
__device__ __forceinline__ void finishSM(f32x16& p0, f32x16& p1, float alpha, float& l_reg, bf16x8& pa0, bf16x8& pa1, bf16x8& pa2, bf16x8& pa3) {
  for (int r = 0; r < 16; ++r) p1[r] = __builtin_amdgcn_exp2f(p1[r]);
  float ps = 0; for (int r = 0; r < 16; ++r) ps += p0[r]; for (int r = 0; r < 16; ++r) ps += p1[r];
  { auto rr = __builtin_amdgcn_permlane32_swap(__float_as_uint(ps), __float_as_uint(ps), false, false);
    ps = __uint_as_float(rr[0]) + __uint_as_float(rr[1]); }
  l_reg = l_reg * alpha + ps;
#define PK4(P, BASE, OUT) do { unsigned a0 = cvtpk(P[BASE + 0], P[BASE + 1]), a1 = cvtpk(P[BASE + 2], P[BASE + 3]);   \
    unsigned b0 = cvtpk(P[BASE + 4], P[BASE + 5]), b1 = cvtpk(P[BASE + 6], P[BASE + 7]);                              \
    u32x4 w = {a0, a1, b0, b1}; OUT = *reinterpret_cast<bf16x8*>(&w); } while (0)
  PK4(p0, 0, pa0); PK4(p0, 8, pa1); PK4(p1, 0, pa2); PK4(p1, 8, pa3);
#undef PK4
}
__device__ __forceinline__ void qkt(f32x16& p0, f32x16& p1, const bf16* Ks, const bf16x8* qr, int r32, int hi) {
  p0 = f32x16{}; p1 = f32x16{};
  for (int d0 = 0; d0 < 8; ++d0) { int cb = (d0 * 16 + hi * 8) * 2;
    bf16x8 b0 = *reinterpret_cast<const bf16x8*>((const char*)Ks + KSWZ(r32, cb));
    bf16x8 b1 = *reinterpret_cast<const bf16x8*>((const char*)Ks + KSWZ(32 + r32, cb));
    p0 = __builtin_amdgcn_mfma_f32_32x32x16_bf16(b0, qr[d0], p0, 0, 0, 0);
    p1 = __builtin_amdgcn_mfma_f32_32x32x16_bf16(b1, qr[d0], p1, 0, 0, 0); }
}
__device__ __forceinline__ int v_st(int k, int c) { const int kk = (k & ~0xC) | ((k & 4) << 1) | ((k & 8) >> 1); return ((kk >> 3) * 4 + (c >> 5)) * 512 + ((kk & 7) * 32 + (c & 31)) * 2; }
__device__ __forceinline__ int v_rd_base(int lane) { return ((lane & 3) << 3) | (((lane >> 2) & 3) << 6) | (((lane >> 4) & 1) << 5) | (((lane >> 5) & 1) << 8); }
constexpr int v_rd_off(int d0, int ks, int half) { return d0 * 512 + ks * 4096 + half * 2048; }
template <int OFF> __device__ __forceinline__ s16x4 tr_read(int vb) {
  s16x4 r; asm volatile("ds_read_b64_tr_b16 %0, %1 offset:%2" : "=&v"(r) : "v"(vb), "i"(OFF) : "memory"); return r;
}
template <int D0> __device__ __forceinline__ void pv_one(f32x16& od, int vb, bf16x8 pa0, bf16x8 pa1, bf16x8 pa2, bf16x8 pa3) {
  const s16x4 l0 = tr_read<v_rd_off(D0, 0, 0)>(vb), h0 = tr_read<v_rd_off(D0, 0, 1)>(vb), l1 = tr_read<v_rd_off(D0, 1, 0)>(vb), h1 = tr_read<v_rd_off(D0, 1, 1)>(vb);
  const s16x4 l2 = tr_read<v_rd_off(D0, 2, 0)>(vb), h2 = tr_read<v_rd_off(D0, 2, 1)>(vb), l3 = tr_read<v_rd_off(D0, 3, 0)>(vb), h3 = tr_read<v_rd_off(D0, 3, 1)>(vb);
  asm volatile("s_waitcnt lgkmcnt(0)" ::: "memory"); SBAR();
#define PK(L, H) (bf16x8){L[0], L[1], L[2], L[3], H[0], H[1], H[2], H[3]}
  od = __builtin_amdgcn_mfma_f32_32x32x16_bf16(pa0, PK(l0, h0), od, 0, 0, 0);
  od = __builtin_amdgcn_mfma_f32_32x32x16_bf16(pa1, PK(l1, h1), od, 0, 0, 0);
  od = __builtin_amdgcn_mfma_f32_32x32x16_bf16(pa2, PK(l2, h2), od, 0, 0, 0);
  od = __builtin_amdgcn_mfma_f32_32x32x16_bf16(pa3, PK(l3, h3), od, 0, 0, 0);
#undef PK
}
struct VFrag { s16x4 l0, h0, l1, h1, l2, h2, l3, h3; };
template <int D0> __device__ __forceinline__ void pv_rd(VFrag& f, int vb) {
  f.l0 = tr_read<v_rd_off(D0, 0, 0)>(vb); f.h0 = tr_read<v_rd_off(D0, 0, 1)>(vb); f.l1 = tr_read<v_rd_off(D0, 1, 0)>(vb); f.h1 = tr_read<v_rd_off(D0, 1, 1)>(vb);
  f.l2 = tr_read<v_rd_off(D0, 2, 0)>(vb); f.h2 = tr_read<v_rd_off(D0, 2, 1)>(vb); f.l3 = tr_read<v_rd_off(D0, 3, 0)>(vb); f.h3 = tr_read<v_rd_off(D0, 3, 1)>(vb);
}
__device__ __forceinline__ void pv_mm(f32x16& od, const VFrag& f, bf16x8 pa0, bf16x8 pa1, bf16x8 pa2, bf16x8 pa3) {
#define PK(L, H) (bf16x8){L[0], L[1], L[2], L[3], H[0], H[1], H[2], H[3]}
  od = __builtin_amdgcn_mfma_f32_32x32x16_bf16(pa0, PK(f.l0, f.h0), od, 0, 0, 0);
  od = __builtin_amdgcn_mfma_f32_32x32x16_bf16(pa1, PK(f.l1, f.h1), od, 0, 0, 0);
  od = __builtin_amdgcn_mfma_f32_32x32x16_bf16(pa2, PK(f.l2, f.h2), od, 0, 0, 0);
  od = __builtin_amdgcn_mfma_f32_32x32x16_bf16(pa3, PK(f.l3, f.h3), od, 0, 0, 0);
#undef PK
}
#define PV_WAIT(n) do { asm volatile("s_waitcnt lgkmcnt(" #n ")" ::: "memory"); SBAR(); } while (0)
__device__ __forceinline__ void pv_d0(f32x16* o, int vb, bf16x8 pa0, bf16x8 pa1, bf16x8 pa2, bf16x8 pa3) {
#if MK_PVPIPE
  VFrag fa, fb;
  pv_rd<0>(fa, vb); pv_rd<1>(fb, vb);
  PV_WAIT(8); pv_mm(o[0], fa, pa0, pa1, pa2, pa3); SBAR();
  pv_rd<2>(fa, vb);
  PV_WAIT(8); pv_mm(o[1], fb, pa0, pa1, pa2, pa3); SBAR();
  pv_rd<3>(fb, vb);
  PV_WAIT(8); pv_mm(o[2], fa, pa0, pa1, pa2, pa3); SBAR();
  PV_WAIT(0); pv_mm(o[3], fb, pa0, pa1, pa2, pa3);
#else
  pv_one<0>(o[0], vb, pa0, pa1, pa2, pa3); pv_one<1>(o[1], vb, pa0, pa1, pa2, pa3); pv_one<2>(o[2], vb, pa0, pa1, pa2, pa3); pv_one<3>(o[3], vb, pa0, pa1, pa2, pa3);
#endif
}
constexpr int crow0(int r) { return (r & 3) + 8 * (r >> 2); }
constexpr float LOG2E = 1.4426950408889634f;
__device__ __forceinline__ void partialSM_neg(f32x16& p0, f32x16& p1, float& m_reg, f32x16& negm, float& alpha, int bounded) {
  if (bounded) {
    alpha = 1.f;
#pragma unroll
    for (int r = 0; r < 16; ++r) p0[r] = __builtin_amdgcn_exp2f(p0[r]);
    return;
  }
  float pmax = p0[0];
#pragma unroll
  for (int r = 1; r < 16; ++r) pmax = fmaxf(pmax, p0[r]);
#pragma unroll
  for (int r = 0; r < 16; ++r) pmax = fmaxf(pmax, p1[r]);
  { auto rr = __builtin_amdgcn_permlane32_swap(__float_as_uint(pmax), __float_as_uint(pmax), false, false);
    pmax = fmaxf(__uint_as_float(rr[0]), __uint_as_float(rr[1])); }
  if (__builtin_expect(__all(pmax <= THR), 1)) { alpha = 1.f; }
  else { const float dl = fmaxf(pmax, 0.f); m_reg += dl; alpha = __builtin_amdgcn_exp2f(-dl);
#pragma unroll
    for (int r = 0; r < 16; ++r) { p0[r] -= dl; p1[r] -= dl; negm[r] = -m_reg; } }
#pragma unroll
  for (int r = 0; r < 16; ++r) p0[r] = __builtin_amdgcn_exp2f(p0[r]);
}
__device__ __forceinline__ void partialSM_dil(f32x16& p0, f32x16& p1, float& m_reg, float& mn, float& alpha, float dq, float dlo, float dhi, float nslopeC) {
  constexpr float C = SCALE * LOG2E;
#pragma unroll
  for (int r = 0; r < 16; ++r) {
    const float d0 = dq + (float)crow0(r), d1 = d0 + 32.f;
    const float t0 = fmaf(p0[r], C, nslopeC * fabsf(d0)), t1 = fmaf(p1[r], C, nslopeC * fabsf(d1));
    p0[r] = (d0 >= dlo && d0 <= dhi) ? t0 : -1e30f;
    p1[r] = (d1 >= dlo && d1 <= dhi) ? t1 : -1e30f;
  }
  float pmax = p0[0];
#pragma unroll
  for (int r = 1; r < 16; ++r) pmax = fmaxf(pmax, p0[r]);
#pragma unroll
  for (int r = 0; r < 16; ++r) pmax = fmaxf(pmax, p1[r]);
  { auto rr = __builtin_amdgcn_permlane32_swap(__float_as_uint(pmax), __float_as_uint(pmax), false, false);
    pmax = fmaxf(__uint_as_float(rr[0]), __uint_as_float(rr[1])); }
  if (__builtin_expect(__all(pmax - m_reg <= THR * LOG2E), 1)) { mn = m_reg; alpha = 1.f; }
  else { mn = fmaxf(m_reg, pmax); alpha = __builtin_amdgcn_exp2f(m_reg - mn); m_reg = mn; }
#pragma unroll
  for (int r = 0; r < 16; ++r) { p0[r] = p0[r] - mn; p1[r] = p1[r] - mn; }
#pragma unroll
  for (int r = 0; r < 16; ++r) p0[r] = __builtin_amdgcn_exp2f(p0[r]);
}

template <bool DIL>
__device__ __forceinline__ void attn_body(const bf16* __restrict__ Qb, const bf16* __restrict__ Kh, const bf16* __restrict__ Vh, long qs, long ks,
                                          bf16* __restrict__ Ob, long os, float* __restrict__ lse_o, int lse_s, int i0, int nsub, float nslopeC, int seq, char* lds) {
  typedef __attribute__((address_space(3))) unsigned lds_u32;
  using St = Stage<bf16>;
  const int tid = otid(), wid = __builtin_amdgcn_readfirstlane(tid >> 6), lane = tid & 63, r32 = lane & 31, hi = lane >> 5;
  char* V_lds = lds + 4 * SHM_K; char* K_lds = lds;
  float* ws = (float*)(lds + 4 * SHM_K + 4 * SHM_V) + wid * 64; float* li_l = ws; float* al_l = ws + 32;
  float m_reg = -1e30f, l_reg = 0; f32x16 o[4] = {}; bf16x8 qr[8];
  const bf16* Qw = Qb + (long)(wid * QBLK + r32) * qs + hi * 8;
#pragma unroll
  for (int d0 = 0; d0 < 8; ++d0) qr[d0] = St::ld8(Qw + d0 * 16);
  const int vb0 = (int)(uintptr_t)V_lds + v_rd_base(lane);
  const int kb = DIL ? i0 - 64 : 0;
#define KROW(k) (DIL ? (long)min(max(kb + (k), 0), nsub - 1) : (long)(k))
  int krow[2], kcol[2], vrow[2], vcol[2];
#pragma unroll
  for (int i = 0; i < 2; ++i) { const int pc = 2 * wid + i;
    krow[i] = pc * 4 + (lane >> 4); kcol[i] = (((lane & 15) ^ (krow[i] & 7)) << 3);
    const int sub = pc * 2 + (lane >> 5), kk = ((sub >> 2) << 3) + ((lane & 31) >> 2);
    vrow[i] = kk; vcol[i] = ((sub & 3) << 5) + ((lane & 3) << 3); }
  unsigned kdo[2], vdo[2];
#pragma unroll
  for (int i = 0; i < 2; ++i) { kdo[i] = (unsigned)(krow[i] * (int)ks + kcol[i]); vdo[i] = (unsigned)(vrow[i] * (int)ks + vcol[i]); }
#define DMA(t, buf) do { if constexpr (DIL) { _Pragma("unroll") for (int i_ = 0; i_ < 2; ++i_) { \
      __builtin_amdgcn_global_load_lds((const unsigned*)(Kh + KROW((t) * KVBLK + krow[i_]) * ks + kcol[i_]), (lds_u32*)(K_lds + (buf) * SHM_K + (2 * wid + i_) * 1024), 16, 0, 0); \
      __builtin_amdgcn_global_load_lds((const unsigned*)(Vh + KROW((t) * KVBLK + vrow[i_]) * ks + vcol[i_]), (lds_u32*)(V_lds + (buf) * SHM_V + (2 * wid + i_) * 1024), 16, 0, 0); } } \
    else { const bf16* Kt_ = Kh + (long)(t) * (KVBLK * ks); const bf16* Vt_ = Vh + (long)(t) * (KVBLK * ks); _Pragma("unroll") for (int i_ = 0; i_ < 2; ++i_) { \
      __builtin_amdgcn_global_load_lds((const unsigned*)(Kt_ + kdo[i_]), (lds_u32*)(K_lds + (buf) * SHM_K + (2 * wid + i_) * 1024), 16, 0, 0); \
      __builtin_amdgcn_global_load_lds((const unsigned*)(Vt_ + vdo[i_]), (lds_u32*)(V_lds + (buf) * SHM_V + (2 * wid + i_) * 1024), 16, 0, 0); } } } while (0)
#define ENDSTEP(j) do { if ((j) + 2 < NT) asm volatile("s_waitcnt vmcnt(4) lgkmcnt(0)\n\ts_barrier" ::: "memory"); else asm volatile("s_waitcnt vmcnt(0) lgkmcnt(0)\n\ts_barrier" ::: "memory"); } while (0)
#define RESC(a) do { if (__any((a) < 1.f)) { if (hi == 0) al_l[r32] = (a); asm volatile("s_waitcnt lgkmcnt(0)" ::: "memory"); \
    for (int d = 0; d < 4; ++d) for (int r = 0; r < 16; ++r) o[d][r] *= al_l[crow(r, hi)]; } } while (0)
#define PSM(P0, P1, MN, AL, jt) do { if constexpr (DIL) { const int t_ = otid(), iq_ = (t_ >> 6) * QBLK + (t_ & 31), hi_ = (t_ >> 5) & 1; \
      partialSM_dil(P0, P1, m_reg, MN, AL, (float)(-64 - iq_ + 4 * hi_ + 64 * (jt)), fmaxf(-64.f, (float)(-(i0 + iq_))), fminf(64.f, (float)(nsub - 1 - (i0 + iq_))), nslopeC); } \
    else partialSM(P0, P1, m_reg, MN, AL); } while (0)
#if MK_SGB
#define SGB_A() do { __builtin_amdgcn_sched_group_barrier(0x100, 4, 0); \
    _Pragma("unroll") for (int g_ = 0; g_ < 12; ++g_) { __builtin_amdgcn_sched_group_barrier(0x008, 1, 0); __builtin_amdgcn_sched_group_barrier(0x100, 1, 0); __builtin_amdgcn_sched_group_barrier(0x002, 6, 0); } \
    _Pragma("unroll") for (int g_ = 0; g_ < 4; ++g_) { __builtin_amdgcn_sched_group_barrier(0x008, 1, 0); __builtin_amdgcn_sched_group_barrier(0x002, 6, 0); } } while (0)
#else
#define SGB_A() do {} while (0)
#endif
#define KBUF(j) ((const bf16*)(K_lds + ((j) & 3) * SHM_K))
#define VBUF(j) (vb0 + ((j) & 3) * (int)SHM_V)
  f32x16 pA0, pA1, pB0, pB1; float mnA, mnB, alA, alB; bf16x8 pa0, pa1, pa2, pa3; const int NT = DIL ? 6 : seq / KVBLK;
  DMA(0, 0); DMA(1, 1);
  if constexpr (!DIL && MK_PP) { DMA(2, 2); asm volatile("s_waitcnt vmcnt(8)\n\ts_barrier" ::: "memory"); }
  else asm volatile("s_waitcnt vmcnt(4)\n\ts_barrier" ::: "memory");
  struct KFrag { bf16x8 a, b; };
  int koff[4];
#pragma unroll
  for (int d0 = 0; d0 < 4; ++d0) koff[d0] = KSWZ(r32, (d0 * 16 + hi * 8) * 2);
  const int kbase0 = (int)(uintptr_t)K_lds;
#define KRD(f, d0, kb) asm volatile("ds_read_b128 %0, %2 offset:%3\n\tds_read_b128 %1, %2 offset:%4" : "=&v"(f.a), "=&v"(f.b) : "v"((kb) + koff[(d0) & 3]), "i"(((d0) >> 2) * 128), "i"(((d0) >> 2) * 128 + 8192) : "memory")
#define QMM(f, d0) do { pA0 = __builtin_amdgcn_mfma_f32_32x32x16_bf16(f.a, qr[d0], pA0, 0, 0, 0); pA1 = __builtin_amdgcn_mfma_f32_32x32x16_bf16(f.b, qr[d0], pA1, 0, 0, 0); } while (0)
#define LW(n) do { asm volatile("s_waitcnt lgkmcnt(" #n ")" ::: "memory"); SBAR(); } while (0)
  if constexpr (DIL) {
    const int rlo = wid >> 1;
    for (int j = 0; j < NT; ++j) {
      if (j + 2 < NT) DMA(j + 2, (j + 2) & 3);
      if (j >= rlo && j <= rlo + 2) {
        SBAR();
        { const int kb_ = kbase0 + (j & 3) * (int)SHM_K; KFrag k0_, k1_, k2_;
          KRD(k0_, 0, kb_); KRD(k1_, 1, kb_); KRD(k2_, 2, kb_); pA0 = f32x16{}; pA1 = f32x16{};
          LW(4); QMM(k0_, 0); SBAR(); KRD(k0_, 3, kb_);
          LW(4); QMM(k1_, 1); SBAR(); KRD(k1_, 4, kb_);
          LW(4); QMM(k2_, 2); SBAR(); KRD(k2_, 5, kb_);
          LW(4); QMM(k0_, 3); SBAR(); KRD(k0_, 6, kb_);
          LW(4); QMM(k1_, 4); SBAR(); KRD(k1_, 7, kb_);
          LW(4); QMM(k2_, 5); SBAR();
          LW(2); QMM(k0_, 6); SBAR();
          LW(0); QMM(k1_, 7); SBAR(); }
        PSM(pA0, pA1, mnA, alA, j); RESC(alA);
        finishSM(pA0, pA1, alA, l_reg, pa0, pa1, pa2, pa3); SBAR();
        pv_d0(o, VBUF(j), pa0, pa1, pa2, pa3);
      }
      if (j + 1 < NT) ENDSTEP(j);
    }
  } else if constexpr (MK_PP) {
    const bool grpB = wid >= 4;
#if MK_NEGM
    m_reg = 0.f; f32x16 negm = f32x16{};
#endif
#define PP_BAR(VM) do { if (VM) { asm volatile("s_waitcnt vmcnt(4) lgkmcnt(0)\n\ts_barrier" ::: "memory"); } else { asm volatile("s_waitcnt vmcnt(0) lgkmcnt(0)\n\ts_barrier" ::: "memory"); } } while (0)
#define PP_BAR_PLAIN() asm volatile("s_waitcnt lgkmcnt(0)\n\ts_barrier" ::: "memory")
    if (grpB) PP_BAR_PLAIN();
    qkt(pA0, pA1, KBUF(0), qr, r32, hi);
    if (grpB) PP_BAR(2 < NT); else PP_BAR_PLAIN();
    for (int t = 0; t < NT; ++t) {
      if (grpB && t + 3 < NT) DMA(t + 3, (t + 3) & 3);
#if MK_NEGM
      partialSM_neg(pA0, pA1, m_reg, negm, alA, i0); if (!i0) RESC(alA);
#else
      PSM(pA0, pA1, mnA, alA, t); RESC(alA);
#endif
      finishSM(pA0, pA1, alA, l_reg, pa0, pa1, pa2, pa3);
#if MK_PROBE_V
      { float dm_ = alA;
#pragma unroll
        for (int q_ = 0; q_ < 32; ++q_) asm volatile("v_add_f32 %0, %0, %0" : "+v"(dm_));
        if (dm_ == 123.456f) l_reg += 1.f; }
#endif
      if (!(MK_PREB && t + 1 < NT)) { if (!grpB) PP_BAR(t + 2 < NT); else PP_BAR_PLAIN(); }
      else if (!grpB) PP_BAR(t + 2 < NT);
      if (!grpB && t + 3 < NT) DMA(t + 3, (t + 3) & 3);
      SBAR();
      if (t + 1 < NT) {
        const int kb_ = kbase0 + ((t + 1) & 3) * (int)SHM_K, vb_ = VBUF(t);
        KFrag k0_, k1_; VFrag fa_, fb_;
        KRD(k0_, 0, kb_); KRD(k1_, 1, kb_); pv_rd<0>(fa_, vb_);
        if (MK_PREB && grpB) asm volatile("s_barrier" ::: "memory");
#if MK_NEGM
        LW(10); pA0 = __builtin_amdgcn_mfma_f32_32x32x16_bf16(k0_.a, qr[0], negm, 0, 0, 0); pA1 = __builtin_amdgcn_mfma_f32_32x32x16_bf16(k0_.b, qr[0], negm, 0, 0, 0); SBAR(); KRD(k0_, 2, kb_);
#else
        pA0 = f32x16{}; pA1 = f32x16{};
        LW(10); QMM(k0_, 0); SBAR(); KRD(k0_, 2, kb_);
#endif
        LW(10); QMM(k1_, 1); SBAR(); KRD(k1_, 3, kb_);
        LW(4);  pv_mm(o[0], fa_, pa0, pa1, pa2, pa3); SBAR(); pv_rd<1>(fb_, vb_);
        LW(10); QMM(k0_, 2); SBAR(); KRD(k0_, 4, kb_);
        LW(10); QMM(k1_, 3); SBAR(); KRD(k1_, 5, kb_);
        LW(4);  pv_mm(o[1], fb_, pa0, pa1, pa2, pa3); SBAR(); pv_rd<2>(fa_, vb_);
        LW(10); QMM(k0_, 4); SBAR(); KRD(k0_, 6, kb_);
        LW(10); QMM(k1_, 5); SBAR(); KRD(k1_, 7, kb_);
        LW(4);  pv_mm(o[2], fa_, pa0, pa1, pa2, pa3); SBAR(); pv_rd<3>(fb_, vb_);
        LW(10); QMM(k0_, 6); SBAR();
        LW(8);  QMM(k1_, 7); SBAR();
        LW(0);  pv_mm(o[3], fb_, pa0, pa1, pa2, pa3);
      } else pv_d0(o, VBUF(t), pa0, pa1, pa2, pa3);
      if (t + 1 < NT) { if (grpB) PP_BAR(t + 3 < NT); else PP_BAR_PLAIN(); }
    }
    if (!grpB) PP_BAR_PLAIN();
#undef PP_BAR
#undef PP_BAR_PLAIN
#undef KRD
#undef QMM
#undef LW
  } else {
  if (2 < NT) DMA(2, 2);
  qkt(pA0, pA1, KBUF(0), qr, r32, hi); PSM(pA0, pA1, mnA, alA, 0);
  ENDSTEP(0);
  for (int j = 1; j + 1 < NT; j += 2) {
    if (j + 2 < NT) DMA(j + 2, (j + 2) & 3);
    SBAR(); qkt(pB0, pB1, KBUF(j), qr, r32, hi);
    finishSM(pA0, pA1, alA, l_reg, pa0, pa1, pa2, pa3); SGB_A(); SBAR();
    pv_d0(o, VBUF(j - 1), pa0, pa1, pa2, pa3); PSM(pB0, pB1, mnB, alB, j);
    RESC(alB); ENDSTEP(j);
    if (j + 3 < NT) DMA(j + 3, (j + 3) & 3);
    SBAR(); qkt(pA0, pA1, KBUF(j + 1), qr, r32, hi);
    finishSM(pB0, pB1, alB, l_reg, pa0, pa1, pa2, pa3); SGB_A(); SBAR();
    pv_d0(o, VBUF(j), pa0, pa1, pa2, pa3); PSM(pA0, pA1, mnA, alA, j + 1);
    RESC(alA); ENDSTEP(j + 1);
  }
  SBAR(); qkt(pB0, pB1, KBUF(NT - 1), qr, r32, hi);
  finishSM(pA0, pA1, alA, l_reg, pa0, pa1, pa2, pa3); SBAR();
  pv_d0(o, VBUF(NT - 2), pa0, pa1, pa2, pa3); PSM(pB0, pB1, mnB, alB, NT - 1);
  RESC(alB);
  finishSM(pB0, pB1, alB, l_reg, pa0, pa1, pa2, pa3); SBAR();
  pv_d0(o, VBUF(NT - 1), pa0, pa1, pa2, pa3);
  }
  if (hi == 0) li_l[r32] = l_reg; asm volatile("s_waitcnt lgkmcnt(0)" ::: "memory");
  if constexpr (DIL) { if (hi == 0) lse_o[(long)(wid * QBLK + r32) * lse_s] = m_reg + __log2f(l_reg); }
  float rli[16];
#pragma unroll
  for (int r = 0; r < 16; ++r) rli[r] = __builtin_amdgcn_rcpf(li_l[crow(r, hi)]);
  bf16* Ow = Ob + (long)(wid * QBLK) * os;
#pragma unroll
  for (int r = 0; r < 16; ++r) { const int orow = crow(r, hi);
#pragma unroll
    for (int d0 = 0; d0 < 4; ++d0) Ow[(long)orow * os + d0 * 32 + r32] = __float2bfloat16(o[d0][r] * rli[r]); }
  asm volatile("s_waitcnt lgkmcnt(0)\n\ts_barrier" ::: "memory");
#undef KROW
#undef DMA
#undef ENDSTEP
#undef RESC
#undef PSM
#undef KBUF
#undef SGB_A
#undef VBUF
}
}

#define GAS __attribute__((address_space(1)))
#define LAS __attribute__((address_space(3)))
typedef unsigned short bf16_t;
typedef unsigned v4u __attribute__((ext_vector_type(4)));
typedef unsigned v2u __attribute__((ext_vector_type(2)));
typedef float f32x4 __attribute__((ext_vector_type(4)));
#define LDS_WAIT() asm volatile("s_waitcnt lgkmcnt(0)" ::: "memory")

constexpr size_t MiB = 1u << 20;
constexpr size_t WS_W1T = 0;
constexpr size_t WS_W2T = 104 * MiB;
constexpr size_t WS_H = 136 * MiB;
constexpr size_t WS_PROJ = 200 * MiB;
constexpr size_t WS_YA = 408 * MiB;
constexpr size_t WS_YB = 440 * MiB;
constexpr size_t WS_LSE = 536 * MiB;
constexpr size_t WS_ROPE = 538 * MiB;
constexpr size_t WS_XB = 540 * MiB;
constexpr size_t WS_ROWSQ = 604 * MiB;
constexpr size_t WS_END = 616 * MiB;
static_assert((size_t)DEPTH * DIN * DM * 2 <= WS_W2T - WS_W1T && (size_t)M * DIN * 2 <= WS_YA - WS_PROJ && (size_t)3 * M * DB * 2 <= WS_LSE - WS_YB, "ws map");
constexpr int LDS_BYTES = 147456;
constexpr int N_PHASES = 2 + 5 * DEPTH;

__device__ __forceinline__ unsigned f2bf(float f) { unsigned u = __builtin_bit_cast(unsigned, f); return (u + 0x7fffu + ((u >> 16) & 1u)) >> 16; }
__device__ __forceinline__ unsigned pk2(float lo, float hi) { return f2bf(lo) | (f2bf(hi) << 16); }
__device__ __forceinline__ float bflo(unsigned w) { return __uint_as_float(w << 16); }
__device__ __forceinline__ float bfhi(unsigned w) { return __uint_as_float(w & 0xffff0000u); }
__device__ __forceinline__ float wave_sum(float v) {
#pragma unroll
    for (int o = 1; o < 64; o <<= 1) v += __shfl_xor(v, o);
    return v;
}

__device__ const float INV_FREQ[32] = {1.000000000e+00f, 7.498942614e-01f, 5.623413324e-01f, 4.216965139e-01f, 3.162277639e-01f, 2.371373773e-01f, 1.778279394e-01f, 1.333521307e-01f,
    1.000000015e-01f, 7.498941571e-02f, 5.623413250e-02f, 4.216965288e-02f, 3.162277490e-02f, 2.371373773e-02f, 1.778279431e-02f, 1.333521493e-02f,
    9.999999776e-03f, 7.498941850e-03f, 5.623413250e-03f, 4.216964822e-03f, 3.162277630e-03f, 2.371373586e-03f, 1.778279431e-03f, 1.333521446e-03f,
    1.000000047e-03f, 7.498942432e-04f, 5.623413017e-04f, 4.216965172e-04f, 3.162277571e-04f, 2.371373703e-04f, 1.778279402e-04f, 1.333521504e-04f};

__device__ __forceinline__ void sincos_acc(float a, float& s, float& c) {
    const double x = (double)a, kd = __builtin_rint(x * 0.63661977236758134308);
    const int k = (int)kd; const double r = x - kd * 1.57079632679489661923, r2 = r * r;
    const double sp = r * (1.0 + r2 * (-1.0 / 6 + r2 * (1.0 / 120 + r2 * (-1.0 / 5040 + r2 * (1.0 / 362880 + r2 * (-1.0 / 39916800 + r2 * (1.0 / 6227020800.0)))))));
    const double cp = 1.0 + r2 * (-0.5 + r2 * (1.0 / 24 + r2 * (-1.0 / 720 + r2 * (1.0 / 40320 + r2 * (-1.0 / 3628800 + r2 * (1.0 / 479001600.0 + r2 * (-1.0 / 87178291200.0)))))));
    const int q = k & 3;
    const double sv = (q == 0) ? sp : (q == 1) ? cp : (q == 2) ? -sp : -cp, cv = (q == 0) ? cp : (q == 1) ? -sp : (q == 2) ? -cp : sp;
    s = (float)sv; c = (float)cv;
}

__device__ __forceinline__ void p0_transpose_item(const float* W, int K, int N, bf16_t* WT, LAS float* scr, int item, int lane, const float* kscale) {
    const int nblk = N / 32, kb = item / nblk, nb = item % nblk, k0 = 64 * kb, n0 = 32 * nb;
#pragma unroll 8
    for (int i = 0; i < 32; ++i) { const int kk = 2 * i + (lane >> 5); scr[kk * 33 + (lane & 31)] = W[(size_t)(k0 + kk) * N + n0 + (lane & 31)] * (kscale ? kscale[k0 + kk] : 1.0f); }
    LDS_WAIT(); asm volatile("" ::: "memory");
    const int c = lane & 7;
#pragma unroll
    for (int j = 0; j < 4; ++j) { const int n = (lane >> 3) + 8 * j; const LAS float* s = scr + (8 * c) * 33 + n;
        v4u o; o.x = pk2(s[0 * 33], s[1 * 33]); o.y = pk2(s[2 * 33], s[3 * 33]); o.z = pk2(s[4 * 33], s[5 * 33]); o.w = pk2(s[6 * 33], s[7 * 33]);
        *(v4u*)(WT + (size_t)(n0 + n) * K + k0 + 8 * c) = o; }
    LDS_WAIT(); asm volatile("" ::: "memory");
}

#define XB_TMO      128
#define XB_XCNT(j)  (256  + 64 * (j))
#define XB_XSUB(j)  (1280 + 64 * (j))
#define XB_XGEN(j)  (2304 + 64 * (j))
#define XB_TOP      3328
#define XB_TOPGEN   3392
#define XCD_BAR_WORDS 3456
#define XB_SPIN_CAP (1u << 18)

__device__ __forceinline__ unsigned xb_ld(unsigned* p)              { return __hip_atomic_load(p, __ATOMIC_RELAXED, __HIP_MEMORY_SCOPE_AGENT); }
__device__ __forceinline__ unsigned xb_add(unsigned* p, unsigned v) { return __hip_atomic_fetch_add(p, v, __ATOMIC_RELAXED, __HIP_MEMORY_SCOPE_AGENT); }
__device__ __forceinline__ unsigned xb_xcc_id() { return (unsigned)__builtin_amdgcn_s_getreg((3 << 11) | 20) & 0xFu; }
#define XB_SPIN(cond, bar) do { unsigned _sp = 0; while (cond) { __builtin_amdgcn_s_sleep(1); \
    if ((++_sp & 255u) == 0u) { if (xb_ld(&(bar)[XB_TMO])) break; if (_sp > XB_SPIN_CAP) { atomicAdd(&(bar)[XB_TMO], 1u); break; } } } } while (0)

struct XcdBarrier {
    unsigned* bar; unsigned x;
    volatile LAS unsigned* st;
};

__device__ __forceinline__ XcdBarrier xcd_barrier_post(unsigned* bar, volatile LAS unsigned* st) {
    XcdBarrier b; b.bar = bar; b.x = xb_xcc_id(); b.st = st;
    if (threadIdx.x == 0) (void)xb_add(&bar[XB_XCNT(b.x)], 1u);
    return b;
}
__device__ __forceinline__ void xcd_barrier_complete(unsigned* bar, unsigned x, unsigned& nloc, unsigned& nx) {
    const unsigned G = gridDim.x * gridDim.y * gridDim.z;
    unsigned sum, cnt, mine, sp = 0u;
    for (;;) {
        sum = 0u; cnt = 0u; mine = 0u;
#pragma unroll
        for (unsigned j = 0; j < 16; ++j) { const unsigned c = xb_ld(&bar[XB_XCNT(j)]); sum += c; cnt += (c > 0u) ? 1u : 0u; mine = (j == x) ? c : mine; }
        if (sum == G) break;
        __builtin_amdgcn_s_sleep(1);
        if ((++sp & 255u) == 0u) { if (xb_ld(&bar[XB_TMO])) break; if (sp > XB_SPIN_CAP) { atomicAdd(&bar[XB_TMO], 1u); break; } }
    }
    nloc = mine > 0u ? mine : 1u; nx = cnt > 0u ? cnt : 1u;
}

__device__ __forceinline__ void xcd_barrier(const XcdBarrier& b) {
    asm volatile("s_waitcnt vmcnt(0)" ::: "memory");
    __syncthreads();
    if (threadIdx.x == 0) {
        unsigned* bar = b.bar;
        __builtin_amdgcn_s_waitcnt(0);
        unsigned nloc = b.st[0], nx = b.st[1];
        if (nloc == 0u) { xcd_barrier_complete(bar, b.x, nloc, nx); b.st[0] = nloc; b.st[1] = nx; }
        const unsigned old = xb_add(&bar[XB_XSUB(b.x)], 1u);
        const unsigned gen = old / nloc;
        if (old + 1u == (gen + 1u) * nloc) {
            __builtin_amdgcn_fence(__ATOMIC_RELEASE, "agent");
            asm volatile("s_waitcnt vmcnt(0)" ::: "memory");
            const unsigned og = xb_add(&bar[XB_TOP], 1u);
            const unsigned tg = og / nx;
            if (og + 1u == (tg + 1u) * nx) xb_add(&bar[XB_TOPGEN], 1u);
            else XB_SPIN(xb_ld(&bar[XB_TOPGEN]) == tg, bar);
            __builtin_amdgcn_fence(__ATOMIC_ACQUIRE, "agent");
            xb_add(&bar[XB_XGEN(b.x)], 1u);
            asm volatile("s_waitcnt vmcnt(0)" ::: "memory");
        } else {
            XB_SPIN(xb_ld(&bar[XB_XGEN(b.x)]) == gen, bar);
            __builtin_amdgcn_fence(__ATOMIC_ACQUIRE, "agent");
            asm volatile("s_waitcnt vmcnt(0)" ::: "memory");
        }
    }
    __syncthreads();
}

constexpr size_t WS_CTL = 539 * MiB, CTL_BYTES = 16384;
constexpr int MISC_OFF = 147456 - 128;
__device__ __forceinline__ void gate_row(int m, int lane, const bf16_t* __restrict__ YA, const bf16_t* __restrict__ YB, const float* __restrict__ LSE, const bf16_t* __restrict__ PROJ,
                                         const float* __restrict__ wa, const float* __restrict__ wb, bf16_t* __restrict__ H) {
                    float ya[2][8], yb[2][8]; float ssa = 0.f, ssb = 0.f;
#pragma unroll
                    for (int j = 0; j < 2; ++j) { const int c = lane + 64 * j, hh = c >> 4;
                        const v4u a = *(const v4u*)(YA + (size_t)m * DA + 8 * c);
                        ya[j][0] = bflo(a.x); ya[j][1] = bfhi(a.x); ya[j][2] = bflo(a.y); ya[j][3] = bfhi(a.y); ya[j][4] = bflo(a.z); ya[j][5] = bfhi(a.z); ya[j][6] = bflo(a.w); ya[j][7] = bfhi(a.w);
                        const float l0 = LSE[((size_t)0 * M + m) * 8 + hh], l1 = LSE[((size_t)1 * M + m) * 8 + hh], l2 = LSE[((size_t)2 * M + m) * 8 + hh];
                        const float mx = fmaxf(l0, fmaxf(l1, l2)); const float e0 = __builtin_amdgcn_exp2f(l0 - mx), e1 = __builtin_amdgcn_exp2f(l1 - mx), e2 = __builtin_amdgcn_exp2f(l2 - mx);
                        const float inv = 1.0f / (e0 + e1 + e2); const float w0 = e0 * inv, w1 = e1 * inv, w2 = e2 * inv;
                        const v4u b0 = *(const v4u*)(YB + ((size_t)0 * M + m) * DB + 8 * c), b1 = *(const v4u*)(YB + ((size_t)1 * M + m) * DB + 8 * c), b2 = *(const v4u*)(YB + ((size_t)2 * M + m) * DB + 8 * c);
                        yb[j][0] = w0 * bflo(b0.x) + w1 * bflo(b1.x) + w2 * bflo(b2.x); yb[j][1] = w0 * bfhi(b0.x) + w1 * bfhi(b1.x) + w2 * bfhi(b2.x);
                        yb[j][2] = w0 * bflo(b0.y) + w1 * bflo(b1.y) + w2 * bflo(b2.y); yb[j][3] = w0 * bfhi(b0.y) + w1 * bfhi(b1.y) + w2 * bfhi(b2.y);
                        yb[j][4] = w0 * bflo(b0.z) + w1 * bflo(b1.z) + w2 * bflo(b2.z); yb[j][5] = w0 * bfhi(b0.z) + w1 * bfhi(b1.z) + w2 * bfhi(b2.z);
                        yb[j][6] = w0 * bflo(b0.w) + w1 * bflo(b1.w) + w2 * bflo(b2.w); yb[j][7] = w0 * bfhi(b0.w) + w1 * bfhi(b1.w) + w2 * bfhi(b2.w);
#pragma unroll
                        for (int i = 0; i < 8; ++i) { ssa += ya[j][i] * ya[j][i]; ssb += yb[j][i] * yb[j][i]; } }
                    const float ra = 1.0f / sqrtf(wave_sum(ssa) * (1.0f / DA) + EPS), rb = 1.0f / sqrtf(wave_sum(ssb) * (1.0f / DB) + EPS);
#pragma unroll
                    for (int j = 0; j < 2; ++j) { const int c = lane + 64 * j;
                        const v4u ga = *(const v4u*)(PROJ + ((size_t)(H_GA + (c >> 4)) * M + m) * HD + 8 * (c & 15)), gb = *(const v4u*)(PROJ + ((size_t)(H_GB + (c >> 4)) * M + m) * HD + 8 * (c & 15));
                        const float gaf[8] = {bflo(ga.x), bfhi(ga.x), bflo(ga.y), bfhi(ga.y), bflo(ga.z), bfhi(ga.z), bflo(ga.w), bfhi(ga.w)};
                        const float gbf[8] = {bflo(gb.x), bfhi(gb.x), bflo(gb.y), bfhi(gb.y), bflo(gb.z), bfhi(gb.z), bflo(gb.w), bfhi(gb.w)};
                        const f32x4 wa0 = *(const f32x4*)(wa + 8 * c), wa1 = *(const f32x4*)(wa + 8 * c + 4), wb0 = *(const f32x4*)(wb + 8 * c), wb1 = *(const f32x4*)(wb + 8 * c + 4);
                        float za[8], zb[8];
#pragma unroll
                        for (int i = 0; i < 8; ++i) { const float wai = i < 4 ? wa0[i & 3] : wa1[i & 3], wbi = i < 4 ? wb0[i & 3] : wb1[i & 3];
                            const float sa = gaf[i] / (1.0f + __expf(-gaf[i])), sb = gbf[i] / (1.0f + __expf(-gbf[i]));
                            za[i] = ya[j][i] * ra * wai * sa; zb[i] = yb[j][i] * rb * wbi * sb; }
                        v4u oa, ob; oa.x = pk2(za[0], za[1]); oa.y = pk2(za[2], za[3]); oa.z = pk2(za[4], za[5]); oa.w = pk2(za[6], za[7]);
                        ob.x = pk2(zb[0], zb[1]); ob.y = pk2(zb[2], zb[3]); ob.z = pk2(zb[4], zb[5]); ob.w = pk2(zb[6], zb[7]);
                        *(v4u*)(H + (size_t)m * DM + 8 * c) = oa; *(v4u*)(H + (size_t)m * DM + DA + 8 * c) = ob; }
}

struct Params { const float *x, *norm_w, *w_in, *qn, *kn, *ona, *onb, *w_out, *fnorm; float* out; unsigned char* ws; int ph_lo, ph_hi; };

__global__ void __launch_bounds__(512, 2) mk_fwd(Params p) {
    extern __shared__ __attribute__((aligned(16))) unsigned char lds[];
    volatile LAS unsigned* MISC = (volatile LAS unsigned*)((LAS unsigned char*)lds + MISC_OFF);
    if (threadIdx.x < 32) MISC[threadIdx.x] = 0u;
    __syncthreads();
    XcdBarrier bar = xcd_barrier_post((unsigned*)(p.ws + WS_CTL), MISC + 8);
    if (p.ph_lo == 0) {
        float* RCOS0 = (float*)(p.ws + WS_ROPE); float* RSIN0 = RCOS0 + 192 * 32;
        for (int i = blockIdx.x * 512 + threadIdx.x; i < 192 * 32; i += gridDim.x * 512) {
            const int pos = i >> 5, f = i & 31; const float pv = (float)(pos < 128 ? pos : pos - 128);
            float sn_, cs_; sincos_acc(pv * INV_FREQ[f], sn_, cs_); RCOS0[i] = cs_; RSIN0[i] = sn_;
        }
    }
    for (int ph = p.ph_lo; ph < p.ph_hi; ++ph) {
        const int tid = otid(), lane = tid & 63, wave = __builtin_amdgcn_readfirstlane(tid >> 6);
        int G = gridDim.x, bx = blockIdx.x; asm volatile("" : "+s"(G), "+s"(bx));
        const int vcu = (G % 8 == 0) ? (bx % 8) * (G / 8) + bx / 8 : bx;
        const int gw = vcu * 8 + wave, NGW = G * 8;
        size_t zoff = 0; asm volatile("" : "+s"(zoff));
        unsigned char* ws = p.ws + zoff;
        bf16_t* W1T = (bf16_t*)(ws + WS_W1T); bf16_t* W2T = (bf16_t*)(ws + WS_W2T); bf16_t* H = (bf16_t*)(ws + WS_H); bf16_t* PROJ = (bf16_t*)(ws + WS_PROJ);
        bf16_t* YA = (bf16_t*)(ws + WS_YA); bf16_t* YB = (bf16_t*)(ws + WS_YB); float* LSE = (float*)(ws + WS_LSE);
        float* RCOS = (float*)(ws + WS_ROPE); float* RSIN = RCOS + 192 * 32;
        bf16_t* XB = (bf16_t*)(ws + WS_XB); float* ROWSQ = (float*)(ws + WS_ROWSQ);
        if (ph == 0) {
            LAS float* scr = (LAS float*)((LAS unsigned char*)lds + wave * 16384);
            constexpr int I1 = (DM / 64) * (DIN / 32), I2 = (DM / 64) * (DM / 32), IL = I1 + I2;
            DUPREP(0) for (int it = gw; it < DEPTH * IL; it += NGW) {
                const int l = it / IL, r = it % IL;
                if (r < I1) p0_transpose_item(p.w_in + (size_t)l * DM * DIN, DM, DIN, W1T + (size_t)l * DIN * DM, scr, r, lane, p.norm_w + (size_t)l * DM);
                else p0_transpose_item(p.w_out + (size_t)l * DM * DM, DM, DM, W2T + (size_t)l * DM * DM, scr, r - I1, lane, nullptr);
            }
            for (int m = gw; m < M; m += NGW) {
                const f32x4* xr = (const f32x4*)(p.x + (size_t)m * DM) + lane; v2u* o8 = (v2u*)(XB + (size_t)m * DM) + lane; float sq = 0.f;
#pragma unroll
                for (int j = 0; j < 8; ++j) { const f32x4 v = xr[64 * j]; v2u w; w.x = pk2(v.x, v.y); w.y = pk2(v.z, v.w); o8[64 * j] = w;
                    const float r0 = bflo(w.x), r1 = bfhi(w.x), r2 = bflo(w.y), r3 = bfhi(w.y); sq += (r0 * r0 + r1 * r1) + (r2 * r2 + r3 * r3); }
                sq = wave_sum(sq); if (lane < 32) ROWSQ[(size_t)m * 32 + lane] = (lane == 0) ? sq : 0.f;
            }
        } else if (ph == N_PHASES - 1) {
            for (int m = gw; m < M; m += NGW) {
                f32x4* xr = (f32x4*)(p.out + (size_t)m * DM) + lane; const f32x4* wr_ = (const f32x4*)p.fnorm + lane; const v2u* xb8 = (const v2u*)(XB + (size_t)m * DM) + lane;
                const float rstd = 1.0f / sqrtf(wave_sum(lane < 32 ? ROWSQ[((size_t)DEPTH * M + m) * 32 + lane] : 0.f) * (1.0f / DM) + EPS);
#pragma unroll
                for (int j = 0; j < 8; ++j) { const v2u w = xb8[64 * j]; const f32x4 v = {bflo(w.x), bfhi(w.x), bflo(w.y), bfhi(w.y)}; xr[64 * j] = v * rstd * wr_[64 * j]; }
            }
        } else {
            const int l = (ph - 1) / 5, st = (ph - 1) % 5 + 1;
            if (st == 1) {
                pg8::Gemm g{XB, W1T + (size_t)l * DIN * DM, M, DIN, DM}; pg8::StaticOrder S; S.init(M, DIN, G, bx);
                pg8::EpiHeadMajor E{PROJ, M, ROWSQ + (size_t)l * M * 32, 1.0f / DM, EPS};
#ifndef MK_NO_G1
                DUPREP(2) pg8::gemm_phase<pg8::EpiHeadMajor, pg8::StaticOrder, PG8_ALIGN, PG8_SP2>((PG8_LAS unsigned char*)lds, g, S, E);
#endif
            } else if (st == 2) {
                const float* qg = p.qn + l * HD; const float* kg = p.kn + l * HD;
                constexpr int QKU = 4;
                for (int it0 = gw; it0 < M * 10 / 4; it0 += QKU * NGW) {
                    const int j = lane & 15, half = j >> 3, jj = j & 7, e = half * 64 + 4 * jj;
                    v2u a[QKU], b[QKU]; f32x4 cs[QKU], sn[QKU]; bf16_t* pp[QKU]; bool isq[QKU];
#pragma unroll
                    for (int u = 0; u < QKU; ++u) { const int it = min(it0 + u * NGW, M * 10 / 4 - 1);
                        const int g = it * 4 + (lane >> 4), row = g / 10, hs = g - row * 10; isq[u] = hs < 8;
                        pp[u] = PROJ + ((size_t)hs * M + row) * HD + e; a[u] = *(const v2u*)pp[u]; b[u] = *(const v2u*)(pp[u] + 32);
                        const int t = row & (T - 1), pos = half ? 128 + (t & 63) : (t >> 6);
                        cs[u] = *(const f32x4*)(RCOS + pos * 32 + 4 * jj); sn[u] = *(const f32x4*)(RSIN + pos * 32 + 4 * jj); }
                    asm volatile("" ::: "memory");
#pragma unroll
                    for (int u = 0; u < QKU; ++u) {
                        float x1[4] = {bflo(a[u].x), bfhi(a[u].x), bflo(a[u].y), bfhi(a[u].y)}, x2[4] = {bflo(b[u].x), bfhi(b[u].x), bflo(b[u].y), bfhi(b[u].y)};
                        float ss = 0.f;
#pragma unroll
                        for (int i = 0; i < 4; ++i) ss += x1[i] * x1[i] + x2[i] * x2[i];
                        ss += __shfl_xor(ss, 1); ss += __shfl_xor(ss, 2); ss += __shfl_xor(ss, 4); ss += __shfl_xor(ss, 8);
                        const float rstd = 1.0f / sqrtf(ss * (1.0f / HD) + EPS);
                        const float* gn = isq[u] ? qg : kg;
                        const float qsc = (MK_NEGM && isq[u]) ? att::SCALE * att::LOG2E : 1.0f;
                        const f32x4 g1 = *(const f32x4*)(gn + e), g2 = *(const f32x4*)(gn + e + 32);
                        float o1[4], o2[4];
#pragma unroll
                        for (int i = 0; i < 4; ++i) { const float y1 = x1[i] * rstd * g1[i], y2 = x2[i] * rstd * g2[i]; o1[i] = (y1 * cs[u][i] - y2 * sn[u][i]) * qsc; o2[i] = (y1 * sn[u][i] + y2 * cs[u][i]) * qsc; }
                        v2u w1, w2; w1.x = pk2(o1[0], o1[1]); w1.y = pk2(o1[2], o1[3]); w2.x = pk2(o2[0], o2[1]); w2.y = pk2(o2[2], o2[3]);
                        if (it0 + u * NGW < M * 10 / 4) { *(v2u*)pp[u] = w1; *(v2u*)(pp[u] + 32) = w2; }
                    }
                }
#ifndef MK_NO_DIL
                DUPREP(3) for (int u = vcu; u < 1536; u += G) {
                    const int pt = u >> 9, rem = u & 511, b = rem >> 8, h = (rem >> 5) & 7, w = rem & 31;
                    const int d = (pt == 0) ? 1 : (pt == 1) ? 4 : 16, res = w & (d - 1), blk = w / d, i0 = blk * 256, nsub = T / d;
                    const float slope = __builtin_amdgcn_exp2f(-(float)(h + 1));
                    const float nslopeC = -slope * (float)d * att::LOG2E;
                    const size_t tok0 = (size_t)b * T + res;
                    const att::bf16* Pb = (const att::bf16*)PROJ + ((size_t)h * M + tok0) * HD;
                    const long rs = (long)d * HD;
                    att::attn_body<true>(Pb + (size_t)H_QB * M * HD + (long)i0 * rs, Pb + (size_t)H_KB * M * HD, Pb + (size_t)H_VB * M * HD, rs, rs,
                                         (att::bf16*)YB + ((size_t)pt * M + tok0 + (size_t)i0 * d) * DB + h * HD, (long)d * DB,
                                         LSE + ((size_t)pt * M + tok0 + (size_t)i0 * d) * 8 + h, d * 8, i0, nsub, nslopeC, 0, (char*)lds);
                }
#endif
            } else if (st == 3) {
#ifndef MK_NO_DENSE
                int bounded;
                { const float* qg = p.qn + l * HD; const float* kg = p.kn + l * HD;
                  float gq = fmaxf(fabsf(qg[lane]), fabsf(qg[lane + 64])), gk = fmaxf(fabsf(kg[lane]), fabsf(kg[lane + 64]));
#pragma unroll
                  for (int o_ = 1; o_ < 64; o_ <<= 1) { gq = fmaxf(gq, __shfl_xor(gq, o_)); gk = fmaxf(gk, __shfl_xor(gk, o_)); }
                  const float bnd = gq * gk * 128.f * att::SCALE * att::LOG2E;
                  bounded = __builtin_amdgcn_readfirstlane((MK_NEGM && bnd <= 64.f) ? 1 : 0); }
                DUPREP(4) for (int u = vcu; u < 512; u += G) {
                    const int combo = u >> 7, b = combo >> 1, kvh = combo & 1, h = kvh * 4 + ((u >> 5) & 3), qb = u & 31;
                    const att::bf16* Pb = (const att::bf16*)PROJ + (size_t)b * T * HD;
                    att::attn_body<false>(Pb + ((size_t)(H_QA + h) * M + qb * 256) * HD, Pb + (size_t)(H_KA + kvh) * M * HD, Pb + (size_t)(H_VA + kvh) * M * HD, HD, HD,
                                          (att::bf16*)YA + ((size_t)b * T + qb * 256) * DA + h * HD, DA, nullptr, 0, bounded, 0, 0.f, T, (char*)lds);
                }
#endif
            } else if (st == 4) {
                const float* wa = p.ona + (size_t)l * DA; const float* wb = p.onb + (size_t)l * DB;
                DUPREP(5) for (int m = gw; m < M; m += 2 * NGW) {
                    gate_row(m, lane, YA, YB, LSE, PROJ, wa, wb, H);
                    if (m + NGW < M) gate_row(m + NGW, lane, YA, YB, LSE, PROJ, wa, wb, H);
                }
            } else {
                pg8::Gemm g{H, W2T + (size_t)l * DM * DM, M, DM, DM}; pg8::StaticOrder S; S.init(M, DM, G, bx);
                pg8::EpiResF32 E{XB, ROWSQ + (size_t)(l + 1) * M * 32, DM};
#ifndef MK_NO_G2
                pg8::gemm_phase<pg8::EpiResF32, pg8::StaticOrder, PG8_ALIGN, PG8_SP2>((PG8_LAS unsigned char*)lds, g, S, E);
#endif
            }
        }
        if (ph + 1 < p.ph_hi) { if (p.ph_hi > 4096) cg::this_grid().sync(); else xcd_barrier(bar); if (MK_DUP & 64) xcd_barrier(bar); }
    }
}

extern "C" void kernel_launch(void* const* d_in, const int* in_sizes, int n_in, void* d_out, int out_size, void* d_ws, size_t ws_size, hipStream_t stream) {
    static int grid = 0;
    if (grid == 0) {
        if (n_in != 9 || in_sizes[0] != M * DM || out_size != M * DM || ws_size < WS_END) { fprintf(stderr, "kernel_launch: unexpected shapes (n_in %d, ws %zu)\n", n_in, ws_size); grid = -1; return; }
        int dev = 0, cus = 0, per_cu = 0;
        hipGetDevice(&dev); hipDeviceGetAttribute(&cus, hipDeviceAttributeMultiprocessorCount, dev);
        if (hipFuncSetAttribute((const void*)mk_fwd, hipFuncAttributeMaxDynamicSharedMemorySize, LDS_BYTES) != hipSuccess) { fprintf(stderr, "kernel_launch: hipFuncSetAttribute failed\n"); grid = -1; return; }
        if (hipOccupancyMaxActiveBlocksPerMultiprocessor(&per_cu, (const void*)mk_fwd, 512, LDS_BYTES) != hipSuccess || per_cu < 1) per_cu = 1;
        (void)hipGetLastError();
        grid = cus * per_cu;
    }
    if (grid < 0) return;
    Params p{};
    p.x = (const float*)d_in[0]; p.norm_w = (const float*)d_in[1]; p.w_in = (const float*)d_in[2]; p.qn = (const float*)d_in[3]; p.kn = (const float*)d_in[4];
    p.ona = (const float*)d_in[5]; p.onb = (const float*)d_in[6]; p.w_out = (const float*)d_in[7]; p.fnorm = (const float*)d_in[8];
    p.out = (float*)d_out; p.ws = (unsigned char*)d_ws;
    if (hipMemsetAsync((char*)d_ws + WS_CTL, 0, CTL_BYTES, stream) != hipSuccess) { fprintf(stderr, "kernel_launch: memset failed\n"); return; }
#if MK_ONE_LAUNCH
    p.ph_lo = 0; p.ph_hi = N_PHASES;
    void* args[] = {&p};
    hipError_t e = hipLaunchCooperativeKernel((const void*)mk_fwd, dim3(grid), dim3(512), args, LDS_BYTES, stream);
    if (e != hipSuccess) fprintf(stderr, "kernel_launch: cooperative launch failed: %s (grid %d)\n", hipGetErrorString(e), grid);
#else
    for (int ph = 0; ph < N_PHASES; ++ph) { p.ph_lo = ph; p.ph_hi = ph + 1; hipLaunchKernelGGL(mk_fwd, dim3(grid), dim3(512), LDS_BYTES, stream, p); }
#endif
}
```

```cpp
#include <hip/hip_runtime.h>
#include <hip/hip_bf16.h>
#include <hip/hip_cooperative_groups.h>
#include <cstdio>
#include <cstdint>
namespace cg = cooperative_groups;

#ifndef MK_DUP
#define MK_DUP 0
#endif
#define DUPREP(k) for (int rep_ = 0; rep_ < 1 + ((MK_DUP >> (k)) & 1); ++rep_)
#ifndef MK_PVPIPE
#define MK_PVPIPE 1
#endif
#ifndef MK_SGB
#define MK_SGB 0
#endif
#ifndef MK_PP
#define MK_PP 1
#endif
#ifndef MK_PROBE_V
#define MK_PROBE_V 0
#endif
#ifndef MK_NEGM
#define MK_NEGM 1
#endif
#ifndef MK_PREB
#define MK_PREB 1
#endif
#ifndef MK_OSTAGE
#define MK_OSTAGE 1
#endif
#ifndef MK_ONE_LAUNCH
#define MK_ONE_LAUNCH 1
#endif
static_assert(!MK_NEGM || MK_PP, "MK_NEGM pre-scales q for the ping-pong dense body only");

constexpr int BATCH = 2, T = 8192, DM = 2048, DEPTH = 4, HD = 128, DA = 1024, DB = 1024, DIN = 6656, M = BATCH * T;
constexpr int C_QA = 0, C_KA = 1024, C_VA = 1280, C_GA = 1536, C_QB = 2560, C_KB = 3584, C_VB = 4608, C_GB = 5632;
constexpr int H_QA = 0, H_KA = 8, H_VA = 10, H_GA = 12, H_QB = 20, H_KB = 28, H_VB = 36, H_GB = 44;
constexpr float EPS = 1e-6f;
__device__ __forceinline__ int otid() { int t = threadIdx.x; asm volatile("" : "+v"(t)); return t; }

namespace pg8 {
#define PG8_LAS __attribute__((address_space(3)))
typedef unsigned short bf16_t;
typedef short bf16x8 __attribute__((ext_vector_type(8)));
typedef float f32x4 __attribute__((ext_vector_type(4)));
typedef unsigned u32x4 __attribute__((ext_vector_type(4)));
constexpr int BM = 256, BK = 64, HALF = 128, HTB = HALF * BK * 2  , STAGE_BYTES = 8 * HTB, NXCD = 8, WGM = 4;

__host__ __device__ __forceinline__ int lds_byte(int r, int c) { const int st = (r >> 4) * 2 + (c >> 5), rr = r & 15, cc = c & 31, ob = rr * 64 + cc * 2; return st * 1024 + (ob ^ (((ob >> 9) & 1) << 5)); }
__host__ __device__ __forceinline__ void stage_rc(int b, int& R, int& C) { const int st = b / 1024, sb = b % 1024, swz = sb ^ (((sb >> 9) & 1) << 5); R = (st >> 1) * 16 + swz / 64; C = (st & 1) * 32 + (swz % 64) / 2; }
__host__ __device__ __forceinline__ int perm32(int rho) { const int n = rho >> 4, i = rho & 15; return 8 * (i >> 2) + 4 * n + (i & 3); }

struct Unit { int pm, pn; };
struct Gemm { const bf16_t* A; const bf16_t* Bt; int M, N, K; };

struct StaticOrder {
    int nM, nN, nwg, G, c;
    __host__ __device__ void init(int M, int N, int G_, int c_) { nM = M / BM; nN = N / BM; nwg = nM * nN; G = G_; c = c_; }
    __host__ __device__ bool next(int i, Unit& u) const {
        const long L = (long)i * G + c; if (L >= nwg) return false;
        int wgid = (int)L; { const int q = nwg / NXCD, r = nwg % NXCD, xcd = wgid % NXCD, off = wgid / NXCD; wgid = (xcd < r ? xcd * (q + 1) : r * (q + 1) + (xcd - r) * q) + off; }
        const int nig = WGM * nN, gid = wgid / nig, fm = gid * WGM, gsz = (nM - fm) < WGM ? (nM - fm) : WGM;
        u.pm = fm + ((wgid % nig) % gsz); u.pn = (wgid % nig) / gsz; return true;
    }
    __device__ __forceinline__ void a_ready(const Unit&) const {}
    __device__ __forceinline__ void done(const Unit&) const {}
};

__device__ __forceinline__ unsigned cvt_pk_bf16(float lo, float hi) { unsigned r; asm volatile("v_cvt_pk_bf16_f32 %0, %1, %2" : "=v"(r) : "v"(lo), "v"(hi)); return r; }
typedef float f32x2 __attribute__((ext_vector_type(2)));
__device__ __forceinline__ f32x2 gelu_pk(f32x2 v) {
    const f32x2 av = __builtin_elementwise_abs(v), d = av * 0.2316418882f + 1.0f;
    f32x2 t; t.x = __builtin_amdgcn_rcpf(d.x); t.y = __builtin_amdgcn_rcpf(d.y);
    f32x2 q = t * 0.5307027145f + (-0.7265760135f); q = q * t + 0.7107068705f; q = q * t + (-0.142248368f); q = q * t + 0.127414796f; q = q * t;
    const f32x2 s = (v * v) * (-0.72134752044f);
    f32x2 e; e.x = __builtin_amdgcn_exp2f(s.x); e.y = __builtin_amdgcn_exp2f(s.y);
    const f32x2 m = v * (q * e), r = v - m;
    f32x2 o; o.x = v.x < 0.f ? m.x : r.x; o.y = v.y < 0.f ? m.y : r.y; return o;
}

template <int ACT  > struct EpiBf16 {
    static constexpr bool PERM = true, AFTER_DRAIN = false; static_assert(ACT == 0 || ACT == 1, "EpiBf16: ACT is 0 (none) or 1 (gelu_pk)");
    bf16_t* O; int ldc; const float* bias; int split_cols; size_t split_stride; float scale0;
    __device__ __forceinline__ void operator()(const f32x4 (&acc)[2][2][4][2], const Unit& u, int wr, int wc, int fr, int fq) const {
        const int row0 = u.pm * BM + wr * 64 + fr; int colt = u.pn * BM; bf16_t* base = O;
        float sc = 1.f; if (split_cols) { const int t = colt / split_cols; base += (size_t)t * split_stride; colt -= t * split_cols; if (t == 0) sc = scale0; }
        const int col0 = colt + wc * 32 + 8 * fq, bcol0 = u.pn * BM + wc * 32 + 8 * fq;
        f32x4 bv[2][2];
#pragma unroll
        for (int bj = 0; bj < 2; ++bj)
#pragma unroll
            for (int n = 0; n < 2; ++n) bv[bj][n] = bias ? *(const f32x4*)(bias + bcol0 + bj * HALF + 4 * n) : (f32x4){0.f, 0.f, 0.f, 0.f};
#pragma unroll
        for (int ai = 0; ai < 2; ++ai)
#pragma unroll
            for (int m = 0; m < 4; ++m) { bf16_t* rowp = base + (size_t)(row0 + ai * HALF + m * 16) * ldc + col0;
#pragma unroll
                for (int bj = 0; bj < 2; ++bj) { f32x4 v0 = acc[ai][bj][m][0] + bv[bj][0], v1 = acc[ai][bj][m][1] + bv[bj][1];
                    if (ACT == 1) { f32x2 a = gelu_pk((f32x2){v0[0], v0[1]}), b = gelu_pk((f32x2){v0[2], v0[3]}), c = gelu_pk((f32x2){v1[0], v1[1]}), d = gelu_pk((f32x2){v1[2], v1[3]});
                        v0 = (f32x4){a.x, a.y, b.x, b.y}; v1 = (f32x4){c.x, c.y, d.x, d.y}; }
                    v0 = v0 * sc; v1 = v1 * sc; u32x4 w; w.x = cvt_pk_bf16(v0[0], v0[1]); w.y = cvt_pk_bf16(v0[2], v0[3]); w.z = cvt_pk_bf16(v1[0], v1[1]); w.w = cvt_pk_bf16(v1[2], v1[3]);
                    *(u32x4*)(rowp + bj * HALF) = w; } }
    }
};
struct EpiHeadMajor {
    static constexpr bool PERM = true, AFTER_DRAIN = false;
    bf16_t* O; int Mrows; const float* rowsq; float inv_k, eps;
    __device__ __forceinline__ void operator()(const f32x4 (&acc)[2][2][4][2], const Unit& u, int wr, int wc, int fr, int fq) const {
        const int row0 = u.pm * BM + wr * 64 + fr, col0 = wc * 32 + 8 * fq;
#pragma unroll
        for (int ai = 0; ai < 2; ++ai) {
            f32x4 pa[4], pb[4];
#pragma unroll
            for (int m = 0; m < 4; ++m) { const f32x4* pp = (const f32x4*)(rowsq + (size_t)(row0 + ai * HALF + m * 16) * 32 + 8 * fq); pa[m] = pp[0]; pb[m] = pp[1]; }
#pragma unroll
            for (int m = 0; m < 4; ++m) { const int row = row0 + ai * HALF + m * 16; const f32x4 a = pa[m], b = pb[m];
                float sq = ((a[0] + a[1]) + (a[2] + a[3])) + ((b[0] + b[1]) + (b[2] + b[3])); sq += __shfl_xor(sq, 16); sq += __shfl_xor(sq, 32);
                const float rs = 1.0f / sqrtf(sq * inv_k + eps);
#pragma unroll
                for (int bj = 0; bj < 2; ++bj) { const f32x4 v0 = acc[ai][bj][m][0] * rs, v1 = acc[ai][bj][m][1] * rs;
                    u32x4 w; w.x = cvt_pk_bf16(v0[0], v0[1]); w.y = cvt_pk_bf16(v0[2], v0[3]); w.z = cvt_pk_bf16(v1[0], v1[1]); w.w = cvt_pk_bf16(v1[2], v1[3]);
                    *(u32x4*)(O + ((size_t)(u.pn * 2 + bj) * Mrows + row) * HALF + col0) = w; } }
            asm volatile("" ::: "memory"); }
    }
};
struct EpiResF32 {
    static constexpr bool PERM = true, AFTER_DRAIN = false;
    bf16_t* xb; float* rowsq; int ldc;
    __device__ __forceinline__ void operator()(const f32x4 (&acc)[2][2][4][2], const Unit& u, int wr, int wc, int fr, int fq) const {
        const int col0 = u.pn * BM + wc * 32 + 8 * fq;
#pragma unroll
        for (int ai = 0; ai < 2; ++ai) {
            u32x4 pre[4][2];
#pragma unroll
            for (int m = 0; m < 4; ++m) { const size_t off = (size_t)(u.pm * BM + ai * HALF + wr * 64 + m * 16 + fr) * ldc + col0;
#pragma unroll
                for (int bj = 0; bj < 2; ++bj) pre[m][bj] = *(const u32x4*)(xb + off + bj * HALF); }
            asm volatile("" ::: "memory");
#pragma unroll
            for (int m = 0; m < 4; ++m) { const int row = u.pm * BM + ai * HALF + wr * 64 + m * 16 + fr; const size_t off = (size_t)row * ldc + col0; float ss = 0.f;
#pragma unroll
                for (int bj = 0; bj < 2; ++bj) { const u32x4 pb = pre[m][bj]; const f32x4 a0 = acc[ai][bj][m][0], a1 = acc[ai][bj][m][1];
                    u32x4 w; w.x = cvt_pk_bf16(__uint_as_float(pb.x << 16) + a0[0], __uint_as_float(pb.x & 0xffff0000u) + a0[1]); w.y = cvt_pk_bf16(__uint_as_float(pb.y << 16) + a0[2], __uint_as_float(pb.y & 0xffff0000u) + a0[3]);
                    w.z = cvt_pk_bf16(__uint_as_float(pb.z << 16) + a1[0], __uint_as_float(pb.z & 0xffff0000u) + a1[1]); w.w = cvt_pk_bf16(__uint_as_float(pb.w << 16) + a1[2], __uint_as_float(pb.w & 0xffff0000u) + a1[3]);
#pragma unroll
                    for (int q = 0; q < 4; ++q) { const float r0 = __uint_as_float(w[q] << 16), r1 = __uint_as_float(w[q] & 0xffff0000u); ss += r0 * r0 + r1 * r1; }
                    *(u32x4*)(xb + off + bj * HALF) = w; }
                ss += __shfl_xor(ss, 16); ss += __shfl_xor(ss, 32);
                if (fq == 0) rowsq[(size_t)row * 32 + u.pn * 4 + wc] = ss; }
            asm volatile("" ::: "memory"); }
    }
};


template <class Epi, class Sched, bool ALIGN_EPI = false, bool SP2 = false>
__device__ __forceinline__ void gemm_phase(PG8_LAS unsigned char* lds, const Gemm g, const Sched& S, const Epi& E) {
    const int tid = otid(), wid = __builtin_amdgcn_readfirstlane(tid >> 6), lane = tid & 63, wr = wid >> 2, wc = wid & 3, fr = lane & 15, fq = lane >> 4;
    const int K = g.K, nt = K / BK;
    unsigned voffA[2], voffB[2];
#pragma unroll
    for (int i = 0; i < 2; ++i) { int R, C; stage_rc(tid * 16 + i * 8192, R, C); const int Rb = Epi::PERM ? ((R & ~31) + perm32(R & 31)) : R;
        voffA[i] = (unsigned)(R * K + C) * 2u; voffB[i] = (unsigned)(Rb * K + C) * 2u; }
    const size_t kstep = (size_t)(BK * 2);
    const size_t hstep = (size_t)HALF * K * 2;
    const size_t tstep = 2 * hstep;
    const unsigned ldsw = (unsigned)wid * 1024u;
    const int aoff = lds_byte(wr * 64 + fr, fq * 8), boff = lds_byte(wc * 32 + fr, fq * 8);
#define PG8_SA(b, h) (((b) * 2 + (h)) * HTB)
#define PG8_SB(b, h) ((4 + (b) * 2 + (h)) * HTB)
#define PG8_STAGE(bufoff, gbase, voff) do { _Pragma("unroll") for (int _i = 0; _i < 2; ++_i) \
        __builtin_amdgcn_global_load_lds((const unsigned*)((const char*)(gbase) + (voff)[_i]), (PG8_LAS unsigned*)(lds + (bufoff) + ldsw + _i * 8192), 16, 0, 0); } while (0)
#define PG8_LDA(dst, b, h) do { _Pragma("unroll") for (int m = 0; m < 4; ++m) _Pragma("unroll") for (int k = 0; k < 2; ++k) dst[m][k] = *(const PG8_LAS bf16x8*)(lds + PG8_SA(b, h) + aoff + m * 2048 + k * 1024); } while (0)
#define PG8_LDB(dst, b, h) do { _Pragma("unroll") for (int n = 0; n < 2; ++n) _Pragma("unroll") for (int k = 0; k < 2; ++k) dst[n][k] = *(const PG8_LAS bf16x8*)(lds + PG8_SB(b, h) + boff + n * 2048 + k * 1024); } while (0)
#define PG8_MMA(ai, bj, At, Bt) do { __builtin_amdgcn_s_setprio(1); _Pragma("unroll") for (int m = 0; m < 4; ++m) _Pragma("unroll") for (int n = 0; n < 2; ++n) _Pragma("unroll") for (int k = 0; k < 2; ++k) \
        acc[ai][bj][m][n] = __builtin_amdgcn_mfma_f32_16x16x32_bf16(Bt[n][k], At[m][k], acc[ai][bj][m][n], 0, 0, 0); __builtin_amdgcn_s_setprio(0); } while (0)
#define PG8_WAIT_V(n) asm volatile("s_waitcnt vmcnt(" #n ")" ::: "memory")
#define PG8_WAIT_L(n) asm volatile("s_waitcnt lgkmcnt(" #n ")" ::: "memory")
#define PG8_BAR __builtin_amdgcn_s_barrier()
#define PG8_SCHED __builtin_amdgcn_sched_barrier(0)
    Unit cur, nxt; int ui = 0;
    if (!S.next(0, cur)) return;
    f32x4 acc[2][2][4][2];
#pragma unroll
    for (int a = 0; a < 2; ++a)
#pragma unroll
        for (int b = 0; b < 2; ++b)
#pragma unroll
            for (int m = 0; m < 4; ++m)
#pragma unroll
                for (int n = 0; n < 2; ++n) acc[a][b][m][n] = (f32x4){0.f, 0.f, 0.f, 0.f};
    bf16x8 At[4][2], B0[2][2], B1[2][2];
    const char* cA = (const char*)g.A + (size_t)cur.pm * tstep; const char* cB = (const char*)g.Bt + (size_t)cur.pn * tstep;
    S.a_ready(cur);
    if constexpr (SP2) {
        PG8_STAGE(PG8_SB(0, 0), cB, voffB); PG8_STAGE(PG8_SB(0, 1), cB + hstep, voffB); PG8_STAGE(PG8_SA(0, 0), cA, voffA); PG8_STAGE(PG8_SA(0, 1), cA + hstep, voffA);
        if (wr == 1) PG8_BAR;
        PG8_WAIT_V(2); PG8_BAR;
        PG8_STAGE(PG8_SB(1, 0), cB + kstep, voffB); PG8_STAGE(PG8_SA(1, 0), cA + kstep, voffA); PG8_STAGE(PG8_SB(1, 1), cB + hstep + kstep, voffB);
        PG8_WAIT_V(6); PG8_BAR;
    } else {
        PG8_STAGE(PG8_SB(0, 0), cB, voffB); PG8_STAGE(PG8_SA(0, 0), cA, voffA); PG8_STAGE(PG8_SB(0, 1), cB + hstep, voffB); PG8_STAGE(PG8_SA(0, 1), cA + hstep, voffA);
        if (wr == 1) PG8_BAR;
        PG8_WAIT_V(4); PG8_BAR;
        PG8_STAGE(PG8_SB(1, 0), cB + kstep, voffB); PG8_STAGE(PG8_SA(1, 0), cA + kstep, voffA); PG8_STAGE(PG8_SB(1, 1), cB + hstep + kstep, voffB);
        PG8_WAIT_V(6); PG8_BAR;
    }
    for (;;) {
        const bool has_next = S.next(ui + 1, nxt);
        const char* nA = has_next ? (const char*)g.A + (size_t)nxt.pm * tstep : cA; const char* nB = has_next ? (const char*)g.Bt + (size_t)nxt.pn * tstep : cB;
        for (int t = 0; t < nt; t += 2) {
            const bool last = (t == nt - 2);
            const char* a1 = cA + (size_t)(t + 1) * kstep;
            const char* a2 = last ? nA : cA + (size_t)(t + 2) * kstep; const char* b2 = last ? nB : cB + (size_t)(t + 2) * kstep;
            const char* a3 = a2 + kstep; const char* b3 = b2 + kstep;
            if (last && has_next) S.a_ready(nxt);
            if constexpr (SP2) {
            PG8_LDB(B0, 0, 0); PG8_LDB(B1, 0, 1); PG8_SCHED; PG8_LDA(At, 0, 0); PG8_STAGE(PG8_SA(1, 1), a1 + hstep, voffA);
            PG8_WAIT_V(8); PG8_WAIT_L(0); PG8_BAR; PG8_MMA(0, 0, At, B0); PG8_MMA(0, 1, At, B1); PG8_BAR; PG8_SCHED;
            PG8_LDA(At, 0, 1); PG8_STAGE(PG8_SB(0, 0), b2, voffB); PG8_STAGE(PG8_SB(0, 1), b2 + hstep, voffB); PG8_STAGE(PG8_SA(0, 0), a2, voffA);
            PG8_WAIT_V(8); PG8_WAIT_L(0); PG8_BAR; PG8_MMA(1, 0, At, B0); PG8_MMA(1, 1, At, B1); PG8_BAR; PG8_SCHED;
            PG8_LDB(B0, 1, 0); PG8_LDB(B1, 1, 1); PG8_SCHED; PG8_LDA(At, 1, 0); PG8_STAGE(PG8_SA(0, 1), a2 + hstep, voffA);
            PG8_WAIT_V(8); PG8_WAIT_L(0); PG8_BAR; PG8_MMA(0, 0, At, B0); PG8_MMA(0, 1, At, B1); PG8_BAR; PG8_SCHED;
            PG8_LDA(At, 1, 1); PG8_STAGE(PG8_SB(1, 0), b3, voffB); PG8_STAGE(PG8_SB(1, 1), b3 + hstep, voffB); PG8_STAGE(PG8_SA(1, 0), a3, voffA);
            PG8_WAIT_V(8); PG8_WAIT_L(0); PG8_BAR; PG8_MMA(1, 0, At, B0); PG8_MMA(1, 1, At, B1); PG8_BAR; PG8_SCHED;
            } else {
            PG8_LDB(B0, 0, 0); PG8_SCHED; PG8_LDA(At, 0, 0); PG8_STAGE(PG8_SA(1, 1), a1 + hstep, voffA);
            PG8_WAIT_L(8); PG8_BAR; PG8_WAIT_L(0); PG8_MMA(0, 0, At, B0); PG8_BAR; PG8_SCHED;
            PG8_LDB(B1, 0, 1); PG8_STAGE(PG8_SB(0, 0), b2, voffB);
            PG8_BAR; PG8_WAIT_L(0); PG8_MMA(0, 1, At, B1); PG8_BAR;
            PG8_LDA(At, 0, 1); PG8_STAGE(PG8_SA(0, 0), a2, voffA);
            PG8_BAR; PG8_WAIT_L(0); PG8_MMA(1, 0, At, B0); PG8_BAR; PG8_SCHED;
            PG8_STAGE(PG8_SB(0, 1), b2 + hstep, voffB);
            PG8_WAIT_V(6); PG8_BAR; PG8_MMA(1, 1, At, B1); PG8_BAR;
            PG8_LDB(B0, 1, 0); PG8_SCHED; PG8_LDA(At, 1, 0); PG8_STAGE(PG8_SA(0, 1), a2 + hstep, voffA);
            PG8_WAIT_L(8); PG8_BAR; PG8_WAIT_L(0); PG8_MMA(0, 0, At, B0); PG8_BAR; PG8_SCHED;
            PG8_LDB(B1, 1, 1); PG8_STAGE(PG8_SB(1, 0), b3, voffB);
            PG8_BAR; PG8_WAIT_L(0); PG8_MMA(0, 1, At, B1); PG8_BAR;
            PG8_LDA(At, 1, 1); PG8_STAGE(PG8_SA(1, 0), a3, voffA);
            PG8_BAR; PG8_WAIT_L(0); PG8_MMA(1, 0, At, B0); PG8_BAR; PG8_SCHED;
            PG8_STAGE(PG8_SB(1, 1), b3 + hstep, voffB);
            PG8_WAIT_V(6); PG8_BAR; PG8_MMA(1, 1, At, B1); PG8_BAR;
            }
        }
        if constexpr (ALIGN_EPI) { if (wr == 0) PG8_BAR; }
        if constexpr (!Epi::AFTER_DRAIN) { E(acc, cur, wr, wc, fr, fq); S.done(cur); }
        if (!has_next) break;
#pragma unroll
        for (int a = 0; a < 2; ++a)
#pragma unroll
            for (int b = 0; b < 2; ++b)
#pragma unroll
                for (int m = 0; m < 4; ++m)
#pragma unroll
                    for (int n = 0; n < 2; ++n) acc[a][b][m][n] = (f32x4){0.f, 0.f, 0.f, 0.f};
        cur = nxt; cA = nA; cB = nB; ++ui;
        if constexpr (ALIGN_EPI) { if (wr == 1) PG8_BAR; }
    }
    PG8_WAIT_V(0);
    if constexpr (!ALIGN_EPI) { if (wr == 0) PG8_BAR; }
    PG8_BAR;
    if constexpr (Epi::AFTER_DRAIN) { E.fused(acc, cur, wr, wc, fr, fq, lds, wid, lane); S.done(cur); }
#undef PG8_SA
#undef PG8_SB
#undef PG8_STAGE
#undef PG8_LDA
#undef PG8_LDB
#undef PG8_MMA
#undef PG8_WAIT_V
#undef PG8_WAIT_L
#undef PG8_BAR
#undef PG8_SCHED
}
}
#define PG8_SP2 true
#define PG8_ALIGN true
namespace att {
using bf16 = __hip_bfloat16;
constexpr int D = 128, NW = 8, QBLK = 32, KVBLK = 64;
constexpr float SCALE = 0.088388347648318440f;
constexpr float THR = 8.f;
constexpr size_t SHM_V = KVBLK * D * 2, SHM_K = KVBLK * D * 2, SHM_ATTN = 2 * SHM_V + 2 * SHM_K + NW * 64 * 4;
using bf16x8 = __attribute__((ext_vector_type(8))) short;
using s16x4  = __attribute__((ext_vector_type(4))) short;
using f32x16 = __attribute__((ext_vector_type(16))) float;
using f32x8  = __attribute__((ext_vector_type(8))) float;
using u32x4  = __attribute__((ext_vector_type(4))) unsigned;
#define KSWZ(row, colB) ((row) * 256 + ((colB) ^ (((row) & 7) << 4)))
#define SBAR() __builtin_amdgcn_sched_barrier(0)
__device__ __forceinline__ int crow(int r, int hi) { return (r & 3) + 8 * (r >> 2) + 4 * hi; }
__device__ __forceinline__ unsigned cvtpk(float lo, float hi) {
  unsigned r; asm("v_cvt_pk_bf16_f32 %0, %1, %2" : "=v"(r) : "v"(lo), "v"(hi)); return r;
}
template <typename TIn> struct Stage;
template <> struct Stage<bf16>  { using T = bf16x8;
  __device__ static __forceinline__ T ld8(const bf16* p) { return *reinterpret_cast<const bf16x8*>(p); }
  __device__ static __forceinline__ bf16x8 tobf(T x) { return x; } };
template <> struct Stage<float> { using T = f32x8;
  __device__ static __forceinline__ T ld8(const float* p) { return *reinterpret_cast<const f32x8*>(p); }
  __device__ static __forceinline__ bf16x8 tobf(T x) {
    u32x4 w = {cvtpk(x[0], x[1]), cvtpk(x[2], x[3]), cvtpk(x[4], x[5]), cvtpk(x[6], x[7])}; return *reinterpret_cast<bf16x8*>(&w); } };

__device__ __forceinline__ void partialSM(f32x16& p0, f32x16& p1, float& m_reg, float& mn, float& alpha) {
  constexpr float C = SCALE * 1.4426950408889634f;
  float pmax = p0[0]; for (int r = 1; r < 16; ++r) pmax = fmaxf(pmax, p0[r]); for (int r = 0; r < 16; ++r) pmax = fmaxf(pmax, p1[r]);
  { auto rr = __builtin_amdgcn_permlane32_swap(__float_as_uint(pmax), __float_as_uint(pmax), false, false);
    pmax = fmaxf(__uint_as_float(rr[0]), __uint_as_float(rr[1])); }
  if (__builtin_expect(__all(pmax - m_reg <= THR / SCALE), 1)) { mn = m_reg; alpha = 1.f; }
  else { mn = fmaxf(m_reg, pmax); alpha = __builtin_amdgcn_exp2f((m_reg - mn) * C); m_reg = mn; }
  float mnC = -mn * C;
  for (int r = 0; r < 16; ++r) p0[r] = fmaf(p0[r], C, mnC); for (int r = 0; r < 16; ++r) p1[r] = fmaf(p1[r], C, mnC);
  for (int r = 0; r < 16; ++r) p0[r] = __builtin_amdgcn_exp2f(p0[r]);
}
__device__ __forceinline__ void finishSM(f32x16& p0, f32x16& p1, float alpha, float& l_reg, bf16x8& pa0, bf16x8& pa1, bf16x8& pa2, bf16x8& pa3) {
  for (int r = 0; r < 16; ++r) p1[r] = __builtin_amdgcn_exp2f(p1[r]);
  float ps = 0; for (int r = 0; r < 16; ++r) ps += p0[r]; for (int r = 0; r < 16; ++r) ps += p1[r];
  { auto rr = __builtin_amdgcn_permlane32_swap(__float_as_uint(ps), __float_as_uint(ps), false, false);
    ps = __uint_as_float(rr[0]) + __uint_as_float(rr[1]); }
  l_reg = l_reg * alpha + ps;
#define PK4(P, BASE, OUT) do { unsigned a0 = cvtpk(P[BASE + 0], P[BASE + 1]), a1 = cvtpk(P[BASE + 2], P[BASE + 3]);   \
    unsigned b0 = cvtpk(P[BASE + 4], P[BASE + 5]), b1 = cvtpk(P[BASE + 6], P[BASE + 7]);                              \
    u32x4 w = {a0, a1, b0, b1}; OUT = *reinterpret_cast<bf16x8*>(&w); } while (0)
  PK4(p0, 0, pa0); PK4(p0, 8, pa1); PK4(p1, 0, pa2); PK4(p1, 8, pa3);
#undef PK4
}
__device__ __forceinline__ void qkt(f32x16& p0, f32x16& p1, const bf16* Ks, const bf16x8* qr, int r32, int hi) {
  p0 = f32x16{}; p1 = f32x16{};
  for (int d0 = 0; d0 < 8; ++d0) { int cb = (d0 * 16 + hi * 8) * 2;
    bf16x8 b0 = *reinterpret_cast<const bf16x8*>((const char*)Ks + KSWZ(r32, cb));
    bf16x8 b1 = *reinterpret_cast<const bf16x8*>((const char*)Ks + KSWZ(32 + r32, cb));
    p0 = __builtin_amdgcn_mfma_f32_32x32x16_bf16(b0, qr[d0], p0, 0, 0, 0);
    p1 = __builtin_amdgcn_mfma_f32_32x32x16_bf16(b1, qr[d0], p1, 0, 0, 0); }
}
__device__ __forceinline__ int v_st(int k, int c) { const int kk = (k & ~0xC) | ((k & 4) << 1) | ((k & 8) >> 1); return ((kk >> 3) * 4 + (c >> 5)) * 512 + ((kk & 7) * 32 + (c & 31)) * 2; }
__device__ __forceinline__ int v_rd_base(int lane) { return ((lane & 3) << 3) | (((lane >> 2) & 3) << 6) | (((lane >> 4) & 1) << 5) | (((lane >> 5) & 1) << 8); }
constexpr int v_rd_off(int d0, int ks, int half) { return d0 * 512 + ks * 4096 + half * 2048; }
template <int OFF> __device__ __forceinline__ s16x4 tr_read(int vb) {
  s16x4 r; asm volatile("ds_read_b64_tr_b16 %0, %1 offset:%2" : "=&v"(r) : "v"(vb), "i"(OFF) : "memory"); return r;
}
template <int D0> __device__ __forceinline__ void pv_one(f32x16& od, int vb, bf16x8 pa0, bf16x8 pa1, bf16x8 pa2, bf16x8 pa3) {
  const s16x4 l0 = tr_read<v_rd_off(D0, 0, 0)>(vb), h0 = tr_read<v_rd_off(D0, 0, 1)>(vb), l1 = tr_read<v_rd_off(D0, 1, 0)>(vb), h1 = tr_read<v_rd_off(D0, 1, 1)>(vb);
  const s16x4 l2 = tr_read<v_rd_off(D0, 2, 0)>(vb), h2 = tr_read<v_rd_off(D0, 2, 1)>(vb), l3 = tr_read<v_rd_off(D0, 3, 0)>(vb), h3 = tr_read<v_rd_off(D0, 3, 1)>(vb);
  asm volatile("s_waitcnt lgkmcnt(0)" ::: "memory"); SBAR();
#define PK(L, H) (bf16x8){L[0], L[1], L[2], L[3], H[0], H[1], H[2], H[3]}
  od = __builtin_amdgcn_mfma_f32_32x32x16_bf16(pa0, PK(l0, h0), od, 0, 0, 0);
  od = __builtin_amdgcn_mfma_f32_32x32x16_bf16(pa1, PK(l1, h1), od, 0, 0, 0);
  od = __builtin_amdgcn_mfma_f32_32x32x16_bf16(pa2, PK(l2, h2), od, 0, 0, 0);
  od = __builtin_amdgcn_mfma_f32_32x32x16_bf16(pa3, PK(l3, h3), od, 0, 0, 0);
#undef PK
}
struct VFrag { s16x4 l0, h0, l1, h1, l2, h2, l3, h3; };
template <int D0> __device__ __forceinline__ void pv_rd(VFrag& f, int vb) {
  f.l0 = tr_read<v_rd_off(D0, 0, 0)>(vb); f.h0 = tr_read<v_rd_off(D0, 0, 1)>(vb); f.l1 = tr_read<v_rd_off(D0, 1, 0)>(vb); f.h1 = tr_read<v_rd_off(D0, 1, 1)>(vb);
  f.l2 = tr_read<v_rd_off(D0, 2, 0)>(vb); f.h2 = tr_read<v_rd_off(D0, 2, 1)>(vb); f.l3 = tr_read<v_rd_off(D0, 3, 0)>(vb); f.h3 = tr_read<v_rd_off(D0, 3, 1)>(vb);
}
__device__ __forceinline__ void pv_mm(f32x16& od, const VFrag& f, bf16x8 pa0, bf16x8 pa1, bf16x8 pa2, bf16x8 pa3) {
#define PK(L, H) (bf16x8){L[0], L[1], L[2], L[3], H[0], H[1], H[2], H[3]}
  od = __builtin_amdgcn_mfma_f32_32x32x16_bf16(pa0, PK(f.l0, f.h0), od, 0, 0, 0);
  od = __builtin_amdgcn_mfma_f32_32x32x16_bf16(pa1, PK(f.l1, f.h1), od, 0, 0, 0);
  od = __builtin_amdgcn_mfma_f32_32x32x16_bf16(pa2, PK(f.l2, f.h2), od, 0, 0, 0);
  od = __builtin_amdgcn_mfma_f32_32x32x16_bf16(pa3, PK(f.l3, f.h3), od, 0, 0, 0);
#undef PK
}
#define PV_WAIT(n) do { asm volatile("s_waitcnt lgkmcnt(" #n ")" ::: "memory"); SBAR(); } while (0)
__device__ __forceinline__ void pv_d0(f32x16* o, int vb, bf16x8 pa0, bf16x8 pa1, bf16x8 pa2, bf16x8 pa3) {
#if MK_PVPIPE
  VFrag fa, fb;
  pv_rd<0>(fa, vb); pv_rd<1>(fb, vb);
  PV_WAIT(8); pv_mm(o[0], fa, pa0, pa1, pa2, pa3); SBAR();
  pv_rd<2>(fa, vb);
  PV_WAIT(8); pv_mm(o[1], fb, pa0, pa1, pa2, pa3); SBAR();
  pv_rd<3>(fb, vb);
  PV_WAIT(8); pv_mm(o[2], fa, pa0, pa1, pa2, pa3); SBAR();
  PV_WAIT(0); pv_mm(o[3], fb, pa0, pa1, pa2, pa3);
#else
  pv_one<0>(o[0], vb, pa0, pa1, pa2, pa3); pv_one<1>(o[1], vb, pa0, pa1, pa2, pa3); pv_one<2>(o[2], vb, pa0, pa1, pa2, pa3); pv_one<3>(o[3], vb, pa0, pa1, pa2, pa3);
#endif
}
constexpr int crow0(int r) { return (r & 3) + 8 * (r >> 2); }
constexpr float LOG2E = 1.4426950408889634f;
__device__ __forceinline__ void partialSM_neg(f32x16& p0, f32x16& p1, float& m_reg, f32x16& negm, float& alpha, int bounded) {
  if (bounded) {
    alpha = 1.f;
#pragma unroll
    for (int r = 0; r < 16; ++r) p0[r] = __builtin_amdgcn_exp2f(p0[r]);
    return;
  }
  float pmax = p0[0];
#pragma unroll
  for (int r = 1; r < 16; ++r) pmax = fmaxf(pmax, p0[r]);
#pragma unroll
  for (int r = 0; r < 16; ++r) pmax = fmaxf(pmax, p1[r]);
  { auto rr = __builtin_amdgcn_permlane32_swap(__float_as_uint(pmax), __float_as_uint(pmax), false, false);
    pmax = fmaxf(__uint_as_float(rr[0]), __uint_as_float(rr[1])); }
  if (__builtin_expect(__all(pmax <= THR), 1)) { alpha = 1.f; }
  else { const float dl = fmaxf(pmax, 0.f); m_reg += dl; alpha = __builtin_amdgcn_exp2f(-dl);
#pragma unroll
    for (int r = 0; r < 16; ++r) { p0[r] -= dl; p1[r] -= dl; negm[r] = -m_reg; } }
#pragma unroll
  for (int r = 0; r < 16; ++r) p0[r] = __builtin_amdgcn_exp2f(p0[r]);
}
__device__ __forceinline__ void partialSM_dil(f32x16& p0, f32x16& p1, float& m_reg, float& mn, float& alpha, float dq, float dlo, float dhi, float nslopeC) {
  constexpr float C = SCALE * LOG2E;
#pragma unroll
  for (int r = 0; r < 16; ++r) {
    const float d0 = dq + (float)crow0(r), d1 = d0 + 32.f;
    const float t0 = fmaf(p0[r], C, nslopeC * fabsf(d0)), t1 = fmaf(p1[r], C, nslopeC * fabsf(d1));
    p0[r] = (d0 >= dlo && d0 <= dhi) ? t0 : -1e30f;
    p1[r] = (d1 >= dlo && d1 <= dhi) ? t1 : -1e30f;
  }
  float pmax = p0[0];
#pragma unroll
  for (int r = 1; r < 16; ++r) pmax = fmaxf(pmax, p0[r]);
#pragma unroll
  for (int r = 0; r < 16; ++r) pmax = fmaxf(pmax, p1[r]);
  { auto rr = __builtin_amdgcn_permlane32_swap(__float_as_uint(pmax), __float_as_uint(pmax), false, false);
    pmax = fmaxf(__uint_as_float(rr[0]), __uint_as_float(rr[1])); }
  if (__builtin_expect(__all(pmax - m_reg <= THR * LOG2E), 1)) { mn = m_reg; alpha = 1.f; }
  else { mn = fmaxf(m_reg, pmax); alpha = __builtin_amdgcn_exp2f(m_reg - mn); m_reg = mn; }
#pragma unroll
  for (int r = 0; r < 16; ++r) { p0[r] = p0[r] - mn; p1[r] = p1[r] - mn; }
#pragma unroll
  for (int r = 0; r < 16; ++r) p0[r] = __builtin_amdgcn_exp2f(p0[r]);
}

template <bool DIL>
__device__ __forceinline__ void attn_body(const bf16* __restrict__ Qb, const bf16* __restrict__ Kh, const bf16* __restrict__ Vh, long qs, long ks,
                                          bf16* __restrict__ Ob, long os, float* __restrict__ lse_o, int lse_s, int i0, int nsub, float nslopeC, int seq, char* lds) {
  typedef __attribute__((address_space(3))) unsigned lds_u32;
  using St = Stage<bf16>;
  const int tid = otid(), wid = __builtin_amdgcn_readfirstlane(tid >> 6), lane = tid & 63, r32 = lane & 31, hi = lane >> 5;
  char* V_lds = lds + 4 * SHM_K; char* K_lds = lds;
  float* ws = (float*)(lds + 4 * SHM_K + 4 * SHM_V) + wid * 64; float* li_l = ws; float* al_l = ws + 32;
  float m_reg = -1e30f, l_reg = 0; f32x16 o[4] = {}; bf16x8 qr[8];
  const bf16* Qw = Qb + (long)(wid * QBLK + r32) * qs + hi * 8;
#pragma unroll
  for (int d0 = 0; d0 < 8; ++d0) qr[d0] = St::ld8(Qw + d0 * 16);
  const int vb0 = (int)(uintptr_t)V_lds + v_rd_base(lane);
  const int kb = DIL ? i0 - 64 : 0;
#define KROW(k) (DIL ? (long)min(max(kb + (k), 0), nsub - 1) : (long)(k))
  int krow[2], kcol[2], vrow[2], vcol[2];
#pragma unroll
  for (int i = 0; i < 2; ++i) { const int pc = 2 * wid + i;
    krow[i] = pc * 4 + (lane >> 4); kcol[i] = (((lane & 15) ^ (krow[i] & 7)) << 3);
    const int sub = pc * 2 + (lane >> 5), kk = ((sub >> 2) << 3) + ((lane & 31) >> 2);
    vrow[i] = kk; vcol[i] = ((sub & 3) << 5) + ((lane & 3) << 3); }
  unsigned kdo[2], vdo[2];
#pragma unroll
  for (int i = 0; i < 2; ++i) { kdo[i] = (unsigned)(krow[i] * (int)ks + kcol[i]); vdo[i] = (unsigned)(vrow[i] * (int)ks + vcol[i]); }
#define DMA(t, buf) do { if constexpr (DIL) { _Pragma("unroll") for (int i_ = 0; i_ < 2; ++i_) { \
      __builtin_amdgcn_global_load_lds((const unsigned*)(Kh + KROW((t) * KVBLK + krow[i_]) * ks + kcol[i_]), (lds_u32*)(K_lds + (buf) * SHM_K + (2 * wid + i_) * 1024), 16, 0, 0); \
      __builtin_amdgcn_global_load_lds((const unsigned*)(Vh + KROW((t) * KVBLK + vrow[i_]) * ks + vcol[i_]), (lds_u32*)(V_lds + (buf) * SHM_V + (2 * wid + i_) * 1024), 16, 0, 0); } } \
    else { const bf16* Kt_ = Kh + (long)(t) * (KVBLK * ks); const bf16* Vt_ = Vh + (long)(t) * (KVBLK * ks); _Pragma("unroll") for (int i_ = 0; i_ < 2; ++i_) { \
      __builtin_amdgcn_global_load_lds((const unsigned*)(Kt_ + kdo[i_]), (lds_u32*)(K_lds + (buf) * SHM_K + (2 * wid + i_) * 1024), 16, 0, 0); \
      __builtin_amdgcn_global_load_lds((const unsigned*)(Vt_ + vdo[i_]), (lds_u32*)(V_lds + (buf) * SHM_V + (2 * wid + i_) * 1024), 16, 0, 0); } } } while (0)
#define ENDSTEP(j) do { if ((j) + 2 < NT) asm volatile("s_waitcnt vmcnt(4) lgkmcnt(0)\n\ts_barrier" ::: "memory"); else asm volatile("s_waitcnt vmcnt(0) lgkmcnt(0)\n\ts_barrier" ::: "memory"); } while (0)
#define RESC(a) do { if (__any((a) < 1.f)) { if (hi == 0) al_l[r32] = (a); asm volatile("s_waitcnt lgkmcnt(0)" ::: "memory"); \
    for (int d = 0; d < 4; ++d) for (int r = 0; r < 16; ++r) o[d][r] *= al_l[crow(r, hi)]; } } while (0)
#define PSM(P0, P1, MN, AL, jt) do { if constexpr (DIL) { const int t_ = otid(), iq_ = (t_ >> 6) * QBLK + (t_ & 31), hi_ = (t_ >> 5) & 1; \
      partialSM_dil(P0, P1, m_reg, MN, AL, (float)(-64 - iq_ + 4 * hi_ + 64 * (jt)), fmaxf(-64.f, (float)(-(i0 + iq_))), fminf(64.f, (float)(nsub - 1 - (i0 + iq_))), nslopeC); } \
    else partialSM(P0, P1, m_reg, MN, AL); } while (0)
#if MK_SGB
#define SGB_A() do { __builtin_amdgcn_sched_group_barrier(0x100, 4, 0); \
    _Pragma("unroll") for (int g_ = 0; g_ < 12; ++g_) { __builtin_amdgcn_sched_group_barrier(0x008, 1, 0); __builtin_amdgcn_sched_group_barrier(0x100, 1, 0); __builtin_amdgcn_sched_group_barrier(0x002, 6, 0); } \
    _Pragma("unroll") for (int g_ = 0; g_ < 4; ++g_) { __builtin_amdgcn_sched_group_barrier(0x008, 1, 0); __builtin_amdgcn_sched_group_barrier(0x002, 6, 0); } } while (0)
#else
#define SGB_A() do {} while (0)
#endif
#define KBUF(j) ((const bf16*)(K_lds + ((j) & 3) * SHM_K))
#define VBUF(j) (vb0 + ((j) & 3) * (int)SHM_V)
  f32x16 pA0, pA1, pB0, pB1; float mnA, mnB, alA, alB; bf16x8 pa0, pa1, pa2, pa3; const int NT = DIL ? 6 : seq / KVBLK;
  DMA(0, 0); DMA(1, 1);
  if constexpr (!DIL && MK_PP) { DMA(2, 2); asm volatile("s_waitcnt vmcnt(8)\n\ts_barrier" ::: "memory"); }
  else asm volatile("s_waitcnt vmcnt(4)\n\ts_barrier" ::: "memory");
  struct KFrag { bf16x8 a, b; };
  int koff[4];
#pragma unroll
  for (int d0 = 0; d0 < 4; ++d0) koff[d0] = KSWZ(r32, (d0 * 16 + hi * 8) * 2);
  const int kbase0 = (int)(uintptr_t)K_lds;
#define KRD(f, d0, kb) asm volatile("ds_read_b128 %0, %2 offset:%3\n\tds_read_b128 %1, %2 offset:%4" : "=&v"(f.a), "=&v"(f.b) : "v"((kb) + koff[(d0) & 3]), "i"(((d0) >> 2) * 128), "i"(((d0) >> 2) * 128 + 8192) : "memory")
#define QMM(f, d0) do { pA0 = __builtin_amdgcn_mfma_f32_32x32x16_bf16(f.a, qr[d0], pA0, 0, 0, 0); pA1 = __builtin_amdgcn_mfma_f32_32x32x16_bf16(f.b, qr[d0], pA1, 0, 0, 0); } while (0)
#define LW(n) do { asm volatile("s_waitcnt lgkmcnt(" #n ")" ::: "memory"); SBAR(); } while (0)
  if constexpr (DIL) {
    const int rlo = wid >> 1;
    for (int j = 0; j < NT; ++j) {
      if (j + 2 < NT) DMA(j + 2, (j + 2) & 3);
      if (j >= rlo && j <= rlo + 2) {
        SBAR();
        { const int kb_ = kbase0 + (j & 3) * (int)SHM_K; KFrag k0_, k1_, k2_;
          KRD(k0_, 0, kb_); KRD(k1_, 1, kb_); KRD(k2_, 2, kb_); pA0 = f32x16{}; pA1 = f32x16{};
          LW(4); QMM(k0_, 0); SBAR(); KRD(k0_, 3, kb_);
          LW(4); QMM(k1_, 1); SBAR(); KRD(k1_, 4, kb_);
          LW(4); QMM(k2_, 2); SBAR(); KRD(k2_, 5, kb_);
          LW(4); QMM(k0_, 3); SBAR(); KRD(k0_, 6, kb_);
          LW(4); QMM(k1_, 4); SBAR(); KRD(k1_, 7, kb_);
          LW(4); QMM(k2_, 5); SBAR();
          LW(2); QMM(k0_, 6); SBAR();
          LW(0); QMM(k1_, 7); SBAR(); }
        PSM(pA0, pA1, mnA, alA, j); RESC(alA);
        finishSM(pA0, pA1, alA, l_reg, pa0, pa1, pa2, pa3); SBAR();
        pv_d0(o, VBUF(j), pa0, pa1, pa2, pa3);
      }
      if (j + 1 < NT) ENDSTEP(j);
    }
  } else if constexpr (MK_PP) {
    const bool grpB = wid >= 4;
#if MK_NEGM
    m_reg = 0.f; f32x16 negm = f32x16{};
#endif
#define PP_BAR(VM) do { if (VM) { asm volatile("s_waitcnt vmcnt(4) lgkmcnt(0)\n\ts_barrier" ::: "memory"); } else { asm volatile("s_waitcnt vmcnt(0) lgkmcnt(0)\n\ts_barrier" ::: "memory"); } } while (0)
#define PP_BAR_PLAIN() asm volatile("s_waitcnt lgkmcnt(0)\n\ts_barrier" ::: "memory")
    if (grpB) PP_BAR_PLAIN();
    qkt(pA0, pA1, KBUF(0), qr, r32, hi);
    if (grpB) PP_BAR(2 < NT); else PP_BAR_PLAIN();
    for (int t = 0; t < NT; ++t) {
      if (grpB && t + 3 < NT) DMA(t + 3, (t + 3) & 3);
#if MK_NEGM
      partialSM_neg(pA0, pA1, m_reg, negm, alA, i0); if (!i0) RESC(alA);
#else
      PSM(pA0, pA1, mnA, alA, t); RESC(alA);
#endif
      finishSM(pA0, pA1, alA, l_reg, pa0, pa1, pa2, pa3);
#if MK_PROBE_V
      { float dm_ = alA;
#pragma unroll
        for (int q_ = 0; q_ < 32; ++q_) asm volatile("v_add_f32 %0, %0, %0" : "+v"(dm_));
        if (dm_ == 123.456f) l_reg += 1.f; }
#endif
      if (!(MK_PREB && t + 1 < NT)) { if (!grpB) PP_BAR(t + 2 < NT); else PP_BAR_PLAIN(); }
      else if (!grpB) PP_BAR(t + 2 < NT);
      if (!grpB && t + 3 < NT) DMA(t + 3, (t + 3) & 3);
      SBAR();
      if (t + 1 < NT) {
        const int kb_ = kbase0 + ((t + 1) & 3) * (int)SHM_K, vb_ = VBUF(t);
        KFrag k0_, k1_; VFrag fa_, fb_;
        KRD(k0_, 0, kb_); KRD(k1_, 1, kb_); pv_rd<0>(fa_, vb_);
        if (MK_PREB && grpB) asm volatile("s_barrier" ::: "memory");
#if MK_NEGM
        LW(10); pA0 = __builtin_amdgcn_mfma_f32_32x32x16_bf16(k0_.a, qr[0], negm, 0, 0, 0); pA1 = __builtin_amdgcn_mfma_f32_32x32x16_bf16(k0_.b, qr[0], negm, 0, 0, 0); SBAR(); KRD(k0_, 2, kb_);
#else
        pA0 = f32x16{}; pA1 = f32x16{};
        LW(10); QMM(k0_, 0); SBAR(); KRD(k0_, 2, kb_);
#endif
        LW(10); QMM(k1_, 1); SBAR(); KRD(k1_, 3, kb_);
        LW(4);  pv_mm(o[0], fa_, pa0, pa1, pa2, pa3); SBAR(); pv_rd<1>(fb_, vb_);
        LW(10); QMM(k0_, 2); SBAR(); KRD(k0_, 4, kb_);
        LW(10); QMM(k1_, 3); SBAR(); KRD(k1_, 5, kb_);
        LW(4);  pv_mm(o[1], fb_, pa0, pa1, pa2, pa3); SBAR(); pv_rd<2>(fa_, vb_);
        LW(10); QMM(k0_, 4); SBAR(); KRD(k0_, 6, kb_);
        LW(10); QMM(k1_, 5); SBAR(); KRD(k1_, 7, kb_);
        LW(4);  pv_mm(o[2], fa_, pa0, pa1, pa2, pa3); SBAR(); pv_rd<3>(fb_, vb_);
        LW(10); QMM(k0_, 6); SBAR();
        LW(8);  QMM(k1_, 7); SBAR();
        LW(0);  pv_mm(o[3], fb_, pa0, pa1, pa2, pa3);
      } else pv_d0(o, VBUF(t), pa0, pa1, pa2, pa3);
      if (t + 1 < NT) { if (grpB) PP_BAR(t + 3 < NT); else PP_BAR_PLAIN(); }
    }
    if (!grpB) PP_BAR_PLAIN();
#undef PP_BAR
#undef PP_BAR_PLAIN
#undef KRD
#undef QMM
#undef LW
  } else {
  if (2 < NT) DMA(2, 2);
  qkt(pA0, pA1, KBUF(0), qr, r32, hi); PSM(pA0, pA1, mnA, alA, 0);
  ENDSTEP(0);
  for (int j = 1; j + 1 < NT; j += 2) {
    if (j + 2 < NT) DMA(j + 2, (j + 2) & 3);
    SBAR(); qkt(pB0, pB1, KBUF(j), qr, r32, hi);
    finishSM(pA0, pA1, alA, l_reg, pa0, pa1, pa2, pa3); SGB_A(); SBAR();
    pv_d0(o, VBUF(j - 1), pa0, pa1, pa2, pa3); PSM(pB0, pB1, mnB, alB, j);
    RESC(alB); ENDSTEP(j);
    if (j + 3 < NT) DMA(j + 3, (j + 3) & 3);
    SBAR(); qkt(pA0, pA1, KBUF(j + 1), qr, r32, hi);
    finishSM(pB0, pB1, alB, l_reg, pa0, pa1, pa2, pa3); SGB_A(); SBAR();
    pv_d0(o, VBUF(j), pa0, pa1, pa2, pa3); PSM(pA0, pA1, mnA, alA, j + 1);
    RESC(alA); ENDSTEP(j + 1);
  }
  SBAR(); qkt(pB0, pB1, KBUF(NT - 1), qr, r32, hi);
  finishSM(pA0, pA1, alA, l_reg, pa0, pa1, pa2, pa3); SBAR();
  pv_d0(o, VBUF(NT - 2), pa0, pa1, pa2, pa3); PSM(pB0, pB1, mnB, alB, NT - 1);
  RESC(alB);
  finishSM(pB0, pB1, alB, l_reg, pa0, pa1, pa2, pa3); SBAR();
  pv_d0(o, VBUF(NT - 1), pa0, pa1, pa2, pa3);
  }
  if (hi == 0) li_l[r32] = l_reg; asm volatile("s_waitcnt lgkmcnt(0)" ::: "memory");
  if constexpr (DIL) { if (hi == 0) lse_o[(long)(wid * QBLK + r32) * lse_s] = m_reg + __log2f(l_reg); }
  float rli[16];
#pragma unroll
  for (int r = 0; r < 16; ++r) rli[r] = __builtin_amdgcn_rcpf(li_l[crow(r, hi)]);
  bf16* Ow = Ob + (long)(wid * QBLK) * os;
#if MK_OSTAGE
  { char* stg = DIL ? ((wid < 4 ? K_lds : V_lds) + 2 * SHM_K + (wid & 3) * 8192) : (K_lds + wid * 8192);
#pragma unroll
    for (int r = 0; r < 16; ++r) { const int orow = crow(r, hi);
#pragma unroll
      for (int d0 = 0; d0 < 4; ++d0) *(bf16*)(stg + orow * 256 + (d0 * 32 + r32) * 2) = __float2bfloat16(o[d0][r] * rli[r]); }
    asm volatile("s_waitcnt lgkmcnt(0)" ::: "memory");
#pragma unroll
    for (int i = 0; i < 8; ++i) { const int row = i * 4 + (lane >> 4), ch = lane & 15;
      const u32x4 v = *(const u32x4*)(stg + row * 256 + ch * 16);
      *(u32x4*)(Ow + (long)row * os + ch * 8) = v; } }
#else
#pragma unroll
  for (int r = 0; r < 16; ++r) { const int orow = crow(r, hi);
#pragma unroll
    for (int d0 = 0; d0 < 4; ++d0) Ow[(long)orow * os + d0 * 32 + r32] = __float2bfloat16(o[d0][r] * rli[r]); }
#endif
  asm volatile("s_waitcnt lgkmcnt(0)\n\ts_barrier" ::: "memory");
#undef KROW
#undef DMA
#undef ENDSTEP
#undef RESC
#undef PSM
#undef KBUF
#undef SGB_A
#undef VBUF
}
}

#define GAS __attribute__((address_space(1)))
#define LAS __attribute__((address_space(3)))
typedef unsigned short bf16_t;
typedef unsigned v4u __attribute__((ext_vector_type(4)));
typedef unsigned v2u __attribute__((ext_vector_type(2)));
typedef float f32x4 __attribute__((ext_vector_type(4)));
#define LDS_WAIT() asm volatile("s_waitcnt lgkmcnt(0)" ::: "memory")

constexpr size_t MiB = 1u << 20;
constexpr size_t WS_W1T = 0;
constexpr size_t WS_W2T = 104 * MiB;
constexpr size_t WS_H = 136 * MiB;
constexpr size_t WS_PROJ = 200 * MiB;
constexpr size_t WS_YA = 408 * MiB;
constexpr size_t WS_YB = 440 * MiB;
constexpr size_t WS_LSE = 536 * MiB;
constexpr size_t WS_ROPE = 538 * MiB;
constexpr size_t WS_XB = 540 * MiB;
constexpr size_t WS_ROWSQ = 604 * MiB;
constexpr size_t WS_END = 616 * MiB;
static_assert((size_t)DEPTH * DIN * DM * 2 <= WS_W2T - WS_W1T && (size_t)M * DIN * 2 <= WS_YA - WS_PROJ && (size_t)3 * M * DB * 2 <= WS_LSE - WS_YB, "ws map");
constexpr int LDS_BYTES = 147456;
constexpr int N_PHASES = 2 + 5 * DEPTH;

__device__ __forceinline__ unsigned f2bf(float f) { unsigned u = __builtin_bit_cast(unsigned, f); return (u + 0x7fffu + ((u >> 16) & 1u)) >> 16; }
__device__ __forceinline__ unsigned pk2(float lo, float hi) { return f2bf(lo) | (f2bf(hi) << 16); }
__device__ __forceinline__ float bflo(unsigned w) { return __uint_as_float(w << 16); }
__device__ __forceinline__ float bfhi(unsigned w) { return __uint_as_float(w & 0xffff0000u); }
__device__ __forceinline__ float wave_sum(float v) {
#pragma unroll
    for (int o = 1; o < 64; o <<= 1) v += __shfl_xor(v, o);
    return v;
}

__device__ const float INV_FREQ[32] = {1.000000000e+00f, 7.498942614e-01f, 5.623413324e-01f, 4.216965139e-01f, 3.162277639e-01f, 2.371373773e-01f, 1.778279394e-01f, 1.333521307e-01f,
    1.000000015e-01f, 7.498941571e-02f, 5.623413250e-02f, 4.216965288e-02f, 3.162277490e-02f, 2.371373773e-02f, 1.778279431e-02f, 1.333521493e-02f,
    9.999999776e-03f, 7.498941850e-03f, 5.623413250e-03f, 4.216964822e-03f, 3.162277630e-03f, 2.371373586e-03f, 1.778279431e-03f, 1.333521446e-03f,
    1.000000047e-03f, 7.498942432e-04f, 5.623413017e-04f, 4.216965172e-04f, 3.162277571e-04f, 2.371373703e-04f, 1.778279402e-04f, 1.333521504e-04f};

__device__ __forceinline__ void sincos_acc(float a, float& s, float& c) {
    const double x = (double)a, kd = __builtin_rint(x * 0.63661977236758134308);
    const int k = (int)kd; const double r = x - kd * 1.57079632679489661923, r2 = r * r;
    const double sp = r * (1.0 + r2 * (-1.0 / 6 + r2 * (1.0 / 120 + r2 * (-1.0 / 5040 + r2 * (1.0 / 362880 + r2 * (-1.0 / 39916800 + r2 * (1.0 / 6227020800.0)))))));
    const double cp = 1.0 + r2 * (-0.5 + r2 * (1.0 / 24 + r2 * (-1.0 / 720 + r2 * (1.0 / 40320 + r2 * (-1.0 / 3628800 + r2 * (1.0 / 479001600.0 + r2 * (-1.0 / 87178291200.0)))))));
    const int q = k & 3;
    const double sv = (q == 0) ? sp : (q == 1) ? cp : (q == 2) ? -sp : -cp, cv = (q == 0) ? cp : (q == 1) ? -sp : (q == 2) ? -cp : sp;
    s = (float)sv; c = (float)cv;
}

__device__ __forceinline__ void p0_transpose_item(const float* W, int K, int N, bf16_t* WT, LAS float* scr, int item, int lane, const float* kscale) {
    const int nblk = N / 32, kb = item / nblk, nb = item % nblk, k0 = 64 * kb, n0 = 32 * nb;
#pragma unroll 8
    for (int i = 0; i < 32; ++i) { const int kk = 2 * i + (lane >> 5); scr[kk * 33 + (lane & 31)] = W[(size_t)(k0 + kk) * N + n0 + (lane & 31)] * (kscale ? kscale[k0 + kk] : 1.0f); }
    LDS_WAIT(); asm volatile("" ::: "memory");
    const int c = lane & 7;
#pragma unroll
    for (int j = 0; j < 4; ++j) { const int n = (lane >> 3) + 8 * j; const LAS float* s = scr + (8 * c) * 33 + n;
        v4u o; o.x = pk2(s[0 * 33], s[1 * 33]); o.y = pk2(s[2 * 33], s[3 * 33]); o.z = pk2(s[4 * 33], s[5 * 33]); o.w = pk2(s[6 * 33], s[7 * 33]);
        *(v4u*)(WT + (size_t)(n0 + n) * K + k0 + 8 * c) = o; }
    LDS_WAIT(); asm volatile("" ::: "memory");
}

#define XB_TMO      128
#define XB_XCNT(j)  (256  + 64 * (j))
#define XB_XSUB(j)  (1280 + 64 * (j))
#define XB_XGEN(j)  (2304 + 64 * (j))
#define XB_TOP      3328
#define XB_TOPGEN   3392
#define XCD_BAR_WORDS 3456
#define XB_SPIN_CAP (1u << 18)

__device__ __forceinline__ unsigned xb_ld(unsigned* p)              { return __hip_atomic_load(p, __ATOMIC_RELAXED, __HIP_MEMORY_SCOPE_AGENT); }
__device__ __forceinline__ unsigned xb_add(unsigned* p, unsigned v) { return __hip_atomic_fetch_add(p, v, __ATOMIC_RELAXED, __HIP_MEMORY_SCOPE_AGENT); }
__device__ __forceinline__ unsigned xb_xcc_id() { return (unsigned)__builtin_amdgcn_s_getreg((3 << 11) | 20) & 0xFu; }
#define XB_SPIN(cond, bar) do { unsigned _sp = 0; while (cond) { __builtin_amdgcn_s_sleep(1); \
    if ((++_sp & 255u) == 0u) { if (xb_ld(&(bar)[XB_TMO])) break; if (_sp > XB_SPIN_CAP) { atomicAdd(&(bar)[XB_TMO], 1u); break; } } } } while (0)

struct XcdBarrier {
    unsigned* bar; unsigned x;
    volatile LAS unsigned* st;
};

__device__ __forceinline__ XcdBarrier xcd_barrier_post(unsigned* bar, volatile LAS unsigned* st) {
    XcdBarrier b; b.bar = bar; b.x = xb_xcc_id(); b.st = st;
    if (threadIdx.x == 0) (void)xb_add(&bar[XB_XCNT(b.x)], 1u);
    return b;
}
__device__ __forceinline__ void xcd_barrier_complete(unsigned* bar, unsigned x, unsigned& nloc, unsigned& nx) {
    const unsigned G = gridDim.x * gridDim.y * gridDim.z;
    unsigned sum, cnt, mine, sp = 0u;
    for (;;) {
        sum = 0u; cnt = 0u; mine = 0u;
#pragma unroll
        for (unsigned j = 0; j < 16; ++j) { const unsigned c = xb_ld(&bar[XB_XCNT(j)]); sum += c; cnt += (c > 0u) ? 1u : 0u; mine = (j == x) ? c : mine; }
        if (sum == G) break;
        __builtin_amdgcn_s_sleep(1);
        if ((++sp & 255u) == 0u) { if (xb_ld(&bar[XB_TMO])) break; if (sp > XB_SPIN_CAP) { atomicAdd(&bar[XB_TMO], 1u); break; } }
    }
    nloc = mine > 0u ? mine : 1u; nx = cnt > 0u ? cnt : 1u;
}

__device__ __forceinline__ void xcd_barrier(const XcdBarrier& b) {
    asm volatile("s_waitcnt vmcnt(0)" ::: "memory");
    __syncthreads();
    if (threadIdx.x == 0) {
        unsigned* bar = b.bar;
        __builtin_amdgcn_s_waitcnt(0);
        unsigned nloc = b.st[0], nx = b.st[1];
        if (nloc == 0u) { xcd_barrier_complete(bar, b.x, nloc, nx); b.st[0] = nloc; b.st[1] = nx; }
        const unsigned old = xb_add(&bar[XB_XSUB(b.x)], 1u);
        const unsigned gen = old / nloc;
        if (old + 1u == (gen + 1u) * nloc) {
            __builtin_amdgcn_fence(__ATOMIC_RELEASE, "agent");
            asm volatile("s_waitcnt vmcnt(0)" ::: "memory");
            const unsigned og = xb_add(&bar[XB_TOP], 1u);
            const unsigned tg = og / nx;
            if (og + 1u == (tg + 1u) * nx) xb_add(&bar[XB_TOPGEN], 1u);
            else XB_SPIN(xb_ld(&bar[XB_TOPGEN]) == tg, bar);
            __builtin_amdgcn_fence(__ATOMIC_ACQUIRE, "agent");
            xb_add(&bar[XB_XGEN(b.x)], 1u);
            asm volatile("s_waitcnt vmcnt(0)" ::: "memory");
        } else {
            XB_SPIN(xb_ld(&bar[XB_XGEN(b.x)]) == gen, bar);
            __builtin_amdgcn_fence(__ATOMIC_ACQUIRE, "agent");
            asm volatile("s_waitcnt vmcnt(0)" ::: "memory");
        }
    }
    __syncthreads();
}

constexpr size_t WS_CTL = 539 * MiB, CTL_BYTES = 16384;
constexpr int MISC_OFF = 147456 - 128;
__device__ __forceinline__ void gate_row(int m, int lane, const bf16_t* __restrict__ YA, const bf16_t* __restrict__ YB, const float* __restrict__ LSE, const bf16_t* __restrict__ PROJ,
                                         const float* __restrict__ wa, const float* __restrict__ wb, bf16_t* __restrict__ H) {
                    float ya[2][8], yb[2][8]; float ssa = 0.f, ssb = 0.f;
#pragma unroll
                    for (int j = 0; j < 2; ++j) { const int c = lane + 64 * j, hh = c >> 4;
                        const v4u a = *(const v4u*)(YA + (size_t)m * DA + 8 * c);
                        ya[j][0] = bflo(a.x); ya[j][1] = bfhi(a.x); ya[j][2] = bflo(a.y); ya[j][3] = bfhi(a.y); ya[j][4] = bflo(a.z); ya[j][5] = bfhi(a.z); ya[j][6] = bflo(a.w); ya[j][7] = bfhi(a.w);
                        const float l0 = LSE[((size_t)0 * M + m) * 8 + hh], l1 = LSE[((size_t)1 * M + m) * 8 + hh], l2 = LSE[((size_t)2 * M + m) * 8 + hh];
                        const float mx = fmaxf(l0, fmaxf(l1, l2)); const float e0 = __builtin_amdgcn_exp2f(l0 - mx), e1 = __builtin_amdgcn_exp2f(l1 - mx), e2 = __builtin_amdgcn_exp2f(l2 - mx);
                        const float inv = 1.0f / (e0 + e1 + e2); const float w0 = e0 * inv, w1 = e1 * inv, w2 = e2 * inv;
                        const v4u b0 = *(const v4u*)(YB + ((size_t)0 * M + m) * DB + 8 * c), b1 = *(const v4u*)(YB + ((size_t)1 * M + m) * DB + 8 * c), b2 = *(const v4u*)(YB + ((size_t)2 * M + m) * DB + 8 * c);
                        yb[j][0] = w0 * bflo(b0.x) + w1 * bflo(b1.x) + w2 * bflo(b2.x); yb[j][1] = w0 * bfhi(b0.x) + w1 * bfhi(b1.x) + w2 * bfhi(b2.x);
                        yb[j][2] = w0 * bflo(b0.y) + w1 * bflo(b1.y) + w2 * bflo(b2.y); yb[j][3] = w0 * bfhi(b0.y) + w1 * bfhi(b1.y) + w2 * bfhi(b2.y);
                        yb[j][4] = w0 * bflo(b0.z) + w1 * bflo(b1.z) + w2 * bflo(b2.z); yb[j][5] = w0 * bfhi(b0.z) + w1 * bfhi(b1.z) + w2 * bfhi(b2.z);
                        yb[j][6] = w0 * bflo(b0.w) + w1 * bflo(b1.w) + w2 * bflo(b2.w); yb[j][7] = w0 * bfhi(b0.w) + w1 * bfhi(b1.w) + w2 * bfhi(b2.w);
#pragma unroll
                        for (int i = 0; i < 8; ++i) { ssa += ya[j][i] * ya[j][i]; ssb += yb[j][i] * yb[j][i]; } }
                    const float ra = 1.0f / sqrtf(wave_sum(ssa) * (1.0f / DA) + EPS), rb = 1.0f / sqrtf(wave_sum(ssb) * (1.0f / DB) + EPS);
#pragma unroll
                    for (int j = 0; j < 2; ++j) { const int c = lane + 64 * j;
                        const v4u ga = *(const v4u*)(PROJ + ((size_t)(H_GA + (c >> 4)) * M + m) * HD + 8 * (c & 15)), gb = *(const v4u*)(PROJ + ((size_t)(H_GB + (c >> 4)) * M + m) * HD + 8 * (c & 15));
                        const float gaf[8] = {bflo(ga.x), bfhi(ga.x), bflo(ga.y), bfhi(ga.y), bflo(ga.z), bfhi(ga.z), bflo(ga.w), bfhi(ga.w)};
                        const float gbf[8] = {bflo(gb.x), bfhi(gb.x), bflo(gb.y), bfhi(gb.y), bflo(gb.z), bfhi(gb.z), bflo(gb.w), bfhi(gb.w)};
                        const f32x4 wa0 = *(const f32x4*)(wa + 8 * c), wa1 = *(const f32x4*)(wa + 8 * c + 4), wb0 = *(const f32x4*)(wb + 8 * c), wb1 = *(const f32x4*)(wb + 8 * c + 4);
                        float za[8], zb[8];
#pragma unroll
                        for (int i = 0; i < 8; ++i) { const float wai = i < 4 ? wa0[i & 3] : wa1[i & 3], wbi = i < 4 ? wb0[i & 3] : wb1[i & 3];
                            const float sa = gaf[i] / (1.0f + __expf(-gaf[i])), sb = gbf[i] / (1.0f + __expf(-gbf[i]));
                            za[i] = ya[j][i] * ra * wai * sa; zb[i] = yb[j][i] * rb * wbi * sb; }
                        v4u oa, ob; oa.x = pk2(za[0], za[1]); oa.y = pk2(za[2], za[3]); oa.z = pk2(za[4], za[5]); oa.w = pk2(za[6], za[7]);
                        ob.x = pk2(zb[0], zb[1]); ob.y = pk2(zb[2], zb[3]); ob.z = pk2(zb[4], zb[5]); ob.w = pk2(zb[6], zb[7]);
                        *(v4u*)(H + (size_t)m * DM + 8 * c) = oa; *(v4u*)(H + (size_t)m * DM + DA + 8 * c) = ob; }
}

struct Params { const float *x, *norm_w, *w_in, *qn, *kn, *ona, *onb, *w_out, *fnorm; float* out; unsigned char* ws; int ph_lo, ph_hi; };

__global__ void __launch_bounds__(512, 2) mk_fwd(Params p) {
    extern __shared__ __attribute__((aligned(16))) unsigned char lds[];
    volatile LAS unsigned* MISC = (volatile LAS unsigned*)((LAS unsigned char*)lds + MISC_OFF);
    if (threadIdx.x < 32) MISC[threadIdx.x] = 0u;
    __syncthreads();
    XcdBarrier bar = xcd_barrier_post((unsigned*)(p.ws + WS_CTL), MISC + 8);
    if (p.ph_lo == 0) {
        float* RCOS0 = (float*)(p.ws + WS_ROPE); float* RSIN0 = RCOS0 + 192 * 32;
        for (int i = blockIdx.x * 512 + threadIdx.x; i < 192 * 32; i += gridDim.x * 512) {
            const int pos = i >> 5, f = i & 31; const float pv = (float)(pos < 128 ? pos : pos - 128);
            float sn_, cs_; sincos_acc(pv * INV_FREQ[f], sn_, cs_); RCOS0[i] = cs_; RSIN0[i] = sn_;
        }
    }
    for (int ph = p.ph_lo; ph < p.ph_hi; ++ph) {
        const int tid = otid(), lane = tid & 63, wave = __builtin_amdgcn_readfirstlane(tid >> 6);
        int G = gridDim.x, bx = blockIdx.x; asm volatile("" : "+s"(G), "+s"(bx));
        const int vcu = (G % 8 == 0) ? (bx % 8) * (G / 8) + bx / 8 : bx;
        const int gw = vcu * 8 + wave, NGW = G * 8;
        size_t zoff = 0; asm volatile("" : "+s"(zoff));
        unsigned char* ws = p.ws + zoff;
        bf16_t* W1T = (bf16_t*)(ws + WS_W1T); bf16_t* W2T = (bf16_t*)(ws + WS_W2T); bf16_t* H = (bf16_t*)(ws + WS_H); bf16_t* PROJ = (bf16_t*)(ws + WS_PROJ);
        bf16_t* YA = (bf16_t*)(ws + WS_YA); bf16_t* YB = (bf16_t*)(ws + WS_YB); float* LSE = (float*)(ws + WS_LSE);
        float* RCOS = (float*)(ws + WS_ROPE); float* RSIN = RCOS + 192 * 32;
        bf16_t* XB = (bf16_t*)(ws + WS_XB); float* ROWSQ = (float*)(ws + WS_ROWSQ);
        if (ph == 0) {
            LAS float* scr = (LAS float*)((LAS unsigned char*)lds + wave * 16384);
            constexpr int I1 = (DM / 64) * (DIN / 32), I2 = (DM / 64) * (DM / 32), IL = I1 + I2;
            DUPREP(0) for (int it = gw; it < DEPTH * IL; it += NGW) {
                const int l = it / IL, r = it % IL;
                if (r < I1) p0_transpose_item(p.w_in + (size_t)l * DM * DIN, DM, DIN, W1T + (size_t)l * DIN * DM, scr, r, lane, p.norm_w + (size_t)l * DM);
                else p0_transpose_item(p.w_out + (size_t)l * DM * DM, DM, DM, W2T + (size_t)l * DM * DM, scr, r - I1, lane, nullptr);
            }
            for (int m = gw; m < M; m += NGW) {
                const f32x4* xr = (const f32x4*)(p.x + (size_t)m * DM) + lane; v2u* o8 = (v2u*)(XB + (size_t)m * DM) + lane; float sq = 0.f;
#pragma unroll
                for (int j = 0; j < 8; ++j) { const f32x4 v = xr[64 * j]; v2u w; w.x = pk2(v.x, v.y); w.y = pk2(v.z, v.w); o8[64 * j] = w;
                    const float r0 = bflo(w.x), r1 = bfhi(w.x), r2 = bflo(w.y), r3 = bfhi(w.y); sq += (r0 * r0 + r1 * r1) + (r2 * r2 + r3 * r3); }
                sq = wave_sum(sq); if (lane < 32) ROWSQ[(size_t)m * 32 + lane] = (lane == 0) ? sq : 0.f;
            }
        } else if (ph == N_PHASES - 1) {
            for (int m = gw; m < M; m += NGW) {
                f32x4* xr = (f32x4*)(p.out + (size_t)m * DM) + lane; const f32x4* wr_ = (const f32x4*)p.fnorm + lane; const v2u* xb8 = (const v2u*)(XB + (size_t)m * DM) + lane;
                const float rstd = 1.0f / sqrtf(wave_sum(lane < 32 ? ROWSQ[((size_t)DEPTH * M + m) * 32 + lane] : 0.f) * (1.0f / DM) + EPS);
#pragma unroll
                for (int j = 0; j < 8; ++j) { const v2u w = xb8[64 * j]; const f32x4 v = {bflo(w.x), bfhi(w.x), bflo(w.y), bfhi(w.y)}; xr[64 * j] = v * rstd * wr_[64 * j]; }
            }
        } else {
            const int l = (ph - 1) / 5, st = (ph - 1) % 5 + 1;
            if (st == 1) {
                pg8::Gemm g{XB, W1T + (size_t)l * DIN * DM, M, DIN, DM}; pg8::StaticOrder S; S.init(M, DIN, G, bx);
                pg8::EpiHeadMajor E{PROJ, M, ROWSQ + (size_t)l * M * 32, 1.0f / DM, EPS};
#ifndef MK_NO_G1
                DUPREP(2) pg8::gemm_phase<pg8::EpiHeadMajor, pg8::StaticOrder, PG8_ALIGN, PG8_SP2>((PG8_LAS unsigned char*)lds, g, S, E);
#endif
            } else if (st == 2) {
                const float* qg = p.qn + l * HD; const float* kg = p.kn + l * HD;
                constexpr int QKU = 4;
                for (int it0 = gw; it0 < M * 10 / 4; it0 += QKU * NGW) {
                    const int j = lane & 15, half = j >> 3, jj = j & 7, e = half * 64 + 4 * jj;
                    v2u a[QKU], b[QKU]; f32x4 cs[QKU], sn[QKU]; bf16_t* pp[QKU]; bool isq[QKU];
#pragma unroll
                    for (int u = 0; u < QKU; ++u) { const int it = min(it0 + u * NGW, M * 10 / 4 - 1);
                        const int g = it * 4 + (lane >> 4), row = g / 10, hs = g - row * 10; isq[u] = hs < 8;
                        pp[u] = PROJ + ((size_t)hs * M + row) * HD + e; a[u] = *(const v2u*)pp[u]; b[u] = *(const v2u*)(pp[u] + 32);
                        const int t = row & (T - 1), pos = half ? 128 + (t & 63) : (t >> 6);
                        cs[u] = *(const f32x4*)(RCOS + pos * 32 + 4 * jj); sn[u] = *(const f32x4*)(RSIN + pos * 32 + 4 * jj); }
                    asm volatile("" ::: "memory");
#pragma unroll
                    for (int u = 0; u < QKU; ++u) {
                        float x1[4] = {bflo(a[u].x), bfhi(a[u].x), bflo(a[u].y), bfhi(a[u].y)}, x2[4] = {bflo(b[u].x), bfhi(b[u].x), bflo(b[u].y), bfhi(b[u].y)};
                        float ss = 0.f;
#pragma unroll
                        for (int i = 0; i < 4; ++i) ss += x1[i] * x1[i] + x2[i] * x2[i];
                        ss += __shfl_xor(ss, 1); ss += __shfl_xor(ss, 2); ss += __shfl_xor(ss, 4); ss += __shfl_xor(ss, 8);
                        const float rstd = 1.0f / sqrtf(ss * (1.0f / HD) + EPS);
                        const float* gn = isq[u] ? qg : kg;
                        const float qsc = (MK_NEGM && isq[u]) ? att::SCALE * att::LOG2E : 1.0f;
                        const f32x4 g1 = *(const f32x4*)(gn + e), g2 = *(const f32x4*)(gn + e + 32);
                        float o1[4], o2[4];
#pragma unroll
                        for (int i = 0; i < 4; ++i) { const float y1 = x1[i] * rstd * g1[i], y2 = x2[i] * rstd * g2[i]; o1[i] = (y1 * cs[u][i] - y2 * sn[u][i]) * qsc; o2[i] = (y1 * sn[u][i] + y2 * cs[u][i]) * qsc; }
                        v2u w1, w2; w1.x = pk2(o1[0], o1[1]); w1.y = pk2(o1[2], o1[3]); w2.x = pk2(o2[0], o2[1]); w2.y = pk2(o2[2], o2[3]);
                        if (it0 + u * NGW < M * 10 / 4) { *(v2u*)pp[u] = w1; *(v2u*)(pp[u] + 32) = w2; }
                    }
                }
#ifndef MK_NO_DIL
                DUPREP(3) for (int u = vcu; u < 1536; u += G) {
                    const int pt = u >> 9, rem = u & 511, b = rem >> 8, h = (rem >> 5) & 7, w = rem & 31;
                    const int d = (pt == 0) ? 1 : (pt == 1) ? 4 : 16, res = w & (d - 1), blk = w / d, i0 = blk * 256, nsub = T / d;
                    const float slope = __builtin_amdgcn_exp2f(-(float)(h + 1));
                    const float nslopeC = -slope * (float)d * att::LOG2E;
                    const size_t tok0 = (size_t)b * T + res;
                    const att::bf16* Pb = (const att::bf16*)PROJ + ((size_t)h * M + tok0) * HD;
                    const long rs = (long)d * HD;
                    att::attn_body<true>(Pb + (size_t)H_QB * M * HD + (long)i0 * rs, Pb + (size_t)H_KB * M * HD, Pb + (size_t)H_VB * M * HD, rs, rs,
                                         (att::bf16*)YB + ((size_t)pt * M + tok0 + (size_t)i0 * d) * DB + h * HD, (long)d * DB,
                                         LSE + ((size_t)pt * M + tok0 + (size_t)i0 * d) * 8 + h, d * 8, i0, nsub, nslopeC, 0, (char*)lds);
                }
#endif
            } else if (st == 3) {
#ifndef MK_NO_DENSE
                int bounded;
                { const float* qg = p.qn + l * HD; const float* kg = p.kn + l * HD;
                  float gq = fmaxf(fabsf(qg[lane]), fabsf(qg[lane + 64])), gk = fmaxf(fabsf(kg[lane]), fabsf(kg[lane + 64]));
#pragma unroll
                  for (int o_ = 1; o_ < 64; o_ <<= 1) { gq = fmaxf(gq, __shfl_xor(gq, o_)); gk = fmaxf(gk, __shfl_xor(gk, o_)); }
                  const float bnd = gq * gk * 128.f * att::SCALE * att::LOG2E;
                  bounded = __builtin_amdgcn_readfirstlane((MK_NEGM && bnd <= 64.f) ? 1 : 0); }
                DUPREP(4) for (int u = vcu; u < 512; u += G) {
                    const int combo = u >> 7, b = combo >> 1, kvh = combo & 1, h = kvh * 4 + ((u >> 5) & 3), qb = u & 31;
                    const att::bf16* Pb = (const att::bf16*)PROJ + (size_t)b * T * HD;
                    att::attn_body<false>(Pb + ((size_t)(H_QA + h) * M + qb * 256) * HD, Pb + (size_t)(H_KA + kvh) * M * HD, Pb + (size_t)(H_VA + kvh) * M * HD, HD, HD,
                                          (att::bf16*)YA + ((size_t)b * T + qb * 256) * DA + h * HD, DA, nullptr, 0, bounded, 0, 0.f, T, (char*)lds);
                }
#endif
            } else if (st == 4) {
                const float* wa = p.ona + (size_t)l * DA; const float* wb = p.onb + (size_t)l * DB;
                DUPREP(5) for (int m = gw; m < M; m += 2 * NGW) {
                    gate_row(m, lane, YA, YB, LSE, PROJ, wa, wb, H);
                    if (m + NGW < M) gate_row(m + NGW, lane, YA, YB, LSE, PROJ, wa, wb, H);
                }
            } else {
                pg8::Gemm g{H, W2T + (size_t)l * DM * DM, M, DM, DM}; pg8::StaticOrder S; S.init(M, DM, G, bx);
                pg8::EpiResF32 E{XB, ROWSQ + (size_t)(l + 1) * M * 32, DM};
#ifndef MK_NO_G2
                pg8::gemm_phase<pg8::EpiResF32, pg8::StaticOrder, PG8_ALIGN, PG8_SP2>((PG8_LAS unsigned char*)lds, g, S, E);
#endif
            }
        }
        if (ph + 1 < p.ph_hi) { if (p.ph_hi > 4096) cg::this_grid().sync(); else xcd_barrier(bar); if (MK_DUP & 64) xcd_barrier(bar); }
    }
}

extern "C" void kernel_launch(void* const* d_in, const int* in_sizes, int n_in, void* d_out, int out_size, void* d_ws, size_t ws_size, hipStream_t stream) {
    static int grid = 0;
    if (grid == 0) {
        if (n_in != 9 || in_sizes[0] != M * DM || out_size != M * DM || ws_size < WS_END) { fprintf(stderr, "kernel_launch: unexpected shapes (n_in %d, ws %zu)\n", n_in, ws_size); grid = -1; return; }
        int dev = 0, cus = 0, per_cu = 0;
        hipGetDevice(&dev); hipDeviceGetAttribute(&cus, hipDeviceAttributeMultiprocessorCount, dev);
        if (hipFuncSetAttribute((const void*)mk_fwd, hipFuncAttributeMaxDynamicSharedMemorySize, LDS_BYTES) != hipSuccess) { fprintf(stderr, "kernel_launch: hipFuncSetAttribute failed\n"); grid = -1; return; }
        if (hipOccupancyMaxActiveBlocksPerMultiprocessor(&per_cu, (const void*)mk_fwd, 512, LDS_BYTES) != hipSuccess || per_cu < 1) per_cu = 1;
        (void)hipGetLastError();
        grid = cus * per_cu;
    }
    if (grid < 0) return;
    Params p{};
    p.x = (const float*)d_in[0]; p.norm_w = (const float*)d_in[1]; p.w_in = (const float*)d_in[2]; p.qn = (const float*)d_in[3]; p.kn = (const float*)d_in[4];
    p.ona = (const float*)d_in[5]; p.onb = (const float*)d_in[6]; p.w_out = (const float*)d_in[7]; p.fnorm = (const float*)d_in[8];
    p.out = (float*)d_out; p.ws = (unsigned char*)d_ws;
    if (hipMemsetAsync((char*)d_ws + WS_CTL, 0, CTL_BYTES, stream) != hipSuccess) { fprintf(stderr, "kernel_launch: memset failed\n"); return; }
#if MK_ONE_LAUNCH
    p.ph_lo = 0; p.ph_hi = N_PHASES;
    void* args[] = {&p};
    hipError_t e = hipLaunchCooperativeKernel((const void*)mk_fwd, dim3(grid), dim3(512), args, LDS_BYTES, stream);
    if (e != hipSuccess) fprintf(stderr, "kernel_launch: cooperative launch failed: %s (grid %d)\n", hipGetErrorString(e), grid);
#else
    for (int ph = 0; ph < N_PHASES; ++ph) { p.ph_lo = ph; p.ph_hi = ph + 1; hipLaunchKernelGGL(mk_fwd, dim3(grid), dim3(512), LDS_BYTES, stream, p); }
#endif
}
```

```cpp
#include <hip/hip_runtime.h>
#include <hip/hip_bf16.h>
#include <hip/hip_cooperative_groups.h>
#include <cstdio>
#include <cstdint>
namespace cg = cooperative_groups;

#ifndef MK_DUP
#define MK_DUP 0
#endif
#define DUPREP(k) for (int rep_ = 0; rep_ < 1 + ((MK_DUP >> (k)) & 1); ++rep_)
#ifndef MK_PVPIPE
#define MK_PVPIPE 1
#endif
#ifndef MK_SGB
#define MK_SGB 0
#endif
#ifndef MK_PP
#define MK_PP 1
#endif
#ifndef MK_PROBE_V
#define MK_PROBE_V 0
#endif
#ifndef MK_NEGM
#define MK_NEGM 1
#endif
#ifndef MK_PREB
#define MK_PREB 1
#endif
#ifndef MK_OSTAGE
#define MK_OSTAGE 1
#endif
#ifndef MK_ONE_LAUNCH
#define MK_ONE_LAUNCH 1
#endif
static_assert(!MK_NEGM || MK_PP, "MK_NEGM pre-scales q for the ping-pong dense body only");

constexpr int BATCH = 2, T = 8192, DM = 2048, DEPTH = 4, HD = 128, DA = 1024, DB = 1024, DIN = 6656, M = BATCH * T;
constexpr int C_QA = 0, C_KA = 1024, C_VA = 1280, C_GA = 1536, C_QB = 2560, C_KB = 3584, C_VB = 4608, C_GB = 5632;
constexpr int H_QA = 0, H_KA = 8, H_VA = 10, H_GA = 12, H_QB = 20, H_KB = 28, H_VB = 36, H_GB = 44;
constexpr float EPS = 1e-6f;
__device__ __forceinline__ int otid() { int t = threadIdx.x; asm volatile("" : "+v"(t)); return t; }

namespace pg8 {
#define PG8_LAS __attribute__((address_space(3)))
typedef unsigned short bf16_t;
typedef short bf16x8 __attribute__((ext_vector_type(8)));
typedef float f32x4 __attribute__((ext_vector_type(4)));
typedef unsigned u32x4 __attribute__((ext_vector_type(4)));
constexpr int BM = 256, BK = 64, HALF = 128, HTB = HALF * BK * 2  , STAGE_BYTES = 8 * HTB, NXCD = 8, WGM = 4;

__host__ __device__ __forceinline__ int lds_byte(int r, int c) { const int st = (r >> 4) * 2 + (c >> 5), rr = r & 15, cc = c & 31, ob = rr * 64 + cc * 2; return st * 1024 + (ob ^ (((ob >> 9) & 1) << 5)); }
__host__ __device__ __forceinline__ void stage_rc(int b, int& R, int& C) { const int st = b / 1024, sb = b % 1024, swz = sb ^ (((sb >> 9) & 1) << 5); R = (st >> 1) * 16 + swz / 64; C = (st & 1) * 32 + (swz % 64) / 2; }
__host__ __device__ __forceinline__ int perm32(int rho) { const int n = rho >> 4, i = rho & 15; return 8 * (i >> 2) + 4 * n + (i & 3); }

struct Unit { int pm, pn; };
struct Gemm { const bf16_t* A; const bf16_t* Bt; int M, N, K; };

struct StaticOrder {
    int nM, nN, nwg, G, c;
    __host__ __device__ void init(int M, int N, int G_, int c_) { nM = M / BM; nN = N / BM; nwg = nM * nN; G = G_; c = c_; }
    __host__ __device__ bool next(int i, Unit& u) const {
        const long L = (long)i * G + c; if (L >= nwg) return false;
        int wgid = (int)L; { const int q = nwg / NXCD, r = nwg % NXCD, xcd = wgid % NXCD, off = wgid / NXCD; wgid = (xcd < r ? xcd * (q + 1) : r * (q + 1) + (xcd - r) * q) + off; }
        const int nig = WGM * nN, gid = wgid / nig, fm = gid * WGM, gsz = (nM - fm) < WGM ? (nM - fm) : WGM;
        u.pm = fm + ((wgid % nig) % gsz); u.pn = (wgid % nig) / gsz; return true;
    }
    __device__ __forceinline__ void a_ready(const Unit&) const {}
    __device__ __forceinline__ void done(const Unit&) const {}
};

__device__ __forceinline__ unsigned cvt_pk_bf16(float lo, float hi) { unsigned r; asm volatile("v_cvt_pk_bf16_f32 %0, %1, %2" : "=v"(r) : "v"(lo), "v"(hi)); return r; }
typedef float f32x2 __attribute__((ext_vector_type(2)));
__device__ __forceinline__ f32x2 gelu_pk(f32x2 v) {
    const f32x2 av = __builtin_elementwise_abs(v), d = av * 0.2316418882f + 1.0f;
    f32x2 t; t.x = __builtin_amdgcn_rcpf(d.x); t.y = __builtin_amdgcn_rcpf(d.y);
    f32x2 q = t * 0.5307027145f + (-0.7265760135f); q = q * t + 0.7107068705f; q = q * t + (-0.142248368f); q = q * t + 0.127414796f; q = q * t;
    const f32x2 s = (v * v) * (-0.72134752044f);
    f32x2 e; e.x = __builtin_amdgcn_exp2f(s.x); e.y = __builtin_amdgcn_exp2f(s.y);
    const f32x2 m = v * (q * e), r = v - m;
    f32x2 o; o.x = v.x < 0.f ? m.x : r.x; o.y = v.y < 0.f ? m.y : r.y; return o;
}

template <int ACT  > struct EpiBf16 {
    static constexpr bool PERM = true, AFTER_DRAIN = false; static_assert(ACT == 0 || ACT == 1, "EpiBf16: ACT is 0 (none) or 1 (gelu_pk)");
    bf16_t* O; int ldc; const float* bias; int split_cols; size_t split_stride; float scale0;
    __device__ __forceinline__ void operator()(const f32x4 (&acc)[2][2][4][2], const Unit& u, int wr, int wc, int fr, int fq) const {
        const int row0 = u.pm * BM + wr * 64 + fr; int colt = u.pn * BM; bf16_t* base = O;
        float sc = 1.f; if (split_cols) { const int t = colt / split_cols; base += (size_t)t * split_stride; colt -= t * split_cols; if (t == 0) sc = scale0; }
        const int col0 = colt + wc * 32 + 8 * fq, bcol0 = u.pn * BM + wc * 32 + 8 * fq;
        f32x4 bv[2][2];
#pragma unroll
        for (int bj = 0; bj < 2; ++bj)
#pragma unroll
            for (int n = 0; n < 2; ++n) bv[bj][n] = bias ? *(const f32x4*)(bias + bcol0 + bj * HALF + 4 * n) : (f32x4){0.f, 0.f, 0.f, 0.f};
#pragma unroll
        for (int ai = 0; ai < 2; ++ai)
#pragma unroll
            for (int m = 0; m < 4; ++m) { bf16_t* rowp = base + (size_t)(row0 + ai * HALF + m * 16) * ldc + col0;
#pragma unroll
                for (int bj = 0; bj < 2; ++bj) { f32x4 v0 = acc[ai][bj][m][0] + bv[bj][0], v1 = acc[ai][bj][m][1] + bv[bj][1];
                    if (ACT == 1) { f32x2 a = gelu_pk((f32x2){v0[0], v0[1]}), b = gelu_pk((f32x2){v0[2], v0[3]}), c = gelu_pk((f32x2){v1[0], v1[1]}), d = gelu_pk((f32x2){v1[2], v1[3]});
                        v0 = (f32x4){a.x, a.y, b.x, b.y}; v1 = (f32x4){c.x, c.y, d.x, d.y}; }
                    v0 = v0 * sc; v1 = v1 * sc; u32x4 w; w.x = cvt_pk_bf16(v0[0], v0[1]); w.y = cvt_pk_bf16(v0[2], v0[3]); w.z = cvt_pk_bf16(v1[0], v1[1]); w.w = cvt_pk_bf16(v1[2], v1[3]);
                    *(u32x4*)(rowp + bj * HALF) = w; } }
    }
};
struct EpiHeadMajor {
    static constexpr bool PERM = true, AFTER_DRAIN = false;
    bf16_t* O; int Mrows; const float* rowsq; float inv_k, eps;
    __device__ __forceinline__ void operator()(const f32x4 (&acc)[2][2][4][2], const Unit& u, int wr, int wc, int fr, int fq) const {
        const int row0 = u.pm * BM + wr * 64 + fr, col0 = wc * 32 + 8 * fq;
#pragma unroll
        for (int ai = 0; ai < 2; ++ai) {
            f32x4 pa[4], pb[4];
#pragma unroll
            for (int m = 0; m < 4; ++m) { const f32x4* pp = (const f32x4*)(rowsq + (size_t)(row0 + ai * HALF + m * 16) * 32 + 8 * fq); pa[m] = pp[0]; pb[m] = pp[1]; }
#pragma unroll
            for (int m = 0; m < 4; ++m) { const int row = row0 + ai * HALF + m * 16; const f32x4 a = pa[m], b = pb[m];
                float sq = ((a[0] + a[1]) + (a[2] + a[3])) + ((b[0] + b[1]) + (b[2] + b[3])); sq += __shfl_xor(sq, 16); sq += __shfl_xor(sq, 32);
                const float rs = 1.0f / sqrtf(sq * inv_k + eps);
#pragma unroll
                for (int bj = 0; bj < 2; ++bj) { const f32x4 v0 = acc[ai][bj][m][0] * rs, v1 = acc[ai][bj][m][1] * rs;
                    u32x4 w; w.x = cvt_pk_bf16(v0[0], v0[1]); w.y = cvt_pk_bf16(v0[2], v0[3]); w.z = cvt_pk_bf16(v1[0], v1[1]); w.w = cvt_pk_bf16(v1[2], v1[3]);
                    *(u32x4*)(O + ((size_t)(u.pn * 2 + bj) * Mrows + row) * HALF + col0) = w; } }
            asm volatile("" ::: "memory"); }
    }
};
struct EpiResF32 {
    static constexpr bool PERM = true, AFTER_DRAIN = false;
    bf16_t* xb; float* rowsq; int ldc;
    __device__ __forceinline__ void operator()(const f32x4 (&acc)[2][2][4][2], const Unit& u, int wr, int wc, int fr, int fq) const {
        const int col0 = u.pn * BM + wc * 32 + 8 * fq;
#pragma unroll
        for (int ai = 0; ai < 2; ++ai) {
            u32x4 pre[4][2];
#pragma unroll
            for (int m = 0; m < 4; ++m) { const size_t off = (size_t)(u.pm * BM + ai * HALF + wr * 64 + m * 16 + fr) * ldc + col0;
#pragma unroll
                for (int bj = 0; bj < 2; ++bj) pre[m][bj] = *(const u32x4*)(xb + off + bj * HALF); }
            asm volatile("" ::: "memory");
#pragma unroll
            for (int m = 0; m < 4; ++m) { const int row = u.pm * BM + ai * HALF + wr * 64 + m * 16 + fr; const size_t off = (size_t)row * ldc + col0; float ss = 0.f;
#pragma unroll
                for (int bj = 0; bj < 2; ++bj) { const u32x4 pb = pre[m][bj]; const f32x4 a0 = acc[ai][bj][m][0], a1 = acc[ai][bj][m][1];
                    u32x4 w; w.x = cvt_pk_bf16(__uint_as_float(pb.x << 16) + a0[0], __uint_as_float(pb.x & 0xffff0000u) + a0[1]); w.y = cvt_pk_bf16(__uint_as_float(pb.y << 16) + a0[2], __uint_as_float(pb.y & 0xffff0000u) + a0[3]);
                    w.z = cvt_pk_bf16(__uint_as_float(pb.z << 16) + a1[0], __uint_as_float(pb.z & 0xffff0000u) + a1[1]); w.w = cvt_pk_bf16(__uint_as_float(pb.w << 16) + a1[2], __uint_as_float(pb.w & 0xffff0000u) + a1[3]);
#pragma unroll
                    for (int q = 0; q < 4; ++q) { const float r0 = __uint_as_float(w[q] << 16), r1 = __uint_as_float(w[q] & 0xffff0000u); ss += r0 * r0 + r1 * r1; }
                    *(u32x4*)(xb + off + bj * HALF) = w; }
                ss += __shfl_xor(ss, 16); ss += __shfl_xor(ss, 32);
                if (fq == 0) rowsq[(size_t)row * 32 + u.pn * 4 + wc] = ss; }
            asm volatile("" ::: "memory"); }
    }
};


template <class Epi, class Sched, bool ALIGN_EPI = false, bool SP2 = false>
__device__ __forceinline__ void gemm_phase(PG8_LAS unsigned char* lds, const Gemm g, const Sched& S, const Epi& E) {
    const int tid = otid(), wid = __builtin_amdgcn_readfirstlane(tid >> 6), lane = tid & 63, wr = wid >> 2, wc = wid & 3, fr = lane & 15, fq = lane >> 4;
    const int K = g.K, nt = K / BK;
    unsigned voffA[2], voffB[2];
#pragma unroll
    for (int i = 0; i < 2; ++i) { int R, C; stage_rc(tid * 16 + i * 8192, R, C); const int Rb = Epi::PERM ? ((R & ~31) + perm32(R & 31)) : R;
        voffA[i] = (unsigned)(R * K + C) * 2u; voffB[i] = (unsigned)(Rb * K + C) * 2u; }
    const size_t kstep = (size_t)(BK * 2);
    const size_t hstep = (size_t)HALF * K * 2;
    const size_t tstep = 2 * hstep;
    const unsigned ldsw = (unsigned)wid * 1024u;
    const int aoff = lds_byte(wr * 64 + fr, fq * 8), boff = lds_byte(wc * 32 + fr, fq * 8);
#define PG8_SA(b, h) (((b) * 2 + (h)) * HTB)
#define PG8_SB(b, h) ((4 + (b) * 2 + (h)) * HTB)
#define PG8_STAGE(bufoff, gbase, voff) do { _Pragma("unroll") for (int _i = 0; _i < 2; ++_i) \
        __builtin_amdgcn_global_load_lds((const unsigned*)((const char*)(gbase) + (voff)[_i]), (PG8_LAS unsigned*)(lds + (bufoff) + ldsw + _i * 8192), 16, 0, 0); } while (0)
#define PG8_LDA(dst, b, h) do { _Pragma("unroll") for (int m = 0; m < 4; ++m) _Pragma("unroll") for (int k = 0; k < 2; ++k) dst[m][k] = *(const PG8_LAS bf16x8*)(lds + PG8_SA(b, h) + aoff + m * 2048 + k * 1024); } while (0)
#define PG8_LDB(dst, b, h) do { _Pragma("unroll") for (int n = 0; n < 2; ++n) _Pragma("unroll") for (int k = 0; k < 2; ++k) dst[n][k] = *(const PG8_LAS bf16x8*)(lds + PG8_SB(b, h) + boff + n * 2048 + k * 1024); } while (0)
#define PG8_MMA(ai, bj, At, Bt) do { __builtin_amdgcn_s_setprio(1); _Pragma("unroll") for (int m = 0; m < 4; ++m) _Pragma("unroll") for (int n = 0; n < 2; ++n) _Pragma("unroll") for (int k = 0; k < 2; ++k) \
        acc[ai][bj][m][n] = __builtin_amdgcn_mfma_f32_16x16x32_bf16(Bt[n][k], At[m][k], acc[ai][bj][m][n], 0, 0, 0); __builtin_amdgcn_s_setprio(0); } while (0)
#define PG8_WAIT_V(n) asm volatile("s_waitcnt vmcnt(" #n ")" ::: "memory")
#define PG8_WAIT_L(n) asm volatile("s_waitcnt lgkmcnt(" #n ")" ::: "memory")
#define PG8_BAR __builtin_amdgcn_s_barrier()
#define PG8_SCHED __builtin_amdgcn_sched_barrier(0)
    Unit cur, nxt; int ui = 0;
    if (!S.next(0, cur)) return;
    f32x4 acc[2][2][4][2];
#pragma unroll
    for (int a = 0; a < 2; ++a)
#pragma unroll
        for (int b = 0; b < 2; ++b)
#pragma unroll
            for (int m = 0; m < 4; ++m)
#pragma unroll
                for (int n = 0; n < 2; ++n) acc[a][b][m][n] = (f32x4){0.f, 0.f, 0.f, 0.f};
    bf16x8 At[4][2], B0[2][2], B1[2][2];
    const char* cA = (const char*)g.A + (size_t)cur.pm * tstep; const char* cB = (const char*)g.Bt + (size_t)cur.pn * tstep;
    S.a_ready(cur);
    if constexpr (SP2) {
        PG8_STAGE(PG8_SB(0, 0), cB, voffB); PG8_STAGE(PG8_SB(0, 1), cB + hstep, voffB); PG8_STAGE(PG8_SA(0, 0), cA, voffA); PG8_STAGE(PG8_SA(0, 1), cA + hstep, voffA);
        if (wr == 1) PG8_BAR;
        PG8_WAIT_V(2); PG8_BAR;
        PG8_STAGE(PG8_SB(1, 0), cB + kstep, voffB); PG8_STAGE(PG8_SA(1, 0), cA + kstep, voffA); PG8_STAGE(PG8_SB(1, 1), cB + hstep + kstep, voffB);
        PG8_WAIT_V(6); PG8_BAR;
    } else {
        PG8_STAGE(PG8_SB(0, 0), cB, voffB); PG8_STAGE(PG8_SA(0, 0), cA, voffA); PG8_STAGE(PG8_SB(0, 1), cB + hstep, voffB); PG8_STAGE(PG8_SA(0, 1), cA + hstep, voffA);
        if (wr == 1) PG8_BAR;
        PG8_WAIT_V(4); PG8_BAR;
        PG8_STAGE(PG8_SB(1, 0), cB + kstep, voffB); PG8_STAGE(PG8_SA(1, 0), cA + kstep, voffA); PG8_STAGE(PG8_SB(1, 1), cB + hstep + kstep, voffB);
        PG8_WAIT_V(6); PG8_BAR;
    }
    for (;;) {
        const bool has_next = S.next(ui + 1, nxt);
        const char* nA = has_next ? (const char*)g.A + (size_t)nxt.pm * tstep : cA; const char* nB = has_next ? (const char*)g.Bt + (size_t)nxt.pn * tstep : cB;
        for (int t = 0; t < nt; t += 2) {
            const bool last = (t == nt - 2);
            const char* a1 = cA + (size_t)(t + 1) * kstep;
            const char* a2 = last ? nA : cA + (size_t)(t + 2) * kstep; const char* b2 = last ? nB : cB + (size_t)(t + 2) * kstep;
            const char* a3 = a2 + kstep; const char* b3 = b2 + kstep;
            if (last && has_next) S.a_ready(nxt);
            if constexpr (SP2) {
            PG8_LDB(B0, 0, 0); PG8_LDB(B1, 0, 1); PG8_SCHED; PG8_LDA(At, 0, 0); PG8_STAGE(PG8_SA(1, 1), a1 + hstep, voffA);
            PG8_WAIT_V(8); PG8_WAIT_L(0); PG8_BAR; PG8_MMA(0, 0, At, B0); PG8_MMA(0, 1, At, B1); PG8_BAR; PG8_SCHED;
            PG8_LDA(At, 0, 1); PG8_STAGE(PG8_SB(0, 0), b2, voffB); PG8_STAGE(PG8_SB(0, 1), b2 + hstep, voffB); PG8_STAGE(PG8_SA(0, 0), a2, voffA);
            PG8_WAIT_V(8); PG8_WAIT_L(0); PG8_BAR; PG8_MMA(1, 0, At, B0); PG8_MMA(1, 1, At, B1); PG8_BAR; PG8_SCHED;
            PG8_LDB(B0, 1, 0); PG8_LDB(B1, 1, 1); PG8_SCHED; PG8_LDA(At, 1, 0); PG8_STAGE(PG8_SA(0, 1), a2 + hstep, voffA);
            PG8_WAIT_V(8); PG8_WAIT_L(0); PG8_BAR; PG8_MMA(0, 0, At, B0); PG8_MMA(0, 1, At, B1); PG8_BAR; PG8_SCHED;
            PG8_LDA(At, 1, 1); PG8_STAGE(PG8_SB(1, 0), b3, voffB); PG8_STAGE(PG8_SB(1, 1), b3 + hstep, voffB); PG8_STAGE(PG8_SA(1, 0), a3, voffA);
            PG8_WAIT_V(8); PG8_WAIT_L(0); PG8_BAR; PG8_MMA(1, 0, At, B0); PG8_MMA(1, 1, At, B1); PG8_BAR; PG8_SCHED;
            } else {
            PG8_LDB(B0, 0, 0); PG8_SCHED; PG8_LDA(At, 0, 0); PG8_STAGE(PG8_SA(1, 1), a1 + hstep, voffA);
            PG8_WAIT_L(8); PG8_BAR; PG8_WAIT_L(0); PG8_MMA(0, 0, At, B0); PG8_BAR; PG8_SCHED;
            PG8_LDB(B1, 0, 1); PG8_STAGE(PG8_SB(0, 0), b2, voffB);
            PG8_BAR; PG8_WAIT_L(0); PG8_MMA(0, 1, At, B1); PG8_BAR;
            PG8_LDA(At, 0, 1); PG8_STAGE(PG8_SA(0, 0), a2, voffA);
            PG8_BAR; PG8_WAIT_L(0); PG8_MMA(1, 0, At, B0); PG8_BAR; PG8_SCHED;
            PG8_STAGE(PG8_SB(0, 1), b2 + hstep, voffB);
            PG8_WAIT_V(6); PG8_BAR; PG8_MMA(1, 1, At, B1); PG8_BAR;
            PG8_LDB(B0, 1, 0); PG8_SCHED; PG8_LDA(At, 1, 0); PG8_STAGE(PG8_SA(0, 1), a2 + hstep, voffA);
            PG8_WAIT_L(8); PG8_BAR; PG8_WAIT_L(0); PG8_MMA(0, 0, At, B0); PG8_BAR; PG8_SCHED;
            PG8_LDB(B1, 1, 1); PG8_STAGE(PG8_SB(1, 0), b3, voffB);
            PG8_BAR; PG8_WAIT_L(0); PG8_MMA(0, 1, At, B1); PG8_BAR;
            PG8_LDA(At, 1, 1); PG8_STAGE(PG8_SA(1, 0), a3, voffA);
            PG8_BAR; PG8_WAIT_L(0); PG8_MMA(1, 0, At, B0); PG8_BAR; PG8_SCHED;
            PG8_STAGE(PG8_SB(1, 1), b3 + hstep, voffB);
            PG8_WAIT_V(6); PG8_BAR; PG8_MMA(1, 1, At, B1); PG8_BAR;
            }
        }
        if constexpr (ALIGN_EPI) { if (wr == 0) PG8_BAR; }
        if constexpr (!Epi::AFTER_DRAIN) { E(acc, cur, wr, wc, fr, fq); S.done(cur); }
        if (!has_next) break;
#pragma unroll
        for (int a = 0; a < 2; ++a)
#pragma unroll
            for (int b = 0; b < 2; ++b)
#pragma unroll
                for (int m = 0; m < 4; ++m)
#pragma unroll
                    for (int n = 0; n < 2; ++n) acc[a][b][m][n] = (f32x4){0.f, 0.f, 0.f, 0.f};
        cur = nxt; cA = nA; cB = nB; ++ui;
        if constexpr (ALIGN_EPI) { if (wr == 1) PG8_BAR; }
    }
    PG8_WAIT_V(0);
    if constexpr (!ALIGN_EPI) { if (wr == 0) PG8_BAR; }
    PG8_BAR;
    if constexpr (Epi::AFTER_DRAIN) { E.fused(acc, cur, wr, wc, fr, fq, lds, wid, lane); S.done(cur); }
#undef PG8_SA
#undef PG8_SB
#undef PG8_STAGE
#undef PG8_LDA
#undef PG8_LDB
#undef PG8_MMA
#undef PG8_WAIT_V
#undef PG8_WAIT_L
#undef PG8_BAR
#undef PG8_SCHED
}
}
#define PG8_SP2 true
#define PG8_ALIGN true
namespace att {
using bf16 = __hip_bfloat16;
constexpr int D = 128, NW = 8, QBLK = 32, KVBLK = 64;
constexpr float SCALE = 0.088388347648318440f;
constexpr float THR = 8.f;
constexpr size_t SHM_V = KVBLK * D * 2, SHM_K = KVBLK * D * 2, SHM_ATTN = 2 * SHM_V + 2 * SHM_K + NW * 64 * 4;
using bf16x8 = __attribute__((ext_vector_type(8))) short;
using s16x4  = __attribute__((ext_vector_type(4))) short;
using f32x16 = __attribute__((ext_vector_type(16))) float;
using f32x8  = __attribute__((ext_vector_type(8))) float;
using u32x4  = __attribute__((ext_vector_type(4))) unsigned;
#define KSWZ(row, colB) ((row) * 256 + ((colB) ^ (((row) & 7) << 4)))
#define SBAR() __builtin_amdgcn_sched_barrier(0)
__device__ __forceinline__ int crow(int r, int hi) { return (r & 3) + 8 * (r >> 2) + 4 * hi; }
__device__ __forceinline__ unsigned cvtpk(float lo, float hi) {
  unsigned r; asm("v_cvt_pk_bf16_f32 %0, %1, %2" : "=v"(r) : "v"(lo), "v"(hi)); return r;
}
template <typename TIn> struct Stage;
template <> struct Stage<bf16>  { using T = bf16x8;
  __device__ static __forceinline__ T ld8(const bf16* p) { return *reinterpret_cast<const bf16x8*>(p); }
  __device__ static __forceinline__ bf16x8 tobf(T x) { return x; } };
template <> struct Stage<float> { using T = f32x8;
  __device__ static __forceinline__ T ld8(const float* p) { return *reinterpret_cast<const f32x8*>(p); }
  __device__ static __forceinline__ bf16x8 tobf(T x) {
    u32x4 w = {cvtpk(x[0], x[1]), cvtpk(x[2], x[3]), cvtpk(x[4], x[5]), cvtpk(x[6], x[7])}; return *reinterpret_cast<bf16x8*>(&w); } };

__device__ __forceinline__ void partialSM(f32x16& p0, f32x16& p1, float& m_reg, float& mn, float& alpha) {
  constexpr float C = SCALE * 1.4426950408889634f;
  float pmax = p0[0]; for (int r = 1; r < 16; ++r) pmax = fmaxf(pmax, p0[r]); for (int r = 0; r < 16; ++r) pmax = fmaxf(pmax, p1[r]);
  { auto rr = __builtin_amdgcn_permlane32_swap(__float_as_uint(pmax), __float_as_uint(pmax), false, false);
    pmax = fmaxf(__uint_as_float(rr[0]), __uint_as_float(rr[1])); }
  if (__builtin_expect(__all(pmax - m_reg <= THR / SCALE), 1)) { mn = m_reg; alpha = 1.f; }
  else { mn = fmaxf(m_reg, pmax); alpha = __builtin_amdgcn_exp2f((m_reg - mn) * C); m_reg = mn; }
  float mnC = -mn * C;
  for (int r = 0; r < 16; ++r) p0[r] = fmaf(p0[r], C, mnC); for (int r = 0; r < 16; ++r) p1[r] = fmaf(p1[r], C, mnC);
  for (int r = 0; r < 16; ++r) p0[r] = __builtin_amdgcn_exp2f(p0[r]);
}
__device__ __forceinline__ void finishSM(f32x16& p0, f32x16& p1, float alpha, float& l_reg, bf16x8& pa0, bf16x8& pa1, bf16x8& pa2, bf16x8& pa3) {
  for (int r = 0; r < 16; ++r) p1[r] = __builtin_amdgcn_exp2f(p1[r]);
  float ps = 0; for (int r = 0; r < 16; ++r) ps += p0[r]; for (int r = 0; r < 16; ++r) ps += p1[r];
  { auto rr = __builtin_amdgcn_permlane32_swap(__float_as_uint(ps), __float_as_uint(ps), false, false);
    ps = __uint_as_float(rr[0]) + __uint_as_float(rr[1]); }
  l_reg = l_reg * alpha + ps;
#define PK4(P, BASE, OUT) do { unsigned a0 = cvtpk(P[BASE + 0], P[BASE + 1]), a1 = cvtpk(P[BASE + 2], P[BASE + 3]);   \
    unsigned b0 = cvtpk(P[BASE + 4], P[BASE + 5]), b1 = cvtpk(P[BASE + 6], P[BASE + 7]);                              \
    u32x4 w = {a0, a1, b0, b1}; OUT = *reinterpret_cast<bf16x8*>(&w); } while (0)
  PK4(p0, 0, pa0); PK4(p0, 8, pa1); PK4(p1, 0, pa2); PK4(p1, 8, pa3);
#undef PK4
}
__device__ __forceinline__ void qkt(f32x16& p0, f32x16& p1, const bf16* Ks, const bf16x8* qr, int r32, int hi) {
  p0 = f32x16{}; p1 = f32x16{};
  for (int d0 = 0; d0 < 8; ++d0) { int cb = (d0 * 16 + hi * 8) * 2;
    bf16x8 b0 = *reinterpret_cast<const bf16x8*>((const char*)Ks + KSWZ(r32, cb));
    bf16x8 b1 = *reinterpret_cast<const bf16x8*>((const char*)Ks + KSWZ(32 + r32, cb));
    p0 = __builtin_amdgcn_mfma_f32_32x32x16_bf16(b0, qr[d0], p0, 0, 0, 0);
    p1 = __builtin_amdgcn_mfma_f32_32x32x16_bf16(b1, qr[d0], p1, 0, 0, 0); }
}
__device__ __forceinline__ int v_st(int k, int c) { const int kk = (k & ~0xC) | ((k & 4) << 1) | ((k & 8) >> 1); return ((kk >> 3) * 4 + (c >> 5)) * 512 + ((kk & 7) * 32 + (c & 31)) * 2; }
__device__ __forceinline__ int v_rd_base(int lane) { return ((lane & 3) << 3) | (((lane >> 2) & 3) << 6) | (((lane >> 4) & 1) << 5) | (((lane >> 5) & 1) << 8); }
constexpr int v_rd_off(int d0, int ks, int half) { return d0 * 512 + ks * 4096 + half * 2048; }
template <int OFF> __device__ __forceinline__ s16x4 tr_read(int vb) {
  s16x4 r; asm volatile("ds_read_b64_tr_b16 %0, %1 offset:%2" : "=&v"(r) : "v"(vb), "i"(OFF) : "memory"); return r;
}
template <int D0> __device__ __forceinline__ void pv_one(f32x16& od, int vb, bf16x8 pa0, bf16x8 pa1, bf16x8 pa2, bf16x8 pa3) {
  const s16x4 l0 = tr_read<v_rd_off(D0, 0, 0)>(vb), h0 = tr_read<v_rd_off(D0, 0, 1)>(vb), l1 = tr_read<v_rd_off(D0, 1, 0)>(vb), h1 = tr_read<v_rd_off(D0, 1, 1)>(vb);
  const s16x4 l2 = tr_read<v_rd_off(D0, 2, 0)>(vb), h2 = tr_read<v_rd_off(D0, 2, 1)>(vb), l3 = tr_read<v_rd_off(D0, 3, 0)>(vb), h3 = tr_read<v_rd_off(D0, 3, 1)>(vb);
  asm volatile("s_waitcnt lgkmcnt(0)" ::: "memory"); SBAR();
#define PK(L, H) (bf16x8){L[0], L[1], L[2], L[3], H[0], H[1], H[2], H[3]}
  od = __builtin_amdgcn_mfma_f32_32x32x16_bf16(pa0, PK(l0, h0), od, 0, 0, 0);
  od = __builtin_amdgcn_mfma_f32_32x32x16_bf16(pa1, PK(l1, h1), od, 0, 0, 0);
  od = __builtin_amdgcn_mfma_f32_32x32x16_bf16(pa2, PK(l2, h2), od, 0, 0, 0);
  od = __builtin_amdgcn_mfma_f32_32x32x16_bf16(pa3, PK(l3, h3), od, 0, 0, 0);
#undef PK
}
struct VFrag { s16x4 l0, h0, l1, h1, l2, h2, l3, h3; };
template <int D0> __device__ __forceinline__ void pv_rd(VFrag& f, int vb) {
  f.l0 = tr_read<v_rd_off(D0, 0, 0)>(vb); f.h0 = tr_read<v_rd_off(D0, 0, 1)>(vb); f.l1 = tr_read<v_rd_off(D0, 1, 0)>(vb); f.h1 = tr_read<v_rd_off(D0, 1, 1)>(vb);
  f.l2 = tr_read<v_rd_off(D0, 2, 0)>(vb); f.h2 = tr_read<v_rd_off(D0, 2, 1)>(vb); f.l3 = tr_read<v_rd_off(D0, 3, 0)>(vb); f.h3 = tr_read<v_rd_off(D0, 3, 1)>(vb);
}
__device__ __forceinline__ void pv_mm(f32x16& od, const VFrag& f, bf16x8 pa0, bf16x8 pa1, bf16x8 pa2, bf16x8 pa3) {
#define PK(L, H) (bf16x8){L[0], L[1], L[2], L[3], H[0], H[1], H[2], H[3]}
  od = __builtin_amdgcn_mfma_f32_32x32x16_bf16(pa0, PK(f.l0, f.h0), od, 0, 0, 0);
  od = __builtin_amdgcn_mfma_f32_32x32x16_bf16(pa1, PK(f.l1, f.h1), od, 0, 0, 0);
  od = __builtin_amdgcn_mfma_f32_32x32x16_bf16(pa2, PK(f.l2, f.h2), od, 0, 0, 0);
  od = __builtin_amdgcn_mfma_f32_32x32x16_bf16(pa3, PK(f.l3, f.h3), od, 0, 0, 0);
#undef PK
}
#define PV_WAIT(n) do { asm volatile("s_waitcnt lgkmcnt(" #n ")" ::: "memory"); SBAR(); } while (0)
__device__ __forceinline__ void pv_d0(f32x16* o, int vb, bf16x8 pa0, bf16x8 pa1, bf16x8 pa2, bf16x8 pa3) {
#if MK_PVPIPE
  VFrag fa, fb;
  pv_rd<0>(fa, vb); pv_rd<1>(fb, vb);
  PV_WAIT(8); pv_mm(o[0], fa, pa0, pa1, pa2, pa3); SBAR();
  pv_rd<2>(fa, vb);
  PV_WAIT(8); pv_mm(o[1], fb, pa0, pa1, pa2, pa3); SBAR();
  pv_rd<3>(fb, vb);
  PV_WAIT(8); pv_mm(o[2], fa, pa0, pa1, pa2, pa3); SBAR();
  PV_WAIT(0); pv_mm(o[3], fb, pa0, pa1, pa2, pa3);
#else
  pv_one<0>(o[0], vb, pa0, pa1, pa2, pa3); pv_one<1>(o[1], vb, pa0, pa1, pa2, pa3); pv_one<2>(o[2], vb, pa0, pa1, pa2, pa3); pv_one<3>(o[3], vb, pa0, pa1, pa2, pa3);
#endif
}
constexpr int crow0(int r) { return (r & 3) + 8 * (r >> 2); }
constexpr float LOG2E = 1.4426950408889634f;
__device__ __forceinline__ void partialSM_neg(f32x16& p0, f32x16& p1, float& m_reg, f32x16& negm, float& alpha, int bounded) {
  if (bounded) {
    alpha = 1.f;
#pragma unroll
    for (int r = 0; r < 16; ++r) p0[r] = __builtin_amdgcn_exp2f(p0[r]);
    return;
  }
  float pmax = p0[0];
#pragma unroll
  for (int r = 1; r < 16; ++r) pmax = fmaxf(pmax, p0[r]);
#pragma unroll
  for (int r = 0; r < 16; ++r) pmax = fmaxf(pmax, p1[r]);
  { auto rr = __builtin_amdgcn_permlane32_swap(__float_as_uint(pmax), __float_as_uint(pmax), false, false);
    pmax = fmaxf(__uint_as_float(rr[0]), __uint_as_float(rr[1])); }
  if (__builtin_expect(__all(pmax <= THR), 1)) { alpha = 1.f; }
  else { const float dl = fmaxf(pmax, 0.f); m_reg += dl; alpha = __builtin_amdgcn_exp2f(-dl);
#pragma unroll
    for (int r = 0; r < 16; ++r) { p0[r] -= dl; p1[r] -= dl; negm[r] = -m_reg; } }
#pragma unroll
  for (int r = 0; r < 16; ++r) p0[r] = __builtin_amdgcn_exp2f(p0[r]);
}
__device__ __forceinline__ void partialSM_dil(f32x16& p0, f32x16& p1, float& m_reg, float& mn, float& alpha, float dq, float dlo, float dhi, float nslopeC) {
  constexpr float C = SCALE * LOG2E;
#pragma unroll
  for (int r = 0; r < 16; ++r) {
    const float d0 = dq + (float)crow0(r), d1 = d0 + 32.f;
    const float t0 = fmaf(p0[r], C, nslopeC * fabsf(d0)), t1 = fmaf(p1[r], C, nslopeC * fabsf(d1));
    p0[r] = (d0 >= dlo && d0 <= dhi) ? t0 : -1e30f;
    p1[r] = (d1 >= dlo && d1 <= dhi) ? t1 : -1e30f;
  }
  float pmax = p0[0];
#pragma unroll
  for (int r = 1; r < 16; ++r) pmax = fmaxf(pmax, p0[r]);
#pragma unroll
  for (int r = 0; r < 16; ++r) pmax = fmaxf(pmax, p1[r]);
  { auto rr = __builtin_amdgcn_permlane32_swap(__float_as_uint(pmax), __float_as_uint(pmax), false, false);
    pmax = fmaxf(__uint_as_float(rr[0]), __uint_as_float(rr[1])); }
  if (__builtin_expect(__all(pmax - m_reg <= THR * LOG2E), 1)) { mn = m_reg; alpha = 1.f; }
  else { mn = fmaxf(m_reg, pmax); alpha = __builtin_amdgcn_exp2f(m_reg - mn); m_reg = mn; }
#pragma unroll
  for (int r = 0; r < 16; ++r) { p0[r] = p0[r] - mn; p1[r] = p1[r] - mn; }
#pragma unroll
  for (int r = 0; r < 16; ++r) p0[r] = __builtin_amdgcn_exp2f(p0[r]);
}

template <bool DIL>
__device__ __forceinline__ void attn_body(const bf16* __restrict__ Qb, const bf16* __restrict__ Kh, const bf16* __restrict__ Vh, long qs, long ks,
                                          bf16* __restrict__ Ob, long os, float* __restrict__ lse_o, int lse_s, int i0, int nsub, float nslopeC, int seq, char* lds) {
  typedef __attribute__((address_space(3))) unsigned lds_u32;
  using St = Stage<bf16>;
  const int tid = otid(), wid = __builtin_amdgcn_readfirstlane(tid >> 6), lane = tid & 63, r32 = lane & 31, hi = lane >> 5;
  char* V_lds = lds + 4 * SHM_K; char* K_lds = lds;
  float* ws = (float*)(lds + 4 * SHM_K + 4 * SHM_V) + wid * 64; float* li_l = ws; float* al_l = ws + 32;
  float m_reg = -1e30f, l_reg = 0; f32x16 o[4] = {}; bf16x8 qr[8];
  const bf16* Qw = Qb + (long)(wid * QBLK + r32) * qs + hi * 8;
#pragma unroll
  for (int d0 = 0; d0 < 8; ++d0) qr[d0] = St::ld8(Qw + d0 * 16);
  const int vb0 = (int)(uintptr_t)V_lds + v_rd_base(lane);
  const int kb = DIL ? i0 - 64 : 0;
#define KROW(k) (DIL ? (long)min(max(kb + (k), 0), nsub - 1) : (long)(k))
  int krow[2], kcol[2], vrow[2], vcol[2];
#pragma unroll
  for (int i = 0; i < 2; ++i) { const int pc = 2 * wid + i;
    krow[i] = pc * 4 + (lane >> 4); kcol[i] = (((lane & 15) ^ (krow[i] & 7)) << 3);
    const int sub = pc * 2 + (lane >> 5), kk = ((sub >> 2) << 3) + ((lane & 31) >> 2);
    vrow[i] = kk; vcol[i] = ((sub & 3) << 5) + ((lane & 3) << 3); }
  unsigned kdo[2], vdo[2];
#pragma unroll
  for (int i = 0; i < 2; ++i) { kdo[i] = (unsigned)(krow[i] * (int)ks + kcol[i]); vdo[i] = (unsigned)(vrow[i] * (int)ks + vcol[i]); }
#define DMA(t, buf) do { if constexpr (DIL) { _Pragma("unroll") for (int i_ = 0; i_ < 2; ++i_) { \
      __builtin_amdgcn_global_load_lds((const unsigned*)(Kh + KROW((t) * KVBLK + krow[i_]) * ks + kcol[i_]), (lds_u32*)(K_lds + (buf) * SHM_K + (2 * wid + i_) * 1024), 16, 0, 0); \
      __builtin_amdgcn_global_load_lds((const unsigned*)(Vh + KROW((t) * KVBLK + vrow[i_]) * ks + vcol[i_]), (lds_u32*)(V_lds + (buf) * SHM_V + (2 * wid + i_) * 1024), 16, 0, 0); } } \
    else { const bf16* Kt_ = Kh + (long)(t) * (KVBLK * ks); const bf16* Vt_ = Vh + (long)(t) * (KVBLK * ks); _Pragma("unroll") for (int i_ = 0; i_ < 2; ++i_) { \
      __builtin_amdgcn_global_load_lds((const unsigned*)(Kt_ + kdo[i_]), (lds_u32*)(K_lds + (buf) * SHM_K + (2 * wid + i_) * 1024), 16, 0, 0); \
      __builtin_amdgcn_global_load_lds((const unsigned*)(Vt_ + vdo[i_]), (lds_u32*)(V_lds + (buf) * SHM_V + (2 * wid + i_) * 1024), 16, 0, 0); } } } while (0)
#define ENDSTEP(j) do { if ((j) + 2 < NT) asm volatile("s_waitcnt vmcnt(4) lgkmcnt(0)\n\ts_barrier" ::: "memory"); else asm volatile("s_waitcnt vmcnt(0) lgkmcnt(0)\n\ts_barrier" ::: "memory"); } while (0)
#define RESC(a) do { if (__any((a) < 1.f)) { if (hi == 0) al_l[r32] = (a); asm volatile("s_waitcnt lgkmcnt(0)" ::: "memory"); \
    for (int d = 0; d < 4; ++d) for (int r = 0; r < 16; ++r) o[d][r] *= al_l[crow(r, hi)]; } } while (0)
#define PSM(P0, P1, MN, AL, jt) do { if constexpr (DIL) { const int t_ = otid(), iq_ = (t_ >> 6) * QBLK + (t_ & 31), hi_ = (t_ >> 5) & 1; \
      partialSM_dil(P0, P1, m_reg, MN, AL, (float)(-64 - iq_ + 4 * hi_ + 64 * (jt)), fmaxf(-64.f, (float)(-(i0 + iq_))), fminf(64.f, (float)(nsub - 1 - (i0 + iq_))), nslopeC); } \
    else partialSM(P0, P1, m_reg, MN, AL); } while (0)
#if MK_SGB
#define SGB_A() do { __builtin_amdgcn_sched_group_barrier(0x100, 4, 0); \
    _Pragma("unroll") for (int g_ = 0; g_ < 12; ++g_) { __builtin_amdgcn_sched_group_barrier(0x008, 1, 0); __builtin_amdgcn_sched_group_barrier(0x100, 1, 0); __builtin_amdgcn_sched_group_barrier(0x002, 6, 0); } \
    _Pragma("unroll") for (int g_ = 0; g_ < 4; ++g_) { __builtin_amdgcn_sched_group_barrier(0x008, 1, 0); __builtin_amdgcn_sched_group_barrier(0x002, 6, 0); } } while (0)
#else
#define SGB_A() do {} while (0)
#endif
#define KBUF(j) ((const bf16*)(K_lds + ((j) & 3) * SHM_K))
#define VBUF(j) (vb0 + ((j) & 3) * (int)SHM_V)
  f32x16 pA0, pA1, pB0, pB1; float mnA, mnB, alA, alB; bf16x8 pa0, pa1, pa2, pa3; const int NT = DIL ? 6 : seq / KVBLK;
  DMA(0, 0); DMA(1, 1);
  if constexpr (!DIL && MK_PP) { DMA(2, 2); asm volatile("s_waitcnt vmcnt(8)\n\ts_barrier" ::: "memory"); }
  else asm volatile("s_waitcnt vmcnt(4)\n\ts_barrier" ::: "memory");
  struct KFrag { bf16x8 a, b; };
  int koff[4];
#pragma unroll
  for (int d0 = 0; d0 < 4; ++d0) koff[d0] = KSWZ(r32, (d0 * 16 + hi * 8) * 2);
  const int kbase0 = (int)(uintptr_t)K_lds;
#define KRD(f, d0, kb) asm volatile("ds_read_b128 %0, %2 offset:%3\n\tds_read_b128 %1, %2 offset:%4" : "=&v"(f.a), "=&v"(f.b) : "v"((kb) + koff[(d0) & 3]), "i"(((d0) >> 2) * 128), "i"(((d0) >> 2) * 128 + 8192) : "memory")
#define QMM(f, d0) do { pA0 = __builtin_amdgcn_mfma_f32_32x32x16_bf16(f.a, qr[d0], pA0, 0, 0, 0); pA1 = __builtin_amdgcn_mfma_f32_32x32x16_bf16(f.b, qr[d0], pA1, 0, 0, 0); } while (0)
#define LW(n) do { asm volatile("s_waitcnt lgkmcnt(" #n ")" ::: "memory"); SBAR(); } while (0)
  if constexpr (DIL) {
    const int rlo = wid >> 1;
    for (int j = 0; j < NT; ++j) {
      if (j + 2 < NT) DMA(j + 2, (j + 2) & 3);
      if (j >= rlo && j <= rlo + 2) {
        SBAR();
        { const int kb_ = kbase0 + (j & 3) * (int)SHM_K; KFrag k0_, k1_, k2_;
          KRD(k0_, 0, kb_); KRD(k1_, 1, kb_); KRD(k2_, 2, kb_); pA0 = f32x16{}; pA1 = f32x16{};
          LW(4); QMM(k0_, 0); SBAR(); KRD(k0_, 3, kb_);
          LW(4); QMM(k1_, 1); SBAR(); KRD(k1_, 4, kb_);
          LW(4); QMM(k2_, 2); SBAR(); KRD(k2_, 5, kb_);
          LW(4); QMM(k0_, 3); SBAR(); KRD(k0_, 6, kb_);
          LW(4); QMM(k1_, 4); SBAR(); KRD(k1_, 7, kb_);
          LW(4); QMM(k2_, 5); SBAR();
          LW(2); QMM(k0_, 6); SBAR();
          LW(0); QMM(k1_, 7); SBAR(); }
        PSM(pA0, pA1, mnA, alA, j); RESC(alA);
        finishSM(pA0, pA1, alA, l_reg, pa0, pa1, pa2, pa3); SBAR();
        pv_d0(o, VBUF(j), pa0, pa1, pa2, pa3);
      }
      if (j + 1 < NT) ENDSTEP(j);
    }
  } else if constexpr (MK_PP) {
    const bool grpB = wid >= 4;
#if MK_NEGM
    m_reg = 0.f; f32x16 negm = f32x16{};
#endif
#define PP_BAR(VM) do { if (VM) { asm volatile("s_waitcnt vmcnt(4) lgkmcnt(0)\n\ts_barrier" ::: "memory"); } else { asm volatile("s_waitcnt vmcnt(0) lgkmcnt(0)\n\ts_barrier" ::: "memory"); } } while (0)
#define PP_BAR_PLAIN() asm volatile("s_waitcnt lgkmcnt(0)\n\ts_barrier" ::: "memory")
    if (grpB) PP_BAR_PLAIN();
    qkt(pA0, pA1, KBUF(0), qr, r32, hi);
    if (grpB) PP_BAR(2 < NT); else PP_BAR_PLAIN();
    for (int t = 0; t < NT; ++t) {
      if (grpB && t + 3 < NT) DMA(t + 3, (t + 3) & 3);
#if MK_NEGM
      partialSM_neg(pA0, pA1, m_reg, negm, alA, i0); if (!i0) RESC(alA);
#else
      PSM(pA0, pA1, mnA, alA, t); RESC(alA);
#endif
      finishSM(pA0, pA1, alA, l_reg, pa0, pa1, pa2, pa3);
#if MK_PROBE_V
      { float dm_ = alA;
#pragma unroll
        for (int q_ = 0; q_ < 32; ++q_) asm volatile("v_add_f32 %0, %0, %0" : "+v"(dm_));
        if (dm_ == 123.456f) l_reg += 1.f; }
#endif
      if (!(MK_PREB && t + 1 < NT)) { if (!grpB) PP_BAR(t + 2 < NT); else PP_BAR_PLAIN(); }
      else if (!grpB) PP_BAR(t + 2 < NT);
      if (!grpB && t + 3 < NT) DMA(t + 3, (t + 3) & 3);
      SBAR();
      if (t + 1 < NT) {
        const int kb_ = kbase0 + ((t + 1) & 3) * (int)SHM_K, vb_ = VBUF(t);
        KFrag k0_, k1_; VFrag fa_, fb_;
        KRD(k0_, 0, kb_); KRD(k1_, 1, kb_); pv_rd<0>(fa_, vb_);
        if (MK_PREB && grpB) asm volatile("s_barrier" ::: "memory");
#if MK_NEGM
        LW(10); pA0 = __builtin_amdgcn_mfma_f32_32x32x16_bf16(k0_.a, qr[0], negm, 0, 0, 0); pA1 = __builtin_amdgcn_mfma_f32_32x32x16_bf16(k0_.b, qr[0], negm, 0, 0, 0); SBAR(); KRD(k0_, 2, kb_);
#else
        pA0 = f32x16{}; pA1 = f32x16{};
        LW(10); QMM(k0_, 0); SBAR(); KRD(k0_, 2, kb_);
#endif
        LW(10); QMM(k1_, 1); SBAR(); KRD(k1_, 3, kb_);
        LW(4);  pv_mm(o[0], fa_, pa0, pa1, pa2, pa3); SBAR(); pv_rd<1>(fb_, vb_);
        LW(10); QMM(k0_, 2); SBAR(); KRD(k0_, 4, kb_);
        LW(10); QMM(k1_, 3); SBAR(); KRD(k1_, 5, kb_);
        LW(4);  pv_mm(o[1], fb_, pa0, pa1, pa2, pa3); SBAR(); pv_rd<2>(fa_, vb_);
        LW(10); QMM(k0_, 4); SBAR(); KRD(k0_, 6, kb_);
        LW(10); QMM(k1_, 5); SBAR(); KRD(k1_, 7, kb_);
        LW(4);  pv_mm(o[2], fa_, pa0, pa1, pa2, pa3); SBAR(); pv_rd<3>(fb_, vb_);
        LW(10); QMM(k0_, 6); SBAR();
        LW(8);  QMM(k1_, 7); SBAR();
        LW(0);  pv_mm(o[3], fb_, pa0, pa1, pa2, pa3);
      } else pv_d0(o, VBUF(t), pa0, pa1, pa2, pa3);
      if (t + 1 < NT) { if (grpB) PP_BAR(t + 3 < NT); else PP_BAR_PLAIN(); }
    }
    if (!grpB) PP_BAR_PLAIN();
#undef PP_BAR
#undef PP_BAR_PLAIN
#undef KRD
#undef QMM
#undef LW
  } else {
  if (2 < NT) DMA(2, 2);
  qkt(pA0, pA1, KBUF(0), qr, r32, hi); PSM(pA0, pA1, mnA, alA, 0);
  ENDSTEP(0);
  for (int j = 1; j + 1 < NT; j += 2) {
    if (j + 2 < NT) DMA(j + 2, (j + 2) & 3);
    SBAR(); qkt(pB0, pB1, KBUF(j), qr, r32, hi);
    finishSM(pA0, pA1, alA, l_reg, pa0, pa1, pa2, pa3); SGB_A(); SBAR();
    pv_d0(o, VBUF(j - 1), pa0, pa1, pa2, pa3); PSM(pB0, pB1, mnB, alB, j);
    RESC(alB); ENDSTEP(j);
    if (j + 3 < NT) DMA(j + 3, (j + 3) & 3);
    SBAR(); qkt(pA0, pA1, KBUF(j + 1), qr, r32, hi);
    finishSM(pB0, pB1, alB, l_reg, pa0, pa1, pa2, pa3); SGB_A(); SBAR();
    pv_d0(o, VBUF(j), pa0, pa1, pa2, pa3); PSM(pA0, pA1, mnA, alA, j + 1);
    RESC(alA); ENDSTEP(j + 1);
  }
  SBAR(); qkt(pB0, pB1, KBUF(NT - 1), qr, r32, hi);
  finishSM(pA0, pA1, alA, l_reg, pa0, pa1, pa2, pa3); SBAR();
  pv_d0(o, VBUF(NT - 2), pa0, pa1, pa2, pa3); PSM(pB0, pB1, mnB, alB, NT - 1);
  RESC(alB);
  finishSM(pB0, pB1, alB, l_reg, pa0, pa1, pa2, pa3); SBAR();
  pv_d0(o, VBUF(NT - 1), pa0, pa1, pa2, pa3);
  }
  if (hi == 0) li_l[r32] = l_reg; asm volatile("s_waitcnt lgkmcnt(0)" ::: "memory");
  if constexpr (DIL) { if (hi == 0) lse_o[(long)(wid * QBLK + r32) * lse_s] = m_reg + __log2f(l_reg); }
  float rli[16];
#pragma unroll
  for (int r = 0; r < 16; ++r) rli[r] = __builtin_amdgcn_rcpf(li_l[crow(r, hi)]);
  bf16* Ow = Ob + (long)(wid * QBLK) * os;
#if MK_OSTAGE
  { char* stg = DIL ? ((wid < 4 ? K_lds : V_lds) + 2 * SHM_K + (wid & 3) * 8192) : (K_lds + wid * 8192);
#pragma unroll
    for (int r = 0; r < 16; ++r) { const int orow = crow(r, hi);
#pragma unroll
      for (int d0 = 0; d0 < 4; ++d0) *(bf16*)(stg + orow * 256 + (d0 * 32 + r32) * 2) = __float2bfloat16(o[d0][r] * rli[r]); }
    asm volatile("s_waitcnt lgkmcnt(0)" ::: "memory");
#pragma unroll
    for (int i = 0; i < 8; ++i) { const int row = i * 4 + (lane >> 4), ch = lane & 15;
      const u32x4 v = *(const u32x4*)(stg + row * 256 + ch * 16);
      *(u32x4*)(Ow + (long)row * os + ch * 8) = v; } }
#else
#pragma unroll
  for (int r = 0; r < 16; ++r) { const int orow = crow(r, hi);
#pragma unroll
    for (int d0 = 0; d0 < 4; ++d0) Ow[(long)orow * os + d0 * 32 + r32] = __float2bfloat16(o[d0][r] * rli[r]); }
#endif
  asm volatile("s_waitcnt lgkmcnt(0)\n\ts_barrier" ::: "memory");
#undef KROW
#undef DMA
#undef ENDSTEP
#undef RESC
#undef PSM
#undef KBUF
#undef SGB_A
#undef VBUF
}
}

#define GAS __attribute__((address_space(1)))
#define LAS __attribute__((address_space(3)))
typedef unsigned short bf16_t;
typedef unsigned v4u __attribute__((ext_vector_type(4)));
typedef unsigned v2u __attribute__((ext_vector_type(2)));
typedef float f32x4 __attribute__((ext_vector_type(4)));
#define LDS_WAIT() asm volatile("s_waitcnt lgkmcnt(0)" ::: "memory")

constexpr size_t MiB = 1u << 20;
constexpr size_t WS_W1T = 0;
constexpr size_t WS_W2T = 104 * MiB;
constexpr size_t WS_H = 136 * MiB;
constexpr size_t WS_PROJ = 200 * MiB;
constexpr size_t WS_YA = 408 * MiB;
constexpr size_t WS_YB = 440 * MiB;
constexpr size_t WS_LSE = 536 * MiB;
constexpr size_t WS_ROPE = 538 * MiB;
constexpr size_t WS_XB = 540 * MiB;
constexpr size_t WS_ROWSQ = 604 * MiB;
constexpr size_t WS_END = 616 * MiB;
static_assert((size_t)DEPTH * DIN * DM * 2 <= WS_W2T - WS_W1T && (size_t)M * DIN * 2 <= WS_YA - WS_PROJ && (size_t)3 * M * DB * 2 <= WS_LSE - WS_YB, "ws map");
constexpr int LDS_BYTES = 147456;
constexpr int N_PHASES = 2 + 5 * DEPTH;

__device__ __forceinline__ unsigned f2bf(float f) { unsigned u = __builtin_bit_cast(unsigned, f); return (u + 0x7fffu + ((u >> 16) & 1u)) >> 16; }
__device__ __forceinline__ unsigned pk2(float lo, float hi) { return f2bf(lo) | (f2bf(hi) << 16); }
__device__ __forceinline__ float bflo(unsigned w) { return __uint_as_float(w << 16); }
__device__ __forceinline__ float bfhi(unsigned w) { return __uint_as_float(w & 0xffff0000u); }
__device__ __forceinline__ float wave_sum(float v) {
#pragma unroll
    for (int o = 1; o < 64; o <<= 1) v += __shfl_xor(v, o);
    return v;
}

__device__ const float INV_FREQ[32] = {1.000000000e+00f, 7.498942614e-01f, 5.623413324e-01f, 4.216965139e-01f, 3.162277639e-01f, 2.371373773e-01f, 1.778279394e-01f, 1.333521307e-01f,
    1.000000015e-01f, 7.498941571e-02f, 5.623413250e-02f, 4.216965288e-02f, 3.162277490e-02f, 2.371373773e-02f, 1.778279431e-02f, 1.333521493e-02f,
    9.999999776e-03f, 7.498941850e-03f, 5.623413250e-03f, 4.216964822e-03f, 3.162277630e-03f, 2.371373586e-03f, 1.778279431e-03f, 1.333521446e-03f,
    1.000000047e-03f, 7.498942432e-04f, 5.623413017e-04f, 4.216965172e-04f, 3.162277571e-04f, 2.371373703e-04f, 1.778279402e-04f, 1.333521504e-04f};

__device__ __forceinline__ void sincos_acc(float a, float& s, float& c) {
    const double x = (double)a, kd = __builtin_rint(x * 0.63661977236758134308);
    const int k = (int)kd; const double r = x - kd * 1.57079632679489661923, r2 = r * r;
    const double sp = r * (1.0 + r2 * (-1.0 / 6 + r2 * (1.0 / 120 + r2 * (-1.0 / 5040 + r2 * (1.0 / 362880 + r2 * (-1.0 / 39916800 + r2 * (1.0 / 6227020800.0)))))));
    const double cp = 1.0 + r2 * (-0.5 + r2 * (1.0 / 24 + r2 * (-1.0 / 720 + r2 * (1.0 / 40320 + r2 * (-1.0 / 3628800 + r2 * (1.0 / 479001600.0 + r2 * (-1.0 / 87178291200.0)))))));
    const int q = k & 3;
    const double sv = (q == 0) ? sp : (q == 1) ? cp : (q == 2) ? -sp : -cp, cv = (q == 0) ? cp : (q == 1) ? -sp : (q == 2) ? -cp : sp;
    s = (float)sv; c = (float)cv;
}

__device__ __forceinline__ void p0_transpose_item(const float* W, int K, int N, bf16_t* WT, LAS float* scr, int item, int lane, const float* kscale) {
    const int nblk = N / 32, kb = item / nblk, nb = item % nblk, k0 = 64 * kb, n0 = 32 * nb;
#pragma unroll 8
    for (int i = 0; i < 32; ++i) { const int kk = 2 * i + (lane >> 5); scr[kk * 33 + (lane & 31)] = W[(size_t)(k0 + kk) * N + n0 + (lane & 31)] * (kscale ? kscale[k0 + kk] : 1.0f); }
    LDS_WAIT(); asm volatile("" ::: "memory");
    const int c = lane & 7;
#pragma unroll
    for (int j = 0; j < 4; ++j) { const int n = (lane >> 3) + 8 * j; const LAS float* s = scr + (8 * c) * 33 + n;
        v4u o; o.x = pk2(s[0 * 33], s[1 * 33]); o.y = pk2(s[2 * 33], s[3 * 33]); o.z = pk2(s[4 * 33], s[5 * 33]); o.w = pk2(s[6 * 33], s[7 * 33]);
        *(v4u*)(WT + (size_t)(n0 + n) * K + k0 + 8 * c) = o; }
    LDS_WAIT(); asm volatile("" ::: "memory");
}

#define XB_TMO      128
#define XB_XCNT(j)  (256  + 64 * (j))
#define XB_XSUB(j)  (1280 + 64 * (j))
#define XB_XGEN(j)  (2304 + 64 * (j))
#define XB_TOP      3328
#define XB_TOPGEN   3392
#define XCD_BAR_WORDS 3456
#define XB_SPIN_CAP (1u << 18)

__device__ __forceinline__ unsigned xb_ld(unsigned* p)              { return __hip_atomic_load(p, __ATOMIC_RELAXED, __HIP_MEMORY_SCOPE_AGENT); }
__device__ __forceinline__ unsigned xb_add(unsigned* p, unsigned v) { return __hip_atomic_fetch_add(p, v, __ATOMIC_RELAXED, __HIP_MEMORY_SCOPE_AGENT); }
__device__ __forceinline__ unsigned xb_xcc_id() { return (unsigned)__builtin_amdgcn_s_getreg((3 << 11) | 20) & 0xFu; }
#define XB_SPIN(cond, bar) do { unsigned _sp = 0; while (cond) { __builtin_amdgcn_s_sleep(1); \
    if ((++_sp & 255u) == 0u) { if (xb_ld(&(bar)[XB_TMO])) break; if (_sp > XB_SPIN_CAP) { atomicAdd(&(bar)[XB_TMO], 1u); break; } } } } while (0)

struct XcdBarrier {
    unsigned* bar; unsigned x;
    volatile LAS unsigned* st;
};

__device__ __forceinline__ XcdBarrier xcd_barrier_post(unsigned* bar, volatile LAS unsigned* st) {
    XcdBarrier b; b.bar = bar; b.x = xb_xcc_id(); b.st = st;
    if (threadIdx.x == 0) (void)xb_add(&bar[XB_XCNT(b.x)], 1u);
    return b;
}
__device__ __forceinline__ void xcd_barrier_complete(unsigned* bar, unsigned x, unsigned& nloc, unsigned& nx) {
    const unsigned G = gridDim.x * gridDim.y * gridDim.z;
    unsigned sum, cnt, mine, sp = 0u;
    for (;;) {
        sum = 0u; cnt = 0u; mine = 0u;
#pragma unroll
        for (unsigned j = 0; j < 16; ++j) { const unsigned c = xb_ld(&bar[XB_XCNT(j)]); sum += c; cnt += (c > 0u) ? 1u : 0u; mine = (j == x) ? c : mine; }
        if (sum == G) break;
        __builtin_amdgcn_s_sleep(1);
        if ((++sp & 255u) == 0u) { if (xb_ld(&bar[XB_TMO])) break; if (sp > XB_SPIN_CAP) { atomicAdd(&bar[XB_TMO], 1u); break; } }
    }
    nloc = mine > 0u ? mine : 1u; nx = cnt > 0u ? cnt : 1u;
}

__device__ __forceinline__ void xcd_barrier(const XcdBarrier& b) {
    asm volatile("s_waitcnt vmcnt(0)" ::: "memory");
    __syncthreads();
    if (threadIdx.x == 0) {
        unsigned* bar = b.bar;
        __builtin_amdgcn_s_waitcnt(0);
        unsigned nloc = b.st[0], nx = b.st[1];
        if (nloc == 0u) { xcd_barrier_complete(bar, b.x, nloc, nx); b.st[0] = nloc; b.st[1] = nx; }
        const unsigned old = xb_add(&bar[XB_XSUB(b.x)], 1u);
        const unsigned gen = old / nloc;
        if (old + 1u == (gen + 1u) * nloc) {
            __builtin_amdgcn_fence(__ATOMIC_RELEASE, "agent");
            asm volatile("s_waitcnt vmcnt(0)" ::: "memory");
            const unsigned og = xb_add(&bar[XB_TOP], 1u);
            const unsigned tg = og / nx;
            if (og + 1u == (tg + 1u) * nx) xb_add(&bar[XB_TOPGEN], 1u);
            else XB_SPIN(xb_ld(&bar[XB_TOPGEN]) == tg, bar);
            __builtin_amdgcn_fence(__ATOMIC_ACQUIRE, "agent");
            xb_add(&bar[XB_XGEN(b.x)], 1u);
            asm volatile("s_waitcnt vmcnt(0)" ::: "memory");
        } else {
            XB_SPIN(xb_ld(&bar[XB_XGEN(b.x)]) == gen, bar);
            __builtin_amdgcn_fence(__ATOMIC_ACQUIRE, "agent");
            asm volatile("s_waitcnt vmcnt(0)" ::: "memory");
        }
    }
    __syncthreads();
}

constexpr size_t WS_CTL = 539 * MiB, CTL_BYTES = 16384;
constexpr int MISC_OFF = 147456 - 128;
__device__ __forceinline__ void gate_row(int m, int lane, const bf16_t* __restrict__ YA, const bf16_t* __restrict__ YB, const float* __restrict__ LSE, const bf16_t* __restrict__ PROJ,
                                         const float* __restrict__ wa, const float* __restrict__ wb, bf16_t* __restrict__ H) {
    v4u a[2], b0[2], b1[2], b2[2], ga[2], gb[2]; float l0[2], l1[2], l2[2];
#pragma unroll
    for (int j = 0; j < 2; ++j) { const int c = lane + 64 * j, hh = c >> 4;
        a[j] = *(const v4u*)(YA + (size_t)m * DA + 8 * c);
        b0[j] = *(const v4u*)(YB + ((size_t)0 * M + m) * DB + 8 * c); b1[j] = *(const v4u*)(YB + ((size_t)1 * M + m) * DB + 8 * c); b2[j] = *(const v4u*)(YB + ((size_t)2 * M + m) * DB + 8 * c);
        l0[j] = LSE[((size_t)0 * M + m) * 8 + hh]; l1[j] = LSE[((size_t)1 * M + m) * 8 + hh]; l2[j] = LSE[((size_t)2 * M + m) * 8 + hh];
        ga[j] = *(const v4u*)(PROJ + ((size_t)(H_GA + (c >> 4)) * M + m) * HD + 8 * (c & 15)); gb[j] = *(const v4u*)(PROJ + ((size_t)(H_GB + (c >> 4)) * M + m) * HD + 8 * (c & 15)); }
    float ya[2][8], yb[2][8]; float ssa = 0.f, ssb = 0.f;
#pragma unroll
    for (int j = 0; j < 2; ++j) {
        ya[j][0] = bflo(a[j].x); ya[j][1] = bfhi(a[j].x); ya[j][2] = bflo(a[j].y); ya[j][3] = bfhi(a[j].y); ya[j][4] = bflo(a[j].z); ya[j][5] = bfhi(a[j].z); ya[j][6] = bflo(a[j].w); ya[j][7] = bfhi(a[j].w);
        const float mx = fmaxf(l0[j], fmaxf(l1[j], l2[j])); const float e0 = __builtin_amdgcn_exp2f(l0[j] - mx), e1 = __builtin_amdgcn_exp2f(l1[j] - mx), e2 = __builtin_amdgcn_exp2f(l2[j] - mx);
        const float inv = __builtin_amdgcn_rcpf(e0 + e1 + e2); const float w0 = e0 * inv, w1 = e1 * inv, w2 = e2 * inv;
        yb[j][0] = w0 * bflo(b0[j].x) + w1 * bflo(b1[j].x) + w2 * bflo(b2[j].x); yb[j][1] = w0 * bfhi(b0[j].x) + w1 * bfhi(b1[j].x) + w2 * bfhi(b2[j].x);
        yb[j][2] = w0 * bflo(b0[j].y) + w1 * bflo(b1[j].y) + w2 * bflo(b2[j].y); yb[j][3] = w0 * bfhi(b0[j].y) + w1 * bfhi(b1[j].y) + w2 * bfhi(b2[j].y);
        yb[j][4] = w0 * bflo(b0[j].z) + w1 * bflo(b1[j].z) + w2 * bflo(b2[j].z); yb[j][5] = w0 * bfhi(b0[j].z) + w1 * bfhi(b1[j].z) + w2 * bfhi(b2[j].z);
        yb[j][6] = w0 * bflo(b0[j].w) + w1 * bflo(b1[j].w) + w2 * bflo(b2[j].w); yb[j][7] = w0 * bfhi(b0[j].w) + w1 * bfhi(b1[j].w) + w2 * bfhi(b2[j].w);
#pragma unroll
        for (int i = 0; i < 8; ++i) { ssa += ya[j][i] * ya[j][i]; ssb += yb[j][i] * yb[j][i]; } }
    const float ra = 1.0f / sqrtf(wave_sum(ssa) * (1.0f / DA) + EPS), rb = 1.0f / sqrtf(wave_sum(ssb) * (1.0f / DB) + EPS);
#pragma unroll
    for (int j = 0; j < 2; ++j) { const int c = lane + 64 * j;
        const float gaf[8] = {bflo(ga[j].x), bfhi(ga[j].x), bflo(ga[j].y), bfhi(ga[j].y), bflo(ga[j].z), bfhi(ga[j].z), bflo(ga[j].w), bfhi(ga[j].w)};
        const float gbf[8] = {bflo(gb[j].x), bfhi(gb[j].x), bflo(gb[j].y), bfhi(gb[j].y), bflo(gb[j].z), bfhi(gb[j].z), bflo(gb[j].w), bfhi(gb[j].w)};
        const f32x4 wa0 = *(const f32x4*)(wa + 8 * c), wa1 = *(const f32x4*)(wa + 8 * c + 4), wb0 = *(const f32x4*)(wb + 8 * c), wb1 = *(const f32x4*)(wb + 8 * c + 4);
        float za[8], zb[8];
#pragma unroll
        for (int i = 0; i < 8; ++i) { const float wai = i < 4 ? wa0[i & 3] : wa1[i & 3], wbi = i < 4 ? wb0[i & 3] : wb1[i & 3];
            const float sa = gaf[i] * __builtin_amdgcn_rcpf(1.0f + __builtin_amdgcn_exp2f(-1.4426950408889634f * gaf[i])), sb = gbf[i] * __builtin_amdgcn_rcpf(1.0f + __builtin_amdgcn_exp2f(-1.4426950408889634f * gbf[i]));
            za[i] = ya[j][i] * ra * wai * sa; zb[i] = yb[j][i] * rb * wbi * sb; }
        v4u oa, ob; oa.x = pk2(za[0], za[1]); oa.y = pk2(za[2], za[3]); oa.z = pk2(za[4], za[5]); oa.w = pk2(za[6], za[7]);
        ob.x = pk2(zb[0], zb[1]); ob.y = pk2(zb[2], zb[3]); ob.z = pk2(zb[4], zb[5]); ob.w = pk2(zb[6], zb[7]);
        *(v4u*)(H + (size_t)m * DM + 8 * c) = oa; *(v4u*)(H + (size_t)m * DM + DA + 8 * c) = ob; }
}

struct Params { const float *x, *norm_w, *w_in, *qn, *kn, *ona, *onb, *w_out, *fnorm; float* out; unsigned char* ws; int ph_lo, ph_hi; };

__global__ void __launch_bounds__(512, 2) mk_fwd(Params p) {
    extern __shared__ __attribute__((aligned(16))) unsigned char lds[];
    volatile LAS unsigned* MISC = (volatile LAS unsigned*)((LAS unsigned char*)lds + MISC_OFF);
    if (threadIdx.x < 32) MISC[threadIdx.x] = 0u;
    __syncthreads();
    XcdBarrier bar = xcd_barrier_post((unsigned*)(p.ws + WS_CTL), MISC + 8);
    if (p.ph_lo == 0) {
        float* RCOS0 = (float*)(p.ws + WS_ROPE); float* RSIN0 = RCOS0 + 192 * 32;
        for (int i = blockIdx.x * 512 + threadIdx.x; i < 192 * 32; i += gridDim.x * 512) {
            const int pos = i >> 5, f = i & 31; const float pv = (float)(pos < 128 ? pos : pos - 128);
            float sn_, cs_; sincos_acc(pv * INV_FREQ[f], sn_, cs_); RCOS0[i] = cs_; RSIN0[i] = sn_;
        }
    }
    for (int ph = p.ph_lo; ph < p.ph_hi; ++ph) {
        const int tid = otid(), lane = tid & 63, wave = __builtin_amdgcn_readfirstlane(tid >> 6);
        int G = gridDim.x, bx = blockIdx.x; asm volatile("" : "+s"(G), "+s"(bx));
        const int vcu = (G % 8 == 0) ? (bx % 8) * (G / 8) + bx / 8 : bx;
        const int gw = vcu * 8 + wave, NGW = G * 8;
        size_t zoff = 0; asm volatile("" : "+s"(zoff));
        unsigned char* ws = p.ws + zoff;
        bf16_t* W1T = (bf16_t*)(ws + WS_W1T); bf16_t* W2T = (bf16_t*)(ws + WS_W2T); bf16_t* H = (bf16_t*)(ws + WS_H); bf16_t* PROJ = (bf16_t*)(ws + WS_PROJ);
        bf16_t* YA = (bf16_t*)(ws + WS_YA); bf16_t* YB = (bf16_t*)(ws + WS_YB); float* LSE = (float*)(ws + WS_LSE);
        float* RCOS = (float*)(ws + WS_ROPE); float* RSIN = RCOS + 192 * 32;
        bf16_t* XB = (bf16_t*)(ws + WS_XB); float* ROWSQ = (float*)(ws + WS_ROWSQ);
        if (ph == 0) {
            LAS float* scr = (LAS float*)((LAS unsigned char*)lds + wave * 16384);
            constexpr int I1 = (DM / 64) * (DIN / 32), I2 = (DM / 64) * (DM / 32), IL = I1 + I2;
            DUPREP(0) for (int it = gw; it < DEPTH * IL; it += NGW) {
                const int l = it / IL, r = it % IL;
                if (r < I1) p0_transpose_item(p.w_in + (size_t)l * DM * DIN, DM, DIN, W1T + (size_t)l * DIN * DM, scr, r, lane, p.norm_w + (size_t)l * DM);
                else p0_transpose_item(p.w_out + (size_t)l * DM * DM, DM, DM, W2T + (size_t)l * DM * DM, scr, r - I1, lane, nullptr);
            }
            for (int m = gw; m < M; m += NGW) {
                const f32x4* xr = (const f32x4*)(p.x + (size_t)m * DM) + lane; v2u* o8 = (v2u*)(XB + (size_t)m * DM) + lane; float sq = 0.f;
#pragma unroll
                for (int j = 0; j < 8; ++j) { const f32x4 v = xr[64 * j]; v2u w; w.x = pk2(v.x, v.y); w.y = pk2(v.z, v.w); o8[64 * j] = w;
                    const float r0 = bflo(w.x), r1 = bfhi(w.x), r2 = bflo(w.y), r3 = bfhi(w.y); sq += (r0 * r0 + r1 * r1) + (r2 * r2 + r3 * r3); }
                sq = wave_sum(sq); if (lane < 32) ROWSQ[(size_t)m * 32 + lane] = (lane == 0) ? sq : 0.f;
            }
        } else if (ph == N_PHASES - 1) {
            for (int m = gw; m < M; m += NGW) {
                f32x4* xr = (f32x4*)(p.out + (size_t)m * DM) + lane; const f32x4* wr_ = (const f32x4*)p.fnorm + lane; const v2u* xb8 = (const v2u*)(XB + (size_t)m * DM) + lane;
                const float rstd = 1.0f / sqrtf(wave_sum(lane < 32 ? ROWSQ[((size_t)DEPTH * M + m) * 32 + lane] : 0.f) * (1.0f / DM) + EPS);
#pragma unroll
                for (int j = 0; j < 8; ++j) { const v2u w = xb8[64 * j]; const f32x4 v = {bflo(w.x), bfhi(w.x), bflo(w.y), bfhi(w.y)}; xr[64 * j] = v * rstd * wr_[64 * j]; }
            }
        } else {
            const int l = (ph - 1) / 5, st = (ph - 1) % 5 + 1;
            if (st == 1) {
                pg8::Gemm g{XB, W1T + (size_t)l * DIN * DM, M, DIN, DM}; pg8::StaticOrder S; S.init(M, DIN, G, bx);
                pg8::EpiHeadMajor E{PROJ, M, ROWSQ + (size_t)l * M * 32, 1.0f / DM, EPS};
#ifndef MK_NO_G1
                DUPREP(2) pg8::gemm_phase<pg8::EpiHeadMajor, pg8::StaticOrder, PG8_ALIGN, PG8_SP2>((PG8_LAS unsigned char*)lds, g, S, E);
#endif
            } else if (st == 2) {
                const float* qg = p.qn + l * HD; const float* kg = p.kn + l * HD;
                constexpr int QKU = 4;
                for (int it0 = gw; it0 < M * 10 / 4; it0 += QKU * NGW) {
                    const int j = lane & 15, half = j >> 3, jj = j & 7, e = half * 64 + 4 * jj;
                    v2u a[QKU], b[QKU]; f32x4 cs[QKU], sn[QKU]; bf16_t* pp[QKU]; bool isq[QKU];
#pragma unroll
                    for (int u = 0; u < QKU; ++u) { const int it = min(it0 + u * NGW, M * 10 / 4 - 1);
                        const int g = it * 4 + (lane >> 4), row = g / 10, hs = g - row * 10; isq[u] = hs < 8;
                        pp[u] = PROJ + ((size_t)hs * M + row) * HD + e; a[u] = *(const v2u*)pp[u]; b[u] = *(const v2u*)(pp[u] + 32);
                        const int t = row & (T - 1), pos = half ? 128 + (t & 63) : (t >> 6);
                        cs[u] = *(const f32x4*)(RCOS + pos * 32 + 4 * jj); sn[u] = *(const f32x4*)(RSIN + pos * 32 + 4 * jj); }
                    asm volatile("" ::: "memory");
#pragma unroll
                    for (int u = 0; u < QKU; ++u) {
                        float x1[4] = {bflo(a[u].x), bfhi(a[u].x), bflo(a[u].y), bfhi(a[u].y)}, x2[4] = {bflo(b[u].x), bfhi(b[u].x), bflo(b[u].y), bfhi(b[u].y)};
                        float ss = 0.f;
#pragma unroll
                        for (int i = 0; i < 4; ++i) ss += x1[i] * x1[i] + x2[i] * x2[i];
                        ss += __shfl_xor(ss, 1); ss += __shfl_xor(ss, 2); ss += __shfl_xor(ss, 4); ss += __shfl_xor(ss, 8);
                        const float rstd = 1.0f / sqrtf(ss * (1.0f / HD) + EPS);
                        const float* gn = isq[u] ? qg : kg;
                        const float qsc = (MK_NEGM && isq[u]) ? att::SCALE * att::LOG2E : 1.0f;
                        const f32x4 g1 = *(const f32x4*)(gn + e), g2 = *(const f32x4*)(gn + e + 32);
                        float o1[4], o2[4];
#pragma unroll
                        for (int i = 0; i < 4; ++i) { const float y1 = x1[i] * rstd * g1[i], y2 = x2[i] * rstd * g2[i]; o1[i] = (y1 * cs[u][i] - y2 * sn[u][i]) * qsc; o2[i] = (y1 * sn[u][i] + y2 * cs[u][i]) * qsc; }
                        v2u w1, w2; w1.x = pk2(o1[0], o1[1]); w1.y = pk2(o1[2], o1[3]); w2.x = pk2(o2[0], o2[1]); w2.y = pk2(o2[2], o2[3]);
                        if (it0 + u * NGW < M * 10 / 4) { *(v2u*)pp[u] = w1; *(v2u*)(pp[u] + 32) = w2; }
                    }
                }
#ifndef MK_NO_DIL
                DUPREP(3) for (int u = vcu; u < 1536; u += G) {
                    const int pt = u >> 9, rem = u & 511, b = rem >> 8, h = (rem >> 5) & 7, w = rem & 31;
                    const int d = (pt == 0) ? 1 : (pt == 1) ? 4 : 16, res = w & (d - 1), blk = w / d, i0 = blk * 256, nsub = T / d;
                    const float slope = __builtin_amdgcn_exp2f(-(float)(h + 1));
                    const float nslopeC = -slope * (float)d * att::LOG2E;
                    const size_t tok0 = (size_t)b * T + res;
                    const att::bf16* Pb = (const att::bf16*)PROJ + ((size_t)h * M + tok0) * HD;
                    const long rs = (long)d * HD;
                    att::attn_body<true>(Pb + (size_t)H_QB * M * HD + (long)i0 * rs, Pb + (size_t)H_KB * M * HD, Pb + (size_t)H_VB * M * HD, rs, rs,
                                         (att::bf16*)YB + ((size_t)pt * M + tok0 + (size_t)i0 * d) * DB + h * HD, (long)d * DB,
                                         LSE + ((size_t)pt * M + tok0 + (size_t)i0 * d) * 8 + h, d * 8, i0, nsub, nslopeC, 0, (char*)lds);
                }
#endif
            } else if (st == 3) {
#ifndef MK_NO_DENSE
                int bounded;
                { const float* qg = p.qn + l * HD; const float* kg = p.kn + l * HD;
                  float gq = fmaxf(fabsf(qg[lane]), fabsf(qg[lane + 64])), gk = fmaxf(fabsf(kg[lane]), fabsf(kg[lane + 64]));
#pragma unroll
                  for (int o_ = 1; o_ < 64; o_ <<= 1) { gq = fmaxf(gq, __shfl_xor(gq, o_)); gk = fmaxf(gk, __shfl_xor(gk, o_)); }
                  const float bnd = gq * gk * 128.f * att::SCALE * att::LOG2E;
                  bounded = __builtin_amdgcn_readfirstlane((MK_NEGM && bnd <= 64.f) ? 1 : 0); }
                DUPREP(4) for (int u = vcu; u < 512; u += G) {
                    const int combo = u >> 7, b = combo >> 1, kvh = combo & 1, h = kvh * 4 + ((u >> 5) & 3), qb = u & 31;
                    const att::bf16* Pb = (const att::bf16*)PROJ + (size_t)b * T * HD;
                    att::attn_body<false>(Pb + ((size_t)(H_QA + h) * M + qb * 256) * HD, Pb + (size_t)(H_KA + kvh) * M * HD, Pb + (size_t)(H_VA + kvh) * M * HD, HD, HD,
                                          (att::bf16*)YA + ((size_t)b * T + qb * 256) * DA + h * HD, DA, nullptr, 0, bounded, 0, 0.f, T, (char*)lds);
                }
#endif
            } else if (st == 4) {
                const float* wa = p.ona + (size_t)l * DA; const float* wb = p.onb + (size_t)l * DB;
                DUPREP(5) for (int m = gw; m < M; m += 2 * NGW) {
                    gate_row(m, lane, YA, YB, LSE, PROJ, wa, wb, H);
                    if (m + NGW < M) gate_row(m + NGW, lane, YA, YB, LSE, PROJ, wa, wb, H);
                }
            } else {
                pg8::Gemm g{H, W2T + (size_t)l * DM * DM, M, DM, DM}; pg8::StaticOrder S; S.init(M, DM, G, bx);
                pg8::EpiResF32 E{XB, ROWSQ + (size_t)(l + 1) * M * 32, DM};
#ifndef MK_NO_G2
                pg8::gemm_phase<pg8::EpiResF32, pg8::StaticOrder, PG8_ALIGN, PG8_SP2>((PG8_LAS unsigned char*)lds, g, S, E);
#endif
            }
        }
        if (ph + 1 < p.ph_hi) { if (p.ph_hi > 4096) cg::this_grid().sync(); else xcd_barrier(bar); if (MK_DUP & 64) xcd_barrier(bar); }
    }
}

extern "C" void kernel_launch(void* const* d_in, const int* in_sizes, int n_in, void* d_out, int out_size, void* d_ws, size_t ws_size, hipStream_t stream) {
    static int grid = 0;
    if (grid == 0) {
        if (n_in != 9 || in_sizes[0] != M * DM || out_size != M * DM || ws_size < WS_END) { fprintf(stderr, "kernel_launch: unexpected shapes (n_in %d, ws %zu)\n", n_in, ws_size); grid = -1; return; }
        int dev = 0, cus = 0, per_cu = 0;
        hipGetDevice(&dev); hipDeviceGetAttribute(&cus, hipDeviceAttributeMultiprocessorCount, dev);
        if (hipFuncSetAttribute((const void*)mk_fwd, hipFuncAttributeMaxDynamicSharedMemorySize, LDS_BYTES) != hipSuccess) { fprintf(stderr, "kernel_launch: hipFuncSetAttribute failed\n"); grid = -1; return; }
        if (hipOccupancyMaxActiveBlocksPerMultiprocessor(&per_cu, (const void*)mk_fwd, 512, LDS_BYTES) != hipSuccess || per_cu < 1) per_cu = 1;
        (void)hipGetLastError();
        grid = cus * per_cu;
    }
    if (grid < 0) return;
    Params p{};
    p.x = (const float*)d_in[0]; p.norm_w = (const float*)d_in[1]; p.w_in = (const float*)d_in[2]; p.qn = (const float*)d_in[3]; p.kn = (const float*)d_in[4];
    p.ona = (const float*)d_in[5]; p.onb = (const float*)d_in[6]; p.w_out = (const float*)d_in[7]; p.fnorm = (const float*)d_in[8];
    p.out = (float*)d_out; p.ws = (unsigned char*)d_ws;
    if (hipMemsetAsync((char*)d_ws + WS_CTL, 0, CTL_BYTES, stream) != hipSuccess) { fprintf(stderr, "kernel_launch: memset failed\n"); return; }
#if MK_ONE_LAUNCH
    p.ph_lo = 0; p.ph_hi = N_PHASES;
    void* args[] = {&p};
    hipError_t e = hipLaunchCooperativeKernel((const void*)mk_fwd, dim3(grid), dim3(512), args, LDS_BYTES, stream);
    if (e != hipSuccess) fprintf(stderr, "kernel_launch: cooperative launch failed: %s (grid %d)\n", hipGetErrorString(e), grid);
#else
    for (int ph = 0; ph < N_PHASES; ++ph) { p.ph_lo = ph; p.ph_hi = ph + 1; hipLaunchKernelGGL(mk_fwd, dim3(grid), dim3(512), LDS_BYTES, stream, p); }
#endif
}
```

```cpp
#include <hip/hip_runtime.h>
#include <hip/hip_bf16.h>
#include <hip/hip_cooperative_groups.h>
#include <cstdio>
#include <cstdint>
namespace cg = cooperative_groups;

#ifndef MK_DUP
#define MK_DUP 0
#endif
#define DUPREP(k) for (int rep_ = 0; rep_ < 1 + ((MK_DUP >> (k)) & 1); ++rep_)
#ifndef MK_PVPIPE
#define MK_PVPIPE 1
#endif
#ifndef MK_SGB
#define MK_SGB 0
#endif
#ifndef MK_PP
#define MK_PP 1
#endif
#ifndef MK_PROBE_V
#define MK_PROBE_V 0
#endif
#ifndef MK_NEGM
#define MK_NEGM 1
#endif
#ifndef MK_PREB
#define MK_PREB 1
#endif
#ifndef MK_OSTAGE
#define MK_OSTAGE 1
#endif
#ifndef MK_QFUSE
#define MK_QFUSE 1
#endif
#ifndef MK_ONE_LAUNCH
#define MK_ONE_LAUNCH 1
#endif
static_assert(!MK_NEGM || MK_PP, "MK_NEGM pre-scales q for the ping-pong dense body only");

constexpr int BATCH = 2, T = 8192, DM = 2048, DEPTH = 4, HD = 128, DA = 1024, DB = 1024, DIN = 6656, M = BATCH * T;
constexpr int C_QA = 0, C_KA = 1024, C_VA = 1280, C_GA = 1536, C_QB = 2560, C_KB = 3584, C_VB = 4608, C_GB = 5632;
constexpr int H_QA = 0, H_KA = 8, H_VA = 10, H_GA = 12, H_QB = 20, H_KB = 28, H_VB = 36, H_GB = 44;
constexpr float EPS = 1e-6f;
__device__ __forceinline__ int otid() { int t = threadIdx.x; asm volatile("" : "+v"(t)); return t; }

namespace pg8 {
#define PG8_LAS __attribute__((address_space(3)))
typedef unsigned short bf16_t;
typedef short bf16x8 __attribute__((ext_vector_type(8)));
typedef float f32x4 __attribute__((ext_vector_type(4)));
typedef unsigned u32x4 __attribute__((ext_vector_type(4)));
constexpr int BM = 256, BK = 64, HALF = 128, HTB = HALF * BK * 2  , STAGE_BYTES = 8 * HTB, NXCD = 8, WGM = 4;

__host__ __device__ __forceinline__ int lds_byte(int r, int c) { const int st = (r >> 4) * 2 + (c >> 5), rr = r & 15, cc = c & 31, ob = rr * 64 + cc * 2; return st * 1024 + (ob ^ (((ob >> 9) & 1) << 5)); }
__host__ __device__ __forceinline__ void stage_rc(int b, int& R, int& C) { const int st = b / 1024, sb = b % 1024, swz = sb ^ (((sb >> 9) & 1) << 5); R = (st >> 1) * 16 + swz / 64; C = (st & 1) * 32 + (swz % 64) / 2; }
__host__ __device__ __forceinline__ int perm32(int rho) { const int n = rho >> 4, i = rho & 15; return 8 * (i >> 2) + 4 * n + (i & 3); }

struct Unit { int pm, pn; };
struct Gemm { const bf16_t* A; const bf16_t* Bt; int M, N, K; };

struct StaticOrder {
    int nM, nN, nwg, G, c;
    __host__ __device__ void init(int M, int N, int G_, int c_) { nM = M / BM; nN = N / BM; nwg = nM * nN; G = G_; c = c_; }
    __host__ __device__ bool next(int i, Unit& u) const {
        const long L = (long)i * G + c; if (L >= nwg) return false;
        int wgid = (int)L; { const int q = nwg / NXCD, r = nwg % NXCD, xcd = wgid % NXCD, off = wgid / NXCD; wgid = (xcd < r ? xcd * (q + 1) : r * (q + 1) + (xcd - r) * q) + off; }
        const int nig = WGM * nN, gid = wgid / nig, fm = gid * WGM, gsz = (nM - fm) < WGM ? (nM - fm) : WGM;
        u.pm = fm + ((wgid % nig) % gsz); u.pn = (wgid % nig) / gsz; return true;
    }
    __device__ __forceinline__ void a_ready(const Unit&) const {}
    __device__ __forceinline__ void done(const Unit&) const {}
};

__device__ __forceinline__ unsigned cvt_pk_bf16(float lo, float hi) { unsigned r; asm volatile("v_cvt_pk_bf16_f32 %0, %1, %2" : "=v"(r) : "v"(lo), "v"(hi)); return r; }
typedef float f32x2 __attribute__((ext_vector_type(2)));
__device__ __forceinline__ f32x2 gelu_pk(f32x2 v) {
    const f32x2 av = __builtin_elementwise_abs(v), d = av * 0.2316418882f + 1.0f;
    f32x2 t; t.x = __builtin_amdgcn_rcpf(d.x); t.y = __builtin_amdgcn_rcpf(d.y);
    f32x2 q = t * 0.5307027145f + (-0.7265760135f); q = q * t + 0.7107068705f; q = q * t + (-0.142248368f); q = q * t + 0.127414796f; q = q * t;
    const f32x2 s = (v * v) * (-0.72134752044f);
    f32x2 e; e.x = __builtin_amdgcn_exp2f(s.x); e.y = __builtin_amdgcn_exp2f(s.y);
    const f32x2 m = v * (q * e), r = v - m;
    f32x2 o; o.x = v.x < 0.f ? m.x : r.x; o.y = v.y < 0.f ? m.y : r.y; return o;
}

template <int ACT  > struct EpiBf16 {
    static constexpr bool PERM = true, AFTER_DRAIN = false; static_assert(ACT == 0 || ACT == 1, "EpiBf16: ACT is 0 (none) or 1 (gelu_pk)");
    bf16_t* O; int ldc; const float* bias; int split_cols; size_t split_stride; float scale0;
    __device__ __forceinline__ void operator()(const f32x4 (&acc)[2][2][4][2], const Unit& u, int wr, int wc, int fr, int fq) const {
        const int row0 = u.pm * BM + wr * 64 + fr; int colt = u.pn * BM; bf16_t* base = O;
        float sc = 1.f; if (split_cols) { const int t = colt / split_cols; base += (size_t)t * split_stride; colt -= t * split_cols; if (t == 0) sc = scale0; }
        const int col0 = colt + wc * 32 + 8 * fq, bcol0 = u.pn * BM + wc * 32 + 8 * fq;
        f32x4 bv[2][2];
#pragma unroll
        for (int bj = 0; bj < 2; ++bj)
#pragma unroll
            for (int n = 0; n < 2; ++n) bv[bj][n] = bias ? *(const f32x4*)(bias + bcol0 + bj * HALF + 4 * n) : (f32x4){0.f, 0.f, 0.f, 0.f};
#pragma unroll
        for (int ai = 0; ai < 2; ++ai)
#pragma unroll
            for (int m = 0; m < 4; ++m) { bf16_t* rowp = base + (size_t)(row0 + ai * HALF + m * 16) * ldc + col0;
#pragma unroll
                for (int bj = 0; bj < 2; ++bj) { f32x4 v0 = acc[ai][bj][m][0] + bv[bj][0], v1 = acc[ai][bj][m][1] + bv[bj][1];
                    if (ACT == 1) { f32x2 a = gelu_pk((f32x2){v0[0], v0[1]}), b = gelu_pk((f32x2){v0[2], v0[3]}), c = gelu_pk((f32x2){v1[0], v1[1]}), d = gelu_pk((f32x2){v1[2], v1[3]});
                        v0 = (f32x4){a.x, a.y, b.x, b.y}; v1 = (f32x4){c.x, c.y, d.x, d.y}; }
                    v0 = v0 * sc; v1 = v1 * sc; u32x4 w; w.x = cvt_pk_bf16(v0[0], v0[1]); w.y = cvt_pk_bf16(v0[2], v0[3]); w.z = cvt_pk_bf16(v1[0], v1[1]); w.w = cvt_pk_bf16(v1[2], v1[3]);
                    *(u32x4*)(rowp + bj * HALF) = w; } }
    }
};
struct EpiHeadMajor {
    static constexpr bool PERM = true, AFTER_DRAIN = false;
    bf16_t* O; int Mrows; const float* rowsq; float inv_k, eps;
    __device__ __forceinline__ void operator()(const f32x4 (&acc)[2][2][4][2], const Unit& u, int wr, int wc, int fr, int fq) const {
        const int row0 = u.pm * BM + wr * 64 + fr, col0 = wc * 32 + 8 * fq;
#pragma unroll
        for (int ai = 0; ai < 2; ++ai) {
            f32x4 pa[4], pb[4];
#pragma unroll
            for (int m = 0; m < 4; ++m) { const f32x4* pp = (const f32x4*)(rowsq + (size_t)(row0 + ai * HALF + m * 16) * 32 + 8 * fq); pa[m] = pp[0]; pb[m] = pp[1]; }
#pragma unroll
            for (int m = 0; m < 4; ++m) { const int row = row0 + ai * HALF + m * 16; const f32x4 a = pa[m], b = pb[m];
                float sq = ((a[0] + a[1]) + (a[2] + a[3])) + ((b[0] + b[1]) + (b[2] + b[3])); sq += __shfl_xor(sq, 16); sq += __shfl_xor(sq, 32);
                const float rs = 1.0f / sqrtf(sq * inv_k + eps);
#pragma unroll
                for (int bj = 0; bj < 2; ++bj) { const f32x4 v0 = acc[ai][bj][m][0] * rs, v1 = acc[ai][bj][m][1] * rs;
                    u32x4 w; w.x = cvt_pk_bf16(v0[0], v0[1]); w.y = cvt_pk_bf16(v0[2], v0[3]); w.z = cvt_pk_bf16(v1[0], v1[1]); w.w = cvt_pk_bf16(v1[2], v1[3]);
                    *(u32x4*)(O + ((size_t)(u.pn * 2 + bj) * Mrows + row) * HALF + col0) = w; } }
            asm volatile("" ::: "memory"); }
    }
};
struct EpiResF32 {
    static constexpr bool PERM = true, AFTER_DRAIN = false;
    bf16_t* xb; float* rowsq; int ldc;
    __device__ __forceinline__ void operator()(const f32x4 (&acc)[2][2][4][2], const Unit& u, int wr, int wc, int fr, int fq) const {
        const int col0 = u.pn * BM + wc * 32 + 8 * fq;
#pragma unroll
        for (int ai = 0; ai < 2; ++ai) {
            u32x4 pre[4][2];
#pragma unroll
            for (int m = 0; m < 4; ++m) { const size_t off = (size_t)(u.pm * BM + ai * HALF + wr * 64 + m * 16 + fr) * ldc + col0;
#pragma unroll
                for (int bj = 0; bj < 2; ++bj) pre[m][bj] = *(const u32x4*)(xb + off + bj * HALF); }
            asm volatile("" ::: "memory");
#pragma unroll
            for (int m = 0; m < 4; ++m) { const int row = u.pm * BM + ai * HALF + wr * 64 + m * 16 + fr; const size_t off = (size_t)row * ldc + col0; float ss = 0.f;
#pragma unroll
                for (int bj = 0; bj < 2; ++bj) { const u32x4 pb = pre[m][bj]; const f32x4 a0 = acc[ai][bj][m][0], a1 = acc[ai][bj][m][1];
                    u32x4 w; w.x = cvt_pk_bf16(__uint_as_float(pb.x << 16) + a0[0], __uint_as_float(pb.x & 0xffff0000u) + a0[1]); w.y = cvt_pk_bf16(__uint_as_float(pb.y << 16) + a0[2], __uint_as_float(pb.y & 0xffff0000u) + a0[3]);
                    w.z = cvt_pk_bf16(__uint_as_float(pb.z << 16) + a1[0], __uint_as_float(pb.z & 0xffff0000u) + a1[1]); w.w = cvt_pk_bf16(__uint_as_float(pb.w << 16) + a1[2], __uint_as_float(pb.w & 0xffff0000u) + a1[3]);
#pragma unroll
                    for (int q = 0; q < 4; ++q) { const float r0 = __uint_as_float(w[q] << 16), r1 = __uint_as_float(w[q] & 0xffff0000u); ss += r0 * r0 + r1 * r1; }
                    *(u32x4*)(xb + off + bj * HALF) = w; }
                ss += __shfl_xor(ss, 16); ss += __shfl_xor(ss, 32);
                if (fq == 0) rowsq[(size_t)row * 32 + u.pn * 4 + wc] = ss; }
            asm volatile("" ::: "memory"); }
    }
};


template <class Epi, class Sched, bool ALIGN_EPI = false, bool SP2 = false>
__device__ __forceinline__ void gemm_phase(PG8_LAS unsigned char* lds, const Gemm g, const Sched& S, const Epi& E) {
    const int tid = otid(), wid = __builtin_amdgcn_readfirstlane(tid >> 6), lane = tid & 63, wr = wid >> 2, wc = wid & 3, fr = lane & 15, fq = lane >> 4;
    const int K = g.K, nt = K / BK;
    unsigned voffA[2], voffB[2];
#pragma unroll
    for (int i = 0; i < 2; ++i) { int R, C; stage_rc(tid * 16 + i * 8192, R, C); const int Rb = Epi::PERM ? ((R & ~31) + perm32(R & 31)) : R;
        voffA[i] = (unsigned)(R * K + C) * 2u; voffB[i] = (unsigned)(Rb * K + C) * 2u; }
    const size_t kstep = (size_t)(BK * 2);
    const size_t hstep = (size_t)HALF * K * 2;
    const size_t tstep = 2 * hstep;
    const unsigned ldsw = (unsigned)wid * 1024u;
    const int aoff = lds_byte(wr * 64 + fr, fq * 8), boff = lds_byte(wc * 32 + fr, fq * 8);
#define PG8_SA(b, h) (((b) * 2 + (h)) * HTB)
#define PG8_SB(b, h) ((4 + (b) * 2 + (h)) * HTB)
#define PG8_STAGE(bufoff, gbase, voff) do { _Pragma("unroll") for (int _i = 0; _i < 2; ++_i) \
        __builtin_amdgcn_global_load_lds((const unsigned*)((const char*)(gbase) + (voff)[_i]), (PG8_LAS unsigned*)(lds + (bufoff) + ldsw + _i * 8192), 16, 0, 0); } while (0)
#define PG8_LDA(dst, b, h) do { _Pragma("unroll") for (int m = 0; m < 4; ++m) _Pragma("unroll") for (int k = 0; k < 2; ++k) dst[m][k] = *(const PG8_LAS bf16x8*)(lds + PG8_SA(b, h) + aoff + m * 2048 + k * 1024); } while (0)
#define PG8_LDB(dst, b, h) do { _Pragma("unroll") for (int n = 0; n < 2; ++n) _Pragma("unroll") for (int k = 0; k < 2; ++k) dst[n][k] = *(const PG8_LAS bf16x8*)(lds + PG8_SB(b, h) + boff + n * 2048 + k * 1024); } while (0)
#define PG8_MMA(ai, bj, At, Bt) do { __builtin_amdgcn_s_setprio(1); _Pragma("unroll") for (int m = 0; m < 4; ++m) _Pragma("unroll") for (int n = 0; n < 2; ++n) _Pragma("unroll") for (int k = 0; k < 2; ++k) \
        acc[ai][bj][m][n] = __builtin_amdgcn_mfma_f32_16x16x32_bf16(Bt[n][k], At[m][k], acc[ai][bj][m][n], 0, 0, 0); __builtin_amdgcn_s_setprio(0); } while (0)
#define PG8_WAIT_V(n) asm volatile("s_waitcnt vmcnt(" #n ")" ::: "memory")
#define PG8_WAIT_L(n) asm volatile("s_waitcnt lgkmcnt(" #n ")" ::: "memory")
#define PG8_BAR __builtin_amdgcn_s_barrier()
#define PG8_SCHED __builtin_amdgcn_sched_barrier(0)
    Unit cur, nxt; int ui = 0;
    if (!S.next(0, cur)) return;
    f32x4 acc[2][2][4][2];
#pragma unroll
    for (int a = 0; a < 2; ++a)
#pragma unroll
        for (int b = 0; b < 2; ++b)
#pragma unroll
            for (int m = 0; m < 4; ++m)
#pragma unroll
                for (int n = 0; n < 2; ++n) acc[a][b][m][n] = (f32x4){0.f, 0.f, 0.f, 0.f};
    bf16x8 At[4][2], B0[2][2], B1[2][2];
    const char* cA = (const char*)g.A + (size_t)cur.pm * tstep; const char* cB = (const char*)g.Bt + (size_t)cur.pn * tstep;
    S.a_ready(cur);
    if constexpr (SP2) {
        PG8_STAGE(PG8_SB(0, 0), cB, voffB); PG8_STAGE(PG8_SB(0, 1), cB + hstep, voffB); PG8_STAGE(PG8_SA(0, 0), cA, voffA); PG8_STAGE(PG8_SA(0, 1), cA + hstep, voffA);
        if (wr == 1) PG8_BAR;
        PG8_WAIT_V(2); PG8_BAR;
        PG8_STAGE(PG8_SB(1, 0), cB + kstep, voffB); PG8_STAGE(PG8_SA(1, 0), cA + kstep, voffA); PG8_STAGE(PG8_SB(1, 1), cB + hstep + kstep, voffB);
        PG8_WAIT_V(6); PG8_BAR;
    } else {
        PG8_STAGE(PG8_SB(0, 0), cB, voffB); PG8_STAGE(PG8_SA(0, 0), cA, voffA); PG8_STAGE(PG8_SB(0, 1), cB + hstep, voffB); PG8_STAGE(PG8_SA(0, 1), cA + hstep, voffA);
        if (wr == 1) PG8_BAR;
        PG8_WAIT_V(4); PG8_BAR;
        PG8_STAGE(PG8_SB(1, 0), cB + kstep, voffB); PG8_STAGE(PG8_SA(1, 0), cA + kstep, voffA); PG8_STAGE(PG8_SB(1, 1), cB + hstep + kstep, voffB);
        PG8_WAIT_V(6); PG8_BAR;
    }
    for (;;) {
        const bool has_next = S.next(ui + 1, nxt);
        const char* nA = has_next ? (const char*)g.A + (size_t)nxt.pm * tstep : cA; const char* nB = has_next ? (const char*)g.Bt + (size_t)nxt.pn * tstep : cB;
        for (int t = 0; t < nt; t += 2) {
            const bool last = (t == nt - 2);
            const char* a1 = cA + (size_t)(t + 1) * kstep;
            const char* a2 = last ? nA : cA + (size_t)(t + 2) * kstep; const char* b2 = last ? nB : cB + (size_t)(t + 2) * kstep;
            const char* a3 = a2 + kstep; const char* b3 = b2 + kstep;
            if (last && has_next) S.a_ready(nxt);
            if constexpr (SP2) {
            PG8_LDB(B0, 0, 0); PG8_LDB(B1, 0, 1); PG8_SCHED; PG8_LDA(At, 0, 0); PG8_STAGE(PG8_SA(1, 1), a1 + hstep, voffA);
            PG8_WAIT_V(8); PG8_WAIT_L(0); PG8_BAR; PG8_MMA(0, 0, At, B0); PG8_MMA(0, 1, At, B1); PG8_BAR; PG8_SCHED;
            PG8_LDA(At, 0, 1); PG8_STAGE(PG8_SB(0, 0), b2, voffB); PG8_STAGE(PG8_SB(0, 1), b2 + hstep, voffB); PG8_STAGE(PG8_SA(0, 0), a2, voffA);
            PG8_WAIT_V(8); PG8_WAIT_L(0); PG8_BAR; PG8_MMA(1, 0, At, B0); PG8_MMA(1, 1, At, B1); PG8_BAR; PG8_SCHED;
            PG8_LDB(B0, 1, 0); PG8_LDB(B1, 1, 1); PG8_SCHED; PG8_LDA(At, 1, 0); PG8_STAGE(PG8_SA(0, 1), a2 + hstep, voffA);
            PG8_WAIT_V(8); PG8_WAIT_L(0); PG8_BAR; PG8_MMA(0, 0, At, B0); PG8_MMA(0, 1, At, B1); PG8_BAR; PG8_SCHED;
            PG8_LDA(At, 1, 1); PG8_STAGE(PG8_SB(1, 0), b3, voffB); PG8_STAGE(PG8_SB(1, 1), b3 + hstep, voffB); PG8_STAGE(PG8_SA(1, 0), a3, voffA);
            PG8_WAIT_V(8); PG8_WAIT_L(0); PG8_BAR; PG8_MMA(1, 0, At, B0); PG8_MMA(1, 1, At, B1); PG8_BAR; PG8_SCHED;
            } else {
            PG8_LDB(B0, 0, 0); PG8_SCHED; PG8_LDA(At, 0, 0); PG8_STAGE(PG8_SA(1, 1), a1 + hstep, voffA);
            PG8_WAIT_L(8); PG8_BAR; PG8_WAIT_L(0); PG8_MMA(0, 0, At, B0); PG8_BAR; PG8_SCHED;
            PG8_LDB(B1, 0, 1); PG8_STAGE(PG8_SB(0, 0), b2, voffB);
            PG8_BAR; PG8_WAIT_L(0); PG8_MMA(0, 1, At, B1); PG8_BAR;
            PG8_LDA(At, 0, 1); PG8_STAGE(PG8_SA(0, 0), a2, voffA);
            PG8_BAR; PG8_WAIT_L(0); PG8_MMA(1, 0, At, B0); PG8_BAR; PG8_SCHED;
            PG8_STAGE(PG8_SB(0, 1), b2 + hstep, voffB);
            PG8_WAIT_V(6); PG8_BAR; PG8_MMA(1, 1, At, B1); PG8_BAR;
            PG8_LDB(B0, 1, 0); PG8_SCHED; PG8_LDA(At, 1, 0); PG8_STAGE(PG8_SA(0, 1), a2 + hstep, voffA);
            PG8_WAIT_L(8); PG8_BAR; PG8_WAIT_L(0); PG8_MMA(0, 0, At, B0); PG8_BAR; PG8_SCHED;
            PG8_LDB(B1, 1, 1); PG8_STAGE(PG8_SB(1, 0), b3, voffB);
            PG8_BAR; PG8_WAIT_L(0); PG8_MMA(0, 1, At, B1); PG8_BAR;
            PG8_LDA(At, 1, 1); PG8_STAGE(PG8_SA(1, 0), a3, voffA);
            PG8_BAR; PG8_WAIT_L(0); PG8_MMA(1, 0, At, B0); PG8_BAR; PG8_SCHED;
            PG8_STAGE(PG8_SB(1, 1), b3 + hstep, voffB);
            PG8_WAIT_V(6); PG8_BAR; PG8_MMA(1, 1, At, B1); PG8_BAR;
            }
        }
        if constexpr (ALIGN_EPI) { if (wr == 0) PG8_BAR; }
        if constexpr (!Epi::AFTER_DRAIN) { E(acc, cur, wr, wc, fr, fq); S.done(cur); }
        if (!has_next) break;
#pragma unroll
        for (int a = 0; a < 2; ++a)
#pragma unroll
            for (int b = 0; b < 2; ++b)
#pragma unroll
                for (int m = 0; m < 4; ++m)
#pragma unroll
                    for (int n = 0; n < 2; ++n) acc[a][b][m][n] = (f32x4){0.f, 0.f, 0.f, 0.f};
        cur = nxt; cA = nA; cB = nB; ++ui;
        if constexpr (ALIGN_EPI) { if (wr == 1) PG8_BAR; }
    }
    PG8_WAIT_V(0);
    if constexpr (!ALIGN_EPI) { if (wr == 0) PG8_BAR; }
    PG8_BAR;
    if constexpr (Epi::AFTER_DRAIN) { E.fused(acc, cur, wr, wc, fr, fq, lds, wid, lane); S.done(cur); }
#undef PG8_SA
#undef PG8_SB
#undef PG8_STAGE
#undef PG8_LDA
#undef PG8_LDB
#undef PG8_MMA
#undef PG8_WAIT_V
#undef PG8_WAIT_L
#undef PG8_BAR
#undef PG8_SCHED
}
}
#define PG8_SP2 true
#define PG8_ALIGN true
namespace att {
using bf16 = __hip_bfloat16;
constexpr int D = 128, NW = 8, QBLK = 32, KVBLK = 64;
constexpr float SCALE = 0.088388347648318440f;
constexpr float THR = 8.f;
constexpr size_t SHM_V = KVBLK * D * 2, SHM_K = KVBLK * D * 2, SHM_ATTN = 2 * SHM_V + 2 * SHM_K + NW * 64 * 4;
using bf16x8 = __attribute__((ext_vector_type(8))) short;
using s16x4  = __attribute__((ext_vector_type(4))) short;
using f32x16 = __attribute__((ext_vector_type(16))) float;
using f32x8  = __attribute__((ext_vector_type(8))) float;
using u32x4  = __attribute__((ext_vector_type(4))) unsigned;
#define KSWZ(row, colB) ((row) * 256 + ((colB) ^ (((row) & 7) << 4)))
#define SBAR() __builtin_amdgcn_sched_barrier(0)
__device__ __forceinline__ int crow(int r, int hi) { return (r & 3) + 8 * (r >> 2) + 4 * hi; }
__device__ __forceinline__ unsigned cvtpk(float lo, float hi) {
  unsigned r; asm("v_cvt_pk_bf16_f32 %0, %1, %2" : "=v"(r) : "v"(lo), "v"(hi)); return r;
}
template <typename TIn> struct Stage;
template <> struct Stage<bf16>  { using T = bf16x8;
  __device__ static __forceinline__ T ld8(const bf16* p) { return *reinterpret_cast<const bf16x8*>(p); }
  __device__ static __forceinline__ bf16x8 tobf(T x) { return x; } };
template <> struct Stage<float> { using T = f32x8;
  __device__ static __forceinline__ T ld8(const float* p) { return *reinterpret_cast<const f32x8*>(p); }
  __device__ static __forceinline__ bf16x8 tobf(T x) {
    u32x4 w = {cvtpk(x[0], x[1]), cvtpk(x[2], x[3]), cvtpk(x[4], x[5]), cvtpk(x[6], x[7])}; return *reinterpret_cast<bf16x8*>(&w); } };

__device__ __forceinline__ void partialSM(f32x16& p0, f32x16& p1, float& m_reg, float& mn, float& alpha) {
  constexpr float C = SCALE * 1.4426950408889634f;
  float pmax = p0[0]; for (int r = 1; r < 16; ++r) pmax = fmaxf(pmax, p0[r]); for (int r = 0; r < 16; ++r) pmax = fmaxf(pmax, p1[r]);
  { auto rr = __builtin_amdgcn_permlane32_swap(__float_as_uint(pmax), __float_as_uint(pmax), false, false);
    pmax = fmaxf(__uint_as_float(rr[0]), __uint_as_float(rr[1])); }
  if (__builtin_expect(__all(pmax - m_reg <= THR / SCALE), 1)) { mn = m_reg; alpha = 1.f; }
  else { mn = fmaxf(m_reg, pmax); alpha = __builtin_amdgcn_exp2f((m_reg - mn) * C); m_reg = mn; }
  float mnC = -mn * C;
  for (int r = 0; r < 16; ++r) p0[r] = fmaf(p0[r], C, mnC); for (int r = 0; r < 16; ++r) p1[r] = fmaf(p1[r], C, mnC);
  for (int r = 0; r < 16; ++r) p0[r] = __builtin_amdgcn_exp2f(p0[r]);
}
__device__ __forceinline__ void finishSM(f32x16& p0, f32x16& p1, float alpha, float& l_reg, bf16x8& pa0, bf16x8& pa1, bf16x8& pa2, bf16x8& pa3) {
  for (int r = 0; r < 16; ++r) p1[r] = __builtin_amdgcn_exp2f(p1[r]);
  float ps = 0; for (int r = 0; r < 16; ++r) ps += p0[r]; for (int r = 0; r < 16; ++r) ps += p1[r];
  { auto rr = __builtin_amdgcn_permlane32_swap(__float_as_uint(ps), __float_as_uint(ps), false, false);
    ps = __uint_as_float(rr[0]) + __uint_as_float(rr[1]); }
  l_reg = l_reg * alpha + ps;
#define PK4(P, BASE, OUT) do { unsigned a0 = cvtpk(P[BASE + 0], P[BASE + 1]), a1 = cvtpk(P[BASE + 2], P[BASE + 3]);   \
    unsigned b0 = cvtpk(P[BASE + 4], P[BASE + 5]), b1 = cvtpk(P[BASE + 6], P[BASE + 7]);                              \
    u32x4 w = {a0, a1, b0, b1}; OUT = *reinterpret_cast<bf16x8*>(&w); } while (0)
  PK4(p0, 0, pa0); PK4(p0, 8, pa1); PK4(p1, 0, pa2); PK4(p1, 8, pa3);
#undef PK4
}
__device__ __forceinline__ void qkt(f32x16& p0, f32x16& p1, const bf16* Ks, const bf16x8* qr, int r32, int hi) {
  p0 = f32x16{}; p1 = f32x16{};
  for (int d0 = 0; d0 < 8; ++d0) { int cb = (d0 * 16 + hi * 8) * 2;
    bf16x8 b0 = *reinterpret_cast<const bf16x8*>((const char*)Ks + KSWZ(r32, cb));
    bf16x8 b1 = *reinterpret_cast<const bf16x8*>((const char*)Ks + KSWZ(32 + r32, cb));
    p0 = __builtin_amdgcn_mfma_f32_32x32x16_bf16(b0, qr[d0], p0, 0, 0, 0);
    p1 = __builtin_amdgcn_mfma_f32_32x32x16_bf16(b1, qr[d0], p1, 0, 0, 0); }
}
__device__ __forceinline__ int v_st(int k, int c) { const int kk = (k & ~0xC) | ((k & 4) << 1) | ((k & 8) >> 1); return ((kk >> 3) * 4 + (c >> 5)) * 512 + ((kk & 7) * 32 + (c & 31)) * 2; }
__device__ __forceinline__ int v_rd_base(int lane) { return ((lane & 3) << 3) | (((lane >> 2) & 3) << 6) | (((lane >> 4) & 1) << 5) | (((lane >> 5) & 1) << 8); }
constexpr int v_rd_off(int d0, int ks, int half) { return d0 * 512 + ks * 4096 + half * 2048; }
template <int OFF> __device__ __forceinline__ s16x4 tr_read(int vb) {
  s16x4 r; asm volatile("ds_read_b64_tr_b16 %0, %1 offset:%2" : "=&v"(r) : "v"(vb), "i"(OFF) : "memory"); return r;
}
template <int D0> __device__ __forceinline__ void pv_one(f32x16& od, int vb, bf16x8 pa0, bf16x8 pa1, bf16x8 pa2, bf16x8 pa3) {
  const s16x4 l0 = tr_read<v_rd_off(D0, 0, 0)>(vb), h0 = tr_read<v_rd_off(D0, 0, 1)>(vb), l1 = tr_read<v_rd_off(D0, 1, 0)>(vb), h1 = tr_read<v_rd_off(D0, 1, 1)>(vb);
  const s16x4 l2 = tr_read<v_rd_off(D0, 2, 0)>(vb), h2 = tr_read<v_rd_off(D0, 2, 1)>(vb), l3 = tr_read<v_rd_off(D0, 3, 0)>(vb), h3 = tr_read<v_rd_off(D0, 3, 1)>(vb);
  asm volatile("s_waitcnt lgkmcnt(0)" ::: "memory"); SBAR();
#define PK(L, H) (bf16x8){L[0], L[1], L[2], L[3], H[0], H[1], H[2], H[3]}
  od = __builtin_amdgcn_mfma_f32_32x32x16_bf16(pa0, PK(l0, h0), od, 0, 0, 0);
  od = __builtin_amdgcn_mfma_f32_32x32x16_bf16(pa1, PK(l1, h1), od, 0, 0, 0);
  od = __builtin_amdgcn_mfma_f32_32x32x16_bf16(pa2, PK(l2, h2), od, 0, 0, 0);
  od = __builtin_amdgcn_mfma_f32_32x32x16_bf16(pa3, PK(l3, h3), od, 0, 0, 0);
#undef PK
}
struct VFrag { s16x4 l0, h0, l1, h1, l2, h2, l3, h3; };
template <int D0> __device__ __forceinline__ void pv_rd(VFrag& f, int vb) {
  f.l0 = tr_read<v_rd_off(D0, 0, 0)>(vb); f.h0 = tr_read<v_rd_off(D0, 0, 1)>(vb); f.l1 = tr_read<v_rd_off(D0, 1, 0)>(vb); f.h1 = tr_read<v_rd_off(D0, 1, 1)>(vb);
  f.l2 = tr_read<v_rd_off(D0, 2, 0)>(vb); f.h2 = tr_read<v_rd_off(D0, 2, 1)>(vb); f.l3 = tr_read<v_rd_off(D0, 3, 0)>(vb); f.h3 = tr_read<v_rd_off(D0, 3, 1)>(vb);
}
__device__ __forceinline__ void pv_mm(f32x16& od, const VFrag& f, bf16x8 pa0, bf16x8 pa1, bf16x8 pa2, bf16x8 pa3) {
#define PK(L, H) (bf16x8){L[0], L[1], L[2], L[3], H[0], H[1], H[2], H[3]}
  od = __builtin_amdgcn_mfma_f32_32x32x16_bf16(pa0, PK(f.l0, f.h0), od, 0, 0, 0);
  od = __builtin_amdgcn_mfma_f32_32x32x16_bf16(pa1, PK(f.l1, f.h1), od, 0, 0, 0);
  od = __builtin_amdgcn_mfma_f32_32x32x16_bf16(pa2, PK(f.l2, f.h2), od, 0, 0, 0);
  od = __builtin_amdgcn_mfma_f32_32x32x16_bf16(pa3, PK(f.l3, f.h3), od, 0, 0, 0);
#undef PK
}
#define PV_WAIT(n) do { asm volatile("s_waitcnt lgkmcnt(" #n ")" ::: "memory"); SBAR(); } while (0)
__device__ __forceinline__ void pv_d0(f32x16* o, int vb, bf16x8 pa0, bf16x8 pa1, bf16x8 pa2, bf16x8 pa3) {
#if MK_PVPIPE
  VFrag fa, fb;
  pv_rd<0>(fa, vb); pv_rd<1>(fb, vb);
  PV_WAIT(8); pv_mm(o[0], fa, pa0, pa1, pa2, pa3); SBAR();
  pv_rd<2>(fa, vb);
  PV_WAIT(8); pv_mm(o[1], fb, pa0, pa1, pa2, pa3); SBAR();
  pv_rd<3>(fb, vb);
  PV_WAIT(8); pv_mm(o[2], fa, pa0, pa1, pa2, pa3); SBAR();
  PV_WAIT(0); pv_mm(o[3], fb, pa0, pa1, pa2, pa3);
#else
  pv_one<0>(o[0], vb, pa0, pa1, pa2, pa3); pv_one<1>(o[1], vb, pa0, pa1, pa2, pa3); pv_one<2>(o[2], vb, pa0, pa1, pa2, pa3); pv_one<3>(o[3], vb, pa0, pa1, pa2, pa3);
#endif
}
constexpr int crow0(int r) { return (r & 3) + 8 * (r >> 2); }
constexpr float LOG2E = 1.4426950408889634f;
__device__ __forceinline__ void partialSM_neg(f32x16& p0, f32x16& p1, float& m_reg, f32x16& negm, float& alpha, int bounded) {
  if (bounded) {
    alpha = 1.f;
#pragma unroll
    for (int r = 0; r < 16; ++r) p0[r] = __builtin_amdgcn_exp2f(p0[r]);
    return;
  }
  float pmax = p0[0];
#pragma unroll
  for (int r = 1; r < 16; ++r) pmax = fmaxf(pmax, p0[r]);
#pragma unroll
  for (int r = 0; r < 16; ++r) pmax = fmaxf(pmax, p1[r]);
  { auto rr = __builtin_amdgcn_permlane32_swap(__float_as_uint(pmax), __float_as_uint(pmax), false, false);
    pmax = fmaxf(__uint_as_float(rr[0]), __uint_as_float(rr[1])); }
  if (__builtin_expect(__all(pmax <= THR), 1)) { alpha = 1.f; }
  else { const float dl = fmaxf(pmax, 0.f); m_reg += dl; alpha = __builtin_amdgcn_exp2f(-dl);
#pragma unroll
    for (int r = 0; r < 16; ++r) { p0[r] -= dl; p1[r] -= dl; negm[r] = -m_reg; } }
#pragma unroll
  for (int r = 0; r < 16; ++r) p0[r] = __builtin_amdgcn_exp2f(p0[r]);
}
__device__ __forceinline__ void partialSM_dil(f32x16& p0, f32x16& p1, float& m_reg, float& mn, float& alpha, float dq, float dlo, float dhi, float nslopeC) {
  constexpr float C = SCALE * LOG2E;
#pragma unroll
  for (int r = 0; r < 16; ++r) {
    const float d0 = dq + (float)crow0(r), d1 = d0 + 32.f;
    const float t0 = fmaf(p0[r], C, nslopeC * fabsf(d0)), t1 = fmaf(p1[r], C, nslopeC * fabsf(d1));
    p0[r] = (d0 >= dlo && d0 <= dhi) ? t0 : -1e30f;
    p1[r] = (d1 >= dlo && d1 <= dhi) ? t1 : -1e30f;
  }
  float pmax = p0[0];
#pragma unroll
  for (int r = 1; r < 16; ++r) pmax = fmaxf(pmax, p0[r]);
#pragma unroll
  for (int r = 0; r < 16; ++r) pmax = fmaxf(pmax, p1[r]);
  { auto rr = __builtin_amdgcn_permlane32_swap(__float_as_uint(pmax), __float_as_uint(pmax), false, false);
    pmax = fmaxf(__uint_as_float(rr[0]), __uint_as_float(rr[1])); }
  if (__builtin_expect(__all(pmax - m_reg <= THR * LOG2E), 1)) { mn = m_reg; alpha = 1.f; }
  else { mn = fmaxf(m_reg, pmax); alpha = __builtin_amdgcn_exp2f(m_reg - mn); m_reg = mn; }
#pragma unroll
  for (int r = 0; r < 16; ++r) { p0[r] = p0[r] - mn; p1[r] = p1[r] - mn; }
#pragma unroll
  for (int r = 0; r < 16; ++r) p0[r] = __builtin_amdgcn_exp2f(p0[r]);
}

template <bool DIL>
__device__ __forceinline__ void attn_body(const bf16* __restrict__ Qb, const bf16* __restrict__ Kh, const bf16* __restrict__ Vh, long qs, long ks,
                                          bf16* __restrict__ Ob, long os, float* __restrict__ lse_o, int lse_s, int i0, int nsub, float nslopeC, int seq, char* lds,
                                          const float* __restrict__ qgain = nullptr, const float* __restrict__ rcos = nullptr, const float* __restrict__ rsin = nullptr, int tq0 = 0) {
  typedef __attribute__((address_space(3))) unsigned lds_u32;
  using St = Stage<bf16>;
  const int tid = otid(), wid = __builtin_amdgcn_readfirstlane(tid >> 6), lane = tid & 63, r32 = lane & 31, hi = lane >> 5;
  char* V_lds = lds + 4 * SHM_K; char* K_lds = lds;
  float* ws = (float*)(lds + 4 * SHM_K + 4 * SHM_V) + wid * 64; float* li_l = ws; float* al_l = ws + 32;
  float m_reg = -1e30f, l_reg = 0; f32x16 o[4] = {}; bf16x8 qr[8];
  const bf16* Qw = Qb + (long)(wid * QBLK + r32) * qs + hi * 8;
#pragma unroll
  for (int d0 = 0; d0 < 8; ++d0) qr[d0] = St::ld8(Qw + d0 * 16);
  const int vb0 = (int)(uintptr_t)V_lds + v_rd_base(lane);
  const int kb = DIL ? i0 - 64 : 0;
#define KROW(k) (DIL ? (long)min(max(kb + (k), 0), nsub - 1) : (long)(k))
  int krow[2], kcol[2], vrow[2], vcol[2];
#pragma unroll
  for (int i = 0; i < 2; ++i) { const int pc = 2 * wid + i;
    krow[i] = pc * 4 + (lane >> 4); kcol[i] = (((lane & 15) ^ (krow[i] & 7)) << 3);
    const int sub = pc * 2 + (lane >> 5), kk = ((sub >> 2) << 3) + ((lane & 31) >> 2);
    vrow[i] = kk; vcol[i] = ((sub & 3) << 5) + ((lane & 3) << 3); }
  unsigned kdo[2], vdo[2];
#pragma unroll
  for (int i = 0; i < 2; ++i) { kdo[i] = (unsigned)(krow[i] * (int)ks + kcol[i]); vdo[i] = (unsigned)(vrow[i] * (int)ks + vcol[i]); }
#define DMA(t, buf) do { if constexpr (DIL) { _Pragma("unroll") for (int i_ = 0; i_ < 2; ++i_) { \
      __builtin_amdgcn_global_load_lds((const unsigned*)(Kh + KROW((t) * KVBLK + krow[i_]) * ks + kcol[i_]), (lds_u32*)(K_lds + (buf) * SHM_K + (2 * wid + i_) * 1024), 16, 0, 0); \
      __builtin_amdgcn_global_load_lds((const unsigned*)(Vh + KROW((t) * KVBLK + vrow[i_]) * ks + vcol[i_]), (lds_u32*)(V_lds + (buf) * SHM_V + (2 * wid + i_) * 1024), 16, 0, 0); } } \
    else { const bf16* Kt_ = Kh + (long)(t) * (KVBLK * ks); const bf16* Vt_ = Vh + (long)(t) * (KVBLK * ks); _Pragma("unroll") for (int i_ = 0; i_ < 2; ++i_) { \
      __builtin_amdgcn_global_load_lds((const unsigned*)(Kt_ + kdo[i_]), (lds_u32*)(K_lds + (buf) * SHM_K + (2 * wid + i_) * 1024), 16, 0, 0); \
      __builtin_amdgcn_global_load_lds((const unsigned*)(Vt_ + vdo[i_]), (lds_u32*)(V_lds + (buf) * SHM_V + (2 * wid + i_) * 1024), 16, 0, 0); } } } while (0)
#define ENDSTEP(j) do { if ((j) + 2 < NT) asm volatile("s_waitcnt vmcnt(4) lgkmcnt(0)\n\ts_barrier" ::: "memory"); else asm volatile("s_waitcnt vmcnt(0) lgkmcnt(0)\n\ts_barrier" ::: "memory"); } while (0)
#define RESC(a) do { if (__any((a) < 1.f)) { if (hi == 0) al_l[r32] = (a); asm volatile("s_waitcnt lgkmcnt(0)" ::: "memory"); \
    for (int d = 0; d < 4; ++d) for (int r = 0; r < 16; ++r) o[d][r] *= al_l[crow(r, hi)]; } } while (0)
#define PSM(P0, P1, MN, AL, jt) do { if constexpr (DIL) { const int t_ = otid(), iq_ = (t_ >> 6) * QBLK + (t_ & 31), hi_ = (t_ >> 5) & 1; \
      partialSM_dil(P0, P1, m_reg, MN, AL, (float)(-64 - iq_ + 4 * hi_ + 64 * (jt)), fmaxf(-64.f, (float)(-(i0 + iq_))), fminf(64.f, (float)(nsub - 1 - (i0 + iq_))), nslopeC); } \
    else partialSM(P0, P1, m_reg, MN, AL); } while (0)
#if MK_SGB
#define SGB_A() do { __builtin_amdgcn_sched_group_barrier(0x100, 4, 0); \
    _Pragma("unroll") for (int g_ = 0; g_ < 12; ++g_) { __builtin_amdgcn_sched_group_barrier(0x008, 1, 0); __builtin_amdgcn_sched_group_barrier(0x100, 1, 0); __builtin_amdgcn_sched_group_barrier(0x002, 6, 0); } \
    _Pragma("unroll") for (int g_ = 0; g_ < 4; ++g_) { __builtin_amdgcn_sched_group_barrier(0x008, 1, 0); __builtin_amdgcn_sched_group_barrier(0x002, 6, 0); } } while (0)
#else
#define SGB_A() do {} while (0)
#endif
#define KBUF(j) ((const bf16*)(K_lds + ((j) & 3) * SHM_K))
#define VBUF(j) (vb0 + ((j) & 3) * (int)SHM_V)
  f32x16 pA0, pA1, pB0, pB1; float mnA, mnB, alA, alB; bf16x8 pa0, pa1, pa2, pa3; const int NT = DIL ? 6 : seq / KVBLK;
  DMA(0, 0); DMA(1, 1);
  if constexpr (!DIL && MK_PP) { DMA(2, 2); asm volatile("s_waitcnt vmcnt(8)\n\ts_barrier" ::: "memory"); }
  else asm volatile("s_waitcnt vmcnt(4)\n\ts_barrier" ::: "memory");
#if MK_QFUSE
  if constexpr (!DIL) {
    float x[8][8]; float ss = 0.f;
#pragma unroll
    for (int d0 = 0; d0 < 8; ++d0)
#pragma unroll
      for (int i = 0; i < 8; ++i) { x[d0][i] = __uint_as_float(((unsigned)(unsigned short)qr[d0][i]) << 16); ss += x[d0][i] * x[d0][i]; }
    { auto rr = __builtin_amdgcn_permlane32_swap(__float_as_uint(ss), __float_as_uint(ss), false, false); ss = __uint_as_float(rr[0]) + __uint_as_float(rr[1]); }
    const float rstd = 1.0f / sqrtf(ss * (1.0f / 128.f) + 1e-6f), qsc = MK_NEGM ? SCALE * LOG2E : 1.0f;
    const int tpos = tq0 + wid * QBLK + r32, grow = tpos >> 6, gcol = tpos & 63;
#pragma unroll
    for (int hf = 0; hf < 2; ++hf) {
      const int trow = hf ? 128 + gcol : grow;
#pragma unroll
      for (int dd = 0; dd < 2; ++dd) { const int d0 = hf * 4 + dd, f0 = dd * 16 + hi * 8;
        const f32x8 cs = *(const f32x8*)(rcos + trow * 32 + f0), sn = *(const f32x8*)(rsin + trow * 32 + f0);
        const f32x8 g1 = *(const f32x8*)(qgain + d0 * 16 + hi * 8), g2 = *(const f32x8*)(qgain + (d0 + 2) * 16 + hi * 8);
#pragma unroll
        for (int i = 0; i < 8; ++i) { const float y1 = x[d0][i] * rstd * g1[i], y2 = x[d0 + 2][i] * rstd * g2[i];
          x[d0][i] = (y1 * cs[i] - y2 * sn[i]) * qsc; x[d0 + 2][i] = (y1 * sn[i] + y2 * cs[i]) * qsc; } } }
#pragma unroll
    for (int d0 = 0; d0 < 8; ++d0) { u32x4 w = {cvtpk(x[d0][0], x[d0][1]), cvtpk(x[d0][2], x[d0][3]), cvtpk(x[d0][4], x[d0][5]), cvtpk(x[d0][6], x[d0][7])}; qr[d0] = *reinterpret_cast<bf16x8*>(&w); }
  }
#endif
  struct KFrag { bf16x8 a, b; };
  int koff[4];
#pragma unroll
  for (int d0 = 0; d0 < 4; ++d0) koff[d0] = KSWZ(r32, (d0 * 16 + hi * 8) * 2);
  const int kbase0 = (int)(uintptr_t)K_lds;
#define KRD(f, d0, kb) asm volatile("ds_read_b128 %0, %2 offset:%3\n\tds_read_b128 %1, %2 offset:%4" : "=&v"(f.a), "=&v"(f.b) : "v"((kb) + koff[(d0) & 3]), "i"(((d0) >> 2) * 128), "i"(((d0) >> 2) * 128 + 8192) : "memory")
#define QMM(f, d0) do { pA0 = __builtin_amdgcn_mfma_f32_32x32x16_bf16(f.a, qr[d0], pA0, 0, 0, 0); pA1 = __builtin_amdgcn_mfma_f32_32x32x16_bf16(f.b, qr[d0], pA1, 0, 0, 0); } while (0)
#define LW(n) do { asm volatile("s_waitcnt lgkmcnt(" #n ")" ::: "memory"); SBAR(); } while (0)
  if constexpr (DIL) {
    const int rlo = wid >> 1;
    for (int j = 0; j < NT; ++j) {
      if (j + 2 < NT) DMA(j + 2, (j + 2) & 3);
      if (j >= rlo && j <= rlo + 2) {
        SBAR();
        { const int kb_ = kbase0 + (j & 3) * (int)SHM_K; KFrag k0_, k1_, k2_;
          KRD(k0_, 0, kb_); KRD(k1_, 1, kb_); KRD(k2_, 2, kb_); pA0 = f32x16{}; pA1 = f32x16{};
          LW(4); QMM(k0_, 0); SBAR(); KRD(k0_, 3, kb_);
          LW(4); QMM(k1_, 1); SBAR(); KRD(k1_, 4, kb_);
          LW(4); QMM(k2_, 2); SBAR(); KRD(k2_, 5, kb_);
          LW(4); QMM(k0_, 3); SBAR(); KRD(k0_, 6, kb_);
          LW(4); QMM(k1_, 4); SBAR(); KRD(k1_, 7, kb_);
          LW(4); QMM(k2_, 5); SBAR();
          LW(2); QMM(k0_, 6); SBAR();
          LW(0); QMM(k1_, 7); SBAR(); }
        PSM(pA0, pA1, mnA, alA, j); RESC(alA);
        finishSM(pA0, pA1, alA, l_reg, pa0, pa1, pa2, pa3); SBAR();
        pv_d0(o, VBUF(j), pa0, pa1, pa2, pa3);
      }
      if (j + 1 < NT) ENDSTEP(j);
    }
  } else if constexpr (MK_PP) {
    const bool grpB = wid >= 4;
#if MK_NEGM
    m_reg = 0.f; f32x16 negm = f32x16{};
#endif
#define PP_BAR(VM) do { if (VM) { asm volatile("s_waitcnt vmcnt(4) lgkmcnt(0)\n\ts_barrier" ::: "memory"); } else { asm volatile("s_waitcnt vmcnt(0) lgkmcnt(0)\n\ts_barrier" ::: "memory"); } } while (0)
#define PP_BAR_PLAIN() asm volatile("s_waitcnt lgkmcnt(0)\n\ts_barrier" ::: "memory")
    if (grpB) PP_BAR_PLAIN();
    qkt(pA0, pA1, KBUF(0), qr, r32, hi);
    if (grpB) PP_BAR(2 < NT); else PP_BAR_PLAIN();
    for (int t = 0; t < NT; ++t) {
      if (grpB && t + 3 < NT) DMA(t + 3, (t + 3) & 3);
#if MK_NEGM
      partialSM_neg(pA0, pA1, m_reg, negm, alA, i0); if (!i0) RESC(alA);
#else
      PSM(pA0, pA1, mnA, alA, t); RESC(alA);
#endif
      finishSM(pA0, pA1, alA, l_reg, pa0, pa1, pa2, pa3);
#if MK_PROBE_V
      { float dm_ = alA;
#pragma unroll
        for (int q_ = 0; q_ < 32; ++q_) asm volatile("v_add_f32 %0, %0, %0" : "+v"(dm_));
        if (dm_ == 123.456f) l_reg += 1.f; }
#endif
      if (!(MK_PREB && t + 1 < NT)) { if (!grpB) PP_BAR(t + 2 < NT); else PP_BAR_PLAIN(); }
      else if (!grpB) PP_BAR(t + 2 < NT);
      if (!grpB && t + 3 < NT) DMA(t + 3, (t + 3) & 3);
      SBAR();
      if (t + 1 < NT) {
        const int kb_ = kbase0 + ((t + 1) & 3) * (int)SHM_K, vb_ = VBUF(t);
        KFrag k0_, k1_; VFrag fa_, fb_;
        KRD(k0_, 0, kb_); KRD(k1_, 1, kb_); pv_rd<0>(fa_, vb_);
        if (MK_PREB && grpB) asm volatile("s_barrier" ::: "memory");
#if MK_NEGM
        LW(10); pA0 = __builtin_amdgcn_mfma_f32_32x32x16_bf16(k0_.a, qr[0], negm, 0, 0, 0); pA1 = __builtin_amdgcn_mfma_f32_32x32x16_bf16(k0_.b, qr[0], negm, 0, 0, 0); SBAR(); KRD(k0_, 2, kb_);
#else
        pA0 = f32x16{}; pA1 = f32x16{};
        LW(10); QMM(k0_, 0); SBAR(); KRD(k0_, 2, kb_);
#endif
        LW(10); QMM(k1_, 1); SBAR(); KRD(k1_, 3, kb_);
        LW(4);  pv_mm(o[0], fa_, pa0, pa1, pa2, pa3); SBAR(); pv_rd<1>(fb_, vb_);
        LW(10); QMM(k0_, 2); SBAR(); KRD(k0_, 4, kb_);
        LW(10); QMM(k1_, 3); SBAR(); KRD(k1_, 5, kb_);
        LW(4);  pv_mm(o[1], fb_, pa0, pa1, pa2, pa3); SBAR(); pv_rd<2>(fa_, vb_);
        LW(10); QMM(k0_, 4); SBAR(); KRD(k0_, 6, kb_);
        LW(10); QMM(k1_, 5); SBAR(); KRD(k1_, 7, kb_);
        LW(4);  pv_mm(o[2], fa_, pa0, pa1, pa2, pa3); SBAR(); pv_rd<3>(fb_, vb_);
        LW(10); QMM(k0_, 6); SBAR();
        LW(8);  QMM(k1_, 7); SBAR();
        LW(0);  pv_mm(o[3], fb_, pa0, pa1, pa2, pa3);
      } else pv_d0(o, VBUF(t), pa0, pa1, pa2, pa3);
      if (t + 1 < NT) { if (grpB) PP_BAR(t + 3 < NT); else PP_BAR_PLAIN(); }
    }
    if (!grpB) PP_BAR_PLAIN();
#undef PP_BAR
#undef PP_BAR_PLAIN
#undef KRD
#undef QMM
#undef LW
  } else {
  if (2 < NT) DMA(2, 2);
  qkt(pA0, pA1, KBUF(0), qr, r32, hi); PSM(pA0, pA1, mnA, alA, 0);
  ENDSTEP(0);
  for (int j = 1; j + 1 < NT; j += 2) {
    if (j + 2 < NT) DMA(j + 2, (j + 2) & 3);
    SBAR(); qkt(pB0, pB1, KBUF(j), qr, r32, hi);
    finishSM(pA0, pA1, alA, l_reg, pa0, pa1, pa2, pa3); SGB_A(); SBAR();
    pv_d0(o, VBUF(j - 1), pa0, pa1, pa2, pa3); PSM(pB0, pB1, mnB, alB, j);
    RESC(alB); ENDSTEP(j);
    if (j + 3 < NT) DMA(j + 3, (j + 3) & 3);
    SBAR(); qkt(pA0, pA1, KBUF(j + 1), qr, r32, hi);
    finishSM(pB0, pB1, alB, l_reg, pa0, pa1, pa2, pa3); SGB_A(); SBAR();
    pv_d0(o, VBUF(j), pa0, pa1, pa2, pa3); PSM(pA0, pA1, mnA, alA, j + 1);
    RESC(alA); ENDSTEP(j + 1);
  }
  SBAR(); qkt(pB0, pB1, KBUF(NT - 1), qr, r32, hi);
  finishSM(pA0, pA1, alA, l_reg, pa0, pa1, pa2, pa3); SBAR();
  pv_d0(o, VBUF(NT - 2), pa0, pa1, pa2, pa3); PSM(pB0, pB1, mnB, alB, NT - 1);
  RESC(alB);
  finishSM(pB0, pB1, alB, l_reg, pa0, pa1, pa2, pa3); SBAR();
  pv_d0(o, VBUF(NT - 1), pa0, pa1, pa2, pa3);
  }
  if (hi == 0) li_l[r32] = l_reg; asm volatile("s_waitcnt lgkmcnt(0)" ::: "memory");
  if constexpr (DIL) { if (hi == 0) lse_o[(long)(wid * QBLK + r32) * lse_s] = m_reg + __log2f(l_reg); }
  float rli[16];
#pragma unroll
  for (int r = 0; r < 16; ++r) rli[r] = __builtin_amdgcn_rcpf(li_l[crow(r, hi)]);
  bf16* Ow = Ob + (long)(wid * QBLK) * os;
#if MK_OSTAGE
  { char* stg = DIL ? ((wid < 4 ? K_lds : V_lds) + 2 * SHM_K + (wid & 3) * 8192) : (K_lds + wid * 8192);
#pragma unroll
    for (int r = 0; r < 16; ++r) { const int orow = crow(r, hi);
#pragma unroll
      for (int d0 = 0; d0 < 4; ++d0) *(bf16*)(stg + orow * 256 + (d0 * 32 + r32) * 2) = __float2bfloat16(o[d0][r] * rli[r]); }
    asm volatile("s_waitcnt lgkmcnt(0)" ::: "memory");
#pragma unroll
    for (int i = 0; i < 8; ++i) { const int row = i * 4 + (lane >> 4), ch = lane & 15;
      const u32x4 v = *(const u32x4*)(stg + row * 256 + ch * 16);
      *(u32x4*)(Ow + (long)row * os + ch * 8) = v; } }
#else
#pragma unroll
  for (int r = 0; r < 16; ++r) { const int orow = crow(r, hi);
#pragma unroll
    for (int d0 = 0; d0 < 4; ++d0) Ow[(long)orow * os + d0 * 32 + r32] = __float2bfloat16(o[d0][r] * rli[r]); }
#endif
  asm volatile("s_waitcnt lgkmcnt(0)\n\ts_barrier" ::: "memory");
#undef KROW
#undef DMA
#undef ENDSTEP
#undef RESC
#undef PSM
#undef KBUF
#undef SGB_A
#undef VBUF
}
}

#define GAS __attribute__((address_space(1)))
#define LAS __attribute__((address_space(3)))
typedef unsigned short bf16_t;
typedef unsigned v4u __attribute__((ext_vector_type(4)));
typedef unsigned v2u __attribute__((ext_vector_type(2)));
typedef float f32x4 __attribute__((ext_vector_type(4)));
#define LDS_WAIT() asm volatile("s_waitcnt lgkmcnt(0)" ::: "memory")

constexpr size_t MiB = 1u << 20;
constexpr size_t WS_W1T = 0;
constexpr size_t WS_W2T = 104 * MiB;
constexpr size_t WS_H = 136 * MiB;
constexpr size_t WS_PROJ = 200 * MiB;
constexpr size_t WS_YA = 408 * MiB;
constexpr size_t WS_YB = 440 * MiB;
constexpr size_t WS_LSE = 536 * MiB;
constexpr size_t WS_ROPE = 538 * MiB;
constexpr size_t WS_XB = 540 * MiB;
constexpr size_t WS_ROWSQ = 604 * MiB;
constexpr size_t WS_END = 616 * MiB;
static_assert((size_t)DEPTH * DIN * DM * 2 <= WS_W2T - WS_W1T && (size_t)M * DIN * 2 <= WS_YA - WS_PROJ && (size_t)3 * M * DB * 2 <= WS_LSE - WS_YB, "ws map");
constexpr int LDS_BYTES = 147456;
constexpr int N_PHASES = 2 + 5 * DEPTH;

__device__ __forceinline__ unsigned f2bf(float f) { unsigned u = __builtin_bit_cast(unsigned, f); return (u + 0x7fffu + ((u >> 16) & 1u)) >> 16; }
__device__ __forceinline__ unsigned pk2(float lo, float hi) { return f2bf(lo) | (f2bf(hi) << 16); }
__device__ __forceinline__ float bflo(unsigned w) { return __uint_as_float(w << 16); }
__device__ __forceinline__ float bfhi(unsigned w) { return __uint_as_float(w & 0xffff0000u); }
__device__ __forceinline__ float wave_sum(float v) {
#pragma unroll
    for (int o = 1; o < 64; o <<= 1) v += __shfl_xor(v, o);
    return v;
}

__device__ const float INV_FREQ[32] = {1.000000000e+00f, 7.498942614e-01f, 5.623413324e-01f, 4.216965139e-01f, 3.162277639e-01f, 2.371373773e-01f, 1.778279394e-01f, 1.333521307e-01f,
    1.000000015e-01f, 7.498941571e-02f, 5.623413250e-02f, 4.216965288e-02f, 3.162277490e-02f, 2.371373773e-02f, 1.778279431e-02f, 1.333521493e-02f,
    9.999999776e-03f, 7.498941850e-03f, 5.623413250e-03f, 4.216964822e-03f, 3.162277630e-03f, 2.371373586e-03f, 1.778279431e-03f, 1.333521446e-03f,
    1.000000047e-03f, 7.498942432e-04f, 5.623413017e-04f, 4.216965172e-04f, 3.162277571e-04f, 2.371373703e-04f, 1.778279402e-04f, 1.333521504e-04f};

__device__ __forceinline__ void sincos_acc(float a, float& s, float& c) {
    const double x = (double)a, kd = __builtin_rint(x * 0.63661977236758134308);
    const int k = (int)kd; const double r = x - kd * 1.57079632679489661923, r2 = r * r;
    const double sp = r * (1.0 + r2 * (-1.0 / 6 + r2 * (1.0 / 120 + r2 * (-1.0 / 5040 + r2 * (1.0 / 362880 + r2 * (-1.0 / 39916800 + r2 * (1.0 / 6227020800.0)))))));
    const double cp = 1.0 + r2 * (-0.5 + r2 * (1.0 / 24 + r2 * (-1.0 / 720 + r2 * (1.0 / 40320 + r2 * (-1.0 / 3628800 + r2 * (1.0 / 479001600.0 + r2 * (-1.0 / 87178291200.0)))))));
    const int q = k & 3;
    const double sv = (q == 0) ? sp : (q == 1) ? cp : (q == 2) ? -sp : -cp, cv = (q == 0) ? cp : (q == 1) ? -sp : (q == 2) ? -cp : sp;
    s = (float)sv; c = (float)cv;
}

__device__ __forceinline__ void p0_transpose_item(const float* W, int K, int N, bf16_t* WT, LAS float* scr, int item, int lane, const float* kscale) {
    const int nblk = N / 32, kb = item / nblk, nb = item % nblk, k0 = 64 * kb, n0 = 32 * nb;
#pragma unroll 8
    for (int i = 0; i < 32; ++i) { const int kk = 2 * i + (lane >> 5); scr[kk * 33 + (lane & 31)] = W[(size_t)(k0 + kk) * N + n0 + (lane & 31)] * (kscale ? kscale[k0 + kk] : 1.0f); }
    LDS_WAIT(); asm volatile("" ::: "memory");
    const int c = lane & 7;
#pragma unroll
    for (int j = 0; j < 4; ++j) { const int n = (lane >> 3) + 8 * j; const LAS float* s = scr + (8 * c) * 33 + n;
        v4u o; o.x = pk2(s[0 * 33], s[1 * 33]); o.y = pk2(s[2 * 33], s[3 * 33]); o.z = pk2(s[4 * 33], s[5 * 33]); o.w = pk2(s[6 * 33], s[7 * 33]);
        *(v4u*)(WT + (size_t)(n0 + n) * K + k0 + 8 * c) = o; }
    LDS_WAIT(); asm volatile("" ::: "memory");
}

#define XB_TMO      128
#define XB_XCNT(j)  (256  + 64 * (j))
#define XB_XSUB(j)  (1280 + 64 * (j))
#define XB_XGEN(j)  (2304 + 64 * (j))
#define XB_TOP      3328
#define XB_TOPGEN   3392
#define XCD_BAR_WORDS 3456
#define XB_SPIN_CAP (1u << 18)

__device__ __forceinline__ unsigned xb_ld(unsigned* p)              { return __hip_atomic_load(p, __ATOMIC_RELAXED, __HIP_MEMORY_SCOPE_AGENT); }
__device__ __forceinline__ unsigned xb_add(unsigned* p, unsigned v) { return __hip_atomic_fetch_add(p, v, __ATOMIC_RELAXED, __HIP_MEMORY_SCOPE_AGENT); }
__device__ __forceinline__ unsigned xb_xcc_id() { return (unsigned)__builtin_amdgcn_s_getreg((3 << 11) | 20) & 0xFu; }
#define XB_SPIN(cond, bar) do { unsigned _sp = 0; while (cond) { __builtin_amdgcn_s_sleep(1); \
    if ((++_sp & 255u) == 0u) { if (xb_ld(&(bar)[XB_TMO])) break; if (_sp > XB_SPIN_CAP) { atomicAdd(&(bar)[XB_TMO], 1u); break; } } } } while (0)

struct XcdBarrier {
    unsigned* bar; unsigned x;
    volatile LAS unsigned* st;
};

__device__ __forceinline__ XcdBarrier xcd_barrier_post(unsigned* bar, volatile LAS unsigned* st) {
    XcdBarrier b; b.bar = bar; b.x = xb_xcc_id(); b.st = st;
    if (threadIdx.x == 0) (void)xb_add(&bar[XB_XCNT(b.x)], 1u);
    return b;
}
__device__ __forceinline__ void xcd_barrier_complete(unsigned* bar, unsigned x, unsigned& nloc, unsigned& nx) {
    const unsigned G = gridDim.x * gridDim.y * gridDim.z;
    unsigned sum, cnt, mine, sp = 0u;
    for (;;) {
        sum = 0u; cnt = 0u; mine = 0u;
#pragma unroll
        for (unsigned j = 0; j < 16; ++j) { const unsigned c = xb_ld(&bar[XB_XCNT(j)]); sum += c; cnt += (c > 0u) ? 1u : 0u; mine = (j == x) ? c : mine; }
        if (sum == G) break;
        __builtin_amdgcn_s_sleep(1);
        if ((++sp & 255u) == 0u) { if (xb_ld(&bar[XB_TMO])) break; if (sp > XB_SPIN_CAP) { atomicAdd(&bar[XB_TMO], 1u); break; } }
    }
    nloc = mine > 0u ? mine : 1u; nx = cnt > 0u ? cnt : 1u;
}

__device__ __forceinline__ void xcd_barrier(const XcdBarrier& b) {
    asm volatile("s_waitcnt vmcnt(0)" ::: "memory");
    __syncthreads();
    if (threadIdx.x == 0) {
        unsigned* bar = b.bar;
        __builtin_amdgcn_s_waitcnt(0);
        unsigned nloc = b.st[0], nx = b.st[1];
        if (nloc == 0u) { xcd_barrier_complete(bar, b.x, nloc, nx); b.st[0] = nloc; b.st[1] = nx; }
        const unsigned old = xb_add(&bar[XB_XSUB(b.x)], 1u);
        const unsigned gen = old / nloc;
        if (old + 1u == (gen + 1u) * nloc) {
            __builtin_amdgcn_fence(__ATOMIC_RELEASE, "agent");
            asm volatile("s_waitcnt vmcnt(0)" ::: "memory");
            const unsigned og = xb_add(&bar[XB_TOP], 1u);
            const unsigned tg = og / nx;
            if (og + 1u == (tg + 1u) * nx) xb_add(&bar[XB_TOPGEN], 1u);
            else XB_SPIN(xb_ld(&bar[XB_TOPGEN]) == tg, bar);
            __builtin_amdgcn_fence(__ATOMIC_ACQUIRE, "agent");
            xb_add(&bar[XB_XGEN(b.x)], 1u);
            asm volatile("s_waitcnt vmcnt(0)" ::: "memory");
        } else {
            XB_SPIN(xb_ld(&bar[XB_XGEN(b.x)]) == gen, bar);
            __builtin_amdgcn_fence(__ATOMIC_ACQUIRE, "agent");
            asm volatile("s_waitcnt vmcnt(0)" ::: "memory");
        }
    }
    __syncthreads();
}

constexpr size_t WS_CTL = 539 * MiB, CTL_BYTES = 16384;
constexpr int MISC_OFF = 147456 - 128;
__device__ __forceinline__ void gate_row(int m, int lane, const bf16_t* __restrict__ YA, const bf16_t* __restrict__ YB, const float* __restrict__ LSE, const bf16_t* __restrict__ PROJ,
                                         const float* __restrict__ wa, const float* __restrict__ wb, bf16_t* __restrict__ H) {
    v4u a[2], b0[2], b1[2], b2[2], ga[2], gb[2]; float l0[2], l1[2], l2[2];
#pragma unroll
    for (int j = 0; j < 2; ++j) { const int c = lane + 64 * j, hh = c >> 4;
        a[j] = *(const v4u*)(YA + (size_t)m * DA + 8 * c);
        b0[j] = *(const v4u*)(YB + ((size_t)0 * M + m) * DB + 8 * c); b1[j] = *(const v4u*)(YB + ((size_t)1 * M + m) * DB + 8 * c); b2[j] = *(const v4u*)(YB + ((size_t)2 * M + m) * DB + 8 * c);
        l0[j] = LSE[((size_t)0 * M + m) * 8 + hh]; l1[j] = LSE[((size_t)1 * M + m) * 8 + hh]; l2[j] = LSE[((size_t)2 * M + m) * 8 + hh];
        ga[j] = *(const v4u*)(PROJ + ((size_t)(H_GA + (c >> 4)) * M + m) * HD + 8 * (c & 15)); gb[j] = *(const v4u*)(PROJ + ((size_t)(H_GB + (c >> 4)) * M + m) * HD + 8 * (c & 15)); }
    float ya[2][8], yb[2][8]; float ssa = 0.f, ssb = 0.f;
#pragma unroll
    for (int j = 0; j < 2; ++j) {
        ya[j][0] = bflo(a[j].x); ya[j][1] = bfhi(a[j].x); ya[j][2] = bflo(a[j].y); ya[j][3] = bfhi(a[j].y); ya[j][4] = bflo(a[j].z); ya[j][5] = bfhi(a[j].z); ya[j][6] = bflo(a[j].w); ya[j][7] = bfhi(a[j].w);
        const float mx = fmaxf(l0[j], fmaxf(l1[j], l2[j])); const float e0 = __builtin_amdgcn_exp2f(l0[j] - mx), e1 = __builtin_amdgcn_exp2f(l1[j] - mx), e2 = __builtin_amdgcn_exp2f(l2[j] - mx);
        const float inv = __builtin_amdgcn_rcpf(e0 + e1 + e2); const float w0 = e0 * inv, w1 = e1 * inv, w2 = e2 * inv;
        yb[j][0] = w0 * bflo(b0[j].x) + w1 * bflo(b1[j].x) + w2 * bflo(b2[j].x); yb[j][1] = w0 * bfhi(b0[j].x) + w1 * bfhi(b1[j].x) + w2 * bfhi(b2[j].x);
        yb[j][2] = w0 * bflo(b0[j].y) + w1 * bflo(b1[j].y) + w2 * bflo(b2[j].y); yb[j][3] = w0 * bfhi(b0[j].y) + w1 * bfhi(b1[j].y) + w2 * bfhi(b2[j].y);
        yb[j][4] = w0 * bflo(b0[j].z) + w1 * bflo(b1[j].z) + w2 * bflo(b2[j].z); yb[j][5] = w0 * bfhi(b0[j].z) + w1 * bfhi(b1[j].z) + w2 * bfhi(b2[j].z);
        yb[j][6] = w0 * bflo(b0[j].w) + w1 * bflo(b1[j].w) + w2 * bflo(b2[j].w); yb[j][7] = w0 * bfhi(b0[j].w) + w1 * bfhi(b1[j].w) + w2 * bfhi(b2[j].w);
#pragma unroll
        for (int i = 0; i < 8; ++i) { ssa += ya[j][i] * ya[j][i]; ssb += yb[j][i] * yb[j][i]; } }
    const float ra = 1.0f / sqrtf(wave_sum(ssa) * (1.0f / DA) + EPS), rb = 1.0f / sqrtf(wave_sum(ssb) * (1.0f / DB) + EPS);
#pragma unroll
    for (int j = 0; j < 2; ++j) { const int c = lane + 64 * j;
        const float gaf[8] = {bflo(ga[j].x), bfhi(ga[j].x), bflo(ga[j].y), bfhi(ga[j].y), bflo(ga[j].z), bfhi(ga[j].z), bflo(ga[j].w), bfhi(ga[j].w)};
        const float gbf[8] = {bflo(gb[j].x), bfhi(gb[j].x), bflo(gb[j].y), bfhi(gb[j].y), bflo(gb[j].z), bfhi(gb[j].z), bflo(gb[j].w), bfhi(gb[j].w)};
        const f32x4 wa0 = *(const f32x4*)(wa + 8 * c), wa1 = *(const f32x4*)(wa + 8 * c + 4), wb0 = *(const f32x4*)(wb + 8 * c), wb1 = *(const f32x4*)(wb + 8 * c + 4);
        float za[8], zb[8];
#pragma unroll
        for (int i = 0; i < 8; ++i) { const float wai = i < 4 ? wa0[i & 3] : wa1[i & 3], wbi = i < 4 ? wb0[i & 3] : wb1[i & 3];
            const float sa = gaf[i] * __builtin_amdgcn_rcpf(1.0f + __builtin_amdgcn_exp2f(-1.4426950408889634f * gaf[i])), sb = gbf[i] * __builtin_amdgcn_rcpf(1.0f + __builtin_amdgcn_exp2f(-1.4426950408889634f * gbf[i]));
            za[i] = ya[j][i] * ra * wai * sa; zb[i] = yb[j][i] * rb * wbi * sb; }
        v4u oa, ob; oa.x = pk2(za[0], za[1]); oa.y = pk2(za[2], za[3]); oa.z = pk2(za[4], za[5]); oa.w = pk2(za[6], za[7]);
        ob.x = pk2(zb[0], zb[1]); ob.y = pk2(zb[2], zb[3]); ob.z = pk2(zb[4], zb[5]); ob.w = pk2(zb[6], zb[7]);
        *(v4u*)(H + (size_t)m * DM + 8 * c) = oa; *(v4u*)(H + (size_t)m * DM + DA + 8 * c) = ob; }
}

struct Params { const float *x, *norm_w, *w_in, *qn, *kn, *ona, *onb, *w_out, *fnorm; float* out; unsigned char* ws; int ph_lo, ph_hi; };

__global__ void __launch_bounds__(512, 2) mk_fwd(Params p) {
    extern __shared__ __attribute__((aligned(16))) unsigned char lds[];
    volatile LAS unsigned* MISC = (volatile LAS unsigned*)((LAS unsigned char*)lds + MISC_OFF);
    if (threadIdx.x < 32) MISC[threadIdx.x] = 0u;
    __syncthreads();
    XcdBarrier bar = xcd_barrier_post((unsigned*)(p.ws + WS_CTL), MISC + 8);
    if (p.ph_lo == 0) {
        float* RCOS0 = (float*)(p.ws + WS_ROPE); float* RSIN0 = RCOS0 + 192 * 32;
        for (int i = blockIdx.x * 512 + threadIdx.x; i < 192 * 32; i += gridDim.x * 512) {
            const int pos = i >> 5, f = i & 31; const float pv = (float)(pos < 128 ? pos : pos - 128);
            float sn_, cs_; sincos_acc(pv * INV_FREQ[f], sn_, cs_); RCOS0[i] = cs_; RSIN0[i] = sn_;
        }
    }
    for (int ph = p.ph_lo; ph < p.ph_hi; ++ph) {
        const int tid = otid(), lane = tid & 63, wave = __builtin_amdgcn_readfirstlane(tid >> 6);
        int G = gridDim.x, bx = blockIdx.x; asm volatile("" : "+s"(G), "+s"(bx));
        const int vcu = (G % 8 == 0) ? (bx % 8) * (G / 8) + bx / 8 : bx;
        const int gw = vcu * 8 + wave, NGW = G * 8;
        size_t zoff = 0; asm volatile("" : "+s"(zoff));
        unsigned char* ws = p.ws + zoff;
        bf16_t* W1T = (bf16_t*)(ws + WS_W1T); bf16_t* W2T = (bf16_t*)(ws + WS_W2T); bf16_t* H = (bf16_t*)(ws + WS_H); bf16_t* PROJ = (bf16_t*)(ws + WS_PROJ);
        bf16_t* YA = (bf16_t*)(ws + WS_YA); bf16_t* YB = (bf16_t*)(ws + WS_YB); float* LSE = (float*)(ws + WS_LSE);
        float* RCOS = (float*)(ws + WS_ROPE); float* RSIN = RCOS + 192 * 32;
        bf16_t* XB = (bf16_t*)(ws + WS_XB); float* ROWSQ = (float*)(ws + WS_ROWSQ);
        if (ph == 0) {
            LAS float* scr = (LAS float*)((LAS unsigned char*)lds + wave * 16384);
            constexpr int I1 = (DM / 64) * (DIN / 32), I2 = (DM / 64) * (DM / 32), IL = I1 + I2;
            DUPREP(0) for (int it = gw; it < DEPTH * IL; it += NGW) {
                const int l = it / IL, r = it % IL;
                if (r < I1) p0_transpose_item(p.w_in + (size_t)l * DM * DIN, DM, DIN, W1T + (size_t)l * DIN * DM, scr, r, lane, p.norm_w + (size_t)l * DM);
                else p0_transpose_item(p.w_out + (size_t)l * DM * DM, DM, DM, W2T + (size_t)l * DM * DM, scr, r - I1, lane, nullptr);
            }
            for (int m = gw; m < M; m += NGW) {
                const f32x4* xr = (const f32x4*)(p.x + (size_t)m * DM) + lane; v2u* o8 = (v2u*)(XB + (size_t)m * DM) + lane; float sq = 0.f;
#pragma unroll
                for (int j = 0; j < 8; ++j) { const f32x4 v = xr[64 * j]; v2u w; w.x = pk2(v.x, v.y); w.y = pk2(v.z, v.w); o8[64 * j] = w;
                    const float r0 = bflo(w.x), r1 = bfhi(w.x), r2 = bflo(w.y), r3 = bfhi(w.y); sq += (r0 * r0 + r1 * r1) + (r2 * r2 + r3 * r3); }
                sq = wave_sum(sq); if (lane < 32) ROWSQ[(size_t)m * 32 + lane] = (lane == 0) ? sq : 0.f;
            }
        } else if (ph == N_PHASES - 1) {
            for (int m = gw; m < M; m += NGW) {
                f32x4* xr = (f32x4*)(p.out + (size_t)m * DM) + lane; const f32x4* wr_ = (const f32x4*)p.fnorm + lane; const v2u* xb8 = (const v2u*)(XB + (size_t)m * DM) + lane;
                const float rstd = 1.0f / sqrtf(wave_sum(lane < 32 ? ROWSQ[((size_t)DEPTH * M + m) * 32 + lane] : 0.f) * (1.0f / DM) + EPS);
#pragma unroll
                for (int j = 0; j < 8; ++j) { const v2u w = xb8[64 * j]; const f32x4 v = {bflo(w.x), bfhi(w.x), bflo(w.y), bfhi(w.y)}; xr[64 * j] = v * rstd * wr_[64 * j]; }
            }
        } else {
            const int l = (ph - 1) / 5, st = (ph - 1) % 5 + 1;
            if (st == 1) {
                pg8::Gemm g{XB, W1T + (size_t)l * DIN * DM, M, DIN, DM}; pg8::StaticOrder S; S.init(M, DIN, G, bx);
                pg8::EpiHeadMajor E{PROJ, M, ROWSQ + (size_t)l * M * 32, 1.0f / DM, EPS};
#ifndef MK_NO_G1
                DUPREP(2) pg8::gemm_phase<pg8::EpiHeadMajor, pg8::StaticOrder, PG8_ALIGN, PG8_SP2>((PG8_LAS unsigned char*)lds, g, S, E);
#endif
            } else if (st == 2) {
                const float* qg = p.qn + l * HD; const float* kg = p.kn + l * HD;
                constexpr int QKU = 4;
                constexpr int NQKI = MK_QFUSE ? M * 2 / 4 : M * 10 / 4;
                for (int it0 = gw; it0 < NQKI; it0 += QKU * NGW) {
                    const int j = lane & 15, half = j >> 3, jj = j & 7, e = half * 64 + 4 * jj;
                    v2u a[QKU], b[QKU]; f32x4 cs[QKU], sn[QKU]; bf16_t* pp[QKU]; bool isq[QKU];
#pragma unroll
                    for (int u = 0; u < QKU; ++u) { const int it = min(it0 + u * NGW, NQKI - 1);
                        const int g = it * 4 + (lane >> 4), row = MK_QFUSE ? (g >> 1) : g / 10, hs = MK_QFUSE ? 8 + (g & 1) : g - row * 10; isq[u] = hs < 8;
                        pp[u] = PROJ + ((size_t)hs * M + row) * HD + e; a[u] = *(const v2u*)pp[u]; b[u] = *(const v2u*)(pp[u] + 32);
                        const int t = row & (T - 1), pos = half ? 128 + (t & 63) : (t >> 6);
                        cs[u] = *(const f32x4*)(RCOS + pos * 32 + 4 * jj); sn[u] = *(const f32x4*)(RSIN + pos * 32 + 4 * jj); }
                    asm volatile("" ::: "memory");
#pragma unroll
                    for (int u = 0; u < QKU; ++u) {
                        float x1[4] = {bflo(a[u].x), bfhi(a[u].x), bflo(a[u].y), bfhi(a[u].y)}, x2[4] = {bflo(b[u].x), bfhi(b[u].x), bflo(b[u].y), bfhi(b[u].y)};
                        float ss = 0.f;
#pragma unroll
                        for (int i = 0; i < 4; ++i) ss += x1[i] * x1[i] + x2[i] * x2[i];
                        ss += __shfl_xor(ss, 1); ss += __shfl_xor(ss, 2); ss += __shfl_xor(ss, 4); ss += __shfl_xor(ss, 8);
                        const float rstd = 1.0f / sqrtf(ss * (1.0f / HD) + EPS);
                        const float* gn = isq[u] ? qg : kg;
                        const float qsc = (MK_NEGM && isq[u]) ? att::SCALE * att::LOG2E : 1.0f;
                        const f32x4 g1 = *(const f32x4*)(gn + e), g2 = *(const f32x4*)(gn + e + 32);
                        float o1[4], o2[4];
#pragma unroll
                        for (int i = 0; i < 4; ++i) { const float y1 = x1[i] * rstd * g1[i], y2 = x2[i] * rstd * g2[i]; o1[i] = (y1 * cs[u][i] - y2 * sn[u][i]) * qsc; o2[i] = (y1 * sn[u][i] + y2 * cs[u][i]) * qsc; }
                        v2u w1, w2; w1.x = pk2(o1[0], o1[1]); w1.y = pk2(o1[2], o1[3]); w2.x = pk2(o2[0], o2[1]); w2.y = pk2(o2[2], o2[3]);
                        if (it0 + u * NGW < NQKI) { *(v2u*)pp[u] = w1; *(v2u*)(pp[u] + 32) = w2; }
                    }
                }
#ifndef MK_NO_DIL
                DUPREP(3) for (int u = vcu; u < 1536; u += G) {
                    const int pt = u >> 9, rem = u & 511, b = rem >> 8, h = (rem >> 5) & 7, w = rem & 31;
                    const int d = (pt == 0) ? 1 : (pt == 1) ? 4 : 16, res = w & (d - 1), blk = w / d, i0 = blk * 256, nsub = T / d;
                    const float slope = __builtin_amdgcn_exp2f(-(float)(h + 1));
                    const float nslopeC = -slope * (float)d * att::LOG2E;
                    const size_t tok0 = (size_t)b * T + res;
                    const att::bf16* Pb = (const att::bf16*)PROJ + ((size_t)h * M + tok0) * HD;
                    const long rs = (long)d * HD;
                    att::attn_body<true>(Pb + (size_t)H_QB * M * HD + (long)i0 * rs, Pb + (size_t)H_KB * M * HD, Pb + (size_t)H_VB * M * HD, rs, rs,
                                         (att::bf16*)YB + ((size_t)pt * M + tok0 + (size_t)i0 * d) * DB + h * HD, (long)d * DB,
                                         LSE + ((size_t)pt * M + tok0 + (size_t)i0 * d) * 8 + h, d * 8, i0, nsub, nslopeC, 0, (char*)lds);
                }
#endif
            } else if (st == 3) {
#ifndef MK_NO_DENSE
                int bounded;
                { const float* qg = p.qn + l * HD; const float* kg = p.kn + l * HD;
                  float gq = fmaxf(fabsf(qg[lane]), fabsf(qg[lane + 64])), gk = fmaxf(fabsf(kg[lane]), fabsf(kg[lane + 64]));
#pragma unroll
                  for (int o_ = 1; o_ < 64; o_ <<= 1) { gq = fmaxf(gq, __shfl_xor(gq, o_)); gk = fmaxf(gk, __shfl_xor(gk, o_)); }
                  const float bnd = gq * gk * 128.f * att::SCALE * att::LOG2E;
                  bounded = __builtin_amdgcn_readfirstlane((MK_NEGM && bnd <= 64.f) ? 1 : 0); }
                DUPREP(4) for (int u = vcu; u < 512; u += G) {
                    const int combo = u >> 7, b = combo >> 1, kvh = combo & 1, h = kvh * 4 + ((u >> 5) & 3), qb = u & 31;
                    const att::bf16* Pb = (const att::bf16*)PROJ + (size_t)b * T * HD;
                    att::attn_body<false>(Pb + ((size_t)(H_QA + h) * M + qb * 256) * HD, Pb + (size_t)(H_KA + kvh) * M * HD, Pb + (size_t)(H_VA + kvh) * M * HD, HD, HD,
                                          (att::bf16*)YA + ((size_t)b * T + qb * 256) * DA + h * HD, DA, nullptr, 0, bounded, 0, 0.f, T, (char*)lds,
                                          p.qn + l * HD, RCOS, RSIN, qb * 256);
                }
#endif
            } else if (st == 4) {
                const float* wa = p.ona + (size_t)l * DA; const float* wb = p.onb + (size_t)l * DB;
                DUPREP(5) for (int m = gw; m < M; m += 2 * NGW) {
                    gate_row(m, lane, YA, YB, LSE, PROJ, wa, wb, H);
                    if (m + NGW < M) gate_row(m + NGW, lane, YA, YB, LSE, PROJ, wa, wb, H);
                }
            } else {
                pg8::Gemm g{H, W2T + (size_t)l * DM * DM, M, DM, DM}; pg8::StaticOrder S; S.init(M, DM, G, bx);
                pg8::EpiResF32 E{XB, ROWSQ + (size_t)(l + 1) * M * 32, DM};
#ifndef MK_NO_G2
                pg8::gemm_phase<pg8::EpiResF32, pg8::StaticOrder, PG8_ALIGN, PG8_SP2>((PG8_LAS unsigned char*)lds, g, S, E);
#endif
            }
        }
        if (ph + 1 < p.ph_hi) { if (p.ph_hi > 4096) cg::this_grid().sync(); else xcd_barrier(bar); if (MK_DUP & 64) xcd_barrier(bar); }
    }
}

extern "C" void kernel_launch(void* const* d_in, const int* in_sizes, int n_in, void* d_out, int out_size, void* d_ws, size_t ws_size, hipStream_t stream) {
    static int grid = 0;
    if (grid == 0) {
        if (n_in != 9 || in_sizes[0] != M * DM || out_size != M * DM || ws_size < WS_END) { fprintf(stderr, "kernel_launch: unexpected shapes (n_in %d, ws %zu)\n", n_in, ws_size); grid = -1; return; }
        int dev = 0, cus = 0, per_cu = 0;
        hipGetDevice(&dev); hipDeviceGetAttribute(&cus, hipDeviceAttributeMultiprocessorCount, dev);
        if (hipFuncSetAttribute((const void*)mk_fwd, hipFuncAttributeMaxDynamicSharedMemorySize, LDS_BYTES) != hipSuccess) { fprintf(stderr, "kernel_launch: hipFuncSetAttribute failed\n"); grid = -1; return; }
        if (hipOccupancyMaxActiveBlocksPerMultiprocessor(&per_cu, (const void*)mk_fwd, 512, LDS_BYTES) != hipSuccess || per_cu < 1) per_cu = 1;
        (void)hipGetLastError();
        grid = cus * per_cu;
    }
    if (grid < 0) return;
    Params p{};
    p.x = (const float*)d_in[0]; p.norm_w = (const float*)d_in[1]; p.w_in = (const float*)d_in[2]; p.qn = (const float*)d_in[3]; p.kn = (const float*)d_in[4];
    p.ona = (const float*)d_in[5]; p.onb = (const float*)d_in[6]; p.w_out = (const float*)d_in[7]; p.fnorm = (const float*)d_in[8];
    p.out = (float*)d_out; p.ws = (unsigned char*)d_ws;
    if (hipMemsetAsync((char*)d_ws + WS_CTL, 0, CTL_BYTES, stream) != hipSuccess) { fprintf(stderr, "kernel_launch: memset failed\n"); return; }
#if MK_ONE_LAUNCH
    p.ph_lo = 0; p.ph_hi = N_PHASES;
    void* args[] = {&p};
    hipError_t e = hipLaunchCooperativeKernel((const void*)mk_fwd, dim3(grid), dim3(512), args, LDS_BYTES, stream);
    if (e != hipSuccess) fprintf(stderr, "kernel_launch: cooperative launch failed: %s (grid %d)\n", hipGetErrorString(e), grid);
#else
    for (int ph = 0; ph < N_PHASES; ++ph) { p.ph_lo = ph; p.ph_hi = ph + 1; hipLaunchKernelGGL(mk_fwd, dim3(grid), dim3(512), LDS_BYTES, stream, p); }
#endif
}
```

```cpp
#include <hip/hip_runtime.h>
#include <hip/hip_bf16.h>
#include <hip/hip_cooperative_groups.h>
#include <cstdio>
#include <cstdint>
namespace cg = cooperative_groups;

#ifndef MK_DUP
#define MK_DUP 0
#endif
#define DUPREP(k) for (int rep_ = 0; rep_ < 1 + ((MK_DUP >> (k)) & 1); ++rep_)
#ifndef MK_PVPIPE
#define MK_PVPIPE 1
#endif
#ifndef MK_SGB
#define MK_SGB 0
#endif
#ifndef MK_PP
#define MK_PP 1
#endif
#ifndef MK_PROBE_V
#define MK_PROBE_V 0
#endif
#ifndef MK_NEGM
#define MK_NEGM 1
#endif
#ifndef MK_PREB
#define MK_PREB 1
#endif
#ifndef MK_OSTAGE
#define MK_OSTAGE 1
#endif
#ifndef MK_QFUSE
#define MK_QFUSE 1
#endif
#ifndef MK_ONE_LAUNCH
#define MK_ONE_LAUNCH 1
#endif
static_assert(!MK_NEGM || MK_PP, "MK_NEGM pre-scales q for the ping-pong dense body only");

constexpr int BATCH = 2, T = 8192, DM = 2048, DEPTH = 4, HD = 128, DA = 1024, DB = 1024, DIN = 6656, M = BATCH * T;
constexpr int C_QA = 0, C_KA = 1024, C_VA = 1280, C_GA = 1536, C_QB = 2560, C_KB = 3584, C_VB = 4608, C_GB = 5632;
constexpr int H_QA = 0, H_KA = 8, H_VA = 10, H_GA = 12, H_QB = 20, H_KB = 28, H_VB = 36, H_GB = 44;
constexpr float EPS = 1e-6f;
__device__ __forceinline__ int otid() { int t = threadIdx.x; asm volatile("" : "+v"(t)); return t; }

namespace pg8 {
#define PG8_LAS __attribute__((address_space(3)))
typedef unsigned short bf16_t;
typedef short bf16x8 __attribute__((ext_vector_type(8)));
typedef float f32x4 __attribute__((ext_vector_type(4)));
typedef unsigned u32x4 __attribute__((ext_vector_type(4)));
constexpr int BM = 256, BK = 64, HALF = 128, HTB = HALF * BK * 2  , STAGE_BYTES = 8 * HTB, NXCD = 8, WGM = 4;

__host__ __device__ __forceinline__ int lds_byte(int r, int c) { const int st = (r >> 4) * 2 + (c >> 5), rr = r & 15, cc = c & 31, ob = rr * 64 + cc * 2; return st * 1024 + (ob ^ (((ob >> 9) & 1) << 5)); }
__host__ __device__ __forceinline__ void stage_rc(int b, int& R, int& C) { const int st = b / 1024, sb = b % 1024, swz = sb ^ (((sb >> 9) & 1) << 5); R = (st >> 1) * 16 + swz / 64; C = (st & 1) * 32 + (swz % 64) / 2; }
__host__ __device__ __forceinline__ int perm32(int rho) { const int n = rho >> 4, i = rho & 15; return 8 * (i >> 2) + 4 * n + (i & 3); }

struct Unit { int pm, pn; };
struct Gemm { const bf16_t* A; const bf16_t* Bt; int M, N, K; };

struct StaticOrder {
    int nM, nN, nwg, G, c;
    __host__ __device__ void init(int M, int N, int G_, int c_) { nM = M / BM; nN = N / BM; nwg = nM * nN; G = G_; c = c_; }
    __host__ __device__ bool next(int i, Unit& u) const {
        const long L = (long)i * G + c; if (L >= nwg) return false;
        int wgid = (int)L; { const int q = nwg / NXCD, r = nwg % NXCD, xcd = wgid % NXCD, off = wgid / NXCD; wgid = (xcd < r ? xcd * (q + 1) : r * (q + 1) + (xcd - r) * q) + off; }
        const int nig = WGM * nN, gid = wgid / nig, fm = gid * WGM, gsz = (nM - fm) < WGM ? (nM - fm) : WGM;
        u.pm = fm + ((wgid % nig) % gsz); u.pn = (wgid % nig) / gsz; return true;
    }
    __device__ __forceinline__ void a_ready(const Unit&) const {}
    __device__ __forceinline__ void done(const Unit&) const {}
};

__device__ __forceinline__ unsigned cvt_pk_bf16(float lo, float hi) { unsigned r; asm volatile("v_cvt_pk_bf16_f32 %0, %1, %2" : "=v"(r) : "v"(lo), "v"(hi)); return r; }
typedef float f32x2 __attribute__((ext_vector_type(2)));
__device__ __forceinline__ f32x2 gelu_pk(f32x2 v) {
    const f32x2 av = __builtin_elementwise_abs(v), d = av * 0.2316418882f + 1.0f;
    f32x2 t; t.x = __builtin_amdgcn_rcpf(d.x); t.y = __builtin_amdgcn_rcpf(d.y);
    f32x2 q = t * 0.5307027145f + (-0.7265760135f); q = q * t + 0.7107068705f; q = q * t + (-0.142248368f); q = q * t + 0.127414796f; q = q * t;
    const f32x2 s = (v * v) * (-0.72134752044f);
    f32x2 e; e.x = __builtin_amdgcn_exp2f(s.x); e.y = __builtin_amdgcn_exp2f(s.y);
    const f32x2 m = v * (q * e), r = v - m;
    f32x2 o; o.x = v.x < 0.f ? m.x : r.x; o.y = v.y < 0.f ? m.y : r.y; return o;
}

template <int ACT  > struct EpiBf16 {
    static constexpr bool PERM = true, AFTER_DRAIN = false; static_assert(ACT == 0 || ACT == 1, "EpiBf16: ACT is 0 (none) or 1 (gelu_pk)");
    bf16_t* O; int ldc; const float* bias; int split_cols; size_t split_stride; float scale0;
    __device__ __forceinline__ void operator()(const f32x4 (&acc)[2][2][4][2], const Unit& u, int wr, int wc, int fr, int fq) const {
        const int row0 = u.pm * BM + wr * 64 + fr; int colt = u.pn * BM; bf16_t* base = O;
        float sc = 1.f; if (split_cols) { const int t = colt / split_cols; base += (size_t)t * split_stride; colt -= t * split_cols; if (t == 0) sc = scale0; }
        const int col0 = colt + wc * 32 + 8 * fq, bcol0 = u.pn * BM + wc * 32 + 8 * fq;
        f32x4 bv[2][2];
#pragma unroll
        for (int bj = 0; bj < 2; ++bj)
#pragma unroll
            for (int n = 0; n < 2; ++n) bv[bj][n] = bias ? *(const f32x4*)(bias + bcol0 + bj * HALF + 4 * n) : (f32x4){0.f, 0.f, 0.f, 0.f};
#pragma unroll
        for (int ai = 0; ai < 2; ++ai)
#pragma unroll
            for (int m = 0; m < 4; ++m) { bf16_t* rowp = base + (size_t)(row0 + ai * HALF + m * 16) * ldc + col0;
#pragma unroll
                for (int bj = 0; bj < 2; ++bj) { f32x4 v0 = acc[ai][bj][m][0] + bv[bj][0], v1 = acc[ai][bj][m][1] + bv[bj][1];
                    if (ACT == 1) { f32x2 a = gelu_pk((f32x2){v0[0], v0[1]}), b = gelu_pk((f32x2){v0[2], v0[3]}), c = gelu_pk((f32x2){v1[0], v1[1]}), d = gelu_pk((f32x2){v1[2], v1[3]});
                        v0 = (f32x4){a.x, a.y, b.x, b.y}; v1 = (f32x4){c.x, c.y, d.x, d.y}; }
                    v0 = v0 * sc; v1 = v1 * sc; u32x4 w; w.x = cvt_pk_bf16(v0[0], v0[1]); w.y = cvt_pk_bf16(v0[2], v0[3]); w.z = cvt_pk_bf16(v1[0], v1[1]); w.w = cvt_pk_bf16(v1[2], v1[3]);
                    *(u32x4*)(rowp + bj * HALF) = w; } }
    }
};
struct EpiHeadMajor {
    static constexpr bool PERM = true, AFTER_DRAIN = false;
    bf16_t* O; int Mrows; const float* rowsq; float inv_k, eps;
    __device__ __forceinline__ void operator()(const f32x4 (&acc)[2][2][4][2], const Unit& u, int wr, int wc, int fr, int fq) const {
        const int row0 = u.pm * BM + wr * 64 + fr, col0 = wc * 32 + 8 * fq;
#pragma unroll
        for (int ai = 0; ai < 2; ++ai) {
            f32x4 pa[4], pb[4];
#pragma unroll
            for (int m = 0; m < 4; ++m) { const f32x4* pp = (const f32x4*)(rowsq + (size_t)(row0 + ai * HALF + m * 16) * 32 + 8 * fq); pa[m] = pp[0]; pb[m] = pp[1]; }
#pragma unroll
            for (int m = 0; m < 4; ++m) { const int row = row0 + ai * HALF + m * 16; const f32x4 a = pa[m], b = pb[m];
                float sq = ((a[0] + a[1]) + (a[2] + a[3])) + ((b[0] + b[1]) + (b[2] + b[3])); sq += __shfl_xor(sq, 16); sq += __shfl_xor(sq, 32);
                const float rs = __builtin_amdgcn_rsqf(sq * inv_k + eps);
#pragma unroll
                for (int bj = 0; bj < 2; ++bj) { const f32x4 v0 = acc[ai][bj][m][0] * rs, v1 = acc[ai][bj][m][1] * rs;
                    u32x4 w; w.x = cvt_pk_bf16(v0[0], v0[1]); w.y = cvt_pk_bf16(v0[2], v0[3]); w.z = cvt_pk_bf16(v1[0], v1[1]); w.w = cvt_pk_bf16(v1[2], v1[3]);
                    *(u32x4*)(O + ((size_t)(u.pn * 2 + bj) * Mrows + row) * HALF + col0) = w; } }
            asm volatile("" ::: "memory"); }
    }
};
struct EpiResF32 {
    static constexpr bool PERM = true, AFTER_DRAIN = false;
    bf16_t* xb; float* rowsq; int ldc;
    __device__ __forceinline__ void operator()(const f32x4 (&acc)[2][2][4][2], const Unit& u, int wr, int wc, int fr, int fq) const {
        const int col0 = u.pn * BM + wc * 32 + 8 * fq;
#pragma unroll
        for (int ai = 0; ai < 2; ++ai) {
            u32x4 pre[4][2];
#pragma unroll
            for (int m = 0; m < 4; ++m) { const size_t off = (size_t)(u.pm * BM + ai * HALF + wr * 64 + m * 16 + fr) * ldc + col0;
#pragma unroll
                for (int bj = 0; bj < 2; ++bj) pre[m][bj] = *(const u32x4*)(xb + off + bj * HALF); }
            asm volatile("" ::: "memory");
#pragma unroll
            for (int m = 0; m < 4; ++m) { const int row = u.pm * BM + ai * HALF + wr * 64 + m * 16 + fr; const size_t off = (size_t)row * ldc + col0; float ss = 0.f;
#pragma unroll
                for (int bj = 0; bj < 2; ++bj) { const u32x4 pb = pre[m][bj]; const f32x4 a0 = acc[ai][bj][m][0], a1 = acc[ai][bj][m][1];
                    u32x4 w; w.x = cvt_pk_bf16(__uint_as_float(pb.x << 16) + a0[0], __uint_as_float(pb.x & 0xffff0000u) + a0[1]); w.y = cvt_pk_bf16(__uint_as_float(pb.y << 16) + a0[2], __uint_as_float(pb.y & 0xffff0000u) + a0[3]);
                    w.z = cvt_pk_bf16(__uint_as_float(pb.z << 16) + a1[0], __uint_as_float(pb.z & 0xffff0000u) + a1[1]); w.w = cvt_pk_bf16(__uint_as_float(pb.w << 16) + a1[2], __uint_as_float(pb.w & 0xffff0000u) + a1[3]);
#pragma unroll
                    for (int q = 0; q < 4; ++q) { const float r0 = __uint_as_float(w[q] << 16), r1 = __uint_as_float(w[q] & 0xffff0000u); ss += r0 * r0 + r1 * r1; }
                    *(u32x4*)(xb + off + bj * HALF) = w; }
                ss += __shfl_xor(ss, 16); ss += __shfl_xor(ss, 32);
                if (fq == 0) rowsq[(size_t)row * 32 + u.pn * 4 + wc] = ss; }
            asm volatile("" ::: "memory"); }
    }
};


template <class Epi, class Sched, bool ALIGN_EPI = false, bool SP2 = false>
__device__ __forceinline__ void gemm_phase(PG8_LAS unsigned char* lds, const Gemm g, const Sched& S, const Epi& E) {
    const int tid = otid(), wid = __builtin_amdgcn_readfirstlane(tid >> 6), lane = tid & 63, wr = wid >> 2, wc = wid & 3, fr = lane & 15, fq = lane >> 4;
    const int K = g.K, nt = K / BK;
    unsigned voffA[2], voffB[2];
#pragma unroll
    for (int i = 0; i < 2; ++i) { int R, C; stage_rc(tid * 16 + i * 8192, R, C); const int Rb = Epi::PERM ? ((R & ~31) + perm32(R & 31)) : R;
        voffA[i] = (unsigned)(R * K + C) * 2u; voffB[i] = (unsigned)(Rb * K + C) * 2u; }
    const size_t kstep = (size_t)(BK * 2);
    const size_t hstep = (size_t)HALF * K * 2;
    const size_t tstep = 2 * hstep;
    const unsigned ldsw = (unsigned)wid * 1024u;
    const int aoff = lds_byte(wr * 64 + fr, fq * 8), boff = lds_byte(wc * 32 + fr, fq * 8);
#define PG8_SA(b, h) (((b) * 2 + (h)) * HTB)
#define PG8_SB(b, h) ((4 + (b) * 2 + (h)) * HTB)
#define PG8_STAGE(bufoff, gbase, voff) do { _Pragma("unroll") for (int _i = 0; _i < 2; ++_i) \
        __builtin_amdgcn_global_load_lds((const unsigned*)((const char*)(gbase) + (voff)[_i]), (PG8_LAS unsigned*)(lds + (bufoff) + ldsw + _i * 8192), 16, 0, 0); } while (0)
#define PG8_LDA(dst, b, h) do { _Pragma("unroll") for (int m = 0; m < 4; ++m) _Pragma("unroll") for (int k = 0; k < 2; ++k) dst[m][k] = *(const PG8_LAS bf16x8*)(lds + PG8_SA(b, h) + aoff + m * 2048 + k * 1024); } while (0)
#define PG8_LDB(dst, b, h) do { _Pragma("unroll") for (int n = 0; n < 2; ++n) _Pragma("unroll") for (int k = 0; k < 2; ++k) dst[n][k] = *(const PG8_LAS bf16x8*)(lds + PG8_SB(b, h) + boff + n * 2048 + k * 1024); } while (0)
#define PG8_MMA(ai, bj, At, Bt) do { __builtin_amdgcn_s_setprio(1); _Pragma("unroll") for (int m = 0; m < 4; ++m) _Pragma("unroll") for (int n = 0; n < 2; ++n) _Pragma("unroll") for (int k = 0; k < 2; ++k) \
        acc[ai][bj][m][n] = __builtin_amdgcn_mfma_f32_16x16x32_bf16(Bt[n][k], At[m][k], acc[ai][bj][m][n], 0, 0, 0); __builtin_amdgcn_s_setprio(0); } while (0)
#define PG8_WAIT_V(n) asm volatile("s_waitcnt vmcnt(" #n ")" ::: "memory")
#define PG8_WAIT_L(n) asm volatile("s_waitcnt lgkmcnt(" #n ")" ::: "memory")
#define PG8_BAR __builtin_amdgcn_s_barrier()
#define PG8_SCHED __builtin_amdgcn_sched_barrier(0)
    Unit cur, nxt; int ui = 0;
    if (!S.next(0, cur)) return;
    f32x4 acc[2][2][4][2];
#pragma unroll
    for (int a = 0; a < 2; ++a)
#pragma unroll
        for (int b = 0; b < 2; ++b)
#pragma unroll
            for (int m = 0; m < 4; ++m)
#pragma unroll
                for (int n = 0; n < 2; ++n) acc[a][b][m][n] = (f32x4){0.f, 0.f, 0.f, 0.f};
    bf16x8 At[4][2], B0[2][2], B1[2][2];
    const char* cA = (const char*)g.A + (size_t)cur.pm * tstep; const char* cB = (const char*)g.Bt + (size_t)cur.pn * tstep;
    S.a_ready(cur);
    if constexpr (SP2) {
        PG8_STAGE(PG8_SB(0, 0), cB, voffB); PG8_STAGE(PG8_SB(0, 1), cB + hstep, voffB); PG8_STAGE(PG8_SA(0, 0), cA, voffA); PG8_STAGE(PG8_SA(0, 1), cA + hstep, voffA);
        if (wr == 1) PG8_BAR;
        PG8_WAIT_V(2); PG8_BAR;
        PG8_STAGE(PG8_SB(1, 0), cB + kstep, voffB); PG8_STAGE(PG8_SA(1, 0), cA + kstep, voffA); PG8_STAGE(PG8_SB(1, 1), cB + hstep + kstep, voffB);
        PG8_WAIT_V(6); PG8_BAR;
    } else {
        PG8_STAGE(PG8_SB(0, 0), cB, voffB); PG8_STAGE(PG8_SA(0, 0), cA, voffA); PG8_STAGE(PG8_SB(0, 1), cB + hstep, voffB); PG8_STAGE(PG8_SA(0, 1), cA + hstep, voffA);
        if (wr == 1) PG8_BAR;
        PG8_WAIT_V(4); PG8_BAR;
        PG8_STAGE(PG8_SB(1, 0), cB + kstep, voffB); PG8_STAGE(PG8_SA(1, 0), cA + kstep, voffA); PG8_STAGE(PG8_SB(1, 1), cB + hstep + kstep, voffB);
        PG8_WAIT_V(6); PG8_BAR;
    }
    for (;;) {
        const bool has_next = S.next(ui + 1, nxt);
        const char* nA = has_next ? (const char*)g.A + (size_t)nxt.pm * tstep : cA; const char* nB = has_next ? (const char*)g.Bt + (size_t)nxt.pn * tstep : cB;
        for (int t = 0; t < nt; t += 2) {
            const bool last = (t == nt - 2);
            const char* a1 = cA + (size_t)(t + 1) * kstep;
            const char* a2 = last ? nA : cA + (size_t)(t + 2) * kstep; const char* b2 = last ? nB : cB + (size_t)(t + 2) * kstep;
            const char* a3 = a2 + kstep; const char* b3 = b2 + kstep;
            if (last && has_next) S.a_ready(nxt);
            if constexpr (SP2) {
            PG8_LDB(B0, 0, 0); PG8_LDB(B1, 0, 1); PG8_SCHED; PG8_LDA(At, 0, 0); PG8_STAGE(PG8_SA(1, 1), a1 + hstep, voffA);
            PG8_WAIT_V(8); PG8_WAIT_L(0); PG8_BAR; PG8_MMA(0, 0, At, B0); PG8_MMA(0, 1, At, B1); PG8_BAR; PG8_SCHED;
            PG8_LDA(At, 0, 1); PG8_STAGE(PG8_SB(0, 0), b2, voffB); PG8_STAGE(PG8_SB(0, 1), b2 + hstep, voffB); PG8_STAGE(PG8_SA(0, 0), a2, voffA);
            PG8_WAIT_V(8); PG8_WAIT_L(0); PG8_BAR; PG8_MMA(1, 0, At, B0); PG8_MMA(1, 1, At, B1); PG8_BAR; PG8_SCHED;
            PG8_LDB(B0, 1, 0); PG8_LDB(B1, 1, 1); PG8_SCHED; PG8_LDA(At, 1, 0); PG8_STAGE(PG8_SA(0, 1), a2 + hstep, voffA);
            PG8_WAIT_V(8); PG8_WAIT_L(0); PG8_BAR; PG8_MMA(0, 0, At, B0); PG8_MMA(0, 1, At, B1); PG8_BAR; PG8_SCHED;
            PG8_LDA(At, 1, 1); PG8_STAGE(PG8_SB(1, 0), b3, voffB); PG8_STAGE(PG8_SB(1, 1), b3 + hstep, voffB); PG8_STAGE(PG8_SA(1, 0), a3, voffA);
            PG8_WAIT_V(8); PG8_WAIT_L(0); PG8_BAR; PG8_MMA(1, 0, At, B0); PG8_MMA(1, 1, At, B1); PG8_BAR; PG8_SCHED;
            } else {
            PG8_LDB(B0, 0, 0); PG8_SCHED; PG8_LDA(At, 0, 0); PG8_STAGE(PG8_SA(1, 1), a1 + hstep, voffA);
            PG8_WAIT_L(8); PG8_BAR; PG8_WAIT_L(0); PG8_MMA(0, 0, At, B0); PG8_BAR; PG8_SCHED;
            PG8_LDB(B1, 0, 1); PG8_STAGE(PG8_SB(0, 0), b2, voffB);
            PG8_BAR; PG8_WAIT_L(0); PG8_MMA(0, 1, At, B1); PG8_BAR;
            PG8_LDA(At, 0, 1); PG8_STAGE(PG8_SA(0, 0), a2, voffA);
            PG8_BAR; PG8_WAIT_L(0); PG8_MMA(1, 0, At, B0); PG8_BAR; PG8_SCHED;
            PG8_STAGE(PG8_SB(0, 1), b2 + hstep, voffB);
            PG8_WAIT_V(6); PG8_BAR; PG8_MMA(1, 1, At, B1); PG8_BAR;
            PG8_LDB(B0, 1, 0); PG8_SCHED; PG8_LDA(At, 1, 0); PG8_STAGE(PG8_SA(0, 1), a2 + hstep, voffA);
            PG8_WAIT_L(8); PG8_BAR; PG8_WAIT_L(0); PG8_MMA(0, 0, At, B0); PG8_BAR; PG8_SCHED;
            PG8_LDB(B1, 1, 1); PG8_STAGE(PG8_SB(1, 0), b3, voffB);
            PG8_BAR; PG8_WAIT_L(0); PG8_MMA(0, 1, At, B1); PG8_BAR;
            PG8_LDA(At, 1, 1); PG8_STAGE(PG8_SA(1, 0), a3, voffA);
            PG8_BAR; PG8_WAIT_L(0); PG8_MMA(1, 0, At, B0); PG8_BAR; PG8_SCHED;
            PG8_STAGE(PG8_SB(1, 1), b3 + hstep, voffB);
            PG8_WAIT_V(6); PG8_BAR; PG8_MMA(1, 1, At, B1); PG8_BAR;
            }
        }
        if constexpr (ALIGN_EPI) { if (wr == 0) PG8_BAR; }
        if constexpr (!Epi::AFTER_DRAIN) { E(acc, cur, wr, wc, fr, fq); S.done(cur); }
        if (!has_next) break;
#pragma unroll
        for (int a = 0; a < 2; ++a)
#pragma unroll
            for (int b = 0; b < 2; ++b)
#pragma unroll
                for (int m = 0; m < 4; ++m)
#pragma unroll
                    for (int n = 0; n < 2; ++n) acc[a][b][m][n] = (f32x4){0.f, 0.f, 0.f, 0.f};
        cur = nxt; cA = nA; cB = nB; ++ui;
        if constexpr (ALIGN_EPI) { if (wr == 1) PG8_BAR; }
    }
    PG8_WAIT_V(0);
    if constexpr (!ALIGN_EPI) { if (wr == 0) PG8_BAR; }
    PG8_BAR;
    if constexpr (Epi::AFTER_DRAIN) { E.fused(acc, cur, wr, wc, fr, fq, lds, wid, lane); S.done(cur); }
#undef PG8_SA
#undef PG8_SB
#undef PG8_STAGE
#undef PG8_LDA
#undef PG8_LDB
#undef PG8_MMA
#undef PG8_WAIT_V
#undef PG8_WAIT_L
#undef PG8_BAR
#undef PG8_SCHED
}
}
#define PG8_SP2 true
#define PG8_ALIGN true
namespace att {
using bf16 = __hip_bfloat16;
constexpr int D = 128, NW = 8, QBLK = 32, KVBLK = 64;
constexpr float SCALE = 0.088388347648318440f;
constexpr float THR = 8.f;
constexpr size_t SHM_V = KVBLK * D * 2, SHM_K = KVBLK * D * 2, SHM_ATTN = 2 * SHM_V + 2 * SHM_K + NW * 64 * 4;
using bf16x8 = __attribute__((ext_vector_type(8))) short;
using s16x4  = __attribute__((ext_vector_type(4))) short;
using f32x16 = __attribute__((ext_vector_type(16))) float;
using f32x8  = __attribute__((ext_vector_type(8))) float;
using u32x4  = __attribute__((ext_vector_type(4))) unsigned;
#define KSWZ(row, colB) ((row) * 256 + ((colB) ^ (((row) & 7) << 4)))
#define SBAR() __builtin_amdgcn_sched_barrier(0)
__device__ __forceinline__ int crow(int r, int hi) { return (r & 3) + 8 * (r >> 2) + 4 * hi; }
__device__ __forceinline__ unsigned cvtpk(float lo, float hi) {
  unsigned r; asm("v_cvt_pk_bf16_f32 %0, %1, %2" : "=v"(r) : "v"(lo), "v"(hi)); return r;
}
template <typename TIn> struct Stage;
template <> struct Stage<bf16>  { using T = bf16x8;
  __device__ static __forceinline__ T ld8(const bf16* p) { return *reinterpret_cast<const bf16x8*>(p); }
  __device__ static __forceinline__ bf16x8 tobf(T x) { return x; } };
template <> struct Stage<float> { using T = f32x8;
  __device__ static __forceinline__ T ld8(const float* p) { return *reinterpret_cast<const f32x8*>(p); }
  __device__ static __forceinline__ bf16x8 tobf(T x) {
    u32x4 w = {cvtpk(x[0], x[1]), cvtpk(x[2], x[3]), cvtpk(x[4], x[5]), cvtpk(x[6], x[7])}; return *reinterpret_cast<bf16x8*>(&w); } };

__device__ __forceinline__ void partialSM(f32x16& p0, f32x16& p1, float& m_reg, float& mn, float& alpha) {
  constexpr float C = SCALE * 1.4426950408889634f;
  float pmax = p0[0]; for (int r = 1; r < 16; ++r) pmax = fmaxf(pmax, p0[r]); for (int r = 0; r < 16; ++r) pmax = fmaxf(pmax, p1[r]);
  { auto rr = __builtin_amdgcn_permlane32_swap(__float_as_uint(pmax), __float_as_uint(pmax), false, false);
    pmax = fmaxf(__uint_as_float(rr[0]), __uint_as_float(rr[1])); }
  if (__builtin_expect(__all(pmax - m_reg <= THR / SCALE), 1)) { mn = m_reg; alpha = 1.f; }
  else { mn = fmaxf(m_reg, pmax); alpha = __builtin_amdgcn_exp2f((m_reg - mn) * C); m_reg = mn; }
  float mnC = -mn * C;
  for (int r = 0; r < 16; ++r) p0[r] = fmaf(p0[r], C, mnC); for (int r = 0; r < 16; ++r) p1[r] = fmaf(p1[r], C, mnC);
  for (int r = 0; r < 16; ++r) p0[r] = __builtin_amdgcn_exp2f(p0[r]);
}
__device__ __forceinline__ void finishSM(f32x16& p0, f32x16& p1, float alpha, float& l_reg, bf16x8& pa0, bf16x8& pa1, bf16x8& pa2, bf16x8& pa3) {
  for (int r = 0; r < 16; ++r) p1[r] = __builtin_amdgcn_exp2f(p1[r]);
  float ps = 0; for (int r = 0; r < 16; ++r) ps += p0[r]; for (int r = 0; r < 16; ++r) ps += p1[r];
  { auto rr = __builtin_amdgcn_permlane32_swap(__float_as_uint(ps), __float_as_uint(ps), false, false);
    ps = __uint_as_float(rr[0]) + __uint_as_float(rr[1]); }
  l_reg = l_reg * alpha + ps;
#define PK4(P, BASE, OUT) do { unsigned a0 = cvtpk(P[BASE + 0], P[BASE + 1]), a1 = cvtpk(P[BASE + 2], P[BASE + 3]);   \
    unsigned b0 = cvtpk(P[BASE + 4], P[BASE + 5]), b1 = cvtpk(P[BASE + 6], P[BASE + 7]);                              \
    u32x4 w = {a0, a1, b0, b1}; OUT = *reinterpret_cast<bf16x8*>(&w); } while (0)
  PK4(p0, 0, pa0); PK4(p0, 8, pa1); PK4(p1, 0, pa2); PK4(p1, 8, pa3);
#undef PK4
}
__device__ __forceinline__ void qkt(f32x16& p0, f32x16& p1, const bf16* Ks, const bf16x8* qr, int r32, int hi) {
  p0 = f32x16{}; p1 = f32x16{};
  for (int d0 = 0; d0 < 8; ++d0) { int cb = (d0 * 16 + hi * 8) * 2;
    bf16x8 b0 = *reinterpret_cast<const bf16x8*>((const char*)Ks + KSWZ(r32, cb));
    bf16x8 b1 = *reinterpret_cast<const bf16x8*>((const char*)Ks + KSWZ(32 + r32, cb));
    p0 = __builtin_amdgcn_mfma_f32_32x32x16_bf16(b0, qr[d0], p0, 0, 0, 0);
    p1 = __builtin_amdgcn_mfma_f32_32x32x16_bf16(b1, qr[d0], p1, 0, 0, 0); }
}
__device__ __forceinline__ int v_st(int k, int c) { const int kk = (k & ~0xC) | ((k & 4) << 1) | ((k & 8) >> 1); return ((kk >> 3) * 4 + (c >> 5)) * 512 + ((kk & 7) * 32 + (c & 31)) * 2; }
__device__ __forceinline__ int v_rd_base(int lane) { return ((lane & 3) << 3) | (((lane >> 2) & 3) << 6) | (((lane >> 4) & 1) << 5) | (((lane >> 5) & 1) << 8); }
constexpr int v_rd_off(int d0, int ks, int half) { return d0 * 512 + ks * 4096 + half * 2048; }
template <int OFF> __device__ __forceinline__ s16x4 tr_read(int vb) {
  s16x4 r; asm volatile("ds_read_b64_tr_b16 %0, %1 offset:%2" : "=&v"(r) : "v"(vb), "i"(OFF) : "memory"); return r;
}
template <int D0> __device__ __forceinline__ void pv_one(f32x16& od, int vb, bf16x8 pa0, bf16x8 pa1, bf16x8 pa2, bf16x8 pa3) {
  const s16x4 l0 = tr_read<v_rd_off(D0, 0, 0)>(vb), h0 = tr_read<v_rd_off(D0, 0, 1)>(vb), l1 = tr_read<v_rd_off(D0, 1, 0)>(vb), h1 = tr_read<v_rd_off(D0, 1, 1)>(vb);
  const s16x4 l2 = tr_read<v_rd_off(D0, 2, 0)>(vb), h2 = tr_read<v_rd_off(D0, 2, 1)>(vb), l3 = tr_read<v_rd_off(D0, 3, 0)>(vb), h3 = tr_read<v_rd_off(D0, 3, 1)>(vb);
  asm volatile("s_waitcnt lgkmcnt(0)" ::: "memory"); SBAR();
#define PK(L, H) (bf16x8){L[0], L[1], L[2], L[3], H[0], H[1], H[2], H[3]}
  od = __builtin_amdgcn_mfma_f32_32x32x16_bf16(pa0, PK(l0, h0), od, 0, 0, 0);
  od = __builtin_amdgcn_mfma_f32_32x32x16_bf16(pa1, PK(l1, h1), od, 0, 0, 0);
  od = __builtin_amdgcn_mfma_f32_32x32x16_bf16(pa2, PK(l2, h2), od, 0, 0, 0);
  od = __builtin_amdgcn_mfma_f32_32x32x16_bf16(pa3, PK(l3, h3), od, 0, 0, 0);
#undef PK
}
struct VFrag { s16x4 l0, h0, l1, h1, l2, h2, l3, h3; };
template <int D0> __device__ __forceinline__ void pv_rd(VFrag& f, int vb) {
  f.l0 = tr_read<v_rd_off(D0, 0, 0)>(vb); f.h0 = tr_read<v_rd_off(D0, 0, 1)>(vb); f.l1 = tr_read<v_rd_off(D0, 1, 0)>(vb); f.h1 = tr_read<v_rd_off(D0, 1, 1)>(vb);
  f.l2 = tr_read<v_rd_off(D0, 2, 0)>(vb); f.h2 = tr_read<v_rd_off(D0, 2, 1)>(vb); f.l3 = tr_read<v_rd_off(D0, 3, 0)>(vb); f.h3 = tr_read<v_rd_off(D0, 3, 1)>(vb);
}
__device__ __forceinline__ void pv_mm(f32x16& od, const VFrag& f, bf16x8 pa0, bf16x8 pa1, bf16x8 pa2, bf16x8 pa3) {
#define PK(L, H) (bf16x8){L[0], L[1], L[2], L[3], H[0], H[1], H[2], H[3]}
  od = __builtin_amdgcn_mfma_f32_32x32x16_bf16(pa0, PK(f.l0, f.h0), od, 0, 0, 0);
  od = __builtin_amdgcn_mfma_f32_32x32x16_bf16(pa1, PK(f.l1, f.h1), od, 0, 0, 0);
  od = __builtin_amdgcn_mfma_f32_32x32x16_bf16(pa2, PK(f.l2, f.h2), od, 0, 0, 0);
  od = __builtin_amdgcn_mfma_f32_32x32x16_bf16(pa3, PK(f.l3, f.h3), od, 0, 0, 0);
#undef PK
}
#define PV_WAIT(n) do { asm volatile("s_waitcnt lgkmcnt(" #n ")" ::: "memory"); SBAR(); } while (0)
__device__ __forceinline__ void pv_d0(f32x16* o, int vb, bf16x8 pa0, bf16x8 pa1, bf16x8 pa2, bf16x8 pa3) {
#if MK_PVPIPE
  VFrag fa, fb;
  pv_rd<0>(fa, vb); pv_rd<1>(fb, vb);
  PV_WAIT(8); pv_mm(o[0], fa, pa0, pa1, pa2, pa3); SBAR();
  pv_rd<2>(fa, vb);
  PV_WAIT(8); pv_mm(o[1], fb, pa0, pa1, pa2, pa3); SBAR();
  pv_rd<3>(fb, vb);
  PV_WAIT(8); pv_mm(o[2], fa, pa0, pa1, pa2, pa3); SBAR();
  PV_WAIT(0); pv_mm(o[3], fb, pa0, pa1, pa2, pa3);
#else
  pv_one<0>(o[0], vb, pa0, pa1, pa2, pa3); pv_one<1>(o[1], vb, pa0, pa1, pa2, pa3); pv_one<2>(o[2], vb, pa0, pa1, pa2, pa3); pv_one<3>(o[3], vb, pa0, pa1, pa2, pa3);
#endif
}
constexpr int crow0(int r) { return (r & 3) + 8 * (r >> 2); }
constexpr float LOG2E = 1.4426950408889634f;
__device__ __forceinline__ void partialSM_neg(f32x16& p0, f32x16& p1, float& m_reg, f32x16& negm, float& alpha, int bounded) {
  if (bounded) {
    alpha = 1.f;
#pragma unroll
    for (int r = 0; r < 16; ++r) p0[r] = __builtin_amdgcn_exp2f(p0[r]);
    return;
  }
  float pmax = p0[0];
#pragma unroll
  for (int r = 1; r < 16; ++r) pmax = fmaxf(pmax, p0[r]);
#pragma unroll
  for (int r = 0; r < 16; ++r) pmax = fmaxf(pmax, p1[r]);
  { auto rr = __builtin_amdgcn_permlane32_swap(__float_as_uint(pmax), __float_as_uint(pmax), false, false);
    pmax = fmaxf(__uint_as_float(rr[0]), __uint_as_float(rr[1])); }
  if (__builtin_expect(__all(pmax <= THR), 1)) { alpha = 1.f; }
  else { const float dl = fmaxf(pmax, 0.f); m_reg += dl; alpha = __builtin_amdgcn_exp2f(-dl);
#pragma unroll
    for (int r = 0; r < 16; ++r) { p0[r] -= dl; p1[r] -= dl; negm[r] = -m_reg; } }
#pragma unroll
  for (int r = 0; r < 16; ++r) p0[r] = __builtin_amdgcn_exp2f(p0[r]);
}
__device__ __forceinline__ void partialSM_dil(f32x16& p0, f32x16& p1, float& m_reg, float& mn, float& alpha, float dq, float dlo, float dhi, float nslopeC) {
  constexpr float C = SCALE * LOG2E;
#pragma unroll
  for (int r = 0; r < 16; ++r) {
    const float d0 = dq + (float)crow0(r), d1 = d0 + 32.f;
    const float t0 = fmaf(p0[r], C, nslopeC * fabsf(d0)), t1 = fmaf(p1[r], C, nslopeC * fabsf(d1));
    p0[r] = (d0 >= dlo && d0 <= dhi) ? t0 : -1e30f;
    p1[r] = (d1 >= dlo && d1 <= dhi) ? t1 : -1e30f;
  }
  float pmax = p0[0];
#pragma unroll
  for (int r = 1; r < 16; ++r) pmax = fmaxf(pmax, p0[r]);
#pragma unroll
  for (int r = 0; r < 16; ++r) pmax = fmaxf(pmax, p1[r]);
  { auto rr = __builtin_amdgcn_permlane32_swap(__float_as_uint(pmax), __float_as_uint(pmax), false, false);
    pmax = fmaxf(__uint_as_float(rr[0]), __uint_as_float(rr[1])); }
  if (__builtin_expect(__all(pmax - m_reg <= THR * LOG2E), 1)) { mn = m_reg; alpha = 1.f; }
  else { mn = fmaxf(m_reg, pmax); alpha = __builtin_amdgcn_exp2f(m_reg - mn); m_reg = mn; }
#pragma unroll
  for (int r = 0; r < 16; ++r) { p0[r] = p0[r] - mn; p1[r] = p1[r] - mn; }
#pragma unroll
  for (int r = 0; r < 16; ++r) p0[r] = __builtin_amdgcn_exp2f(p0[r]);
}

template <bool DIL>
__device__ __forceinline__ void attn_body(const bf16* __restrict__ Qb, const bf16* __restrict__ Kh, const bf16* __restrict__ Vh, long qs, long ks,
                                          bf16* __restrict__ Ob, long os, float* __restrict__ lse_o, int lse_s, int i0, int nsub, float nslopeC, int seq, char* lds,
                                          const float* __restrict__ qgain = nullptr, const float* __restrict__ rcos = nullptr, const float* __restrict__ rsin = nullptr, int tq0 = 0) {
  typedef __attribute__((address_space(3))) unsigned lds_u32;
  using St = Stage<bf16>;
  const int tid = otid(), wid = __builtin_amdgcn_readfirstlane(tid >> 6), lane = tid & 63, r32 = lane & 31, hi = lane >> 5;
  char* V_lds = lds + 4 * SHM_K; char* K_lds = lds;
  float* ws = (float*)(lds + 4 * SHM_K + 4 * SHM_V) + wid * 64; float* li_l = ws; float* al_l = ws + 32;
  float m_reg = -1e30f, l_reg = 0; f32x16 o[4] = {}; bf16x8 qr[8];
  const bf16* Qw = Qb + (long)(wid * QBLK + r32) * qs + hi * 8;
#pragma unroll
  for (int d0 = 0; d0 < 8; ++d0) qr[d0] = St::ld8(Qw + d0 * 16);
  const int vb0 = (int)(uintptr_t)V_lds + v_rd_base(lane);
  const int kb = DIL ? i0 - 64 : 0;
#define KROW(k) (DIL ? (long)min(max(kb + (k), 0), nsub - 1) : (long)(k))
  int krow[2], kcol[2], vrow[2], vcol[2];
#pragma unroll
  for (int i = 0; i < 2; ++i) { const int pc = 2 * wid + i;
    krow[i] = pc * 4 + (lane >> 4); kcol[i] = (((lane & 15) ^ (krow[i] & 7)) << 3);
    const int sub = pc * 2 + (lane >> 5), kk = ((sub >> 2) << 3) + ((lane & 31) >> 2);
    vrow[i] = kk; vcol[i] = ((sub & 3) << 5) + ((lane & 3) << 3); }
  unsigned kdo[2], vdo[2];
#pragma unroll
  for (int i = 0; i < 2; ++i) { kdo[i] = (unsigned)(krow[i] * (int)ks + kcol[i]); vdo[i] = (unsigned)(vrow[i] * (int)ks + vcol[i]); }
#define DMA(t, buf) do { if constexpr (DIL) { _Pragma("unroll") for (int i_ = 0; i_ < 2; ++i_) { \
      __builtin_amdgcn_global_load_lds((const unsigned*)(Kh + KROW((t) * KVBLK + krow[i_]) * ks + kcol[i_]), (lds_u32*)(K_lds + (buf) * SHM_K + (2 * wid + i_) * 1024), 16, 0, 0); \
      __builtin_amdgcn_global_load_lds((const unsigned*)(Vh + KROW((t) * KVBLK + vrow[i_]) * ks + vcol[i_]), (lds_u32*)(V_lds + (buf) * SHM_V + (2 * wid + i_) * 1024), 16, 0, 0); } } \
    else { const bf16* Kt_ = Kh + (long)(t) * (KVBLK * ks); const bf16* Vt_ = Vh + (long)(t) * (KVBLK * ks); _Pragma("unroll") for (int i_ = 0; i_ < 2; ++i_) { \
      __builtin_amdgcn_global_load_lds((const unsigned*)(Kt_ + kdo[i_]), (lds_u32*)(K_lds + (buf) * SHM_K + (2 * wid + i_) * 1024), 16, 0, 0); \
      __builtin_amdgcn_global_load_lds((const unsigned*)(Vt_ + vdo[i_]), (lds_u32*)(V_lds + (buf) * SHM_V + (2 * wid + i_) * 1024), 16, 0, 0); } } } while (0)
#define ENDSTEP(j) do { if ((j) + 2 < NT) asm volatile("s_waitcnt vmcnt(4) lgkmcnt(0)\n\ts_barrier" ::: "memory"); else asm volatile("s_waitcnt vmcnt(0) lgkmcnt(0)\n\ts_barrier" ::: "memory"); } while (0)
#define RESC(a) do { if (__any((a) < 1.f)) { if (hi == 0) al_l[r32] = (a); asm volatile("s_waitcnt lgkmcnt(0)" ::: "memory"); \
    for (int d = 0; d < 4; ++d) for (int r = 0; r < 16; ++r) o[d][r] *= al_l[crow(r, hi)]; } } while (0)
#define PSM(P0, P1, MN, AL, jt) do { if constexpr (DIL) { const int t_ = otid(), iq_ = (t_ >> 6) * QBLK + (t_ & 31), hi_ = (t_ >> 5) & 1; \
      partialSM_dil(P0, P1, m_reg, MN, AL, (float)(-64 - iq_ + 4 * hi_ + 64 * (jt)), fmaxf(-64.f, (float)(-(i0 + iq_))), fminf(64.f, (float)(nsub - 1 - (i0 + iq_))), nslopeC); } \
    else partialSM(P0, P1, m_reg, MN, AL); } while (0)
#if MK_SGB
#define SGB_A() do { __builtin_amdgcn_sched_group_barrier(0x100, 4, 0); \
    _Pragma("unroll") for (int g_ = 0; g_ < 12; ++g_) { __builtin_amdgcn_sched_group_barrier(0x008, 1, 0); __builtin_amdgcn_sched_group_barrier(0x100, 1, 0); __builtin_amdgcn_sched_group_barrier(0x002, 6, 0); } \
    _Pragma("unroll") for (int g_ = 0; g_ < 4; ++g_) { __builtin_amdgcn_sched_group_barrier(0x008, 1, 0); __builtin_amdgcn_sched_group_barrier(0x002, 6, 0); } } while (0)
#else
#define SGB_A() do {} while (0)
#endif
#define KBUF(j) ((const bf16*)(K_lds + ((j) & 3) * SHM_K))
#define VBUF(j) (vb0 + ((j) & 3) * (int)SHM_V)
  f32x16 pA0, pA1, pB0, pB1; float mnA, mnB, alA, alB; bf16x8 pa0, pa1, pa2, pa3; const int NT = DIL ? 6 : seq / KVBLK;
  DMA(0, 0); DMA(1, 1);
  if constexpr (!DIL && MK_PP) { DMA(2, 2); asm volatile("s_waitcnt vmcnt(8)\n\ts_barrier" ::: "memory"); }
  else asm volatile("s_waitcnt vmcnt(4)\n\ts_barrier" ::: "memory");
#if MK_QFUSE
  if constexpr (!DIL) {
    float x[8][8]; float ss = 0.f;
#pragma unroll
    for (int d0 = 0; d0 < 8; ++d0)
#pragma unroll
      for (int i = 0; i < 8; ++i) { x[d0][i] = __uint_as_float(((unsigned)(unsigned short)qr[d0][i]) << 16); ss += x[d0][i] * x[d0][i]; }
    { auto rr = __builtin_amdgcn_permlane32_swap(__float_as_uint(ss), __float_as_uint(ss), false, false); ss = __uint_as_float(rr[0]) + __uint_as_float(rr[1]); }
    const float rstd = 1.0f / sqrtf(ss * (1.0f / 128.f) + 1e-6f), qsc = MK_NEGM ? SCALE * LOG2E : 1.0f;
    const int tpos = tq0 + wid * QBLK + r32, grow = tpos >> 6, gcol = tpos & 63;
#pragma unroll
    for (int hf = 0; hf < 2; ++hf) {
      const int trow = hf ? 128 + gcol : grow;
#pragma unroll
      for (int dd = 0; dd < 2; ++dd) { const int d0 = hf * 4 + dd, f0 = dd * 16 + hi * 8;
        const f32x8 cs = *(const f32x8*)(rcos + trow * 32 + f0), sn = *(const f32x8*)(rsin + trow * 32 + f0);
        const f32x8 g1 = *(const f32x8*)(qgain + d0 * 16 + hi * 8), g2 = *(const f32x8*)(qgain + (d0 + 2) * 16 + hi * 8);
#pragma unroll
        for (int i = 0; i < 8; ++i) { const float y1 = x[d0][i] * rstd * g1[i], y2 = x[d0 + 2][i] * rstd * g2[i];
          x[d0][i] = (y1 * cs[i] - y2 * sn[i]) * qsc; x[d0 + 2][i] = (y1 * sn[i] + y2 * cs[i]) * qsc; } } }
#pragma unroll
    for (int d0 = 0; d0 < 8; ++d0) { u32x4 w = {cvtpk(x[d0][0], x[d0][1]), cvtpk(x[d0][2], x[d0][3]), cvtpk(x[d0][4], x[d0][5]), cvtpk(x[d0][6], x[d0][7])}; qr[d0] = *reinterpret_cast<bf16x8*>(&w); }
  }
#endif
  struct KFrag { bf16x8 a, b; };
  int koff[4];
#pragma unroll
  for (int d0 = 0; d0 < 4; ++d0) koff[d0] = KSWZ(r32, (d0 * 16 + hi * 8) * 2);
  const int kbase0 = (int)(uintptr_t)K_lds;
#define KRD(f, d0, kb) asm volatile("ds_read_b128 %0, %2 offset:%3\n\tds_read_b128 %1, %2 offset:%4" : "=&v"(f.a), "=&v"(f.b) : "v"((kb) + koff[(d0) & 3]), "i"(((d0) >> 2) * 128), "i"(((d0) >> 2) * 128 + 8192) : "memory")
#define QMM(f, d0) do { pA0 = __builtin_amdgcn_mfma_f32_32x32x16_bf16(f.a, qr[d0], pA0, 0, 0, 0); pA1 = __builtin_amdgcn_mfma_f32_32x32x16_bf16(f.b, qr[d0], pA1, 0, 0, 0); } while (0)
#define LW(n) do { asm volatile("s_waitcnt lgkmcnt(" #n ")" ::: "memory"); SBAR(); } while (0)
  if constexpr (DIL) {
    const int rlo = wid >> 1;
    for (int j = 0; j < NT; ++j) {
      if (j + 2 < NT) DMA(j + 2, (j + 2) & 3);
      if (j >= rlo && j <= rlo + 2) {
        SBAR();
        { const int kb_ = kbase0 + (j & 3) * (int)SHM_K; KFrag k0_, k1_, k2_;
          KRD(k0_, 0, kb_); KRD(k1_, 1, kb_); KRD(k2_, 2, kb_); pA0 = f32x16{}; pA1 = f32x16{};
          LW(4); QMM(k0_, 0); SBAR(); KRD(k0_, 3, kb_);
          LW(4); QMM(k1_, 1); SBAR(); KRD(k1_, 4, kb_);
          LW(4); QMM(k2_, 2); SBAR(); KRD(k2_, 5, kb_);
          LW(4); QMM(k0_, 3); SBAR(); KRD(k0_, 6, kb_);
          LW(4); QMM(k1_, 4); SBAR(); KRD(k1_, 7, kb_);
          LW(4); QMM(k2_, 5); SBAR();
          LW(2); QMM(k0_, 6); SBAR();
          LW(0); QMM(k1_, 7); SBAR(); }
        PSM(pA0, pA1, mnA, alA, j); RESC(alA);
        finishSM(pA0, pA1, alA, l_reg, pa0, pa1, pa2, pa3); SBAR();
        pv_d0(o, VBUF(j), pa0, pa1, pa2, pa3);
      }
      if (j + 1 < NT) ENDSTEP(j);
    }
  } else if constexpr (MK_PP) {
    const bool grpB = wid >= 4;
#if MK_NEGM
    m_reg = 0.f; f32x16 negm = f32x16{};
#endif
#define PP_BAR(VM) do { if (VM) { asm volatile("s_waitcnt vmcnt(4) lgkmcnt(0)\n\ts_barrier" ::: "memory"); } else { asm volatile("s_waitcnt vmcnt(0) lgkmcnt(0)\n\ts_barrier" ::: "memory"); } } while (0)
#define PP_BAR_PLAIN() asm volatile("s_waitcnt lgkmcnt(0)\n\ts_barrier" ::: "memory")
    if (grpB) PP_BAR_PLAIN();
    qkt(pA0, pA1, KBUF(0), qr, r32, hi);
    if (grpB) PP_BAR(2 < NT); else PP_BAR_PLAIN();
    for (int t = 0; t < NT; ++t) {
      if (grpB && t + 3 < NT) DMA(t + 3, (t + 3) & 3);
#if MK_NEGM
      partialSM_neg(pA0, pA1, m_reg, negm, alA, i0); if (!i0) RESC(alA);
#else
      PSM(pA0, pA1, mnA, alA, t); RESC(alA);
#endif
      finishSM(pA0, pA1, alA, l_reg, pa0, pa1, pa2, pa3);
#if MK_PROBE_V
      { float dm_ = alA;
#pragma unroll
        for (int q_ = 0; q_ < 32; ++q_) asm volatile("v_add_f32 %0, %0, %0" : "+v"(dm_));
        if (dm_ == 123.456f) l_reg += 1.f; }
#endif
      if (!(MK_PREB && t + 1 < NT)) { if (!grpB) PP_BAR(t + 2 < NT); else PP_BAR_PLAIN(); }
      else if (!grpB) PP_BAR(t + 2 < NT);
      if (!grpB && t + 3 < NT) DMA(t + 3, (t + 3) & 3);
      SBAR();
      if (t + 1 < NT) {
        const int kb_ = kbase0 + ((t + 1) & 3) * (int)SHM_K, vb_ = VBUF(t);
        KFrag k0_, k1_; VFrag fa_, fb_;
        KRD(k0_, 0, kb_); KRD(k1_, 1, kb_); pv_rd<0>(fa_, vb_);
        if (MK_PREB && grpB) asm volatile("s_barrier" ::: "memory");
#if MK_NEGM
        LW(10); pA0 = __builtin_amdgcn_mfma_f32_32x32x16_bf16(k0_.a, qr[0], negm, 0, 0, 0); pA1 = __builtin_amdgcn_mfma_f32_32x32x16_bf16(k0_.b, qr[0], negm, 0, 0, 0); SBAR(); KRD(k0_, 2, kb_);
#else
        pA0 = f32x16{}; pA1 = f32x16{};
        LW(10); QMM(k0_, 0); SBAR(); KRD(k0_, 2, kb_);
#endif
        LW(10); QMM(k1_, 1); SBAR(); KRD(k1_, 3, kb_);
        LW(4);  pv_mm(o[0], fa_, pa0, pa1, pa2, pa3); SBAR(); pv_rd<1>(fb_, vb_);
        LW(10); QMM(k0_, 2); SBAR(); KRD(k0_, 4, kb_);
        LW(10); QMM(k1_, 3); SBAR(); KRD(k1_, 5, kb_);
        LW(4);  pv_mm(o[1], fb_, pa0, pa1, pa2, pa3); SBAR(); pv_rd<2>(fa_, vb_);
        LW(10); QMM(k0_, 4); SBAR(); KRD(k0_, 6, kb_);
        LW(10); QMM(k1_, 5); SBAR(); KRD(k1_, 7, kb_);
        LW(4);  pv_mm(o[2], fa_, pa0, pa1, pa2, pa3); SBAR(); pv_rd<3>(fb_, vb_);
        LW(10); QMM(k0_, 6); SBAR();
        LW(8);  QMM(k1_, 7); SBAR();
        LW(0);  pv_mm(o[3], fb_, pa0, pa1, pa2, pa3);
      } else pv_d0(o, VBUF(t), pa0, pa1, pa2, pa3);
      if (t + 1 < NT) { if (grpB) PP_BAR(t + 3 < NT); else PP_BAR_PLAIN(); }
    }
    if (!grpB) PP_BAR_PLAIN();
#undef PP_BAR
#undef PP_BAR_PLAIN
#undef KRD
#undef QMM
#undef LW
  } else {
  if (2 < NT) DMA(2, 2);
  qkt(pA0, pA1, KBUF(0), qr, r32, hi); PSM(pA0, pA1, mnA, alA, 0);
  ENDSTEP(0);
  for (int j = 1; j + 1 < NT; j += 2) {
    if (j + 2 < NT) DMA(j + 2, (j + 2) & 3);
    SBAR(); qkt(pB0, pB1, KBUF(j), qr, r32, hi);
    finishSM(pA0, pA1, alA, l_reg, pa0, pa1, pa2, pa3); SGB_A(); SBAR();
    pv_d0(o, VBUF(j - 1), pa0, pa1, pa2, pa3); PSM(pB0, pB1, mnB, alB, j);
    RESC(alB); ENDSTEP(j);
    if (j + 3 < NT) DMA(j + 3, (j + 3) & 3);
    SBAR(); qkt(pA0, pA1, KBUF(j + 1), qr, r32, hi);
    finishSM(pB0, pB1, alB, l_reg, pa0, pa1, pa2, pa3); SGB_A(); SBAR();
    pv_d0(o, VBUF(j), pa0, pa1, pa2, pa3); PSM(pA0, pA1, mnA, alA, j + 1);
    RESC(alA); ENDSTEP(j + 1);
  }
  SBAR(); qkt(pB0, pB1, KBUF(NT - 1), qr, r32, hi);
  finishSM(pA0, pA1, alA, l_reg, pa0, pa1, pa2, pa3); SBAR();
  pv_d0(o, VBUF(NT - 2), pa0, pa1, pa2, pa3); PSM(pB0, pB1, mnB, alB, NT - 1);
  RESC(alB);
  finishSM(pB0, pB1, alB, l_reg, pa0, pa1, pa2, pa3); SBAR();
  pv_d0(o, VBUF(NT - 1), pa0, pa1, pa2, pa3);
  }
  if (hi == 0) li_l[r32] = l_reg; asm volatile("s_waitcnt lgkmcnt(0)" ::: "memory");
  if constexpr (DIL) { if (hi == 0) lse_o[(long)(wid * QBLK + r32) * lse_s] = m_reg + __log2f(l_reg); }
  float rli[16];
#pragma unroll
  for (int r = 0; r < 16; ++r) rli[r] = __builtin_amdgcn_rcpf(li_l[crow(r, hi)]);
  bf16* Ow = Ob + (long)(wid * QBLK) * os;
#if MK_OSTAGE
  { char* stg = DIL ? ((wid < 4 ? K_lds : V_lds) + 2 * SHM_K + (wid & 3) * 8192) : (K_lds + wid * 8192);
#pragma unroll
    for (int r = 0; r < 16; ++r) { const int orow = crow(r, hi);
#pragma unroll
      for (int d0 = 0; d0 < 4; ++d0) *(bf16*)(stg + orow * 256 + (d0 * 32 + r32) * 2) = __float2bfloat16(o[d0][r] * rli[r]); }
    asm volatile("s_waitcnt lgkmcnt(0)" ::: "memory");
#pragma unroll
    for (int i = 0; i < 8; ++i) { const int row = i * 4 + (lane >> 4), ch = lane & 15;
      const u32x4 v = *(const u32x4*)(stg + row * 256 + ch * 16);
      *(u32x4*)(Ow + (long)row * os + ch * 8) = v; } }
#else
#pragma unroll
  for (int r = 0; r < 16; ++r) { const int orow = crow(r, hi);
#pragma unroll
    for (int d0 = 0; d0 < 4; ++d0) Ow[(long)orow * os + d0 * 32 + r32] = __float2bfloat16(o[d0][r] * rli[r]); }
#endif
  asm volatile("s_waitcnt lgkmcnt(0)\n\ts_barrier" ::: "memory");
#undef KROW
#undef DMA
#undef ENDSTEP
#undef RESC
#undef PSM
#undef KBUF
#undef SGB_A
#undef VBUF
}
}

#define GAS __attribute__((address_space(1)))
#define LAS __attribute__((address_space(3)))
typedef unsigned short bf16_t;
typedef unsigned v4u __attribute__((ext_vector_type(4)));
typedef unsigned v2u __attribute__((ext_vector_type(2)));
typedef float f32x4 __attribute__((ext_vector_type(4)));
#define LDS_WAIT() asm volatile("s_waitcnt lgkmcnt(0)" ::: "memory")

constexpr size_t MiB = 1u << 20;
constexpr size_t WS_W1T = 0;
constexpr size_t WS_W2T = 104 * MiB;
constexpr size_t WS_H = 136 * MiB;
constexpr size_t WS_PROJ = 200 * MiB;
constexpr size_t WS_YA = 408 * MiB;
constexpr size_t WS_YB = 440 * MiB;
constexpr size_t WS_LSE = 536 * MiB;
constexpr size_t WS_ROPE = 538 * MiB;
constexpr size_t WS_XB = 540 * MiB;
constexpr size_t WS_ROWSQ = 604 * MiB;
constexpr size_t WS_END = 616 * MiB;
static_assert((size_t)DEPTH * DIN * DM * 2 <= WS_W2T - WS_W1T && (size_t)M * DIN * 2 <= WS_YA - WS_PROJ && (size_t)3 * M * DB * 2 <= WS_LSE - WS_YB, "ws map");
constexpr int LDS_BYTES = 147456;
constexpr int N_PHASES = 2 + 5 * DEPTH;

__device__ __forceinline__ unsigned f2bf(float f) { unsigned u = __builtin_bit_cast(unsigned, f); return (u + 0x7fffu + ((u >> 16) & 1u)) >> 16; }
__device__ __forceinline__ unsigned pk2(float lo, float hi) { return f2bf(lo) | (f2bf(hi) << 16); }
__device__ __forceinline__ float bflo(unsigned w) { return __uint_as_float(w << 16); }
__device__ __forceinline__ float bfhi(unsigned w) { return __uint_as_float(w & 0xffff0000u); }
__device__ __forceinline__ float wave_sum(float v) {
#pragma unroll
    for (int o = 1; o < 64; o <<= 1) v += __shfl_xor(v, o);
    return v;
}

__device__ const float INV_FREQ[32] = {1.000000000e+00f, 7.498942614e-01f, 5.623413324e-01f, 4.216965139e-01f, 3.162277639e-01f, 2.371373773e-01f, 1.778279394e-01f, 1.333521307e-01f,
    1.000000015e-01f, 7.498941571e-02f, 5.623413250e-02f, 4.216965288e-02f, 3.162277490e-02f, 2.371373773e-02f, 1.778279431e-02f, 1.333521493e-02f,
    9.999999776e-03f, 7.498941850e-03f, 5.623413250e-03f, 4.216964822e-03f, 3.162277630e-03f, 2.371373586e-03f, 1.778279431e-03f, 1.333521446e-03f,
    1.000000047e-03f, 7.498942432e-04f, 5.623413017e-04f, 4.216965172e-04f, 3.162277571e-04f, 2.371373703e-04f, 1.778279402e-04f, 1.333521504e-04f};

__device__ __forceinline__ void sincos_acc(float a, float& s, float& c) {
    const double x = (double)a, kd = __builtin_rint(x * 0.63661977236758134308);
    const int k = (int)kd; const double r = x - kd * 1.57079632679489661923, r2 = r * r;
    const double sp = r * (1.0 + r2 * (-1.0 / 6 + r2 * (1.0 / 120 + r2 * (-1.0 / 5040 + r2 * (1.0 / 362880 + r2 * (-1.0 / 39916800 + r2 * (1.0 / 6227020800.0)))))));
    const double cp = 1.0 + r2 * (-0.5 + r2 * (1.0 / 24 + r2 * (-1.0 / 720 + r2 * (1.0 / 40320 + r2 * (-1.0 / 3628800 + r2 * (1.0 / 479001600.0 + r2 * (-1.0 / 87178291200.0)))))));
    const int q = k & 3;
    const double sv = (q == 0) ? sp : (q == 1) ? cp : (q == 2) ? -sp : -cp, cv = (q == 0) ? cp : (q == 1) ? -sp : (q == 2) ? -cp : sp;
    s = (float)sv; c = (float)cv;
}

__device__ __forceinline__ void p0_transpose_item(const float* W, int K, int N, bf16_t* WT, LAS float* scr, int item, int lane, const float* kscale) {
    const int nblk = N / 32, kb = item / nblk, nb = item % nblk, k0 = 64 * kb, n0 = 32 * nb;
#pragma unroll 8
    for (int i = 0; i < 32; ++i) { const int kk = 2 * i + (lane >> 5); scr[kk * 33 + (lane & 31)] = W[(size_t)(k0 + kk) * N + n0 + (lane & 31)] * (kscale ? kscale[k0 + kk] : 1.0f); }
    LDS_WAIT(); asm volatile("" ::: "memory");
    const int c = lane & 7;
#pragma unroll
    for (int j = 0; j < 4; ++j) { const int n = (lane >> 3) + 8 * j; const LAS float* s = scr + (8 * c) * 33 + n;
        v4u o; o.x = pk2(s[0 * 33], s[1 * 33]); o.y = pk2(s[2 * 33], s[3 * 33]); o.z = pk2(s[4 * 33], s[5 * 33]); o.w = pk2(s[6 * 33], s[7 * 33]);
        *(v4u*)(WT + (size_t)(n0 + n) * K + k0 + 8 * c) = o; }
    LDS_WAIT(); asm volatile("" ::: "memory");
}

#define XB_TMO      128
#define XB_XCNT(j)  (256  + 64 * (j))
#define XB_XSUB(j)  (1280 + 64 * (j))
#define XB_XGEN(j)  (2304 + 64 * (j))
#define XB_TOP      3328
#define XB_TOPGEN   3392
#define XCD_BAR_WORDS 3456
#define XB_SPIN_CAP (1u << 18)

__device__ __forceinline__ unsigned xb_ld(unsigned* p)              { return __hip_atomic_load(p, __ATOMIC_RELAXED, __HIP_MEMORY_SCOPE_AGENT); }
__device__ __forceinline__ unsigned xb_add(unsigned* p, unsigned v) { return __hip_atomic_fetch_add(p, v, __ATOMIC_RELAXED, __HIP_MEMORY_SCOPE_AGENT); }
__device__ __forceinline__ unsigned xb_xcc_id() { return (unsigned)__builtin_amdgcn_s_getreg((3 << 11) | 20) & 0xFu; }
#define XB_SPIN(cond, bar) do { unsigned _sp = 0; while (cond) { __builtin_amdgcn_s_sleep(1); \
    if ((++_sp & 255u) == 0u) { if (xb_ld(&(bar)[XB_TMO])) break; if (_sp > XB_SPIN_CAP) { atomicAdd(&(bar)[XB_TMO], 1u); break; } } } } while (0)

struct XcdBarrier {
    unsigned* bar; unsigned x;
    volatile LAS unsigned* st;
};

__device__ __forceinline__ XcdBarrier xcd_barrier_post(unsigned* bar, volatile LAS unsigned* st) {
    XcdBarrier b; b.bar = bar; b.x = xb_xcc_id(); b.st = st;
    if (threadIdx.x == 0) (void)xb_add(&bar[XB_XCNT(b.x)], 1u);
    return b;
}
__device__ __forceinline__ void xcd_barrier_complete(unsigned* bar, unsigned x, unsigned& nloc, unsigned& nx) {
    const unsigned G = gridDim.x * gridDim.y * gridDim.z;
    unsigned sum, cnt, mine, sp = 0u;
    for (;;) {
        sum = 0u; cnt = 0u; mine = 0u;
#pragma unroll
        for (unsigned j = 0; j < 16; ++j) { const unsigned c = xb_ld(&bar[XB_XCNT(j)]); sum += c; cnt += (c > 0u) ? 1u : 0u; mine = (j == x) ? c : mine; }
        if (sum == G) break;
        __builtin_amdgcn_s_sleep(1);
        if ((++sp & 255u) == 0u) { if (xb_ld(&bar[XB_TMO])) break; if (sp > XB_SPIN_CAP) { atomicAdd(&bar[XB_TMO], 1u); break; } }
    }
    nloc = mine > 0u ? mine : 1u; nx = cnt > 0u ? cnt : 1u;
}

__device__ __forceinline__ void xcd_barrier(const XcdBarrier& b) {
    asm volatile("s_waitcnt vmcnt(0)" ::: "memory");
    __syncthreads();
    if (threadIdx.x == 0) {
        unsigned* bar = b.bar;
        __builtin_amdgcn_s_waitcnt(0);
        unsigned nloc = b.st[0], nx = b.st[1];
        if (nloc == 0u) { xcd_barrier_complete(bar, b.x, nloc, nx); b.st[0] = nloc; b.st[1] = nx; }
        const unsigned old = xb_add(&bar[XB_XSUB(b.x)], 1u);
        const unsigned gen = old / nloc;
        if (old + 1u == (gen + 1u) * nloc) {
            __builtin_amdgcn_fence(__ATOMIC_RELEASE, "agent");
            asm volatile("s_waitcnt vmcnt(0)" ::: "memory");
            const unsigned og = xb_add(&bar[XB_TOP], 1u);
            const unsigned tg = og / nx;
            if (og + 1u == (tg + 1u) * nx) xb_add(&bar[XB_TOPGEN], 1u);
            else XB_SPIN(xb_ld(&bar[XB_TOPGEN]) == tg, bar);
            __builtin_amdgcn_fence(__ATOMIC_ACQUIRE, "agent");
            xb_add(&bar[XB_XGEN(b.x)], 1u);
            asm volatile("s_waitcnt vmcnt(0)" ::: "memory");
        } else {
            XB_SPIN(xb_ld(&bar[XB_XGEN(b.x)]) == gen, bar);
            __builtin_amdgcn_fence(__ATOMIC_ACQUIRE, "agent");
            asm volatile("s_waitcnt vmcnt(0)" ::: "memory");
        }
    }
    __syncthreads();
}

constexpr size_t WS_CTL = 539 * MiB, CTL_BYTES = 16384;
constexpr int MISC_OFF = 147456 - 128;
__device__ __forceinline__ void gate_row(int m, int lane, const bf16_t* __restrict__ YA, const bf16_t* __restrict__ YB, const float* __restrict__ LSE, const bf16_t* __restrict__ PROJ,
                                         const float* __restrict__ wa, const float* __restrict__ wb, bf16_t* __restrict__ H) {
    v4u a[2], b0[2], b1[2], b2[2], ga[2], gb[2]; float l0[2], l1[2], l2[2];
#pragma unroll
    for (int j = 0; j < 2; ++j) { const int c = lane + 64 * j, hh = c >> 4;
        a[j] = *(const v4u*)(YA + (size_t)m * DA + 8 * c);
        b0[j] = *(const v4u*)(YB + ((size_t)0 * M + m) * DB + 8 * c); b1[j] = *(const v4u*)(YB + ((size_t)1 * M + m) * DB + 8 * c); b2[j] = *(const v4u*)(YB + ((size_t)2 * M + m) * DB + 8 * c);
        l0[j] = LSE[((size_t)0 * M + m) * 8 + hh]; l1[j] = LSE[((size_t)1 * M + m) * 8 + hh]; l2[j] = LSE[((size_t)2 * M + m) * 8 + hh];
        ga[j] = *(const v4u*)(PROJ + ((size_t)(H_GA + (c >> 4)) * M + m) * HD + 8 * (c & 15)); gb[j] = *(const v4u*)(PROJ + ((size_t)(H_GB + (c >> 4)) * M + m) * HD + 8 * (c & 15)); }
    float ya[2][8], yb[2][8]; float ssa = 0.f, ssb = 0.f;
#pragma unroll
    for (int j = 0; j < 2; ++j) {
        ya[j][0] = bflo(a[j].x); ya[j][1] = bfhi(a[j].x); ya[j][2] = bflo(a[j].y); ya[j][3] = bfhi(a[j].y); ya[j][4] = bflo(a[j].z); ya[j][5] = bfhi(a[j].z); ya[j][6] = bflo(a[j].w); ya[j][7] = bfhi(a[j].w);
        const float mx = fmaxf(l0[j], fmaxf(l1[j], l2[j])); const float e0 = __builtin_amdgcn_exp2f(l0[j] - mx), e1 = __builtin_amdgcn_exp2f(l1[j] - mx), e2 = __builtin_amdgcn_exp2f(l2[j] - mx);
        const float inv = __builtin_amdgcn_rcpf(e0 + e1 + e2); const float w0 = e0 * inv, w1 = e1 * inv, w2 = e2 * inv;
        yb[j][0] = w0 * bflo(b0[j].x) + w1 * bflo(b1[j].x) + w2 * bflo(b2[j].x); yb[j][1] = w0 * bfhi(b0[j].x) + w1 * bfhi(b1[j].x) + w2 * bfhi(b2[j].x);
        yb[j][2] = w0 * bflo(b0[j].y) + w1 * bflo(b1[j].y) + w2 * bflo(b2[j].y); yb[j][3] = w0 * bfhi(b0[j].y) + w1 * bfhi(b1[j].y) + w2 * bfhi(b2[j].y);
        yb[j][4] = w0 * bflo(b0[j].z) + w1 * bflo(b1[j].z) + w2 * bflo(b2[j].z); yb[j][5] = w0 * bfhi(b0[j].z) + w1 * bfhi(b1[j].z) + w2 * bfhi(b2[j].z);
        yb[j][6] = w0 * bflo(b0[j].w) + w1 * bflo(b1[j].w) + w2 * bflo(b2[j].w); yb[j][7] = w0 * bfhi(b0[j].w) + w1 * bfhi(b1[j].w) + w2 * bfhi(b2[j].w);
#pragma unroll
        for (int i = 0; i < 8; ++i) { ssa += ya[j][i] * ya[j][i]; ssb += yb[j][i] * yb[j][i]; } }
    const float ra = 1.0f / sqrtf(wave_sum(ssa) * (1.0f / DA) + EPS), rb = 1.0f / sqrtf(wave_sum(ssb) * (1.0f / DB) + EPS);
#pragma unroll
    for (int j = 0; j < 2; ++j) { const int c = lane + 64 * j;
        const float gaf[8] = {bflo(ga[j].x), bfhi(ga[j].x), bflo(ga[j].y), bfhi(ga[j].y), bflo(ga[j].z), bfhi(ga[j].z), bflo(ga[j].w), bfhi(ga[j].w)};
        const float gbf[8] = {bflo(gb[j].x), bfhi(gb[j].x), bflo(gb[j].y), bfhi(gb[j].y), bflo(gb[j].z), bfhi(gb[j].z), bflo(gb[j].w), bfhi(gb[j].w)};
        const f32x4 wa0 = *(const f32x4*)(wa + 8 * c), wa1 = *(const f32x4*)(wa + 8 * c + 4), wb0 = *(const f32x4*)(wb + 8 * c), wb1 = *(const f32x4*)(wb + 8 * c + 4);
        float za[8], zb[8];
#pragma unroll
        for (int i = 0; i < 8; ++i) { const float wai = i < 4 ? wa0[i & 3] : wa1[i & 3], wbi = i < 4 ? wb0[i & 3] : wb1[i & 3];
            const float sa = gaf[i] * __builtin_amdgcn_rcpf(1.0f + __builtin_amdgcn_exp2f(-1.4426950408889634f * gaf[i])), sb = gbf[i] * __builtin_amdgcn_rcpf(1.0f + __builtin_amdgcn_exp2f(-1.4426950408889634f * gbf[i]));
            za[i] = ya[j][i] * ra * wai * sa; zb[i] = yb[j][i] * rb * wbi * sb; }
        v4u oa, ob; oa.x = pk2(za[0], za[1]); oa.y = pk2(za[2], za[3]); oa.z = pk2(za[4], za[5]); oa.w = pk2(za[6], za[7]);
        ob.x = pk2(zb[0], zb[1]); ob.y = pk2(zb[2], zb[3]); ob.z = pk2(zb[4], zb[5]); ob.w = pk2(zb[6], zb[7]);
        *(v4u*)(H + (size_t)m * DM + 8 * c) = oa; *(v4u*)(H + (size_t)m * DM + DA + 8 * c) = ob; }
}

struct Params { const float *x, *norm_w, *w_in, *qn, *kn, *ona, *onb, *w_out, *fnorm; float* out; unsigned char* ws; int ph_lo, ph_hi; };

__global__ void __launch_bounds__(512, 2) mk_fwd(Params p) {
    extern __shared__ __attribute__((aligned(16))) unsigned char lds[];
    volatile LAS unsigned* MISC = (volatile LAS unsigned*)((LAS unsigned char*)lds + MISC_OFF);
    if (threadIdx.x < 32) MISC[threadIdx.x] = 0u;
    __syncthreads();
    XcdBarrier bar = xcd_barrier_post((unsigned*)(p.ws + WS_CTL), MISC + 8);
    if (p.ph_lo == 0) {
        float* RCOS0 = (float*)(p.ws + WS_ROPE); float* RSIN0 = RCOS0 + 192 * 32;
        for (int i = blockIdx.x * 512 + threadIdx.x; i < 192 * 32; i += gridDim.x * 512) {
            const int pos = i >> 5, f = i & 31; const float pv = (float)(pos < 128 ? pos : pos - 128);
            float sn_, cs_; sincos_acc(pv * INV_FREQ[f], sn_, cs_); RCOS0[i] = cs_; RSIN0[i] = sn_;
        }
    }
    for (int ph = p.ph_lo; ph < p.ph_hi; ++ph) {
        const int tid = otid(), lane = tid & 63, wave = __builtin_amdgcn_readfirstlane(tid >> 6);
        int G = gridDim.x, bx = blockIdx.x; asm volatile("" : "+s"(G), "+s"(bx));
        const int vcu = (G % 8 == 0) ? (bx % 8) * (G / 8) + bx / 8 : bx;
        const int gw = vcu * 8 + wave, NGW = G * 8;
        size_t zoff = 0; asm volatile("" : "+s"(zoff));
        unsigned char* ws = p.ws + zoff;
        bf16_t* W1T = (bf16_t*)(ws + WS_W1T); bf16_t* W2T = (bf16_t*)(ws + WS_W2T); bf16_t* H = (bf16_t*)(ws + WS_H); bf16_t* PROJ = (bf16_t*)(ws + WS_PROJ);
        bf16_t* YA = (bf16_t*)(ws + WS_YA); bf16_t* YB = (bf16_t*)(ws + WS_YB); float* LSE = (float*)(ws + WS_LSE);
        float* RCOS = (float*)(ws + WS_ROPE); float* RSIN = RCOS + 192 * 32;
        bf16_t* XB = (bf16_t*)(ws + WS_XB); float* ROWSQ = (float*)(ws + WS_ROWSQ);
        if (ph == 0) {
            LAS float* scr = (LAS float*)((LAS unsigned char*)lds + wave * 16384);
            constexpr int I1 = (DM / 64) * (DIN / 32), I2 = (DM / 64) * (DM / 32), IL = I1 + I2;
            DUPREP(0) for (int it = gw; it < DEPTH * IL; it += NGW) {
                const int l = it / IL, r = it % IL;
                if (r < I1) p0_transpose_item(p.w_in + (size_t)l * DM * DIN, DM, DIN, W1T + (size_t)l * DIN * DM, scr, r, lane, p.norm_w + (size_t)l * DM);
                else p0_transpose_item(p.w_out + (size_t)l * DM * DM, DM, DM, W2T + (size_t)l * DM * DM, scr, r - I1, lane, nullptr);
            }
            for (int m = gw; m < M; m += NGW) {
                const f32x4* xr = (const f32x4*)(p.x + (size_t)m * DM) + lane; v2u* o8 = (v2u*)(XB + (size_t)m * DM) + lane; float sq = 0.f;
#pragma unroll
                for (int j = 0; j < 8; ++j) { const f32x4 v = xr[64 * j]; v2u w; w.x = pk2(v.x, v.y); w.y = pk2(v.z, v.w); o8[64 * j] = w;
                    const float r0 = bflo(w.x), r1 = bfhi(w.x), r2 = bflo(w.y), r3 = bfhi(w.y); sq += (r0 * r0 + r1 * r1) + (r2 * r2 + r3 * r3); }
                sq = wave_sum(sq); if (lane < 32) ROWSQ[(size_t)m * 32 + lane] = (lane == 0) ? sq : 0.f;
            }
        } else if (ph == N_PHASES - 1) {
            for (int m = gw; m < M; m += NGW) {
                f32x4* xr = (f32x4*)(p.out + (size_t)m * DM) + lane; const f32x4* wr_ = (const f32x4*)p.fnorm + lane; const v2u* xb8 = (const v2u*)(XB + (size_t)m * DM) + lane;
                const float rstd = 1.0f / sqrtf(wave_sum(lane < 32 ? ROWSQ[((size_t)DEPTH * M + m) * 32 + lane] : 0.f) * (1.0f / DM) + EPS);
#pragma unroll
                for (int j = 0; j < 8; ++j) { const v2u w = xb8[64 * j]; const f32x4 v = {bflo(w.x), bfhi(w.x), bflo(w.y), bfhi(w.y)}; xr[64 * j] = v * rstd * wr_[64 * j]; }
            }
        } else {
            const int l = (ph - 1) / 5, st = (ph - 1) % 5 + 1;
            if (st == 1) {
                pg8::Gemm g{XB, W1T + (size_t)l * DIN * DM, M, DIN, DM}; pg8::StaticOrder S; S.init(M, DIN, G, bx);
                pg8::EpiHeadMajor E{PROJ, M, ROWSQ + (size_t)l * M * 32, 1.0f / DM, EPS};
#ifndef MK_NO_G1
                DUPREP(2) pg8::gemm_phase<pg8::EpiHeadMajor, pg8::StaticOrder, PG8_ALIGN, PG8_SP2>((PG8_LAS unsigned char*)lds, g, S, E);
#endif
            } else if (st == 2) {
                const float* qg = p.qn + l * HD; const float* kg = p.kn + l * HD;
                constexpr int QKU = 4;
                constexpr int NQKI = MK_QFUSE ? M * 2 / 4 : M * 10 / 4;
                for (int it0 = gw; it0 < NQKI; it0 += QKU * NGW) {
                    const int j = lane & 15, half = j >> 3, jj = j & 7, e = half * 64 + 4 * jj;
                    v2u a[QKU], b[QKU]; f32x4 cs[QKU], sn[QKU]; bf16_t* pp[QKU]; bool isq[QKU];
#pragma unroll
                    for (int u = 0; u < QKU; ++u) { const int it = min(it0 + u * NGW, NQKI - 1);
                        const int g = it * 4 + (lane >> 4), row = MK_QFUSE ? (g >> 1) : g / 10, hs = MK_QFUSE ? 8 + (g & 1) : g - row * 10; isq[u] = hs < 8;
                        pp[u] = PROJ + ((size_t)hs * M + row) * HD + e; a[u] = *(const v2u*)pp[u]; b[u] = *(const v2u*)(pp[u] + 32);
                        const int t = row & (T - 1), pos = half ? 128 + (t & 63) : (t >> 6);
                        cs[u] = *(const f32x4*)(RCOS + pos * 32 + 4 * jj); sn[u] = *(const f32x4*)(RSIN + pos * 32 + 4 * jj); }
                    asm volatile("" ::: "memory");
#pragma unroll
                    for (int u = 0; u < QKU; ++u) {
                        float x1[4] = {bflo(a[u].x), bfhi(a[u].x), bflo(a[u].y), bfhi(a[u].y)}, x2[4] = {bflo(b[u].x), bfhi(b[u].x), bflo(b[u].y), bfhi(b[u].y)};
                        float ss = 0.f;
#pragma unroll
                        for (int i = 0; i < 4; ++i) ss += x1[i] * x1[i] + x2[i] * x2[i];
                        ss += __shfl_xor(ss, 1); ss += __shfl_xor(ss, 2); ss += __shfl_xor(ss, 4); ss += __shfl_xor(ss, 8);
                        const float rstd = 1.0f / sqrtf(ss * (1.0f / HD) + EPS);
                        const float* gn = isq[u] ? qg : kg;
                        const float qsc = (MK_NEGM && isq[u]) ? att::SCALE * att::LOG2E : 1.0f;
                        const f32x4 g1 = *(const f32x4*)(gn + e), g2 = *(const f32x4*)(gn + e + 32);
                        float o1[4], o2[4];
#pragma unroll
                        for (int i = 0; i < 4; ++i) { const float y1 = x1[i] * rstd * g1[i], y2 = x2[i] * rstd * g2[i]; o1[i] = (y1 * cs[u][i] - y2 * sn[u][i]) * qsc; o2[i] = (y1 * sn[u][i] + y2 * cs[u][i]) * qsc; }
                        v2u w1, w2; w1.x = pk2(o1[0], o1[1]); w1.y = pk2(o1[2], o1[3]); w2.x = pk2(o2[0], o2[1]); w2.y = pk2(o2[2], o2[3]);
                        if (it0 + u * NGW < NQKI) { *(v2u*)pp[u] = w1; *(v2u*)(pp[u] + 32) = w2; }
                    }
                }
#ifndef MK_NO_DIL
                DUPREP(3) for (int u = vcu; u < 1536; u += G) {
                    const int pt = u >> 9, rem = u & 511, b = rem >> 8, h = (rem >> 5) & 7, w = rem & 31;
                    const int d = (pt == 0) ? 1 : (pt == 1) ? 4 : 16, res = w & (d - 1), blk = w / d, i0 = blk * 256, nsub = T / d;
                    const float slope = __builtin_amdgcn_exp2f(-(float)(h + 1));
                    const float nslopeC = -slope * (float)d * att::LOG2E;
                    const size_t tok0 = (size_t)b * T + res;
                    const att::bf16* Pb = (const att::bf16*)PROJ + ((size_t)h * M + tok0) * HD;
                    const long rs = (long)d * HD;
                    att::attn_body<true>(Pb + (size_t)H_QB * M * HD + (long)i0 * rs, Pb + (size_t)H_KB * M * HD, Pb + (size_t)H_VB * M * HD, rs, rs,
                                         (att::bf16*)YB + ((size_t)pt * M + tok0 + (size_t)i0 * d) * DB + h * HD, (long)d * DB,
                                         LSE + ((size_t)pt * M + tok0 + (size_t)i0 * d) * 8 + h, d * 8, i0, nsub, nslopeC, 0, (char*)lds);
                }
#endif
            } else if (st == 3) {
#ifndef MK_NO_DENSE
                int bounded;
                { const float* qg = p.qn + l * HD; const float* kg = p.kn + l * HD;
                  float gq = fmaxf(fabsf(qg[lane]), fabsf(qg[lane + 64])), gk = fmaxf(fabsf(kg[lane]), fabsf(kg[lane + 64]));
#pragma unroll
                  for (int o_ = 1; o_ < 64; o_ <<= 1) { gq = fmaxf(gq, __shfl_xor(gq, o_)); gk = fmaxf(gk, __shfl_xor(gk, o_)); }
                  const float bnd = gq * gk * 128.f * att::SCALE * att::LOG2E;
                  bounded = __builtin_amdgcn_readfirstlane((MK_NEGM && bnd <= 64.f) ? 1 : 0); }
                DUPREP(4) for (int u = vcu; u < 512; u += G) {
                    const int combo = u >> 7, b = combo >> 1, kvh = combo & 1, h = kvh * 4 + ((u >> 5) & 3), qb = u & 31;
                    const att::bf16* Pb = (const att::bf16*)PROJ + (size_t)b * T * HD;
                    att::attn_body<false>(Pb + ((size_t)(H_QA + h) * M + qb * 256) * HD, Pb + (size_t)(H_KA + kvh) * M * HD, Pb + (size_t)(H_VA + kvh) * M * HD, HD, HD,
                                          (att::bf16*)YA + ((size_t)b * T + qb * 256) * DA + h * HD, DA, nullptr, 0, bounded, 0, 0.f, T, (char*)lds,
                                          p.qn + l * HD, RCOS, RSIN, qb * 256);
                }
#endif
            } else if (st == 4) {
                const float* wa = p.ona + (size_t)l * DA; const float* wb = p.onb + (size_t)l * DB;
                DUPREP(5) for (int m = gw; m < M; m += 2 * NGW) {
                    gate_row(m, lane, YA, YB, LSE, PROJ, wa, wb, H);
                    if (m + NGW < M) gate_row(m + NGW, lane, YA, YB, LSE, PROJ, wa, wb, H);
                }
            } else {
                pg8::Gemm g{H, W2T + (size_t)l * DM * DM, M, DM, DM}; pg8::StaticOrder S; S.init(M, DM, G, bx);
                pg8::EpiResF32 E{XB, ROWSQ + (size_t)(l + 1) * M * 32, DM};
#ifndef MK_NO_G2
                pg8::gemm_phase<pg8::EpiResF32, pg8::StaticOrder, PG8_ALIGN, PG8_SP2>((PG8_LAS unsigned char*)lds, g, S, E);
#endif
            }
        }
        if (ph + 1 < p.ph_hi) { if (p.ph_hi > 4096) cg::this_grid().sync(); else xcd_barrier(bar); if (MK_DUP & 64) xcd_barrier(bar); }
    }
}

extern "C" void kernel_launch(void* const* d_in, const int* in_sizes, int n_in, void* d_out, int out_size, void* d_ws, size_t ws_size, hipStream_t stream) {
    static int grid = 0;
    if (grid == 0) {
        if (n_in != 9 || in_sizes[0] != M * DM || out_size != M * DM || ws_size < WS_END) { fprintf(stderr, "kernel_launch: unexpected shapes (n_in %d, ws %zu)\n", n_in, ws_size); grid = -1; return; }
        int dev = 0, cus = 0, per_cu = 0;
        hipGetDevice(&dev); hipDeviceGetAttribute(&cus, hipDeviceAttributeMultiprocessorCount, dev);
        if (hipFuncSetAttribute((const void*)mk_fwd, hipFuncAttributeMaxDynamicSharedMemorySize, LDS_BYTES) != hipSuccess) { fprintf(stderr, "kernel_launch: hipFuncSetAttribute failed\n"); grid = -1; return; }
        if (hipOccupancyMaxActiveBlocksPerMultiprocessor(&per_cu, (const void*)mk_fwd, 512, LDS_BYTES) != hipSuccess || per_cu < 1) per_cu = 1;
        (void)hipGetLastError();
        grid = cus * per_cu;
    }
    if (grid < 0) return;
    Params p{};
    p.x = (const float*)d_in[0]; p.norm_w = (const float*)d_in[1]; p.w_in = (const float*)d_in[2]; p.qn = (const float*)d_in[3]; p.kn = (const float*)d_in[4];
    p.ona = (const float*)d_in[5]; p.onb = (const float*)d_in[6]; p.w_out = (const float*)d_in[7]; p.fnorm = (const float*)d_in[8];
    p.out = (float*)d_out; p.ws = (unsigned char*)d_ws;
    if (hipMemsetAsync((char*)d_ws + WS_CTL, 0, CTL_BYTES, stream) != hipSuccess) { fprintf(stderr, "kernel_launch: memset failed\n"); return; }
#if MK_ONE_LAUNCH
    p.ph_lo = 0; p.ph_hi = N_PHASES;
    void* args[] = {&p};
    hipError_t e = hipLaunchCooperativeKernel((const void*)mk_fwd, dim3(grid), dim3(512), args, LDS_BYTES, stream);
    if (e != hipSuccess) fprintf(stderr, "kernel_launch: cooperative launch failed: %s (grid %d)\n", hipGetErrorString(e), grid);
#else
    for (int ph = 0; ph < N_PHASES; ++ph) { p.ph_lo = ph; p.ph_hi = ph + 1; hipLaunchKernelGGL(mk_fwd, dim3(grid), dim3(512), LDS_BYTES, stream, p); }
#endif
}
```
